# Optimizing an MI355X kernel written in HIP

```python
import math
import jax
import jax.numpy as jnp
from jax import lax
import numpy as np

D_MODEL = 1024
BATCH = 8
SEQ = 2048
DEPTH = 4

GRID_W = 64
CTX_LEN = 256
GROUP_W = D_MODEL // 4
D_MIX = 4 * GROUP_W
NA_HEADS = 4
NA_HD = GROUP_W // NA_HEADS
NA_KH = 8
NA_KW = 16
MLA_HEADS = 4
MLA_NOPE = 64
MLA_ROPE = 32
MLA_V = GROUP_W // MLA_HEADS
MLA_Q_RANK = 256
MLA_KV_RANK = 128
DIFF_HEADS = 4
DIFF_V = GROUP_W // DIFF_HEADS
DIFF_QK = DIFF_V // 2
SSD_D_INNER = GROUP_W
SSD_HD = 64
SSD_HEADS = SSD_D_INNER // SSD_HD
SSD_GROUPS = 2
SSD_STATE = 128
SSD_CONV = 5
SSD_CHUNK = 64
SSD_XBC = SSD_D_INNER + 2 * SSD_GROUPS * SSD_STATE
NA_IN = 3 * NA_HEADS * NA_HD
MLA_IN = MLA_Q_RANK + MLA_KV_RANK + MLA_ROPE
DIFF_IN = 2 * DIFF_HEADS * 2 * DIFF_QK + DIFF_HEADS * DIFF_V
SSD_IN = SSD_D_INNER + SSD_XBC + 2 * SSD_HEADS
N_IN = NA_IN + MLA_IN + DIFF_IN + SSD_IN
SPLIT_AT = [NA_IN, NA_IN + MLA_IN, NA_IN + MLA_IN + DIFF_IN]
ROPE_DIM = 32
ROPE_BASE = 10000.0
Q_BLOCK = 128
MOE_GROUPS = 4
MOE_EPG = 4
MOE_EXPERTS = MOE_GROUPS * MOE_EPG
MOE_TOP_K = 2
MOE_FF = 512
MOE_BLOCK = 128
NORM_EPS = 1e-6

kernel_name = 'hybrid_grid_flow_block'


def _rmsnorm(x, g):
    xf = x.astype(jnp.float32)
    y = xf * lax.rsqrt(jnp.mean(xf * xf, axis=-1, keepdims=True) + NORM_EPS)
    return (y * g.astype(jnp.float32)).astype(x.dtype)


def _axial_rope(n_tok, dtype):
    n_freq = ROPE_DIM // 4
    inv = jnp.power(ROPE_BASE, -jnp.arange(n_freq, dtype=jnp.float32) / n_freq)
    t = jnp.arange(n_tok, dtype=jnp.int32)
    row = (t // GRID_W).astype(jnp.float32)
    col = (t % GRID_W).astype(jnp.float32)
    ang = jnp.concatenate([row[:, None] * inv, col[:, None] * inv], axis=-1)
    return jnp.cos(ang).astype(dtype), jnp.sin(ang).astype(dtype)


def _apply_rope(x, cos, sin):
    half = x.shape[-1] // 2
    x1, x2 = x[..., :half], x[..., half:]
    return jnp.concatenate([x1 * cos - x2 * sin, x1 * sin + x2 * cos], axis=-1)


def _softmax_attend(q, k, v, scale):
    s = jnp.einsum('bqhd,bkhd->bhqk', q, k, preferred_element_type=jnp.float32) * scale
    p = jax.nn.softmax(s, axis=-1).astype(v.dtype)
    return jnp.einsum('bhqk,bkhd->bqhd', p, v)


def _diff_attend(q1, q2, k1, k2, v, lam, scale):
    s1 = jnp.einsum('bqhd,bkhd->bhqk', q1, k1, preferred_element_type=jnp.float32) * scale
    s2 = jnp.einsum('bqhd,bkhd->bhqk', q2, k2, preferred_element_type=jnp.float32) * scale
    p = (jax.nn.softmax(s1, axis=-1) - lam * jax.nn.softmax(s2, axis=-1)).astype(v.dtype)
    return jnp.einsum('bhqk,bkhd->bqhd', p, v)


def _over_query_blocks(fn, *qs):
    b, s = qs[0].shape[:2]
    nb = s // Q_BLOCK
    blocks = tuple(q.reshape((b, nb, Q_BLOCK) + q.shape[2:]).swapaxes(0, 1) for q in qs)
    out = lax.map(lambda qb: fn(*qb), blocks)
    return out.swapaxes(0, 1).reshape((b, s) + out.shape[3:])


def _na_mixer(p_ctx, p_lat, g_q, g_k, rel_bias, with_ctx_out):
    def heads(p):
        b, n = p.shape[:2]
        q, k, v = (t.reshape(b, n, NA_HEADS, NA_HD) for t in jnp.split(p, 3, axis=-1))
        return _rmsnorm(q, g_q), _rmsnorm(k, g_k), v
    qc, kc, vc = heads(p_ctx)
    ql, kl, vl = heads(p_lat)
    b, n = p_lat.shape[:2]
    n_ctx = kc.shape[1]
    rows = n // GRID_W
    kh = min(NA_KH, rows)
    scale = NA_HD ** -0.5
    r = np.arange(rows)
    row_idx = np.clip(r - kh // 2, 0, rows - kh)[:, None] + np.arange(kh)[None, :]
    cq = np.arange(GRID_W)
    col_lo = np.clip(cq - NA_KW // 2, 0, GRID_W - NA_KW)
    col_mask = (cq[None, :] >= col_lo[:, None]) & (cq[None, :] < col_lo[:, None] + NA_KW)
    row_off = row_idx - r[:, None] + (NA_KH - 1)
    col_off = np.clip(cq[None, :] - cq[:, None], 1 - NA_KW, NA_KW - 1) + (NA_KW - 1)
    bias = rel_bias[:, row_off[:, None, :, None], col_off[None, :, None, :]]
    bias = jnp.where(col_mask[None, None, :, None, :], bias, -jnp.inf)
    qg = ql.reshape(b, rows, GRID_W, NA_HEADS, NA_HD)
    kg = kl.reshape(b, rows, GRID_W, NA_HEADS, NA_HD)[:, row_idx]
    vg = vl.reshape(b, rows, GRID_W, NA_HEADS, NA_HD)[:, row_idx]
    s_nb = jnp.einsum('brqhd,brkwhd->bhrqkw', qg, kg, preferred_element_type=jnp.float32) * scale + bias[None]
    s_nb = s_nb.reshape(b, NA_HEADS, rows, GRID_W, kh * GRID_W)
    s_cx = jnp.einsum('brqhd,bchd->bhrqc', qg, kc, preferred_element_type=jnp.float32) * scale
    p = jax.nn.softmax(jnp.concatenate([s_cx, s_nb], axis=-1), axis=-1).astype(vl.dtype)
    p_nb = p[..., n_ctx:].reshape(b, NA_HEADS, rows, GRID_W, kh, GRID_W)
    o = (jnp.einsum('bhrqc,bchd->brqhd', p[..., :n_ctx], vc)
         + jnp.einsum('bhrqkw,brkwhd->brqhd', p_nb, vg))
    o_lat = o.reshape(b, n, NA_HEADS * NA_HD)
    o_ctx = _softmax_attend(qc, kc, vc, scale).reshape(b, n_ctx, -1) if with_ctx_out else None
    return o_ctx, o_lat


def _mla_project(p, g_qa, w_qb, g_kva, w_kvb, g_q, g_k, cos, sin):
    b, n = p.shape[:2]
    cq, ckv, kr = jnp.split(p, [MLA_Q_RANK, MLA_Q_RANK + MLA_KV_RANK], axis=-1)
    q = (_rmsnorm(cq, g_qa) @ w_qb).reshape(b, n, MLA_HEADS, MLA_NOPE + MLA_ROPE)
    kv = (_rmsnorm(ckv, g_kva) @ w_kvb).reshape(b, n, MLA_HEADS, MLA_NOPE + MLA_V)
    k_nope, v = jnp.split(kv, [MLA_NOPE], axis=-1)
    k = jnp.concatenate([k_nope, jnp.broadcast_to(kr[:, :, None, :], (b, n, MLA_HEADS, MLA_ROPE))], axis=-1)
    q = _rmsnorm(q, g_q)
    k = _rmsnorm(k, g_k)
    if cos is not None:
        q = jnp.concatenate([q[..., :MLA_NOPE], _apply_rope(q[..., MLA_NOPE:], cos[:, None], sin[:, None])], axis=-1)
        k = jnp.concatenate([k[..., :MLA_NOPE], _apply_rope(k[..., MLA_NOPE:], cos[:, None], sin[:, None])], axis=-1)
    return q, k, v


def _mla_mixer(p_ctx, p_lat, cos, sin, g_qa, w_qb, g_kva, w_kvb, g_q, g_k, with_ctx_out):
    qc, kc, vc = _mla_project(p_ctx, g_qa, w_qb, g_kva, w_kvb, g_q, g_k, None, None)
    ql, kl, vl = _mla_project(p_lat, g_qa, w_qb, g_kva, w_kvb, g_q, g_k, cos, sin)
    scale = (MLA_NOPE + MLA_ROPE) ** -0.5
    k_all = jnp.concatenate([kc, kl], axis=1)
    v_all = jnp.concatenate([vc, vl], axis=1)
    o_lat = _over_query_blocks(lambda qb: _softmax_attend(qb, k_all, v_all, scale), ql)
    b, n = p_lat.shape[:2]
    o_ctx = _softmax_attend(qc, kc, vc, scale).reshape(b, kc.shape[1], -1) if with_ctx_out else None
    return o_ctx, o_lat.reshape(b, n, -1)


def _diff_mixer(p_ctx, p_lat, cos, sin, g_q, g_k, lam_vecs, g_sub, lam_init, with_ctx_out):
    def heads(p, cos_t, sin_t):
        b, n = p.shape[:2]
        nq = DIFF_HEADS * 2 * DIFF_QK
        q, k, v = jnp.split(p, [nq, 2 * nq], axis=-1)
        q = _rmsnorm(q.reshape(b, n, DIFF_HEADS, 2, DIFF_QK), g_q)
        k = _rmsnorm(k.reshape(b, n, DIFF_HEADS, 2, DIFF_QK), g_k)
        if cos_t is not None:
            q = _apply_rope(q, cos_t[:, None, None], sin_t[:, None, None])
            k = _apply_rope(k, cos_t[:, None, None], sin_t[:, None, None])
        return q[..., 0, :], q[..., 1, :], k[..., 0, :], k[..., 1, :], v.reshape(b, n, DIFF_HEADS, DIFF_V)
    lv = lam_vecs.astype(jnp.float32)
    lam = jnp.exp(jnp.sum(lv[0] * lv[1])) - jnp.exp(jnp.sum(lv[2] * lv[3])) + lam_init
    scale = DIFF_QK ** -0.5
    q1c, q2c, k1c, k2c, vc = heads(p_ctx, None, None)
    q1l, q2l, k1l, k2l, vl = heads(p_lat, cos, sin)
    k1 = jnp.concatenate([k1c, k1l], axis=1)
    k2 = jnp.concatenate([k2c, k2l], axis=1)
    v_all = jnp.concatenate([vc, vl], axis=1)
    o_lat = _over_query_blocks(lambda q1b, q2b: _diff_attend(q1b, q2b, k1, k2, v_all, lam, scale), q1l, q2l)

    def finish(o):
        return (_rmsnorm(o, g_sub) * (1.0 - lam_init)).reshape(o.shape[0], o.shape[1], -1)
    o_ctx = finish(_diff_attend(q1c, q2c, k1c, k2c, vc, lam, scale)) if with_ctx_out else None
    return o_ctx, finish(o_lat)


def _dwconv_centred(u, w, bias):
    k = w.shape[0]
    out = lax.conv_general_dilated(u, w[:, None, :], window_strides=(1,), padding=[(k // 2, k // 2)],
                                   dimension_numbers=('NWC', 'WIO', 'NWC'), feature_group_count=u.shape[-1])
    return out + bias


def _ssd_chunked(x, dt, a, b_in, c_in, h0):
    bsz, seqlen, nh, hp = x.shape
    ng, ns = b_in.shape[2], b_in.shape[3]
    nc = seqlen // SSD_CHUNK
    rep = nh // ng
    xdt = (x * dt[..., None]).reshape(bsz, nc, SSD_CHUNK, nh, hp)
    bh = jnp.repeat(b_in, rep, axis=2).reshape(bsz, nc, SSD_CHUNK, nh, ns)
    ch = jnp.repeat(c_in, rep, axis=2).reshape(bsz, nc, SSD_CHUNK, nh, ns)
    la = (dt.astype(jnp.float32) * a).reshape(bsz, nc, SSD_CHUNK, nh).transpose(0, 1, 3, 2)
    la_cum = jnp.cumsum(la, axis=-1)
    tril = np.tril(np.ones((SSD_CHUNK, SSD_CHUNK), dtype=bool))
    seg = la_cum[..., :, None] - la_cum[..., None, :]
    decay = jnp.where(tril, jnp.exp(jnp.where(tril, seg, 0.0)), 0.0).astype(x.dtype)
    scores = jnp.einsum('bclhn,bcshn->bchls', ch, bh) * decay
    y_diag = jnp.einsum('bchls,bcshp->bclhp', scores, xdt)
    to_end = jnp.exp(la_cum[..., -1:] - la_cum).astype(x.dtype)
    chunk_states = jnp.einsum('bclhn,bchl,bclhp->bchpn', bh, to_end, xdt)
    chunk_decay = jnp.exp(la_cum[..., -1]).astype(x.dtype)

    def step(h, inp):
        st, dec = inp
        return h * dec[..., None, None] + st, h
    h_final, h_enter = lax.scan(step, h0, (jnp.moveaxis(chunk_states, 1, 0), jnp.moveaxis(chunk_decay, 1, 0)))
    h_enter = jnp.moveaxis(h_enter, 0, 1)
    y_off = jnp.einsum('bclhn,bchpn,bchl->bclhp', ch, h_enter, jnp.exp(la_cum).astype(x.dtype))
    return (y_diag + y_off).reshape(bsz, seqlen, nh, hp), h_final


def _ssd_mixer(p_ctx, p_lat, conv_w, conv_b, dt_bias, a_log, d_skip, g_norm, with_ctx_out):
    def prep(p):
        b, n = p.shape[:2]
        z, xbc, dt_raw = jnp.split(p, [SSD_D_INNER, SSD_D_INNER + SSD_XBC], axis=-1)
        xbc = jax.nn.silu(_dwconv_centred(xbc, conv_w, conv_b))
        xs, bs, cs = jnp.split(xbc, [SSD_D_INNER, SSD_D_INNER + SSD_GROUPS * SSD_STATE], axis=-1)
        return (z, xs.reshape(b, n, SSD_HEADS, SSD_HD), bs.reshape(b, n, SSD_GROUPS, SSD_STATE),
                cs.reshape(b, n, SSD_GROUPS, SSD_STATE), dt_raw.reshape(b, n, 2, SSD_HEADS))
    zc, xc, bc, cc, dtc = prep(p_ctx)
    zl, xl, bl, cl, dtl = prep(p_lat)
    bsz = xl.shape[0]
    ys_c, ys_l = [], []
    for d in range(2):
        flip = (lambda u: jnp.flip(u, axis=1)) if d == 1 else (lambda u: u)
        a = -jnp.exp(a_log[d].astype(jnp.float32))
        dt_c = jax.nn.softplus(dtc[:, :, d] + dt_bias[d])
        dt_l = jax.nn.softplus(dtl[:, :, d] + dt_bias[d])
        h0 = jnp.zeros((bsz, SSD_HEADS, SSD_HD, SSD_STATE), xl.dtype)
        yc, h_ctx = _ssd_chunked(flip(xc), flip(dt_c), a, flip(bc), flip(cc), h0)
        yl, _ = _ssd_chunked(flip(xl), flip(dt_l), a, flip(bl), flip(cl), h_ctx)
        ys_c.append(flip(yc) + d_skip[d][:, None] * xc)
        ys_l.append(flip(yl) + d_skip[d][:, None] * xl)

    def finish(y, z):
        b, n = z.shape[:2]
        return _rmsnorm(y.reshape(b, n, SSD_D_INNER) * jax.nn.silu(z), g_norm)
    o_ctx = finish(ys_c[0] + ys_c[1], zc) if with_ctx_out else None
    return o_ctx, finish(ys_l[0] + ys_l[1], zl)


def _moe_dispatch(h, expert_idx, expert_w, w_gate, w_up, w_down):
    n_tok, d = h.shape
    k = expert_idx.shape[1]
    n_asg = n_tok * k
    n_exp = w_gate.shape[0]
    flat_e = expert_idx.reshape(-1)
    order = jnp.argsort(flat_e)
    sorted_e = flat_e[order]
    counts = jnp.bincount(flat_e, length=n_exp)
    padded = (counts + MOE_BLOCK - 1) // MOE_BLOCK * MOE_BLOCK
    pad_end = jnp.cumsum(padded)
    pad_start = pad_end - padded
    seg_start = jnp.cumsum(counts) - counts
    dest = pad_start[sorted_e] + jnp.arange(n_asg, dtype=jnp.int32) - seg_start[sorted_e]
    n_blocks = -(-n_asg // MOE_BLOCK) + n_exp
    cap = n_blocks * MOE_BLOCK
    slot_tok = jnp.full((cap,), n_tok, jnp.int32).at[dest].set((order // k).astype(jnp.int32))
    slot_w = jnp.zeros((cap,), h.dtype).at[dest].set(expert_w.reshape(-1)[order])
    block_e = jnp.minimum(jnp.searchsorted(pad_end, jnp.arange(n_blocks) * MOE_BLOCK, side='right'), n_exp - 1)
    h_pad = jnp.concatenate([h, jnp.zeros((1, d), h.dtype)], axis=0)

    def run_block(args):
        tok, e = args
        xb = h_pad[tok]
        return (jax.nn.silu(xb @ w_gate[e]) * (xb @ w_up[e])) @ w_down[e]
    y = lax.map(run_block, (slot_tok.reshape(n_blocks, MOE_BLOCK), block_e)).reshape(cap, d)
    out = jnp.zeros((n_tok + 1, d), h.dtype).at[slot_tok].add(y * slot_w[:, None])
    return out[:n_tok]


def _hier_moe(h, w_group, b_group, w_expert, b_expert, w_gate, w_up, w_down):
    n_tok = h.shape[0]
    g_prob = jax.nn.softmax((h @ w_group + b_group).astype(jnp.float32), axis=-1)
    g_top_p, g_top = lax.top_k(g_prob, 1)
    e_logits = (h @ w_expert + b_expert).astype(jnp.float32).reshape(n_tok, MOE_GROUPS, MOE_EPG)
    e_in = jnp.take_along_axis(e_logits, g_top[:, :, None], axis=1)[:, 0]
    e_top_l, e_top = lax.top_k(e_in, MOE_TOP_K)
    e_w = jax.nn.softmax(e_top_l, axis=-1) * g_top_p
    expert_idx = g_top * MOE_EPG + e_top
    return _moe_dispatch(h, expert_idx, e_w.astype(h.dtype), w_gate, w_up, w_down)


def setup_inputs(seed: int = 0) -> dict:
    key = jax.random.key(seed)
    keys = iter(jax.random.split(key, 40))
    f32 = jnp.float32
    L, D = DEPTH, D_MODEL

    def nrm(shape, std):
        return jax.random.normal(next(keys), shape, f32) * std

    def gain(shape):
        return 1.0 + nrm(shape, 0.02)
    x = nrm((BATCH, SEQ, D), 1.0)
    c = nrm((BATCH, D), 1.0)
    ctx = nrm((BATCH, CTX_LEN, D), 1.0)
    c_ctx = nrm((D,), 1.0)
    w_mod = nrm((L, D, 6 * D), 0.5 * D ** -0.5)
    b_mod = nrm((L, 6 * D), 0.02)
    g_mix = gain((L, D))
    w_in = nrm((L, D, N_IN), D ** -0.5)
    w_out = nrm((L, D_MIX, D), D_MIX ** -0.5)
    na_g_q = gain((L, NA_HD))
    na_g_k = gain((L, NA_HD))
    na_rel_bias = nrm((L, NA_HEADS, 2 * NA_KH - 1, 2 * NA_KW - 1), 0.1)
    mla_g_qa = gain((L, MLA_Q_RANK))
    mla_w_qb = nrm((L, MLA_Q_RANK, MLA_HEADS * (MLA_NOPE + MLA_ROPE)), MLA_Q_RANK ** -0.5)
    mla_g_kva = gain((L, MLA_KV_RANK))
    mla_w_kvb = nrm((L, MLA_KV_RANK, MLA_HEADS * (MLA_NOPE + MLA_V)), MLA_KV_RANK ** -0.5)
    mla_g_q = gain((L, MLA_NOPE + MLA_ROPE))
    mla_g_k = gain((L, MLA_NOPE + MLA_ROPE))
    diff_g_q = gain((L, DIFF_QK))
    diff_g_k = gain((L, DIFF_QK))
    diff_lambda = nrm((L, 4, DIFF_QK), 0.1)
    diff_g_sub = gain((L, DIFF_V))
    ssd_conv_w = nrm((L, SSD_CONV, SSD_XBC), SSD_CONV ** -0.5)
    ssd_conv_b = nrm((L, SSD_XBC), 0.02)
    dt0 = jnp.exp(jax.random.uniform(next(keys), (L, 2, SSD_HEADS), f32, math.log(1e-3), math.log(1e-1)))
    ssd_dt_bias = dt0 + jnp.log(-jnp.expm1(-dt0))
    ssd_a_log = jnp.log(jax.random.uniform(next(keys), (L, 2, SSD_HEADS), f32, 1.0, 16.0))
    ssd_d = 1.0 + nrm((L, 2, SSD_HEADS), 0.1)
    ssd_g_norm = gain((L, SSD_D_INNER))
    g_ffn = gain((L, D))
    moe_w_group = nrm((L, D, MOE_GROUPS), D ** -0.5)
    moe_b_group = nrm((L, MOE_GROUPS), 0.01)
    moe_w_expert = nrm((L, D, MOE_EXPERTS), D ** -0.5)
    moe_b_expert = nrm((L, MOE_EXPERTS), 0.01)
    moe_w_gate = nrm((L, MOE_EXPERTS, D, MOE_FF), D ** -0.5)
    moe_w_up = nrm((L, MOE_EXPERTS, D, MOE_FF), D ** -0.5)
    moe_w_down = nrm((L, MOE_EXPERTS, MOE_FF, D), MOE_FF ** -0.5)
    return {'x': x, 'c': c, 'ctx': ctx, 'c_ctx': c_ctx, 'w_mod': w_mod, 'b_mod': b_mod,
            'g_mix': g_mix, 'w_in': w_in, 'w_out': w_out,
            'na_g_q': na_g_q, 'na_g_k': na_g_k, 'na_rel_bias': na_rel_bias,
            'mla_g_qa': mla_g_qa, 'mla_w_qb': mla_w_qb, 'mla_g_kva': mla_g_kva, 'mla_w_kvb': mla_w_kvb,
            'mla_g_q': mla_g_q, 'mla_g_k': mla_g_k,
            'diff_g_q': diff_g_q, 'diff_g_k': diff_g_k, 'diff_lambda': diff_lambda, 'diff_g_sub': diff_g_sub,
            'ssd_conv_w': ssd_conv_w, 'ssd_conv_b': ssd_conv_b, 'ssd_dt_bias': ssd_dt_bias,
            'ssd_a_log': ssd_a_log, 'ssd_d': ssd_d, 'ssd_g_norm': ssd_g_norm,
            'g_ffn': g_ffn, 'moe_w_group': moe_w_group, 'moe_b_group': moe_b_group,
            'moe_w_expert': moe_w_expert, 'moe_b_expert': moe_b_expert,
            'moe_w_gate': moe_w_gate, 'moe_w_up': moe_w_up, 'moe_w_down': moe_w_down}


def reference(x, c, ctx, c_ctx, w_mod, b_mod, g_mix, w_in, w_out, na_g_q, na_g_k, na_rel_bias,
              mla_g_qa, mla_w_qb, mla_g_kva, mla_w_kvb, mla_g_q, mla_g_k,
              diff_g_q, diff_g_k, diff_lambda, diff_g_sub,
              ssd_conv_w, ssd_conv_b, ssd_dt_bias, ssd_a_log, ssd_d, ssd_g_norm,
              g_ffn, moe_w_group, moe_b_group, moe_w_expert, moe_b_expert, moe_w_gate, moe_w_up, moe_w_down):
    bsz, n_lat, d_model = x.shape
    n_ctx = ctx.shape[1]
    cos, sin = _axial_rope(n_lat, x.dtype)
    silu_c = jax.nn.silu(c)
    silu_cc = jax.nn.silu(c_ctx)
    h_lat, h_ctx = x, ctx
    for layer in range(DEPTH):
        ctx_out = layer < DEPTH - 1
        mod_l = jnp.split((silu_c @ w_mod[layer] + b_mod[layer])[:, None, :], 6, axis=-1)
        mod_c = jnp.split(silu_cc @ w_mod[layer] + b_mod[layer], 6, axis=-1)
        a_lat = _rmsnorm(h_lat, g_mix[layer]) * (1 + mod_l[1]) + mod_l[0]
        a_ctx = _rmsnorm(h_ctx, g_mix[layer]) * (1 + mod_c[1]) + mod_c[0]
        p_lat = jnp.split(a_lat @ w_in[layer], SPLIT_AT, axis=-1)
        p_ctx = jnp.split(a_ctx @ w_in[layer], SPLIT_AT, axis=-1)
        lam_init = 0.8 - 0.6 * math.exp(-0.3 * layer)
        outs = [
            _na_mixer(p_ctx[0], p_lat[0], na_g_q[layer], na_g_k[layer], na_rel_bias[layer], ctx_out),
            _mla_mixer(p_ctx[1], p_lat[1], cos, sin, mla_g_qa[layer], mla_w_qb[layer], mla_g_kva[layer],
                       mla_w_kvb[layer], mla_g_q[layer], mla_g_k[layer], ctx_out),
            _diff_mixer(p_ctx[2], p_lat[2], cos, sin, diff_g_q[layer], diff_g_k[layer], diff_lambda[layer],
                        diff_g_sub[layer], lam_init, ctx_out),
            _ssd_mixer(p_ctx[3], p_lat[3], ssd_conv_w[layer], ssd_conv_b[layer], ssd_dt_bias[layer],
                       ssd_a_log[layer], ssd_d[layer], ssd_g_norm[layer], ctx_out),
        ]
        h_lat = h_lat + mod_l[2] * (jnp.concatenate([o[1] for o in outs], axis=-1) @ w_out[layer])
        if ctx_out:
            h_ctx = h_ctx + mod_c[2] * (jnp.concatenate([o[0] for o in outs], axis=-1) @ w_out[layer])
        moe_p = (moe_w_group[layer], moe_b_group[layer], moe_w_expert[layer], moe_b_expert[layer],
                 moe_w_gate[layer], moe_w_up[layer], moe_w_down[layer])
        f_lat = (_rmsnorm(h_lat, g_ffn[layer]) * (1 + mod_l[4]) + mod_l[3]).reshape(-1, d_model)
        if ctx_out:
            f_ctx = (_rmsnorm(h_ctx, g_ffn[layer]) * (1 + mod_c[4]) + mod_c[3]).reshape(-1, d_model)
            y = _hier_moe(jnp.concatenate([f_ctx, f_lat], axis=0), *moe_p)
            n_ctx_tok = f_ctx.shape[0]
            h_ctx = h_ctx + mod_c[5] * y[:n_ctx_tok].reshape(bsz, n_ctx, d_model)
            y_lat = y[n_ctx_tok:]
        else:
            y_lat = _hier_moe(f_lat, *moe_p)
        h_lat = h_lat + mod_l[5] * y_lat.reshape(bsz, n_lat, d_model)
    return h_lat
```

```cpp
#include <hip/hip_runtime.h>
#include <cstdio>
#include <cstdint>

#ifndef MK_ONE_LAUNCH
#define MK_ONE_LAUNCH 0
#endif

#define LAS __attribute__((address_space(3)))
typedef unsigned short bf16;
typedef short bf16x8 __attribute__((ext_vector_type(8)));
typedef float f32x4 __attribute__((ext_vector_type(4)));
typedef float f32x2 __attribute__((ext_vector_type(2)));
typedef unsigned u32x4 __attribute__((ext_vector_type(4)));
typedef unsigned u32x2 __attribute__((ext_vector_type(2)));

constexpr int NB = 8, TLAT = 2048, TCTX = 256, SQ = 2304, DM = 1024, DEPTH = 4;
constexpr int NLAT = NB * TLAT, NCTXR = NB * TCTX, NROW = NLAT + NCTXR;
constexpr int NIN = 2984, NP = 3072;
constexpr int C_NA = 0, C_MLA = 768, C_DF = 1184, C_SSD = 1952;
constexpr int C_Z = C_SSD, C_XBC = C_SSD + 256, C_DT = C_SSD + 1024;
constexpr float EPS = 1e-6f;
constexpr int NEXP = 16, FF = 512, ACT_ROWS = 40960;
constexpr int NPH_L = 9, PH_FINAL = 1 + NPH_L * DEPTH, NPHASE = PH_FINAL + 1;

constexpr size_t MiB = 1u << 20;
constexpr size_t WS_CTL = 0, CTL_BYTES = 1 * MiB;
constexpr size_t WS_MOD = 1 * MiB;
constexpr size_t WS_ROPE = 2 * MiB;
constexpr size_t WS_WIN = 4 * MiB;
constexpr size_t WS_WOUT = 28 * MiB;
constexpr size_t WS_WQB = 36 * MiB;
constexpr size_t WS_WKVB = 37 * MiB;
constexpr size_t WS_WGU = 38 * MiB;
constexpr size_t WS_WD = 70 * MiB;
constexpr size_t WS_HC = 86 * MiB;
constexpr size_t WS_A = 94 * MiB;
constexpr size_t WS_P = 130 * MiB;
constexpr size_t WS_ACT = 130 * MiB;
constexpr size_t WS_YK = 170 * MiB;
constexpr size_t WS_MIX = 238 * MiB;
constexpr size_t WS_QNA = 274 * MiB, WS_KNA = 283 * MiB, WS_VNA = 292 * MiB;
constexpr size_t WS_QML = 301 * MiB, WS_KML = 315 * MiB, WS_VML = 329 * MiB;
constexpr size_t WS_QDF = 338 * MiB, WS_KDF = 347 * MiB, WS_VDF = 356 * MiB;
constexpr size_t WS_XT = 365 * MiB, WS_BTM = 374 * MiB, WS_BT = 383 * MiB, WS_CTM = 392 * MiB;
constexpr size_t WS_DT = 401 * MiB;
constexpr size_t WS_CST = 402 * MiB;
constexpr size_t WS_CDEC = 474 * MiB;
constexpr size_t WS_HENT = 475 * MiB;
constexpr size_t WS_RT = 511 * MiB;
constexpr size_t WS_ELIST = 512 * MiB;
constexpr size_t WS_END = 514 * MiB;
constexpr int CW_BAR = 4096;
constexpr int CW_ECNT = 16384;

constexpr int RING_BYTES = 131072, LDSCTL_OFF = RING_BYTES, LDS_BYTES = 147456;

__device__ __forceinline__ float bf2f(bf16 v) { return __uint_as_float(((unsigned)v) << 16); }
__device__ __forceinline__ bf16 f2bf(float f) { unsigned u = __float_as_uint(f); return (bf16)((u + 0x7fffu + ((u >> 16) & 1u)) >> 16); }
__device__ __forceinline__ unsigned pk2(float lo, float hi) { return (unsigned)f2bf(lo) | ((unsigned)f2bf(hi) << 16); }
__device__ __forceinline__ float wsum(float v) {
#pragma unroll
    for (int o = 32; o >= 1; o >>= 1) v += __shfl_xor(v, o);
    return v; }
__device__ __forceinline__ float wmaxf(float v) {
#pragma unroll
    for (int o = 32; o >= 1; o >>= 1) v = fmaxf(v, __shfl_xor(v, o));
    return v; }
#define LDS_WAIT() asm volatile("s_waitcnt lgkmcnt(0)" ::: "memory")
__device__ __forceinline__ void row2bs(int r, int& b, int& s) { if (r < NLAT) { b = r >> 11; s = 256 + (r & 2047); } else { const int j = r - NLAT; b = j >> 8; s = j & 255; } }
__device__ __forceinline__ int bs2row(int b, int s) { return s < 256 ? NLAT + b * 256 + s : b * 2048 + s - 256; }
__device__ __forceinline__ int vpos(int s) { return (s & ~12) | ((s & 4) << 1) | ((s & 8) >> 1); }
__device__ __forceinline__ float siluf(float x) { return x / (1.f + __expf(-x)); }

#define XB_TMO      128
#define XB_XCNT(j)  (256  + 64 * (j))
#define XB_XSUB(j)  (1280 + 64 * (j))
#define XB_XGEN(j)  (2304 + 64 * (j))
#define XB_TOP      3328
#define XB_TOPGEN   3392
#define XCD_BAR_WORDS 3456
#define XB_SPIN_CAP (1u << 18)
__device__ __forceinline__ unsigned xb_ld(unsigned* p)              { return __hip_atomic_load(p, __ATOMIC_RELAXED, __HIP_MEMORY_SCOPE_AGENT); }
__device__ __forceinline__ unsigned xb_add(unsigned* p, unsigned v) { return __hip_atomic_fetch_add(p, v, __ATOMIC_RELAXED, __HIP_MEMORY_SCOPE_AGENT); }
__device__ __forceinline__ unsigned xb_xcc_id() { return (unsigned)__builtin_amdgcn_s_getreg((3 << 11) | 20) & 0xFu; }
#define XB_SPIN(cond, bar) do { unsigned _sp = 0; while (cond) { __builtin_amdgcn_s_sleep(1); \
    if ((++_sp & 255u) == 0u) { if (xb_ld(&(bar)[XB_TMO])) break; if (_sp > XB_SPIN_CAP) { atomicAdd(&(bar)[XB_TMO], 1u); break; } } } } while (0)
struct XcdBarrier { unsigned* bar; unsigned x; volatile LAS unsigned* st; };
__device__ __forceinline__ XcdBarrier xcd_barrier_post(unsigned* bar, volatile LAS unsigned* st) {
    XcdBarrier b; b.bar = bar; b.x = xb_xcc_id(); b.st = st;
    if (threadIdx.x == 0) (void)xb_add(&bar[XB_XCNT(b.x)], 1u);
    return b;
}
__device__ __forceinline__ void xcd_barrier_complete(unsigned* bar, unsigned x, unsigned& nloc, unsigned& nx) {
    const unsigned G = gridDim.x * gridDim.y * gridDim.z;
    unsigned sum, cnt, mine, sp = 0u;
    for (;;) {
        sum = 0u; cnt = 0u; mine = 0u;
#pragma unroll
        for (unsigned j = 0; j < 16; ++j) { const unsigned c = xb_ld(&bar[XB_XCNT(j)]); sum += c; cnt += (c > 0u) ? 1u : 0u; mine = (j == x) ? c : mine; }
        if (sum == G) break;
        __builtin_amdgcn_s_sleep(1);
        if ((++sp & 255u) == 0u) { if (xb_ld(&bar[XB_TMO])) break; if (sp > XB_SPIN_CAP) { atomicAdd(&bar[XB_TMO], 1u); break; } }
    }
    nloc = mine > 0u ? mine : 1u; nx = cnt > 0u ? cnt : 1u;
}
__device__ __forceinline__ void xcd_barrier(const XcdBarrier& b) {
    asm volatile("s_waitcnt vmcnt(0)" ::: "memory");
    __syncthreads();
    if (threadIdx.x == 0) {
        unsigned* bar = b.bar;
        __builtin_amdgcn_s_waitcnt(0);
        unsigned nloc = b.st[0], nx = b.st[1];
        if (nloc == 0u) { xcd_barrier_complete(bar, b.x, nloc, nx); b.st[0] = nloc; b.st[1] = nx; }
        const unsigned old = xb_add(&bar[XB_XSUB(b.x)], 1u);
        const unsigned gen = old / nloc;
        if (old + 1u == (gen + 1u) * nloc) {
            __builtin_amdgcn_fence(__ATOMIC_RELEASE, "agent");
            asm volatile("s_waitcnt vmcnt(0)" ::: "memory");
            const unsigned og = xb_add(&bar[XB_TOP], 1u);
            const unsigned tg = og / nx;
            if (og + 1u == (tg + 1u) * nx) xb_add(&bar[XB_TOPGEN], 1u);
            else XB_SPIN(xb_ld(&bar[XB_TOPGEN]) == tg, bar);
            __builtin_amdgcn_fence(__ATOMIC_ACQUIRE, "agent");
            xb_add(&bar[XB_XGEN(b.x)], 1u);
            asm volatile("s_waitcnt vmcnt(0)" ::: "memory");
        } else {
            XB_SPIN(xb_ld(&bar[XB_XGEN(b.x)]) == gen, bar);
            __builtin_amdgcn_fence(__ATOMIC_ACQUIRE, "agent");
            asm volatile("s_waitcnt vmcnt(0)" ::: "memory");
        }
    }
    __syncthreads();
}

namespace pg8 {
constexpr int BM = 256, BK = 64, HALF = 128, HTB = HALF * BK * 2, NXCD = 8, WGM = 8;
__device__ __forceinline__ int lds_byte(int r, int c) { const int st = (r >> 4) * 2 + (c >> 5), rr = r & 15, cc = c & 31, ob = rr * 64 + cc * 2; return st * 1024 + (ob ^ (((ob >> 9) & 1) << 5)); }
__device__ __forceinline__ void stage_rc(int b, int& R, int& C) { const int st = b / 1024, sb = b % 1024, swz = sb ^ (((sb >> 9) & 1) << 5); R = (st >> 1) * 16 + swz / 64; C = (st & 1) * 32 + (swz % 64) / 2; }
__device__ __forceinline__ int perm32(int rho) { const int n = rho >> 4, i = rho & 15; return 8 * (i >> 2) + 4 * n + (i & 3); }
struct Unit { int pm, pn, e, j, cnt; };

template <class Epi, class Sched>
__device__ __forceinline__ void gemm_phase(LAS unsigned char* lds, const int tid, const int K, const Sched& S, const Epi& E) {
    const int wid = __builtin_amdgcn_readfirstlane(tid >> 6), lane = tid & 63, wr = wid >> 2, wc = wid & 3, fr = lane & 15, fq = lane >> 4;
    const int nt = K / BK;
    int Rr[2]; unsigned Cb[2], voffB[2];
#pragma unroll
    for (int i = 0; i < 2; ++i) { int R, C; stage_rc(tid * 16 + i * 8192, R, C); const int Rb = Epi::PERM ? ((R & ~31) + perm32(R & 31)) : R;
        Rr[i] = R; Cb[i] = (unsigned)C * 2u; voffB[i] = (unsigned)(Rb * K + C) * 2u; }
    const size_t kstep = (size_t)(BK * 2);
    const size_t hstep = (size_t)HALF * K * 2;
    const unsigned ldsw = (unsigned)wid * 1024u;
    const int aoff = lds_byte(wr * 64 + fr, fq * 8), boff = lds_byte(wc * 32 + fr, fq * 8);
#define PG8_SA(b, h) (((b) * 2 + (h)) * HTB)
#define PG8_SB(b, h) ((4 + (b) * 2 + (h)) * HTB)
#define PG8_STAGE(bufoff, gbase, voff) do { _Pragma("unroll") for (int _i = 0; _i < 2; ++_i) \
        __builtin_amdgcn_global_load_lds((const unsigned*)((const char*)(gbase) + (voff)[_i]), (LAS unsigned*)(lds + (bufoff) + ldsw + _i * 8192), 16, 0, 0); } while (0)
#define PG8_LDA(dst, b, h) do { _Pragma("unroll") for (int m = 0; m < 4; ++m) _Pragma("unroll") for (int k = 0; k < 2; ++k) dst[m][k] = *(const LAS bf16x8*)(lds + PG8_SA(b, h) + aoff + m * 2048 + k * 1024); } while (0)
#define PG8_LDB(dst, b, h) do { _Pragma("unroll") for (int n = 0; n < 2; ++n) _Pragma("unroll") for (int k = 0; k < 2; ++k) dst[n][k] = *(const LAS bf16x8*)(lds + PG8_SB(b, h) + boff + n * 2048 + k * 1024); } while (0)
#define PG8_MMA(ai, bj, At, Bt) do { __builtin_amdgcn_s_setprio(1); _Pragma("unroll") for (int m = 0; m < 4; ++m) _Pragma("unroll") for (int n = 0; n < 2; ++n) _Pragma("unroll") for (int k = 0; k < 2; ++k) \
        acc[ai][bj][m][n] = __builtin_amdgcn_mfma_f32_16x16x32_bf16(Bt[n][k], At[m][k], acc[ai][bj][m][n], 0, 0, 0); __builtin_amdgcn_s_setprio(0); } while (0)
#define PG8_WAIT_V(n) asm volatile("s_waitcnt vmcnt(" #n ")" ::: "memory")
#define PG8_WAIT_L(n) asm volatile("s_waitcnt lgkmcnt(" #n ")" ::: "memory")
#define PG8_BAR __builtin_amdgcn_s_barrier()
#define PG8_SCHED __builtin_amdgcn_sched_barrier(0)
    Unit cur, nxt; int ui = 0;
    if (!S.next(0, cur)) return;
    f32x4 acc[2][2][4][2];
#pragma unroll
    for (int a = 0; a < 2; ++a)
#pragma unroll
        for (int b = 0; b < 2; ++b)
#pragma unroll
            for (int m = 0; m < 4; ++m)
#pragma unroll
                for (int n = 0; n < 2; ++n) acc[a][b][m][n] = (f32x4){0.f, 0.f, 0.f, 0.f};
    bf16x8 At[4][2], B0[2][2], B1[2][2];
    unsigned vA0[2], vA1[2];
    const char* cA = S.a_ptr(cur);
    if constexpr (Sched::GATHER) { S.a_offs(cur, Rr, vA0, vA1);
#pragma unroll
        for (int i = 0; i < 2; ++i) { vA0[i] += Cb[i]; vA1[i] += Cb[i]; }
        asm volatile("s_waitcnt vmcnt(0)" ::: "memory");
    } else {
#pragma unroll
        for (int i = 0; i < 2; ++i) { vA0[i] = (unsigned)(Rr[i] * K * 2) + Cb[i]; vA1[i] = vA0[i]; } }
    const size_t ahs = Sched::GATHER ? (size_t)0 : hstep;
    const char* cB = S.b_ptr(cur);
    PG8_STAGE(PG8_SB(0, 0), cB, voffB); PG8_STAGE(PG8_SB(0, 1), cB + hstep, voffB); PG8_STAGE(PG8_SA(0, 0), cA, vA0); PG8_STAGE(PG8_SA(0, 1), cA + ahs, vA1);
    if (wr == 1) PG8_BAR;
    PG8_WAIT_V(2); PG8_BAR;
    PG8_STAGE(PG8_SB(1, 0), cB + kstep, voffB); PG8_STAGE(PG8_SA(1, 0), cA + kstep, vA0); PG8_STAGE(PG8_SB(1, 1), cB + hstep + kstep, voffB);
    PG8_WAIT_V(6); PG8_BAR;
    for (;;) {
        const bool has_next = S.next(ui + 1, nxt);
        const char* nA = has_next ? S.a_ptr(nxt) : cA; const char* nB = has_next ? S.b_ptr(nxt) : cB;
        for (int t = 0; t < nt; t += 2) {
            const bool last = (t == nt - 2);
            const char* a1 = cA + (size_t)(t + 1) * kstep;
            const char* a2 = last ? nA : cA + (size_t)(t + 2) * kstep; const char* b2 = last ? nB : cB + (size_t)(t + 2) * kstep;
            const char* a3 = a2 + kstep; const char* b3 = b2 + kstep;
            PG8_LDB(B0, 0, 0); PG8_LDB(B1, 0, 1); PG8_SCHED; PG8_LDA(At, 0, 0); PG8_STAGE(PG8_SA(1, 1), a1 + ahs, vA1);
            if constexpr (Sched::GATHER) { if (last && has_next) { S.a_offs(nxt, Rr, vA0, vA1);
#pragma unroll
                for (int i = 0; i < 2; ++i) { vA0[i] += Cb[i]; vA1[i] += Cb[i]; }
                asm volatile("s_waitcnt vmcnt(0)" ::: "memory"); } }
            PG8_WAIT_V(8); PG8_WAIT_L(0); PG8_BAR; PG8_MMA(0, 0, At, B0); PG8_MMA(0, 1, At, B1); PG8_BAR; PG8_SCHED;
            PG8_LDA(At, 0, 1); PG8_STAGE(PG8_SB(0, 0), b2, voffB); PG8_STAGE(PG8_SB(0, 1), b2 + hstep, voffB); PG8_STAGE(PG8_SA(0, 0), a2, vA0);
            PG8_WAIT_V(8); PG8_WAIT_L(0); PG8_BAR; PG8_MMA(1, 0, At, B0); PG8_MMA(1, 1, At, B1); PG8_BAR; PG8_SCHED;
            PG8_LDB(B0, 1, 0); PG8_LDB(B1, 1, 1); PG8_SCHED; PG8_LDA(At, 1, 0); PG8_STAGE(PG8_SA(0, 1), a2 + ahs, vA1);
            PG8_WAIT_V(8); PG8_WAIT_L(0); PG8_BAR; PG8_MMA(0, 0, At, B0); PG8_MMA(0, 1, At, B1); PG8_BAR; PG8_SCHED;
            PG8_LDA(At, 1, 1); PG8_STAGE(PG8_SB(1, 0), b3, voffB); PG8_STAGE(PG8_SB(1, 1), b3 + hstep, voffB); PG8_STAGE(PG8_SA(1, 0), a3, vA0);
            PG8_WAIT_V(8); PG8_WAIT_L(0); PG8_BAR; PG8_MMA(1, 0, At, B0); PG8_MMA(1, 1, At, B1); PG8_BAR; PG8_SCHED;
        }
        if (wr == 0) PG8_BAR;
        E(acc, cur, wr, wc, fr, fq);
        if (!has_next) break;
#pragma unroll
        for (int a = 0; a < 2; ++a)
#pragma unroll
            for (int b = 0; b < 2; ++b)
#pragma unroll
                for (int m = 0; m < 4; ++m)
#pragma unroll
                    for (int n = 0; n < 2; ++n) acc[a][b][m][n] = (f32x4){0.f, 0.f, 0.f, 0.f};
        cur = nxt; cA = nA; cB = nB; ++ui;
        if (wr == 1) PG8_BAR;
    }
    PG8_WAIT_V(0);
    PG8_BAR;
#undef PG8_SA
#undef PG8_SB
#undef PG8_STAGE
#undef PG8_LDA
#undef PG8_LDB
#undef PG8_MMA
#undef PG8_WAIT_V
#undef PG8_WAIT_L
#undef PG8_BAR
#undef PG8_SCHED
}
__device__ __forceinline__ unsigned cvt_pk_bf16(float lo, float hi) { unsigned r; asm volatile("v_cvt_pk_bf16_f32 %0, %1, %2" : "=v"(r) : "v"(lo), "v"(hi)); return r; }

struct DenseSched {
    const char* A; const char* Bt; int K, nM, nN, nwg, G, c;
    __device__ void init(const void* A_, const void* Bt_, int K_, int M, int N, int G_, int c_) { A = (const char*)A_; Bt = (const char*)Bt_; K = K_; nM = M / BM; nN = N / BM; nwg = nM * nN; G = G_; c = c_; }
    __device__ __forceinline__ bool next(int i, Unit& u) const {
        const long L = (long)i * G + c; if (L >= nwg) return false;
        int wgid = (int)L; { const int q = nwg / NXCD, r = nwg % NXCD, xcd = wgid % NXCD, off = wgid / NXCD; wgid = (xcd < r ? xcd * (q + 1) : r * (q + 1) + (xcd - r) * q) + off; }
        const int nig = WGM * nN, gid = wgid / nig, fm = gid * WGM, gsz = (nM - fm) < WGM ? (nM - fm) : WGM;
        u.pm = fm + ((wgid % nig) % gsz); u.pn = (wgid % nig) / gsz; u.e = 0; u.j = 0; u.cnt = 256; return true;
    }
    static constexpr bool GATHER = false;
    __device__ __forceinline__ const char* a_ptr(const Unit& u) const { return A + (size_t)u.pm * BM * K * 2; }
    __device__ __forceinline__ void a_offs(const Unit&, const int (&)[2], unsigned (&)[2], unsigned (&)[2]) const {}
    __device__ __forceinline__ const char* b_ptr(const Unit& u) const { return Bt + (size_t)u.pn * BM * K * 2; }
};
template <bool GATHER_> struct MoeSched {
    static constexpr bool GATHER = GATHER_;
    const char* A; const char* W; size_t wstride; int K, G, c; const int* elist; const volatile LAS int* T; const volatile LAS int* Cn;
    __device__ __forceinline__ bool next(int i, Unit& u) const {
        const long L = (long)i * G + c; const int nT = T[16]; if (L >= 4L * nT) return false;
        const int tile = (int)(L >> 2); u.pn = (int)(L & 3); u.pm = tile;
        int e = 0;
#pragma unroll
        for (int k = 1; k < 16; ++k) e += (tile >= T[k]) ? 1 : 0;
        u.e = e; u.j = tile - T[e]; u.cnt = Cn[e]; return true;
    }
    __device__ __forceinline__ const char* a_ptr(const Unit& u) const { return GATHER ? A : A + (size_t)u.pm * BM * K * 2; }
    __device__ __forceinline__ void a_offs(const Unit& u, const int (&Rr)[2], unsigned (&v0)[2], unsigned (&v1)[2]) const {
#pragma unroll
        for (int i = 0; i < 2; ++i) {
            const int p0 = u.j * BM + Rr[i], p1 = p0 + HALF;
            const int t0 = p0 < u.cnt ? (elist[u.e * NROW + p0] >> 1) : 0, t1 = p1 < u.cnt ? (elist[u.e * NROW + p1] >> 1) : 0;
            v0[i] = (unsigned)(t0 * K * 2); v1[i] = (unsigned)(t1 * K * 2);
        } }
    __device__ __forceinline__ const char* b_ptr(const Unit& u) const { return W + (size_t)u.e * wstride + (size_t)u.pn * BM * K * 2; }
};
struct EpiP {
    static constexpr bool PERM = true;
    bf16* O;
    __device__ __forceinline__ void operator()(const f32x4 (&acc)[2][2][4][2], const Unit& u, int wr, int wc, int fr, int fq) const {
        const int row0 = u.pm * BM + wr * 64 + fr, col0 = u.pn * BM + wc * 32 + 8 * fq;
#pragma unroll
        for (int ai = 0; ai < 2; ++ai)
#pragma unroll
            for (int m = 0; m < 4; ++m) { bf16* rowp = O + (size_t)(row0 + ai * HALF + m * 16) * NP + col0;
#pragma unroll
                for (int bj = 0; bj < 2; ++bj) { const f32x4 v0 = acc[ai][bj][m][0], v1 = acc[ai][bj][m][1];
                    u32x4 w; w.x = cvt_pk_bf16(v0[0], v0[1]); w.y = cvt_pk_bf16(v0[2], v0[3]); w.z = cvt_pk_bf16(v1[0], v1[1]); w.w = cvt_pk_bf16(v1[2], v1[3]);
                    *(u32x4*)(rowp + bj * HALF) = w; } }
    }
};
struct EpiRes {
    static constexpr bool PERM = false;
    const float* hin_l; const float* hin_c; float* hout_l; float* hout_c; const float* gate;
    __device__ __forceinline__ void operator()(const f32x4 (&acc)[2][2][4][2], const Unit& u, int wr, int wc, int fr, int fq) const {
        const int row0 = u.pm * BM + wr * 64 + fr, col0 = u.pn * BM + wc * 32 + 4 * fq;
#pragma unroll
        for (int ai = 0; ai < 2; ++ai)
#pragma unroll
            for (int m = 0; m < 4; ++m) { const int r = row0 + ai * HALF + m * 16; const bool lat = r < NLAT; const int bb = lat ? (r >> 11) : 8;
                const float* hi = lat ? hin_l + (size_t)r * DM : hin_c + (size_t)(r - NLAT) * DM; float* ho = lat ? hout_l + (size_t)r * DM : hout_c + (size_t)(r - NLAT) * DM;
                const float* g = gate + (size_t)bb * 6144;
#pragma unroll
                for (int bj = 0; bj < 2; ++bj)
#pragma unroll
                    for (int n = 0; n < 2; ++n) { const int c = col0 + bj * HALF + n * 16; const f32x4 gv = *(const f32x4*)(g + c), hv = *(const f32x4*)(hi + c);
                        *(f32x4*)(ho + c) = hv + gv * acc[ai][bj][m][n]; } }
    }
};
struct EpiAct {
    static constexpr bool PERM = true;
    bf16* O;
    __device__ __forceinline__ void operator()(const f32x4 (&acc)[2][2][4][2], const Unit& u, int wr, int wc, int fr, int fq) const {
        const int row0 = u.pm * BM + wr * 64 + fr, col0 = u.pn * HALF + wc * 32 + 8 * fq;
#pragma unroll
        for (int ai = 0; ai < 2; ++ai)
#pragma unroll
            for (int m = 0; m < 4; ++m) { bf16* rowp = O + (size_t)(row0 + ai * HALF + m * 16) * FF + col0;
                float o[8];
#pragma unroll
                for (int n = 0; n < 2; ++n)
#pragma unroll
                    for (int j = 0; j < 4; ++j) { const float g = acc[ai][0][m][n][j], up = acc[ai][1][m][n][j]; o[n * 4 + j] = g / (1.f + __expf(-g)) * up; }
                u32x4 w; w.x = cvt_pk_bf16(o[0], o[1]); w.y = cvt_pk_bf16(o[2], o[3]); w.z = cvt_pk_bf16(o[4], o[5]); w.w = cvt_pk_bf16(o[6], o[7]);
                *(u32x4*)rowp = w; }
    }
};
struct EpiDown {
    static constexpr bool PERM = true;
    bf16* O; const int* elist; const float* rtw;
    __device__ __forceinline__ void operator()(const f32x4 (&acc)[2][2][4][2], const Unit& u, int wr, int wc, int fr, int fq) const {
        const int col0 = u.pn * BM + wc * 32 + 8 * fq;
#pragma unroll
        for (int ai = 0; ai < 2; ++ai)
#pragma unroll
            for (int m = 0; m < 4; ++m) { const int pos = u.j * BM + ai * HALF + wr * 64 + m * 16 + fr;
                if (pos < u.cnt) { const int a = elist[u.e * NROW + pos]; const float w8 = rtw[a]; bf16* rowp = O + (size_t)a * DM + col0;
#pragma unroll
                    for (int bj = 0; bj < 2; ++bj) { const f32x4 v0 = acc[ai][bj][m][0] * w8, v1 = acc[ai][bj][m][1] * w8;
                        u32x4 w; w.x = cvt_pk_bf16(v0[0], v0[1]); w.y = cvt_pk_bf16(v0[2], v0[3]); w.z = cvt_pk_bf16(v1[0], v1[1]); w.w = cvt_pk_bf16(v1[2], v1[3]);
                        *(u32x4*)(rowp + bj * HALF) = w; } } }
    }
};
}

struct Args { const float* in[36]; float* out; unsigned char* ws; int ph_lo, ph_hi; };
struct Fr {
    LAS unsigned char* lds; int tid, lane, wave, G, vcu, gw, NGW; const __attribute__((address_space(4))) Args* A;
    __device__ __forceinline__ const float* x() const { return A->in[0]; }
    __device__ __forceinline__ const float* cvec() const { return A->in[1]; }
    __device__ __forceinline__ const float* ctx() const { return A->in[2]; }
    __device__ __forceinline__ const float* cctx() const { return A->in[3]; }
    __device__ __forceinline__ const float* w_mod() const { return A->in[4]; }
    __device__ __forceinline__ const float* b_mod() const { return A->in[5]; }
    __device__ __forceinline__ const float* g_mix() const { return A->in[6]; }
    __device__ __forceinline__ const float* w_in() const { return A->in[7]; }
    __device__ __forceinline__ const float* w_out() const { return A->in[8]; }
    __device__ __forceinline__ const float* na_gq() const { return A->in[9]; }
    __device__ __forceinline__ const float* na_gk() const { return A->in[10]; }
    __device__ __forceinline__ const float* na_rb() const { return A->in[11]; }
    __device__ __forceinline__ const float* mla_gqa() const { return A->in[12]; }
    __device__ __forceinline__ const float* mla_wqb() const { return A->in[13]; }
    __device__ __forceinline__ const float* mla_gkva() const { return A->in[14]; }
    __device__ __forceinline__ const float* mla_wkvb() const { return A->in[15]; }
    __device__ __forceinline__ const float* mla_gq() const { return A->in[16]; }
    __device__ __forceinline__ const float* mla_gk() const { return A->in[17]; }
    __device__ __forceinline__ const float* df_gq() const { return A->in[18]; }
    __device__ __forceinline__ const float* df_gk() const { return A->in[19]; }
    __device__ __forceinline__ const float* df_lam() const { return A->in[20]; }
    __device__ __forceinline__ const float* df_gsub() const { return A->in[21]; }
    __device__ __forceinline__ const float* conv_w() const { return A->in[22]; }
    __device__ __forceinline__ const float* conv_b() const { return A->in[23]; }
    __device__ __forceinline__ const float* dt_bias() const { return A->in[24]; }
    __device__ __forceinline__ const float* a_log() const { return A->in[25]; }
    __device__ __forceinline__ const float* ssd_d() const { return A->in[26]; }
    __device__ __forceinline__ const float* ssd_gn() const { return A->in[27]; }
    __device__ __forceinline__ const float* g_ffn() const { return A->in[28]; }
    __device__ __forceinline__ const float* w_grp() const { return A->in[29]; }
    __device__ __forceinline__ const float* b_grp() const { return A->in[30]; }
    __device__ __forceinline__ const float* w_exp() const { return A->in[31]; }
    __device__ __forceinline__ const float* b_exp() const { return A->in[32]; }
    __device__ __forceinline__ const float* w_gate() const { return A->in[33]; }
    __device__ __forceinline__ const float* w_up() const { return A->in[34]; }
    __device__ __forceinline__ const float* w_down() const { return A->in[35]; }
    __device__ __forceinline__ float* out() const { return A->out; }
    __device__ __forceinline__ unsigned* ctl() const { return (unsigned*)(A->ws + WS_CTL); }
    __device__ __forceinline__ float* modv() const { return (float*)(A->ws + WS_MOD); }
    __device__ __forceinline__ float* rcos() const { return (float*)(A->ws + WS_ROPE); }
    __device__ __forceinline__ float* rsin() const { return (float*)(A->ws + WS_ROPE + TLAT * 16 * 4); }
    __device__ __forceinline__ bf16* winT() const { return (bf16*)(A->ws + WS_WIN); }
    __device__ __forceinline__ bf16* woutT() const { return (bf16*)(A->ws + WS_WOUT); }
    __device__ __forceinline__ bf16* wqbT() const { return (bf16*)(A->ws + WS_WQB); }
    __device__ __forceinline__ bf16* wkvbT() const { return (bf16*)(A->ws + WS_WKVB); }
    __device__ __forceinline__ bf16* wgu() const { return (bf16*)(A->ws + WS_WGU); }
    __device__ __forceinline__ bf16* wd() const { return (bf16*)(A->ws + WS_WD); }
    __device__ __forceinline__ float* hc() const { return (float*)(A->ws + WS_HC); }
    __device__ __forceinline__ bf16* abuf() const { return (bf16*)(A->ws + WS_A); }
    __device__ __forceinline__ bf16* pbuf() const { return (bf16*)(A->ws + WS_P); }
    __device__ __forceinline__ bf16* act() const { return (bf16*)(A->ws + WS_ACT); }
    __device__ __forceinline__ bf16* yk() const { return (bf16*)(A->ws + WS_YK); }
    __device__ __forceinline__ bf16* mix() const { return (bf16*)(A->ws + WS_MIX); }
    __device__ __forceinline__ bf16* qna() const { return (bf16*)(A->ws + WS_QNA); }
    __device__ __forceinline__ bf16* kna() const { return (bf16*)(A->ws + WS_KNA); }
    __device__ __forceinline__ bf16* vna() const { return (bf16*)(A->ws + WS_VNA); }
    __device__ __forceinline__ bf16* qml() const { return (bf16*)(A->ws + WS_QML); }
    __device__ __forceinline__ bf16* kml() const { return (bf16*)(A->ws + WS_KML); }
    __device__ __forceinline__ bf16* vml() const { return (bf16*)(A->ws + WS_VML); }
    __device__ __forceinline__ bf16* qdf() const { return (bf16*)(A->ws + WS_QDF); }
    __device__ __forceinline__ bf16* kdf() const { return (bf16*)(A->ws + WS_KDF); }
    __device__ __forceinline__ bf16* vdf() const { return (bf16*)(A->ws + WS_VDF); }
    __device__ __forceinline__ bf16* xT() const { return (bf16*)(A->ws + WS_XT); }
    __device__ __forceinline__ bf16* btm() const { return (bf16*)(A->ws + WS_BTM); }
    __device__ __forceinline__ bf16* bT() const { return (bf16*)(A->ws + WS_BT); }
    __device__ __forceinline__ bf16* ctm() const { return (bf16*)(A->ws + WS_CTM); }
    __device__ __forceinline__ float* dtv() const { return (float*)(A->ws + WS_DT); }
    __device__ __forceinline__ float* cst() const { return (float*)(A->ws + WS_CST); }
    __device__ __forceinline__ float* cdec() const { return (float*)(A->ws + WS_CDEC); }
    __device__ __forceinline__ bf16* hent() const { return (bf16*)(A->ws + WS_HENT); }
    __device__ __forceinline__ float* ydir() const { return (float*)(A->ws + WS_CST); }
    __device__ __forceinline__ int* rte() const { return (int*)(A->ws + WS_RT); }
    __device__ __forceinline__ float* rtw() const { return (float*)(A->ws + WS_RT + 256 * 1024); }
    __device__ __forceinline__ int* elist() const { return (int*)(A->ws + WS_ELIST); }
};

__device__ __forceinline__ Fr refresh(const Fr& F0) { Fr F = F0; int w = F0.wave; asm volatile("" : "+s"(w)); asm volatile("" : "+s"(F.A));
    int l; asm volatile("v_mbcnt_lo_u32_b32 %0, -1, 0\n\tv_mbcnt_hi_u32_b32 %0, -1, %0" : "=v"(l)); F.wave = w; F.lane = l; F.tid = w * 64 + l; F.gw = F.vcu * 8 + w; return F; }
__device__ __forceinline__ void tr_item(const float* W, int ldw, int nvalid, int k0, int n0, bf16* dst, int ldd, LAS float* scr, int lane) {
    const int cn = n0 + (lane & 31);
#pragma unroll 8
    for (int i = 0; i < 32; ++i) { const int kk = 2 * i + (lane >> 5); scr[kk * 33 + (lane & 31)] = cn < nvalid ? W[(size_t)(k0 + kk) * ldw + cn] : 0.f; }
    LDS_WAIT();
    const int c = lane & 7;
#pragma unroll
    for (int j = 0; j < 4; ++j) { const int n = (lane >> 3) + 8 * j; const LAS float* s = scr + (8 * c) * 33 + n;
        u32x4 o; o.x = pk2(s[0 * 33], s[1 * 33]); o.y = pk2(s[2 * 33], s[3 * 33]); o.z = pk2(s[4 * 33], s[5 * 33]); o.w = pk2(s[6 * 33], s[7 * 33]);
        *(u32x4*)(dst + (size_t)n * ldd + k0 + 8 * c) = o; }
    LDS_WAIT();
}
__device__ __forceinline__ void moe_weight_convert(const Fr& F, int L) {
    LAS float* scr = (LAS float*)(F.lds + F.wave * 16384);
    constexpr int I_GU = 16 * 16, I_D = 8 * 32;
    for (int it = F.gw; it < NEXP * (2 * I_GU + I_D); it += F.NGW) {
        const int e = it / (2 * I_GU + I_D); int r = it % (2 * I_GU + I_D);
        if (r < 2 * I_GU) { const int bj = r / I_GU; r %= I_GU; const int kb = r / 16, nb = r % 16, n0 = nb * 32;
            const float* W = (bj ? F.w_up() : F.w_gate()) + ((size_t)L * NEXP + e) * DM * FF;
            tr_item(W, FF, FF, kb * 64, n0, F.wgu() + ((size_t)e * 1024 + (n0 >> 7) * 256 + bj * 128 + (n0 & 127)) * DM, DM, scr, F.lane);
        } else { r -= 2 * I_GU; const int kb = r / 32, nb = r % 32, n0 = nb * 32;
            const float* W = F.w_down() + ((size_t)L * NEXP + e) * FF * DM;
            tr_item(W, DM, DM, kb * 64, n0, F.wd() + ((size_t)e * 1024 + n0) * FF, FF, scr, F.lane); }
    }
}
__device__ __forceinline__ void phase_prologue(const Fr& F) {
    LAS float* sc = (LAS float*)F.lds;
    for (int u = blockIdx.x; u < 48; u += F.G) {
        for (int i = F.tid; i < 9 * 1024; i += 512) { const float v = i < 8192 ? F.cvec()[i] : F.cctx()[i - 8192]; sc[i] = siluf(v); }
        __syncthreads();
        const int col = u * 512 + F.tid, L = col / 6144, n = col % 6144;
        float acc[9];
#pragma unroll
        for (int b = 0; b < 9; ++b) acc[b] = 0.f;
        const float* w = F.w_mod() + (size_t)L * 1024 * 6144 + n;
#pragma unroll 8
        for (int k = 0; k < 1024; ++k) { const float wv = w[(size_t)k * 6144];
#pragma unroll
            for (int b = 0; b < 9; ++b) acc[b] += sc[b * 1024 + k] * wv; }
        const float bm = F.b_mod()[L * 6144 + n];
#pragma unroll
        for (int b = 0; b < 9; ++b) F.modv()[((size_t)L * 9 + b) * 6144 + n] = acc[b] + bm;
        __syncthreads();
    }
    for (int i = blockIdx.x * 512 + F.tid; i < TLAT * 16; i += F.G * 512) { const int t = i >> 4, k = i & 15; const float inv = powf(10000.f, -(float)(k & 7) / 8.f);
        const float pos = (k < 8) ? (float)(t >> 6) : (float)(t & 63); const float ang = pos * inv; F.rcos()[i] = cosf(ang); F.rsin()[i] = sinf(ang); }
    __syncthreads();
    LAS float* scr = (LAS float*)(F.lds + F.wave * 16384);
    constexpr int I_IN = 16 * 96, I_OUT = 16 * 32, I_QB = 4 * 12, I_KVB = 2 * 16, I_L = I_IN + I_OUT + I_QB + I_KVB;
    for (int it = F.gw; it < DEPTH * I_L; it += F.NGW) {
        const int L = it / I_L; int r = it % I_L;
        if (r < I_IN) { const int kb = r / 96, nb = r % 96; tr_item(F.w_in() + (size_t)L * DM * NIN, NIN, NIN, kb * 64, nb * 32, F.winT() + ((size_t)L * NP + nb * 32) * DM, DM, scr, F.lane); continue; } r -= I_IN;
        if (r < I_OUT) { const int kb = r / 32, nb = r % 32; tr_item(F.w_out() + (size_t)L * DM * DM, DM, DM, kb * 64, nb * 32, F.woutT() + ((size_t)L * DM + nb * 32) * DM, DM, scr, F.lane); continue; } r -= I_OUT;
        if (r < I_QB) { const int kb = r / 12, nb = r % 12; tr_item(F.mla_wqb() + (size_t)L * 256 * 384, 384, 384, kb * 64, nb * 32, F.wqbT() + ((size_t)L * 384 + nb * 32) * 256, 256, scr, F.lane); continue; } r -= I_QB;
        { const int kb = r / 16, nb = r % 16; tr_item(F.mla_wkvb() + (size_t)L * 128 * 512, 512, 512, kb * 64, nb * 32, F.wkvbT() + ((size_t)L * 512 + nb * 32) * 128, 128, scr, F.lane); }
    }
}

__device__ __forceinline__ void phase_norm(const Fr& F, int L) {
    const int nrows = (L == DEPTH) ? NLAT : NROW;
    for (int r = F.gw; r < nrows; r += F.NGW) {
        const bool lat = r < NLAT; const int bb = lat ? (r >> 11) : 8;
        const float* hin = (L == 0) ? (lat ? F.x() + (size_t)r * DM : F.ctx() + (size_t)(r - NLAT) * DM) : (lat ? F.out() + (size_t)r * DM : F.hc() + (size_t)(r - NLAT) * DM);
        float* hout = lat ? F.out() + (size_t)r * DM : F.hc() + (size_t)(r - NLAT) * DM;
        f32x4 v[4];
#pragma unroll
        for (int j = 0; j < 4; ++j) v[j] = *(const f32x4*)(hin + 4 * F.lane + 256 * j);
        if (L > 0) {
            const float* m5 = F.modv() + ((size_t)(L - 1) * 9 + bb) * 6144 + 5 * 1024;
#pragma unroll
            for (int j = 0; j < 4; ++j) { const int c = 4 * F.lane + 256 * j; const f32x4 g = *(const f32x4*)(m5 + c);
                const u32x2 y0 = *(const u32x2*)(F.yk() + (size_t)(2 * r) * DM + c), y1 = *(const u32x2*)(F.yk() + (size_t)(2 * r + 1) * DM + c);
                f32x4 ys; ys[0] = __uint_as_float(y0.x << 16) + __uint_as_float(y1.x << 16); ys[1] = __uint_as_float(y0.x & 0xffff0000u) + __uint_as_float(y1.x & 0xffff0000u);
                ys[2] = __uint_as_float(y0.y << 16) + __uint_as_float(y1.y << 16); ys[3] = __uint_as_float(y0.y & 0xffff0000u) + __uint_as_float(y1.y & 0xffff0000u);
                v[j] = v[j] + g * ys; *(f32x4*)(hout + c) = v[j]; }
        }
        if (L == DEPTH) continue;
        float ss = 0.f;
#pragma unroll
        for (int j = 0; j < 4; ++j) ss += (v[j][0] * v[j][0] + v[j][1] * v[j][1]) + (v[j][2] * v[j][2] + v[j][3] * v[j][3]);
        const float rstd = rsqrtf(wsum(ss) * (1.f / DM) + EPS);
        const float* md = F.modv() + ((size_t)L * 9 + bb) * 6144;
#pragma unroll
        for (int j = 0; j < 4; ++j) { const int c = 4 * F.lane + 256 * j; const f32x4 g = *(const f32x4*)(F.g_mix() + L * DM + c), sh = *(const f32x4*)(md + c), scl = *(const f32x4*)(md + 1024 + c);
            const f32x4 a = v[j] * rstd * g * (scl + 1.f) + sh; u32x2 o; o.x = pk2(a[0], a[1]); o.y = pk2(a[2], a[3]); *(u32x2*)(F.abuf() + (size_t)r * DM + c) = o; }
    }
}

__device__ __forceinline__ void prep_row(const Fr& F, int L, int r, LAS float* scr) {
    const int lane = F.lane; int b, s; row2bs(r, b, s); const bool lat = r < NLAT; const int t = s - 256;
    const bf16* p = F.pbuf() + (size_t)r * NP;
#pragma unroll
    for (int h = 0; h < 4; ++h) {
        const float q = bf2f(p[C_NA + h * 64 + lane]), k = bf2f(p[C_NA + 256 + h * 64 + lane]);
        const float rq = rsqrtf(wsum(q * q) * (1.f / 64) + EPS), rk = rsqrtf(wsum(k * k) * (1.f / 64) + EPS);
        const size_t o = ((size_t)(b * 4 + h) * SQ + s) * 64 + lane;
        F.qna()[o] = f2bf(q * rq * F.na_gq()[L * 64 + lane]); F.kna()[o] = f2bf(k * rk * F.na_gk()[L * 64 + lane]);
        F.vna()[((size_t)(b * 4 + h) * 64 + lane) * SQ + vpos(s)] = p[C_NA + 512 + h * 64 + lane];
    }
    {
        float c[4], d[2]; float ss = 0.f;
#pragma unroll
        for (int i = 0; i < 4; ++i) { c[i] = bf2f(p[C_MLA + lane + 64 * i]); ss += c[i] * c[i]; }
        const float r1 = rsqrtf(wsum(ss) * (1.f / 256) + EPS);
#pragma unroll
        for (int i = 0; i < 4; ++i) scr[lane + 64 * i] = c[i] * r1 * F.mla_gqa()[L * 256 + lane + 64 * i];
        ss = 0.f;
#pragma unroll
        for (int i = 0; i < 2; ++i) { d[i] = bf2f(p[C_MLA + 256 + lane + 64 * i]); ss += d[i] * d[i]; }
        const float r2 = rsqrtf(wsum(ss) * (1.f / 128) + EPS);
#pragma unroll
        for (int i = 0; i < 2; ++i) scr[256 + lane + 64 * i] = d[i] * r2 * F.mla_gkva()[L * 128 + lane + 64 * i];
        if (lane < 32) scr[1408 + lane] = bf2f(p[C_MLA + 384 + lane]);
        LDS_WAIT();
        float qa[6], ka[8];
#pragma unroll
        for (int i = 0; i < 6; ++i) qa[i] = 0.f;
#pragma unroll
        for (int i = 0; i < 8; ++i) ka[i] = 0.f;
        const float* wq = F.mla_wqb() + (size_t)L * 256 * 384 + lane;
        for (int k = 0; k < 256; ++k) { const float xv = scr[k];
#pragma unroll
            for (int i = 0; i < 6; ++i) qa[i] += xv * wq[k * 384 + 64 * i]; }
        const float* wk = F.mla_wkvb() + (size_t)L * 128 * 512 + lane;
        for (int k = 0; k < 128; ++k) { const float xv = scr[256 + k];
#pragma unroll
            for (int i = 0; i < 8; ++i) ka[i] += xv * wk[k * 512 + 64 * i]; }
#pragma unroll
        for (int i = 0; i < 6; ++i) scr[512 + lane + 64 * i] = qa[i];
#pragma unroll
        for (int i = 0; i < 8; ++i) scr[896 + lane + 64 * i] = ka[i];
        LDS_WAIT();
        float cs = 1.f, sn = 0.f;
        if (lat && lane < 32) { cs = F.rcos()[t * 16 + (lane & 15)]; sn = F.rsin()[t * 16 + (lane & 15)]; }
#pragma unroll
        for (int h = 0; h < 4; ++h) {
            const size_t o = ((size_t)(b * 4 + h) * SQ + s) * 96;
            {
                float x0 = scr[512 + h * 96 + lane], x1 = lane < 32 ? scr[512 + h * 96 + 64 + lane] : 0.f;
                const float rs = rsqrtf(wsum(x0 * x0 + x1 * x1) * (1.f / 96) + EPS);
                x0 *= rs * F.mla_gq()[L * 96 + lane]; if (lane < 32) x1 *= rs * F.mla_gq()[L * 96 + 64 + lane];
                const float xp = __shfl_xor(x1, 16);
                if (lat) x1 = (lane < 16) ? x1 * cs - xp * sn : xp * sn + x1 * cs;
                F.qml()[o + lane] = f2bf(x0); if (lane < 32) F.qml()[o + 64 + lane] = f2bf(x1);
            }
            {
                float x0 = scr[896 + h * 128 + lane], x1 = lane < 32 ? scr[1408 + lane] : 0.f;
                const float rs = rsqrtf(wsum(x0 * x0 + x1 * x1) * (1.f / 96) + EPS);
                x0 *= rs * F.mla_gk()[L * 96 + lane]; if (lane < 32) x1 *= rs * F.mla_gk()[L * 96 + 64 + lane];
                const float xp = __shfl_xor(x1, 16);
                if (lat) x1 = (lane < 16) ? x1 * cs - xp * sn : xp * sn + x1 * cs;
                F.kml()[o + lane] = f2bf(x0); if (lane < 32) F.kml()[o + 64 + lane] = f2bf(x1);
            }
            F.vml()[((size_t)(b * 4 + h) * 64 + lane) * SQ + vpos(s)] = f2bf(scr[896 + h * 128 + 64 + lane]);
        }
        LDS_WAIT();
    }
    {
        const int idx = lane & 31; float cs = 1.f, sn = 0.f;
        if (lat) { cs = F.rcos()[t * 16 + (idx & 15)]; sn = F.rsin()[t * 16 + (idx & 15)]; }
#pragma unroll
        for (int h = 0; h < 4; ++h) {
            float q = bf2f(p[C_DF + h * 64 + lane]), k = bf2f(p[C_DF + 256 + h * 64 + lane]);
            float sq = q * q, sk = k * k;
#pragma unroll
            for (int o = 16; o >= 1; o >>= 1) { sq += __shfl_xor(sq, o); sk += __shfl_xor(sk, o); }
            q *= rsqrtf(sq * (1.f / 32) + EPS) * F.df_gq()[L * 32 + idx]; k *= rsqrtf(sk * (1.f / 32) + EPS) * F.df_gk()[L * 32 + idx];
            const float qp = __shfl_xor(q, 16), kp = __shfl_xor(k, 16);
            if (lat) { q = (idx < 16) ? q * cs - qp * sn : qp * sn + q * cs; k = (idx < 16) ? k * cs - kp * sn : kp * sn + k * cs; }
            const size_t o = ((size_t)(b * 4 + h) * SQ + s) * 64 + lane;
            F.qdf()[o] = f2bf(q); F.kdf()[o] = f2bf(k);
            F.vdf()[((size_t)(b * 4 + h) * 64 + lane) * SQ + vpos(s)] = p[C_DF + 512 + h * 64 + lane];
        }
    }
    {
        const int tt = lat ? t : s, len = lat ? TLAT : TCTX;
#pragma unroll
        for (int i = 0; i < 12; ++i) { const int c = lane + 64 * i; float acc = F.conv_b()[L * 768 + c];
#pragma unroll
            for (int j = 0; j < 5; ++j) { const int tj = tt + j - 2; if (tj >= 0 && tj < len) acc += F.conv_w()[(L * 5 + j) * 768 + c] * bf2f(F.pbuf()[(size_t)(r + j - 2) * NP + C_XBC + c]); }
            const bf16 v = f2bf(siluf(acc));
            if (i < 4) F.xT()[((size_t)b * 256 + c) * SQ + s] = v;
            else if (i < 8) { F.btm()[((size_t)b * SQ + s) * 256 + c - 256] = v; F.bT()[((size_t)b * 256 + c - 256) * SQ + s] = v; }
            else F.ctm()[((size_t)b * SQ + s) * 256 + c - 512] = v; }
        if (lane < 8) { const float raw = bf2f(p[C_DT + lane]) + F.dt_bias()[L * 8 + lane]; const float ex = __expf(raw); F.dtv()[((size_t)b * 8 + lane) * SQ + s] = raw > 20.f ? raw : (ex < 0.03f ? ex * (1.f - ex * (0.5f - ex * (0.33333334f - 0.25f * ex))) : __logf(1.f + ex)); }
    }
}
__device__ __forceinline__ void phase_prep(const Fr& F, int L) {
    LAS float* scr = (LAS float*)(F.lds + F.wave * 16384);
    for (int r = F.gw; r < NROW; r += F.NGW) prep_row(F, L, r, scr);
}

__device__ __forceinline__ void phase_ssd_naive(const Fr& F, int L) {
    if (F.wave != 0 || blockIdx.x >= 64) return;
    const int w = blockIdx.x, b = w >> 3, d = (w >> 2) & 1, h = w & 3, g = h >> 1, p = F.lane;
    const float a = -expf(F.a_log()[L * 8 + d * 4 + h]);
    float hs[128];
#pragma unroll
    for (int n = 0; n < 128; ++n) hs[n] = 0.f;
    const float* dtp = F.dtv() + ((size_t)b * 8 + d * 4 + h) * SQ;
    const bf16* xp = F.xT() + ((size_t)b * 256 + h * 64 + p) * SQ;
    for (int step = 0; step < SQ; ++step) {
        const int s = d == 0 ? step : (step < 256 ? 255 - step : SQ - 1 - (step - 256));
        const float dtv = dtp[s], dA = __expf(dtv * a), xv = bf2f(xp[s]) * dtv;
        const u32x4* Bp = (const u32x4*)(F.btm() + ((size_t)b * SQ + s) * 256 + g * 128);
        const u32x4* Cp = (const u32x4*)(F.ctm() + ((size_t)b * SQ + s) * 256 + g * 128);
        float y = 0.f;
#pragma unroll
        for (int n8 = 0; n8 < 16; ++n8) { const u32x4 bv = Bp[n8], cv = Cp[n8];
#pragma unroll
            for (int j = 0; j < 4; ++j) { const int n = n8 * 8 + 2 * j;
                hs[n] = hs[n] * dA + xv * __uint_as_float(bv[j] << 16); hs[n + 1] = hs[n + 1] * dA + xv * __uint_as_float(bv[j] & 0xffff0000u);
                y += __uint_as_float(cv[j] << 16) * hs[n] + __uint_as_float(cv[j] & 0xffff0000u) * hs[n + 1]; } }
        F.ydir()[((size_t)d * NROW + bs2row(b, s)) * 256 + h * 64 + p] = y;
    }
}

template <int KIND>
__device__ __forceinline__ void naive_attn_job(const Fr& F, int L, int r, int h, LAS float* scr) {
    constexpr int DQ = KIND == 1 ? 96 : (KIND == 0 ? 64 : 32), QS = KIND == 1 ? 96 : 64;
    const int lane = F.lane; int b, s; row2bs(r, b, s); const bool lat = r < NLAT; const int t = s - 256;
    const bf16* Qb = (KIND == 0 ? F.qna() : KIND == 1 ? F.qml() : F.qdf()) + ((size_t)(b * 4 + h) * SQ + s) * QS;
    const bf16* Kb = (KIND == 0 ? F.kna() : KIND == 1 ? F.kml() : F.kdf()) + (size_t)(b * 4 + h) * SQ * QS;
    const bf16* Vt = (KIND == 0 ? F.vna() : KIND == 1 ? F.vml() : F.vdf()) + ((size_t)(b * 4 + h) * 64 + lane) * SQ;
    const float scale = KIND == 1 ? 0.10206207261596577f : (KIND == 0 ? 0.125f : 0.17677669529663687f);
    const int qr = t >> 6, qc = t & 63, row_lo = min(max(qr - 4, 0), 24), col_lo = min(max(qc - 8, 0), 48);
    const bool nb = (KIND == 0) && lat;
    const int nk = lat ? (KIND == 0 ? 768 : SQ) : 256;
    const int koff = nb ? row_lo * 64 : 0;
    float oc[2] = {0.f, 0.f};
#pragma unroll
    for (int comp = 0; comp < (KIND == 2 ? 2 : 1); ++comp) {
        for (int i = lane; i < DQ; i += 64) scr[i] = bf2f(Qb[comp * 32 + i]);
        LDS_WAIT();
        float m = -INFINITY;
        for (int kk = lane; kk < nk; kk += 64) {
            const int sk = kk < 256 ? kk : kk + koff; float bias = 0.f; bool valid = true;
            if (nb && kk >= 256) { const int w = kk - 256, kr = w >> 6, kc = w & 63; valid = kc >= col_lo && kc < col_lo + 16;
                const int ro = row_lo + kr - qr + 7, co = min(max(kc - qc, -15), 15) + 15; bias = F.na_rb()[((L * 4 + h) * 15 + ro) * 31 + co]; }
            const u32x4* kp = (const u32x4*)(Kb + (size_t)sk * QS + (KIND == 2 ? comp * 32 : 0));
            float dot = 0.f;
#pragma unroll
            for (int i8 = 0; i8 < DQ / 8; ++i8) { const u32x4 kv = kp[i8];
#pragma unroll
                for (int j = 0; j < 4; ++j) dot += scr[i8 * 8 + 2 * j] * __uint_as_float(kv[j] << 16) + scr[i8 * 8 + 2 * j + 1] * __uint_as_float(kv[j] & 0xffff0000u); }
            const float sc = valid ? dot * scale + bias : -INFINITY;
            scr[128 + kk] = sc; m = fmaxf(m, sc);
        }
        m = wmaxf(m);
        float sum = 0.f;
        for (int kk = lane; kk < nk; kk += 64) { const float pv = __expf(scr[128 + kk] - m); scr[128 + kk] = pv; sum += pv; }
        sum = wsum(sum);
        LDS_WAIT();
        float o = 0.f;
        for (int kb = 0; kb < nk; kb += 8) {
            const int sb = kb < 256 ? kb : kb + koff;
            const u32x4 vv = *(const u32x4*)(Vt + sb);
#pragma unroll
            for (int j = 0; j < 8; ++j) { const int kk = (kb & ~15) + vpos((kb & 15) + j); const unsigned wv = vv[j >> 1];
                o += scr[128 + kk] * ((j & 1) ? __uint_as_float(wv & 0xffff0000u) : __uint_as_float(wv << 16)); }
        }
        oc[comp] = o / sum;
        LDS_WAIT();
    }
    bf16* mo = F.mix() + (size_t)r * DM + (KIND == 0 ? 0 : KIND == 1 ? 256 : 512) + h * 64 + lane;
    if (KIND == 2) {
        const float* lv = F.df_lam() + L * 128; const float li = 0.8f - 0.6f * expf(-0.3f * (float)L);
        float d1 = 0.f, d2 = 0.f;
#pragma unroll
        for (int i = 0; i < 32; ++i) { d1 += lv[i] * lv[32 + i]; d2 += lv[64 + i] * lv[96 + i]; }
        const float lam = expf(d1) - expf(d2) + li;
        const float o = oc[0] - lam * oc[1];
        const float rs = rsqrtf(wsum(o * o) * (1.f / 64) + EPS);
        *mo = f2bf(o * rs * F.df_gsub()[L * 64 + lane] * (1.f - li));
    } else *mo = f2bf(oc[0]);
}
__device__ __forceinline__ void phase_mix_naive(const Fr& F, int L) {
    LAS float* scr = (LAS float*)(F.lds + F.wave * 16384);
    const int nrows = (L == DEPTH - 1) ? NLAT : NROW;
    for (int j = F.gw; j < nrows * 4; j += F.NGW) naive_attn_job<2>(F, L, j >> 2, j & 3, scr);
    for (int j = F.gw; j < nrows * 4; j += F.NGW) naive_attn_job<1>(F, L, j >> 2, j & 3, scr);
    for (int j = F.gw; j < nrows * 4; j += F.NGW) naive_attn_job<0>(F, L, j >> 2, j & 3, scr);
    for (int r = F.gw; r < nrows; r += F.NGW) {
        int b, s; row2bs(r, b, s); const int h = F.lane >> 4; const float dsk = F.ssd_d()[L * 8 + h] + F.ssd_d()[L * 8 + 4 + h];
        float y[4]; float ss = 0.f;
#pragma unroll
        for (int j = 0; j < 4; ++j) { const int ch = F.lane * 4 + j; const float xv = bf2f(F.xT()[((size_t)b * 256 + ch) * SQ + s]);
            const float z = bf2f(F.pbuf()[(size_t)r * NP + C_Z + ch]);
            y[j] = (F.ydir()[(size_t)r * 256 + ch] + F.ydir()[((size_t)NROW + r) * 256 + ch] + dsk * xv) * siluf(z); ss += y[j] * y[j]; }
        const float rs = rsqrtf(wsum(ss) * (1.f / 256) + EPS);
#pragma unroll
        for (int j = 0; j < 4; ++j) { const int ch = F.lane * 4 + j; F.mix()[(size_t)r * DM + 768 + ch] = f2bf(y[j] * rs * F.ssd_gn()[L * 256 + ch]); }
    }
}

__device__ __forceinline__ void phase_route(const Fr& F, int L) {
    const int nrows = (L == DEPTH - 1) ? NLAT : NROW;
    for (int r = F.gw; r < nrows; r += F.NGW) {
        const bool lat = r < NLAT; const int bb = lat ? (r >> 11) : 8;
        const float* hp = lat ? F.out() + (size_t)r * DM : F.hc() + (size_t)(r - NLAT) * DM;
        f32x4 v[4]; float ss = 0.f;
#pragma unroll
        for (int j = 0; j < 4; ++j) { v[j] = *(const f32x4*)(hp + 4 * F.lane + 256 * j); ss += (v[j][0] * v[j][0] + v[j][1] * v[j][1]) + (v[j][2] * v[j][2] + v[j][3] * v[j][3]); }
        const float rstd = rsqrtf(wsum(ss) * (1.f / DM) + EPS);
        const float* md = F.modv() + ((size_t)L * 9 + bb) * 6144;
        float lg[20];
#pragma unroll
        for (int o = 0; o < 20; ++o) lg[o] = 0.f;
#pragma unroll
        for (int j = 0; j < 4; ++j) { const int c = 4 * F.lane + 256 * j; const f32x4 g = *(const f32x4*)(F.g_ffn() + L * DM + c), sh = *(const f32x4*)(md + 3 * 1024 + c), scl = *(const f32x4*)(md + 4 * 1024 + c);
            const f32x4 f = v[j] * rstd * g * (scl + 1.f) + sh; u32x2 o2; o2.x = pk2(f[0], f[1]); o2.y = pk2(f[2], f[3]); *(u32x2*)(F.abuf() + (size_t)r * DM + c) = o2;
#pragma unroll
            for (int e = 0; e < 4; ++e) { const int k = c + e; const f32x4 wg = *(const f32x4*)(F.w_grp() + ((size_t)L * DM + k) * 4);
#pragma unroll
                for (int o = 0; o < 4; ++o) lg[o] += f[e] * wg[o];
#pragma unroll
                for (int q = 0; q < 4; ++q) { const f32x4 we = *(const f32x4*)(F.w_exp() + ((size_t)L * DM + k) * 16 + 4 * q);
#pragma unroll
                    for (int o = 0; o < 4; ++o) lg[4 + 4 * q + o] += f[e] * we[o]; } } }
#pragma unroll
        for (int o = 0; o < 20; ++o) lg[o] = wsum(lg[o]);
        if (F.lane == 0) {
            float gl[4]; float gm = -INFINITY; int gt = 0;
#pragma unroll
            for (int o = 0; o < 4; ++o) { gl[o] = lg[o] + F.b_grp()[L * 4 + o]; if (gl[o] > gm) { gm = gl[o]; gt = o; } }
            float gs = 0.f;
#pragma unroll
            for (int o = 0; o < 4; ++o) gs += expf(gl[o] - gm);
            const float gp = 1.f / gs;
            float el[4];
#pragma unroll
            for (int o = 0; o < 4; ++o) { float v4 = 0.f;
#pragma unroll
                for (int q = 0; q < 4; ++q) v4 = (gt == q) ? lg[4 + 4 * q + o] + F.b_exp()[L * 16 + 4 * q + o] : v4;
                el[o] = v4; }
            int i0 = 0; float m0 = el[0];
#pragma unroll
            for (int o = 1; o < 4; ++o) if (el[o] > m0) { m0 = el[o]; i0 = o; }
            int i1 = -1; float m1 = -INFINITY;
#pragma unroll
            for (int o = 0; o < 4; ++o) if (o != i0 && el[o] > m1) { m1 = el[o]; i1 = o; }
            const float e1 = expf(m1 - m0), w0 = gp / (1.f + e1), w1 = gp * e1 / (1.f + e1);
            const int x0 = gt * 4 + i0, x1 = gt * 4 + i1;
            F.rtw()[2 * r] = w0; F.rtw()[2 * r + 1] = w1;
            const unsigned p0 = atomicAdd(F.ctl() + CW_ECNT + (L * 16 + x0) * 64, 1u), p1 = atomicAdd(F.ctl() + CW_ECNT + (L * 16 + x1) * 64, 1u);
            F.elist()[x0 * NROW + p0] = 2 * r; F.elist()[x1 * NROW + p1] = 2 * r + 1;
        }
    }
}
__device__ __forceinline__ void moe_table(const Fr& F, int L) {
    volatile LAS int* T = (volatile LAS int*)(F.lds + LDSCTL_OFF + 64);
    volatile LAS int* Cn = (volatile LAS int*)(F.lds + LDSCTL_OFF + 160);
    __syncthreads();
    if (F.tid == 0) { int acc = 0;
        for (int e = 0; e < 16; ++e) { const int c = (int)__hip_atomic_load(F.ctl() + CW_ECNT + (L * 16 + e) * 64, __ATOMIC_RELAXED, __HIP_MEMORY_SCOPE_AGENT); T[e] = acc; Cn[e] = c; acc += (c + 255) >> 8; }
        T[16] = acc; }
    __syncthreads();
}

__global__ void __launch_bounds__(512, 2) fwd_kernel(Args args) {
    extern __shared__ __attribute__((aligned(16))) unsigned char lds_raw[];
    Fr F0;
    F0.lds = (LAS unsigned char*)lds_raw; F0.tid = threadIdx.x; F0.lane = F0.tid & 63; F0.wave = __builtin_amdgcn_readfirstlane(F0.tid >> 6);
    F0.G = gridDim.x; { const int bx = blockIdx.x; F0.vcu = (F0.G % 8 == 0) ? (bx % 8) * (F0.G / 8) + bx / 8 : bx; }
    F0.gw = F0.vcu * 8 + F0.wave; F0.NGW = F0.G * 8;
    F0.A = (const __attribute__((address_space(4))) Args*)__builtin_amdgcn_kernarg_segment_ptr();
    for (int u = F0.tid; u < (LDS_BYTES - LDSCTL_OFF) / 4; u += 512) ((LAS unsigned*)(F0.lds + LDSCTL_OFF))[u] = 0u;
    __syncthreads();
    const int lo = args.ph_lo, hi = args.ph_hi;
    XcdBarrier bar; bar.bar = F0.ctl() + CW_BAR; bar.x = 0; bar.st = nullptr;
    if (hi - lo > 1) bar = xcd_barrier_post(F0.ctl() + CW_BAR, (volatile LAS unsigned*)(F0.lds + LDSCTL_OFF));
#ifndef PH_MASK
#define PH_MASK 0xFFFF
#endif
#define PM(b) ((PH_MASK >> (b)) & 1)
#define IN(k) (lo <= (k) && (k) < hi)
#define SEAM(k) do { if (IN(k) && IN((k) + 1)) { const Fr Fb = refresh(F0); XcdBarrier b2 = bar; b2.bar = Fb.ctl() + CW_BAR; xcd_barrier(b2); } } while (0)

    if (PM(0) && IN(0)) { const Fr F = refresh(F0); phase_prologue(F); }
    SEAM(0);
    for (int L = 0; L < DEPTH; ++L) {
        const int pb = 1 + NPH_L * L;
        const bool lastL = (L == DEPTH - 1);
        if (PM(1) && IN(pb + 0)) { const Fr F = refresh(F0); phase_norm(F, L); moe_weight_convert(F, L); }
        SEAM(pb + 0);
        if (PM(2) && IN(pb + 1)) { const Fr F = refresh(F0); pg8::DenseSched S; S.init(F.abuf(), F.winT() + (size_t)L * NP * DM, DM, NROW, NP, F.G, (int)blockIdx.x); pg8::EpiP E{F.pbuf()}; pg8::gemm_phase(F.lds, F.tid, DM, S, E); }
        SEAM(pb + 1);
        if (PM(3) && IN(pb + 2)) { const Fr F = refresh(F0); phase_prep(F, L); }
        SEAM(pb + 2);
        if (PM(4) && IN(pb + 3)) { const Fr F = refresh(F0); phase_ssd_naive(F, L); }
        SEAM(pb + 3);
        if (PM(5) && IN(pb + 4)) { const Fr F = refresh(F0); phase_mix_naive(F, L); }
        SEAM(pb + 4);
        if (PM(6) && IN(pb + 5)) { const Fr F = refresh(F0); pg8::DenseSched S; S.init(F.mix(), F.woutT() + (size_t)L * DM * DM, DM, lastL ? NLAT : NROW, DM, F.G, (int)blockIdx.x);
            pg8::EpiRes E{L == 0 ? F.x() : F.out(), L == 0 ? F.ctx() : F.hc(), F.out(), F.hc(), F.modv() + (size_t)L * 9 * 6144 + 2 * 1024}; pg8::gemm_phase(F.lds, F.tid, DM, S, E); }
        SEAM(pb + 5);
        if (PM(7) && IN(pb + 6)) { const Fr F = refresh(F0); phase_route(F, L); }
        SEAM(pb + 6);
        if (PM(8) && IN(pb + 7)) { const Fr F = refresh(F0); moe_table(F, L);
            pg8::MoeSched<true> S{(const char*)F.abuf(), (const char*)F.wgu(), (size_t)1024 * DM * 2, DM, F.G, F.vcu, F.elist(), (const volatile LAS int*)(F.lds + LDSCTL_OFF + 64), (const volatile LAS int*)(F.lds + LDSCTL_OFF + 160)};
            pg8::EpiAct E{F.act()}; pg8::gemm_phase(F.lds, F.tid, DM, S, E); }
        SEAM(pb + 7);
        if (PM(9) && IN(pb + 8)) { const Fr F = refresh(F0); moe_table(F, L);
            pg8::MoeSched<false> S{(const char*)F.act(), (const char*)F.wd(), (size_t)1024 * FF * 2, FF, F.G, F.vcu, F.elist(), (const volatile LAS int*)(F.lds + LDSCTL_OFF + 64), (const volatile LAS int*)(F.lds + LDSCTL_OFF + 160)};
            pg8::EpiDown E{F.yk(), F.elist(), F.rtw()}; pg8::gemm_phase(F.lds, F.tid, FF, S, E); }
        SEAM(pb + 8);
    }
    if (PM(1) && IN(PH_FINAL)) { const Fr F = refresh(F0); phase_norm(F, DEPTH); }
#undef IN
#undef SEAM
}

extern "C" void kernel_launch(void* const* d_in, const int* in_sizes, int n_in, void* d_out, int out_size, void* d_ws, size_t ws_size, hipStream_t stream) {
    static int grid = 0;
    if (grid == 0) {
        if (n_in != 36 || out_size != NLAT * DM || ws_size < WS_END) { fprintf(stderr, "kernel_launch: unexpected shapes (n_in %d out %d ws %zu)\n", n_in, out_size, ws_size); grid = -1; return; }
        int dev = 0, cus = 0, per_cu = 0;
        if (hipGetDevice(&dev) != hipSuccess || hipDeviceGetAttribute(&cus, hipDeviceAttributeMultiprocessorCount, dev) != hipSuccess) { grid = -1; return; }
        if (hipFuncSetAttribute((const void*)fwd_kernel, hipFuncAttributeMaxDynamicSharedMemorySize, LDS_BYTES) != hipSuccess) { fprintf(stderr, "kernel_launch: hipFuncSetAttribute failed\n"); grid = -1; return; }
        if (hipOccupancyMaxActiveBlocksPerMultiprocessor(&per_cu, (const void*)fwd_kernel, 512, LDS_BYTES) != hipSuccess || per_cu < 1) { fprintf(stderr, "kernel_launch: occupancy query says %d\n", per_cu); }
        (void)hipGetLastError();
        grid = cus;
    }
    if (grid < 0) return;
    (void)hipMemsetAsync((char*)d_ws + WS_CTL, 0, CTL_BYTES, stream);
    Args a{};
    for (int i = 0; i < 36; ++i) a.in[i] = (const float*)d_in[i];
    a.out = (float*)d_out; a.ws = (unsigned char*)d_ws;
#if MK_ONE_LAUNCH
    a.ph_lo = 0; a.ph_hi = NPHASE;
    hipLaunchKernelGGL(fwd_kernel, dim3(grid), dim3(512), LDS_BYTES, stream, a);
#else
    for (int ph = 0; ph < NPHASE; ++ph) { a.ph_lo = ph; a.ph_hi = ph + 1; hipLaunchKernelGGL(fwd_kernel, dim3(grid), dim3(512), LDS_BYTES, stream, a); }
#endif
}
```

```cpp
#include <hip/hip_runtime.h>
#include <cstdio>
#include <cstdint>

#ifndef MK_ONE_LAUNCH
#define MK_ONE_LAUNCH 1
#endif

#define LAS __attribute__((address_space(3)))
typedef unsigned short bf16;
typedef short bf16x8 __attribute__((ext_vector_type(8)));
typedef float f32x4 __attribute__((ext_vector_type(4)));
typedef float f32x2 __attribute__((ext_vector_type(2)));
typedef unsigned u32x4 __attribute__((ext_vector_type(4)));
typedef unsigned u32x2 __attribute__((ext_vector_type(2)));

constexpr int NB = 8, TLAT = 2048, TCTX = 256, SQ = 2304, DM = 1024, DEPTH = 4;
constexpr int NLAT = NB * TLAT, NCTXR = NB * TCTX, NROW = NLAT + NCTXR;
constexpr int NIN = 2984, NP = 3072;
constexpr int C_NA = 0, C_MLA = 768, C_DF = 1184, C_SSD = 1952;
constexpr int C_Z = C_SSD, C_XBC = C_SSD + 256, C_DT = C_SSD + 1024;
constexpr float EPS = 1e-6f;
constexpr int NEXP = 16, FF = 512, ACT_ROWS = 40960;
constexpr int NPH_L = 9, PH_FINAL = 1 + NPH_L * DEPTH, NPHASE = PH_FINAL + 1;

constexpr size_t MiB = 1u << 20;
constexpr size_t WS_CTL = 0, CTL_BYTES = 1 * MiB;
constexpr size_t WS_MOD = 1 * MiB;
constexpr size_t WS_ROPE = 2 * MiB;
constexpr size_t WS_WIN = 4 * MiB;
constexpr size_t WS_WOUT = 28 * MiB;
constexpr size_t WS_WQB = 36 * MiB;
constexpr size_t WS_WKVB = 37 * MiB;
constexpr size_t WS_WGU = 38 * MiB;
constexpr size_t WS_WD = 70 * MiB;
constexpr size_t WS_HC = 86 * MiB;
constexpr size_t WS_A = 94 * MiB;
constexpr size_t WS_P = 130 * MiB;
constexpr size_t WS_ACT = 130 * MiB;
constexpr size_t WS_YK = 170 * MiB;
constexpr size_t WS_MIX = 238 * MiB;
constexpr size_t WS_QNA = 274 * MiB, WS_KNA = 283 * MiB, WS_VNA = 292 * MiB;
constexpr size_t WS_QML = 301 * MiB, WS_KML = 315 * MiB, WS_VML = 329 * MiB;
constexpr size_t WS_QDF = 338 * MiB, WS_KDF = 347 * MiB, WS_VDF = 356 * MiB;
constexpr size_t WS_XT = 365 * MiB, WS_BTM = 374 * MiB, WS_BT = 383 * MiB, WS_CTM = 392 * MiB;
constexpr size_t WS_DT = 401 * MiB;
constexpr size_t WS_CST = 402 * MiB;
constexpr size_t WS_CDEC = 474 * MiB;
constexpr size_t WS_HENT = 475 * MiB;
constexpr size_t WS_RT = 511 * MiB;
constexpr size_t WS_ELIST = 512 * MiB;
constexpr size_t WS_END = 514 * MiB;
constexpr int CW_BAR = 4096;
constexpr int CW_ECNT = 16384;

constexpr int RING_BYTES = 131072, LDSCTL_OFF = RING_BYTES, LDS_BYTES = 147456;

__device__ __forceinline__ float bf2f(bf16 v) { return __uint_as_float(((unsigned)v) << 16); }
__device__ __forceinline__ bf16 f2bf(float f) { unsigned u = __float_as_uint(f); return (bf16)((u + 0x7fffu + ((u >> 16) & 1u)) >> 16); }
__device__ __forceinline__ unsigned pk2(float lo, float hi) { return (unsigned)f2bf(lo) | ((unsigned)f2bf(hi) << 16); }
__device__ __forceinline__ float wsum(float v) {
#pragma unroll
    for (int o = 32; o >= 1; o >>= 1) v += __shfl_xor(v, o);
    return v; }
__device__ __forceinline__ float wmaxf(float v) {
#pragma unroll
    for (int o = 32; o >= 1; o >>= 1) v = fmaxf(v, __shfl_xor(v, o));
    return v; }
#define LDS_WAIT() asm volatile("s_waitcnt lgkmcnt(0)" ::: "memory")
__device__ __forceinline__ void row2bs(int r, int& b, int& s) { if (r < NLAT) { b = r >> 11; s = 256 + (r & 2047); } else { const int j = r - NLAT; b = j >> 8; s = j & 255; } }
__device__ __forceinline__ int bs2row(int b, int s) { return s < 256 ? NLAT + b * 256 + s : b * 2048 + s - 256; }
__device__ __forceinline__ int vpos(int s) { return (s & ~12) | ((s & 4) << 1) | ((s & 8) >> 1); }
__device__ __forceinline__ float siluf(float x) { return x / (1.f + __expf(-x)); }

#define XB_TMO      128
#define XB_XCNT(j)  (256  + 64 * (j))
#define XB_XSUB(j)  (1280 + 64 * (j))
#define XB_XGEN(j)  (2304 + 64 * (j))
#define XB_TOP      3328
#define XB_TOPGEN   3392
#define XCD_BAR_WORDS 3456
#define XB_SPIN_CAP (1u << 24)
__device__ __forceinline__ unsigned xb_ld(unsigned* p)              { return __hip_atomic_load(p, __ATOMIC_RELAXED, __HIP_MEMORY_SCOPE_AGENT); }
__device__ __forceinline__ unsigned xb_add(unsigned* p, unsigned v) { return __hip_atomic_fetch_add(p, v, __ATOMIC_RELAXED, __HIP_MEMORY_SCOPE_AGENT); }
__device__ __forceinline__ unsigned xb_xcc_id() { return (unsigned)__builtin_amdgcn_s_getreg((3 << 11) | 20) & 0xFu; }
#define XB_SPIN(cond, bar) do { unsigned _sp = 0; while (cond) { __builtin_amdgcn_s_sleep(1); \
    if ((++_sp & 255u) == 0u) { if (xb_ld(&(bar)[XB_TMO])) break; if (_sp > XB_SPIN_CAP) { atomicAdd(&(bar)[XB_TMO], 1u); break; } } } } while (0)
struct XcdBarrier { unsigned* bar; unsigned x; volatile LAS unsigned* st; };
__device__ __forceinline__ XcdBarrier xcd_barrier_post(unsigned* bar, volatile LAS unsigned* st) {
    XcdBarrier b; b.bar = bar; b.x = xb_xcc_id(); b.st = st;
    if (threadIdx.x == 0) (void)xb_add(&bar[XB_XCNT(b.x)], 1u);
    return b;
}
__device__ __forceinline__ void xcd_barrier_complete(unsigned* bar, unsigned x, unsigned& nloc, unsigned& nx) {
    const unsigned G = gridDim.x * gridDim.y * gridDim.z;
    unsigned sum, cnt, mine, sp = 0u;
    for (;;) {
        sum = 0u; cnt = 0u; mine = 0u;
#pragma unroll
        for (unsigned j = 0; j < 16; ++j) { const unsigned c = xb_ld(&bar[XB_XCNT(j)]); sum += c; cnt += (c > 0u) ? 1u : 0u; mine = (j == x) ? c : mine; }
        if (sum == G) break;
        __builtin_amdgcn_s_sleep(1);
        if ((++sp & 255u) == 0u) { if (xb_ld(&bar[XB_TMO])) break; if (sp > XB_SPIN_CAP) { atomicAdd(&bar[XB_TMO], 1u); break; } }
    }
    nloc = mine > 0u ? mine : 1u; nx = cnt > 0u ? cnt : 1u;
}
__device__ __forceinline__ void xcd_barrier(const XcdBarrier& b) {
    asm volatile("s_waitcnt vmcnt(0)" ::: "memory");
    __syncthreads();
    if (threadIdx.x == 0) {
        unsigned* bar = b.bar;
        __builtin_amdgcn_s_waitcnt(0);
        unsigned nloc = b.st[0], nx = b.st[1];
        if (nloc == 0u) { xcd_barrier_complete(bar, b.x, nloc, nx); b.st[0] = nloc; b.st[1] = nx; }
        const unsigned old = xb_add(&bar[XB_XSUB(b.x)], 1u);
        const unsigned gen = old / nloc;
        if (old + 1u == (gen + 1u) * nloc) {
            __builtin_amdgcn_fence(__ATOMIC_RELEASE, "agent");
            asm volatile("s_waitcnt vmcnt(0)" ::: "memory");
            const unsigned og = xb_add(&bar[XB_TOP], 1u);
            const unsigned tg = og / nx;
            if (og + 1u == (tg + 1u) * nx) xb_add(&bar[XB_TOPGEN], 1u);
            else XB_SPIN(xb_ld(&bar[XB_TOPGEN]) == tg, bar);
            __builtin_amdgcn_fence(__ATOMIC_ACQUIRE, "agent");
            xb_add(&bar[XB_XGEN(b.x)], 1u);
            asm volatile("s_waitcnt vmcnt(0)" ::: "memory");
        } else {
            XB_SPIN(xb_ld(&bar[XB_XGEN(b.x)]) == gen, bar);
            __builtin_amdgcn_fence(__ATOMIC_ACQUIRE, "agent");
            asm volatile("s_waitcnt vmcnt(0)" ::: "memory");
        }
    }
    __syncthreads();
}

namespace pg8 {
constexpr int BM = 256, BK = 64, HALF = 128, HTB = HALF * BK * 2, NXCD = 8, WGM = 8;
__device__ __forceinline__ int lds_byte(int r, int c) { const int st = (r >> 4) * 2 + (c >> 5), rr = r & 15, cc = c & 31, ob = rr * 64 + cc * 2; return st * 1024 + (ob ^ (((ob >> 9) & 1) << 5)); }
__device__ __forceinline__ void stage_rc(int b, int& R, int& C) { const int st = b / 1024, sb = b % 1024, swz = sb ^ (((sb >> 9) & 1) << 5); R = (st >> 1) * 16 + swz / 64; C = (st & 1) * 32 + (swz % 64) / 2; }
__device__ __forceinline__ int perm32(int rho) { const int n = rho >> 4, i = rho & 15; return 8 * (i >> 2) + 4 * n + (i & 3); }
struct Unit { int pm, pn, e, j, cnt; };

template <class Epi, class Sched>
__device__ __forceinline__ void gemm_phase(LAS unsigned char* lds, const int tid, const int K, const Sched& S, const Epi& E) {
    const int wid = __builtin_amdgcn_readfirstlane(tid >> 6), lane = tid & 63, wr = wid >> 2, wc = wid & 3, fr = lane & 15, fq = lane >> 4;
    const int nt = K / BK;
    int Rr[2]; unsigned Cb[2], voffB[2];
#pragma unroll
    for (int i = 0; i < 2; ++i) { int R, C; stage_rc(tid * 16 + i * 8192, R, C); const int Rb = Epi::PERM ? ((R & ~31) + perm32(R & 31)) : R;
        Rr[i] = R; Cb[i] = (unsigned)C * 2u; voffB[i] = (unsigned)(Rb * K + C) * 2u; }
    const size_t kstep = (size_t)(BK * 2);
    const size_t hstep = (size_t)HALF * K * 2;
    const unsigned ldsw = (unsigned)wid * 1024u;
    const int aoff = lds_byte(wr * 64 + fr, fq * 8), boff = lds_byte(wc * 32 + fr, fq * 8);
#define PG8_SA(b, h) (((b) * 2 + (h)) * HTB)
#define PG8_SB(b, h) ((4 + (b) * 2 + (h)) * HTB)
#define PG8_STAGE(bufoff, gbase, voff) do { _Pragma("unroll") for (int _i = 0; _i < 2; ++_i) \
        __builtin_amdgcn_global_load_lds((const unsigned*)((const char*)(gbase) + (voff)[_i]), (LAS unsigned*)(lds + (bufoff) + ldsw + _i * 8192), 16, 0, 0); } while (0)
#define PG8_LDA(dst, b, h) do { _Pragma("unroll") for (int m = 0; m < 4; ++m) _Pragma("unroll") for (int k = 0; k < 2; ++k) dst[m][k] = *(const LAS bf16x8*)(lds + PG8_SA(b, h) + aoff + m * 2048 + k * 1024); } while (0)
#define PG8_LDB(dst, b, h) do { _Pragma("unroll") for (int n = 0; n < 2; ++n) _Pragma("unroll") for (int k = 0; k < 2; ++k) dst[n][k] = *(const LAS bf16x8*)(lds + PG8_SB(b, h) + boff + n * 2048 + k * 1024); } while (0)
#define PG8_MMA(ai, bj, At, Bt) do { __builtin_amdgcn_s_setprio(1); _Pragma("unroll") for (int m = 0; m < 4; ++m) _Pragma("unroll") for (int n = 0; n < 2; ++n) _Pragma("unroll") for (int k = 0; k < 2; ++k) \
        acc[ai][bj][m][n] = __builtin_amdgcn_mfma_f32_16x16x32_bf16(Bt[n][k], At[m][k], acc[ai][bj][m][n], 0, 0, 0); __builtin_amdgcn_s_setprio(0); } while (0)
#define PG8_WAIT_V(n) asm volatile("s_waitcnt vmcnt(" #n ")" ::: "memory")
#define PG8_WAIT_L(n) asm volatile("s_waitcnt lgkmcnt(" #n ")" ::: "memory")
#define PG8_BAR __builtin_amdgcn_s_barrier()
#define PG8_SCHED __builtin_amdgcn_sched_barrier(0)
    Unit cur, nxt; int ui = 0;
    if (!S.next(0, cur)) return;
    f32x4 acc[2][2][4][2];
#pragma unroll
    for (int a = 0; a < 2; ++a)
#pragma unroll
        for (int b = 0; b < 2; ++b)
#pragma unroll
            for (int m = 0; m < 4; ++m)
#pragma unroll
                for (int n = 0; n < 2; ++n) acc[a][b][m][n] = (f32x4){0.f, 0.f, 0.f, 0.f};
    bf16x8 At[4][2], B0[2][2], B1[2][2];
    unsigned vA0[2], vA1[2];
    const char* cA = S.a_ptr(cur);
    if constexpr (Sched::GATHER) { S.a_offs(cur, Rr, vA0, vA1);
#pragma unroll
        for (int i = 0; i < 2; ++i) { vA0[i] += Cb[i]; vA1[i] += Cb[i]; }
        asm volatile("s_waitcnt vmcnt(0)" ::: "memory");
    } else {
#pragma unroll
        for (int i = 0; i < 2; ++i) { vA0[i] = (unsigned)(Rr[i] * K * 2) + Cb[i]; vA1[i] = vA0[i]; } }
    const size_t ahs = Sched::GATHER ? (size_t)0 : hstep;
    const char* cB = S.b_ptr(cur);
    PG8_STAGE(PG8_SB(0, 0), cB, voffB); PG8_STAGE(PG8_SB(0, 1), cB + hstep, voffB); PG8_STAGE(PG8_SA(0, 0), cA, vA0); PG8_STAGE(PG8_SA(0, 1), cA + ahs, vA1);
    if (wr == 1) PG8_BAR;
    PG8_WAIT_V(2); PG8_BAR;
    PG8_STAGE(PG8_SB(1, 0), cB + kstep, voffB); PG8_STAGE(PG8_SA(1, 0), cA + kstep, vA0); PG8_STAGE(PG8_SB(1, 1), cB + hstep + kstep, voffB);
    PG8_WAIT_V(6); PG8_BAR;
    for (;;) {
        const bool has_next = S.next(ui + 1, nxt);
        const char* nA = has_next ? S.a_ptr(nxt) : cA; const char* nB = has_next ? S.b_ptr(nxt) : cB;
        for (int t = 0; t < nt; t += 2) {
            const bool last = (t == nt - 2);
            const char* a1 = cA + (size_t)(t + 1) * kstep;
            const char* a2 = last ? nA : cA + (size_t)(t + 2) * kstep; const char* b2 = last ? nB : cB + (size_t)(t + 2) * kstep;
            const char* a3 = a2 + kstep; const char* b3 = b2 + kstep;
            PG8_LDB(B0, 0, 0); PG8_LDB(B1, 0, 1); PG8_SCHED; PG8_LDA(At, 0, 0); PG8_STAGE(PG8_SA(1, 1), a1 + ahs, vA1);
            if constexpr (Sched::GATHER) { if (last && has_next) { S.a_offs(nxt, Rr, vA0, vA1);
#pragma unroll
                for (int i = 0; i < 2; ++i) { vA0[i] += Cb[i]; vA1[i] += Cb[i]; }
                asm volatile("s_waitcnt vmcnt(0)" ::: "memory"); } }
            PG8_WAIT_V(8); PG8_WAIT_L(0); PG8_BAR; PG8_MMA(0, 0, At, B0); PG8_MMA(0, 1, At, B1); PG8_BAR; PG8_SCHED;
            PG8_LDA(At, 0, 1); PG8_STAGE(PG8_SB(0, 0), b2, voffB); PG8_STAGE(PG8_SB(0, 1), b2 + hstep, voffB); PG8_STAGE(PG8_SA(0, 0), a2, vA0);
            PG8_WAIT_V(8); PG8_WAIT_L(0); PG8_BAR; PG8_MMA(1, 0, At, B0); PG8_MMA(1, 1, At, B1); PG8_BAR; PG8_SCHED;
            PG8_LDB(B0, 1, 0); PG8_LDB(B1, 1, 1); PG8_SCHED; PG8_LDA(At, 1, 0); PG8_STAGE(PG8_SA(0, 1), a2 + ahs, vA1);
            PG8_WAIT_V(8); PG8_WAIT_L(0); PG8_BAR; PG8_MMA(0, 0, At, B0); PG8_MMA(0, 1, At, B1); PG8_BAR; PG8_SCHED;
            PG8_LDA(At, 1, 1); PG8_STAGE(PG8_SB(1, 0), b3, voffB); PG8_STAGE(PG8_SB(1, 1), b3 + hstep, voffB); PG8_STAGE(PG8_SA(1, 0), a3, vA0);
            PG8_WAIT_V(8); PG8_WAIT_L(0); PG8_BAR; PG8_MMA(1, 0, At, B0); PG8_MMA(1, 1, At, B1); PG8_BAR; PG8_SCHED;
        }
        if (wr == 0) PG8_BAR;
        E(acc, cur, wr, wc, fr, fq);
        if (!has_next) break;
#pragma unroll
        for (int a = 0; a < 2; ++a)
#pragma unroll
            for (int b = 0; b < 2; ++b)
#pragma unroll
                for (int m = 0; m < 4; ++m)
#pragma unroll
                    for (int n = 0; n < 2; ++n) acc[a][b][m][n] = (f32x4){0.f, 0.f, 0.f, 0.f};
        cur = nxt; cA = nA; cB = nB; ++ui;
        if (wr == 1) PG8_BAR;
    }
    PG8_WAIT_V(0);
    PG8_BAR;
#undef PG8_SA
#undef PG8_SB
#undef PG8_STAGE
#undef PG8_LDA
#undef PG8_LDB
#undef PG8_MMA
#undef PG8_WAIT_V
#undef PG8_WAIT_L
#undef PG8_BAR
#undef PG8_SCHED
}
__device__ __forceinline__ unsigned cvt_pk_bf16(float lo, float hi) { unsigned r; asm volatile("v_cvt_pk_bf16_f32 %0, %1, %2" : "=v"(r) : "v"(lo), "v"(hi)); return r; }

struct DenseSched {
    const char* A; const char* Bt; int K, nM, nN, nwg, G, c;
    __device__ void init(const void* A_, const void* Bt_, int K_, int M, int N, int G_, int c_) { A = (const char*)A_; Bt = (const char*)Bt_; K = K_; nM = M / BM; nN = N / BM; nwg = nM * nN; G = G_; c = c_; }
    __device__ __forceinline__ bool next(int i, Unit& u) const {
        const long L = (long)i * G + c; if (L >= nwg) return false;
        int wgid = (int)L; { const int q = nwg / NXCD, r = nwg % NXCD, xcd = wgid % NXCD, off = wgid / NXCD; wgid = (xcd < r ? xcd * (q + 1) : r * (q + 1) + (xcd - r) * q) + off; }
        const int nig = WGM * nN, gid = wgid / nig, fm = gid * WGM, gsz = (nM - fm) < WGM ? (nM - fm) : WGM;
        u.pm = fm + ((wgid % nig) % gsz); u.pn = (wgid % nig) / gsz; u.e = 0; u.j = 0; u.cnt = 256; return true;
    }
    static constexpr bool GATHER = false;
    __device__ __forceinline__ const char* a_ptr(const Unit& u) const { return A + (size_t)u.pm * BM * K * 2; }
    __device__ __forceinline__ void a_offs(const Unit&, const int (&)[2], unsigned (&)[2], unsigned (&)[2]) const {}
    __device__ __forceinline__ const char* b_ptr(const Unit& u) const { return Bt + (size_t)u.pn * BM * K * 2; }
};
template <bool GATHER_> struct MoeSched {
    static constexpr bool GATHER = GATHER_;
    const char* A; const char* W; size_t wstride; int K, G, c; const int* elist; const volatile LAS int* T; const volatile LAS int* Cn;
    __device__ __forceinline__ bool next(int i, Unit& u) const {
        const long L = (long)i * G + c; const int nT = T[16]; if (L >= 4L * nT) return false;
        const int tile = (int)(L >> 2); u.pn = (int)(L & 3); u.pm = tile;
        int e = 0;
#pragma unroll
        for (int k = 1; k < 16; ++k) e += (tile >= T[k]) ? 1 : 0;
        u.e = e; u.j = tile - T[e]; u.cnt = Cn[e]; return true;
    }
    __device__ __forceinline__ const char* a_ptr(const Unit& u) const { return GATHER ? A : A + (size_t)u.pm * BM * K * 2; }
    __device__ __forceinline__ void a_offs(const Unit& u, const int (&Rr)[2], unsigned (&v0)[2], unsigned (&v1)[2]) const {
#pragma unroll
        for (int i = 0; i < 2; ++i) {
            const int p0 = u.j * BM + Rr[i], p1 = p0 + HALF;
            const int t0 = p0 < u.cnt ? (elist[u.e * NROW + p0] >> 1) : 0, t1 = p1 < u.cnt ? (elist[u.e * NROW + p1] >> 1) : 0;
            v0[i] = (unsigned)(t0 * K * 2); v1[i] = (unsigned)(t1 * K * 2);
        } }
    __device__ __forceinline__ const char* b_ptr(const Unit& u) const { return W + (size_t)u.e * wstride + (size_t)u.pn * BM * K * 2; }
};
struct EpiP {
    static constexpr bool PERM = true;
    bf16* O;
    __device__ __forceinline__ void operator()(const f32x4 (&acc)[2][2][4][2], const Unit& u, int wr, int wc, int fr, int fq) const {
        const int row0 = u.pm * BM + wr * 64 + fr, col0 = u.pn * BM + wc * 32 + 8 * fq;
#pragma unroll
        for (int ai = 0; ai < 2; ++ai)
#pragma unroll
            for (int m = 0; m < 4; ++m) { bf16* rowp = O + (size_t)(row0 + ai * HALF + m * 16) * NP + col0;
#pragma unroll
                for (int bj = 0; bj < 2; ++bj) { const f32x4 v0 = acc[ai][bj][m][0], v1 = acc[ai][bj][m][1];
                    u32x4 w; w.x = cvt_pk_bf16(v0[0], v0[1]); w.y = cvt_pk_bf16(v0[2], v0[3]); w.z = cvt_pk_bf16(v1[0], v1[1]); w.w = cvt_pk_bf16(v1[2], v1[3]);
                    *(u32x4*)(rowp + bj * HALF) = w; } }
    }
};
struct EpiRes {
    static constexpr bool PERM = false;
    const float* hin_l; const float* hin_c; float* hout_l; float* hout_c; const float* gate;
    __device__ __forceinline__ void operator()(const f32x4 (&acc)[2][2][4][2], const Unit& u, int wr, int wc, int fr, int fq) const {
        const int row0 = u.pm * BM + wr * 64 + fr, col0 = u.pn * BM + wc * 32 + 4 * fq;
#pragma unroll
        for (int ai = 0; ai < 2; ++ai)
#pragma unroll
            for (int m = 0; m < 4; ++m) { const int r = row0 + ai * HALF + m * 16; const bool lat = r < NLAT; const int bb = lat ? (r >> 11) : 8;
                const float* hi = lat ? hin_l + (size_t)r * DM : hin_c + (size_t)(r - NLAT) * DM; float* ho = lat ? hout_l + (size_t)r * DM : hout_c + (size_t)(r - NLAT) * DM;
                const float* g = gate + (size_t)bb * 6144;
#pragma unroll
                for (int bj = 0; bj < 2; ++bj)
#pragma unroll
                    for (int n = 0; n < 2; ++n) { const int c = col0 + bj * HALF + n * 16; const f32x4 gv = *(const f32x4*)(g + c), hv = *(const f32x4*)(hi + c);
                        *(f32x4*)(ho + c) = hv + gv * acc[ai][bj][m][n]; } }
    }
};
struct EpiAct {
    static constexpr bool PERM = true;
    bf16* O;
    __device__ __forceinline__ void operator()(const f32x4 (&acc)[2][2][4][2], const Unit& u, int wr, int wc, int fr, int fq) const {
        const int row0 = u.pm * BM + wr * 64 + fr, col0 = u.pn * HALF + wc * 32 + 8 * fq;
#pragma unroll
        for (int ai = 0; ai < 2; ++ai)
#pragma unroll
            for (int m = 0; m < 4; ++m) { bf16* rowp = O + (size_t)(row0 + ai * HALF + m * 16) * FF + col0;
                float o[8];
#pragma unroll
                for (int n = 0; n < 2; ++n)
#pragma unroll
                    for (int j = 0; j < 4; ++j) { const float g = acc[ai][0][m][n][j], up = acc[ai][1][m][n][j]; o[n * 4 + j] = g / (1.f + __expf(-g)) * up; }
                u32x4 w; w.x = cvt_pk_bf16(o[0], o[1]); w.y = cvt_pk_bf16(o[2], o[3]); w.z = cvt_pk_bf16(o[4], o[5]); w.w = cvt_pk_bf16(o[6], o[7]);
                *(u32x4*)rowp = w; }
    }
};
struct EpiDown {
    static constexpr bool PERM = true;
    bf16* O; const int* elist; const float* rtw;
    __device__ __forceinline__ void operator()(const f32x4 (&acc)[2][2][4][2], const Unit& u, int wr, int wc, int fr, int fq) const {
        const int col0 = u.pn * BM + wc * 32 + 8 * fq;
#pragma unroll
        for (int ai = 0; ai < 2; ++ai)
#pragma unroll
            for (int m = 0; m < 4; ++m) { const int pos = u.j * BM + ai * HALF + wr * 64 + m * 16 + fr;
                if (pos < u.cnt) { const int a = elist[u.e * NROW + pos]; const float w8 = rtw[a]; bf16* rowp = O + (size_t)a * DM + col0;
#pragma unroll
                    for (int bj = 0; bj < 2; ++bj) { const f32x4 v0 = acc[ai][bj][m][0] * w8, v1 = acc[ai][bj][m][1] * w8;
                        u32x4 w; w.x = cvt_pk_bf16(v0[0], v0[1]); w.y = cvt_pk_bf16(v0[2], v0[3]); w.z = cvt_pk_bf16(v1[0], v1[1]); w.w = cvt_pk_bf16(v1[2], v1[3]);
                        *(u32x4*)(rowp + bj * HALF) = w; } } }
    }
};
}

struct Args { const float* in[36]; float* out; unsigned char* ws; int ph_lo, ph_hi; };
struct Fr {
    LAS unsigned char* lds; int tid, lane, wave, G, vcu, gw, NGW; const __attribute__((address_space(4))) Args* A;
    __device__ __forceinline__ const float* x() const { return A->in[0]; }
    __device__ __forceinline__ const float* cvec() const { return A->in[1]; }
    __device__ __forceinline__ const float* ctx() const { return A->in[2]; }
    __device__ __forceinline__ const float* cctx() const { return A->in[3]; }
    __device__ __forceinline__ const float* w_mod() const { return A->in[4]; }
    __device__ __forceinline__ const float* b_mod() const { return A->in[5]; }
    __device__ __forceinline__ const float* g_mix() const { return A->in[6]; }
    __device__ __forceinline__ const float* w_in() const { return A->in[7]; }
    __device__ __forceinline__ const float* w_out() const { return A->in[8]; }
    __device__ __forceinline__ const float* na_gq() const { return A->in[9]; }
    __device__ __forceinline__ const float* na_gk() const { return A->in[10]; }
    __device__ __forceinline__ const float* na_rb() const { return A->in[11]; }
    __device__ __forceinline__ const float* mla_gqa() const { return A->in[12]; }
    __device__ __forceinline__ const float* mla_wqb() const { return A->in[13]; }
    __device__ __forceinline__ const float* mla_gkva() const { return A->in[14]; }
    __device__ __forceinline__ const float* mla_wkvb() const { return A->in[15]; }
    __device__ __forceinline__ const float* mla_gq() const { return A->in[16]; }
    __device__ __forceinline__ const float* mla_gk() const { return A->in[17]; }
    __device__ __forceinline__ const float* df_gq() const { return A->in[18]; }
    __device__ __forceinline__ const float* df_gk() const { return A->in[19]; }
    __device__ __forceinline__ const float* df_lam() const { return A->in[20]; }
    __device__ __forceinline__ const float* df_gsub() const { return A->in[21]; }
    __device__ __forceinline__ const float* conv_w() const { return A->in[22]; }
    __device__ __forceinline__ const float* conv_b() const { return A->in[23]; }
    __device__ __forceinline__ const float* dt_bias() const { return A->in[24]; }
    __device__ __forceinline__ const float* a_log() const { return A->in[25]; }
    __device__ __forceinline__ const float* ssd_d() const { return A->in[26]; }
    __device__ __forceinline__ const float* ssd_gn() const { return A->in[27]; }
    __device__ __forceinline__ const float* g_ffn() const { return A->in[28]; }
    __device__ __forceinline__ const float* w_grp() const { return A->in[29]; }
    __device__ __forceinline__ const float* b_grp() const { return A->in[30]; }
    __device__ __forceinline__ const float* w_exp() const { return A->in[31]; }
    __device__ __forceinline__ const float* b_exp() const { return A->in[32]; }
    __device__ __forceinline__ const float* w_gate() const { return A->in[33]; }
    __device__ __forceinline__ const float* w_up() const { return A->in[34]; }
    __device__ __forceinline__ const float* w_down() const { return A->in[35]; }
    __device__ __forceinline__ float* out() const { return A->out; }
    __device__ __forceinline__ unsigned* ctl() const { return (unsigned*)(A->ws + WS_CTL); }
    __device__ __forceinline__ float* modv() const { return (float*)(A->ws + WS_MOD); }
    __device__ __forceinline__ float* rcos() const { return (float*)(A->ws + WS_ROPE); }
    __device__ __forceinline__ float* rsin() const { return (float*)(A->ws + WS_ROPE + TLAT * 16 * 4); }
    __device__ __forceinline__ bf16* winT() const { return (bf16*)(A->ws + WS_WIN); }
    __device__ __forceinline__ bf16* woutT() const { return (bf16*)(A->ws + WS_WOUT); }
    __device__ __forceinline__ bf16* wqbT() const { return (bf16*)(A->ws + WS_WQB); }
    __device__ __forceinline__ bf16* wkvbT() const { return (bf16*)(A->ws + WS_WKVB); }
    __device__ __forceinline__ bf16* wgu() const { return (bf16*)(A->ws + WS_WGU); }
    __device__ __forceinline__ bf16* wd() const { return (bf16*)(A->ws + WS_WD); }
    __device__ __forceinline__ float* hc() const { return (float*)(A->ws + WS_HC); }
    __device__ __forceinline__ bf16* abuf() const { return (bf16*)(A->ws + WS_A); }
    __device__ __forceinline__ bf16* pbuf() const { return (bf16*)(A->ws + WS_P); }
    __device__ __forceinline__ bf16* act() const { return (bf16*)(A->ws + WS_ACT); }
    __device__ __forceinline__ bf16* yk() const { return (bf16*)(A->ws + WS_YK); }
    __device__ __forceinline__ bf16* mix() const { return (bf16*)(A->ws + WS_MIX); }
    __device__ __forceinline__ bf16* qna() const { return (bf16*)(A->ws + WS_QNA); }
    __device__ __forceinline__ bf16* kna() const { return (bf16*)(A->ws + WS_KNA); }
    __device__ __forceinline__ bf16* vna() const { return (bf16*)(A->ws + WS_VNA); }
    __device__ __forceinline__ bf16* qml() const { return (bf16*)(A->ws + WS_QML); }
    __device__ __forceinline__ bf16* kml() const { return (bf16*)(A->ws + WS_KML); }
    __device__ __forceinline__ bf16* vml() const { return (bf16*)(A->ws + WS_VML); }
    __device__ __forceinline__ bf16* qdf() const { return (bf16*)(A->ws + WS_QDF); }
    __device__ __forceinline__ bf16* kdf() const { return (bf16*)(A->ws + WS_KDF); }
    __device__ __forceinline__ bf16* vdf() const { return (bf16*)(A->ws + WS_VDF); }
    __device__ __forceinline__ bf16* xT() const { return (bf16*)(A->ws + WS_XT); }
    __device__ __forceinline__ bf16* btm() const { return (bf16*)(A->ws + WS_BTM); }
    __device__ __forceinline__ bf16* bT() const { return (bf16*)(A->ws + WS_BT); }
    __device__ __forceinline__ bf16* ctm() const { return (bf16*)(A->ws + WS_CTM); }
    __device__ __forceinline__ float* dtv() const { return (float*)(A->ws + WS_DT); }
    __device__ __forceinline__ float* cst() const { return (float*)(A->ws + WS_CST); }
    __device__ __forceinline__ float* cdec() const { return (float*)(A->ws + WS_CDEC); }
    __device__ __forceinline__ bf16* hent() const { return (bf16*)(A->ws + WS_HENT); }
    __device__ __forceinline__ float* ydir() const { return (float*)(A->ws + WS_CST); }
    __device__ __forceinline__ int* rte() const { return (int*)(A->ws + WS_RT); }
    __device__ __forceinline__ float* rtw() const { return (float*)(A->ws + WS_RT + 256 * 1024); }
    __device__ __forceinline__ int* elist() const { return (int*)(A->ws + WS_ELIST); }
};

__device__ __forceinline__ Fr refresh(const Fr& F0) { Fr F = F0; int w = F0.wave; asm volatile("" : "+s"(w)); asm volatile("" : "+s"(F.A));
    int l; asm volatile("v_mbcnt_lo_u32_b32 %0, -1, 0\n\tv_mbcnt_hi_u32_b32 %0, -1, %0" : "=v"(l)); F.wave = w; F.lane = l; F.tid = w * 64 + l; F.gw = F.vcu * 8 + w; return F; }
__device__ __forceinline__ void tr_item(const float* W, int ldw, int nvalid, int k0, int n0, bf16* dst, int ldd, LAS float* scr, int lane) {
    const int cn = n0 + (lane & 31);
#pragma unroll 8
    for (int i = 0; i < 32; ++i) { const int kk = 2 * i + (lane >> 5); scr[kk * 33 + (lane & 31)] = cn < nvalid ? W[(size_t)(k0 + kk) * ldw + cn] : 0.f; }
    LDS_WAIT();
    const int c = lane & 7;
#pragma unroll
    for (int j = 0; j < 4; ++j) { const int n = (lane >> 3) + 8 * j; const LAS float* s = scr + (8 * c) * 33 + n;
        u32x4 o; o.x = pk2(s[0 * 33], s[1 * 33]); o.y = pk2(s[2 * 33], s[3 * 33]); o.z = pk2(s[4 * 33], s[5 * 33]); o.w = pk2(s[6 * 33], s[7 * 33]);
        *(u32x4*)(dst + (size_t)n * ldd + k0 + 8 * c) = o; }
    LDS_WAIT();
}
__device__ __forceinline__ void moe_weight_convert(const Fr& F, int L) {
    LAS float* scr = (LAS float*)(F.lds + F.wave * 16384);
    constexpr int I_GU = 16 * 16, I_D = 8 * 32;
    for (int it = F.gw; it < NEXP * (2 * I_GU + I_D); it += F.NGW) {
        const int e = it / (2 * I_GU + I_D); int r = it % (2 * I_GU + I_D);
        if (r < 2 * I_GU) { const int bj = r / I_GU; r %= I_GU; const int kb = r / 16, nb = r % 16, n0 = nb * 32;
            const float* W = (bj ? F.w_up() : F.w_gate()) + ((size_t)L * NEXP + e) * DM * FF;
            tr_item(W, FF, FF, kb * 64, n0, F.wgu() + ((size_t)e * 1024 + (n0 >> 7) * 256 + bj * 128 + (n0 & 127)) * DM, DM, scr, F.lane);
        } else { r -= 2 * I_GU; const int kb = r / 32, nb = r % 32, n0 = nb * 32;
            const float* W = F.w_down() + ((size_t)L * NEXP + e) * FF * DM;
            tr_item(W, DM, DM, kb * 64, n0, F.wd() + ((size_t)e * 1024 + n0) * FF, FF, scr, F.lane); }
    }
}
__device__ __forceinline__ void phase_prologue(const Fr& F) {
    LAS float* sc = (LAS float*)F.lds;
    for (int u = blockIdx.x; u < 48; u += F.G) {
        for (int i = F.tid; i < 9 * 1024; i += 512) { const float v = i < 8192 ? F.cvec()[i] : F.cctx()[i - 8192]; sc[i] = siluf(v); }
        __syncthreads();
        const int col = u * 512 + F.tid, L = col / 6144, n = col % 6144;
        float acc[9];
#pragma unroll
        for (int b = 0; b < 9; ++b) acc[b] = 0.f;
        const float* w = F.w_mod() + (size_t)L * 1024 * 6144 + n;
#pragma unroll 8
        for (int k = 0; k < 1024; ++k) { const float wv = w[(size_t)k * 6144];
#pragma unroll
            for (int b = 0; b < 9; ++b) acc[b] += sc[b * 1024 + k] * wv; }
        const float bm = F.b_mod()[L * 6144 + n];
#pragma unroll
        for (int b = 0; b < 9; ++b) F.modv()[((size_t)L * 9 + b) * 6144 + n] = acc[b] + bm;
        __syncthreads();
    }
    for (int i = blockIdx.x * 512 + F.tid; i < TLAT * 16; i += F.G * 512) { const int t = i >> 4, k = i & 15; const float inv = powf(10000.f, -(float)(k & 7) / 8.f);
        const float pos = (k < 8) ? (float)(t >> 6) : (float)(t & 63); const float ang = pos * inv; F.rcos()[i] = cosf(ang); F.rsin()[i] = sinf(ang); }
    __syncthreads();
    LAS float* scr = (LAS float*)(F.lds + F.wave * 16384);
    constexpr int I_IN = 16 * 96, I_OUT = 16 * 32, I_QB = 4 * 12, I_KVB = 2 * 16, I_L = I_IN + I_OUT + I_QB + I_KVB;
    for (int it = F.gw; it < DEPTH * I_L; it += F.NGW) {
        const int L = it / I_L; int r = it % I_L;
        if (r < I_IN) { const int kb = r / 96, nb = r % 96; tr_item(F.w_in() + (size_t)L * DM * NIN, NIN, NIN, kb * 64, nb * 32, F.winT() + ((size_t)L * NP + nb * 32) * DM, DM, scr, F.lane); continue; } r -= I_IN;
        if (r < I_OUT) { const int kb = r / 32, nb = r % 32; tr_item(F.w_out() + (size_t)L * DM * DM, DM, DM, kb * 64, nb * 32, F.woutT() + ((size_t)L * DM + nb * 32) * DM, DM, scr, F.lane); continue; } r -= I_OUT;
        if (r < I_QB) { const int kb = r / 12, nb = r % 12; tr_item(F.mla_wqb() + (size_t)L * 256 * 384, 384, 384, kb * 64, nb * 32, F.wqbT() + ((size_t)L * 384 + nb * 32) * 256, 256, scr, F.lane); continue; } r -= I_QB;
        { const int kb = r / 16, nb = r % 16; tr_item(F.mla_wkvb() + (size_t)L * 128 * 512, 512, 512, kb * 64, nb * 32, F.wkvbT() + ((size_t)L * 512 + nb * 32) * 128, 128, scr, F.lane); }
    }
}

__device__ __forceinline__ void phase_norm(const Fr& F, int L) {
    const int nrows = (L == DEPTH) ? NLAT : NROW;
    for (int r = F.gw; r < nrows; r += F.NGW) {
        const bool lat = r < NLAT; const int bb = lat ? (r >> 11) : 8;
        const float* hin = (L == 0) ? (lat ? F.x() + (size_t)r * DM : F.ctx() + (size_t)(r - NLAT) * DM) : (lat ? F.out() + (size_t)r * DM : F.hc() + (size_t)(r - NLAT) * DM);
        float* hout = lat ? F.out() + (size_t)r * DM : F.hc() + (size_t)(r - NLAT) * DM;
        f32x4 v[4];
#pragma unroll
        for (int j = 0; j < 4; ++j) v[j] = *(const f32x4*)(hin + 4 * F.lane + 256 * j);
        if (L > 0) {
            const float* m5 = F.modv() + ((size_t)(L - 1) * 9 + bb) * 6144 + 5 * 1024;
#pragma unroll
            for (int j = 0; j < 4; ++j) { const int c = 4 * F.lane + 256 * j; const f32x4 g = *(const f32x4*)(m5 + c);
                const u32x2 y0 = *(const u32x2*)(F.yk() + (size_t)(2 * r) * DM + c), y1 = *(const u32x2*)(F.yk() + (size_t)(2 * r + 1) * DM + c);
                f32x4 ys; ys[0] = __uint_as_float(y0.x << 16) + __uint_as_float(y1.x << 16); ys[1] = __uint_as_float(y0.x & 0xffff0000u) + __uint_as_float(y1.x & 0xffff0000u);
                ys[2] = __uint_as_float(y0.y << 16) + __uint_as_float(y1.y << 16); ys[3] = __uint_as_float(y0.y & 0xffff0000u) + __uint_as_float(y1.y & 0xffff0000u);
                v[j] = v[j] + g * ys; *(f32x4*)(hout + c) = v[j]; }
        }
        if (L == DEPTH) continue;
        float ss = 0.f;
#pragma unroll
        for (int j = 0; j < 4; ++j) ss += (v[j][0] * v[j][0] + v[j][1] * v[j][1]) + (v[j][2] * v[j][2] + v[j][3] * v[j][3]);
        const float rstd = rsqrtf(wsum(ss) * (1.f / DM) + EPS);
        const float* md = F.modv() + ((size_t)L * 9 + bb) * 6144;
#pragma unroll
        for (int j = 0; j < 4; ++j) { const int c = 4 * F.lane + 256 * j; const f32x4 g = *(const f32x4*)(F.g_mix() + L * DM + c), sh = *(const f32x4*)(md + c), scl = *(const f32x4*)(md + 1024 + c);
            const f32x4 a = v[j] * rstd * g * (scl + 1.f) + sh; u32x2 o; o.x = pk2(a[0], a[1]); o.y = pk2(a[2], a[3]); *(u32x2*)(F.abuf() + (size_t)r * DM + c) = o; }
    }
}

__device__ __forceinline__ void prep_row(const Fr& F, int L, int r, LAS float* scr) {
    const int lane = F.lane; int b, s; row2bs(r, b, s); const bool lat = r < NLAT; const int t = s - 256;
    const bf16* p = F.pbuf() + (size_t)r * NP;
#pragma unroll
    for (int h = 0; h < 4; ++h) {
        const float q = bf2f(p[C_NA + h * 64 + lane]), k = bf2f(p[C_NA + 256 + h * 64 + lane]);
        const float rq = rsqrtf(wsum(q * q) * (1.f / 64) + EPS), rk = rsqrtf(wsum(k * k) * (1.f / 64) + EPS);
        const size_t o = ((size_t)(b * 4 + h) * SQ + s) * 64 + lane;
        F.qna()[o] = f2bf(q * rq * F.na_gq()[L * 64 + lane]); F.kna()[o] = f2bf(k * rk * F.na_gk()[L * 64 + lane]);
        F.vna()[((size_t)(b * 4 + h) * 64 + lane) * SQ + vpos(s)] = p[C_NA + 512 + h * 64 + lane];
    }
    {
        float c[4], d[2]; float ss = 0.f;
#pragma unroll
        for (int i = 0; i < 4; ++i) { c[i] = bf2f(p[C_MLA + lane + 64 * i]); ss += c[i] * c[i]; }
        const float r1 = rsqrtf(wsum(ss) * (1.f / 256) + EPS);
#pragma unroll
        for (int i = 0; i < 4; ++i) scr[lane + 64 * i] = c[i] * r1 * F.mla_gqa()[L * 256 + lane + 64 * i];
        ss = 0.f;
#pragma unroll
        for (int i = 0; i < 2; ++i) { d[i] = bf2f(p[C_MLA + 256 + lane + 64 * i]); ss += d[i] * d[i]; }
        const float r2 = rsqrtf(wsum(ss) * (1.f / 128) + EPS);
#pragma unroll
        for (int i = 0; i < 2; ++i) scr[256 + lane + 64 * i] = d[i] * r2 * F.mla_gkva()[L * 128 + lane + 64 * i];
        if (lane < 32) scr[1408 + lane] = bf2f(p[C_MLA + 384 + lane]);
        LDS_WAIT();
        float qa[6], ka[8];
#pragma unroll
        for (int i = 0; i < 6; ++i) qa[i] = 0.f;
#pragma unroll
        for (int i = 0; i < 8; ++i) ka[i] = 0.f;
        const float* wq = F.mla_wqb() + (size_t)L * 256 * 384 + lane;
        for (int k = 0; k < 256; ++k) { const float xv = scr[k];
#pragma unroll
            for (int i = 0; i < 6; ++i) qa[i] += xv * wq[k * 384 + 64 * i]; }
        const float* wk = F.mla_wkvb() + (size_t)L * 128 * 512 + lane;
        for (int k = 0; k < 128; ++k) { const float xv = scr[256 + k];
#pragma unroll
            for (int i = 0; i < 8; ++i) ka[i] += xv * wk[k * 512 + 64 * i]; }
#pragma unroll
        for (int i = 0; i < 6; ++i) scr[512 + lane + 64 * i] = qa[i];
#pragma unroll
        for (int i = 0; i < 8; ++i) scr[896 + lane + 64 * i] = ka[i];
        LDS_WAIT();
        float cs = 1.f, sn = 0.f;
        if (lat && lane < 32) { cs = F.rcos()[t * 16 + (lane & 15)]; sn = F.rsin()[t * 16 + (lane & 15)]; }
#pragma unroll
        for (int h = 0; h < 4; ++h) {
            const size_t o = ((size_t)(b * 4 + h) * SQ + s) * 96;
            {
                float x0 = scr[512 + h * 96 + lane], x1 = lane < 32 ? scr[512 + h * 96 + 64 + lane] : 0.f;
                const float rs = rsqrtf(wsum(x0 * x0 + x1 * x1) * (1.f / 96) + EPS);
                x0 *= rs * F.mla_gq()[L * 96 + lane]; if (lane < 32) x1 *= rs * F.mla_gq()[L * 96 + 64 + lane];
                const float xp = __shfl_xor(x1, 16);
                if (lat) x1 = (lane < 16) ? x1 * cs - xp * sn : xp * sn + x1 * cs;
                F.qml()[o + lane] = f2bf(x0); if (lane < 32) F.qml()[o + 64 + lane] = f2bf(x1);
            }
            {
                float x0 = scr[896 + h * 128 + lane], x1 = lane < 32 ? scr[1408 + lane] : 0.f;
                const float rs = rsqrtf(wsum(x0 * x0 + x1 * x1) * (1.f / 96) + EPS);
                x0 *= rs * F.mla_gk()[L * 96 + lane]; if (lane < 32) x1 *= rs * F.mla_gk()[L * 96 + 64 + lane];
                const float xp = __shfl_xor(x1, 16);
                if (lat) x1 = (lane < 16) ? x1 * cs - xp * sn : xp * sn + x1 * cs;
                F.kml()[o + lane] = f2bf(x0); if (lane < 32) F.kml()[o + 64 + lane] = f2bf(x1);
            }
            F.vml()[((size_t)(b * 4 + h) * 64 + lane) * SQ + vpos(s)] = f2bf(scr[896 + h * 128 + 64 + lane]);
        }
        LDS_WAIT();
    }
    {
        const int idx = lane & 31; float cs = 1.f, sn = 0.f;
        if (lat) { cs = F.rcos()[t * 16 + (idx & 15)]; sn = F.rsin()[t * 16 + (idx & 15)]; }
#pragma unroll
        for (int h = 0; h < 4; ++h) {
            float q = bf2f(p[C_DF + h * 64 + lane]), k = bf2f(p[C_DF + 256 + h * 64 + lane]);
            float sq = q * q, sk = k * k;
#pragma unroll
            for (int o = 16; o >= 1; o >>= 1) { sq += __shfl_xor(sq, o); sk += __shfl_xor(sk, o); }
            q *= rsqrtf(sq * (1.f / 32) + EPS) * F.df_gq()[L * 32 + idx]; k *= rsqrtf(sk * (1.f / 32) + EPS) * F.df_gk()[L * 32 + idx];
            const float qp = __shfl_xor(q, 16), kp = __shfl_xor(k, 16);
            if (lat) { q = (idx < 16) ? q * cs - qp * sn : qp * sn + q * cs; k = (idx < 16) ? k * cs - kp * sn : kp * sn + k * cs; }
            const size_t o = ((size_t)(b * 4 + h) * SQ + s) * 64 + lane;
            F.qdf()[o] = f2bf(q); F.kdf()[o] = f2bf(k);
            F.vdf()[((size_t)(b * 4 + h) * 64 + lane) * SQ + vpos(s)] = p[C_DF + 512 + h * 64 + lane];
        }
    }
    {
        const int tt = lat ? t : s, len = lat ? TLAT : TCTX;
#pragma unroll
        for (int i = 0; i < 12; ++i) { const int c = lane + 64 * i; float acc = F.conv_b()[L * 768 + c];
#pragma unroll
            for (int j = 0; j < 5; ++j) { const int tj = tt + j - 2; if (tj >= 0 && tj < len) acc += F.conv_w()[(L * 5 + j) * 768 + c] * bf2f(F.pbuf()[(size_t)(r + j - 2) * NP + C_XBC + c]); }
            const bf16 v = f2bf(siluf(acc));
            if (i < 4) F.xT()[((size_t)b * 256 + c) * SQ + s] = v;
            else if (i < 8) { F.btm()[((size_t)b * SQ + s) * 256 + c - 256] = v; F.bT()[((size_t)b * 256 + c - 256) * SQ + s] = v; }
            else F.ctm()[((size_t)b * SQ + s) * 256 + c - 512] = v; }
        if (lane < 8) { const float raw = bf2f(p[C_DT + lane]) + F.dt_bias()[L * 8 + lane]; const float ex = __expf(raw); F.dtv()[((size_t)b * 8 + lane) * SQ + s] = raw > 20.f ? raw : (ex < 0.03f ? ex * (1.f - ex * (0.5f - ex * (0.33333334f - 0.25f * ex))) : __logf(1.f + ex)); }
    }
}
__device__ __forceinline__ void phase_prep(const Fr& F, int L) {
    LAS float* scr = (LAS float*)(F.lds + F.wave * 16384);
    for (int r = F.gw; r < NROW; r += F.NGW) prep_row(F, L, r, scr);
}

__device__ __forceinline__ void phase_ssd_naive(const Fr& F, int L) {
    if (F.wave != 0 || blockIdx.x >= 64) return;
    const int w = blockIdx.x, b = w >> 3, d = (w >> 2) & 1, h = w & 3, g = h >> 1, p = F.lane;
    const float a = -expf(F.a_log()[L * 8 + d * 4 + h]);
    float hs[128];
#pragma unroll
    for (int n = 0; n < 128; ++n) hs[n] = 0.f;
    const float* dtp = F.dtv() + ((size_t)b * 8 + d * 4 + h) * SQ;
    const bf16* xp = F.xT() + ((size_t)b * 256 + h * 64 + p) * SQ;
    for (int step = 0; step < SQ; ++step) {
        const int s = d == 0 ? step : (step < 256 ? 255 - step : SQ - 1 - (step - 256));
        const float dtv = dtp[s], dA = __expf(dtv * a), xv = bf2f(xp[s]) * dtv;
        const u32x4* Bp = (const u32x4*)(F.btm() + ((size_t)b * SQ + s) * 256 + g * 128);
        const u32x4* Cp = (const u32x4*)(F.ctm() + ((size_t)b * SQ + s) * 256 + g * 128);
        float y = 0.f;
#pragma unroll
        for (int n8 = 0; n8 < 16; ++n8) { const u32x4 bv = Bp[n8], cv = Cp[n8];
#pragma unroll
            for (int j = 0; j < 4; ++j) { const int n = n8 * 8 + 2 * j;
                hs[n] = hs[n] * dA + xv * __uint_as_float(bv[j] << 16); hs[n + 1] = hs[n + 1] * dA + xv * __uint_as_float(bv[j] & 0xffff0000u);
                y += __uint_as_float(cv[j] << 16) * hs[n] + __uint_as_float(cv[j] & 0xffff0000u) * hs[n + 1]; } }
        F.ydir()[((size_t)d * NROW + bs2row(b, s)) * 256 + h * 64 + p] = y;
    }
}

template <int KIND>
__device__ __forceinline__ void naive_attn_job(const Fr& F, int L, int r, int h, LAS float* scr) {
    constexpr int DQ = KIND == 1 ? 96 : (KIND == 0 ? 64 : 32), QS = KIND == 1 ? 96 : 64;
    const int lane = F.lane; int b, s; row2bs(r, b, s); const bool lat = r < NLAT; const int t = s - 256;
    const bf16* Qb = (KIND == 0 ? F.qna() : KIND == 1 ? F.qml() : F.qdf()) + ((size_t)(b * 4 + h) * SQ + s) * QS;
    const bf16* Kb = (KIND == 0 ? F.kna() : KIND == 1 ? F.kml() : F.kdf()) + (size_t)(b * 4 + h) * SQ * QS;
    const bf16* Vt = (KIND == 0 ? F.vna() : KIND == 1 ? F.vml() : F.vdf()) + ((size_t)(b * 4 + h) * 64 + lane) * SQ;
    const float scale = KIND == 1 ? 0.10206207261596577f : (KIND == 0 ? 0.125f : 0.17677669529663687f);
    const int qr = t >> 6, qc = t & 63, row_lo = min(max(qr - 4, 0), 24), col_lo = min(max(qc - 8, 0), 48);
    const bool nb = (KIND == 0) && lat;
    const int nk = lat ? (KIND == 0 ? 768 : SQ) : 256;
    const int koff = nb ? row_lo * 64 : 0;
    float oc[2] = {0.f, 0.f};
#pragma unroll
    for (int comp = 0; comp < (KIND == 2 ? 2 : 1); ++comp) {
        for (int i = lane; i < DQ; i += 64) scr[i] = bf2f(Qb[comp * 32 + i]);
        LDS_WAIT();
        float m = -INFINITY;
        for (int kk = lane; kk < nk; kk += 64) {
            const int sk = kk < 256 ? kk : kk + koff; float bias = 0.f; bool valid = true;
            if (nb && kk >= 256) { const int w = kk - 256, kr = w >> 6, kc = w & 63; valid = kc >= col_lo && kc < col_lo + 16;
                const int ro = row_lo + kr - qr + 7, co = min(max(kc - qc, -15), 15) + 15; bias = F.na_rb()[((L * 4 + h) * 15 + ro) * 31 + co]; }
            const u32x4* kp = (const u32x4*)(Kb + (size_t)sk * QS + (KIND == 2 ? comp * 32 : 0));
            float dot = 0.f;
#pragma unroll
            for (int i8 = 0; i8 < DQ / 8; ++i8) { const u32x4 kv = kp[i8];
#pragma unroll
                for (int j = 0; j < 4; ++j) dot += scr[i8 * 8 + 2 * j] * __uint_as_float(kv[j] << 16) + scr[i8 * 8 + 2 * j + 1] * __uint_as_float(kv[j] & 0xffff0000u); }
            const float sc = valid ? dot * scale + bias : -INFINITY;
            scr[128 + kk] = sc; m = fmaxf(m, sc);
        }
        m = wmaxf(m);
        float sum = 0.f;
        for (int kk = lane; kk < nk; kk += 64) { const float pv = __expf(scr[128 + kk] - m); scr[128 + kk] = pv; sum += pv; }
        sum = wsum(sum);
        LDS_WAIT();
        float o = 0.f;
        for (int kb = 0; kb < nk; kb += 8) {
            const int sb = kb < 256 ? kb : kb + koff;
            const u32x4 vv = *(const u32x4*)(Vt + sb);
#pragma unroll
            for (int j = 0; j < 8; ++j) { const int kk = (kb & ~15) + vpos((kb & 15) + j); const unsigned wv = vv[j >> 1];
                o += scr[128 + kk] * ((j & 1) ? __uint_as_float(wv & 0xffff0000u) : __uint_as_float(wv << 16)); }
        }
        oc[comp] = o / sum;
        LDS_WAIT();
    }
    bf16* mo = F.mix() + (size_t)r * DM + (KIND == 0 ? 0 : KIND == 1 ? 256 : 512) + h * 64 + lane;
    if (KIND == 2) {
        const float* lv = F.df_lam() + L * 128; const float li = 0.8f - 0.6f * expf(-0.3f * (float)L);
        float d1 = 0.f, d2 = 0.f;
#pragma unroll
        for (int i = 0; i < 32; ++i) { d1 += lv[i] * lv[32 + i]; d2 += lv[64 + i] * lv[96 + i]; }
        const float lam = expf(d1) - expf(d2) + li;
        const float o = oc[0] - lam * oc[1];
        const float rs = rsqrtf(wsum(o * o) * (1.f / 64) + EPS);
        *mo = f2bf(o * rs * F.df_gsub()[L * 64 + lane] * (1.f - li));
    } else *mo = f2bf(oc[0]);
}
__device__ __forceinline__ void phase_mix_naive(const Fr& F, int L) {
    LAS float* scr = (LAS float*)(F.lds + F.wave * 16384);
    const int nrows = (L == DEPTH - 1) ? NLAT : NROW;
    for (int j = F.gw; j < nrows * 4; j += F.NGW) naive_attn_job<2>(F, L, j >> 2, j & 3, scr);
    for (int j = F.gw; j < nrows * 4; j += F.NGW) naive_attn_job<1>(F, L, j >> 2, j & 3, scr);
    for (int j = F.gw; j < nrows * 4; j += F.NGW) naive_attn_job<0>(F, L, j >> 2, j & 3, scr);
    for (int r = F.gw; r < nrows; r += F.NGW) {
        int b, s; row2bs(r, b, s); const int h = F.lane >> 4; const float dsk = F.ssd_d()[L * 8 + h] + F.ssd_d()[L * 8 + 4 + h];
        float y[4]; float ss = 0.f;
#pragma unroll
        for (int j = 0; j < 4; ++j) { const int ch = F.lane * 4 + j; const float xv = bf2f(F.xT()[((size_t)b * 256 + ch) * SQ + s]);
            const float z = bf2f(F.pbuf()[(size_t)r * NP + C_Z + ch]);
            y[j] = (F.ydir()[(size_t)r * 256 + ch] + F.ydir()[((size_t)NROW + r) * 256 + ch] + dsk * xv) * siluf(z); ss += y[j] * y[j]; }
        const float rs = rsqrtf(wsum(ss) * (1.f / 256) + EPS);
#pragma unroll
        for (int j = 0; j < 4; ++j) { const int ch = F.lane * 4 + j; F.mix()[(size_t)r * DM + 768 + ch] = f2bf(y[j] * rs * F.ssd_gn()[L * 256 + ch]); }
    }
}

__device__ __forceinline__ void phase_route(const Fr& F, int L) {
    const int nrows = (L == DEPTH - 1) ? NLAT : NROW;
    for (int r = F.gw; r < nrows; r += F.NGW) {
        const bool lat = r < NLAT; const int bb = lat ? (r >> 11) : 8;
        const float* hp = lat ? F.out() + (size_t)r * DM : F.hc() + (size_t)(r - NLAT) * DM;
        f32x4 v[4]; float ss = 0.f;
#pragma unroll
        for (int j = 0; j < 4; ++j) { v[j] = *(const f32x4*)(hp + 4 * F.lane + 256 * j); ss += (v[j][0] * v[j][0] + v[j][1] * v[j][1]) + (v[j][2] * v[j][2] + v[j][3] * v[j][3]); }
        const float rstd = rsqrtf(wsum(ss) * (1.f / DM) + EPS);
        const float* md = F.modv() + ((size_t)L * 9 + bb) * 6144;
        float lg[20];
#pragma unroll
        for (int o = 0; o < 20; ++o) lg[o] = 0.f;
#pragma unroll
        for (int j = 0; j < 4; ++j) { const int c = 4 * F.lane + 256 * j; const f32x4 g = *(const f32x4*)(F.g_ffn() + L * DM + c), sh = *(const f32x4*)(md + 3 * 1024 + c), scl = *(const f32x4*)(md + 4 * 1024 + c);
            const f32x4 f = v[j] * rstd * g * (scl + 1.f) + sh; u32x2 o2; o2.x = pk2(f[0], f[1]); o2.y = pk2(f[2], f[3]); *(u32x2*)(F.abuf() + (size_t)r * DM + c) = o2;
#pragma unroll
            for (int e = 0; e < 4; ++e) { const int k = c + e; const f32x4 wg = *(const f32x4*)(F.w_grp() + ((size_t)L * DM + k) * 4);
#pragma unroll
                for (int o = 0; o < 4; ++o) lg[o] += f[e] * wg[o];
#pragma unroll
                for (int q = 0; q < 4; ++q) { const f32x4 we = *(const f32x4*)(F.w_exp() + ((size_t)L * DM + k) * 16 + 4 * q);
#pragma unroll
                    for (int o = 0; o < 4; ++o) lg[4 + 4 * q + o] += f[e] * we[o]; } } }
#pragma unroll
        for (int o = 0; o < 20; ++o) lg[o] = wsum(lg[o]);
        if (F.lane == 0) {
            float gl[4]; float gm = -INFINITY; int gt = 0;
#pragma unroll
            for (int o = 0; o < 4; ++o) { gl[o] = lg[o] + F.b_grp()[L * 4 + o]; if (gl[o] > gm) { gm = gl[o]; gt = o; } }
            float gs = 0.f;
#pragma unroll
            for (int o = 0; o < 4; ++o) gs += expf(gl[o] - gm);
            const float gp = 1.f / gs;
            float el[4];
#pragma unroll
            for (int o = 0; o < 4; ++o) { float v4 = 0.f;
#pragma unroll
                for (int q = 0; q < 4; ++q) v4 = (gt == q) ? lg[4 + 4 * q + o] + F.b_exp()[L * 16 + 4 * q + o] : v4;
                el[o] = v4; }
            int i0 = 0; float m0 = el[0];
#pragma unroll
            for (int o = 1; o < 4; ++o) if (el[o] > m0) { m0 = el[o]; i0 = o; }
            int i1 = -1; float m1 = -INFINITY;
#pragma unroll
            for (int o = 0; o < 4; ++o) if (o != i0 && el[o] > m1) { m1 = el[o]; i1 = o; }
            const float e1 = expf(m1 - m0), w0 = gp / (1.f + e1), w1 = gp * e1 / (1.f + e1);
            const int x0 = gt * 4 + i0, x1 = gt * 4 + i1;
            F.rtw()[2 * r] = w0; F.rtw()[2 * r + 1] = w1;
            const unsigned p0 = atomicAdd(F.ctl() + CW_ECNT + (L * 16 + x0) * 64, 1u), p1 = atomicAdd(F.ctl() + CW_ECNT + (L * 16 + x1) * 64, 1u);
            F.elist()[x0 * NROW + p0] = 2 * r; F.elist()[x1 * NROW + p1] = 2 * r + 1;
        }
    }
}
__device__ __forceinline__ void moe_table(const Fr& F, int L) {
    volatile LAS int* T = (volatile LAS int*)(F.lds + LDSCTL_OFF + 64);
    volatile LAS int* Cn = (volatile LAS int*)(F.lds + LDSCTL_OFF + 160);
    __syncthreads();
    if (F.tid == 0) { int acc = 0;
        for (int e = 0; e < 16; ++e) { const int c = (int)__hip_atomic_load(F.ctl() + CW_ECNT + (L * 16 + e) * 64, __ATOMIC_RELAXED, __HIP_MEMORY_SCOPE_AGENT); T[e] = acc; Cn[e] = c; acc += (c + 255) >> 8; }
        T[16] = acc; }
    __syncthreads();
}

__global__ void __launch_bounds__(512, 2) fwd_kernel(Args args) {
    extern __shared__ __attribute__((aligned(16))) unsigned char lds_raw[];
    Fr F0;
    F0.lds = (LAS unsigned char*)lds_raw; F0.tid = threadIdx.x; F0.lane = F0.tid & 63; F0.wave = __builtin_amdgcn_readfirstlane(F0.tid >> 6);
    F0.G = gridDim.x; { const int bx = blockIdx.x; F0.vcu = (F0.G % 8 == 0) ? (bx % 8) * (F0.G / 8) + bx / 8 : bx; }
    F0.gw = F0.vcu * 8 + F0.wave; F0.NGW = F0.G * 8;
    F0.A = (const __attribute__((address_space(4))) Args*)__builtin_amdgcn_kernarg_segment_ptr();
    for (int u = F0.tid; u < (LDS_BYTES - LDSCTL_OFF) / 4; u += 512) ((LAS unsigned*)(F0.lds + LDSCTL_OFF))[u] = 0u;
    __syncthreads();
    const int lo = args.ph_lo, hi = args.ph_hi;
    XcdBarrier bar; bar.bar = F0.ctl() + CW_BAR; bar.x = 0; bar.st = nullptr;
    if (hi - lo > 1) bar = xcd_barrier_post(F0.ctl() + CW_BAR, (volatile LAS unsigned*)(F0.lds + LDSCTL_OFF));
#ifndef PH_MASK
#define PH_MASK 0xFFFF
#endif
#define PM(b) ((PH_MASK >> (b)) & 1)
#define IN(k) (lo <= (k) && (k) < hi)
#define SEAM(k) do { if (IN(k) && IN((k) + 1)) { const Fr Fb = refresh(F0); XcdBarrier b2 = bar; b2.bar = Fb.ctl() + CW_BAR; xcd_barrier(b2); } } while (0)

    if (PM(0) && IN(0)) { const Fr F = refresh(F0); phase_prologue(F); }
    SEAM(0);
    for (int L = 0; L < DEPTH; ++L) {
        const int pb = 1 + NPH_L * L;
        const bool lastL = (L == DEPTH - 1);
        if (PM(1) && IN(pb + 0)) { const Fr F = refresh(F0); phase_norm(F, L); moe_weight_convert(F, L); }
        SEAM(pb + 0);
        if (PM(2) && IN(pb + 1)) { const Fr F = refresh(F0); pg8::DenseSched S; S.init(F.abuf(), F.winT() + (size_t)L * NP * DM, DM, NROW, NP, F.G, (int)blockIdx.x); pg8::EpiP E{F.pbuf()}; pg8::gemm_phase(F.lds, F.tid, DM, S, E); }
        SEAM(pb + 1);
        if (PM(3) && IN(pb + 2)) { const Fr F = refresh(F0); phase_prep(F, L); }
        SEAM(pb + 2);
        if (PM(4) && IN(pb + 3)) { const Fr F = refresh(F0); phase_ssd_naive(F, L); }
        SEAM(pb + 3);
        if (PM(5) && IN(pb + 4)) { const Fr F = refresh(F0); phase_mix_naive(F, L); }
        SEAM(pb + 4);
        if (PM(6) && IN(pb + 5)) { const Fr F = refresh(F0); pg8::DenseSched S; S.init(F.mix(), F.woutT() + (size_t)L * DM * DM, DM, lastL ? NLAT : NROW, DM, F.G, (int)blockIdx.x);
            pg8::EpiRes E{L == 0 ? F.x() : F.out(), L == 0 ? F.ctx() : F.hc(), F.out(), F.hc(), F.modv() + (size_t)L * 9 * 6144 + 2 * 1024}; pg8::gemm_phase(F.lds, F.tid, DM, S, E); }
        SEAM(pb + 5);
        if (PM(7) && IN(pb + 6)) { const Fr F = refresh(F0); phase_route(F, L); }
        SEAM(pb + 6);
        if (PM(8) && IN(pb + 7)) { const Fr F = refresh(F0); moe_table(F, L);
            pg8::MoeSched<true> S{(const char*)F.abuf(), (const char*)F.wgu(), (size_t)1024 * DM * 2, DM, F.G, F.vcu, F.elist(), (const volatile LAS int*)(F.lds + LDSCTL_OFF + 64), (const volatile LAS int*)(F.lds + LDSCTL_OFF + 160)};
            pg8::EpiAct E{F.act()}; pg8::gemm_phase(F.lds, F.tid, DM, S, E); }
        SEAM(pb + 7);
        if (PM(9) && IN(pb + 8)) { const Fr F = refresh(F0); moe_table(F, L);
            pg8::MoeSched<false> S{(const char*)F.act(), (const char*)F.wd(), (size_t)1024 * FF * 2, FF, F.G, F.vcu, F.elist(), (const volatile LAS int*)(F.lds + LDSCTL_OFF + 64), (const volatile LAS int*)(F.lds + LDSCTL_OFF + 160)};
            pg8::EpiDown E{F.yk(), F.elist(), F.rtw()}; pg8::gemm_phase(F.lds, F.tid, FF, S, E); }
        SEAM(pb + 8);
    }
    if (PM(1) && IN(PH_FINAL)) { const Fr F = refresh(F0); phase_norm(F, DEPTH); }
#undef IN
#undef SEAM
}

extern "C" void kernel_launch(void* const* d_in, const int* in_sizes, int n_in, void* d_out, int out_size, void* d_ws, size_t ws_size, hipStream_t stream) {
    static int grid = 0;
    if (grid == 0) {
        if (n_in != 36 || out_size != NLAT * DM || ws_size < WS_END) { fprintf(stderr, "kernel_launch: unexpected shapes (n_in %d out %d ws %zu)\n", n_in, out_size, ws_size); grid = -1; return; }
        int dev = 0, cus = 0, per_cu = 0;
        if (hipGetDevice(&dev) != hipSuccess || hipDeviceGetAttribute(&cus, hipDeviceAttributeMultiprocessorCount, dev) != hipSuccess) { grid = -1; return; }
        if (hipFuncSetAttribute((const void*)fwd_kernel, hipFuncAttributeMaxDynamicSharedMemorySize, LDS_BYTES) != hipSuccess) { fprintf(stderr, "kernel_launch: hipFuncSetAttribute failed\n"); grid = -1; return; }
        if (hipOccupancyMaxActiveBlocksPerMultiprocessor(&per_cu, (const void*)fwd_kernel, 512, LDS_BYTES) != hipSuccess || per_cu < 1) { fprintf(stderr, "kernel_launch: occupancy query says %d\n", per_cu); }
        (void)hipGetLastError();
        grid = cus;
    }
    if (grid < 0) return;
    (void)hipMemsetAsync((char*)d_ws + WS_CTL, 0, CTL_BYTES, stream);
    Args a{};
    for (int i = 0; i < 36; ++i) a.in[i] = (const float*)d_in[i];
    a.out = (float*)d_out; a.ws = (unsigned char*)d_ws;
#if MK_ONE_LAUNCH
    a.ph_lo = 0; a.ph_hi = NPHASE;
    hipLaunchKernelGGL(fwd_kernel, dim3(grid), dim3(512), LDS_BYTES, stream, a);
#else
    for (int ph = 0; ph < NPHASE; ++ph) { a.ph_lo = ph; a.ph_hi = ph + 1; hipLaunchKernelGGL(fwd_kernel, dim3(grid), dim3(512), LDS_BYTES, stream, a); }
#endif
}
```

```cpp
#include <hip/hip_runtime.h>
#include <cstdio>
#include <cstdint>

#ifndef MK_ONE_LAUNCH
#define MK_ONE_LAUNCH 1
#endif

#define LAS __attribute__((address_space(3)))
typedef unsigned short bf16;
typedef short bf16x8 __attribute__((ext_vector_type(8)));
typedef float f32x4 __attribute__((ext_vector_type(4)));
typedef float f32x2 __attribute__((ext_vector_type(2)));
typedef unsigned u32x4 __attribute__((ext_vector_type(4)));
typedef unsigned u32x2 __attribute__((ext_vector_type(2)));

constexpr int NB = 8, TLAT = 2048, TCTX = 256, SQ = 2304, DM = 1024, DEPTH = 4;
constexpr int NLAT = NB * TLAT, NCTXR = NB * TCTX, NROW = NLAT + NCTXR;
constexpr int NIN = 2984, NP = 3072;
constexpr int C_NA = 0, C_MLA = 768, C_DF = 1184, C_SSD = 1952;
constexpr int C_Z = C_SSD, C_XBC = C_SSD + 256, C_DT = C_SSD + 1024;
constexpr float EPS = 1e-6f;
constexpr int NEXP = 16, FF = 512, ACT_ROWS = 40960;
constexpr int NPH_L = 10, PH_FINAL = 1 + NPH_L * DEPTH, NPHASE = PH_FINAL + 1;

constexpr size_t MiB = 1u << 20;
constexpr size_t WS_CTL = 0, CTL_BYTES = 1 * MiB;
constexpr size_t WS_MOD = 1 * MiB;
constexpr size_t WS_ROPE = 2 * MiB;
constexpr size_t WS_WIN = 4 * MiB;
constexpr size_t WS_WOUT = 28 * MiB;
constexpr size_t WS_WQB = 36 * MiB;
constexpr size_t WS_WKVB = 37 * MiB;
constexpr size_t WS_WGU = 38 * MiB;
constexpr size_t WS_WD = 70 * MiB;
constexpr size_t WS_HC = 86 * MiB;
constexpr size_t WS_A = 94 * MiB;
constexpr size_t WS_P = 130 * MiB;
constexpr size_t WS_ACT = 130 * MiB;
constexpr size_t WS_YK = 170 * MiB;
constexpr size_t WS_MIX = 238 * MiB;
constexpr size_t WS_QNA = 274 * MiB, WS_KNA = 283 * MiB, WS_VNA = 292 * MiB;
constexpr size_t WS_QML = 301 * MiB, WS_KML = 315 * MiB, WS_VML = 329 * MiB;
constexpr size_t WS_QDF = 338 * MiB, WS_KDF = 347 * MiB, WS_VDF = 356 * MiB;
constexpr size_t WS_XT = 365 * MiB, WS_BTM = 374 * MiB, WS_BT = 383 * MiB, WS_CTM = 392 * MiB;
constexpr size_t WS_DT = 401 * MiB;
constexpr size_t WS_CST = 402 * MiB;
constexpr size_t WS_CDEC = 474 * MiB;
constexpr size_t WS_HENT = 475 * MiB;
constexpr size_t WS_RT = 511 * MiB;
constexpr size_t WS_ELIST = 512 * MiB;
constexpr size_t WS_END = 514 * MiB;
constexpr int CW_BAR = 4096;
constexpr int CW_ECNT = 16384;

constexpr int RING_BYTES = 131072, LDSCTL_OFF = RING_BYTES, LDS_BYTES = 147456;

typedef float f32x16 __attribute__((ext_vector_type(16)));
#define MFMA32(a, b, c) __builtin_amdgcn_mfma_f32_32x32x16_bf16((a), (b), (c), 0, 0, 0)
__device__ __forceinline__ int crow16(int reg, int hh) { return (reg & 3) + 8 * (reg >> 2) + 4 * hh; }
__device__ __forceinline__ float bf2f(bf16 v) { return __uint_as_float(((unsigned)v) << 16); }
__device__ __forceinline__ bf16 f2bf(float f) { unsigned u = __float_as_uint(f); return (bf16)((u + 0x7fffu + ((u >> 16) & 1u)) >> 16); }
__device__ __forceinline__ unsigned pk2(float lo, float hi) { return (unsigned)f2bf(lo) | ((unsigned)f2bf(hi) << 16); }
__device__ __forceinline__ float wsum(float v) {
#pragma unroll
    for (int o = 32; o >= 1; o >>= 1) v += __shfl_xor(v, o);
    return v; }
__device__ __forceinline__ float wmaxf(float v) {
#pragma unroll
    for (int o = 32; o >= 1; o >>= 1) v = fmaxf(v, __shfl_xor(v, o));
    return v; }
#define LDS_WAIT() asm volatile("s_waitcnt lgkmcnt(0)" ::: "memory")
__device__ __forceinline__ void row2bs(int r, int& b, int& s) { if (r < NLAT) { b = r >> 11; s = 256 + (r & 2047); } else { const int j = r - NLAT; b = j >> 8; s = j & 255; } }
__device__ __forceinline__ int bs2row(int b, int s) { return s < 256 ? NLAT + b * 256 + s : b * 2048 + s - 256; }
__device__ __forceinline__ int vpos(int s) { return (s & ~12) | ((s & 4) << 1) | ((s & 8) >> 1); }
__device__ __forceinline__ float siluf(float x) { return x / (1.f + __expf(-x)); }

#define XB_TMO      128
#define XB_XCNT(j)  (256  + 64 * (j))
#define XB_XSUB(j)  (1280 + 64 * (j))
#define XB_XGEN(j)  (2304 + 64 * (j))
#define XB_TOP      3328
#define XB_TOPGEN   3392
#define XCD_BAR_WORDS 3456
#define XB_SPIN_CAP (1u << 24)
__device__ __forceinline__ unsigned xb_ld(unsigned* p)              { return __hip_atomic_load(p, __ATOMIC_RELAXED, __HIP_MEMORY_SCOPE_AGENT); }
__device__ __forceinline__ unsigned xb_add(unsigned* p, unsigned v) { return __hip_atomic_fetch_add(p, v, __ATOMIC_RELAXED, __HIP_MEMORY_SCOPE_AGENT); }
__device__ __forceinline__ unsigned xb_xcc_id() { return (unsigned)__builtin_amdgcn_s_getreg((3 << 11) | 20) & 0xFu; }
#define XB_SPIN(cond, bar) do { unsigned _sp = 0; while (cond) { __builtin_amdgcn_s_sleep(1); \
    if ((++_sp & 255u) == 0u) { if (xb_ld(&(bar)[XB_TMO])) break; if (_sp > XB_SPIN_CAP) { atomicAdd(&(bar)[XB_TMO], 1u); break; } } } } while (0)
struct XcdBarrier { unsigned* bar; unsigned x; volatile LAS unsigned* st; };
__device__ __forceinline__ XcdBarrier xcd_barrier_post(unsigned* bar, volatile LAS unsigned* st) {
    XcdBarrier b; b.bar = bar; b.x = xb_xcc_id(); b.st = st;
    if (threadIdx.x == 0) (void)xb_add(&bar[XB_XCNT(b.x)], 1u);
    return b;
}
__device__ __forceinline__ void xcd_barrier_complete(unsigned* bar, unsigned x, unsigned& nloc, unsigned& nx) {
    const unsigned G = gridDim.x * gridDim.y * gridDim.z;
    unsigned sum, cnt, mine, sp = 0u;
    for (;;) {
        sum = 0u; cnt = 0u; mine = 0u;
#pragma unroll
        for (unsigned j = 0; j < 16; ++j) { const unsigned c = xb_ld(&bar[XB_XCNT(j)]); sum += c; cnt += (c > 0u) ? 1u : 0u; mine = (j == x) ? c : mine; }
        if (sum == G) break;
        __builtin_amdgcn_s_sleep(1);
        if ((++sp & 255u) == 0u) { if (xb_ld(&bar[XB_TMO])) break; if (sp > XB_SPIN_CAP) { atomicAdd(&bar[XB_TMO], 1u); break; } }
    }
    nloc = mine > 0u ? mine : 1u; nx = cnt > 0u ? cnt : 1u;
}
__device__ __forceinline__ void xcd_barrier(const XcdBarrier& b) {
    asm volatile("s_waitcnt vmcnt(0)" ::: "memory");
    __syncthreads();
    if (threadIdx.x == 0) {
        unsigned* bar = b.bar;
        __builtin_amdgcn_s_waitcnt(0);
        unsigned nloc = b.st[0], nx = b.st[1];
        if (nloc == 0u) { xcd_barrier_complete(bar, b.x, nloc, nx); b.st[0] = nloc; b.st[1] = nx; }
        const unsigned old = xb_add(&bar[XB_XSUB(b.x)], 1u);
        const unsigned gen = old / nloc;
        if (old + 1u == (gen + 1u) * nloc) {
            __builtin_amdgcn_fence(__ATOMIC_RELEASE, "agent");
            asm volatile("s_waitcnt vmcnt(0)" ::: "memory");
            const unsigned og = xb_add(&bar[XB_TOP], 1u);
            const unsigned tg = og / nx;
            if (og + 1u == (tg + 1u) * nx) xb_add(&bar[XB_TOPGEN], 1u);
            else XB_SPIN(xb_ld(&bar[XB_TOPGEN]) == tg, bar);
            __builtin_amdgcn_fence(__ATOMIC_ACQUIRE, "agent");
            xb_add(&bar[XB_XGEN(b.x)], 1u);
            asm volatile("s_waitcnt vmcnt(0)" ::: "memory");
        } else {
            XB_SPIN(xb_ld(&bar[XB_XGEN(b.x)]) == gen, bar);
            __builtin_amdgcn_fence(__ATOMIC_ACQUIRE, "agent");
            asm volatile("s_waitcnt vmcnt(0)" ::: "memory");
        }
    }
    __syncthreads();
}

namespace pg8 {
constexpr int BM = 256, BK = 64, HALF = 128, HTB = HALF * BK * 2, NXCD = 8, WGM = 8;
__device__ __forceinline__ int lds_byte(int r, int c) { const int st = (r >> 4) * 2 + (c >> 5), rr = r & 15, cc = c & 31, ob = rr * 64 + cc * 2; return st * 1024 + (ob ^ (((ob >> 9) & 1) << 5)); }
__device__ __forceinline__ void stage_rc(int b, int& R, int& C) { const int st = b / 1024, sb = b % 1024, swz = sb ^ (((sb >> 9) & 1) << 5); R = (st >> 1) * 16 + swz / 64; C = (st & 1) * 32 + (swz % 64) / 2; }
__device__ __forceinline__ int perm32(int rho) { const int n = rho >> 4, i = rho & 15; return 8 * (i >> 2) + 4 * n + (i & 3); }
struct Unit { int pm, pn, e, j, cnt; };

template <class Epi, class Sched>
__device__ __forceinline__ void gemm_phase(LAS unsigned char* lds, const int tid, const int K, const Sched& S, const Epi& E) {
    const int wid = __builtin_amdgcn_readfirstlane(tid >> 6), lane = tid & 63, wr = wid >> 2, wc = wid & 3, fr = lane & 15, fq = lane >> 4;
    const int nt = K / BK;
    int Rr[2]; unsigned Cb[2], voffB[2];
#pragma unroll
    for (int i = 0; i < 2; ++i) { int R, C; stage_rc(tid * 16 + i * 8192, R, C); const int Rb = Epi::PERM ? ((R & ~31) + perm32(R & 31)) : R;
        Rr[i] = R; Cb[i] = (unsigned)C * 2u; voffB[i] = (unsigned)(Rb * K + C) * 2u; }
    const size_t kstep = (size_t)(BK * 2);
    const size_t hstep = (size_t)HALF * K * 2;
    const unsigned ldsw = (unsigned)wid * 1024u;
    const int aoff = lds_byte(wr * 64 + fr, fq * 8), boff = lds_byte(wc * 32 + fr, fq * 8);
#define PG8_SA(b, h) (((b) * 2 + (h)) * HTB)
#define PG8_SB(b, h) ((4 + (b) * 2 + (h)) * HTB)
#define PG8_STAGE(bufoff, gbase, voff) do { _Pragma("unroll") for (int _i = 0; _i < 2; ++_i) \
        __builtin_amdgcn_global_load_lds((const unsigned*)((const char*)(gbase) + (voff)[_i]), (LAS unsigned*)(lds + (bufoff) + ldsw + _i * 8192), 16, 0, 0); } while (0)
#define PG8_LDA(dst, b, h) do { _Pragma("unroll") for (int m = 0; m < 4; ++m) _Pragma("unroll") for (int k = 0; k < 2; ++k) dst[m][k] = *(const LAS bf16x8*)(lds + PG8_SA(b, h) + aoff + m * 2048 + k * 1024); } while (0)
#define PG8_LDB(dst, b, h) do { _Pragma("unroll") for (int n = 0; n < 2; ++n) _Pragma("unroll") for (int k = 0; k < 2; ++k) dst[n][k] = *(const LAS bf16x8*)(lds + PG8_SB(b, h) + boff + n * 2048 + k * 1024); } while (0)
#define PG8_MMA(ai, bj, At, Bt) do { __builtin_amdgcn_s_setprio(1); _Pragma("unroll") for (int m = 0; m < 4; ++m) _Pragma("unroll") for (int n = 0; n < 2; ++n) _Pragma("unroll") for (int k = 0; k < 2; ++k) \
        acc[ai][bj][m][n] = __builtin_amdgcn_mfma_f32_16x16x32_bf16(Bt[n][k], At[m][k], acc[ai][bj][m][n], 0, 0, 0); __builtin_amdgcn_s_setprio(0); } while (0)
#define PG8_WAIT_V(n) asm volatile("s_waitcnt vmcnt(" #n ")" ::: "memory")
#define PG8_WAIT_L(n) asm volatile("s_waitcnt lgkmcnt(" #n ")" ::: "memory")
#define PG8_BAR __builtin_amdgcn_s_barrier()
#define PG8_SCHED __builtin_amdgcn_sched_barrier(0)
    Unit cur, nxt; int ui = 0;
    if (!S.next(0, cur)) return;
    f32x4 acc[2][2][4][2];
#pragma unroll
    for (int a = 0; a < 2; ++a)
#pragma unroll
        for (int b = 0; b < 2; ++b)
#pragma unroll
            for (int m = 0; m < 4; ++m)
#pragma unroll
                for (int n = 0; n < 2; ++n) acc[a][b][m][n] = (f32x4){0.f, 0.f, 0.f, 0.f};
    bf16x8 At[4][2], B0[2][2], B1[2][2];
    unsigned vA0[2], vA1[2];
    const char* cA = S.a_ptr(cur);
    if constexpr (Sched::GATHER) { S.a_offs(cur, Rr, vA0, vA1);
#pragma unroll
        for (int i = 0; i < 2; ++i) { vA0[i] += Cb[i]; vA1[i] += Cb[i]; }
        asm volatile("s_waitcnt vmcnt(0)" ::: "memory");
    } else {
#pragma unroll
        for (int i = 0; i < 2; ++i) { vA0[i] = (unsigned)(Rr[i] * K * 2) + Cb[i]; vA1[i] = vA0[i]; } }
    const size_t ahs = Sched::GATHER ? (size_t)0 : hstep;
    const char* cB = S.b_ptr(cur);
    PG8_STAGE(PG8_SB(0, 0), cB, voffB); PG8_STAGE(PG8_SB(0, 1), cB + hstep, voffB); PG8_STAGE(PG8_SA(0, 0), cA, vA0); PG8_STAGE(PG8_SA(0, 1), cA + ahs, vA1);
    if (wr == 1) PG8_BAR;
    PG8_WAIT_V(2); PG8_BAR;
    PG8_STAGE(PG8_SB(1, 0), cB + kstep, voffB); PG8_STAGE(PG8_SA(1, 0), cA + kstep, vA0); PG8_STAGE(PG8_SB(1, 1), cB + hstep + kstep, voffB);
    PG8_WAIT_V(6); PG8_BAR;
    for (;;) {
        const bool has_next = S.next(ui + 1, nxt);
        const char* nA = has_next ? S.a_ptr(nxt) : cA; const char* nB = has_next ? S.b_ptr(nxt) : cB;
        for (int t = 0; t < nt; t += 2) {
            const bool last = (t == nt - 2);
            const char* a1 = cA + (size_t)(t + 1) * kstep;
            const char* a2 = last ? nA : cA + (size_t)(t + 2) * kstep; const char* b2 = last ? nB : cB + (size_t)(t + 2) * kstep;
            const char* a3 = a2 + kstep; const char* b3 = b2 + kstep;
            PG8_LDB(B0, 0, 0); PG8_LDB(B1, 0, 1); PG8_SCHED; PG8_LDA(At, 0, 0); PG8_STAGE(PG8_SA(1, 1), a1 + ahs, vA1);
            if constexpr (Sched::GATHER) { if (last && has_next) { S.a_offs(nxt, Rr, vA0, vA1);
#pragma unroll
                for (int i = 0; i < 2; ++i) { vA0[i] += Cb[i]; vA1[i] += Cb[i]; }
                asm volatile("s_waitcnt vmcnt(0)" ::: "memory"); } }
            PG8_WAIT_V(8); PG8_WAIT_L(0); PG8_BAR; PG8_MMA(0, 0, At, B0); PG8_MMA(0, 1, At, B1); PG8_BAR; PG8_SCHED;
            PG8_LDA(At, 0, 1); PG8_STAGE(PG8_SB(0, 0), b2, voffB); PG8_STAGE(PG8_SB(0, 1), b2 + hstep, voffB); PG8_STAGE(PG8_SA(0, 0), a2, vA0);
            PG8_WAIT_V(8); PG8_WAIT_L(0); PG8_BAR; PG8_MMA(1, 0, At, B0); PG8_MMA(1, 1, At, B1); PG8_BAR; PG8_SCHED;
            PG8_LDB(B0, 1, 0); PG8_LDB(B1, 1, 1); PG8_SCHED; PG8_LDA(At, 1, 0); PG8_STAGE(PG8_SA(0, 1), a2 + ahs, vA1);
            PG8_WAIT_V(8); PG8_WAIT_L(0); PG8_BAR; PG8_MMA(0, 0, At, B0); PG8_MMA(0, 1, At, B1); PG8_BAR; PG8_SCHED;
            PG8_LDA(At, 1, 1); PG8_STAGE(PG8_SB(1, 0), b3, voffB); PG8_STAGE(PG8_SB(1, 1), b3 + hstep, voffB); PG8_STAGE(PG8_SA(1, 0), a3, vA0);
            PG8_WAIT_V(8); PG8_WAIT_L(0); PG8_BAR; PG8_MMA(1, 0, At, B0); PG8_MMA(1, 1, At, B1); PG8_BAR; PG8_SCHED;
        }
        if (wr == 0) PG8_BAR;
        E(acc, cur, wr, wc, fr, fq);
        if (!has_next) break;
#pragma unroll
        for (int a = 0; a < 2; ++a)
#pragma unroll
            for (int b = 0; b < 2; ++b)
#pragma unroll
                for (int m = 0; m < 4; ++m)
#pragma unroll
                    for (int n = 0; n < 2; ++n) acc[a][b][m][n] = (f32x4){0.f, 0.f, 0.f, 0.f};
        cur = nxt; cA = nA; cB = nB; ++ui;
        if (wr == 1) PG8_BAR;
    }
    PG8_WAIT_V(0);
    PG8_BAR;
#undef PG8_SA
#undef PG8_SB
#undef PG8_STAGE
#undef PG8_LDA
#undef PG8_LDB
#undef PG8_MMA
#undef PG8_WAIT_V
#undef PG8_WAIT_L
#undef PG8_BAR
#undef PG8_SCHED
}
__device__ __forceinline__ unsigned cvt_pk_bf16(float lo, float hi) { unsigned r; asm volatile("v_cvt_pk_bf16_f32 %0, %1, %2" : "=v"(r) : "v"(lo), "v"(hi)); return r; }

struct DenseSched {
    const char* A; const char* Bt; int K, nM, nN, nwg, G, c;
    __device__ void init(const void* A_, const void* Bt_, int K_, int M, int N, int G_, int c_) { A = (const char*)A_; Bt = (const char*)Bt_; K = K_; nM = M / BM; nN = N / BM; nwg = nM * nN; G = G_; c = c_; }
    __device__ __forceinline__ bool next(int i, Unit& u) const {
        const long L = (long)i * G + c; if (L >= nwg) return false;
        int wgid = (int)L; { const int q = nwg / NXCD, r = nwg % NXCD, xcd = wgid % NXCD, off = wgid / NXCD; wgid = (xcd < r ? xcd * (q + 1) : r * (q + 1) + (xcd - r) * q) + off; }
        const int nig = WGM * nN, gid = wgid / nig, fm = gid * WGM, gsz = (nM - fm) < WGM ? (nM - fm) : WGM;
        u.pm = fm + ((wgid % nig) % gsz); u.pn = (wgid % nig) / gsz; u.e = 0; u.j = 0; u.cnt = 256; return true;
    }
    static constexpr bool GATHER = false;
    __device__ __forceinline__ const char* a_ptr(const Unit& u) const { return A + (size_t)u.pm * BM * K * 2; }
    __device__ __forceinline__ void a_offs(const Unit&, const int (&)[2], unsigned (&)[2], unsigned (&)[2]) const {}
    __device__ __forceinline__ const char* b_ptr(const Unit& u) const { return Bt + (size_t)u.pn * BM * K * 2; }
};
template <bool GATHER_> struct MoeSched {
    static constexpr bool GATHER = GATHER_;
    const char* A; const char* W; size_t wstride; int K, G, c; const int* elist; const volatile LAS int* T; const volatile LAS int* Cn;
    __device__ __forceinline__ bool next(int i, Unit& u) const {
        const long L = (long)i * G + c; const int nT = T[16]; if (L >= 4L * nT) return false;
        const int tile = (int)(L >> 2); u.pn = (int)(L & 3); u.pm = tile;
        int e = 0;
#pragma unroll
        for (int k = 1; k < 16; ++k) e += (tile >= T[k]) ? 1 : 0;
        u.e = e; u.j = tile - T[e]; u.cnt = Cn[e]; return true;
    }
    __device__ __forceinline__ const char* a_ptr(const Unit& u) const { return GATHER ? A : A + (size_t)u.pm * BM * K * 2; }
    __device__ __forceinline__ void a_offs(const Unit& u, const int (&Rr)[2], unsigned (&v0)[2], unsigned (&v1)[2]) const {
#pragma unroll
        for (int i = 0; i < 2; ++i) {
            const int p0 = u.j * BM + Rr[i], p1 = p0 + HALF;
            const int t0 = p0 < u.cnt ? (elist[u.e * NROW + p0] >> 1) : 0, t1 = p1 < u.cnt ? (elist[u.e * NROW + p1] >> 1) : 0;
            v0[i] = (unsigned)(t0 * K * 2); v1[i] = (unsigned)(t1 * K * 2);
        } }
    __device__ __forceinline__ const char* b_ptr(const Unit& u) const { return W + (size_t)u.e * wstride + (size_t)u.pn * BM * K * 2; }
};
struct EpiP {
    static constexpr bool PERM = true;
    bf16* O;
    __device__ __forceinline__ void operator()(const f32x4 (&acc)[2][2][4][2], const Unit& u, int wr, int wc, int fr, int fq) const {
        const int row0 = u.pm * BM + wr * 64 + fr, col0 = u.pn * BM + wc * 32 + 8 * fq;
#pragma unroll
        for (int ai = 0; ai < 2; ++ai)
#pragma unroll
            for (int m = 0; m < 4; ++m) { bf16* rowp = O + (size_t)(row0 + ai * HALF + m * 16) * NP + col0;
#pragma unroll
                for (int bj = 0; bj < 2; ++bj) { const f32x4 v0 = acc[ai][bj][m][0], v1 = acc[ai][bj][m][1];
                    u32x4 w; w.x = cvt_pk_bf16(v0[0], v0[1]); w.y = cvt_pk_bf16(v0[2], v0[3]); w.z = cvt_pk_bf16(v1[0], v1[1]); w.w = cvt_pk_bf16(v1[2], v1[3]);
                    *(u32x4*)(rowp + bj * HALF) = w; } }
    }
};
struct EpiRes {
    static constexpr bool PERM = false;
    const float* hin_l; const float* hin_c; float* hout_l; float* hout_c; const float* gate;
    __device__ __forceinline__ void operator()(const f32x4 (&acc)[2][2][4][2], const Unit& u, int wr, int wc, int fr, int fq) const {
        const int row0 = u.pm * BM + wr * 64 + fr, col0 = u.pn * BM + wc * 32 + 4 * fq;
#pragma unroll
        for (int ai = 0; ai < 2; ++ai)
#pragma unroll
            for (int m = 0; m < 4; ++m) { const int r = row0 + ai * HALF + m * 16; const bool lat = r < NLAT; const int bb = lat ? (r >> 11) : 8;
                const float* hi = lat ? hin_l + (size_t)r * DM : hin_c + (size_t)(r - NLAT) * DM; float* ho = lat ? hout_l + (size_t)r * DM : hout_c + (size_t)(r - NLAT) * DM;
                const float* g = gate + (size_t)bb * 6144;
#pragma unroll
                for (int bj = 0; bj < 2; ++bj)
#pragma unroll
                    for (int n = 0; n < 2; ++n) { const int c = col0 + bj * HALF + n * 16; const f32x4 gv = *(const f32x4*)(g + c), hv = *(const f32x4*)(hi + c);
                        *(f32x4*)(ho + c) = hv + gv * acc[ai][bj][m][n]; } }
    }
};
struct EpiAct {
    static constexpr bool PERM = true;
    bf16* O;
    __device__ __forceinline__ void operator()(const f32x4 (&acc)[2][2][4][2], const Unit& u, int wr, int wc, int fr, int fq) const {
        const int row0 = u.pm * BM + wr * 64 + fr, col0 = u.pn * HALF + wc * 32 + 8 * fq;
#pragma unroll
        for (int ai = 0; ai < 2; ++ai)
#pragma unroll
            for (int m = 0; m < 4; ++m) { bf16* rowp = O + (size_t)(row0 + ai * HALF + m * 16) * FF + col0;
                float o[8];
#pragma unroll
                for (int n = 0; n < 2; ++n)
#pragma unroll
                    for (int j = 0; j < 4; ++j) { const float g = acc[ai][0][m][n][j], up = acc[ai][1][m][n][j]; o[n * 4 + j] = g / (1.f + __expf(-g)) * up; }
                u32x4 w; w.x = cvt_pk_bf16(o[0], o[1]); w.y = cvt_pk_bf16(o[2], o[3]); w.z = cvt_pk_bf16(o[4], o[5]); w.w = cvt_pk_bf16(o[6], o[7]);
                *(u32x4*)rowp = w; }
    }
};
struct EpiDown {
    static constexpr bool PERM = true;
    bf16* O; const int* elist; const float* rtw;
    __device__ __forceinline__ void operator()(const f32x4 (&acc)[2][2][4][2], const Unit& u, int wr, int wc, int fr, int fq) const {
        const int col0 = u.pn * BM + wc * 32 + 8 * fq;
#pragma unroll
        for (int ai = 0; ai < 2; ++ai)
#pragma unroll
            for (int m = 0; m < 4; ++m) { const int pos = u.j * BM + ai * HALF + wr * 64 + m * 16 + fr;
                if (pos < u.cnt) { const int a = elist[u.e * NROW + pos]; const float w8 = rtw[a]; bf16* rowp = O + (size_t)a * DM + col0;
#pragma unroll
                    for (int bj = 0; bj < 2; ++bj) { const f32x4 v0 = acc[ai][bj][m][0] * w8, v1 = acc[ai][bj][m][1] * w8;
                        u32x4 w; w.x = cvt_pk_bf16(v0[0], v0[1]); w.y = cvt_pk_bf16(v0[2], v0[3]); w.z = cvt_pk_bf16(v1[0], v1[1]); w.w = cvt_pk_bf16(v1[2], v1[3]);
                        *(u32x4*)(rowp + bj * HALF) = w; } } }
    }
};
}

struct Args { const float* in[36]; float* out; unsigned char* ws; int ph_lo, ph_hi; };
struct Fr {
    LAS unsigned char* lds; int tid, lane, wave, G, vcu, gw, NGW; const __attribute__((address_space(4))) Args* A;
    __device__ __forceinline__ const float* x() const { return A->in[0]; }
    __device__ __forceinline__ const float* cvec() const { return A->in[1]; }
    __device__ __forceinline__ const float* ctx() const { return A->in[2]; }
    __device__ __forceinline__ const float* cctx() const { return A->in[3]; }
    __device__ __forceinline__ const float* w_mod() const { return A->in[4]; }
    __device__ __forceinline__ const float* b_mod() const { return A->in[5]; }
    __device__ __forceinline__ const float* g_mix() const { return A->in[6]; }
    __device__ __forceinline__ const float* w_in() const { return A->in[7]; }
    __device__ __forceinline__ const float* w_out() const { return A->in[8]; }
    __device__ __forceinline__ const float* na_gq() const { return A->in[9]; }
    __device__ __forceinline__ const float* na_gk() const { return A->in[10]; }
    __device__ __forceinline__ const float* na_rb() const { return A->in[11]; }
    __device__ __forceinline__ const float* mla_gqa() const { return A->in[12]; }
    __device__ __forceinline__ const float* mla_wqb() const { return A->in[13]; }
    __device__ __forceinline__ const float* mla_gkva() const { return A->in[14]; }
    __device__ __forceinline__ const float* mla_wkvb() const { return A->in[15]; }
    __device__ __forceinline__ const float* mla_gq() const { return A->in[16]; }
    __device__ __forceinline__ const float* mla_gk() const { return A->in[17]; }
    __device__ __forceinline__ const float* df_gq() const { return A->in[18]; }
    __device__ __forceinline__ const float* df_gk() const { return A->in[19]; }
    __device__ __forceinline__ const float* df_lam() const { return A->in[20]; }
    __device__ __forceinline__ const float* df_gsub() const { return A->in[21]; }
    __device__ __forceinline__ const float* conv_w() const { return A->in[22]; }
    __device__ __forceinline__ const float* conv_b() const { return A->in[23]; }
    __device__ __forceinline__ const float* dt_bias() const { return A->in[24]; }
    __device__ __forceinline__ const float* a_log() const { return A->in[25]; }
    __device__ __forceinline__ const float* ssd_d() const { return A->in[26]; }
    __device__ __forceinline__ const float* ssd_gn() const { return A->in[27]; }
    __device__ __forceinline__ const float* g_ffn() const { return A->in[28]; }
    __device__ __forceinline__ const float* w_grp() const { return A->in[29]; }
    __device__ __forceinline__ const float* b_grp() const { return A->in[30]; }
    __device__ __forceinline__ const float* w_exp() const { return A->in[31]; }
    __device__ __forceinline__ const float* b_exp() const { return A->in[32]; }
    __device__ __forceinline__ const float* w_gate() const { return A->in[33]; }
    __device__ __forceinline__ const float* w_up() const { return A->in[34]; }
    __device__ __forceinline__ const float* w_down() const { return A->in[35]; }
    __device__ __forceinline__ float* out() const { return A->out; }
    __device__ __forceinline__ unsigned* ctl() const { return (unsigned*)(A->ws + WS_CTL); }
    __device__ __forceinline__ float* modv() const { return (float*)(A->ws + WS_MOD); }
    __device__ __forceinline__ float* rcos() const { return (float*)(A->ws + WS_ROPE); }
    __device__ __forceinline__ float* rsin() const { return (float*)(A->ws + WS_ROPE + TLAT * 16 * 4); }
    __device__ __forceinline__ bf16* winT() const { return (bf16*)(A->ws + WS_WIN); }
    __device__ __forceinline__ bf16* woutT() const { return (bf16*)(A->ws + WS_WOUT); }
    __device__ __forceinline__ bf16* wqbT() const { return (bf16*)(A->ws + WS_WQB); }
    __device__ __forceinline__ bf16* wkvbT() const { return (bf16*)(A->ws + WS_WKVB); }
    __device__ __forceinline__ bf16* wgu() const { return (bf16*)(A->ws + WS_WGU); }
    __device__ __forceinline__ bf16* wd() const { return (bf16*)(A->ws + WS_WD); }
    __device__ __forceinline__ float* hc() const { return (float*)(A->ws + WS_HC); }
    __device__ __forceinline__ bf16* abuf() const { return (bf16*)(A->ws + WS_A); }
    __device__ __forceinline__ bf16* pbuf() const { return (bf16*)(A->ws + WS_P); }
    __device__ __forceinline__ bf16* act() const { return (bf16*)(A->ws + WS_ACT); }
    __device__ __forceinline__ bf16* yk() const { return (bf16*)(A->ws + WS_YK); }
    __device__ __forceinline__ bf16* mix() const { return (bf16*)(A->ws + WS_MIX); }
    __device__ __forceinline__ bf16* qna() const { return (bf16*)(A->ws + WS_QNA); }
    __device__ __forceinline__ bf16* kna() const { return (bf16*)(A->ws + WS_KNA); }
    __device__ __forceinline__ bf16* vna() const { return (bf16*)(A->ws + WS_VNA); }
    __device__ __forceinline__ bf16* qml() const { return (bf16*)(A->ws + WS_QML); }
    __device__ __forceinline__ bf16* kml() const { return (bf16*)(A->ws + WS_KML); }
    __device__ __forceinline__ bf16* vml() const { return (bf16*)(A->ws + WS_VML); }
    __device__ __forceinline__ bf16* qdf() const { return (bf16*)(A->ws + WS_QDF); }
    __device__ __forceinline__ bf16* kdf() const { return (bf16*)(A->ws + WS_KDF); }
    __device__ __forceinline__ bf16* vdf() const { return (bf16*)(A->ws + WS_VDF); }
    __device__ __forceinline__ bf16* xT() const { return (bf16*)(A->ws + WS_XT); }
    __device__ __forceinline__ bf16* btm() const { return (bf16*)(A->ws + WS_BTM); }
    __device__ __forceinline__ bf16* bT() const { return (bf16*)(A->ws + WS_BT); }
    __device__ __forceinline__ bf16* ctm() const { return (bf16*)(A->ws + WS_CTM); }
    __device__ __forceinline__ float* dtv() const { return (float*)(A->ws + WS_DT); }
    __device__ __forceinline__ float* cst() const { return (float*)(A->ws + WS_CST); }
    __device__ __forceinline__ float* cdec() const { return (float*)(A->ws + WS_CDEC); }
    __device__ __forceinline__ bf16* hent() const { return (bf16*)(A->ws + WS_HENT); }
    __device__ __forceinline__ float* ydir() const { return (float*)(A->ws + WS_CST); }
    __device__ __forceinline__ int* rte() const { return (int*)(A->ws + WS_RT); }
    __device__ __forceinline__ float* rtw() const { return (float*)(A->ws + WS_RT + 256 * 1024); }
    __device__ __forceinline__ int* elist() const { return (int*)(A->ws + WS_ELIST); }
};

__device__ __forceinline__ Fr refresh(const Fr& F0) { Fr F = F0; int w = F0.wave; asm volatile("" : "+s"(w)); asm volatile("" : "+s"(F.A));
    int l; asm volatile("v_mbcnt_lo_u32_b32 %0, -1, 0\n\tv_mbcnt_hi_u32_b32 %0, -1, %0" : "=v"(l)); F.wave = w; F.lane = l; F.tid = w * 64 + l; F.gw = F.vcu * 8 + w; return F; }
__device__ __forceinline__ void tr_item(const float* W, int ldw, int nvalid, int k0, int n0, bf16* dst, int ldd, LAS float* scr, int lane, const float* ksc = nullptr) {
    const int cn = n0 + (lane & 31);
#pragma unroll 8
    for (int i = 0; i < 32; ++i) { const int kk = 2 * i + (lane >> 5); const float sc1 = ksc ? ksc[k0 + kk] : 1.f; scr[kk * 33 + (lane & 31)] = cn < nvalid ? W[(size_t)(k0 + kk) * ldw + cn] * sc1 : 0.f; }
    LDS_WAIT();
    const int c = lane & 7;
#pragma unroll
    for (int j = 0; j < 4; ++j) { const int n = (lane >> 3) + 8 * j; const LAS float* s = scr + (8 * c) * 33 + n;
        u32x4 o; o.x = pk2(s[0 * 33], s[1 * 33]); o.y = pk2(s[2 * 33], s[3 * 33]); o.z = pk2(s[4 * 33], s[5 * 33]); o.w = pk2(s[6 * 33], s[7 * 33]);
        *(u32x4*)(dst + (size_t)n * ldd + k0 + 8 * c) = o; }
    LDS_WAIT();
}
__device__ __forceinline__ void moe_weight_convert(const Fr& F, int L) {
    LAS float* scr = (LAS float*)(F.lds + F.wave * 16384);
    constexpr int I_GU = 16 * 16, I_D = 8 * 32;
    for (int it = F.gw; it < NEXP * (2 * I_GU + I_D); it += F.NGW) {
        const int e = it / (2 * I_GU + I_D); int r = it % (2 * I_GU + I_D);
        if (r < 2 * I_GU) { const int bj = r / I_GU; r %= I_GU; const int kb = r / 16, nb = r % 16, n0 = nb * 32;
            const float* W = (bj ? F.w_up() : F.w_gate()) + ((size_t)L * NEXP + e) * DM * FF;
            tr_item(W, FF, FF, kb * 64, n0, F.wgu() + ((size_t)e * 1024 + (n0 >> 7) * 256 + bj * 128 + (n0 & 127)) * DM, DM, scr, F.lane);
        } else { r -= 2 * I_GU; const int kb = r / 32, nb = r % 32, n0 = nb * 32;
            const float* W = F.w_down() + ((size_t)L * NEXP + e) * FF * DM;
            tr_item(W, DM, DM, kb * 64, n0, F.wd() + ((size_t)e * 1024 + n0) * FF, FF, scr, F.lane); }
    }
}
__device__ __forceinline__ void phase_prologue(const Fr& F) {
    LAS float* sc = (LAS float*)F.lds;
    for (int u = blockIdx.x; u < 48; u += F.G) {
        for (int i = F.tid; i < 9 * 1024; i += 512) { const float v = i < 8192 ? F.cvec()[i] : F.cctx()[i - 8192]; sc[i] = siluf(v); }
        __syncthreads();
        const int col = u * 512 + F.tid, L = col / 6144, n = col % 6144;
        float acc[9];
#pragma unroll
        for (int b = 0; b < 9; ++b) acc[b] = 0.f;
        const float* w = F.w_mod() + (size_t)L * 1024 * 6144 + n;
#pragma unroll 8
        for (int k = 0; k < 1024; ++k) { const float wv = w[(size_t)k * 6144];
#pragma unroll
            for (int b = 0; b < 9; ++b) acc[b] += sc[b * 1024 + k] * wv; }
        const float bm = F.b_mod()[L * 6144 + n];
#pragma unroll
        for (int b = 0; b < 9; ++b) F.modv()[((size_t)L * 9 + b) * 6144 + n] = acc[b] + bm;
        __syncthreads();
    }
    for (int i = blockIdx.x * 512 + F.tid; i < TLAT * 16; i += F.G * 512) { const int t = i >> 4, k = i & 15; const float inv = powf(10000.f, -(float)(k & 7) / 8.f);
        const float pos = (k < 8) ? (float)(t >> 6) : (float)(t & 63); const float ang = pos * inv; F.rcos()[i] = cosf(ang); F.rsin()[i] = sinf(ang); }
    __syncthreads();
    LAS float* scr = (LAS float*)(F.lds + F.wave * 16384);
    constexpr int I_IN = 16 * 96, I_OUT = 16 * 32, I_QB = 4 * 12, I_KVB = 2 * 16, I_L = I_IN + I_OUT + I_QB + I_KVB;
    for (int it = F.gw; it < DEPTH * I_L; it += F.NGW) {
        const int L = it / I_L; int r = it % I_L;
        if (r < I_IN) { const int kb = r / 96, nb = r % 96; tr_item(F.w_in() + (size_t)L * DM * NIN, NIN, NIN, kb * 64, nb * 32, F.winT() + ((size_t)L * NP + nb * 32) * DM, DM, scr, F.lane); continue; } r -= I_IN;
        if (r < I_OUT) { const int kb = r / 32, nb = r % 32; tr_item(F.w_out() + (size_t)L * DM * DM, DM, DM, kb * 64, nb * 32, F.woutT() + ((size_t)L * DM + nb * 32) * DM, DM, scr, F.lane); continue; } r -= I_OUT;
        if (r < I_QB) { const int kb = r / 12, nb = r % 12; tr_item(F.mla_wqb() + (size_t)L * 256 * 384, 384, 384, kb * 64, nb * 32, F.wqbT() + ((size_t)L * 384 + nb * 32) * 256, 256, scr, F.lane, F.mla_gqa() + L * 256); continue; } r -= I_QB;
        { const int kb = r / 16, nb = r % 16; tr_item(F.mla_wkvb() + (size_t)L * 128 * 512, 512, 512, kb * 64, nb * 32, F.wkvbT() + ((size_t)L * 512 + nb * 32) * 128, 128, scr, F.lane, F.mla_gkva() + L * 128); }
    }
}

__device__ __forceinline__ void phase_norm(const Fr& F, int L) {
    const int nrows = (L == DEPTH) ? NLAT : NROW;
    for (int r = F.gw; r < nrows; r += F.NGW) {
        const bool lat = r < NLAT; const int bb = lat ? (r >> 11) : 8;
        const float* hin = (L == 0) ? (lat ? F.x() + (size_t)r * DM : F.ctx() + (size_t)(r - NLAT) * DM) : (lat ? F.out() + (size_t)r * DM : F.hc() + (size_t)(r - NLAT) * DM);
        float* hout = lat ? F.out() + (size_t)r * DM : F.hc() + (size_t)(r - NLAT) * DM;
        f32x4 v[4];
#pragma unroll
        for (int j = 0; j < 4; ++j) v[j] = *(const f32x4*)(hin + 4 * F.lane + 256 * j);
        if (L > 0) {
            const float* m5 = F.modv() + ((size_t)(L - 1) * 9 + bb) * 6144 + 5 * 1024;
#pragma unroll
            for (int j = 0; j < 4; ++j) { const int c = 4 * F.lane + 256 * j; const f32x4 g = *(const f32x4*)(m5 + c);
                const u32x2 y0 = *(const u32x2*)(F.yk() + (size_t)(2 * r) * DM + c), y1 = *(const u32x2*)(F.yk() + (size_t)(2 * r + 1) * DM + c);
                f32x4 ys; ys[0] = __uint_as_float(y0.x << 16) + __uint_as_float(y1.x << 16); ys[1] = __uint_as_float(y0.x & 0xffff0000u) + __uint_as_float(y1.x & 0xffff0000u);
                ys[2] = __uint_as_float(y0.y << 16) + __uint_as_float(y1.y << 16); ys[3] = __uint_as_float(y0.y & 0xffff0000u) + __uint_as_float(y1.y & 0xffff0000u);
                v[j] = v[j] + g * ys; *(f32x4*)(hout + c) = v[j]; }
        }
        if (L == DEPTH) continue;
        float ss = 0.f;
#pragma unroll
        for (int j = 0; j < 4; ++j) ss += (v[j][0] * v[j][0] + v[j][1] * v[j][1]) + (v[j][2] * v[j][2] + v[j][3] * v[j][3]);
        const float rstd = rsqrtf(wsum(ss) * (1.f / DM) + EPS);
        const float* md = F.modv() + ((size_t)L * 9 + bb) * 6144;
#pragma unroll
        for (int j = 0; j < 4; ++j) { const int c = 4 * F.lane + 256 * j; const f32x4 g = *(const f32x4*)(F.g_mix() + L * DM + c), sh = *(const f32x4*)(md + c), scl = *(const f32x4*)(md + 1024 + c);
            const f32x4 a = v[j] * rstd * g * (scl + 1.f) + sh; u32x2 o; o.x = pk2(a[0], a[1]); o.y = pk2(a[2], a[3]); *(u32x2*)(F.abuf() + (size_t)r * DM + c) = o; }
    }
}

__device__ __forceinline__ void prep_row(const Fr& F, int L, int r, LAS float* scr) {
    int lane_ = F.lane; asm volatile("" : "+v"(lane_)); const int lane = lane_; int b, s; row2bs(r, b, s); const bool lat = r < NLAT; const int t = s - 256;
    const bf16* p = F.pbuf() + (size_t)r * NP;
#pragma unroll
    for (int h = 0; h < 4; ++h) {
        const float q = bf2f(p[C_NA + h * 64 + lane]), k = bf2f(p[C_NA + 256 + h * 64 + lane]);
        const float rq = rsqrtf(wsum(q * q) * (1.f / 64) + EPS), rk = rsqrtf(wsum(k * k) * (1.f / 64) + EPS);
        const size_t o = ((size_t)(b * 4 + h) * SQ + s) * 64 + lane;
        F.qna()[o] = f2bf(q * rq * F.na_gq()[L * 64 + lane]); F.kna()[o] = f2bf(k * rk * F.na_gk()[L * 64 + lane]);
        F.vna()[((size_t)(b * 4 + h) * 64 + lane) * SQ + vpos(s)] = p[C_NA + 512 + h * 64 + lane];
    }
    {
        const int idx = lane & 31; float cs = 1.f, sn = 0.f;
        if (lat) { cs = F.rcos()[t * 16 + (idx & 15)]; sn = F.rsin()[t * 16 + (idx & 15)]; }
#pragma unroll
        for (int h = 0; h < 4; ++h) {
            float q = bf2f(p[C_DF + h * 64 + lane]), k = bf2f(p[C_DF + 256 + h * 64 + lane]);
            float sq = q * q, sk = k * k;
#pragma unroll
            for (int o = 16; o >= 1; o >>= 1) { sq += __shfl_xor(sq, o); sk += __shfl_xor(sk, o); }
            q *= rsqrtf(sq * (1.f / 32) + EPS) * F.df_gq()[L * 32 + idx]; k *= rsqrtf(sk * (1.f / 32) + EPS) * F.df_gk()[L * 32 + idx];
            const float qp = __shfl_xor(q, 16), kp = __shfl_xor(k, 16);
            if (lat) { q = (idx < 16) ? q * cs - qp * sn : qp * sn + q * cs; k = (idx < 16) ? k * cs - kp * sn : kp * sn + k * cs; }
            const size_t o = ((size_t)(b * 4 + h) * SQ + s) * 64 + lane;
            F.qdf()[o] = f2bf(q); F.kdf()[o] = f2bf(k);
            F.vdf()[((size_t)(b * 4 + h) * 64 + lane) * SQ + vpos(s)] = p[C_DF + 512 + h * 64 + lane];
        }
    }
    {
        const int tt = lat ? t : s, len = lat ? TLAT : TCTX;
#pragma unroll
        for (int i = 0; i < 12; ++i) { const int c = lane + 64 * i; float acc = F.conv_b()[L * 768 + c];
#pragma unroll
            for (int j = 0; j < 5; ++j) { const int tj = tt + j - 2; if (tj >= 0 && tj < len) acc += F.conv_w()[(L * 5 + j) * 768 + c] * bf2f(F.pbuf()[(size_t)(r + j - 2) * NP + C_XBC + c]); }
            const bf16 v = f2bf(siluf(acc));
            if (i < 4) F.xT()[((size_t)b * 256 + c) * SQ + s] = v;
            else if (i < 8) { F.btm()[((size_t)b * SQ + s) * 256 + c - 256] = v; F.bT()[((size_t)b * 256 + c - 256) * SQ + s] = v; }
            else F.ctm()[((size_t)b * SQ + s) * 256 + c - 512] = v; }
        if (lane < 8) { const float raw = bf2f(p[C_DT + lane]) + F.dt_bias()[L * 8 + lane]; const float ex = __expf(raw); F.dtv()[((size_t)b * 8 + lane) * SQ + s] = raw > 20.f ? raw : (ex < 0.03f ? ex * (1.f - ex * (0.5f - ex * (0.33333334f - 0.25f * ex))) : __logf(1.f + ex)); }
    }
}
__device__ __forceinline__ void mla_prep_block(const Fr& F, int L, int b, int j32) {
    int lane_ = F.lane; asm volatile("" : "+v"(lane_));
    const int lane = lane_, wave = F.wave, r = lane & 31, hh = lane >> 5, s = 32 * j32 + r, t = s - 256; const bool lat = s >= 256;
    const size_t row = bs2row(b, s);
    const bf16* p = F.pbuf() + row * NP + C_MLA;
    const int tt = lat ? t : 0; const float latf = lat ? 1.f : 0.f;
    if (wave < 4) {
        const int hq = wave;
        bf16x8 Bq[16]; float ss = 0.f;
#pragma unroll
        for (int kk = 0; kk < 16; ++kk) { Bq[kk] = *(const bf16x8*)(p + 16 * kk + 8 * hh);
#pragma unroll
            for (int j = 0; j < 8; ++j) { const float v = bf2f((bf16)Bq[kk][j]); ss += v * v; } }
        ss += __shfl_xor(ss, 32); const float rq = rsqrtf(ss * (1.f / 256) + EPS);
        f32x16 acc[3]; float hs = 0.f;
#pragma unroll
        for (int j3 = 0; j3 < 3; ++j3) {
#pragma unroll
            for (int i = 0; i < 16; ++i) acc[j3][i] = 0.f;
            const bf16* wp = F.wqbT() + ((size_t)L * 384 + 96 * hq + 32 * j3 + r) * 256 + 8 * hh;
#pragma unroll
            for (int kk = 0; kk < 16; ++kk) acc[j3] = MFMA32(*(const bf16x8*)(wp + 16 * kk), Bq[kk], acc[j3]);
            asm volatile("" ::: "memory");
#pragma unroll
            for (int i = 0; i < 16; ++i) hs += acc[j3][i] * acc[j3][i]; }
        hs = (hs + __shfl_xor(hs, 32)) * rq * rq; const float rs = rsqrtf(hs * (1.f / 96) + EPS) * rq;
        bf16* qo = F.qml() + ((size_t)(b * 4 + hq) * SQ + s) * 96 + 4 * hh;
#pragma unroll
        for (int j3 = 0; j3 < 3; ++j3) {
#pragma unroll
            for (int i = 0; i < 16; ++i) acc[j3][i] *= rs * F.mla_gq()[L * 96 + 32 * j3 + crow16(i, hh)];
            if (j3 == 2) {
#pragma unroll
                for (int i = 0; i < 8; ++i) { const float rc = lat ? F.rcos()[tt * 16 + crow16(i, hh)] : 1.f, rsn = F.rsin()[tt * 16 + crow16(i, hh)] * latf;
                    const float x1 = acc[2][i], x2 = acc[2][i + 8]; acc[2][i] = x1 * rc - x2 * rsn; acc[2][i + 8] = x1 * rsn + x2 * rc; } }
#pragma unroll
            for (int g = 0; g < 4; ++g) { u32x2 w; w.x = pk2(acc[j3][4 * g], acc[j3][4 * g + 1]); w.y = pk2(acc[j3][4 * g + 2], acc[j3][4 * g + 3]); *(u32x2*)(qo + 32 * j3 + 8 * g) = w; } }
    } else {
        const int hk = wave - 4;
        LAS unsigned char* wl = F.lds + wave * 16384;
        bf16x8 Bkv[8]; float ss = 0.f;
#pragma unroll
        for (int kk = 0; kk < 8; ++kk) { Bkv[kk] = *(const bf16x8*)(p + 256 + 16 * kk + 8 * hh);
#pragma unroll
            for (int j = 0; j < 8; ++j) { const float v = bf2f((bf16)Bkv[kk][j]); ss += v * v; } }
        ss += __shfl_xor(ss, 32); const float rk = rsqrtf(ss * (1.f / 128) + EPS);
        float kr[16]; float hs = 0.f;
#pragma unroll
        for (int g = 0; g < 4; ++g) { const u32x2 k4 = *(const u32x2*)(p + 384 + 8 * g + 4 * hh);
            kr[4 * g] = __uint_as_float(k4.x << 16); kr[4 * g + 1] = __uint_as_float(k4.x & 0xffff0000u); kr[4 * g + 2] = __uint_as_float(k4.y << 16); kr[4 * g + 3] = __uint_as_float(k4.y & 0xffff0000u); }
#pragma unroll
        for (int i = 0; i < 16; ++i) hs += kr[i] * kr[i];
        f32x16 acc[4]; float ks = 0.f;
#pragma unroll
        for (int j4 = 0; j4 < 4; ++j4) {
#pragma unroll
            for (int i = 0; i < 16; ++i) acc[j4][i] = 0.f;
            const bf16* wp = F.wkvbT() + ((size_t)L * 512 + 128 * hk + 32 * j4 + r) * 128 + 8 * hh;
#pragma unroll
            for (int kk = 0; kk < 8; ++kk) acc[j4] = MFMA32(*(const bf16x8*)(wp + 16 * kk), Bkv[kk], acc[j4]);
            asm volatile("" ::: "memory");
            if (j4 < 2) {
#pragma unroll
                for (int i = 0; i < 16; ++i) ks += acc[j4][i] * acc[j4][i]; } }
        hs += ks * rk * rk; hs += __shfl_xor(hs, 32); const float rs = rsqrtf(hs * (1.f / 96) + EPS);
        bf16* ko = F.kml() + ((size_t)(b * 4 + hk) * SQ + s) * 96 + 4 * hh;
#pragma unroll
        for (int j2 = 0; j2 < 2; ++j2) {
#pragma unroll
            for (int i = 0; i < 16; ++i) acc[j2][i] *= rs * rk * F.mla_gk()[L * 96 + 32 * j2 + crow16(i, hh)];
#pragma unroll
            for (int g = 0; g < 4; ++g) { u32x2 w; w.x = pk2(acc[j2][4 * g], acc[j2][4 * g + 1]); w.y = pk2(acc[j2][4 * g + 2], acc[j2][4 * g + 3]); *(u32x2*)(ko + 32 * j2 + 8 * g) = w; } }
#pragma unroll
        for (int i = 0; i < 16; ++i) kr[i] *= rs * F.mla_gk()[L * 96 + 64 + crow16(i, hh)];
#pragma unroll
        for (int i = 0; i < 8; ++i) { const float rc = lat ? F.rcos()[tt * 16 + crow16(i, hh)] : 1.f, rsn = F.rsin()[tt * 16 + crow16(i, hh)] * latf;
            const float x1 = kr[i], x2 = kr[i + 8]; kr[i] = x1 * rc - x2 * rsn; kr[i + 8] = x1 * rsn + x2 * rc; }
#pragma unroll
        for (int g = 0; g < 4; ++g) { u32x2 w; w.x = pk2(kr[4 * g], kr[4 * g + 1]); w.y = pk2(kr[4 * g + 2], kr[4 * g + 3]); *(u32x2*)(ko + 64 + 8 * g) = w; }
        LAS bf16* vl = (LAS bf16*)wl;
#pragma unroll
        for (int mt = 0; mt < 2; ++mt)
#pragma unroll
            for (int i = 0; i < 16; ++i) vl[(32 * mt + crow16(i, hh)) * 40 + vpos(r)] = f2bf(acc[2 + mt][i] * rk);
        LDS_WAIT();
        { const LAS u32x4* src4 = (const LAS u32x4*)(wl + lane * 80); u32x4* dst = (u32x4*)(F.vml() + ((size_t)(b * 4 + hk) * 64 + lane) * SQ + 32 * j32);
#pragma unroll
          for (int q = 0; q < 4; ++q) dst[q] = src4[q]; }
        LDS_WAIT();
    }
}
__device__ __forceinline__ void phase_prep(const Fr& F, int L) {
    LAS float* scr = (LAS float*)(F.lds + F.wave * 16384);
#ifndef PREP_MASK
#define PREP_MASK 3
#endif
    if (PREP_MASK & 1) { const Fr F1 = refresh(F); for (int r = F1.gw; r < NROW; r += F1.NGW) prep_row(F1, L, r, scr); }
    if (PREP_MASK & 2) { const Fr F2 = refresh(F); for (int j = F2.vcu; j < NB * 72; j += F2.G) mla_prep_block(F2, L, j / 72, j % 72); }
}

__device__ __forceinline__ void phase_ssd_naive(const Fr& F, int L) {
    if (F.wave != 0 || blockIdx.x >= 64) return;
    const int w = blockIdx.x, b = w >> 3, d = (w >> 2) & 1, h = w & 3, g = h >> 1, p = F.lane;
    const float a = -expf(F.a_log()[L * 8 + d * 4 + h]);
    float hs[128];
#pragma unroll
    for (int n = 0; n < 128; ++n) hs[n] = 0.f;
    const float* dtp = F.dtv() + ((size_t)b * 8 + d * 4 + h) * SQ;
    const bf16* xp = F.xT() + ((size_t)b * 256 + h * 64 + p) * SQ;
    for (int step = 0; step < SQ; ++step) {
        const int s = d == 0 ? step : (step < 256 ? 255 - step : SQ - 1 - (step - 256));
        const float dtv = dtp[s], dA = __expf(dtv * a), xv = bf2f(xp[s]) * dtv;
        const u32x4* Bp = (const u32x4*)(F.btm() + ((size_t)b * SQ + s) * 256 + g * 128);
        const u32x4* Cp = (const u32x4*)(F.ctm() + ((size_t)b * SQ + s) * 256 + g * 128);
        float y = 0.f;
#pragma unroll
        for (int n8 = 0; n8 < 16; ++n8) { const u32x4 bv = Bp[n8], cv = Cp[n8];
#pragma unroll
            for (int j = 0; j < 4; ++j) { const int n = n8 * 8 + 2 * j;
                hs[n] = hs[n] * dA + xv * __uint_as_float(bv[j] << 16); hs[n + 1] = hs[n + 1] * dA + xv * __uint_as_float(bv[j] & 0xffff0000u);
                y += __uint_as_float(cv[j] << 16) * hs[n] + __uint_as_float(cv[j] & 0xffff0000u) * hs[n + 1]; } }
        F.ydir()[((size_t)d * NROW + bs2row(b, s)) * 256 + h * 64 + p] = y;
    }
}

template <int KIND>
__device__ __forceinline__ void naive_attn_job(const Fr& F, int L, int r, int h, LAS float* scr) {
    constexpr int DQ = KIND == 1 ? 96 : (KIND == 0 ? 64 : 32), QS = KIND == 1 ? 96 : 64;
    const int lane = F.lane; int b, s; row2bs(r, b, s); const bool lat = r < NLAT; const int t = s - 256;
    const bf16* Qb = (KIND == 0 ? F.qna() : KIND == 1 ? F.qml() : F.qdf()) + ((size_t)(b * 4 + h) * SQ + s) * QS;
    const bf16* Kb = (KIND == 0 ? F.kna() : KIND == 1 ? F.kml() : F.kdf()) + (size_t)(b * 4 + h) * SQ * QS;
    const bf16* Vt = (KIND == 0 ? F.vna() : KIND == 1 ? F.vml() : F.vdf()) + ((size_t)(b * 4 + h) * 64 + lane) * SQ;
    const float scale = KIND == 1 ? 0.10206207261596577f : (KIND == 0 ? 0.125f : 0.17677669529663687f);
    const int qr = t >> 6, qc = t & 63, row_lo = min(max(qr - 4, 0), 24), col_lo = min(max(qc - 8, 0), 48);
    const bool nb = (KIND == 0) && lat;
    const int nk = lat ? (KIND == 0 ? 768 : SQ) : 256;
    const int koff = nb ? row_lo * 64 : 0;
    float oc[2] = {0.f, 0.f};
#pragma unroll
    for (int comp = 0; comp < (KIND == 2 ? 2 : 1); ++comp) {
        for (int i = lane; i < DQ; i += 64) scr[i] = bf2f(Qb[comp * 32 + i]);
        LDS_WAIT();
        float m = -INFINITY;
        for (int kk = lane; kk < nk; kk += 64) {
            const int sk = kk < 256 ? kk : kk + koff; float bias = 0.f; bool valid = true;
            if (nb && kk >= 256) { const int w = kk - 256, kr = w >> 6, kc = w & 63; valid = kc >= col_lo && kc < col_lo + 16;
                const int ro = row_lo + kr - qr + 7, co = min(max(kc - qc, -15), 15) + 15; bias = F.na_rb()[((L * 4 + h) * 15 + ro) * 31 + co]; }
            const u32x4* kp = (const u32x4*)(Kb + (size_t)sk * QS + (KIND == 2 ? comp * 32 : 0));
            float dot = 0.f;
#pragma unroll
            for (int i8 = 0; i8 < DQ / 8; ++i8) { const u32x4 kv = kp[i8];
#pragma unroll
                for (int j = 0; j < 4; ++j) dot += scr[i8 * 8 + 2 * j] * __uint_as_float(kv[j] << 16) + scr[i8 * 8 + 2 * j + 1] * __uint_as_float(kv[j] & 0xffff0000u); }
            const float sc = valid ? dot * scale + bias : -INFINITY;
            scr[128 + kk] = sc; m = fmaxf(m, sc);
        }
        m = wmaxf(m);
        float sum = 0.f;
        for (int kk = lane; kk < nk; kk += 64) { const float pv = __expf(scr[128 + kk] - m); scr[128 + kk] = pv; sum += pv; }
        sum = wsum(sum);
        LDS_WAIT();
        float o = 0.f;
        for (int kb = 0; kb < nk; kb += 8) {
            const int sb = kb < 256 ? kb : kb + koff;
            const u32x4 vv = *(const u32x4*)(Vt + sb);
#pragma unroll
            for (int j = 0; j < 8; ++j) { const int kk = (kb & ~15) + vpos((kb & 15) + j); const unsigned wv = vv[j >> 1];
                o += scr[128 + kk] * ((j & 1) ? __uint_as_float(wv & 0xffff0000u) : __uint_as_float(wv << 16)); }
        }
        oc[comp] = o / sum;
        LDS_WAIT();
    }
    bf16* mo = F.mix() + (size_t)r * DM + (KIND == 0 ? 0 : KIND == 1 ? 256 : 512) + h * 64 + lane;
    if (KIND == 2) {
        const float* lv = F.df_lam() + L * 128; const float li = 0.8f - 0.6f * expf(-0.3f * (float)L);
        float d1 = 0.f, d2 = 0.f;
#pragma unroll
        for (int i = 0; i < 32; ++i) { d1 += lv[i] * lv[32 + i]; d2 += lv[64 + i] * lv[96 + i]; }
        const float lam = expf(d1) - expf(d2) + li;
        const float o = oc[0] - lam * oc[1];
        const float rs = rsqrtf(wsum(o * o) * (1.f / 64) + EPS);
        *mo = f2bf(o * rs * F.df_gsub()[L * 64 + lane] * (1.f - li));
    } else *mo = f2bf(oc[0]);
}
__device__ __forceinline__ void phase_mix_naive(const Fr& F, int L) {
    LAS float* scr = (LAS float*)(F.lds + F.wave * 16384);
    const int nrows = (L == DEPTH - 1) ? NLAT : NROW;
    for (int j = F.gw; j < nrows * 4; j += F.NGW) naive_attn_job<2>(F, L, j >> 2, j & 3, scr);
    for (int j = F.gw; j < nrows * 4; j += F.NGW) naive_attn_job<1>(F, L, j >> 2, j & 3, scr);
    for (int j = F.gw; j < nrows * 4; j += F.NGW) naive_attn_job<0>(F, L, j >> 2, j & 3, scr);
    for (int r = F.gw; r < nrows; r += F.NGW) {
        int b, s; row2bs(r, b, s); const int h = F.lane >> 4; const float dsk = F.ssd_d()[L * 8 + h] + F.ssd_d()[L * 8 + 4 + h];
        float y[4]; float ss = 0.f;
#pragma unroll
        for (int j = 0; j < 4; ++j) { const int ch = F.lane * 4 + j; const float xv = bf2f(F.xT()[((size_t)b * 256 + ch) * SQ + s]);
            const float z = bf2f(F.pbuf()[(size_t)r * NP + C_Z + ch]);
            y[j] = (F.ydir()[(size_t)r * 256 + ch] + F.ydir()[((size_t)NROW + r) * 256 + ch] + dsk * xv) * siluf(z); ss += y[j] * y[j]; }
        const float rs = rsqrtf(wsum(ss) * (1.f / 256) + EPS);
#pragma unroll
        for (int j = 0; j < 4; ++j) { const int ch = F.lane * 4 + j; F.mix()[(size_t)r * DM + 768 + ch] = f2bf(y[j] * rs * F.ssd_gn()[L * 256 + ch]); }
    }
}

template <int S8> __device__ __forceinline__ bf16x8 pack_step(const f32x16& x) {
    u32x4 p;
    asm volatile("v_cvt_pk_bf16_f32 %0, %4, %5\n\tv_cvt_pk_bf16_f32 %1, %6, %7\n\tv_cvt_pk_bf16_f32 %2, %8, %9\n\tv_cvt_pk_bf16_f32 %3, %10, %11\n\ts_nop 1"
                 : "=&v"(p[0]), "=&v"(p[1]), "=&v"(p[2]), "=&v"(p[3])
                 : "v"(x[S8]), "v"(x[S8 + 1]), "v"(x[S8 + 2]), "v"(x[S8 + 3]), "v"(x[S8 + 4]), "v"(x[S8 + 5]), "v"(x[S8 + 6]), "v"(x[S8 + 7]));
    return __builtin_bit_cast(bf16x8, p);
}
constexpr float LOG2E = 1.4426950408889634f;
template <int KIND>
__device__ __forceinline__ void attn_unit(const Fr& F, int L, int b, int h, int qb) {
    constexpr int QS = KIND == 1 ? 96 : 64, NKS = KIND == 1 ? 6 : (KIND == 0 ? 4 : 2);
    constexpr int PK = QS * 2 + 16, PV = 144, KBYTES = 64 * PK, VBYTES = 64 * PV;
    LAS unsigned char* const Kl = F.lds; LAS unsigned char* const Vl = F.lds + 2 * KBYTES;
    LAS float* const biasl = (LAS float*)(F.lds + 2 * KBYTES + 2 * VBYTES);
    const int lane = F.lane, wave = F.wave, tid = F.tid, r = lane & 31, hh = lane >> 5;
    const bool isctx = qb < 0;
    const int comp = KIND == 2 ? (wave & 1) : 0, qg = KIND == 2 ? (wave >> 1) : wave;
    const bf16* Qg = (KIND == 0 ? F.qna() : KIND == 1 ? F.qml() : F.qdf()) + (size_t)(b * 4 + h) * SQ * QS;
    const bf16* Kg = (KIND == 0 ? F.kna() : KIND == 1 ? F.kml() : F.kdf()) + (size_t)(b * 4 + h) * SQ * QS;
    const bf16* Vg = (KIND == 0 ? F.vna() : KIND == 1 ? F.vml() : F.vdf()) + (size_t)(b * 4 + h) * 64 * SQ;
    const float cs = (KIND == 1 ? 0.10206207261596577f : (KIND == 0 ? 0.125f : 0.17677669529663687f)) * LOG2E;
    int sq, qrow = 0, qcol = 0;
    if (KIND == 2) sq = (isctx ? 128 * (-qb - 1) : 256 + 128 * qb) + 32 * qg + r;
    else if (isctx) sq = 32 * wave + r; else if (KIND == 0) { qrow = 4 * qb + (wave >> 1); qcol = 32 * (wave & 1) + r; sq = 256 + 64 * qrow + qcol; } else sq = 256 + 256 * qb + 32 * wave + r;
    int nt = 36, lo_u = 0;
    if (isctx) nt = 4; else if (KIND == 0) { lo_u = min(max(4 * qb - 4, 0), 24); nt = 4 + min(max(4 * qb - 1, 0), 24) + 8 - lo_u; }
    const int my_lo = min(max(qrow - 4, 0), 24), col_lo = min(max(qcol - 8, 0), 48);
    if (KIND == 0 && !isctx) for (int i = tid; i < 465; i += 512) biasl[i] = F.na_rb()[(L * 4 + h) * 465 + i] * LOG2E;
    bf16x8 Q[NKS];
    { const bf16* qp = Qg + (size_t)sq * QS + comp * 32 + 8 * hh;
#pragma unroll
      for (int kk = 0; kk < NKS; ++kk) Q[kk] = *(const bf16x8*)(qp + 16 * kk); }
    f32x16 O[2]; float m = -INFINITY, l = 0.f;
#pragma unroll
    for (int mt = 0; mt < 2; ++mt)
#pragma unroll
        for (int i = 0; i < 16; ++i) O[mt][i] = 0.f;
    const int kp0 = tid, kp1 = tid + 512;
    const int kr0 = QS == 96 ? kp0 / 12 : kp0 >> 3, kc0 = QS == 96 ? (kp0 % 12) * 16 : (kp0 & 7) * 16;
    const int kr1 = kp1 / 12, kc1 = (kp1 % 12) * 16;
    const int vr0 = tid >> 3, vc0 = (tid & 7) * 16;
    u32x4 rk0, rk1, rv0;
    rk1 = (u32x4){0u, 0u, 0u, 0u};
#define AT_SK0(t) ((isctx || KIND != 0) ? 64 * (t) : ((t) < 4 ? 64 * (t) : 256 + 64 * (lo_u + (t) - 4)))
#define AT_LOAD(t) do { const int sk0_ = AT_SK0(t); const char* kg_ = (const char*)(Kg + (size_t)sk0_ * QS); rk0 = *(const u32x4*)(kg_ + kp0 * 16); \
        if (QS == 96 && tid < 256) rk1 = *(const u32x4*)(kg_ + kp1 * 16); rv0 = *(const u32x4*)((const char*)(Vg + (size_t)vr0 * SQ + sk0_) + vc0); } while (0)
#define AT_STORE(buf) do { *(LAS u32x4*)(Kl + (buf) * KBYTES + kr0 * PK + kc0) = rk0; if (QS == 96 && tid < 256) *(LAS u32x4*)(Kl + (buf) * KBYTES + kr1 * PK + kc1) = rk1; \
        *(LAS u32x4*)(Vl + (buf) * VBYTES + vr0 * PV + vc0) = rv0; } while (0)
    AT_LOAD(0); AT_STORE(0);
    __syncthreads();
    for (int t = 0; t < nt; ++t) {
        const int buf = t & 1;
        if (t + 1 < nt) AT_LOAD(t + 1);
        const int krow = lo_u + t - 4;
        const bool nbt = (KIND == 0) && !isctx && t >= 4;
        const bool mine = !nbt || (krow >= my_lo && krow < my_lo + 8);
        if (mine) {
            const LAS unsigned char* Kb = Kl + buf * KBYTES + r * PK + (comp * 32 + 8 * hh) * 2; const LAS unsigned char* Vb = Vl + buf * VBYTES + r * PV + 16 * hh;
            f32x16 S0, S1;
#pragma unroll
            for (int i = 0; i < 16; ++i) { S0[i] = 0.f; S1[i] = 0.f; }
#pragma unroll
            for (int kk = 0; kk < NKS; ++kk) { const bf16x8 a0 = *(const LAS bf16x8*)(Kb + 32 * kk), a1 = *(const LAS bf16x8*)(Kb + 32 * PK + 32 * kk);
                S0 = MFMA32(a0, Q[kk], S0); S1 = MFMA32(a1, Q[kk], S1); }
            float tmax = -INFINITY;
            if (nbt) { const int drow = (krow - qrow + 7) * 31 - qcol + 15;
#pragma unroll
                for (int i = 0; i < 16; ++i) { const int kc = (i & 3) + 8 * (i >> 2) + 4 * hh;
                    { const bool v = (unsigned)(kc - col_lo) < 16u; const float bb = biasl[v ? drow + kc : 0]; S0[i] = v ? S0[i] * cs + bb : -INFINITY; }
                    { const bool v = (unsigned)(kc + 32 - col_lo) < 16u; const float bb = biasl[v ? drow + kc + 32 : 0]; S1[i] = v ? S1[i] * cs + bb : -INFINITY; }
                    tmax = fmaxf(tmax, fmaxf(S0[i], S1[i])); }
            } else {
#pragma unroll
                for (int i = 0; i < 16; ++i) { S0[i] *= cs; S1[i] *= cs; tmax = fmaxf(tmax, fmaxf(S0[i], S1[i])); } }
            tmax = fmaxf(tmax, __shfl_xor(tmax, 32));
            const float mn = fmaxf(m, tmax), al = __builtin_amdgcn_exp2f(m - mn); m = mn;
            float ps = 0.f;
#pragma unroll
            for (int i = 0; i < 16; ++i) { S0[i] = __builtin_amdgcn_exp2f(S0[i] - mn); S1[i] = __builtin_amdgcn_exp2f(S1[i] - mn); ps += S0[i] + S1[i]; }
            l = l * al + ps;
#pragma unroll
            for (int mt = 0; mt < 2; ++mt)
#pragma unroll
                for (int i = 0; i < 16; ++i) O[mt][i] *= al;
            const bf16x8 p00 = pack_step<0>(S0), p01 = pack_step<8>(S0), p10 = pack_step<0>(S1), p11 = pack_step<8>(S1);
#pragma unroll
            for (int mt = 0; mt < 2; ++mt) {
                const LAS unsigned char* vb = Vb + mt * 32 * PV;
                O[mt] = MFMA32(*(const LAS bf16x8*)(vb + 0), p00, O[mt]); O[mt] = MFMA32(*(const LAS bf16x8*)(vb + 32), p01, O[mt]);
                O[mt] = MFMA32(*(const LAS bf16x8*)(vb + 64), p10, O[mt]); O[mt] = MFMA32(*(const LAS bf16x8*)(vb + 96), p11, O[mt]); }
        }
        if (t + 1 < nt) AT_STORE(buf ^ 1);
        __syncthreads();
    }
#undef AT_SK0
#undef AT_LOAD
#undef AT_STORE
    const float inv = 1.f / (l + __shfl_xor(l, 32));
    bf16* mo = F.mix() + (size_t)bs2row(b, sq) * DM + (KIND == 0 ? 0 : KIND == 1 ? 256 : 512) + h * 64 + 4 * hh;
    if (KIND == 2) {
        LAS float* xo = (LAS float*)F.lds + qg * 2048;
        if (comp == 1) {
#pragma unroll
            for (int mt = 0; mt < 2; ++mt)
#pragma unroll
                for (int i = 0; i < 16; ++i) xo[(mt * 16 + i) * 64 + lane] = O[mt][i] * inv; }
        __syncthreads();
        if (comp == 0) {
            const float* lv = F.df_lam() + L * 128; const float li = 0.8f - 0.6f * expf(-0.3f * (float)L);
            float d1 = 0.f, d2 = 0.f;
#pragma unroll
            for (int i = 0; i < 32; ++i) { d1 += lv[i] * lv[32 + i]; d2 += lv[64 + i] * lv[96 + i]; }
            const float lam = expf(d1) - expf(d2) + li;
            float ss = 0.f;
#pragma unroll
            for (int mt = 0; mt < 2; ++mt)
#pragma unroll
                for (int i = 0; i < 16; ++i) { const float o = O[mt][i] * inv - lam * xo[(mt * 16 + i) * 64 + lane]; O[mt][i] = o; ss += o * o; }
            ss += __shfl_xor(ss, 32);
            const float rs = rsqrtf(ss * (1.f / 64) + EPS) * (1.f - li);
#pragma unroll
            for (int mt = 0; mt < 2; ++mt)
#pragma unroll
                for (int g = 0; g < 4; ++g) { const f32x4 gs = *(const f32x4*)(F.df_gsub() + L * 64 + 32 * mt + 8 * g + 4 * hh);
                    u32x2 w; w.x = pk2(O[mt][4 * g] * rs * gs[0], O[mt][4 * g + 1] * rs * gs[1]); w.y = pk2(O[mt][4 * g + 2] * rs * gs[2], O[mt][4 * g + 3] * rs * gs[3]);
                    *(u32x2*)(mo + 32 * mt + 8 * g) = w; }
        }
        __syncthreads();
    } else {
#pragma unroll
        for (int mt = 0; mt < 2; ++mt)
#pragma unroll
            for (int g = 0; g < 4; ++g) { u32x2 w; w.x = pk2(O[mt][4 * g] * inv, O[mt][4 * g + 1] * inv); w.y = pk2(O[mt][4 * g + 2] * inv, O[mt][4 * g + 3] * inv);
                *(u32x2*)(mo + 32 * mt + 8 * g) = w; }
    }
}
__device__ __forceinline__ float ssd_cum(const Fr& F, int L, int b, int h, int d, int s0, float& dt, float& cum) {
    const int lane = F.lane;
    dt = F.dtv()[((size_t)b * 8 + d * 4 + h) * SQ + s0 + lane];
    const float la = dt * -__expf(F.a_log()[L * 8 + d * 4 + h]);
    float v = la;
#pragma unroll
    for (int o = 1; o < 64; o <<= 1) { const float t = __shfl_up(v, o); if (lane >= o) v += t; }
    const float total = __shfl(v, 63);
    cum = d == 0 ? v : total - v + la;
    return total;
}
__device__ __forceinline__ void ssd_s1_job(const Fr& F, int L, int b, int c, int h, LAS float* scr) {
    const int lane = F.lane, r = lane & 31, hh = lane >> 5, s0 = 64 * c, g = h >> 1;
#pragma unroll
    for (int d = 0; d < 2; ++d) { float dt, cum; const float tot = ssd_cum(F, L, b, h, d, s0, dt, cum); scr[d * 64 + lane] = dt * __expf(tot - cum);
        if (lane == 0) F.cdec()[((b * 2 + d) * 4 + h) * 36 + c] = __expf(tot); }
    LDS_WAIT();
    bf16x8 A[2][2][4];
#pragma unroll
    for (int mt = 0; mt < 2; ++mt)
#pragma unroll
        for (int kk = 0; kk < 4; ++kk) { const bf16x8 raw = *(const bf16x8*)(F.xT() + ((size_t)b * 256 + h * 64 + 32 * mt + r) * SQ + s0 + 16 * kk + 8 * hh);
#pragma unroll
            for (int d = 0; d < 2; ++d) { u32x4 o;
#pragma unroll
                for (int j = 0; j < 4; ++j) { const float w0 = scr[d * 64 + 16 * kk + 8 * hh + 2 * j], w1 = scr[d * 64 + 16 * kk + 8 * hh + 2 * j + 1];
                    o[j] = pk2(bf2f((bf16)raw[2 * j]) * w0, bf2f((bf16)raw[2 * j + 1]) * w1); }
                A[d][mt][kk] = __builtin_bit_cast(bf16x8, o); } }
#pragma unroll
    for (int nt = 0; nt < 4; ++nt) {
        bf16x8 Bf[4];
#pragma unroll
        for (int kk = 0; kk < 4; ++kk) Bf[kk] = *(const bf16x8*)(F.bT() + ((size_t)b * 256 + g * 128 + 32 * nt + r) * SQ + s0 + 16 * kk + 8 * hh);
#pragma unroll
        for (int d = 0; d < 2; ++d)
#pragma unroll
            for (int mt = 0; mt < 2; ++mt) { f32x16 acc;
#pragma unroll
                for (int i = 0; i < 16; ++i) acc[i] = 0.f;
#pragma unroll
                for (int kk = 0; kk < 4; ++kk) acc = MFMA32(A[d][mt][kk], Bf[kk], acc);
                float* dst = F.cst() + ((((size_t)(b * 2 + d) * 4 + h) * 36 + c) * 64 + 32 * mt) * 128 + 32 * nt + r;
#pragma unroll
                for (int i = 0; i < 16; ++i) dst[crow16(i, hh) * 128] = acc[i]; }
    }
    LDS_WAIT();
}
__device__ __forceinline__ void phase_ssd_s1(const Fr& F, int L) {
    LAS float* scr = (LAS float*)(F.lds + F.wave * 16384);
    for (int j = F.gw; j < NB * 36 * 4; j += F.NGW) ssd_s1_job(F, L, j / 144, (j / 4) % 36, j & 3, scr);
}
__device__ __forceinline__ void phase_ssd_scan(const Fr& F, int L) {
    for (int e = blockIdx.x * 512 + F.tid; e < NB * 2 * 4 * 8192; e += F.G * 512) {
        const int bdh = e >> 13, pn = e & 8191, d = (bdh >> 2) & 1;
        float hst = 0.f;
        for (int step = 0; step < 36; ++step) { const int c = d == 0 ? step : (step < 4 ? 3 - step : 39 - step);
            const size_t o = ((size_t)bdh * 36 + c) * 8192 + pn;
            F.hent()[o] = f2bf(hst);
            hst = hst * F.cdec()[bdh * 36 + c] + F.cst()[o]; }
    }
}
__device__ __forceinline__ void ssd_s3_unit(const Fr& F, int L, int b, int c) {
    const int lane = F.lane, wave = F.wave, r = lane & 31, hh = lane >> 5, s0 = 64 * c, h = wave >> 1, it = wave & 1, g = h >> 1, itok = 32 * it + r;
    LAS float* scr = (LAS float*)(F.lds + wave * 16384);
    LAS float* red = (LAS float*)(F.lds + 8192);
#pragma unroll
    for (int d = 0; d < 2; ++d) { float dt, cum; (void)ssd_cum(F, L, b, h, d, s0, dt, cum); scr[d * 128 + lane] = cum; scr[d * 128 + 64 + lane] = dt; }
    LDS_WAIT();
    bf16x8 Cf[8];
#pragma unroll
    for (int kk = 0; kk < 8; ++kk) Cf[kk] = *(const bf16x8*)(F.ctm() + ((size_t)b * SQ + s0 + itok) * 256 + g * 128 + 16 * kk + 8 * hh);
    f32x16 G[2];
#pragma unroll
    for (int jt = 0; jt < 2; ++jt) {
#pragma unroll
        for (int i = 0; i < 16; ++i) G[jt][i] = 0.f;
#pragma unroll
        for (int kk = 0; kk < 8; ++kk) { const bf16x8 bf = *(const bf16x8*)(F.btm() + ((size_t)b * SQ + s0 + 32 * jt + r) * 256 + g * 128 + 16 * kk + 8 * hh); G[jt] = MFMA32(bf, Cf[kk], G[jt]); } }
    bf16x8 X[2][4];
#pragma unroll
    for (int mt = 0; mt < 2; ++mt)
#pragma unroll
        for (int ks = 0; ks < 4; ++ks) { const bf16* xp = F.xT() + ((size_t)b * 256 + h * 64 + 32 * mt + r) * SQ + s0 + 16 * ks + 4 * hh;
            const u32x2 lo = *(const u32x2*)xp, hi = *(const u32x2*)(xp + 8); u32x4 o; o.x = lo.x; o.y = lo.y; o.z = hi.x; o.w = hi.y; X[mt][ks] = __builtin_bit_cast(bf16x8, o); }
    f32x16 Y[2];
#pragma unroll
    for (int mt = 0; mt < 2; ++mt)
#pragma unroll
        for (int i = 0; i < 16; ++i) Y[mt][i] = 0.f;
    const float Dsum = F.ssd_d()[L * 8 + h] + F.ssd_d()[L * 8 + 4 + h];
#pragma unroll 1
    for (int d = 0; d < 2; ++d) {
        const float cum_i = scr[d * 128 + itok];
        f32x16 Pm[2];
#pragma unroll
        for (int jt = 0; jt < 2; ++jt)
#pragma unroll
            for (int i = 0; i < 16; ++i) { const int j = 32 * jt + crow16(i, hh); const bool valid = d == 0 ? (j <= itok) : (j >= itok);
                const float arg = valid ? cum_i - scr[d * 128 + j] : -INFINITY;
                float pv = G[jt][i] * __expf(arg) * scr[d * 128 + 64 + j];
                if (d == 0 && j == itok) pv += Dsum;
                Pm[jt][i] = pv; }
        const bf16x8 p0 = pack_step<0>(Pm[0]), p1 = pack_step<8>(Pm[0]), p2 = pack_step<0>(Pm[1]), p3 = pack_step<8>(Pm[1]);
#pragma unroll
        for (int mt = 0; mt < 2; ++mt) { Y[mt] = MFMA32(X[mt][0], p0, Y[mt]); Y[mt] = MFMA32(X[mt][1], p1, Y[mt]); Y[mt] = MFMA32(X[mt][2], p2, Y[mt]); Y[mt] = MFMA32(X[mt][3], p3, Y[mt]); }
        const float ei = __expf(cum_i);
#pragma unroll
        for (int mt = 0; mt < 2; ++mt) { f32x16 T;
#pragma unroll
            for (int i = 0; i < 16; ++i) T[i] = 0.f;
#pragma unroll
            for (int kk = 0; kk < 8; ++kk) { const bf16x8 hf = *(const bf16x8*)(F.hent() + ((((size_t)(b * 2 + d) * 4 + h) * 36 + c) * 64 + 32 * mt + r) * 128 + 16 * kk + 8 * hh); T = MFMA32(hf, Cf[kk], T); }
#pragma unroll
            for (int i = 0; i < 16; ++i) Y[mt][i] += ei * T[i]; }
    }
    const size_t row = bs2row(b, s0 + itok);
    const bf16* zp = F.pbuf() + row * NP + C_Z + h * 64 + 4 * hh;
    float ss = 0.f;
#pragma unroll
    for (int mt = 0; mt < 2; ++mt)
#pragma unroll
        for (int gq = 0; gq < 4; ++gq) { const u32x2 z4 = *(const u32x2*)(zp + 32 * mt + 8 * gq);
            const float z0 = __uint_as_float(z4.x << 16), z1 = __uint_as_float(z4.x & 0xffff0000u), z2 = __uint_as_float(z4.y << 16), z3 = __uint_as_float(z4.y & 0xffff0000u);
            Y[mt][4 * gq] *= siluf(z0); Y[mt][4 * gq + 1] *= siluf(z1); Y[mt][4 * gq + 2] *= siluf(z2); Y[mt][4 * gq + 3] *= siluf(z3);
            ss += (Y[mt][4 * gq] * Y[mt][4 * gq] + Y[mt][4 * gq + 1] * Y[mt][4 * gq + 1]) + (Y[mt][4 * gq + 2] * Y[mt][4 * gq + 2] + Y[mt][4 * gq + 3] * Y[mt][4 * gq + 3]); }
    ss += __shfl_xor(ss, 32);
    if (hh == 0) red[(it * 4 + h) * 32 + r] = ss;
    __syncthreads();
    const float tot = (red[(it * 4 + 0) * 32 + r] + red[(it * 4 + 1) * 32 + r]) + (red[(it * 4 + 2) * 32 + r] + red[(it * 4 + 3) * 32 + r]);
    const float rs = rsqrtf(tot * (1.f / 256) + EPS);
    bf16* mo = F.mix() + row * DM + 768 + h * 64 + 4 * hh;
#pragma unroll
    for (int mt = 0; mt < 2; ++mt)
#pragma unroll
        for (int gq = 0; gq < 4; ++gq) { const f32x4 gn = *(const f32x4*)(F.ssd_gn() + L * 256 + h * 64 + 32 * mt + 8 * gq + 4 * hh);
            u32x2 w; w.x = pk2(Y[mt][4 * gq] * rs * gn[0], Y[mt][4 * gq + 1] * rs * gn[1]); w.y = pk2(Y[mt][4 * gq + 2] * rs * gn[2], Y[mt][4 * gq + 3] * rs * gn[3]);
            *(u32x2*)(mo + 32 * mt + 8 * gq) = w; }
    __syncthreads();
}
template <int KIND> __device__ __forceinline__ void attn_units(const Fr& F, int L) {
    if (KIND == 2) { const int nu = (L == DEPTH - 1) ? 512 : 576;
        for (int u = F.vcu; u < nu; u += F.G) { if (u < 512) attn_unit<2>(F, L, u >> 6, (u >> 4) & 3, u & 15); else attn_unit<2>(F, L, (u - 512) >> 3, ((u - 512) >> 1) & 3, -1 - (u & 1)); }
    } else { const int nu = (L == DEPTH - 1) ? 256 : 288;
        for (int u = F.vcu; u < nu; u += F.G) { if (u < 256) attn_unit<KIND>(F, L, u >> 5, (u >> 3) & 3, u & 7); else attn_unit<KIND>(F, L, (u - 256) >> 2, (u - 256) & 3, -1); } }
}
__device__ __forceinline__ void phase_mix_fast(const Fr& F, int L) {
#ifndef ATT_MASK
#define ATT_MASK 7
#endif
    if (ATT_MASK & 4) attn_units<2>(F, L); if (ATT_MASK & 2) attn_units<1>(F, L); if (ATT_MASK & 1) attn_units<0>(F, L);
    const int c0 = (L == DEPTH - 1) ? 4 : 0;
    for (int u = F.vcu; u < NB * (36 - c0); u += F.G) ssd_s3_unit(F, L, u / (36 - c0), c0 + u % (36 - c0));
}

__device__ __forceinline__ void phase_route(const Fr& F, int L) {
    const int nrows = (L == DEPTH - 1) ? NLAT : NROW;
    for (int r = F.gw; r < nrows; r += F.NGW) {
        const bool lat = r < NLAT; const int bb = lat ? (r >> 11) : 8;
        const float* hp = lat ? F.out() + (size_t)r * DM : F.hc() + (size_t)(r - NLAT) * DM;
        f32x4 v[4]; float ss = 0.f;
#pragma unroll
        for (int j = 0; j < 4; ++j) { v[j] = *(const f32x4*)(hp + 4 * F.lane + 256 * j); ss += (v[j][0] * v[j][0] + v[j][1] * v[j][1]) + (v[j][2] * v[j][2] + v[j][3] * v[j][3]); }
        const float rstd = rsqrtf(wsum(ss) * (1.f / DM) + EPS);
        const float* md = F.modv() + ((size_t)L * 9 + bb) * 6144;
        float lg[20];
#pragma unroll
        for (int o = 0; o < 20; ++o) lg[o] = 0.f;
#pragma unroll
        for (int j = 0; j < 4; ++j) { const int c = 4 * F.lane + 256 * j; const f32x4 g = *(const f32x4*)(F.g_ffn() + L * DM + c), sh = *(const f32x4*)(md + 3 * 1024 + c), scl = *(const f32x4*)(md + 4 * 1024 + c);
            const f32x4 f = v[j] * rstd * g * (scl + 1.f) + sh; u32x2 o2; o2.x = pk2(f[0], f[1]); o2.y = pk2(f[2], f[3]); *(u32x2*)(F.abuf() + (size_t)r * DM + c) = o2;
#pragma unroll
            for (int e = 0; e < 4; ++e) { const int k = c + e; const f32x4 wg = *(const f32x4*)(F.w_grp() + ((size_t)L * DM + k) * 4);
#pragma unroll
                for (int o = 0; o < 4; ++o) lg[o] += f[e] * wg[o];
#pragma unroll
                for (int q = 0; q < 4; ++q) { const f32x4 we = *(const f32x4*)(F.w_exp() + ((size_t)L * DM + k) * 16 + 4 * q);
#pragma unroll
                    for (int o = 0; o < 4; ++o) lg[4 + 4 * q + o] += f[e] * we[o]; } } }
#pragma unroll
        for (int o = 0; o < 20; ++o) lg[o] = wsum(lg[o]);
        if (F.lane == 0) {
            float gl[4]; float gm = -INFINITY; int gt = 0;
#pragma unroll
            for (int o = 0; o < 4; ++o) { gl[o] = lg[o] + F.b_grp()[L * 4 + o]; if (gl[o] > gm) { gm = gl[o]; gt = o; } }
            float gs = 0.f;
#pragma unroll
            for (int o = 0; o < 4; ++o) gs += expf(gl[o] - gm);
            const float gp = 1.f / gs;
            float el[4];
#pragma unroll
            for (int o = 0; o < 4; ++o) { float v4 = 0.f;
#pragma unroll
                for (int q = 0; q < 4; ++q) v4 = (gt == q) ? lg[4 + 4 * q + o] + F.b_exp()[L * 16 + 4 * q + o] : v4;
                el[o] = v4; }
            int i0 = 0; float m0 = el[0];
#pragma unroll
            for (int o = 1; o < 4; ++o) if (el[o] > m0) { m0 = el[o]; i0 = o; }
            int i1 = -1; float m1 = -INFINITY;
#pragma unroll
            for (int o = 0; o < 4; ++o) if (o != i0 && el[o] > m1) { m1 = el[o]; i1 = o; }
            const float e1 = expf(m1 - m0), w0 = gp / (1.f + e1), w1 = gp * e1 / (1.f + e1);
            const int x0 = gt * 4 + i0, x1 = gt * 4 + i1;
            F.rtw()[2 * r] = w0; F.rtw()[2 * r + 1] = w1;
            const unsigned p0 = atomicAdd(F.ctl() + CW_ECNT + (L * 16 + x0) * 64, 1u), p1 = atomicAdd(F.ctl() + CW_ECNT + (L * 16 + x1) * 64, 1u);
            F.elist()[x0 * NROW + p0] = 2 * r; F.elist()[x1 * NROW + p1] = 2 * r + 1;
        }
    }
}
__device__ __forceinline__ void moe_table(const Fr& F, int L) {
    volatile LAS int* T = (volatile LAS int*)(F.lds + LDSCTL_OFF + 64);
    volatile LAS int* Cn = (volatile LAS int*)(F.lds + LDSCTL_OFF + 160);
    __syncthreads();
    if (F.tid == 0) { int acc = 0;
        for (int e = 0; e < 16; ++e) { const int c = (int)__hip_atomic_load(F.ctl() + CW_ECNT + (L * 16 + e) * 64, __ATOMIC_RELAXED, __HIP_MEMORY_SCOPE_AGENT); T[e] = acc; Cn[e] = c; acc += (c + 255) >> 8; }
        T[16] = acc; }
    __syncthreads();
}

__global__ void __launch_bounds__(512, 2) fwd_kernel(Args args) {
    extern __shared__ __attribute__((aligned(16))) unsigned char lds_raw[];
    Fr F0;
    F0.lds = (LAS unsigned char*)lds_raw; F0.tid = threadIdx.x; F0.lane = F0.tid & 63; F0.wave = __builtin_amdgcn_readfirstlane(F0.tid >> 6);
    F0.G = gridDim.x; { const int bx = blockIdx.x; F0.vcu = (F0.G % 8 == 0) ? (bx % 8) * (F0.G / 8) + bx / 8 : bx; }
    F0.gw = F0.vcu * 8 + F0.wave; F0.NGW = F0.G * 8;
    F0.A = (const __attribute__((address_space(4))) Args*)__builtin_amdgcn_kernarg_segment_ptr();
    for (int u = F0.tid; u < (LDS_BYTES - LDSCTL_OFF) / 4; u += 512) ((LAS unsigned*)(F0.lds + LDSCTL_OFF))[u] = 0u;
    __syncthreads();
    const int lo = args.ph_lo, hi = args.ph_hi;
    XcdBarrier bar; bar.bar = F0.ctl() + CW_BAR; bar.x = 0; bar.st = nullptr;
    if (hi - lo > 1) bar = xcd_barrier_post(F0.ctl() + CW_BAR, (volatile LAS unsigned*)(F0.lds + LDSCTL_OFF));
#ifndef PH_MASK
#define PH_MASK 0xFFFF
#endif
#define PM(b) ((PH_MASK >> (b)) & 1)
#define IN(k) (lo <= (k) && (k) < hi)
#define SEAM(k) do { if (IN(k) && IN((k) + 1)) { const Fr Fb = refresh(F0); XcdBarrier b2 = bar; b2.bar = Fb.ctl() + CW_BAR; xcd_barrier(b2); } } while (0)

    if (PM(0) && IN(0)) { const Fr F = refresh(F0); phase_prologue(F); }
    SEAM(0);
    for (int L = 0; L < DEPTH; ++L) {
        const int pb = 1 + NPH_L * L;
        const bool lastL = (L == DEPTH - 1);
        if (PM(1) && IN(pb + 0)) { const Fr F = refresh(F0); phase_norm(F, L); moe_weight_convert(F, L); }
        SEAM(pb + 0);
        if (PM(2) && IN(pb + 1)) { const Fr F = refresh(F0); pg8::DenseSched S; S.init(F.abuf(), F.winT() + (size_t)L * NP * DM, DM, NROW, NP, F.G, (int)blockIdx.x); pg8::EpiP E{F.pbuf()}; pg8::gemm_phase(F.lds, F.tid, DM, S, E); }
        SEAM(pb + 1);
        if (PM(3) && IN(pb + 2)) { const Fr F = refresh(F0); phase_prep(F, L); }
        SEAM(pb + 2);
        if (PM(4) && IN(pb + 3)) { const Fr F = refresh(F0); phase_ssd_s1(F, L); }
        SEAM(pb + 3);
        if (PM(4) && IN(pb + 4)) { const Fr F = refresh(F0); phase_ssd_scan(F, L); }
        SEAM(pb + 4);
        if (PM(5) && IN(pb + 5)) { const Fr F = refresh(F0); phase_mix_fast(F, L); }
        SEAM(pb + 5);
        if (PM(6) && IN(pb + 6)) { const Fr F = refresh(F0); pg8::DenseSched S; S.init(F.mix(), F.woutT() + (size_t)L * DM * DM, DM, lastL ? NLAT : NROW, DM, F.G, (int)blockIdx.x);
            pg8::EpiRes E{L == 0 ? F.x() : F.out(), L == 0 ? F.ctx() : F.hc(), F.out(), F.hc(), F.modv() + (size_t)L * 9 * 6144 + 2 * 1024}; pg8::gemm_phase(F.lds, F.tid, DM, S, E); }
        SEAM(pb + 6);
        if (PM(7) && IN(pb + 7)) { const Fr F = refresh(F0); phase_route(F, L); }
        SEAM(pb + 7);
        if (PM(8) && IN(pb + 8)) { const Fr F = refresh(F0); moe_table(F, L);
            pg8::MoeSched<true> S{(const char*)F.abuf(), (const char*)F.wgu(), (size_t)1024 * DM * 2, DM, F.G, F.vcu, F.elist(), (const volatile LAS int*)(F.lds + LDSCTL_OFF + 64), (const volatile LAS int*)(F.lds + LDSCTL_OFF + 160)};
            pg8::EpiAct E{F.act()}; pg8::gemm_phase(F.lds, F.tid, DM, S, E); }
        SEAM(pb + 8);
        if (PM(9) && IN(pb + 9)) { const Fr F = refresh(F0); moe_table(F, L);
            pg8::MoeSched<false> S{(const char*)F.act(), (const char*)F.wd(), (size_t)1024 * FF * 2, FF, F.G, F.vcu, F.elist(), (const volatile LAS int*)(F.lds + LDSCTL_OFF + 64), (const volatile LAS int*)(F.lds + LDSCTL_OFF + 160)};
            pg8::EpiDown E{F.yk(), F.elist(), F.rtw()}; pg8::gemm_phase(F.lds, F.tid, FF, S, E); }
        SEAM(pb + 9);
    }
    if (PM(1) && IN(PH_FINAL)) { const Fr F = refresh(F0); phase_norm(F, DEPTH); }
#undef IN
#undef SEAM
}

extern "C" void kernel_launch(void* const* d_in, const int* in_sizes, int n_in, void* d_out, int out_size, void* d_ws, size_t ws_size, hipStream_t stream) {
    static int grid = 0;
    if (grid == 0) {
        if (n_in != 36 || out_size != NLAT * DM || ws_size < WS_END) { fprintf(stderr, "kernel_launch: unexpected shapes (n_in %d out %d ws %zu)\n", n_in, out_size, ws_size); grid = -1; return; }
        int dev = 0, cus = 0, per_cu = 0;
        if (hipGetDevice(&dev) != hipSuccess || hipDeviceGetAttribute(&cus, hipDeviceAttributeMultiprocessorCount, dev) != hipSuccess) { grid = -1; return; }
        if (hipFuncSetAttribute((const void*)fwd_kernel, hipFuncAttributeMaxDynamicSharedMemorySize, LDS_BYTES) != hipSuccess) { fprintf(stderr, "kernel_launch: hipFuncSetAttribute failed\n"); grid = -1; return; }
        if (hipOccupancyMaxActiveBlocksPerMultiprocessor(&per_cu, (const void*)fwd_kernel, 512, LDS_BYTES) != hipSuccess || per_cu < 1) { fprintf(stderr, "kernel_launch: occupancy query says %d\n", per_cu); }
        (void)hipGetLastError();
        grid = cus;
    }
    if (grid < 0) return;
    (void)hipMemsetAsync((char*)d_ws + WS_CTL, 0, CTL_BYTES, stream);
    Args a{};
    for (int i = 0; i < 36; ++i) a.in[i] = (const float*)d_in[i];
    a.out = (float*)d_out; a.ws = (unsigned char*)d_ws;
#if MK_ONE_LAUNCH
    a.ph_lo = 0; a.ph_hi = NPHASE;
    hipLaunchKernelGGL(fwd_kernel, dim3(grid), dim3(512), LDS_BYTES, stream, a);
#else
    for (int ph = 0; ph < NPHASE; ++ph) { a.ph_lo = ph; a.ph_hi = ph + 1; hipLaunchKernelGGL(fwd_kernel, dim3(grid), dim3(512), LDS_BYTES, stream, a); }
#endif
}
```

```cpp
#include <hip/hip_runtime.h>
#include <cstdio>
#include <cstdint>

#ifndef MK_ONE_LAUNCH
#define MK_ONE_LAUNCH 1
#endif

#define LAS __attribute__((address_space(3)))
typedef unsigned short bf16;
typedef short bf16x8 __attribute__((ext_vector_type(8)));
typedef float f32x4 __attribute__((ext_vector_type(4)));
typedef float f32x2 __attribute__((ext_vector_type(2)));
typedef unsigned u32x4 __attribute__((ext_vector_type(4)));
typedef unsigned u32x2 __attribute__((ext_vector_type(2)));

constexpr int NB = 8, TLAT = 2048, TCTX = 256, SQ = 2304, DM = 1024, DEPTH = 4;
constexpr int NLAT = NB * TLAT, NCTXR = NB * TCTX, NROW = NLAT + NCTXR;
constexpr int NIN = 2984, NP = 3072;
constexpr int C_NA = 0, C_MLA = 768, C_DF = 1184, C_SSD = 1952;
constexpr int C_Z = C_SSD, C_XBC = C_SSD + 256, C_DT = C_SSD + 1024;
constexpr float EPS = 1e-6f;
constexpr int NEXP = 16, FF = 512, ACT_ROWS = 40960;
constexpr int NPH_L = 10, PH_FINAL = 1 + NPH_L * DEPTH, NPHASE = PH_FINAL + 1;

constexpr size_t MiB = 1u << 20;
constexpr size_t WS_CTL = 0, CTL_BYTES = 1 * MiB;
constexpr size_t WS_MOD = 1 * MiB;
constexpr size_t WS_ROPE = 2 * MiB;
constexpr size_t WS_WIN = 4 * MiB;
constexpr size_t WS_WOUT = 28 * MiB;
constexpr size_t WS_WQB = 36 * MiB;
constexpr size_t WS_WKVB = 37 * MiB;
constexpr size_t WS_WGU = 38 * MiB;
constexpr size_t WS_WD = 70 * MiB;
constexpr size_t WS_HC = 86 * MiB;
constexpr size_t WS_A = 94 * MiB;
constexpr size_t WS_P = 130 * MiB;
constexpr size_t WS_ACT = 130 * MiB;
constexpr size_t WS_YK = 170 * MiB;
constexpr size_t WS_MIX = 238 * MiB;
constexpr size_t WS_QNA = 274 * MiB, WS_KNA = 283 * MiB, WS_VNA = 292 * MiB;
constexpr size_t WS_QML = 301 * MiB, WS_KML = 315 * MiB, WS_VML = 329 * MiB;
constexpr size_t WS_QDF = 338 * MiB, WS_KDF = 347 * MiB, WS_VDF = 356 * MiB;
constexpr size_t WS_XT = 365 * MiB, WS_BTM = 374 * MiB, WS_BT = 383 * MiB, WS_CTM = 392 * MiB;
constexpr size_t WS_DT = 401 * MiB;
constexpr size_t WS_CST = 402 * MiB;
constexpr size_t WS_CDEC = 474 * MiB;
constexpr size_t WS_HENT = 475 * MiB;
constexpr size_t WS_RT = 511 * MiB;
constexpr size_t WS_ELIST = 512 * MiB;
constexpr size_t WS_END = 514 * MiB;
constexpr int CW_BAR = 4096;
constexpr int CW_ECNT = 16384;
constexpr int CW_QUEUE = 32768;

constexpr int RING_BYTES = 131072, LDSCTL_OFF = RING_BYTES, LDS_BYTES = 147456;

typedef float f32x16 __attribute__((ext_vector_type(16)));
#define MFMA32(a, b, c) __builtin_amdgcn_mfma_f32_32x32x16_bf16((a), (b), (c), 0, 0, 0)
__device__ __forceinline__ int crow16(int reg, int hh) { return (reg & 3) + 8 * (reg >> 2) + 4 * hh; }
__device__ __forceinline__ float bf2f(bf16 v) { return __uint_as_float(((unsigned)v) << 16); }
__device__ __forceinline__ bf16 f2bf(float f) { unsigned u = __float_as_uint(f); return (bf16)((u + 0x7fffu + ((u >> 16) & 1u)) >> 16); }
__device__ __forceinline__ unsigned pk2(float lo, float hi) { return (unsigned)f2bf(lo) | ((unsigned)f2bf(hi) << 16); }
template <int CTRL> __device__ __forceinline__ float dppf(float v) { return __int_as_float(__builtin_amdgcn_update_dpp(0, __float_as_int(v), CTRL, 0xF, 0xF, true)); }
__device__ __forceinline__ float rlane(float v, int l) { return __int_as_float(__builtin_amdgcn_readlane(__float_as_int(v), l)); }
__device__ __forceinline__ float wsum(float v) {
    v += dppf<0xB1>(v); v += dppf<0x4E>(v); v += dppf<0x141>(v); v += dppf<0x140>(v);
    return (rlane(v, 0) + rlane(v, 16)) + (rlane(v, 32) + rlane(v, 48)); }
__device__ __forceinline__ float wmaxf(float v) {
    v = fmaxf(v, dppf<0xB1>(v)); v = fmaxf(v, dppf<0x4E>(v)); v = fmaxf(v, dppf<0x141>(v)); v = fmaxf(v, dppf<0x140>(v));
    return fmaxf(fmaxf(rlane(v, 0), rlane(v, 16)), fmaxf(rlane(v, 32), rlane(v, 48))); }
#define LDS_WAIT() asm volatile("s_waitcnt lgkmcnt(0)" ::: "memory")
__device__ __forceinline__ void row2bs(int r, int& b, int& s) { if (r < NLAT) { b = r >> 11; s = 256 + (r & 2047); } else { const int j = r - NLAT; b = j >> 8; s = j & 255; } }
__device__ __forceinline__ int bs2row(int b, int s) { return s < 256 ? NLAT + b * 256 + s : b * 2048 + s - 256; }
__device__ __forceinline__ int vpos(int s) { return (s & ~12) | ((s & 4) << 1) | ((s & 8) >> 1); }
__device__ __forceinline__ float siluf(float x) { return x / (1.f + __expf(-x)); }

#define XB_TMO      128
#define XB_XCNT(j)  (256  + 64 * (j))
#define XB_XSUB(j)  (1280 + 64 * (j))
#define XB_XGEN(j)  (2304 + 64 * (j))
#define XB_TOP      3328
#define XB_TOPGEN   3392
#define XCD_BAR_WORDS 3456
#define XB_SPIN_CAP (1u << 24)
__device__ __forceinline__ unsigned xb_ld(unsigned* p)              { return __hip_atomic_load(p, __ATOMIC_RELAXED, __HIP_MEMORY_SCOPE_AGENT); }
__device__ __forceinline__ unsigned xb_add(unsigned* p, unsigned v) { return __hip_atomic_fetch_add(p, v, __ATOMIC_RELAXED, __HIP_MEMORY_SCOPE_AGENT); }
__device__ __forceinline__ unsigned xb_xcc_id() { return (unsigned)__builtin_amdgcn_s_getreg((3 << 11) | 20) & 0xFu; }
#define XB_SPIN(cond, bar) do { unsigned _sp = 0; while (cond) { __builtin_amdgcn_s_sleep(1); \
    if ((++_sp & 255u) == 0u) { if (xb_ld(&(bar)[XB_TMO])) break; if (_sp > XB_SPIN_CAP) { atomicAdd(&(bar)[XB_TMO], 1u); break; } } } } while (0)
struct XcdBarrier { unsigned* bar; unsigned x; volatile LAS unsigned* st; };
__device__ __forceinline__ XcdBarrier xcd_barrier_post(unsigned* bar, volatile LAS unsigned* st) {
    XcdBarrier b; b.bar = bar; b.x = xb_xcc_id(); b.st = st;
    if (threadIdx.x == 0) (void)xb_add(&bar[XB_XCNT(b.x)], 1u);
    return b;
}
__device__ __forceinline__ void xcd_barrier_complete(unsigned* bar, unsigned x, unsigned& nloc, unsigned& nx) {
    const unsigned G = gridDim.x * gridDim.y * gridDim.z;
    unsigned sum, cnt, mine, sp = 0u;
    for (;;) {
        sum = 0u; cnt = 0u; mine = 0u;
#pragma unroll
        for (unsigned j = 0; j < 16; ++j) { const unsigned c = xb_ld(&bar[XB_XCNT(j)]); sum += c; cnt += (c > 0u) ? 1u : 0u; mine = (j == x) ? c : mine; }
        if (sum == G) break;
        __builtin_amdgcn_s_sleep(1);
        if ((++sp & 255u) == 0u) { if (xb_ld(&bar[XB_TMO])) break; if (sp > XB_SPIN_CAP) { atomicAdd(&bar[XB_TMO], 1u); break; } }
    }
    nloc = mine > 0u ? mine : 1u; nx = cnt > 0u ? cnt : 1u;
}
__device__ __forceinline__ void xcd_barrier(const XcdBarrier& b) {
    asm volatile("s_waitcnt vmcnt(0)" ::: "memory");
    __syncthreads();
    if (threadIdx.x == 0) {
        unsigned* bar = b.bar;
        __builtin_amdgcn_s_waitcnt(0);
        unsigned nloc = b.st[0], nx = b.st[1];
        if (nloc == 0u) { xcd_barrier_complete(bar, b.x, nloc, nx); b.st[0] = nloc; b.st[1] = nx; }
        const unsigned old = xb_add(&bar[XB_XSUB(b.x)], 1u);
        const unsigned gen = old / nloc;
        if (old + 1u == (gen + 1u) * nloc) {
            __builtin_amdgcn_fence(__ATOMIC_RELEASE, "agent");
            asm volatile("s_waitcnt vmcnt(0)" ::: "memory");
            const unsigned og = xb_add(&bar[XB_TOP], 1u);
            const unsigned tg = og / nx;
            if (og + 1u == (tg + 1u) * nx) xb_add(&bar[XB_TOPGEN], 1u);
            else XB_SPIN(xb_ld(&bar[XB_TOPGEN]) == tg, bar);
            __builtin_amdgcn_fence(__ATOMIC_ACQUIRE, "agent");
            xb_add(&bar[XB_XGEN(b.x)], 1u);
            asm volatile("s_waitcnt vmcnt(0)" ::: "memory");
        } else {
            XB_SPIN(xb_ld(&bar[XB_XGEN(b.x)]) == gen, bar);
            __builtin_amdgcn_fence(__ATOMIC_ACQUIRE, "agent");
            asm volatile("s_waitcnt vmcnt(0)" ::: "memory");
        }
    }
    __syncthreads();
}

namespace pg8 {
constexpr int BM = 256, BK = 64, HALF = 128, HTB = HALF * BK * 2, NXCD = 8, WGM = 8;
__device__ __forceinline__ int lds_byte(int r, int c) { const int st = (r >> 4) * 2 + (c >> 5), rr = r & 15, cc = c & 31, ob = rr * 64 + cc * 2; return st * 1024 + (ob ^ (((ob >> 9) & 1) << 5)); }
__device__ __forceinline__ void stage_rc(int b, int& R, int& C) { const int st = b / 1024, sb = b % 1024, swz = sb ^ (((sb >> 9) & 1) << 5); R = (st >> 1) * 16 + swz / 64; C = (st & 1) * 32 + (swz % 64) / 2; }
__device__ __forceinline__ int perm32(int rho) { const int n = rho >> 4, i = rho & 15; return 8 * (i >> 2) + 4 * n + (i & 3); }
struct Unit { int pm, pn, e, j, cnt; };

template <class Epi, class Sched>
__device__ __forceinline__ void gemm_phase(LAS unsigned char* lds, const int tid, const int K, const Sched& S, const Epi& E) {
    const int wid = __builtin_amdgcn_readfirstlane(tid >> 6), lane = tid & 63, wr = wid >> 2, wc = wid & 3, fr = lane & 15, fq = lane >> 4;
    const int nt = K / BK;
    int Rr[2]; unsigned Cb[2], voffB[2];
#pragma unroll
    for (int i = 0; i < 2; ++i) { int R, C; stage_rc(tid * 16 + i * 8192, R, C); const int Rb = Epi::PERM ? ((R & ~31) + perm32(R & 31)) : R;
        Rr[i] = R; Cb[i] = (unsigned)C * 2u; voffB[i] = (unsigned)(Rb * K + C) * 2u; }
    const size_t kstep = (size_t)(BK * 2);
    const size_t hstep = (size_t)HALF * K * 2;
    const unsigned ldsw = (unsigned)wid * 1024u;
    const int aoff = lds_byte(wr * 64 + fr, fq * 8), boff = lds_byte(wc * 32 + fr, fq * 8);
#define PG8_SA(b, h) (((b) * 2 + (h)) * HTB)
#define PG8_SB(b, h) ((4 + (b) * 2 + (h)) * HTB)
#define PG8_STAGE(bufoff, gbase, voff) do { _Pragma("unroll") for (int _i = 0; _i < 2; ++_i) \
        __builtin_amdgcn_global_load_lds((const unsigned*)((const char*)(gbase) + (voff)[_i]), (LAS unsigned*)(lds + (bufoff) + ldsw + _i * 8192), 16, 0, 0); } while (0)
#define PG8_LDA(dst, b, h) do { _Pragma("unroll") for (int m = 0; m < 4; ++m) _Pragma("unroll") for (int k = 0; k < 2; ++k) dst[m][k] = *(const LAS bf16x8*)(lds + PG8_SA(b, h) + aoff + m * 2048 + k * 1024); } while (0)
#define PG8_LDB(dst, b, h) do { _Pragma("unroll") for (int n = 0; n < 2; ++n) _Pragma("unroll") for (int k = 0; k < 2; ++k) dst[n][k] = *(const LAS bf16x8*)(lds + PG8_SB(b, h) + boff + n * 2048 + k * 1024); } while (0)
#define PG8_MMA(ai, bj, At, Bt) do { __builtin_amdgcn_s_setprio(1); _Pragma("unroll") for (int m = 0; m < 4; ++m) _Pragma("unroll") for (int n = 0; n < 2; ++n) _Pragma("unroll") for (int k = 0; k < 2; ++k) \
        acc[ai][bj][m][n] = __builtin_amdgcn_mfma_f32_16x16x32_bf16(Bt[n][k], At[m][k], acc[ai][bj][m][n], 0, 0, 0); __builtin_amdgcn_s_setprio(0); } while (0)
#define PG8_WAIT_V(n) asm volatile("s_waitcnt vmcnt(" #n ")" ::: "memory")
#define PG8_WAIT_L(n) asm volatile("s_waitcnt lgkmcnt(" #n ")" ::: "memory")
#define PG8_BAR __builtin_amdgcn_s_barrier()
#define PG8_SCHED __builtin_amdgcn_sched_barrier(0)
    Unit cur, nxt; int ui = 0;
    if (!S.next(0, cur)) return;
    f32x4 acc[2][2][4][2];
#pragma unroll
    for (int a = 0; a < 2; ++a)
#pragma unroll
        for (int b = 0; b < 2; ++b)
#pragma unroll
            for (int m = 0; m < 4; ++m)
#pragma unroll
                for (int n = 0; n < 2; ++n) acc[a][b][m][n] = (f32x4){0.f, 0.f, 0.f, 0.f};
    bf16x8 At[4][2], B0[2][2], B1[2][2];
    unsigned vA0[2], vA1[2];
    const char* cA = S.a_ptr(cur);
    if constexpr (Sched::GATHER) { S.a_offs(cur, Rr, vA0, vA1);
#pragma unroll
        for (int i = 0; i < 2; ++i) { vA0[i] += Cb[i]; vA1[i] += Cb[i]; }
        asm volatile("s_waitcnt vmcnt(0)" ::: "memory");
    } else {
#pragma unroll
        for (int i = 0; i < 2; ++i) { vA0[i] = (unsigned)(Rr[i] * K * 2) + Cb[i]; vA1[i] = vA0[i]; } }
    const size_t ahs = Sched::GATHER ? (size_t)0 : hstep;
    const char* cB = S.b_ptr(cur);
    PG8_STAGE(PG8_SB(0, 0), cB, voffB); PG8_STAGE(PG8_SB(0, 1), cB + hstep, voffB); PG8_STAGE(PG8_SA(0, 0), cA, vA0); PG8_STAGE(PG8_SA(0, 1), cA + ahs, vA1);
    if (wr == 1) PG8_BAR;
    PG8_WAIT_V(2); PG8_BAR;
    PG8_STAGE(PG8_SB(1, 0), cB + kstep, voffB); PG8_STAGE(PG8_SA(1, 0), cA + kstep, vA0); PG8_STAGE(PG8_SB(1, 1), cB + hstep + kstep, voffB);
    PG8_WAIT_V(6); PG8_BAR;
    for (;;) {
        const bool has_next = S.next(ui + 1, nxt);
        const char* nA = has_next ? S.a_ptr(nxt) : cA; const char* nB = has_next ? S.b_ptr(nxt) : cB;
        for (int t = 0; t < nt; t += 2) {
            const bool last = (t == nt - 2);
            const char* a1 = cA + (size_t)(t + 1) * kstep;
            const char* a2 = last ? nA : cA + (size_t)(t + 2) * kstep; const char* b2 = last ? nB : cB + (size_t)(t + 2) * kstep;
            const char* a3 = a2 + kstep; const char* b3 = b2 + kstep;
            PG8_LDB(B0, 0, 0); PG8_LDB(B1, 0, 1); PG8_SCHED; PG8_LDA(At, 0, 0); PG8_STAGE(PG8_SA(1, 1), a1 + ahs, vA1);
            if constexpr (Sched::GATHER) { if (last && has_next) { S.a_offs(nxt, Rr, vA0, vA1);
#pragma unroll
                for (int i = 0; i < 2; ++i) { vA0[i] += Cb[i]; vA1[i] += Cb[i]; }
                asm volatile("s_waitcnt vmcnt(0)" ::: "memory"); } }
            PG8_WAIT_V(8); PG8_WAIT_L(0); PG8_BAR; PG8_MMA(0, 0, At, B0); PG8_MMA(0, 1, At, B1); PG8_BAR; PG8_SCHED;
            PG8_LDA(At, 0, 1); PG8_STAGE(PG8_SB(0, 0), b2, voffB); PG8_STAGE(PG8_SB(0, 1), b2 + hstep, voffB); PG8_STAGE(PG8_SA(0, 0), a2, vA0);
            PG8_WAIT_V(8); PG8_WAIT_L(0); PG8_BAR; PG8_MMA(1, 0, At, B0); PG8_MMA(1, 1, At, B1); PG8_BAR; PG8_SCHED;
            PG8_LDB(B0, 1, 0); PG8_LDB(B1, 1, 1); PG8_SCHED; PG8_LDA(At, 1, 0); PG8_STAGE(PG8_SA(0, 1), a2 + ahs, vA1);
            PG8_WAIT_V(8); PG8_WAIT_L(0); PG8_BAR; PG8_MMA(0, 0, At, B0); PG8_MMA(0, 1, At, B1); PG8_BAR; PG8_SCHED;
            PG8_LDA(At, 1, 1); PG8_STAGE(PG8_SB(1, 0), b3, voffB); PG8_STAGE(PG8_SB(1, 1), b3 + hstep, voffB); PG8_STAGE(PG8_SA(1, 0), a3, vA0);
            PG8_WAIT_V(8); PG8_WAIT_L(0); PG8_BAR; PG8_MMA(1, 0, At, B0); PG8_MMA(1, 1, At, B1); PG8_BAR; PG8_SCHED;
        }
        if (wr == 0) PG8_BAR;
        E(acc, cur, wr, wc, fr, fq);
        if (!has_next) break;
#pragma unroll
        for (int a = 0; a < 2; ++a)
#pragma unroll
            for (int b = 0; b < 2; ++b)
#pragma unroll
                for (int m = 0; m < 4; ++m)
#pragma unroll
                    for (int n = 0; n < 2; ++n) acc[a][b][m][n] = (f32x4){0.f, 0.f, 0.f, 0.f};
        cur = nxt; cA = nA; cB = nB; ++ui;
        if (wr == 1) PG8_BAR;
    }
    PG8_WAIT_V(0);
    PG8_BAR;
#undef PG8_SA
#undef PG8_SB
#undef PG8_STAGE
#undef PG8_LDA
#undef PG8_LDB
#undef PG8_MMA
#undef PG8_WAIT_V
#undef PG8_WAIT_L
#undef PG8_BAR
#undef PG8_SCHED
}
__device__ __forceinline__ unsigned cvt_pk_bf16(float lo, float hi) { unsigned r; asm volatile("v_cvt_pk_bf16_f32 %0, %1, %2" : "=v"(r) : "v"(lo), "v"(hi)); return r; }

struct DenseSched {
    const char* A; const char* Bt; int K, nM, nN, nwg, G, c;
    __device__ void init(const void* A_, const void* Bt_, int K_, int M, int N, int G_, int c_) { A = (const char*)A_; Bt = (const char*)Bt_; K = K_; nM = M / BM; nN = N / BM; nwg = nM * nN; G = G_; c = c_; }
    __device__ __forceinline__ bool next(int i, Unit& u) const {
        const long L = (long)i * G + c; if (L >= nwg) return false;
        int wgid = (int)L; { const int q = nwg / NXCD, r = nwg % NXCD, xcd = wgid % NXCD, off = wgid / NXCD; wgid = (xcd < r ? xcd * (q + 1) : r * (q + 1) + (xcd - r) * q) + off; }
        const int nig = WGM * nN, gid = wgid / nig, fm = gid * WGM, gsz = (nM - fm) < WGM ? (nM - fm) : WGM;
        u.pm = fm + ((wgid % nig) % gsz); u.pn = (wgid % nig) / gsz; u.e = 0; u.j = 0; u.cnt = 256; return true;
    }
    static constexpr bool GATHER = false;
    __device__ __forceinline__ const char* a_ptr(const Unit& u) const { return A + (size_t)u.pm * BM * K * 2; }
    __device__ __forceinline__ void a_offs(const Unit&, const int (&)[2], unsigned (&)[2], unsigned (&)[2]) const {}
    __device__ __forceinline__ const char* b_ptr(const Unit& u) const { return Bt + (size_t)u.pn * BM * K * 2; }
};
template <bool GATHER_> struct MoeSched {
    static constexpr bool GATHER = GATHER_;
    const char* A; const char* W; size_t wstride; int K, G, c; const int* elist; const volatile LAS int* T; const volatile LAS int* Cn;
    __device__ __forceinline__ bool next(int i, Unit& u) const {
        const long L = (long)i * G + c; const int nT = T[16]; if (L >= 4L * nT) return false;
        const int tile = (int)(L >> 2); u.pn = (int)(L & 3); u.pm = tile;
        int e = 0;
#pragma unroll
        for (int k = 1; k < 16; ++k) e += (tile >= T[k]) ? 1 : 0;
        u.e = e; u.j = tile - T[e]; u.cnt = Cn[e]; return true;
    }
    __device__ __forceinline__ const char* a_ptr(const Unit& u) const { return GATHER ? A : A + (size_t)u.pm * BM * K * 2; }
    __device__ __forceinline__ void a_offs(const Unit& u, const int (&Rr)[2], unsigned (&v0)[2], unsigned (&v1)[2]) const {
#pragma unroll
        for (int i = 0; i < 2; ++i) {
            const int p0 = u.j * BM + Rr[i], p1 = p0 + HALF;
            int t0 = p0 < u.cnt ? (elist[u.e * NROW + p0] >> 1) : 0, t1 = p1 < u.cnt ? (elist[u.e * NROW + p1] >> 1) : 0;
            t0 = min(max(t0, 0), NROW - 1); t1 = min(max(t1, 0), NROW - 1);
            v0[i] = (unsigned)(t0 * K * 2); v1[i] = (unsigned)(t1 * K * 2);
        } }
    __device__ __forceinline__ const char* b_ptr(const Unit& u) const { return W + (size_t)u.e * wstride + (size_t)u.pn * BM * K * 2; }
};
struct EpiP {
    static constexpr bool PERM = true;
    bf16* O;
    __device__ __forceinline__ void operator()(const f32x4 (&acc)[2][2][4][2], const Unit& u, int wr, int wc, int fr, int fq) const {
        const int row0 = u.pm * BM + wr * 64 + fr, col0 = u.pn * BM + wc * 32 + 8 * fq;
#pragma unroll
        for (int ai = 0; ai < 2; ++ai)
#pragma unroll
            for (int m = 0; m < 4; ++m) { bf16* rowp = O + (size_t)(row0 + ai * HALF + m * 16) * NP + col0;
#pragma unroll
                for (int bj = 0; bj < 2; ++bj) { const f32x4 v0 = acc[ai][bj][m][0], v1 = acc[ai][bj][m][1];
                    u32x4 w; w.x = cvt_pk_bf16(v0[0], v0[1]); w.y = cvt_pk_bf16(v0[2], v0[3]); w.z = cvt_pk_bf16(v1[0], v1[1]); w.w = cvt_pk_bf16(v1[2], v1[3]);
                    *(u32x4*)(rowp + bj * HALF) = w; } }
    }
};
struct EpiRes {
    static constexpr bool PERM = false;
    const float* hin_l; const float* hin_c; float* hout_l; float* hout_c; const float* gate; float gsc;
    __device__ __forceinline__ void operator()(const f32x4 (&acc)[2][2][4][2], const Unit& u, int wr, int wc, int fr, int fq) const {
        const int row0 = u.pm * BM + wr * 64 + fr, col0 = u.pn * BM + wc * 32 + 4 * fq;
#pragma unroll
        for (int ai = 0; ai < 2; ++ai)
#pragma unroll
            for (int m = 0; m < 4; ++m) { const int r = row0 + ai * HALF + m * 16; const bool lat = r < NLAT; const int bb = lat ? (r >> 11) : 8;
                const float* hi = lat ? hin_l + (size_t)r * DM : hin_c + (size_t)(r - NLAT) * DM; float* ho = lat ? hout_l + (size_t)r * DM : hout_c + (size_t)(r - NLAT) * DM;
                const float* g = gate + (size_t)bb * 6144;
#pragma unroll
                for (int bj = 0; bj < 2; ++bj)
#pragma unroll
                    for (int n = 0; n < 2; ++n) { const int c = col0 + bj * HALF + n * 16; const f32x4 gv = *(const f32x4*)(g + c), hv = *(const f32x4*)(hi + c);
                        *(f32x4*)(ho + c) = hv + gv * gsc * acc[ai][bj][m][n]; } }
    }
};
struct EpiAct {
    static constexpr bool PERM = true;
    bf16* O;
    __device__ __forceinline__ void operator()(const f32x4 (&acc)[2][2][4][2], const Unit& u, int wr, int wc, int fr, int fq) const {
        const int row0 = u.pm * BM + wr * 64 + fr, col0 = u.pn * HALF + wc * 32 + 8 * fq;
#pragma unroll
        for (int ai = 0; ai < 2; ++ai)
#pragma unroll
            for (int m = 0; m < 4; ++m) { bf16* rowp = O + (size_t)(row0 + ai * HALF + m * 16) * FF + col0;
                float o[8];
#pragma unroll
                for (int n = 0; n < 2; ++n)
#pragma unroll
                    for (int j = 0; j < 4; ++j) { const float g = acc[ai][0][m][n][j], up = acc[ai][1][m][n][j]; o[n * 4 + j] = g / (1.f + __expf(-g)) * up; }
                u32x4 w; w.x = cvt_pk_bf16(o[0], o[1]); w.y = cvt_pk_bf16(o[2], o[3]); w.z = cvt_pk_bf16(o[4], o[5]); w.w = cvt_pk_bf16(o[6], o[7]);
                *(u32x4*)rowp = w; }
    }
};
struct EpiDown {
    static constexpr bool PERM = true;
    bf16* O; const int* elist; const float* rtw;
    __device__ __forceinline__ void operator()(const f32x4 (&acc)[2][2][4][2], const Unit& u, int wr, int wc, int fr, int fq) const {
        const int col0 = u.pn * BM + wc * 32 + 8 * fq;
#pragma unroll
        for (int ai = 0; ai < 2; ++ai)
#pragma unroll
            for (int m = 0; m < 4; ++m) { const int pos = u.j * BM + ai * HALF + wr * 64 + m * 16 + fr;
                if (pos < u.cnt) { const int a = min(max(elist[u.e * NROW + pos], 0), 2 * NROW - 1); const float w8 = rtw[a]; bf16* rowp = O + (size_t)a * DM + col0;
#pragma unroll
                    for (int bj = 0; bj < 2; ++bj) { const f32x4 v0 = acc[ai][bj][m][0] * w8, v1 = acc[ai][bj][m][1] * w8;
                        u32x4 w; w.x = cvt_pk_bf16(v0[0], v0[1]); w.y = cvt_pk_bf16(v0[2], v0[3]); w.z = cvt_pk_bf16(v1[0], v1[1]); w.w = cvt_pk_bf16(v1[2], v1[3]);
                        *(u32x4*)(rowp + bj * HALF) = w; } } }
    }
};
}

struct Args { const float* in[36]; float* out; unsigned char* ws; int ph_lo, ph_hi; };
struct Fr {
    LAS unsigned char* lds; int tid, lane, wave, G, vcu, gw, NGW; const __attribute__((address_space(4))) Args* A;
    __device__ __forceinline__ const float* x() const { return A->in[0]; }
    __device__ __forceinline__ const float* cvec() const { return A->in[1]; }
    __device__ __forceinline__ const float* ctx() const { return A->in[2]; }
    __device__ __forceinline__ const float* cctx() const { return A->in[3]; }
    __device__ __forceinline__ const float* w_mod() const { return A->in[4]; }
    __device__ __forceinline__ const float* b_mod() const { return A->in[5]; }
    __device__ __forceinline__ const float* g_mix() const { return A->in[6]; }
    __device__ __forceinline__ const float* w_in() const { return A->in[7]; }
    __device__ __forceinline__ const float* w_out() const { return A->in[8]; }
    __device__ __forceinline__ const float* na_gq() const { return A->in[9]; }
    __device__ __forceinline__ const float* na_gk() const { return A->in[10]; }
    __device__ __forceinline__ const float* na_rb() const { return A->in[11]; }
    __device__ __forceinline__ const float* mla_gqa() const { return A->in[12]; }
    __device__ __forceinline__ const float* mla_wqb() const { return A->in[13]; }
    __device__ __forceinline__ const float* mla_gkva() const { return A->in[14]; }
    __device__ __forceinline__ const float* mla_wkvb() const { return A->in[15]; }
    __device__ __forceinline__ const float* mla_gq() const { return A->in[16]; }
    __device__ __forceinline__ const float* mla_gk() const { return A->in[17]; }
    __device__ __forceinline__ const float* df_gq() const { return A->in[18]; }
    __device__ __forceinline__ const float* df_gk() const { return A->in[19]; }
    __device__ __forceinline__ const float* df_lam() const { return A->in[20]; }
    __device__ __forceinline__ const float* df_gsub() const { return A->in[21]; }
    __device__ __forceinline__ const float* conv_w() const { return A->in[22]; }
    __device__ __forceinline__ const float* conv_b() const { return A->in[23]; }
    __device__ __forceinline__ const float* dt_bias() const { return A->in[24]; }
    __device__ __forceinline__ const float* a_log() const { return A->in[25]; }
    __device__ __forceinline__ const float* ssd_d() const { return A->in[26]; }
    __device__ __forceinline__ const float* ssd_gn() const { return A->in[27]; }
    __device__ __forceinline__ const float* g_ffn() const { return A->in[28]; }
    __device__ __forceinline__ const float* w_grp() const { return A->in[29]; }
    __device__ __forceinline__ const float* b_grp() const { return A->in[30]; }
    __device__ __forceinline__ const float* w_exp() const { return A->in[31]; }
    __device__ __forceinline__ const float* b_exp() const { return A->in[32]; }
    __device__ __forceinline__ const float* w_gate() const { return A->in[33]; }
    __device__ __forceinline__ const float* w_up() const { return A->in[34]; }
    __device__ __forceinline__ const float* w_down() const { return A->in[35]; }
    __device__ __forceinline__ float* out() const { return A->out; }
    __device__ __forceinline__ unsigned* ctl() const { return (unsigned*)(A->ws + WS_CTL); }
    __device__ __forceinline__ float* modv() const { return (float*)(A->ws + WS_MOD); }
    __device__ __forceinline__ float* rcos() const { return (float*)(A->ws + WS_ROPE); }
    __device__ __forceinline__ float* rsin() const { return (float*)(A->ws + WS_ROPE + TLAT * 16 * 4); }
    __device__ __forceinline__ bf16* winT() const { return (bf16*)(A->ws + WS_WIN); }
    __device__ __forceinline__ bf16* woutT() const { return (bf16*)(A->ws + WS_WOUT); }
    __device__ __forceinline__ bf16* wqbT() const { return (bf16*)(A->ws + WS_WQB); }
    __device__ __forceinline__ bf16* wkvbT() const { return (bf16*)(A->ws + WS_WKVB); }
    __device__ __forceinline__ bf16* wgu() const { return (bf16*)(A->ws + WS_WGU); }
    __device__ __forceinline__ bf16* wd() const { return (bf16*)(A->ws + WS_WD); }
    __device__ __forceinline__ float* hc() const { return (float*)(A->ws + WS_HC); }
    __device__ __forceinline__ bf16* abuf() const { return (bf16*)(A->ws + WS_A); }
    __device__ __forceinline__ bf16* pbuf() const { return (bf16*)(A->ws + WS_P); }
    __device__ __forceinline__ bf16* act() const { return (bf16*)(A->ws + WS_ACT); }
    __device__ __forceinline__ bf16* yk() const { return (bf16*)(A->ws + WS_YK); }
    __device__ __forceinline__ bf16* mix() const { return (bf16*)(A->ws + WS_MIX); }
    __device__ __forceinline__ bf16* qna() const { return (bf16*)(A->ws + WS_QNA); }
    __device__ __forceinline__ bf16* kna() const { return (bf16*)(A->ws + WS_KNA); }
    __device__ __forceinline__ bf16* vna() const { return (bf16*)(A->ws + WS_VNA); }
    __device__ __forceinline__ bf16* qml() const { return (bf16*)(A->ws + WS_QML); }
    __device__ __forceinline__ bf16* kml() const { return (bf16*)(A->ws + WS_KML); }
    __device__ __forceinline__ bf16* vml() const { return (bf16*)(A->ws + WS_VML); }
    __device__ __forceinline__ bf16* qdf() const { return (bf16*)(A->ws + WS_QDF); }
    __device__ __forceinline__ bf16* kdf() const { return (bf16*)(A->ws + WS_KDF); }
    __device__ __forceinline__ bf16* vdf() const { return (bf16*)(A->ws + WS_VDF); }
    __device__ __forceinline__ bf16* xT() const { return (bf16*)(A->ws + WS_XT); }
    __device__ __forceinline__ bf16* btm() const { return (bf16*)(A->ws + WS_BTM); }
    __device__ __forceinline__ bf16* bT() const { return (bf16*)(A->ws + WS_BT); }
    __device__ __forceinline__ bf16* ctm() const { return (bf16*)(A->ws + WS_CTM); }
    __device__ __forceinline__ float* dtv() const { return (float*)(A->ws + WS_DT); }
    __device__ __forceinline__ float* cst() const { return (float*)(A->ws + WS_CST); }
    __device__ __forceinline__ float* cdec() const { return (float*)(A->ws + WS_CDEC); }
    __device__ __forceinline__ bf16* hent() const { return (bf16*)(A->ws + WS_HENT); }
    __device__ __forceinline__ float* ydir() const { return (float*)(A->ws + WS_CST); }
    __device__ __forceinline__ int* rte() const { return (int*)(A->ws + WS_RT); }
    __device__ __forceinline__ float* rtw() const { return (float*)(A->ws + WS_RT + 256 * 1024); }
    __device__ __forceinline__ int* elist() const { return (int*)(A->ws + WS_ELIST); }
};

__device__ __forceinline__ Fr refresh(const Fr& F0) { Fr F = F0; int w = F0.wave; asm volatile("" : "+s"(w)); asm volatile("" : "+s"(F.A));
    int l; asm volatile("v_mbcnt_lo_u32_b32 %0, -1, 0\n\tv_mbcnt_hi_u32_b32 %0, -1, %0" : "=v"(l)); F.wave = w; F.lane = l; F.tid = w * 64 + l; F.gw = F.vcu * 8 + w; return F; }
__device__ __forceinline__ void tr_item(const float* W, int ldw, int nvalid, int k0, int n0, bf16* dst, int ldd, LAS float* scr, int lane, const float* ksc = nullptr) {
    const int cn = n0 + (lane & 31);
#pragma unroll 8
    for (int i = 0; i < 32; ++i) { const int kk = 2 * i + (lane >> 5); const float sc1 = ksc ? ksc[k0 + kk] : 1.f; scr[kk * 33 + (lane & 31)] = cn < nvalid ? W[(size_t)(k0 + kk) * ldw + cn] * sc1 : 0.f; }
    LDS_WAIT();
    const int c = lane & 7;
#pragma unroll
    for (int j = 0; j < 4; ++j) { const int n = (lane >> 3) + 8 * j; const LAS float* s = scr + (8 * c) * 33 + n;
        u32x4 o; o.x = pk2(s[0 * 33], s[1 * 33]); o.y = pk2(s[2 * 33], s[3 * 33]); o.z = pk2(s[4 * 33], s[5 * 33]); o.w = pk2(s[6 * 33], s[7 * 33]);
        *(u32x4*)(dst + (size_t)n * ldd + k0 + 8 * c) = o; }
    LDS_WAIT();
}
__device__ __forceinline__ void moe_weight_convert(const Fr& F, int L) {
    LAS float* scr = (LAS float*)(F.lds + F.wave * 16384);
    constexpr int I_GU = 16 * 16, I_D = 8 * 32;
    for (int it = F.gw; it < NEXP * (2 * I_GU + I_D); it += F.NGW) {
        const int e = it / (2 * I_GU + I_D); int r = it % (2 * I_GU + I_D);
        if (r < 2 * I_GU) { const int bj = r / I_GU; r %= I_GU; const int kb = r / 16, nb = r % 16, n0 = nb * 32;
            const float* W = (bj ? F.w_up() : F.w_gate()) + ((size_t)L * NEXP + e) * DM * FF;
            tr_item(W, FF, FF, kb * 64, n0, F.wgu() + ((size_t)e * 1024 + (n0 >> 7) * 256 + bj * 128 + (n0 & 127)) * DM, DM, scr, F.lane);
        } else { r -= 2 * I_GU; const int kb = r / 32, nb = r % 32, n0 = nb * 32;
            const float* W = F.w_down() + ((size_t)L * NEXP + e) * FF * DM;
            tr_item(W, DM, DM, kb * 64, n0, F.wd() + ((size_t)e * 1024 + n0) * FF, FF, scr, F.lane); }
    }
}
__device__ __forceinline__ void phase_prologue(const Fr& F) {
    LAS float* sc = (LAS float*)F.lds;
    for (int u = blockIdx.x; u < 48; u += F.G) {
        for (int i = F.tid; i < 9 * 1024; i += 512) { const float v = i < 8192 ? F.cvec()[i] : F.cctx()[i - 8192]; sc[i] = siluf(v); }
        __syncthreads();
        const int col = u * 512 + F.tid, L = col / 6144, n = col % 6144;
        float acc[9];
#pragma unroll
        for (int b = 0; b < 9; ++b) acc[b] = 0.f;
        const float* w = F.w_mod() + (size_t)L * 1024 * 6144 + n;
#pragma unroll 8
        for (int k = 0; k < 1024; ++k) { const float wv = w[(size_t)k * 6144];
#pragma unroll
            for (int b = 0; b < 9; ++b) acc[b] += sc[b * 1024 + k] * wv; }
        const float bm = F.b_mod()[L * 6144 + n];
#pragma unroll
        for (int b = 0; b < 9; ++b) F.modv()[((size_t)L * 9 + b) * 6144 + n] = acc[b] + bm;
        __syncthreads();
    }
    for (int i = blockIdx.x * 512 + F.tid; i < TLAT * 16; i += F.G * 512) { const int t = i >> 4, k = i & 15; const float inv = powf(10000.f, -(float)(k & 7) / 8.f);
        const float pos = (k < 8) ? (float)(t >> 6) : (float)(t & 63); const float ang = pos * inv; F.rcos()[i] = cosf(ang); F.rsin()[i] = sinf(ang); }
    __syncthreads();
    LAS float* scr = (LAS float*)(F.lds + F.wave * 16384);
    constexpr int I_IN = 16 * 96, I_OUT = 16 * 32, I_QB = 4 * 12, I_KVB = 2 * 16, I_L = I_IN + I_OUT + I_QB + I_KVB;
    for (int it = F.gw; it < DEPTH * I_L; it += F.NGW) {
        const int L = it / I_L; int r = it % I_L;
        if (r < I_IN) { const int kb = r / 96, nb = r % 96; tr_item(F.w_in() + (size_t)L * DM * NIN, NIN, NIN, kb * 64, nb * 32, F.winT() + ((size_t)L * NP + nb * 32) * DM, DM, scr, F.lane); continue; } r -= I_IN;
        if (r < I_OUT) { const int kb = r / 32, nb = r % 32; tr_item(F.w_out() + (size_t)L * DM * DM, DM, DM, kb * 64, nb * 32, F.woutT() + ((size_t)L * DM + nb * 32) * DM, DM, scr, F.lane); continue; } r -= I_OUT;
        if (r < I_QB) { const int kb = r / 12, nb = r % 12; tr_item(F.mla_wqb() + (size_t)L * 256 * 384, 384, 384, kb * 64, nb * 32, F.wqbT() + ((size_t)L * 384 + nb * 32) * 256, 256, scr, F.lane, F.mla_gqa() + L * 256); continue; } r -= I_QB;
        { const int kb = r / 16, nb = r % 16; tr_item(F.mla_wkvb() + (size_t)L * 128 * 512, 512, 512, kb * 64, nb * 32, F.wkvbT() + ((size_t)L * 512 + nb * 32) * 128, 128, scr, F.lane, F.mla_gkva() + L * 128); }
    }
}

__device__ __forceinline__ void phase_norm(const Fr& F, int L, bool combine = true) {
    const int nrows = (L == DEPTH) ? NLAT : NROW;
    for (int r = F.gw; r < nrows; r += F.NGW) {
        const bool lat = r < NLAT; const int bb = lat ? (r >> 11) : 8;
        const float* hin = (L == 0) ? (lat ? F.x() + (size_t)r * DM : F.ctx() + (size_t)(r - NLAT) * DM) : (lat ? F.out() + (size_t)r * DM : F.hc() + (size_t)(r - NLAT) * DM);
        float* hout = lat ? F.out() + (size_t)r * DM : F.hc() + (size_t)(r - NLAT) * DM;
        f32x4 v[4];
#pragma unroll
        for (int j = 0; j < 4; ++j) v[j] = *(const f32x4*)(hin + 4 * F.lane + 256 * j);
        if (L > 0 && combine) {
            const float* m5 = F.modv() + ((size_t)(L - 1) * 9 + bb) * 6144 + 5 * 1024;
#pragma unroll
            for (int j = 0; j < 4; ++j) { const int c = 4 * F.lane + 256 * j; const f32x4 g = *(const f32x4*)(m5 + c);
                const u32x2 y0 = *(const u32x2*)(F.yk() + (size_t)(2 * r) * DM + c), y1 = *(const u32x2*)(F.yk() + (size_t)(2 * r + 1) * DM + c);
                f32x4 ys; ys[0] = __uint_as_float(y0.x << 16) + __uint_as_float(y1.x << 16); ys[1] = __uint_as_float(y0.x & 0xffff0000u) + __uint_as_float(y1.x & 0xffff0000u);
                ys[2] = __uint_as_float(y0.y << 16) + __uint_as_float(y1.y << 16); ys[3] = __uint_as_float(y0.y & 0xffff0000u) + __uint_as_float(y1.y & 0xffff0000u);
                v[j] = v[j] + g * ys; *(f32x4*)(hout + c) = v[j]; }
        }
        if (L == DEPTH) continue;
        float ss = 0.f;
#pragma unroll
        for (int j = 0; j < 4; ++j) ss += (v[j][0] * v[j][0] + v[j][1] * v[j][1]) + (v[j][2] * v[j][2] + v[j][3] * v[j][3]);
        const float rstd = rsqrtf(wsum(ss) * (1.f / DM) + EPS);
        const float* md = F.modv() + ((size_t)L * 9 + bb) * 6144;
#pragma unroll
        for (int j = 0; j < 4; ++j) { const int c = 4 * F.lane + 256 * j; const f32x4 g = *(const f32x4*)(F.g_mix() + L * DM + c), sh = *(const f32x4*)(md + c), scl = *(const f32x4*)(md + 1024 + c);
            const f32x4 a = v[j] * rstd * g * (scl + 1.f) + sh; u32x2 o; o.x = pk2(a[0], a[1]); o.y = pk2(a[2], a[3]); *(u32x2*)(F.abuf() + (size_t)r * DM + c) = o; }
    }
}

__device__ __forceinline__ void prep_row(const Fr& F, int L, int r, LAS float* scr) {
    int lane_ = F.lane; asm volatile("" : "+v"(lane_)); const int lane = lane_; int b, s; row2bs(r, b, s); const bool lat = r < NLAT; const int t = s - 256;
    const bf16* p = F.pbuf() + (size_t)r * NP;
#pragma unroll
    for (int h = 0; h < 4; ++h) {
        const float q = bf2f(p[C_NA + h * 64 + lane]), k = bf2f(p[C_NA + 256 + h * 64 + lane]);
        const float rq = rsqrtf(wsum(q * q) * (1.f / 64) + EPS), rk = rsqrtf(wsum(k * k) * (1.f / 64) + EPS);
        const size_t o = ((size_t)(b * 4 + h) * SQ + s) * 64 + lane;
        F.qna()[o] = f2bf(q * rq * F.na_gq()[L * 64 + lane]); F.kna()[o] = f2bf(k * rk * F.na_gk()[L * 64 + lane]);
    }
    {
        const int idx = lane & 31; float cs = 1.f, sn = 0.f;
        if (lat) { cs = F.rcos()[t * 16 + (idx & 15)]; sn = F.rsin()[t * 16 + (idx & 15)]; }
#pragma unroll
        for (int h = 0; h < 4; ++h) {
            float q = bf2f(p[C_DF + h * 64 + lane]), k = bf2f(p[C_DF + 256 + h * 64 + lane]);
            float sq = q * q, sk = k * k;
#pragma unroll
            for (int o = 16; o >= 1; o >>= 1) { sq += __shfl_xor(sq, o); sk += __shfl_xor(sk, o); }
            q *= rsqrtf(sq * (1.f / 32) + EPS) * F.df_gq()[L * 32 + idx]; k *= rsqrtf(sk * (1.f / 32) + EPS) * F.df_gk()[L * 32 + idx];
            const float qp = __shfl_xor(q, 16), kp = __shfl_xor(k, 16);
            if (lat) { q = (idx < 16) ? q * cs - qp * sn : qp * sn + q * cs; k = (idx < 16) ? k * cs - kp * sn : kp * sn + k * cs; }
            const size_t o = ((size_t)(b * 4 + h) * SQ + s) * 64 + lane;
            F.qdf()[o] = f2bf(q); F.kdf()[o] = f2bf(k);
        }
    }
}
__device__ __forceinline__ void prep_tile(const Fr& F, int L, int b, int c) {
    int tid_ = F.tid; asm volatile("" : "+v"(tid_)); const int tid = tid_;
    const int s0 = 64 * c; const size_t r0 = bs2row(b, s0);
    LAS bf16* Lv = (LAS bf16*)F.lds;
#ifndef PT_MASK
#define PT_MASK 7
#endif
    if (PT_MASK & 1)
#pragma unroll 1
    for (int mx = 0; mx < 2; ++mx) {
        const int voff = mx == 0 ? C_NA + 512 : C_DF + 512; bf16* vt = mx == 0 ? F.vna() : F.vdf();
#pragma unroll
        for (int k = 0; k < 4; ++k) { const int idx = tid + 512 * k, tok = idx >> 5, d8 = (idx & 31) * 8;
            const u32x4 v = *(const u32x4*)(F.pbuf() + (r0 + tok) * NP + voff + d8); const int pc = vpos(tok);
#pragma unroll
            for (int e = 0; e < 4; ++e) { Lv[(d8 + 2 * e) * 72 + pc] = (bf16)(v[e] & 0xffffu); Lv[(d8 + 2 * e + 1) * 72 + pc] = (bf16)(v[e] >> 16); } }
        __syncthreads();
#pragma unroll
        for (int k = 0; k < 4; ++k) { const int idx = tid + 512 * k, dv = idx >> 3, pc = idx & 7;
            const u32x4 v = *(const LAS u32x4*)(Lv + dv * 72 + pc * 8);
#ifndef PT_NOSTORE
#define PT_NOSTORE 0
#endif
            if (!PT_NOSTORE || v.x == 0x12345678u) *(u32x4*)(vt + ((size_t)(b * 4 + (dv >> 6)) * 64 + (dv & 63)) * SQ + s0 + pc * 8) = v; }
        __syncthreads();
    }
    const int len = c < 4 ? TCTX : TLAT, t0 = c < 4 ? s0 : s0 - 256;
    LAS bf16* Lc = (LAS bf16*)F.lds;
    if (PT_MASK & 2)
#pragma unroll 1
    for (int gch = 0; gch < 3; ++gch) {
        for (int idx = tid; idx < 68 * 32; idx += 512) { const int j = idx >> 5, c8 = (idx & 31) * 8, tj = t0 - 2 + j;
            u32x4 v = (u32x4){0u, 0u, 0u, 0u};
            if (tj >= 0 && tj < len) v = *(const u32x4*)(F.pbuf() + (r0 + j - 2) * NP + C_XBC + gch * 256 + c8);
            *(LAS u32x4*)(Lc + j * 256 + c8) = v; }
        __syncthreads();
        const int ch = tid & 255, tq = tid >> 8, cg = gch * 256 + ch;
        float w[5];
#pragma unroll
        for (int j = 0; j < 5; ++j) w[j] = F.conv_w()[(L * 5 + j) * 768 + cg];
        const float bias = F.conv_b()[L * 768 + cg];
        const LAS bf16* lp = Lc + (32 * tq) * 256 + ch;
        float x0 = bf2f(lp[0]), x1 = bf2f(lp[256]), x2 = bf2f(lp[512]), x3 = bf2f(lp[768]);
        bf16* tm = (gch == 1 ? F.btm() : F.ctm()) + ((size_t)b * SQ + s0 + 32 * tq) * 256 + ch;
        bf16* cm = (gch == 0 ? F.xT() : F.bT()) + ((size_t)b * 256 + ch) * SQ + s0 + 32 * tq;
#pragma unroll
        for (int g8 = 0; g8 < 4; ++g8) { unsigned pk[4];
#pragma unroll
            for (int e = 0; e < 8; ++e) { const int i = 8 * g8 + e; const float x4 = bf2f(lp[(i + 4) * 256]);
                const float acc = bias + w[0] * x0 + w[1] * x1 + w[2] * x2 + w[3] * x3 + w[4] * x4; const unsigned o = f2bf(siluf(acc));
                if (gch >= 1) tm[(size_t)i * 256] = (bf16)o;
                if (e & 1) pk[e >> 1] |= o << 16; else pk[e >> 1] = o;
                x0 = x1; x1 = x2; x2 = x3; x3 = x4; }
            if (gch <= 1) { u32x4 v; v.x = pk[0]; v.y = pk[1]; v.z = pk[2]; v.w = pk[3]; *(u32x4*)(cm + 8 * g8) = v; } }
        __syncthreads();
    }
    if (PT_MASK & 4) { const int tok = tid >> 3, i = tid & 7; const float raw = bf2f(F.pbuf()[(r0 + tok) * NP + C_DT + i]) + F.dt_bias()[L * 8 + i]; const float ex = __expf(raw);
      F.dtv()[((size_t)b * 8 + i) * SQ + s0 + tok] = raw > 20.f ? raw : (ex < 0.03f ? ex * (1.f - ex * (0.5f - ex * (0.33333334f - 0.25f * ex))) : __logf(1.f + ex)); }
}
__device__ __forceinline__ void mla_prep_block(const Fr& F, int L, int b, int j32) {
    int lane_ = F.lane; asm volatile("" : "+v"(lane_));
    const int lane = lane_, wave = F.wave, r = lane & 31, hh = lane >> 5, s = 32 * j32 + r, t = s - 256; const bool lat = s >= 256;
    const size_t row = bs2row(b, s);
    const bf16* p = F.pbuf() + row * NP + C_MLA;
    const int tt = lat ? t : 0; const float latf = lat ? 1.f : 0.f;
    if (wave < 4) {
        const int hq = wave;
        bf16x8 Bq[16]; float ss = 0.f;
#pragma unroll
        for (int kk = 0; kk < 16; ++kk) { Bq[kk] = *(const bf16x8*)(p + 16 * kk + 8 * hh);
#pragma unroll
            for (int j = 0; j < 8; ++j) { const float v = bf2f((bf16)Bq[kk][j]); ss += v * v; } }
        ss += __shfl_xor(ss, 32); const float rq = rsqrtf(ss * (1.f / 256) + EPS);
        f32x16 acc[3]; float hs = 0.f;
#pragma unroll
        for (int j3 = 0; j3 < 3; ++j3) {
#pragma unroll
            for (int i = 0; i < 16; ++i) acc[j3][i] = 0.f;
            const bf16* wp = F.wqbT() + ((size_t)L * 384 + 96 * hq + 32 * j3 + r) * 256 + 8 * hh;
#pragma unroll
            for (int kk = 0; kk < 16; ++kk) acc[j3] = MFMA32(*(const bf16x8*)(wp + 16 * kk), Bq[kk], acc[j3]);
            asm volatile("" ::: "memory");
#pragma unroll
            for (int i = 0; i < 16; ++i) hs += acc[j3][i] * acc[j3][i]; }
        hs = (hs + __shfl_xor(hs, 32)) * rq * rq; const float rs = rsqrtf(hs * (1.f / 96) + EPS) * rq;
        bf16* qo = F.qml() + ((size_t)(b * 4 + hq) * SQ + s) * 96 + 4 * hh;
#pragma unroll
        for (int j3 = 0; j3 < 3; ++j3) {
#pragma unroll
            for (int i = 0; i < 16; ++i) acc[j3][i] *= rs * F.mla_gq()[L * 96 + 32 * j3 + crow16(i, hh)];
            if (j3 == 2) {
#pragma unroll
                for (int i = 0; i < 8; ++i) { const float rc = lat ? F.rcos()[tt * 16 + crow16(i, hh)] : 1.f, rsn = F.rsin()[tt * 16 + crow16(i, hh)] * latf;
                    const float x1 = acc[2][i], x2 = acc[2][i + 8]; acc[2][i] = x1 * rc - x2 * rsn; acc[2][i + 8] = x1 * rsn + x2 * rc; } }
#pragma unroll
            for (int g = 0; g < 4; ++g) { u32x2 w; w.x = pk2(acc[j3][4 * g], acc[j3][4 * g + 1]); w.y = pk2(acc[j3][4 * g + 2], acc[j3][4 * g + 3]); *(u32x2*)(qo + 32 * j3 + 8 * g) = w; } }
    } else {
        const int hk = wave - 4;
        LAS unsigned char* wl = F.lds + wave * 16384;
        bf16x8 Bkv[8]; float ss = 0.f;
#pragma unroll
        for (int kk = 0; kk < 8; ++kk) { Bkv[kk] = *(const bf16x8*)(p + 256 + 16 * kk + 8 * hh);
#pragma unroll
            for (int j = 0; j < 8; ++j) { const float v = bf2f((bf16)Bkv[kk][j]); ss += v * v; } }
        ss += __shfl_xor(ss, 32); const float rk = rsqrtf(ss * (1.f / 128) + EPS);
        float kr[16]; float hs = 0.f;
#pragma unroll
        for (int g = 0; g < 4; ++g) { const u32x2 k4 = *(const u32x2*)(p + 384 + 8 * g + 4 * hh);
            kr[4 * g] = __uint_as_float(k4.x << 16); kr[4 * g + 1] = __uint_as_float(k4.x & 0xffff0000u); kr[4 * g + 2] = __uint_as_float(k4.y << 16); kr[4 * g + 3] = __uint_as_float(k4.y & 0xffff0000u); }
#pragma unroll
        for (int i = 0; i < 16; ++i) hs += kr[i] * kr[i];
        f32x16 acc[4]; float ks = 0.f;
#pragma unroll
        for (int j4 = 0; j4 < 4; ++j4) {
#pragma unroll
            for (int i = 0; i < 16; ++i) acc[j4][i] = 0.f;
            const bf16* wp = F.wkvbT() + ((size_t)L * 512 + 128 * hk + 32 * j4 + r) * 128 + 8 * hh;
#pragma unroll
            for (int kk = 0; kk < 8; ++kk) acc[j4] = MFMA32(*(const bf16x8*)(wp + 16 * kk), Bkv[kk], acc[j4]);
            asm volatile("" ::: "memory");
            if (j4 < 2) {
#pragma unroll
                for (int i = 0; i < 16; ++i) ks += acc[j4][i] * acc[j4][i]; } }
        hs += ks * rk * rk; hs += __shfl_xor(hs, 32); const float rs = rsqrtf(hs * (1.f / 96) + EPS);
        bf16* ko = F.kml() + ((size_t)(b * 4 + hk) * SQ + s) * 96 + 4 * hh;
#pragma unroll
        for (int j2 = 0; j2 < 2; ++j2) {
#pragma unroll
            for (int i = 0; i < 16; ++i) acc[j2][i] *= rs * rk * F.mla_gk()[L * 96 + 32 * j2 + crow16(i, hh)];
#pragma unroll
            for (int g = 0; g < 4; ++g) { u32x2 w; w.x = pk2(acc[j2][4 * g], acc[j2][4 * g + 1]); w.y = pk2(acc[j2][4 * g + 2], acc[j2][4 * g + 3]); *(u32x2*)(ko + 32 * j2 + 8 * g) = w; } }
#pragma unroll
        for (int i = 0; i < 16; ++i) kr[i] *= rs * F.mla_gk()[L * 96 + 64 + crow16(i, hh)];
#pragma unroll
        for (int i = 0; i < 8; ++i) { const float rc = lat ? F.rcos()[tt * 16 + crow16(i, hh)] : 1.f, rsn = F.rsin()[tt * 16 + crow16(i, hh)] * latf;
            const float x1 = kr[i], x2 = kr[i + 8]; kr[i] = x1 * rc - x2 * rsn; kr[i + 8] = x1 * rsn + x2 * rc; }
#pragma unroll
        for (int g = 0; g < 4; ++g) { u32x2 w; w.x = pk2(kr[4 * g], kr[4 * g + 1]); w.y = pk2(kr[4 * g + 2], kr[4 * g + 3]); *(u32x2*)(ko + 64 + 8 * g) = w; }
        LAS bf16* vl = (LAS bf16*)wl;
#pragma unroll
        for (int mt = 0; mt < 2; ++mt)
#pragma unroll
            for (int i = 0; i < 16; ++i) vl[(32 * mt + crow16(i, hh)) * 40 + vpos(r)] = f2bf(acc[2 + mt][i] * rk);
        LDS_WAIT();
        { const LAS u32x4* src4 = (const LAS u32x4*)(wl + lane * 80); u32x4* dst = (u32x4*)(F.vml() + ((size_t)(b * 4 + hk) * 64 + lane) * SQ + 32 * j32);
#pragma unroll
          for (int q = 0; q < 4; ++q) dst[q] = src4[q]; }
        LDS_WAIT();
    }
}
__device__ __forceinline__ int grab_unit(const Fr& F, unsigned* ctr) {
    volatile LAS int* slot = (volatile LAS int*)(F.lds + LDSCTL_OFF + 256);
    __syncthreads();
    if (F.tid == 0) *slot = (int)__hip_atomic_fetch_add(ctr, 1u, __ATOMIC_RELAXED, __HIP_MEMORY_SCOPE_AGENT);
    __syncthreads();
    return __builtin_amdgcn_readfirstlane(*slot);
}
__device__ __forceinline__ void prep_qk(const Fr& F, int L, int b, int j32) {
    int lane_ = F.lane; asm volatile("" : "+v"(lane_)); const int l = lane_, h = l >> 4;
    u32x2 raw[4][4];
#pragma unroll
    for (int i = 0; i < 4; ++i) { const int s = 32 * j32 + 4 * F.wave + i; const bf16* p = F.pbuf() + (size_t)bs2row(b, s) * NP + 4 * l;
        raw[i][0] = *(const u32x2*)(p + C_NA); raw[i][1] = *(const u32x2*)(p + C_NA + 256); raw[i][2] = *(const u32x2*)(p + C_DF); raw[i][3] = *(const u32x2*)(p + C_DF + 256); }
    const f32x4 gnq = *(const f32x4*)(F.na_gq() + L * 64 + 4 * (l & 15)), gnk = *(const f32x4*)(F.na_gk() + L * 64 + 4 * (l & 15));
    const f32x4 gdq = *(const f32x4*)(F.df_gq() + L * 32 + 4 * (l & 7)), gdk = *(const f32x4*)(F.df_gk() + L * 32 + 4 * (l & 7));
#pragma unroll
    for (int i = 0; i < 4; ++i) { const int s = 32 * j32 + 4 * F.wave + i, t = s - 256; const bool lat = s >= 256;
#pragma unroll
        for (int w = 0; w < 4; ++w) {
            f32x4 x; x[0] = __uint_as_float(raw[i][w].x << 16); x[1] = __uint_as_float(raw[i][w].x & 0xffff0000u); x[2] = __uint_as_float(raw[i][w].y << 16); x[3] = __uint_as_float(raw[i][w].y & 0xffff0000u);
            float ss = (x[0] * x[0] + x[1] * x[1]) + (x[2] * x[2] + x[3] * x[3]);
            ss += dppf<0xB1>(ss); ss += dppf<0x4E>(ss); ss += dppf<0x141>(ss);
            if (w < 2) { ss += dppf<0x140>(ss);
                const float rs = rsqrtf(ss * (1.f / 64) + EPS); const f32x4 g = w == 0 ? gnq : gnk; x = x * rs * g;
                u32x2 o; o.x = pk2(x[0], x[1]); o.y = pk2(x[2], x[3]);
                *(u32x2*)((w == 0 ? F.qna() : F.kna()) + ((size_t)(b * 4 + h) * SQ + s) * 64 + 4 * (l & 15)) = o;
            } else {
                const float rs = rsqrtf(ss * (1.f / 32) + EPS); const f32x4 g = w == 2 ? gdq : gdk; x = x * rs * g;
                f32x4 xp; xp[0] = __shfl_xor(x[0], 4); xp[1] = __shfl_xor(x[1], 4); xp[2] = __shfl_xor(x[2], 4); xp[3] = __shfl_xor(x[3], 4);
                if (lat) { const f32x4 cs = *(const f32x4*)(F.rcos() + t * 16 + 4 * (l & 3)), sn = *(const f32x4*)(F.rsin() + t * 16 + 4 * (l & 3));
                    x = (l & 4) ? xp * sn + x * cs : x * cs - xp * sn; }
                u32x2 o; o.x = pk2(x[0], x[1]); o.y = pk2(x[2], x[3]);
                *(u32x2*)((w == 2 ? F.qdf() : F.kdf()) + ((size_t)(b * 4 + h) * SQ + s) * 64 + 4 * (l & 15)) = o;
            } } }
}
__device__ __forceinline__ void prep_vconv(const Fr& F, int L, int b, int j32) {
    int tid_ = F.tid; asm volatile("; VCONV_BEGIN" : "+v"(tid_)); const int tid = tid_;
    const int s0 = 32 * j32; const size_t r0 = bs2row(b, s0);
    LAS bf16* Lv = (LAS bf16*)F.lds;
#ifndef VC_MASK
#define VC_MASK 7
#endif
    if (VC_MASK & 1) {   u32x4 v[4];
#pragma unroll
        for (int k = 0; k < 4; ++k) { const int idx = tid + 512 * k, mx = idx >> 10, tok = (idx >> 5) & 31, d8 = (idx & 31) * 8;
            v[k] = *(const u32x4*)(F.pbuf() + (r0 + tok) * NP + (mx ? C_DF + 512 : C_NA + 512) + d8); }
#pragma unroll
        for (int k = 0; k < 4; ++k) { const int idx = tid + 512 * k, mx = idx >> 10, tok = (idx >> 5) & 31, d8 = (idx & 31) * 8, pc = vpos(tok);
#pragma unroll
            for (int e = 0; e < 4; ++e) { Lv[(mx * 256 + d8 + 2 * e) * 40 + pc] = (bf16)(v[k][e] & 0xffffu); Lv[(mx * 256 + d8 + 2 * e + 1) * 40 + pc] = (bf16)(v[k][e] >> 16); } }
        __syncthreads();
#pragma unroll
        for (int k = 0; k < 4; ++k) { const int idx = tid + 512 * k, mx = idx >> 10, dv = (idx >> 2) & 255, pc = idx & 3;
            const u32x4 w = *(const LAS u32x4*)(Lv + (mx * 256 + dv) * 40 + pc * 8);
            *(u32x4*)((mx ? F.vdf() : F.vna()) + ((size_t)(b * 4 + (dv >> 6)) * 64 + (dv & 63)) * SQ + s0 + pc * 8) = w; }
        __syncthreads();
    }
    const bool isctx = s0 < 256; const int len = isctx ? TCTX : TLAT, t0 = isctx ? s0 : s0 - 256;
    LAS bf16* Lc = (LAS bf16*)F.lds;
    if (VC_MASK & 2) {   u32x4 v[7];
#pragma unroll
        for (int k = 0; k < 7; ++k) { const int idx = tid + 512 * k, j = idx / 96, c8 = (idx - 96 * j) * 8, tj = t0 - 2 + j; const int jc = min(max(tj, 0), len - 1) - t0;
            v[k] = (u32x4){0u, 0u, 0u, 0u};
            if (idx < 36 * 96) { v[k] = *(const u32x4*)(F.pbuf() + (size_t)((long)r0 + jc) * NP + C_XBC + c8); if (tj < 0 || tj >= len) v[k] = (u32x4){0u, 0u, 0u, 0u}; } }
#pragma unroll
        for (int k = 0; k < 7; ++k) { const int idx = tid + 512 * k, j = idx / 96, c8 = (idx - 96 * j) * 8; if (idx < 36 * 96) *(LAS u32x4*)(Lc + j * 768 + c8) = v[k]; }
    }
    __syncthreads();
    if (VC_MASK & 2)
#pragma unroll 1
    for (int pass = 0; pass < 2; ++pass) {
        const int cg = pass == 0 ? tid : 512 + tid;
        if (cg < 768) {
            float w[5];
#pragma unroll
            for (int j = 0; j < 5; ++j) w[j] = F.conv_w()[(L * 5 + j) * 768 + cg];
            const float bias = F.conv_b()[L * 768 + cg];
            const LAS bf16* lp = Lc + cg;
            float x0 = bf2f(lp[0]), x1 = bf2f(lp[768]), x2 = bf2f(lp[2 * 768]), x3 = bf2f(lp[3 * 768]);
            const int gch = cg >> 8, ch = cg & 255;
            bf16* tm = (gch == 1 ? F.btm() : F.ctm()) + ((size_t)b * SQ + s0) * 256 + ch;
            bf16* cm = (gch == 0 ? F.xT() : F.bT()) + ((size_t)b * 256 + ch) * SQ + s0;
#pragma unroll
            for (int g8 = 0; g8 < 4; ++g8) { unsigned pk[4];
#pragma unroll
                for (int e = 0; e < 8; ++e) { const int i = 8 * g8 + e; const float x4 = bf2f(lp[(i + 4) * 768]);
                    const float acc = bias + w[0] * x0 + w[1] * x1 + w[2] * x2 + w[3] * x3 + w[4] * x4; const unsigned o = f2bf(siluf(acc));
                    if (gch >= 1) tm[(size_t)i * 256] = (bf16)o;
                    if (e & 1) pk[e >> 1] |= o << 16; else pk[e >> 1] = o;
                    x0 = x1; x1 = x2; x2 = x3; x3 = x4; }
                if (gch <= 1) { u32x4 v; v.x = pk[0]; v.y = pk[1]; v.z = pk[2]; v.w = pk[3]; *(u32x4*)(cm + 8 * g8) = v; } }
        }
    }
    if ((VC_MASK & 4) && tid < 256) { const int tok = tid >> 3, i = tid & 7; const float raw = bf2f(F.pbuf()[(r0 + tok) * NP + C_DT + i]) + F.dt_bias()[L * 8 + i]; const float ex = __expf(raw);
      F.dtv()[((size_t)b * 8 + i) * SQ + s0 + tok] = raw > 20.f ? raw : (ex < 0.03f ? ex * (1.f - ex * (0.5f - ex * (0.33333334f - 0.25f * ex))) : __logf(1.f + ex)); }
    __syncthreads();
    asm volatile("; VCONV_END" ::: "memory");
}
__device__ __forceinline__ void phase_prep(const Fr& F0_, int L) {
    unsigned* ctr = F0_.ctl() + CW_QUEUE + (L * 16 + 0) * 64;
    for (;;) {
        const int u = grab_unit(F0_, ctr); if (u >= NB * 72) break;
        const int b = u / 72, j32 = u - 72 * b;
        { const Fr F = refresh(F0_); prep_qk(F, L, b, j32); }
        { const Fr F = refresh(F0_); mla_prep_block(F, L, b, j32); }
        __syncthreads();
    }
    __syncthreads();
    { const Fr F3 = refresh(F0_); for (int u = F3.G - 1 - F3.vcu; u < NB * 36; u += F3.G) prep_tile(F3, L, u / 36, u % 36); }
}

__device__ __forceinline__ void phase_ssd_naive(const Fr& F, int L) {
    if (F.wave != 0 || blockIdx.x >= 64) return;
    const int w = blockIdx.x, b = w >> 3, d = (w >> 2) & 1, h = w & 3, g = h >> 1, p = F.lane;
    const float a = -expf(F.a_log()[L * 8 + d * 4 + h]);
    float hs[128];
#pragma unroll
    for (int n = 0; n < 128; ++n) hs[n] = 0.f;
    const float* dtp = F.dtv() + ((size_t)b * 8 + d * 4 + h) * SQ;
    const bf16* xp = F.xT() + ((size_t)b * 256 + h * 64 + p) * SQ;
    for (int step = 0; step < SQ; ++step) {
        const int s = d == 0 ? step : (step < 256 ? 255 - step : SQ - 1 - (step - 256));
        const float dtv = dtp[s], dA = __expf(dtv * a), xv = bf2f(xp[s]) * dtv;
        const u32x4* Bp = (const u32x4*)(F.btm() + ((size_t)b * SQ + s) * 256 + g * 128);
        const u32x4* Cp = (const u32x4*)(F.ctm() + ((size_t)b * SQ + s) * 256 + g * 128);
        float y = 0.f;
#pragma unroll
        for (int n8 = 0; n8 < 16; ++n8) { const u32x4 bv = Bp[n8], cv = Cp[n8];
#pragma unroll
            for (int j = 0; j < 4; ++j) { const int n = n8 * 8 + 2 * j;
                hs[n] = hs[n] * dA + xv * __uint_as_float(bv[j] << 16); hs[n + 1] = hs[n + 1] * dA + xv * __uint_as_float(bv[j] & 0xffff0000u);
                y += __uint_as_float(cv[j] << 16) * hs[n] + __uint_as_float(cv[j] & 0xffff0000u) * hs[n + 1]; } }
        F.ydir()[((size_t)d * NROW + bs2row(b, s)) * 256 + h * 64 + p] = y;
    }
}

template <int KIND>
__device__ __forceinline__ void naive_attn_job(const Fr& F, int L, int r, int h, LAS float* scr) {
    constexpr int DQ = KIND == 1 ? 96 : (KIND == 0 ? 64 : 32), QS = KIND == 1 ? 96 : 64;
    const int lane = F.lane; int b, s; row2bs(r, b, s); const bool lat = r < NLAT; const int t = s - 256;
    const bf16* Qb = (KIND == 0 ? F.qna() : KIND == 1 ? F.qml() : F.qdf()) + ((size_t)(b * 4 + h) * SQ + s) * QS;
    const bf16* Kb = (KIND == 0 ? F.kna() : KIND == 1 ? F.kml() : F.kdf()) + (size_t)(b * 4 + h) * SQ * QS;
    const bf16* Vt = (KIND == 0 ? F.vna() : KIND == 1 ? F.vml() : F.vdf()) + ((size_t)(b * 4 + h) * 64 + lane) * SQ;
    const float scale = KIND == 1 ? 0.10206207261596577f : (KIND == 0 ? 0.125f : 0.17677669529663687f);
    const int qr = t >> 6, qc = t & 63, row_lo = min(max(qr - 4, 0), 24), col_lo = min(max(qc - 8, 0), 48);
    const bool nb = (KIND == 0) && lat;
    const int nk = lat ? (KIND == 0 ? 768 : SQ) : 256;
    const int koff = nb ? row_lo * 64 : 0;
    float oc[2] = {0.f, 0.f};
#pragma unroll
    for (int comp = 0; comp < (KIND == 2 ? 2 : 1); ++comp) {
        for (int i = lane; i < DQ; i += 64) scr[i] = bf2f(Qb[comp * 32 + i]);
        LDS_WAIT();
        float m = -INFINITY;
        for (int kk = lane; kk < nk; kk += 64) {
            const int sk = kk < 256 ? kk : kk + koff; float bias = 0.f; bool valid = true;
            if (nb && kk >= 256) { const int w = kk - 256, kr = w >> 6, kc = w & 63; valid = kc >= col_lo && kc < col_lo + 16;
                const int ro = row_lo + kr - qr + 7, co = min(max(kc - qc, -15), 15) + 15; bias = F.na_rb()[((L * 4 + h) * 15 + ro) * 31 + co]; }
            const u32x4* kp = (const u32x4*)(Kb + (size_t)sk * QS + (KIND == 2 ? comp * 32 : 0));
            float dot = 0.f;
#pragma unroll
            for (int i8 = 0; i8 < DQ / 8; ++i8) { const u32x4 kv = kp[i8];
#pragma unroll
                for (int j = 0; j < 4; ++j) dot += scr[i8 * 8 + 2 * j] * __uint_as_float(kv[j] << 16) + scr[i8 * 8 + 2 * j + 1] * __uint_as_float(kv[j] & 0xffff0000u); }
            const float sc = valid ? dot * scale + bias : -INFINITY;
            scr[128 + kk] = sc; m = fmaxf(m, sc);
        }
        m = wmaxf(m);
        float sum = 0.f;
        for (int kk = lane; kk < nk; kk += 64) { const float pv = __expf(scr[128 + kk] - m); scr[128 + kk] = pv; sum += pv; }
        sum = wsum(sum);
        LDS_WAIT();
        float o = 0.f;
        for (int kb = 0; kb < nk; kb += 8) {
            const int sb = kb < 256 ? kb : kb + koff;
            const u32x4 vv = *(const u32x4*)(Vt + sb);
#pragma unroll
            for (int j = 0; j < 8; ++j) { const int kk = (kb & ~15) + vpos((kb & 15) + j); const unsigned wv = vv[j >> 1];
                o += scr[128 + kk] * ((j & 1) ? __uint_as_float(wv & 0xffff0000u) : __uint_as_float(wv << 16)); }
        }
        oc[comp] = o / sum;
        LDS_WAIT();
    }
    bf16* mo = F.mix() + (size_t)r * DM + (KIND == 0 ? 0 : KIND == 1 ? 256 : 512) + h * 64 + lane;
    if (KIND == 2) {
        const float* lv = F.df_lam() + L * 128; const float li = 0.8f - 0.6f * expf(-0.3f * (float)L);
        float d1 = 0.f, d2 = 0.f;
#pragma unroll
        for (int i = 0; i < 32; ++i) { d1 += lv[i] * lv[32 + i]; d2 += lv[64 + i] * lv[96 + i]; }
        const float lam = expf(d1) - expf(d2) + li;
        const float o = oc[0] - lam * oc[1];
        const float rs = rsqrtf(wsum(o * o) * (1.f / 64) + EPS);
        *mo = f2bf(o * rs * F.df_gsub()[L * 64 + lane] * (1.f - li));
    } else *mo = f2bf(oc[0]);
}
__device__ __forceinline__ void phase_mix_naive(const Fr& F, int L) {
    LAS float* scr = (LAS float*)(F.lds + F.wave * 16384);
    const int nrows = (L == DEPTH - 1) ? NLAT : NROW;
    for (int j = F.gw; j < nrows * 4; j += F.NGW) naive_attn_job<2>(F, L, j >> 2, j & 3, scr);
    for (int j = F.gw; j < nrows * 4; j += F.NGW) naive_attn_job<1>(F, L, j >> 2, j & 3, scr);
    for (int j = F.gw; j < nrows * 4; j += F.NGW) naive_attn_job<0>(F, L, j >> 2, j & 3, scr);
    for (int r = F.gw; r < nrows; r += F.NGW) {
        int b, s; row2bs(r, b, s); const int h = F.lane >> 4; const float dsk = F.ssd_d()[L * 8 + h] + F.ssd_d()[L * 8 + 4 + h];
        float y[4]; float ss = 0.f;
#pragma unroll
        for (int j = 0; j < 4; ++j) { const int ch = F.lane * 4 + j; const float xv = bf2f(F.xT()[((size_t)b * 256 + ch) * SQ + s]);
            const float z = bf2f(F.pbuf()[(size_t)r * NP + C_Z + ch]);
            y[j] = (F.ydir()[(size_t)r * 256 + ch] + F.ydir()[((size_t)NROW + r) * 256 + ch] + dsk * xv) * siluf(z); ss += y[j] * y[j]; }
        const float rs = rsqrtf(wsum(ss) * (1.f / 256) + EPS);
#pragma unroll
        for (int j = 0; j < 4; ++j) { const int ch = F.lane * 4 + j; F.mix()[(size_t)r * DM + 768 + ch] = f2bf(y[j] * rs * F.ssd_gn()[L * 256 + ch]); }
    }
}

template <int S8> __device__ __forceinline__ bf16x8 pack_step(const f32x16& x) {
    u32x4 p;
    asm volatile("v_cvt_pk_bf16_f32 %0, %4, %5\n\tv_cvt_pk_bf16_f32 %1, %6, %7\n\tv_cvt_pk_bf16_f32 %2, %8, %9\n\tv_cvt_pk_bf16_f32 %3, %10, %11\n\ts_nop 1"
                 : "=&v"(p[0]), "=&v"(p[1]), "=&v"(p[2]), "=&v"(p[3])
                 : "v"(x[S8]), "v"(x[S8 + 1]), "v"(x[S8 + 2]), "v"(x[S8 + 3]), "v"(x[S8 + 4]), "v"(x[S8 + 5]), "v"(x[S8 + 6]), "v"(x[S8 + 7]));
    return __builtin_bit_cast(bf16x8, p);
}
constexpr float LOG2E = 1.4426950408889634f;
template <int KIND>
__device__ __forceinline__ void attn_unit(const Fr& F, int L, int b, int h, int qb) {
    constexpr int QS = KIND == 1 ? 96 : 64, NKS = KIND == 1 ? 6 : (KIND == 0 ? 4 : 2);
    constexpr int PK = QS * 2 + 16, PV = 144, KBYTES = 64 * PK, VBYTES = 64 * PV;
    LAS unsigned char* const Kl = F.lds; LAS unsigned char* const Vl = F.lds + 2 * KBYTES;
    LAS float* const biasl = (LAS float*)(F.lds + 2 * KBYTES + 2 * VBYTES);
    const int lane = F.lane, wave = F.wave, tid = F.tid, r = lane & 31, hh = lane >> 5;
    const bool isctx = qb < 0;
    const int comp = KIND == 2 ? (wave & 1) : 0, qg = KIND == 2 ? (wave >> 1) : wave;
    const bf16* Qg = (KIND == 0 ? F.qna() : KIND == 1 ? F.qml() : F.qdf()) + (size_t)(b * 4 + h) * SQ * QS;
    const bf16* Kg = (KIND == 0 ? F.kna() : KIND == 1 ? F.kml() : F.kdf()) + (size_t)(b * 4 + h) * SQ * QS;
    const bf16* Vg = (KIND == 0 ? F.vna() : KIND == 1 ? F.vml() : F.vdf()) + (size_t)(b * 4 + h) * 64 * SQ;
    const float cs = (KIND == 1 ? 0.10206207261596577f : (KIND == 0 ? 0.125f : 0.17677669529663687f)) * LOG2E;
    int sq, qrow = 0, qcol = 0;
    if (KIND == 2) sq = (isctx ? 128 * (-qb - 1) : 256 + 128 * qb) + 32 * qg + r;
    else if (isctx) sq = 32 * wave + r; else if (KIND == 0) { qrow = 4 * qb + (wave >> 1); qcol = 32 * (wave & 1) + r; sq = 256 + 64 * qrow + qcol; } else sq = 256 + 256 * qb + 32 * wave + r;
    int nt = 36, lo_u = 0;
    if (isctx) nt = 4; else if (KIND == 0) { lo_u = min(max(4 * qb - 4, 0), 24); nt = 4 + min(max(4 * qb - 1, 0), 24) + 8 - lo_u; }
    const int my_lo = min(max(qrow - 4, 0), 24), col_lo = min(max(qcol - 8, 0), 48);
    if (KIND == 0 && !isctx) for (int i = tid; i < 465; i += 512) biasl[i] = F.na_rb()[(L * 4 + h) * 465 + i] * LOG2E;
    bf16x8 Q[NKS];
    { const bf16* qp = Qg + (size_t)sq * QS + comp * 32 + 8 * hh;
#pragma unroll
      for (int kk = 0; kk < NKS; ++kk) Q[kk] = *(const bf16x8*)(qp + 16 * kk); }
    f32x16 O[2]; float m = -INFINITY, l = 0.f;
#pragma unroll
    for (int mt = 0; mt < 2; ++mt)
#pragma unroll
        for (int i = 0; i < 16; ++i) O[mt][i] = 0.f;
    const int kp0 = tid, kp1 = tid + 512;
    const int kr0 = QS == 96 ? kp0 / 12 : kp0 >> 3, kc0 = QS == 96 ? (kp0 % 12) * 16 : (kp0 & 7) * 16;
    const int kr1 = kp1 / 12, kc1 = (kp1 % 12) * 16;
    const int vr0 = tid >> 3, vc0 = (tid & 7) * 16;
    u32x4 rk0_0, rk1_0, rv0_0, rk0_1, rk1_1, rv0_1;
    rk1_0 = (u32x4){0u, 0u, 0u, 0u}; rk1_1 = rk1_0;
#define AT_SK0(t) ((isctx || KIND != 0) ? 64 * (t) : ((t) < 4 ? 64 * (t) : 256 + 64 * (lo_u + (t) - 4)))
#define AT_LOAD(t, S_) do { const int sk0_ = AT_SK0(t); const char* kg_ = (const char*)(Kg + (size_t)sk0_ * QS); rk0_##S_ = *(const u32x4*)(kg_ + kp0 * 16); \
        if (QS == 96 && tid < 256) rk1_##S_ = *(const u32x4*)(kg_ + kp1 * 16); rv0_##S_ = *(const u32x4*)((const char*)(Vg + (size_t)vr0 * SQ + sk0_) + vc0); } while (0)
#define AT_STORE(buf, S_) do { *(LAS u32x4*)(Kl + (buf) * KBYTES + kr0 * PK + kc0) = rk0_##S_; if (QS == 96 && tid < 256) *(LAS u32x4*)(Kl + (buf) * KBYTES + kr1 * PK + kc1) = rk1_##S_; \
        *(LAS u32x4*)(Vl + (buf) * VBYTES + vr0 * PV + vc0) = rv0_##S_; } while (0)
#define AT_COMPUTE(t_, buf_) do { \
        const int krow = lo_u + (t_) - 4; \
        const bool nbt = (KIND == 0) && !isctx && (t_) >= 4; \
        const bool mine = !nbt || (krow >= my_lo && krow < my_lo + 8); \
        if (mine) { \
            const LAS unsigned char* Kb = Kl + (buf_) * KBYTES + r * PK + (comp * 32 + 8 * hh) * 2; const LAS unsigned char* Vb = Vl + (buf_) * VBYTES + r * PV + 16 * hh; \
            f32x16 S0, S1; \
            _Pragma("unroll") for (int i = 0; i < 16; ++i) { S0[i] = 0.f; S1[i] = 0.f; } \
            _Pragma("unroll") for (int kk = 0; kk < NKS; ++kk) { const bf16x8 a0 = *(const LAS bf16x8*)(Kb + 32 * kk), a1 = *(const LAS bf16x8*)(Kb + 32 * PK + 32 * kk); \
                S0 = MFMA32(a0, Q[kk], S0); S1 = MFMA32(a1, Q[kk], S1); } \
            float tmax = -INFINITY; \
            if (nbt) { const int drow = (krow - qrow + 7) * 31 - qcol + 15; \
                _Pragma("unroll") for (int i = 0; i < 16; ++i) { const int kc = (i & 3) + 8 * (i >> 2) + 4 * hh; \
                    { const bool v = (unsigned)(kc - col_lo) < 16u; const float bb = biasl[v ? drow + kc : 0]; S0[i] = v ? S0[i] * cs + bb : -INFINITY; } \
                    { const bool v = (unsigned)(kc + 32 - col_lo) < 16u; const float bb = biasl[v ? drow + kc + 32 : 0]; S1[i] = v ? S1[i] * cs + bb : -INFINITY; } \
                    tmax = fmaxf(tmax, fmaxf(S0[i], S1[i])); } \
            } else { \
                _Pragma("unroll") for (int i = 0; i < 16; ++i) tmax = fmaxf(tmax, fmaxf(S0[i], S1[i])); \
                tmax *= cs; } \
            tmax = fmaxf(tmax, __shfl_xor(tmax, 32)); \
            if (__any(tmax > m + 8.f)) { const float mn = fmaxf(m, tmax), al = __builtin_amdgcn_exp2f(m - mn); m = mn; l *= al; \
                _Pragma("unroll") for (int mt = 0; mt < 2; ++mt) _Pragma("unroll") for (int i = 0; i < 16; ++i) O[mt][i] *= al; } \
            float ps = 0.f; \
            if (nbt) { \
                _Pragma("unroll") for (int i = 0; i < 16; ++i) { S0[i] = __builtin_amdgcn_exp2f(S0[i] - m); S1[i] = __builtin_amdgcn_exp2f(S1[i] - m); ps += S0[i] + S1[i]; } \
            } else { const float nm = -m; \
                _Pragma("unroll") for (int i = 0; i < 16; ++i) { S0[i] = __builtin_amdgcn_exp2f(__builtin_fmaf(S0[i], cs, nm)); S1[i] = __builtin_amdgcn_exp2f(__builtin_fmaf(S1[i], cs, nm)); ps += S0[i] + S1[i]; } } \
            l += ps; \
            const bf16x8 p00 = pack_step<0>(S0), p01 = pack_step<8>(S0), p10 = pack_step<0>(S1), p11 = pack_step<8>(S1); \
            _Pragma("unroll") for (int mt = 0; mt < 2; ++mt) { \
                const LAS unsigned char* vb = Vb + mt * 32 * PV; \
                O[mt] = MFMA32(*(const LAS bf16x8*)(vb + 0), p00, O[mt]); O[mt] = MFMA32(*(const LAS bf16x8*)(vb + 32), p01, O[mt]); \
                O[mt] = MFMA32(*(const LAS bf16x8*)(vb + 64), p10, O[mt]); O[mt] = MFMA32(*(const LAS bf16x8*)(vb + 96), p11, O[mt]); } \
        } } while (0)
    AT_LOAD(0, 0); if (nt > 1) AT_LOAD(1, 1);
    AT_STORE(0, 0);
    __syncthreads();
    for (int t = 0; t < nt; t += 2) {
        if (t + 2 < nt) AT_LOAD(t + 2, 0);
        AT_COMPUTE(t, 0);
        if (t + 1 < nt) AT_STORE(1, 1);
        __syncthreads();
        if (t + 1 >= nt) break;
        if (t + 3 < nt) AT_LOAD(t + 3, 1);
        AT_COMPUTE(t + 1, 1);
        if (t + 2 < nt) AT_STORE(0, 0);
        __syncthreads();
    }
#undef AT_COMPUTE
#undef AT_SK0
#undef AT_LOAD
#undef AT_STORE
    const float inv = 1.f / (l + __shfl_xor(l, 32));
    bf16* mo = F.mix() + (size_t)bs2row(b, sq) * DM + (KIND == 0 ? 0 : KIND == 1 ? 256 : 512) + h * 64 + 4 * hh;
    if (KIND == 2) {
        LAS float* xo = (LAS float*)F.lds + qg * 2048;
        if (comp == 1) {
#pragma unroll
            for (int mt = 0; mt < 2; ++mt)
#pragma unroll
                for (int i = 0; i < 16; ++i) xo[(mt * 16 + i) * 64 + lane] = O[mt][i] * inv; }
        __syncthreads();
        if (comp == 0) {
            const float* lv = F.df_lam() + L * 128; const float li = 0.8f - 0.6f * expf(-0.3f * (float)L);
            float d1 = 0.f, d2 = 0.f;
#pragma unroll
            for (int i = 0; i < 32; ++i) { d1 += lv[i] * lv[32 + i]; d2 += lv[64 + i] * lv[96 + i]; }
            const float lam = expf(d1) - expf(d2) + li;
            float ss = 0.f;
#pragma unroll
            for (int mt = 0; mt < 2; ++mt)
#pragma unroll
                for (int i = 0; i < 16; ++i) { const float o = O[mt][i] * inv - lam * xo[(mt * 16 + i) * 64 + lane]; O[mt][i] = o; ss += o * o; }
            ss += __shfl_xor(ss, 32);
            const float rs = rsqrtf(ss * (1.f / 64) + EPS) * (1.f - li);
#pragma unroll
            for (int mt = 0; mt < 2; ++mt)
#pragma unroll
                for (int g = 0; g < 4; ++g) { const f32x4 gs = *(const f32x4*)(F.df_gsub() + L * 64 + 32 * mt + 8 * g + 4 * hh);
                    u32x2 w; w.x = pk2(O[mt][4 * g] * rs * gs[0], O[mt][4 * g + 1] * rs * gs[1]); w.y = pk2(O[mt][4 * g + 2] * rs * gs[2], O[mt][4 * g + 3] * rs * gs[3]);
                    *(u32x2*)(mo + 32 * mt + 8 * g) = w; }
        }
        __syncthreads();
    } else {
#pragma unroll
        for (int mt = 0; mt < 2; ++mt)
#pragma unroll
            for (int g = 0; g < 4; ++g) { u32x2 w; w.x = pk2(O[mt][4 * g] * inv, O[mt][4 * g + 1] * inv); w.y = pk2(O[mt][4 * g + 2] * inv, O[mt][4 * g + 3] * inv);
                *(u32x2*)(mo + 32 * mt + 8 * g) = w; }
    }
}
__device__ __forceinline__ float ssd_cum(const Fr& F, int L, int b, int h, int d, int s0, float& dt, float& cum) {
    const int lane = F.lane;
    dt = F.dtv()[((size_t)b * 8 + d * 4 + h) * SQ + s0 + lane];
    const float la = dt * -__expf(F.a_log()[L * 8 + d * 4 + h]);
    float v = la;
#pragma unroll
    for (int o = 1; o < 64; o <<= 1) { const float t = __shfl_up(v, o); if (lane >= o) v += t; }
    const float total = __shfl(v, 63);
    cum = d == 0 ? v : total - v + la;
    return total;
}
__device__ __forceinline__ void ssd_s1_job(const Fr& F, int L, int b, int c, int h, LAS float* scr) {
    const int lane = F.lane, r = lane & 31, hh = lane >> 5, s0 = 64 * c, g = h >> 1;
#pragma unroll
    for (int d = 0; d < 2; ++d) { float dt, cum; const float tot = ssd_cum(F, L, b, h, d, s0, dt, cum); scr[d * 64 + lane] = dt * __expf(tot - cum);
        if (lane == 0) F.cdec()[((b * 2 + d) * 4 + h) * 36 + c] = __expf(tot); }
    LDS_WAIT();
    bf16x8 A[2][2][4];
#pragma unroll
    for (int mt = 0; mt < 2; ++mt)
#pragma unroll
        for (int kk = 0; kk < 4; ++kk) { const bf16x8 raw = *(const bf16x8*)(F.xT() + ((size_t)b * 256 + h * 64 + 32 * mt + r) * SQ + s0 + 16 * kk + 8 * hh);
#pragma unroll
            for (int d = 0; d < 2; ++d) { u32x4 o;
#pragma unroll
                for (int j = 0; j < 4; ++j) { const float w0 = scr[d * 64 + 16 * kk + 8 * hh + 2 * j], w1 = scr[d * 64 + 16 * kk + 8 * hh + 2 * j + 1];
                    o[j] = pk2(bf2f((bf16)raw[2 * j]) * w0, bf2f((bf16)raw[2 * j + 1]) * w1); }
                A[d][mt][kk] = __builtin_bit_cast(bf16x8, o); } }
#pragma unroll
    for (int nt = 0; nt < 4; ++nt) {
        bf16x8 Bf[4];
#pragma unroll
        for (int kk = 0; kk < 4; ++kk) Bf[kk] = *(const bf16x8*)(F.bT() + ((size_t)b * 256 + g * 128 + 32 * nt + r) * SQ + s0 + 16 * kk + 8 * hh);
#pragma unroll
        for (int d = 0; d < 2; ++d)
#pragma unroll
            for (int mt = 0; mt < 2; ++mt) { f32x16 acc;
#pragma unroll
                for (int i = 0; i < 16; ++i) acc[i] = 0.f;
#pragma unroll
                for (int kk = 0; kk < 4; ++kk) acc = MFMA32(A[d][mt][kk], Bf[kk], acc);
                float* dst = F.cst() + ((((size_t)(b * 2 + d) * 4 + h) * 36 + c) * 64 + 32 * mt) * 128 + 32 * nt + r;
#pragma unroll
                for (int i = 0; i < 16; ++i) dst[crow16(i, hh) * 128] = acc[i]; }
    }
    LDS_WAIT();
}
__device__ __forceinline__ void phase_ssd_s1(const Fr& F, int L) {
    LAS float* scr = (LAS float*)(F.lds + F.wave * 16384);
    for (int j = F.gw; j < NB * 36 * 4; j += F.NGW) ssd_s1_job(F, L, j / 144, (j / 4) % 36, j & 3, scr);
}
__device__ __forceinline__ void phase_ssd_scan(const Fr& F, int L) {
    for (int e = blockIdx.x * 512 + F.tid; e < NB * 2 * 4 * 8192; e += F.G * 512) {
        const int bdh = e >> 13, pn = e & 8191, d = (bdh >> 2) & 1;
        float hst = 0.f;
        for (int step = 0; step < 36; ++step) { const int c = d == 0 ? step : (step < 4 ? 3 - step : 39 - step);
            const size_t o = ((size_t)bdh * 36 + c) * 8192 + pn;
            F.hent()[o] = f2bf(hst);
            hst = hst * F.cdec()[bdh * 36 + c] + F.cst()[o]; }
    }
}
__device__ __forceinline__ void ssd_s3_unit(const Fr& F, int L, int b, int c) {
    const int lane = F.lane, wave = F.wave, r = lane & 31, hh = lane >> 5, s0 = 64 * c, h = wave >> 1, it = wave & 1, g = h >> 1, itok = 32 * it + r;
    LAS float* scr = (LAS float*)(F.lds + wave * 16384);
    LAS float* red = (LAS float*)(F.lds + 8192);
#pragma unroll
    for (int d = 0; d < 2; ++d) { float dt, cum; (void)ssd_cum(F, L, b, h, d, s0, dt, cum); scr[d * 128 + lane] = cum; scr[d * 128 + 64 + lane] = dt; }
    LDS_WAIT();
    bf16x8 Cf[8];
#pragma unroll
    for (int kk = 0; kk < 8; ++kk) Cf[kk] = *(const bf16x8*)(F.ctm() + ((size_t)b * SQ + s0 + itok) * 256 + g * 128 + 16 * kk + 8 * hh);
    f32x16 G[2];
#pragma unroll
    for (int jt = 0; jt < 2; ++jt) {
#pragma unroll
        for (int i = 0; i < 16; ++i) G[jt][i] = 0.f;
#pragma unroll
        for (int kk = 0; kk < 8; ++kk) { const bf16x8 bf = *(const bf16x8*)(F.btm() + ((size_t)b * SQ + s0 + 32 * jt + r) * 256 + g * 128 + 16 * kk + 8 * hh); G[jt] = MFMA32(bf, Cf[kk], G[jt]); } }
    bf16x8 X[2][4];
#pragma unroll
    for (int mt = 0; mt < 2; ++mt)
#pragma unroll
        for (int ks = 0; ks < 4; ++ks) { const bf16* xp = F.xT() + ((size_t)b * 256 + h * 64 + 32 * mt + r) * SQ + s0 + 16 * ks + 4 * hh;
            const u32x2 lo = *(const u32x2*)xp, hi = *(const u32x2*)(xp + 8); u32x4 o; o.x = lo.x; o.y = lo.y; o.z = hi.x; o.w = hi.y; X[mt][ks] = __builtin_bit_cast(bf16x8, o); }
    f32x16 Y[2];
#pragma unroll
    for (int mt = 0; mt < 2; ++mt)
#pragma unroll
        for (int i = 0; i < 16; ++i) Y[mt][i] = 0.f;
    const float Dsum = F.ssd_d()[L * 8 + h] + F.ssd_d()[L * 8 + 4 + h];
#pragma unroll 1
    for (int d = 0; d < 2; ++d) {
        const float cum_i = scr[d * 128 + itok];
        f32x16 Pm[2];
#pragma unroll
        for (int jt = 0; jt < 2; ++jt)
#pragma unroll
            for (int i = 0; i < 16; ++i) { const int j = 32 * jt + crow16(i, hh); const bool valid = d == 0 ? (j <= itok) : (j >= itok);
                const float arg = valid ? cum_i - scr[d * 128 + j] : -INFINITY;
                float pv = G[jt][i] * __expf(arg) * scr[d * 128 + 64 + j];
                if (d == 0 && j == itok) pv += Dsum;
                Pm[jt][i] = pv; }
        const bf16x8 p0 = pack_step<0>(Pm[0]), p1 = pack_step<8>(Pm[0]), p2 = pack_step<0>(Pm[1]), p3 = pack_step<8>(Pm[1]);
#pragma unroll
        for (int mt = 0; mt < 2; ++mt) { Y[mt] = MFMA32(X[mt][0], p0, Y[mt]); Y[mt] = MFMA32(X[mt][1], p1, Y[mt]); Y[mt] = MFMA32(X[mt][2], p2, Y[mt]); Y[mt] = MFMA32(X[mt][3], p3, Y[mt]); }
        const float ei = __expf(cum_i);
#pragma unroll
        for (int mt = 0; mt < 2; ++mt) { f32x16 T;
#pragma unroll
            for (int i = 0; i < 16; ++i) T[i] = 0.f;
#pragma unroll
            for (int kk = 0; kk < 8; ++kk) { const bf16x8 hf = *(const bf16x8*)(F.hent() + ((((size_t)(b * 2 + d) * 4 + h) * 36 + c) * 64 + 32 * mt + r) * 128 + 16 * kk + 8 * hh); T = MFMA32(hf, Cf[kk], T); }
#pragma unroll
            for (int i = 0; i < 16; ++i) Y[mt][i] += ei * T[i]; }
    }
    const size_t row = bs2row(b, s0 + itok);
    const bf16* zp = F.pbuf() + row * NP + C_Z + h * 64 + 4 * hh;
    float ss = 0.f;
#pragma unroll
    for (int mt = 0; mt < 2; ++mt)
#pragma unroll
        for (int gq = 0; gq < 4; ++gq) { const u32x2 z4 = *(const u32x2*)(zp + 32 * mt + 8 * gq);
            const float z0 = __uint_as_float(z4.x << 16), z1 = __uint_as_float(z4.x & 0xffff0000u), z2 = __uint_as_float(z4.y << 16), z3 = __uint_as_float(z4.y & 0xffff0000u);
            Y[mt][4 * gq] *= siluf(z0); Y[mt][4 * gq + 1] *= siluf(z1); Y[mt][4 * gq + 2] *= siluf(z2); Y[mt][4 * gq + 3] *= siluf(z3);
            ss += (Y[mt][4 * gq] * Y[mt][4 * gq] + Y[mt][4 * gq + 1] * Y[mt][4 * gq + 1]) + (Y[mt][4 * gq + 2] * Y[mt][4 * gq + 2] + Y[mt][4 * gq + 3] * Y[mt][4 * gq + 3]); }
    ss += __shfl_xor(ss, 32);
    if (hh == 0) red[(it * 4 + h) * 32 + r] = ss;
    __syncthreads();
    const float tot = (red[(it * 4 + 0) * 32 + r] + red[(it * 4 + 1) * 32 + r]) + (red[(it * 4 + 2) * 32 + r] + red[(it * 4 + 3) * 32 + r]);
    const float rs = rsqrtf(tot * (1.f / 256) + EPS);
    bf16* mo = F.mix() + row * DM + 768 + h * 64 + 4 * hh;
#pragma unroll
    for (int mt = 0; mt < 2; ++mt)
#pragma unroll
        for (int gq = 0; gq < 4; ++gq) { const f32x4 gn = *(const f32x4*)(F.ssd_gn() + L * 256 + h * 64 + 32 * mt + 8 * gq + 4 * hh);
            u32x2 w; w.x = pk2(Y[mt][4 * gq] * rs * gn[0], Y[mt][4 * gq + 1] * rs * gn[1]); w.y = pk2(Y[mt][4 * gq + 2] * rs * gn[2], Y[mt][4 * gq + 3] * rs * gn[3]);
            *(u32x2*)(mo + 32 * mt + 8 * gq) = w; }
    __syncthreads();
}
template <int KIND> __device__ __forceinline__ void attn_units(const Fr& F, int L) {
    if (KIND == 2) { const int nu = (L == DEPTH - 1) ? 512 : 576;
        for (int u = F.vcu; u < nu; u += F.G) { if (u < 512) attn_unit<2>(F, L, u >> 6, (u >> 4) & 3, u & 15); else attn_unit<2>(F, L, (u - 512) >> 3, ((u - 512) >> 1) & 3, -1 - (u & 1)); }
    } else { const int nu = (L == DEPTH - 1) ? 256 : 288;
        for (int u = F.vcu; u < nu; u += F.G) { if (u < 256) attn_unit<KIND>(F, L, u >> 5, (u >> 3) & 3, u & 7); else attn_unit<KIND>(F, L, (u - 256) >> 2, (u - 256) & 3, -1); } }
}
__device__ __forceinline__ void phase_mix_fast(const Fr& F, int L) {
#ifndef ATT_MASK
#define ATT_MASK 7
#endif
#ifndef ATT_DUP
#define ATT_DUP 0
#endif
    for (int rp = 0; rp < ((ATT_DUP & 4) ? 2 : 1); ++rp) attn_units<2>(F, L);
    for (int rp = 0; rp < ((ATT_DUP & 2) ? 2 : 1); ++rp) attn_units<1>(F, L);
    for (int rp = 0; rp < ((ATT_DUP & 1) ? 2 : 1); ++rp) attn_units<0>(F, L);
    const int c0 = (L == DEPTH - 1) ? 4 : 0;
    for (int rp = 0; rp < ((ATT_DUP & 8) ? 2 : 1); ++rp)
    for (int u = F.vcu; u < NB * (36 - c0); u += F.G) ssd_s3_unit(F, L, u / (36 - c0), c0 + u % (36 - c0));
}

__device__ __forceinline__ void phase_route(const Fr& F, int L, bool commit = true) {
    const int nrows = (L == DEPTH - 1) ? NLAT : NROW;
    LAS float* wl = (LAS float*)F.lds;
    {   const f32x4* wg4 = (const f32x4*)(F.w_grp() + (size_t)L * DM * 4); const f32x4* we4 = (const f32x4*)(F.w_exp() + (size_t)L * DM * 16);
        f32x4 tg[2], te[8];
#pragma unroll
        for (int n = 0; n < 2; ++n) tg[n] = wg4[F.tid + 512 * n];
#pragma unroll
        for (int n = 0; n < 8; ++n) te[n] = we4[F.tid + 512 * n];
#pragma unroll
        for (int n = 0; n < 2; ++n) { const int k = F.tid + 512 * n;
#pragma unroll
            for (int o = 0; o < 4; ++o) wl[o * DM + k] = tg[n][o]; }
#pragma unroll
        for (int n = 0; n < 8; ++n) { const int i = F.tid + 512 * n, k = i >> 2, q = i & 3;
#pragma unroll
            for (int o = 0; o < 4; ++o) wl[(4 + 4 * q + o) * DM + k] = te[n][o]; }
    }
    __syncthreads();
    float keep[20];
#pragma unroll
    for (int o = 0; o < 20; ++o) keep[o] = 0.f;
    f32x4 v[4], vn[4];
    { const int r = F.gw; if (r < nrows) { const float* hp = r < NLAT ? F.out() + (size_t)r * DM : F.hc() + (size_t)(r - NLAT) * DM;
#pragma unroll
        for (int j = 0; j < 4; ++j) vn[j] = *(const f32x4*)(hp + 4 * F.lane + 256 * j); } }
    int it = 0;
    for (int r = F.gw; r < nrows; r += F.NGW, ++it) {
        const bool lat = r < NLAT; const int bb = lat ? (r >> 11) : 8;
#pragma unroll
        for (int j = 0; j < 4; ++j) v[j] = vn[j];
        { const int rn = r + F.NGW; if (rn < nrows) { const float* hp = rn < NLAT ? F.out() + (size_t)rn * DM : F.hc() + (size_t)(rn - NLAT) * DM;
#pragma unroll
            for (int j = 0; j < 4; ++j) vn[j] = *(const f32x4*)(hp + 4 * F.lane + 256 * j); } }
        float ss = 0.f;
#pragma unroll
        for (int j = 0; j < 4; ++j) ss += (v[j][0] * v[j][0] + v[j][1] * v[j][1]) + (v[j][2] * v[j][2] + v[j][3] * v[j][3]);
        const float rstd = rsqrtf(wsum(ss) * (1.f / DM) + EPS);
        const float* md = F.modv() + ((size_t)L * 9 + bb) * 6144;
        float lg[20];
#pragma unroll
        for (int o = 0; o < 20; ++o) lg[o] = 0.f;
#pragma unroll
        for (int j = 0; j < 4; ++j) { const int c = 4 * F.lane + 256 * j; const f32x4 g = *(const f32x4*)(F.g_ffn() + L * DM + c), sh = *(const f32x4*)(md + 3 * 1024 + c), scl = *(const f32x4*)(md + 4 * 1024 + c);
            const f32x4 f = v[j] * rstd * g * (scl + 1.f) + sh; u32x2 o2; o2.x = pk2(f[0], f[1]); o2.y = pk2(f[2], f[3]); *(u32x2*)(F.abuf() + (size_t)r * DM + c) = o2;
#pragma unroll
            for (int o = 0; o < 20; ++o) { const f32x4 w = *(const LAS f32x4*)(wl + o * DM + c); lg[o] += (f[0] * w[0] + f[1] * w[1]) + (f[2] * w[2] + f[3] * w[3]); }
            asm volatile("" ::: "memory"); }
#pragma unroll
        for (int o = 0; o < 20; ++o) { const float t = wsum(lg[o]); keep[o] = (F.lane == it) ? t : keep[o]; }
    }
    if (F.lane < it) {
        const int r = F.gw + F.lane * F.NGW;
        float gl[4]; float gm = -INFINITY; int gt = 0;
#pragma unroll
        for (int o = 0; o < 4; ++o) { gl[o] = keep[o] + F.b_grp()[L * 4 + o]; if (gl[o] > gm) { gm = gl[o]; gt = o; } }
        float gs = 0.f;
#pragma unroll
        for (int o = 0; o < 4; ++o) gs += expf(gl[o] - gm);
        const float gp = 1.f / gs;
        float el[4];
#pragma unroll
        for (int o = 0; o < 4; ++o) { float v4 = 0.f;
#pragma unroll
            for (int q = 0; q < 4; ++q) v4 = (gt == q) ? keep[4 + 4 * q + o] + F.b_exp()[L * 16 + 4 * q + o] : v4;
            el[o] = v4; }
        int i0 = 0; float m0 = el[0];
#pragma unroll
        for (int o = 1; o < 4; ++o) if (el[o] > m0) { m0 = el[o]; i0 = o; }
        int i1 = i0 == 0 ? 1 : 0; float m1 = i0 == 0 ? el[1] : el[0];
#pragma unroll
        for (int o = 1; o < 4; ++o) if (o != i0 && el[o] > m1) { m1 = el[o]; i1 = o; }
        const float e1 = expf(m1 - m0), w0 = gp / (1.f + e1), w1 = gp * e1 / (1.f + e1);
        const int x0 = gt * 4 + i0, x1 = gt * 4 + i1;
        if (commit) {
            F.rtw()[2 * r] = w0; F.rtw()[2 * r + 1] = w1;
            const unsigned p0 = atomicAdd(F.ctl() + CW_ECNT + (L * 16 + x0) * 64, 1u), p1 = atomicAdd(F.ctl() + CW_ECNT + (L * 16 + x1) * 64, 1u);
            F.elist()[x0 * NROW + p0] = 2 * r; F.elist()[x1 * NROW + p1] = 2 * r + 1; }
        else if (w0 + w1 < -1.f) F.rtw()[0] = 0.f;
    }
    __syncthreads();
}
__device__ __forceinline__ void moe_table(const Fr& F, int L) {
    volatile LAS int* T = (volatile LAS int*)(F.lds + LDSCTL_OFF + 64);
    volatile LAS int* Cn = (volatile LAS int*)(F.lds + LDSCTL_OFF + 160);
    __syncthreads();
    if (F.tid == 0) { int acc = 0;
        for (int e = 0; e < 16; ++e) { int c = (int)__hip_atomic_load(F.ctl() + CW_ECNT + (L * 16 + e) * 64, __ATOMIC_RELAXED, __HIP_MEMORY_SCOPE_AGENT); c = min(max(c, 0), NROW); T[e] = acc; Cn[e] = c; acc += (c + 255) >> 8; }
        T[16] = acc; }
    __syncthreads();
}

__global__ void __launch_bounds__(512, 2) fwd_kernel(Args args) {
    extern __shared__ __attribute__((aligned(16))) unsigned char lds_raw[];
    Fr F0;
    F0.lds = (LAS unsigned char*)lds_raw; F0.tid = threadIdx.x; F0.lane = F0.tid & 63; F0.wave = __builtin_amdgcn_readfirstlane(F0.tid >> 6);
    F0.G = gridDim.x; { const int bx = blockIdx.x; F0.vcu = (F0.G % 8 == 0) ? (bx % 8) * (F0.G / 8) + bx / 8 : bx; }
    F0.gw = F0.vcu * 8 + F0.wave; F0.NGW = F0.G * 8;
    F0.A = (const __attribute__((address_space(4))) Args*)__builtin_amdgcn_kernarg_segment_ptr();
    for (int u = F0.tid; u < (LDS_BYTES - LDSCTL_OFF) / 4; u += 512) ((LAS unsigned*)(F0.lds + LDSCTL_OFF))[u] = 0u;
    __syncthreads();
    const int lo = args.ph_lo, hi = args.ph_hi;
    XcdBarrier bar; bar.bar = F0.ctl() + CW_BAR; bar.x = 0; bar.st = nullptr;
    if (hi - lo > 1) bar = xcd_barrier_post(F0.ctl() + CW_BAR, (volatile LAS unsigned*)(F0.lds + LDSCTL_OFF));
#ifndef PH_MASK
#define PH_MASK 0xFFFF
#endif
#define PM(b) ((PH_MASK >> (b)) & 1)
#ifndef DUP_MASK
#define DUP_MASK 0
#endif
#ifndef DBL_SEAM
#define DBL_SEAM 0
#endif
#define NREP(b) (((DUP_MASK >> (b)) & 1) ? 2 : 1)
#define IN(k) (lo <= (k) && (k) < hi)
#define SEAM(k) do { if (IN(k) && IN((k) + 1)) { const Fr Fb = refresh(F0); XcdBarrier b2 = bar; b2.bar = Fb.ctl() + CW_BAR; xcd_barrier(b2); if ((DUP_MASK & 0x10000) || ((DBL_SEAM >> (((k) + NPH_L - 1) % NPH_L)) & 1)) xcd_barrier(b2); } } while (0)

    if (PM(0) && IN(0)) { for (int rep_ = 0; rep_ < NREP(0); ++rep_) { if (rep_) __syncthreads(); const Fr F = refresh(F0); phase_prologue(F); } }
    SEAM(0);
    for (int L = 0; L < DEPTH; ++L) {
        const int pb = 1 + NPH_L * L;
        const bool lastL = (L == DEPTH - 1);
        if (PM(1) && IN(pb + 0)) { const Fr F = refresh(F0); phase_norm(F, L); if (DUP_MASK & 2048) { __syncthreads(); phase_norm(F, L, false); } for (int rp = 0; rp < NREP(10); ++rp) moe_weight_convert(F, L); }
        SEAM(pb + 0);
        if (PM(2) && IN(pb + 1)) { for (int rep_ = 0; rep_ < NREP(2); ++rep_) { if (rep_) __syncthreads(); const Fr F = refresh(F0); pg8::DenseSched S; S.init(F.abuf(), F.winT() + (size_t)L * NP * DM, DM, NROW, NP, F.G, (int)blockIdx.x); pg8::EpiP E{F.pbuf()}; pg8::gemm_phase(F.lds, F.tid, DM, S, E); } }
        SEAM(pb + 1);
        if (PM(3) && IN(pb + 2)) { for (int rep_ = 0; rep_ < NREP(3); ++rep_) { if (rep_) __syncthreads(); const Fr F = refresh(F0); phase_prep(F, L); } }
        SEAM(pb + 2);
        if (PM(4) && IN(pb + 3)) { for (int rep_ = 0; rep_ < NREP(4); ++rep_) { if (rep_) __syncthreads(); const Fr F = refresh(F0); phase_ssd_s1(F, L); } }
        SEAM(pb + 3);
        if (PM(4) && IN(pb + 4)) { for (int rep_ = 0; rep_ < NREP(6); ++rep_) { if (rep_) __syncthreads(); const Fr F = refresh(F0); phase_ssd_scan(F, L); } }
        SEAM(pb + 4);
        if (PM(5) && IN(pb + 5)) { for (int rep_ = 0; rep_ < NREP(5); ++rep_) { if (rep_) __syncthreads(); const Fr F = refresh(F0); phase_mix_fast(F, L); } }
        SEAM(pb + 5);
        if (PM(6) && IN(pb + 6)) { const Fr F = refresh(F0); pg8::DenseSched S; S.init(F.mix(), F.woutT() + (size_t)L * DM * DM, DM, lastL ? NLAT : NROW, DM, F.G, (int)blockIdx.x);
            pg8::EpiRes E{L == 0 ? F.x() : F.out(), L == 0 ? F.ctx() : F.hc(), F.out(), F.hc(), F.modv() + (size_t)L * 9 * 6144 + 2 * 1024, 1.f}; pg8::gemm_phase(F.lds, F.tid, DM, S, E);
            if (DUP_MASK & 8192) { __syncthreads(); pg8::EpiRes E2{F.out(), F.hc(), F.out(), F.hc(), F.modv() + (size_t)L * 9 * 6144 + 2 * 1024, 0.f}; pg8::gemm_phase(F.lds, F.tid, DM, S, E2); } }
        SEAM(pb + 6);
        if (PM(7) && IN(pb + 7)) { const Fr F = refresh(F0); phase_route(F, L); if (DUP_MASK & 4096) phase_route(F, L, false); }
        SEAM(pb + 7);
        if (PM(8) && IN(pb + 8)) { for (int rep_ = 0; rep_ < NREP(8); ++rep_) { if (rep_) __syncthreads(); const Fr F = refresh(F0); moe_table(F, L);
            pg8::MoeSched<true> S{(const char*)F.abuf(), (const char*)F.wgu(), (size_t)1024 * DM * 2, DM, F.G, F.vcu, F.elist(), (const volatile LAS int*)(F.lds + LDSCTL_OFF + 64), (const volatile LAS int*)(F.lds + LDSCTL_OFF + 160)};
            pg8::EpiAct E{F.act()}; pg8::gemm_phase(F.lds, F.tid, DM, S, E); } }
        SEAM(pb + 8);
        if (PM(9) && IN(pb + 9)) { for (int rep_ = 0; rep_ < NREP(9); ++rep_) { if (rep_) __syncthreads(); const Fr F = refresh(F0); moe_table(F, L);
            pg8::MoeSched<false> S{(const char*)F.act(), (const char*)F.wd(), (size_t)1024 * FF * 2, FF, F.G, F.vcu, F.elist(), (const volatile LAS int*)(F.lds + LDSCTL_OFF + 64), (const volatile LAS int*)(F.lds + LDSCTL_OFF + 160)};
            pg8::EpiDown E{F.yk(), F.elist(), F.rtw()}; pg8::gemm_phase(F.lds, F.tid, FF, S, E); } }
        SEAM(pb + 9);
    }
    if (PM(1) && IN(PH_FINAL)) { const Fr F = refresh(F0); phase_norm(F, DEPTH); }
#undef IN
#undef SEAM
}

extern "C" void kernel_launch(void* const* d_in, const int* in_sizes, int n_in, void* d_out, int out_size, void* d_ws, size_t ws_size, hipStream_t stream) {
    static int grid = 0;
    if (grid == 0) {
        if (n_in != 36 || out_size != NLAT * DM || ws_size < WS_END) { fprintf(stderr, "kernel_launch: unexpected shapes (n_in %d out %d ws %zu)\n", n_in, out_size, ws_size); grid = -1; return; }
        int dev = 0, cus = 0, per_cu = 0;
        if (hipGetDevice(&dev) != hipSuccess || hipDeviceGetAttribute(&cus, hipDeviceAttributeMultiprocessorCount, dev) != hipSuccess) { grid = -1; return; }
        if (hipFuncSetAttribute((const void*)fwd_kernel, hipFuncAttributeMaxDynamicSharedMemorySize, LDS_BYTES) != hipSuccess) { fprintf(stderr, "kernel_launch: hipFuncSetAttribute failed\n"); grid = -1; return; }
        if (hipOccupancyMaxActiveBlocksPerMultiprocessor(&per_cu, (const void*)fwd_kernel, 512, LDS_BYTES) != hipSuccess || per_cu < 1) { fprintf(stderr, "kernel_launch: occupancy query says %d\n", per_cu); }
        (void)hipGetLastError();
        grid = cus;
    }
    if (grid < 0) return;
    (void)hipMemsetAsync((char*)d_ws + WS_CTL, 0, CTL_BYTES, stream);
    Args a{};
    for (int i = 0; i < 36; ++i) a.in[i] = (const float*)d_in[i];
    a.out = (float*)d_out; a.ws = (unsigned char*)d_ws;
#if MK_ONE_LAUNCH
    a.ph_lo = 0; a.ph_hi = NPHASE;
    hipLaunchKernelGGL(fwd_kernel, dim3(grid), dim3(512), LDS_BYTES, stream, a);
#else
    for (int ph = 0; ph < NPHASE; ++ph) { a.ph_lo = ph; a.ph_hi = ph + 1; hipLaunchKernelGGL(fwd_kernel, dim3(grid), dim3(512), LDS_BYTES, stream, a); }
#endif
}
```

```cpp
#include <hip/hip_runtime.h>
#include <cstdio>
#include <cstdint>

#ifndef MK_ONE_LAUNCH
#define MK_ONE_LAUNCH 1
#endif

#define LAS __attribute__((address_space(3)))
typedef unsigned short bf16;
typedef short bf16x8 __attribute__((ext_vector_type(8)));
typedef float f32x4 __attribute__((ext_vector_type(4)));
typedef float f32x2 __attribute__((ext_vector_type(2)));
typedef unsigned u32x4 __attribute__((ext_vector_type(4)));
typedef unsigned u32x2 __attribute__((ext_vector_type(2)));

constexpr int NB = 8, TLAT = 2048, TCTX = 256, SQ = 2304, DM = 1024, DEPTH = 4;
constexpr int NLAT = NB * TLAT, NCTXR = NB * TCTX, NROW = NLAT + NCTXR;
constexpr int NIN = 2984, NP = 3072;
constexpr int C_NA = 0, C_MLA = 768, C_DF = 1184, C_SSD = 1952;
constexpr int C_Z = C_SSD, C_XBC = C_SSD + 256, C_DT = C_SSD + 1024;
constexpr float EPS = 1e-6f;
constexpr int NEXP = 16, FF = 512, ACT_ROWS = 40960;
constexpr int NPH_L = 10, PH_FINAL = 1 + NPH_L * DEPTH, NPHASE = PH_FINAL + 1;

constexpr size_t MiB = 1u << 20;
constexpr size_t WS_CTL = 0, CTL_BYTES = 1 * MiB;
constexpr size_t WS_MOD = 1 * MiB;
constexpr size_t WS_ROPE = 2 * MiB;
constexpr size_t WS_WIN = 4 * MiB;
constexpr size_t WS_WOUT = 28 * MiB;
constexpr size_t WS_WQB = 36 * MiB;
constexpr size_t WS_WKVB = 37 * MiB;
constexpr size_t WS_WGU = 38 * MiB;
constexpr size_t WS_WD = 70 * MiB;
constexpr size_t WS_HC = 86 * MiB;
constexpr size_t WS_A = 94 * MiB;
constexpr size_t WS_P = 130 * MiB;
constexpr size_t WS_ACT = 130 * MiB;
constexpr size_t WS_YK = 170 * MiB;
constexpr size_t WS_MIX = 238 * MiB;
constexpr size_t WS_QNA = 274 * MiB, WS_KNA = 283 * MiB, WS_VNA = 292 * MiB;
constexpr size_t WS_QML = 301 * MiB, WS_KML = 315 * MiB, WS_VML = 329 * MiB;
constexpr size_t WS_QDF = 338 * MiB, WS_KDF = 347 * MiB, WS_VDF = 356 * MiB;
constexpr size_t WS_XT = 365 * MiB, WS_BTM = 374 * MiB, WS_BT = 383 * MiB, WS_CTM = 392 * MiB;
constexpr size_t WS_DT = 401 * MiB;
constexpr size_t WS_CST = 402 * MiB;
constexpr size_t WS_CDEC = 474 * MiB;
constexpr size_t WS_HENT = 475 * MiB;
constexpr size_t WS_RT = 511 * MiB;
constexpr size_t WS_ELIST = 512 * MiB;
constexpr size_t WS_END = 514 * MiB;
constexpr int CW_BAR = 4096;
constexpr int CW_ECNT = 16384;
constexpr int CW_KMAX = 65536;
constexpr int CW_QUEUE = 32768;

constexpr int RING_BYTES = 131072, LDSCTL_OFF = RING_BYTES, LDS_BYTES = 147456;

typedef float f32x16 __attribute__((ext_vector_type(16)));
#define MFMA32(a, b, c) __builtin_amdgcn_mfma_f32_32x32x16_bf16((a), (b), (c), 0, 0, 0)
__device__ __forceinline__ int crow16(int reg, int hh) { return (reg & 3) + 8 * (reg >> 2) + 4 * hh; }
__device__ __forceinline__ float bf2f(bf16 v) { return __uint_as_float(((unsigned)v) << 16); }
__device__ __forceinline__ bf16 f2bf(float f) { unsigned u = __float_as_uint(f); return (bf16)((u + 0x7fffu + ((u >> 16) & 1u)) >> 16); }
__device__ __forceinline__ unsigned pk2(float lo, float hi) { return (unsigned)f2bf(lo) | ((unsigned)f2bf(hi) << 16); }
template <int CTRL> __device__ __forceinline__ float dppf(float v) { return __int_as_float(__builtin_amdgcn_update_dpp(0, __float_as_int(v), CTRL, 0xF, 0xF, true)); }
__device__ __forceinline__ float rlane(float v, int l) { return __int_as_float(__builtin_amdgcn_readlane(__float_as_int(v), l)); }
__device__ __forceinline__ float wsum(float v) {
    v += dppf<0xB1>(v); v += dppf<0x4E>(v); v += dppf<0x141>(v); v += dppf<0x140>(v);
    return (rlane(v, 0) + rlane(v, 16)) + (rlane(v, 32) + rlane(v, 48)); }
__device__ __forceinline__ float wmaxf(float v) {
    v = fmaxf(v, dppf<0xB1>(v)); v = fmaxf(v, dppf<0x4E>(v)); v = fmaxf(v, dppf<0x141>(v)); v = fmaxf(v, dppf<0x140>(v));
    return fmaxf(fmaxf(rlane(v, 0), rlane(v, 16)), fmaxf(rlane(v, 32), rlane(v, 48))); }
#define LDS_WAIT() asm volatile("s_waitcnt lgkmcnt(0)" ::: "memory")
__device__ __forceinline__ void row2bs(int r, int& b, int& s) { if (r < NLAT) { b = r >> 11; s = 256 + (r & 2047); } else { const int j = r - NLAT; b = j >> 8; s = j & 255; } }
__device__ __forceinline__ int bs2row(int b, int s) { return s < 256 ? NLAT + b * 256 + s : b * 2048 + s - 256; }
__device__ __forceinline__ int vpos(int s) { return (s & ~12) | ((s & 4) << 1) | ((s & 8) >> 1); }
__device__ __forceinline__ float siluf(float x) { return x / (1.f + __expf(-x)); }

#define XB_TMO      128
#define XB_XCNT(j)  (256  + 64 * (j))
#define XB_XSUB(j)  (1280 + 64 * (j))
#define XB_XGEN(j)  (2304 + 64 * (j))
#define XB_TOP      3328
#define XB_TOPGEN   3392
#define XCD_BAR_WORDS 3456
#define XB_SPIN_CAP (1u << 24)
__device__ __forceinline__ unsigned xb_ld(unsigned* p)              { return __hip_atomic_load(p, __ATOMIC_RELAXED, __HIP_MEMORY_SCOPE_AGENT); }
__device__ __forceinline__ unsigned xb_add(unsigned* p, unsigned v) { return __hip_atomic_fetch_add(p, v, __ATOMIC_RELAXED, __HIP_MEMORY_SCOPE_AGENT); }
__device__ __forceinline__ unsigned xb_xcc_id() { return (unsigned)__builtin_amdgcn_s_getreg((3 << 11) | 20) & 0xFu; }
#define XB_SPIN(cond, bar) do { unsigned _sp = 0; while (cond) { __builtin_amdgcn_s_sleep(1); \
    if ((++_sp & 255u) == 0u) { if (xb_ld(&(bar)[XB_TMO])) break; if (_sp > XB_SPIN_CAP) { atomicAdd(&(bar)[XB_TMO], 1u); break; } } } } while (0)
struct XcdBarrier { unsigned* bar; unsigned x; volatile LAS unsigned* st; };
__device__ __forceinline__ XcdBarrier xcd_barrier_post(unsigned* bar, volatile LAS unsigned* st) {
    XcdBarrier b; b.bar = bar; b.x = xb_xcc_id(); b.st = st;
    if (threadIdx.x == 0) (void)xb_add(&bar[XB_XCNT(b.x)], 1u);
    return b;
}
__device__ __forceinline__ void xcd_barrier_complete(unsigned* bar, unsigned x, unsigned& nloc, unsigned& nx) {
    const unsigned G = gridDim.x * gridDim.y * gridDim.z;
    unsigned sum, cnt, mine, sp = 0u;
    for (;;) {
        sum = 0u; cnt = 0u; mine = 0u;
#pragma unroll
        for (unsigned j = 0; j < 16; ++j) { const unsigned c = xb_ld(&bar[XB_XCNT(j)]); sum += c; cnt += (c > 0u) ? 1u : 0u; mine = (j == x) ? c : mine; }
        if (sum == G) break;
        __builtin_amdgcn_s_sleep(1);
        if ((++sp & 255u) == 0u) { if (xb_ld(&bar[XB_TMO])) break; if (sp > XB_SPIN_CAP) { atomicAdd(&bar[XB_TMO], 1u); break; } }
    }
    nloc = mine > 0u ? mine : 1u; nx = cnt > 0u ? cnt : 1u;
}
__device__ __forceinline__ void xcd_barrier(const XcdBarrier& b) {
    asm volatile("s_waitcnt vmcnt(0)" ::: "memory");
    __syncthreads();
    if (threadIdx.x == 0) {
        unsigned* bar = b.bar;
        __builtin_amdgcn_s_waitcnt(0);
        unsigned nloc = b.st[0], nx = b.st[1];
        if (nloc == 0u) { xcd_barrier_complete(bar, b.x, nloc, nx); b.st[0] = nloc; b.st[1] = nx; }
        const unsigned old = xb_add(&bar[XB_XSUB(b.x)], 1u);
        const unsigned gen = old / nloc;
        if (old + 1u == (gen + 1u) * nloc) {
            __builtin_amdgcn_fence(__ATOMIC_RELEASE, "agent");
            asm volatile("s_waitcnt vmcnt(0)" ::: "memory");
            const unsigned og = xb_add(&bar[XB_TOP], 1u);
            const unsigned tg = og / nx;
            if (og + 1u == (tg + 1u) * nx) xb_add(&bar[XB_TOPGEN], 1u);
            else XB_SPIN(xb_ld(&bar[XB_TOPGEN]) == tg, bar);
            __builtin_amdgcn_fence(__ATOMIC_ACQUIRE, "agent");
            xb_add(&bar[XB_XGEN(b.x)], 1u);
            asm volatile("s_waitcnt vmcnt(0)" ::: "memory");
        } else {
            XB_SPIN(xb_ld(&bar[XB_XGEN(b.x)]) == gen, bar);
            __builtin_amdgcn_fence(__ATOMIC_ACQUIRE, "agent");
            asm volatile("s_waitcnt vmcnt(0)" ::: "memory");
        }
    }
    __syncthreads();
}

namespace pg8 {
constexpr int BM = 256, BK = 64, HALF = 128, HTB = HALF * BK * 2, NXCD = 8, WGM = 8;
__device__ __forceinline__ int lds_byte(int r, int c) { const int st = (r >> 4) * 2 + (c >> 5), rr = r & 15, cc = c & 31, ob = rr * 64 + cc * 2; return st * 1024 + (ob ^ (((ob >> 9) & 1) << 5)); }
__device__ __forceinline__ void stage_rc(int b, int& R, int& C) { const int st = b / 1024, sb = b % 1024, swz = sb ^ (((sb >> 9) & 1) << 5); R = (st >> 1) * 16 + swz / 64; C = (st & 1) * 32 + (swz % 64) / 2; }
__device__ __forceinline__ int perm32(int rho) { const int n = rho >> 4, i = rho & 15; return 8 * (i >> 2) + 4 * n + (i & 3); }
struct Unit { int pm, pn, e, j, cnt; };

template <class Epi, class Sched>
__device__ __forceinline__ void gemm_phase(LAS unsigned char* lds, const int tid, const int K, const Sched& S, const Epi& E) {
    const int wid = __builtin_amdgcn_readfirstlane(tid >> 6), lane = tid & 63, wr = wid >> 2, wc = wid & 3, fr = lane & 15, fq = lane >> 4;
    const int nt = K / BK;
    int Rr[2]; unsigned Cb[2], voffB[2];
#pragma unroll
    for (int i = 0; i < 2; ++i) { int R, C; stage_rc(tid * 16 + i * 8192, R, C); const int Rb = Epi::PERM ? ((R & ~31) + perm32(R & 31)) : R;
        Rr[i] = R; Cb[i] = (unsigned)C * 2u; voffB[i] = (unsigned)(Rb * K + C) * 2u; }
    const size_t kstep = (size_t)(BK * 2);
    const size_t hstep = (size_t)HALF * K * 2;
    const unsigned ldsw = (unsigned)wid * 1024u;
    const int aoff = lds_byte(wr * 64 + fr, fq * 8), boff = lds_byte(wc * 32 + fr, fq * 8);
#define PG8_SA(b, h) (((b) * 2 + (h)) * HTB)
#define PG8_SB(b, h) ((4 + (b) * 2 + (h)) * HTB)
#define PG8_STAGE(bufoff, gbase, voff) do { _Pragma("unroll") for (int _i = 0; _i < 2; ++_i) \
        __builtin_amdgcn_global_load_lds((const unsigned*)((const char*)(gbase) + (voff)[_i]), (LAS unsigned*)(lds + (bufoff) + ldsw + _i * 8192), 16, 0, 0); } while (0)
#define PG8_LDA(dst, b, h) do { _Pragma("unroll") for (int m = 0; m < 4; ++m) _Pragma("unroll") for (int k = 0; k < 2; ++k) dst[m][k] = *(const LAS bf16x8*)(lds + PG8_SA(b, h) + aoff + m * 2048 + k * 1024); } while (0)
#define PG8_LDB(dst, b, h) do { _Pragma("unroll") for (int n = 0; n < 2; ++n) _Pragma("unroll") for (int k = 0; k < 2; ++k) dst[n][k] = *(const LAS bf16x8*)(lds + PG8_SB(b, h) + boff + n * 2048 + k * 1024); } while (0)
#define PG8_MMA(ai, bj, At, Bt) do { __builtin_amdgcn_s_setprio(1); _Pragma("unroll") for (int m = 0; m < 4; ++m) _Pragma("unroll") for (int n = 0; n < 2; ++n) _Pragma("unroll") for (int k = 0; k < 2; ++k) \
        acc[ai][bj][m][n] = __builtin_amdgcn_mfma_f32_16x16x32_bf16(Bt[n][k], At[m][k], acc[ai][bj][m][n], 0, 0, 0); __builtin_amdgcn_s_setprio(0); } while (0)
#define PG8_WAIT_V(n) asm volatile("s_waitcnt vmcnt(" #n ")" ::: "memory")
#define PG8_WAIT_L(n) asm volatile("s_waitcnt lgkmcnt(" #n ")" ::: "memory")
#define PG8_BAR __builtin_amdgcn_s_barrier()
#define PG8_SCHED __builtin_amdgcn_sched_barrier(0)
    Unit cur, nxt; int ui = 0;
    if (!S.next(0, cur)) return;
    f32x4 acc[2][2][4][2];
#pragma unroll
    for (int a = 0; a < 2; ++a)
#pragma unroll
        for (int b = 0; b < 2; ++b)
#pragma unroll
            for (int m = 0; m < 4; ++m)
#pragma unroll
                for (int n = 0; n < 2; ++n) acc[a][b][m][n] = (f32x4){0.f, 0.f, 0.f, 0.f};
    bf16x8 At[4][2], B0[2][2], B1[2][2];
    unsigned vA0[2], vA1[2];
    const char* cA = S.a_ptr(cur);
    if constexpr (Sched::GATHER) { S.a_offs(cur, Rr, vA0, vA1);
#pragma unroll
        for (int i = 0; i < 2; ++i) { vA0[i] += Cb[i]; vA1[i] += Cb[i]; }
        asm volatile("s_waitcnt vmcnt(0)" ::: "memory");
    } else {
#pragma unroll
        for (int i = 0; i < 2; ++i) { vA0[i] = (unsigned)(Rr[i] * K * 2) + Cb[i]; vA1[i] = vA0[i]; } }
    const size_t ahs = Sched::GATHER ? (size_t)0 : hstep;
    const char* cB = S.b_ptr(cur);
    PG8_STAGE(PG8_SB(0, 0), cB, voffB); PG8_STAGE(PG8_SB(0, 1), cB + hstep, voffB); PG8_STAGE(PG8_SA(0, 0), cA, vA0); PG8_STAGE(PG8_SA(0, 1), cA + ahs, vA1);
    if (wr == 1) PG8_BAR;
    PG8_WAIT_V(2); PG8_BAR;
    PG8_STAGE(PG8_SB(1, 0), cB + kstep, voffB); PG8_STAGE(PG8_SA(1, 0), cA + kstep, vA0); PG8_STAGE(PG8_SB(1, 1), cB + hstep + kstep, voffB);
    PG8_WAIT_V(6); PG8_BAR;
    for (;;) {
        const bool has_next = S.next(ui + 1, nxt);
        const char* nA = has_next ? S.a_ptr(nxt) : cA; const char* nB = has_next ? S.b_ptr(nxt) : cB;
        for (int t = 0; t < nt; t += 2) {
            const bool last = (t == nt - 2);
            const char* a1 = cA + (size_t)(t + 1) * kstep;
            const char* a2 = last ? nA : cA + (size_t)(t + 2) * kstep; const char* b2 = last ? nB : cB + (size_t)(t + 2) * kstep;
            const char* a3 = a2 + kstep; const char* b3 = b2 + kstep;
            PG8_LDB(B0, 0, 0); PG8_LDB(B1, 0, 1); PG8_SCHED; PG8_LDA(At, 0, 0); PG8_STAGE(PG8_SA(1, 1), a1 + ahs, vA1);
            if constexpr (Sched::GATHER) { if (last && has_next) { S.a_offs(nxt, Rr, vA0, vA1);
#pragma unroll
                for (int i = 0; i < 2; ++i) { vA0[i] += Cb[i]; vA1[i] += Cb[i]; }
                asm volatile("s_waitcnt vmcnt(0)" ::: "memory"); } }
            PG8_WAIT_V(8); PG8_WAIT_L(0); PG8_BAR; PG8_MMA(0, 0, At, B0); PG8_MMA(0, 1, At, B1); PG8_BAR; PG8_SCHED;
            PG8_LDA(At, 0, 1); PG8_STAGE(PG8_SB(0, 0), b2, voffB); PG8_STAGE(PG8_SB(0, 1), b2 + hstep, voffB); PG8_STAGE(PG8_SA(0, 0), a2, vA0);
            PG8_WAIT_V(8); PG8_WAIT_L(0); PG8_BAR; PG8_MMA(1, 0, At, B0); PG8_MMA(1, 1, At, B1); PG8_BAR; PG8_SCHED;
            PG8_LDB(B0, 1, 0); PG8_LDB(B1, 1, 1); PG8_SCHED; PG8_LDA(At, 1, 0); PG8_STAGE(PG8_SA(0, 1), a2 + ahs, vA1);
            PG8_WAIT_V(8); PG8_WAIT_L(0); PG8_BAR; PG8_MMA(0, 0, At, B0); PG8_MMA(0, 1, At, B1); PG8_BAR; PG8_SCHED;
            PG8_LDA(At, 1, 1); PG8_STAGE(PG8_SB(1, 0), b3, voffB); PG8_STAGE(PG8_SB(1, 1), b3 + hstep, voffB); PG8_STAGE(PG8_SA(1, 0), a3, vA0);
            PG8_WAIT_V(8); PG8_WAIT_L(0); PG8_BAR; PG8_MMA(1, 0, At, B0); PG8_MMA(1, 1, At, B1); PG8_BAR; PG8_SCHED;
        }
        if (wr == 0) PG8_BAR;
        E(acc, cur, wr, wc, fr, fq);
        if (!has_next) break;
#pragma unroll
        for (int a = 0; a < 2; ++a)
#pragma unroll
            for (int b = 0; b < 2; ++b)
#pragma unroll
                for (int m = 0; m < 4; ++m)
#pragma unroll
                    for (int n = 0; n < 2; ++n) acc[a][b][m][n] = (f32x4){0.f, 0.f, 0.f, 0.f};
        cur = nxt; cA = nA; cB = nB; ++ui;
        if (wr == 1) PG8_BAR;
    }
    PG8_WAIT_V(0);
    PG8_BAR;
#undef PG8_SA
#undef PG8_SB
#undef PG8_STAGE
#undef PG8_LDA
#undef PG8_LDB
#undef PG8_MMA
#undef PG8_WAIT_V
#undef PG8_WAIT_L
#undef PG8_BAR
#undef PG8_SCHED
}
__device__ __forceinline__ unsigned cvt_pk_bf16(float lo, float hi) { unsigned r; asm volatile("v_cvt_pk_bf16_f32 %0, %1, %2" : "=v"(r) : "v"(lo), "v"(hi)); return r; }

struct DenseSched {
    const char* A; const char* Bt; int K, nM, nN, nwg, G, c;
    __device__ void init(const void* A_, const void* Bt_, int K_, int M, int N, int G_, int c_) { A = (const char*)A_; Bt = (const char*)Bt_; K = K_; nM = M / BM; nN = N / BM; nwg = nM * nN; G = G_; c = c_; }
    __device__ __forceinline__ bool next(int i, Unit& u) const {
        const long L = (long)i * G + c; if (L >= nwg) return false;
        int wgid = (int)L; { const int q = nwg / NXCD, r = nwg % NXCD, xcd = wgid % NXCD, off = wgid / NXCD; wgid = (xcd < r ? xcd * (q + 1) : r * (q + 1) + (xcd - r) * q) + off; }
        const int nig = WGM * nN, gid = wgid / nig, fm = gid * WGM, gsz = (nM - fm) < WGM ? (nM - fm) : WGM;
        u.pm = fm + ((wgid % nig) % gsz); u.pn = (wgid % nig) / gsz; u.e = 0; u.j = 0; u.cnt = 256; return true;
    }
    static constexpr bool GATHER = false;
    __device__ __forceinline__ const char* a_ptr(const Unit& u) const { return A + (size_t)u.pm * BM * K * 2; }
    __device__ __forceinline__ void a_offs(const Unit&, const int (&)[2], unsigned (&)[2], unsigned (&)[2]) const {}
    __device__ __forceinline__ const char* b_ptr(const Unit& u) const { return Bt + (size_t)u.pn * BM * K * 2; }
};
template <bool GATHER_> struct MoeSched {
    static constexpr bool GATHER = GATHER_;
    const char* A; const char* W; size_t wstride; int K, G, c; const int* elist; const volatile LAS int* T; const volatile LAS int* Cn;
    __device__ __forceinline__ bool next(int i, Unit& u) const {
        const long L = (long)i * G + c; const int nT = T[16]; if (L >= 4L * nT) return false;
        const int tile = (int)(L >> 2); u.pn = (int)(L & 3); u.pm = tile;
        int e = 0;
#pragma unroll
        for (int k = 1; k < 16; ++k) e += (tile >= T[k]) ? 1 : 0;
        u.e = e; u.j = tile - T[e]; u.cnt = Cn[e]; return true;
    }
    __device__ __forceinline__ const char* a_ptr(const Unit& u) const { return GATHER ? A : A + (size_t)u.pm * BM * K * 2; }
    __device__ __forceinline__ void a_offs(const Unit& u, const int (&Rr)[2], unsigned (&v0)[2], unsigned (&v1)[2]) const {
#pragma unroll
        for (int i = 0; i < 2; ++i) {
            const int p0 = u.j * BM + Rr[i], p1 = p0 + HALF;
            int t0 = p0 < u.cnt ? (elist[u.e * NROW + p0] >> 1) : 0, t1 = p1 < u.cnt ? (elist[u.e * NROW + p1] >> 1) : 0;
            t0 = min(max(t0, 0), NROW - 1); t1 = min(max(t1, 0), NROW - 1);
            v0[i] = (unsigned)(t0 * K * 2); v1[i] = (unsigned)(t1 * K * 2);
        } }
    __device__ __forceinline__ const char* b_ptr(const Unit& u) const { return W + (size_t)u.e * wstride + (size_t)u.pn * BM * K * 2; }
};
struct EpiP {
    static constexpr bool PERM = true;
    bf16* O;
    __device__ __forceinline__ void operator()(const f32x4 (&acc)[2][2][4][2], const Unit& u, int wr, int wc, int fr, int fq) const {
        const int row0 = u.pm * BM + wr * 64 + fr, col0 = u.pn * BM + wc * 32 + 8 * fq;
#pragma unroll
        for (int ai = 0; ai < 2; ++ai)
#pragma unroll
            for (int m = 0; m < 4; ++m) { bf16* rowp = O + (size_t)(row0 + ai * HALF + m * 16) * NP + col0;
#pragma unroll
                for (int bj = 0; bj < 2; ++bj) { const f32x4 v0 = acc[ai][bj][m][0], v1 = acc[ai][bj][m][1];
                    u32x4 w; w.x = cvt_pk_bf16(v0[0], v0[1]); w.y = cvt_pk_bf16(v0[2], v0[3]); w.z = cvt_pk_bf16(v1[0], v1[1]); w.w = cvt_pk_bf16(v1[2], v1[3]);
                    *(u32x4*)(rowp + bj * HALF) = w; } }
    }
};
struct EpiRes {
    static constexpr bool PERM = false;
    const float* hin_l; const float* hin_c; float* hout_l; float* hout_c; const float* gate; float gsc;
    __device__ __forceinline__ void operator()(const f32x4 (&acc)[2][2][4][2], const Unit& u, int wr, int wc, int fr, int fq) const {
        const int row0 = u.pm * BM + wr * 64 + fr, col0 = u.pn * BM + wc * 32 + 4 * fq;
#pragma unroll
        for (int ai = 0; ai < 2; ++ai)
#pragma unroll
            for (int m = 0; m < 4; ++m) { const int r = row0 + ai * HALF + m * 16; const bool lat = r < NLAT; const int bb = lat ? (r >> 11) : 8;
                const float* hi = lat ? hin_l + (size_t)r * DM : hin_c + (size_t)(r - NLAT) * DM; float* ho = lat ? hout_l + (size_t)r * DM : hout_c + (size_t)(r - NLAT) * DM;
                const float* g = gate + (size_t)bb * 6144;
#pragma unroll
                for (int bj = 0; bj < 2; ++bj)
#pragma unroll
                    for (int n = 0; n < 2; ++n) { const int c = col0 + bj * HALF + n * 16; const f32x4 gv = *(const f32x4*)(g + c), hv = *(const f32x4*)(hi + c);
                        *(f32x4*)(ho + c) = hv + gv * gsc * acc[ai][bj][m][n]; } }
    }
};
struct EpiAct {
    static constexpr bool PERM = true;
    bf16* O;
    __device__ __forceinline__ void operator()(const f32x4 (&acc)[2][2][4][2], const Unit& u, int wr, int wc, int fr, int fq) const {
        const int row0 = u.pm * BM + wr * 64 + fr, col0 = u.pn * HALF + wc * 32 + 8 * fq;
#pragma unroll
        for (int ai = 0; ai < 2; ++ai)
#pragma unroll
            for (int m = 0; m < 4; ++m) { bf16* rowp = O + (size_t)(row0 + ai * HALF + m * 16) * FF + col0;
                float o[8];
#pragma unroll
                for (int n = 0; n < 2; ++n)
#pragma unroll
                    for (int j = 0; j < 4; ++j) { const float g = acc[ai][0][m][n][j], up = acc[ai][1][m][n][j]; o[n * 4 + j] = g / (1.f + __expf(-g)) * up; }
                u32x4 w; w.x = cvt_pk_bf16(o[0], o[1]); w.y = cvt_pk_bf16(o[2], o[3]); w.z = cvt_pk_bf16(o[4], o[5]); w.w = cvt_pk_bf16(o[6], o[7]);
                *(u32x4*)rowp = w; }
    }
};
struct EpiDown {
    static constexpr bool PERM = true;
    bf16* O; const int* elist; const float* rtw;
    __device__ __forceinline__ void operator()(const f32x4 (&acc)[2][2][4][2], const Unit& u, int wr, int wc, int fr, int fq) const {
        const int col0 = u.pn * BM + wc * 32 + 8 * fq;
#pragma unroll
        for (int ai = 0; ai < 2; ++ai)
#pragma unroll
            for (int m = 0; m < 4; ++m) { const int pos = u.j * BM + ai * HALF + wr * 64 + m * 16 + fr;
                if (pos < u.cnt) { const int a = min(max(elist[u.e * NROW + pos], 0), 2 * NROW - 1); const float w8 = rtw[a]; bf16* rowp = O + (size_t)a * DM + col0;
#pragma unroll
                    for (int bj = 0; bj < 2; ++bj) { const f32x4 v0 = acc[ai][bj][m][0] * w8, v1 = acc[ai][bj][m][1] * w8;
                        u32x4 w; w.x = cvt_pk_bf16(v0[0], v0[1]); w.y = cvt_pk_bf16(v0[2], v0[3]); w.z = cvt_pk_bf16(v1[0], v1[1]); w.w = cvt_pk_bf16(v1[2], v1[3]);
                        *(u32x4*)(rowp + bj * HALF) = w; } } }
    }
};
}

struct Args { const float* in[36]; float* out; unsigned char* ws; int ph_lo, ph_hi; };
struct Fr {
    LAS unsigned char* lds; int tid, lane, wave, G, vcu, gw, NGW; const __attribute__((address_space(4))) Args* A;
    __device__ __forceinline__ const float* x() const { return A->in[0]; }
    __device__ __forceinline__ const float* cvec() const { return A->in[1]; }
    __device__ __forceinline__ const float* ctx() const { return A->in[2]; }
    __device__ __forceinline__ const float* cctx() const { return A->in[3]; }
    __device__ __forceinline__ const float* w_mod() const { return A->in[4]; }
    __device__ __forceinline__ const float* b_mod() const { return A->in[5]; }
    __device__ __forceinline__ const float* g_mix() const { return A->in[6]; }
    __device__ __forceinline__ const float* w_in() const { return A->in[7]; }
    __device__ __forceinline__ const float* w_out() const { return A->in[8]; }
    __device__ __forceinline__ const float* na_gq() const { return A->in[9]; }
    __device__ __forceinline__ const float* na_gk() const { return A->in[10]; }
    __device__ __forceinline__ const float* na_rb() const { return A->in[11]; }
    __device__ __forceinline__ const float* mla_gqa() const { return A->in[12]; }
    __device__ __forceinline__ const float* mla_wqb() const { return A->in[13]; }
    __device__ __forceinline__ const float* mla_gkva() const { return A->in[14]; }
    __device__ __forceinline__ const float* mla_wkvb() const { return A->in[15]; }
    __device__ __forceinline__ const float* mla_gq() const { return A->in[16]; }
    __device__ __forceinline__ const float* mla_gk() const { return A->in[17]; }
    __device__ __forceinline__ const float* df_gq() const { return A->in[18]; }
    __device__ __forceinline__ const float* df_gk() const { return A->in[19]; }
    __device__ __forceinline__ const float* df_lam() const { return A->in[20]; }
    __device__ __forceinline__ const float* df_gsub() const { return A->in[21]; }
    __device__ __forceinline__ const float* conv_w() const { return A->in[22]; }
    __device__ __forceinline__ const float* conv_b() const { return A->in[23]; }
    __device__ __forceinline__ const float* dt_bias() const { return A->in[24]; }
    __device__ __forceinline__ const float* a_log() const { return A->in[25]; }
    __device__ __forceinline__ const float* ssd_d() const { return A->in[26]; }
    __device__ __forceinline__ const float* ssd_gn() const { return A->in[27]; }
    __device__ __forceinline__ const float* g_ffn() const { return A->in[28]; }
    __device__ __forceinline__ const float* w_grp() const { return A->in[29]; }
    __device__ __forceinline__ const float* b_grp() const { return A->in[30]; }
    __device__ __forceinline__ const float* w_exp() const { return A->in[31]; }
    __device__ __forceinline__ const float* b_exp() const { return A->in[32]; }
    __device__ __forceinline__ const float* w_gate() const { return A->in[33]; }
    __device__ __forceinline__ const float* w_up() const { return A->in[34]; }
    __device__ __forceinline__ const float* w_down() const { return A->in[35]; }
    __device__ __forceinline__ float* out() const { return A->out; }
    __device__ __forceinline__ unsigned* ctl() const { return (unsigned*)(A->ws + WS_CTL); }
    __device__ __forceinline__ float* modv() const { return (float*)(A->ws + WS_MOD); }
    __device__ __forceinline__ float* rcos() const { return (float*)(A->ws + WS_ROPE); }
    __device__ __forceinline__ float* rsin() const { return (float*)(A->ws + WS_ROPE + TLAT * 16 * 4); }
    __device__ __forceinline__ bf16* winT() const { return (bf16*)(A->ws + WS_WIN); }
    __device__ __forceinline__ bf16* woutT() const { return (bf16*)(A->ws + WS_WOUT); }
    __device__ __forceinline__ bf16* wqbT() const { return (bf16*)(A->ws + WS_WQB); }
    __device__ __forceinline__ bf16* wkvbT() const { return (bf16*)(A->ws + WS_WKVB); }
    __device__ __forceinline__ bf16* wgu() const { return (bf16*)(A->ws + WS_WGU); }
    __device__ __forceinline__ bf16* wd() const { return (bf16*)(A->ws + WS_WD); }
    __device__ __forceinline__ float* hc() const { return (float*)(A->ws + WS_HC); }
    __device__ __forceinline__ bf16* abuf() const { return (bf16*)(A->ws + WS_A); }
    __device__ __forceinline__ bf16* pbuf() const { return (bf16*)(A->ws + WS_P); }
    __device__ __forceinline__ bf16* act() const { return (bf16*)(A->ws + WS_ACT); }
    __device__ __forceinline__ bf16* yk() const { return (bf16*)(A->ws + WS_YK); }
    __device__ __forceinline__ bf16* mix() const { return (bf16*)(A->ws + WS_MIX); }
    __device__ __forceinline__ bf16* qna() const { return (bf16*)(A->ws + WS_QNA); }
    __device__ __forceinline__ bf16* kna() const { return (bf16*)(A->ws + WS_KNA); }
    __device__ __forceinline__ bf16* vna() const { return (bf16*)(A->ws + WS_VNA); }
    __device__ __forceinline__ bf16* qml() const { return (bf16*)(A->ws + WS_QML); }
    __device__ __forceinline__ bf16* kml() const { return (bf16*)(A->ws + WS_KML); }
    __device__ __forceinline__ bf16* vml() const { return (bf16*)(A->ws + WS_VML); }
    __device__ __forceinline__ bf16* qdf() const { return (bf16*)(A->ws + WS_QDF); }
    __device__ __forceinline__ bf16* kdf() const { return (bf16*)(A->ws + WS_KDF); }
    __device__ __forceinline__ bf16* vdf() const { return (bf16*)(A->ws + WS_VDF); }
    __device__ __forceinline__ bf16* xT() const { return (bf16*)(A->ws + WS_XT); }
    __device__ __forceinline__ bf16* btm() const { return (bf16*)(A->ws + WS_BTM); }
    __device__ __forceinline__ bf16* bT() const { return (bf16*)(A->ws + WS_BT); }
    __device__ __forceinline__ bf16* ctm() const { return (bf16*)(A->ws + WS_CTM); }
    __device__ __forceinline__ float* dtv() const { return (float*)(A->ws + WS_DT); }
    __device__ __forceinline__ float* cst() const { return (float*)(A->ws + WS_CST); }
    __device__ __forceinline__ float* cdec() const { return (float*)(A->ws + WS_CDEC); }
    __device__ __forceinline__ bf16* hent() const { return (bf16*)(A->ws + WS_HENT); }
    __device__ __forceinline__ float* ydir() const { return (float*)(A->ws + WS_CST); }
    __device__ __forceinline__ int* rte() const { return (int*)(A->ws + WS_RT); }
    __device__ __forceinline__ float* rtw() const { return (float*)(A->ws + WS_RT + 256 * 1024); }
    __device__ __forceinline__ int* elist() const { return (int*)(A->ws + WS_ELIST); }
};

__device__ __forceinline__ Fr refresh(const Fr& F0) { Fr F = F0; int w = F0.wave; asm volatile("" : "+s"(w)); asm volatile("" : "+s"(F.A));
    int l; asm volatile("v_mbcnt_lo_u32_b32 %0, -1, 0\n\tv_mbcnt_hi_u32_b32 %0, -1, %0" : "=v"(l)); F.wave = w; F.lane = l; F.tid = w * 64 + l; F.gw = F.vcu * 8 + w; return F; }
__device__ __forceinline__ void tr_item(const float* W, int ldw, int nvalid, int k0, int n0, bf16* dst, int ldd, LAS float* scr, int lane, const float* ksc = nullptr) {
    const int cn = n0 + (lane & 31), cnc = min(cn, nvalid - 1);
    float tv[32];
#pragma unroll
    for (int i = 0; i < 32; ++i) { const int kk = 2 * i + (lane >> 5); tv[i] = W[(size_t)(k0 + kk) * ldw + cnc]; }
#pragma unroll
    for (int i = 0; i < 32; ++i) { const int kk = 2 * i + (lane >> 5); const float sc1 = ksc ? ksc[k0 + kk] : 1.f; scr[kk * 33 + (lane & 31)] = cn < nvalid ? tv[i] * sc1 : 0.f; }
    LDS_WAIT();
    const int c = lane & 7;
#pragma unroll
    for (int j = 0; j < 4; ++j) { const int n = (lane >> 3) + 8 * j; const LAS float* s = scr + (8 * c) * 33 + n;
        u32x4 o; o.x = pk2(s[0 * 33], s[1 * 33]); o.y = pk2(s[2 * 33], s[3 * 33]); o.z = pk2(s[4 * 33], s[5 * 33]); o.w = pk2(s[6 * 33], s[7 * 33]);
        *(u32x4*)(dst + (size_t)n * ldd + k0 + 8 * c) = o; }
    LDS_WAIT();
}
__device__ __forceinline__ void moe_weight_convert(const Fr& F, int L) {
    LAS float* scr = (LAS float*)(F.lds + F.wave * 16384);
    constexpr int I_GU = 16 * 16, I_D = 8 * 32;
    for (int it = F.gw; it < NEXP * (2 * I_GU + I_D); it += F.NGW) {
        const int e = it / (2 * I_GU + I_D); int r = it % (2 * I_GU + I_D);
        if (r < 2 * I_GU) { const int bj = r / I_GU; r %= I_GU; const int kb = r / 16, nb = r % 16, n0 = nb * 32;
            const float* W = (bj ? F.w_up() : F.w_gate()) + ((size_t)L * NEXP + e) * DM * FF;
            tr_item(W, FF, FF, kb * 64, n0, F.wgu() + ((size_t)e * 1024 + (n0 >> 7) * 256 + bj * 128 + (n0 & 127)) * DM, DM, scr, F.lane);
        } else { r -= 2 * I_GU; const int kb = r / 32, nb = r % 32, n0 = nb * 32;
            const float* W = F.w_down() + ((size_t)L * NEXP + e) * FF * DM;
            tr_item(W, DM, DM, kb * 64, n0, F.wd() + ((size_t)e * 1024 + n0) * FF, FF, scr, F.lane); }
    }
}
__device__ __forceinline__ void phase_prologue(const Fr& F) {
    {   LAS float* sc = (LAS float*)F.lds;
        LAS float* part = (LAS float*)(F.lds + 40960);
        for (int i = F.tid; i < 9 * 1024; i += 512) { const float v = i < 8192 ? F.cvec()[i] : F.cctx()[i - 8192]; sc[i] = siluf(v); }
        __syncthreads();
        for (int u = F.vcu; u < 384; u += F.G) {
            const int col = u * 64 + F.lane, L = col / 6144, n = col - L * 6144;
            const float* w = F.w_mod() + ((size_t)L * 1024 + F.wave * 128) * 6144 + n;
            float acc[9];
#pragma unroll
            for (int b = 0; b < 9; ++b) acc[b] = 0.f;
#pragma unroll 1
            for (int k0 = 0; k0 < 128; k0 += 16) { float wv[16];
#pragma unroll
                for (int j = 0; j < 16; ++j) wv[j] = w[(size_t)(k0 + j) * 6144];
#pragma unroll
                for (int j = 0; j < 16; ++j)
#pragma unroll
                    for (int b = 0; b < 9; ++b) acc[b] += sc[b * 1024 + F.wave * 128 + k0 + j] * wv[j]; }
#pragma unroll
            for (int b = 0; b < 9; ++b) part[(F.wave * 9 + b) * 64 + F.lane] = acc[b];
            __syncthreads();
            for (int i = F.tid; i < 9 * 64; i += 512) { const int b = i >> 6, l = i & 63; float s = 0.f;
#pragma unroll
                for (int w8 = 0; w8 < 8; ++w8) s += part[(w8 * 9 + b) * 64 + l];
                const int c2 = u * 64 + l, L2 = c2 / 6144, n2 = c2 - L2 * 6144;
                F.modv()[((size_t)L2 * 9 + b) * 6144 + n2] = s + F.b_mod()[L2 * 6144 + n2]; }
            __syncthreads();
        }
    }
    for (int i = blockIdx.x * 512 + F.tid; i < TLAT * 16; i += F.G * 512) { const int t = i >> 4, k = i & 15; const float inv = powf(10000.f, -(float)(k & 7) / 8.f);
        const float pos = (k < 8) ? (float)(t >> 6) : (float)(t & 63); const float ang = pos * inv; F.rcos()[i] = cosf(ang); F.rsin()[i] = sinf(ang); }
    __syncthreads();
    LAS float* scr = (LAS float*)(F.lds + F.wave * 16384);
    constexpr int I_IN = 16 * 96, I_OUT = 16 * 32, I_QB = 4 * 12, I_KVB = 2 * 16, I_L = I_IN + I_OUT + I_QB + I_KVB;
    for (int it = F.gw; it < DEPTH * I_L; it += F.NGW) {
        const int L = it / I_L; int r = it % I_L;
        if (r < I_IN) { const int kb = r / 96, nb = r % 96; tr_item(F.w_in() + (size_t)L * DM * NIN, NIN, NIN, kb * 64, nb * 32, F.winT() + ((size_t)L * NP + nb * 32) * DM, DM, scr, F.lane); continue; } r -= I_IN;
        if (r < I_OUT) { const int kb = r / 32, nb = r % 32; tr_item(F.w_out() + (size_t)L * DM * DM, DM, DM, kb * 64, nb * 32, F.woutT() + ((size_t)L * DM + nb * 32) * DM, DM, scr, F.lane); continue; } r -= I_OUT;
        if (r < I_QB) { const int kb = r / 12, nb = r % 12; tr_item(F.mla_wqb() + (size_t)L * 256 * 384, 384, 384, kb * 64, nb * 32, F.wqbT() + ((size_t)L * 384 + nb * 32) * 256, 256, scr, F.lane, F.mla_gqa() + L * 256); continue; } r -= I_QB;
        { const int kb = r / 16, nb = r % 16; tr_item(F.mla_wkvb() + (size_t)L * 128 * 512, 512, 512, kb * 64, nb * 32, F.wkvbT() + ((size_t)L * 512 + nb * 32) * 128, 128, scr, F.lane, F.mla_gkva() + L * 128); }
    }
}

__device__ __forceinline__ void phase_norm(const Fr& F, int L, bool combine = true) {
    const int nrows = (L == DEPTH) ? NLAT : NROW;
    for (int r = F.gw; r < nrows; r += F.NGW) {
        const bool lat = r < NLAT; const int bb = lat ? (r >> 11) : 8;
        const float* hin = (L == 0) ? (lat ? F.x() + (size_t)r * DM : F.ctx() + (size_t)(r - NLAT) * DM) : (lat ? F.out() + (size_t)r * DM : F.hc() + (size_t)(r - NLAT) * DM);
        float* hout = lat ? F.out() + (size_t)r * DM : F.hc() + (size_t)(r - NLAT) * DM;
        f32x4 v[4];
#pragma unroll
        for (int j = 0; j < 4; ++j) v[j] = *(const f32x4*)(hin + 4 * F.lane + 256 * j);
        if (L > 0 && combine) {
            const float* m5 = F.modv() + ((size_t)(L - 1) * 9 + bb) * 6144 + 5 * 1024;
#pragma unroll
            for (int j = 0; j < 4; ++j) { const int c = 4 * F.lane + 256 * j; const f32x4 g = *(const f32x4*)(m5 + c);
                const u32x2 y0 = *(const u32x2*)(F.yk() + (size_t)(2 * r) * DM + c), y1 = *(const u32x2*)(F.yk() + (size_t)(2 * r + 1) * DM + c);
                f32x4 ys; ys[0] = __uint_as_float(y0.x << 16) + __uint_as_float(y1.x << 16); ys[1] = __uint_as_float(y0.x & 0xffff0000u) + __uint_as_float(y1.x & 0xffff0000u);
                ys[2] = __uint_as_float(y0.y << 16) + __uint_as_float(y1.y << 16); ys[3] = __uint_as_float(y0.y & 0xffff0000u) + __uint_as_float(y1.y & 0xffff0000u);
                v[j] = v[j] + g * ys; *(f32x4*)(hout + c) = v[j]; }
        }
        if (L == DEPTH) continue;
        float ss = 0.f;
#pragma unroll
        for (int j = 0; j < 4; ++j) ss += (v[j][0] * v[j][0] + v[j][1] * v[j][1]) + (v[j][2] * v[j][2] + v[j][3] * v[j][3]);
        const float rstd = rsqrtf(wsum(ss) * (1.f / DM) + EPS);
        const float* md = F.modv() + ((size_t)L * 9 + bb) * 6144;
#pragma unroll
        for (int j = 0; j < 4; ++j) { const int c = 4 * F.lane + 256 * j; const f32x4 g = *(const f32x4*)(F.g_mix() + L * DM + c), sh = *(const f32x4*)(md + c), scl = *(const f32x4*)(md + 1024 + c);
            const f32x4 a = v[j] * rstd * g * (scl + 1.f) + sh; u32x2 o; o.x = pk2(a[0], a[1]); o.y = pk2(a[2], a[3]); *(u32x2*)(F.abuf() + (size_t)r * DM + c) = o; }
    }
}

__device__ __forceinline__ void prep_row(const Fr& F, int L, int r, LAS float* scr) {
    int lane_ = F.lane; asm volatile("" : "+v"(lane_)); const int lane = lane_; int b, s; row2bs(r, b, s); const bool lat = r < NLAT; const int t = s - 256;
    const bf16* p = F.pbuf() + (size_t)r * NP;
#pragma unroll
    for (int h = 0; h < 4; ++h) {
        const float q = bf2f(p[C_NA + h * 64 + lane]), k = bf2f(p[C_NA + 256 + h * 64 + lane]);
        const float rq = rsqrtf(wsum(q * q) * (1.f / 64) + EPS), rk = rsqrtf(wsum(k * k) * (1.f / 64) + EPS);
        const size_t o = ((size_t)(b * 4 + h) * SQ + s) * 64 + lane;
        F.qna()[o] = f2bf(q * rq * F.na_gq()[L * 64 + lane]); F.kna()[o] = f2bf(k * rk * F.na_gk()[L * 64 + lane]);
    }
    {
        const int idx = lane & 31; float cs = 1.f, sn = 0.f;
        if (lat) { cs = F.rcos()[t * 16 + (idx & 15)]; sn = F.rsin()[t * 16 + (idx & 15)]; }
#pragma unroll
        for (int h = 0; h < 4; ++h) {
            float q = bf2f(p[C_DF + h * 64 + lane]), k = bf2f(p[C_DF + 256 + h * 64 + lane]);
            float sq = q * q, sk = k * k;
#pragma unroll
            for (int o = 16; o >= 1; o >>= 1) { sq += __shfl_xor(sq, o); sk += __shfl_xor(sk, o); }
            q *= rsqrtf(sq * (1.f / 32) + EPS) * F.df_gq()[L * 32 + idx]; k *= rsqrtf(sk * (1.f / 32) + EPS) * F.df_gk()[L * 32 + idx];
            const float qp = __shfl_xor(q, 16), kp = __shfl_xor(k, 16);
            if (lat) { q = (idx < 16) ? q * cs - qp * sn : qp * sn + q * cs; k = (idx < 16) ? k * cs - kp * sn : kp * sn + k * cs; }
            const size_t o = ((size_t)(b * 4 + h) * SQ + s) * 64 + lane;
            F.qdf()[o] = f2bf(q); F.kdf()[o] = f2bf(k);
        }
    }
}
__device__ __forceinline__ void prep_tile(const Fr& F, int L, int b, int c) {
    int tid_ = F.tid; asm volatile("" : "+v"(tid_)); const int tid = tid_;
    const int s0 = 64 * c; const size_t r0 = bs2row(b, s0);
    LAS bf16* Lv = (LAS bf16*)F.lds;
#ifndef PT_MASK
#define PT_MASK 7
#endif
    if (PT_MASK & 1)
#pragma unroll 1
    for (int mx = 0; mx < 2; ++mx) {
        const int voff = mx == 0 ? C_NA + 512 : C_DF + 512; bf16* vt = mx == 0 ? F.vna() : F.vdf();
#pragma unroll
        for (int k = 0; k < 4; ++k) { const int idx = tid + 512 * k, tok = idx >> 5, d8 = (idx & 31) * 8;
            const u32x4 v = *(const u32x4*)(F.pbuf() + (r0 + tok) * NP + voff + d8); const int pc = vpos(tok);
#pragma unroll
            for (int e = 0; e < 4; ++e) { Lv[(d8 + 2 * e) * 72 + pc] = (bf16)(v[e] & 0xffffu); Lv[(d8 + 2 * e + 1) * 72 + pc] = (bf16)(v[e] >> 16); } }
        __syncthreads();
#pragma unroll
        for (int k = 0; k < 4; ++k) { const int idx = tid + 512 * k, dv = idx >> 3, pc = idx & 7;
            const u32x4 v = *(const LAS u32x4*)(Lv + dv * 72 + pc * 8);
#ifndef PT_NOSTORE
#define PT_NOSTORE 0
#endif
            if (!PT_NOSTORE || v.x == 0x12345678u) *(u32x4*)(vt + ((size_t)(b * 4 + (dv >> 6)) * 64 + (dv & 63)) * SQ + s0 + pc * 8) = v; }
        __syncthreads();
    }
    const int len = c < 4 ? TCTX : TLAT, t0 = c < 4 ? s0 : s0 - 256;
    LAS bf16* Lc = (LAS bf16*)F.lds;
    if (PT_MASK & 2)
#pragma unroll 1
    for (int gch = 0; gch < 3; ++gch) {
        {   u32x4 v[5];
#pragma unroll
            for (int k = 0; k < 5; ++k) { const int idx = min(tid + 512 * k, 68 * 32 - 1), j = idx >> 5, c8 = (idx & 31) * 8, tj = t0 - 2 + j, jc = min(max(tj, 0), len - 1) - t0;
                v[k] = *(const u32x4*)(F.pbuf() + (size_t)((long)r0 + jc) * NP + C_XBC + gch * 256 + c8);
                const unsigned keep = (tj >= 0 && tj < len) ? 0xffffffffu : 0u; v[k].x &= keep; v[k].y &= keep; v[k].z &= keep; v[k].w &= keep; }
#pragma unroll
            for (int k = 0; k < 5; ++k) { const int idx = tid + 512 * k, j = idx >> 5, c8 = (idx & 31) * 8; if (idx < 68 * 32) *(LAS u32x4*)(Lc + j * 256 + c8) = v[k]; }
        }
        __syncthreads();
        const int ch = tid & 255, tq = tid >> 8, cg = gch * 256 + ch;
        float w[5];
#pragma unroll
        for (int j = 0; j < 5; ++j) w[j] = F.conv_w()[(L * 5 + j) * 768 + cg];
        const float bias = F.conv_b()[L * 768 + cg];
        const LAS bf16* lp = Lc + (32 * tq) * 256 + ch;
        float x0 = bf2f(lp[0]), x1 = bf2f(lp[256]), x2 = bf2f(lp[512]), x3 = bf2f(lp[768]);
        bf16* tm = (gch == 1 ? F.btm() : F.ctm()) + ((size_t)b * SQ + s0 + 32 * tq) * 256 + ch;
        bf16* cm = (gch == 0 ? F.xT() : F.bT()) + ((size_t)b * 256 + ch) * SQ + s0 + 32 * tq;
#pragma unroll
        for (int g8 = 0; g8 < 4; ++g8) { unsigned pk[4];
#pragma unroll
            for (int e = 0; e < 8; ++e) { const int i = 8 * g8 + e; const float x4 = bf2f(lp[(i + 4) * 256]);
                const float acc = bias + w[0] * x0 + w[1] * x1 + w[2] * x2 + w[3] * x3 + w[4] * x4; const unsigned o = f2bf(siluf(acc));
                if (gch >= 1) tm[(size_t)i * 256] = (bf16)o;
                if (e & 1) pk[e >> 1] |= o << 16; else pk[e >> 1] = o;
                x0 = x1; x1 = x2; x2 = x3; x3 = x4; }
            if (gch <= 1) { u32x4 v; v.x = pk[0]; v.y = pk[1]; v.z = pk[2]; v.w = pk[3]; *(u32x4*)(cm + 8 * g8) = v; } }
        __syncthreads();
    }
    if (PT_MASK & 4) { const int tok = tid >> 3, i = tid & 7; const float raw = bf2f(F.pbuf()[(r0 + tok) * NP + C_DT + i]) + F.dt_bias()[L * 8 + i]; const float ex = __expf(raw);
      F.dtv()[((size_t)b * 8 + i) * SQ + s0 + tok] = raw > 20.f ? raw : (ex < 0.03f ? ex * (1.f - ex * (0.5f - ex * (0.33333334f - 0.25f * ex))) : __logf(1.f + ex)); }
}
__device__ __forceinline__ void mla_prep_block(const Fr& F, int L, int b, int j32) {
    int lane_ = F.lane; asm volatile("" : "+v"(lane_));
    const int lane = lane_, wave = F.wave, r = lane & 31, hh = lane >> 5, s = 32 * j32 + r, t = s - 256; const bool lat = s >= 256;
    const size_t row = bs2row(b, s);
    const bf16* p = F.pbuf() + row * NP + C_MLA;
    const int tt = lat ? t : 0; const float latf = lat ? 1.f : 0.f;
    if (wave < 4) {
        const int hq = wave;
        bf16x8 Bq[16]; float ss = 0.f;
#pragma unroll
        for (int kk = 0; kk < 16; ++kk) { Bq[kk] = *(const bf16x8*)(p + 16 * kk + 8 * hh);
#pragma unroll
            for (int j = 0; j < 8; ++j) { const float v = bf2f((bf16)Bq[kk][j]); ss += v * v; } }
        ss += __shfl_xor(ss, 32); const float rq = rsqrtf(ss * (1.f / 256) + EPS);
        f32x16 acc[3]; float hs = 0.f;
#pragma unroll
        for (int j3 = 0; j3 < 3; ++j3) {
#pragma unroll
            for (int i = 0; i < 16; ++i) acc[j3][i] = 0.f;
            const bf16* wp = F.wqbT() + ((size_t)L * 384 + 96 * hq + 32 * j3 + r) * 256 + 8 * hh;
#pragma unroll
            for (int kk = 0; kk < 16; ++kk) acc[j3] = MFMA32(*(const bf16x8*)(wp + 16 * kk), Bq[kk], acc[j3]);
            asm volatile("" ::: "memory");
#pragma unroll
            for (int i = 0; i < 16; ++i) hs += acc[j3][i] * acc[j3][i]; }
        hs = (hs + __shfl_xor(hs, 32)) * rq * rq; const float rs = rsqrtf(hs * (1.f / 96) + EPS) * rq;
        bf16* qo = F.qml() + ((size_t)(b * 4 + hq) * SQ + s) * 96 + 4 * hh;
#pragma unroll
        for (int j3 = 0; j3 < 3; ++j3) {
#pragma unroll
            for (int i = 0; i < 16; ++i) acc[j3][i] *= rs * F.mla_gq()[L * 96 + 32 * j3 + crow16(i, hh)];
            if (j3 == 2) {
#pragma unroll
                for (int i = 0; i < 8; ++i) { const float rc = lat ? F.rcos()[tt * 16 + crow16(i, hh)] : 1.f, rsn = F.rsin()[tt * 16 + crow16(i, hh)] * latf;
                    const float x1 = acc[2][i], x2 = acc[2][i + 8]; acc[2][i] = x1 * rc - x2 * rsn; acc[2][i + 8] = x1 * rsn + x2 * rc; } }
#pragma unroll
            for (int g = 0; g < 4; ++g) { u32x2 w; w.x = pk2(acc[j3][4 * g], acc[j3][4 * g + 1]); w.y = pk2(acc[j3][4 * g + 2], acc[j3][4 * g + 3]); *(u32x2*)(qo + 32 * j3 + 8 * g) = w; } }
    } else {
        const int hk = wave - 4;
        LAS unsigned char* wl = F.lds + wave * 16384;
        bf16x8 Bkv[8]; float ss = 0.f;
#pragma unroll
        for (int kk = 0; kk < 8; ++kk) { Bkv[kk] = *(const bf16x8*)(p + 256 + 16 * kk + 8 * hh);
#pragma unroll
            for (int j = 0; j < 8; ++j) { const float v = bf2f((bf16)Bkv[kk][j]); ss += v * v; } }
        ss += __shfl_xor(ss, 32); const float rk = rsqrtf(ss * (1.f / 128) + EPS);
        float kr[16]; float hs = 0.f;
#pragma unroll
        for (int g = 0; g < 4; ++g) { const u32x2 k4 = *(const u32x2*)(p + 384 + 8 * g + 4 * hh);
            kr[4 * g] = __uint_as_float(k4.x << 16); kr[4 * g + 1] = __uint_as_float(k4.x & 0xffff0000u); kr[4 * g + 2] = __uint_as_float(k4.y << 16); kr[4 * g + 3] = __uint_as_float(k4.y & 0xffff0000u); }
#pragma unroll
        for (int i = 0; i < 16; ++i) hs += kr[i] * kr[i];
        f32x16 acc[4]; float ks = 0.f;
#pragma unroll
        for (int j4 = 0; j4 < 4; ++j4) {
#pragma unroll
            for (int i = 0; i < 16; ++i) acc[j4][i] = 0.f;
            const bf16* wp = F.wkvbT() + ((size_t)L * 512 + 128 * hk + 32 * j4 + r) * 128 + 8 * hh;
#pragma unroll
            for (int kk = 0; kk < 8; ++kk) acc[j4] = MFMA32(*(const bf16x8*)(wp + 16 * kk), Bkv[kk], acc[j4]);
            asm volatile("" ::: "memory");
            if (j4 < 2) {
#pragma unroll
                for (int i = 0; i < 16; ++i) ks += acc[j4][i] * acc[j4][i]; } }
        hs += ks * rk * rk; hs += __shfl_xor(hs, 32); const float rs = rsqrtf(hs * (1.f / 96) + EPS);
        bf16* ko = F.kml() + ((size_t)(b * 4 + hk) * SQ + s) * 96 + 4 * hh;
#pragma unroll
        for (int j2 = 0; j2 < 2; ++j2) {
#pragma unroll
            for (int i = 0; i < 16; ++i) acc[j2][i] *= rs * rk * F.mla_gk()[L * 96 + 32 * j2 + crow16(i, hh)];
#pragma unroll
            for (int g = 0; g < 4; ++g) { u32x2 w; w.x = pk2(acc[j2][4 * g], acc[j2][4 * g + 1]); w.y = pk2(acc[j2][4 * g + 2], acc[j2][4 * g + 3]); *(u32x2*)(ko + 32 * j2 + 8 * g) = w; } }
#pragma unroll
        for (int i = 0; i < 16; ++i) kr[i] *= rs * F.mla_gk()[L * 96 + 64 + crow16(i, hh)];
#pragma unroll
        for (int i = 0; i < 8; ++i) { const float rc = lat ? F.rcos()[tt * 16 + crow16(i, hh)] : 1.f, rsn = F.rsin()[tt * 16 + crow16(i, hh)] * latf;
            const float x1 = kr[i], x2 = kr[i + 8]; kr[i] = x1 * rc - x2 * rsn; kr[i + 8] = x1 * rsn + x2 * rc; }
#pragma unroll
        for (int g = 0; g < 4; ++g) { u32x2 w; w.x = pk2(kr[4 * g], kr[4 * g + 1]); w.y = pk2(kr[4 * g + 2], kr[4 * g + 3]); *(u32x2*)(ko + 64 + 8 * g) = w; }
        { float n2 = 0.f;
#pragma unroll
          for (int i = 0; i < 16; ++i) n2 += acc[0][i] * acc[0][i] + acc[1][i] * acc[1][i] + kr[i] * kr[i];
          n2 += __shfl_xor(n2, 32); n2 = wmaxf(n2);
          if (lane == 0) atomicMax(F.ctl() + CW_KMAX + ((L * 3 + 1) * 8 + b) * 8 + hk * 2, __float_as_uint(n2 * 1.02f)); }
        LAS bf16* vl = (LAS bf16*)wl;
#pragma unroll
        for (int mt = 0; mt < 2; ++mt)
#pragma unroll
            for (int i = 0; i < 16; ++i) vl[(32 * mt + crow16(i, hh)) * 40 + vpos(r)] = f2bf(acc[2 + mt][i] * rk);
        LDS_WAIT();
        { const LAS u32x4* src4 = (const LAS u32x4*)(wl + lane * 80); u32x4* dst = (u32x4*)(F.vml() + ((size_t)(b * 4 + hk) * 64 + lane) * SQ + 32 * j32);
#pragma unroll
          for (int q = 0; q < 4; ++q) dst[q] = src4[q]; }
        LDS_WAIT();
    }
}
__device__ __forceinline__ int grab_unit(const Fr& F, unsigned* ctr) {
    volatile LAS int* slot = (volatile LAS int*)(F.lds + LDSCTL_OFF + 256);
    __syncthreads();
    if (F.tid == 0) *slot = (int)__hip_atomic_fetch_add(ctr, 1u, __ATOMIC_RELAXED, __HIP_MEMORY_SCOPE_AGENT);
    __syncthreads();
    return __builtin_amdgcn_readfirstlane(*slot);
}
__device__ __forceinline__ void prep_qk(const Fr& F, int L, int b, int j32) {
    int lane_ = F.lane; asm volatile("" : "+v"(lane_)); const int l = lane_, h = l >> 4;
    u32x2 raw[4][4];
#pragma unroll
    for (int i = 0; i < 4; ++i) { const int s = 32 * j32 + 4 * F.wave + i; const bf16* p = F.pbuf() + (size_t)bs2row(b, s) * NP + 4 * l;
        raw[i][0] = *(const u32x2*)(p + C_NA); raw[i][1] = *(const u32x2*)(p + C_NA + 256); raw[i][2] = *(const u32x2*)(p + C_DF); raw[i][3] = *(const u32x2*)(p + C_DF + 256); }
    const f32x4 gnq = *(const f32x4*)(F.na_gq() + L * 64 + 4 * (l & 15)), gnk = *(const f32x4*)(F.na_gk() + L * 64 + 4 * (l & 15));
    const f32x4 gdq = *(const f32x4*)(F.df_gq() + L * 32 + 4 * (l & 7)), gdk = *(const f32x4*)(F.df_gk() + L * 32 + 4 * (l & 7));
    float kmx_na = 0.f, kmx_df = 0.f;
#pragma unroll
    for (int i = 0; i < 4; ++i) { const int s = 32 * j32 + 4 * F.wave + i, t = s - 256; const bool lat = s >= 256;
#pragma unroll
        for (int w = 0; w < 4; ++w) {
            f32x4 x; x[0] = __uint_as_float(raw[i][w].x << 16); x[1] = __uint_as_float(raw[i][w].x & 0xffff0000u); x[2] = __uint_as_float(raw[i][w].y << 16); x[3] = __uint_as_float(raw[i][w].y & 0xffff0000u);
            float ss = (x[0] * x[0] + x[1] * x[1]) + (x[2] * x[2] + x[3] * x[3]);
            ss += dppf<0xB1>(ss); ss += dppf<0x4E>(ss); ss += dppf<0x141>(ss);
            if (w < 2) { ss += dppf<0x140>(ss);
                const float rs = rsqrtf(ss * (1.f / 64) + EPS); const f32x4 g = w == 0 ? gnq : gnk; x = x * rs * g;
                u32x2 o; o.x = pk2(x[0], x[1]); o.y = pk2(x[2], x[3]);
                if (w == 1) { float n2 = (x[0] * x[0] + x[1] * x[1]) + (x[2] * x[2] + x[3] * x[3]); n2 += dppf<0xB1>(n2); n2 += dppf<0x4E>(n2); n2 += dppf<0x141>(n2); n2 += dppf<0x140>(n2); kmx_na = fmaxf(kmx_na, n2); }
                *(u32x2*)((w == 0 ? F.qna() : F.kna()) + ((size_t)(b * 4 + h) * SQ + s) * 64 + 4 * (l & 15)) = o;
            } else {
                const float rs = rsqrtf(ss * (1.f / 32) + EPS); const f32x4 g = w == 2 ? gdq : gdk; x = x * rs * g;
                f32x4 xp; xp[0] = __shfl_xor(x[0], 4); xp[1] = __shfl_xor(x[1], 4); xp[2] = __shfl_xor(x[2], 4); xp[3] = __shfl_xor(x[3], 4);
                if (lat) { const f32x4 cs = *(const f32x4*)(F.rcos() + t * 16 + 4 * (l & 3)), sn = *(const f32x4*)(F.rsin() + t * 16 + 4 * (l & 3));
                    x = (l & 4) ? xp * sn + x * cs : x * cs - xp * sn; }
                u32x2 o; o.x = pk2(x[0], x[1]); o.y = pk2(x[2], x[3]);
                if (w == 3) { float n2 = (x[0] * x[0] + x[1] * x[1]) + (x[2] * x[2] + x[3] * x[3]); n2 += dppf<0xB1>(n2); n2 += dppf<0x4E>(n2); n2 += dppf<0x141>(n2); kmx_df = fmaxf(kmx_df, n2); }
                *(u32x2*)((w == 2 ? F.qdf() : F.kdf()) + ((size_t)(b * 4 + h) * SQ + s) * 64 + 4 * (l & 15)) = o;
            } } }
    if ((l & 15) == 0) atomicMax(F.ctl() + CW_KMAX + ((L * 3 + 0) * 8 + b) * 8 + h * 2, __float_as_uint(kmx_na * 1.02f));
    if ((l & 7) == 0) atomicMax(F.ctl() + CW_KMAX + ((L * 3 + 2) * 8 + b) * 8 + h * 2 + ((l >> 3) & 1), __float_as_uint(kmx_df * 1.02f));
}
__device__ __forceinline__ void prep_vconv(const Fr& F, int L, int b, int j32) {
    int tid_ = F.tid; asm volatile("; VCONV_BEGIN" : "+v"(tid_)); const int tid = tid_;
    const int s0 = 32 * j32; const size_t r0 = bs2row(b, s0);
    LAS bf16* Lv = (LAS bf16*)F.lds;
#ifndef VC_MASK
#define VC_MASK 7
#endif
    if (VC_MASK & 1) {   u32x4 v[4];
#pragma unroll
        for (int k = 0; k < 4; ++k) { const int idx = tid + 512 * k, mx = idx >> 10, tok = (idx >> 5) & 31, d8 = (idx & 31) * 8;
            v[k] = *(const u32x4*)(F.pbuf() + (r0 + tok) * NP + (mx ? C_DF + 512 : C_NA + 512) + d8); }
#pragma unroll
        for (int k = 0; k < 4; ++k) { const int idx = tid + 512 * k, mx = idx >> 10, tok = (idx >> 5) & 31, d8 = (idx & 31) * 8, pc = vpos(tok);
#pragma unroll
            for (int e = 0; e < 4; ++e) { Lv[(mx * 256 + d8 + 2 * e) * 40 + pc] = (bf16)(v[k][e] & 0xffffu); Lv[(mx * 256 + d8 + 2 * e + 1) * 40 + pc] = (bf16)(v[k][e] >> 16); } }
        __syncthreads();
#pragma unroll
        for (int k = 0; k < 4; ++k) { const int idx = tid + 512 * k, mx = idx >> 10, dv = (idx >> 2) & 255, pc = idx & 3;
            const u32x4 w = *(const LAS u32x4*)(Lv + (mx * 256 + dv) * 40 + pc * 8);
            *(u32x4*)((mx ? F.vdf() : F.vna()) + ((size_t)(b * 4 + (dv >> 6)) * 64 + (dv & 63)) * SQ + s0 + pc * 8) = w; }
        __syncthreads();
    }
    const bool isctx = s0 < 256; const int len = isctx ? TCTX : TLAT, t0 = isctx ? s0 : s0 - 256;
    LAS bf16* Lc = (LAS bf16*)F.lds;
    if (VC_MASK & 2) {   u32x4 v[7];
#pragma unroll
        for (int k = 0; k < 7; ++k) { const int idx = tid + 512 * k, j = idx / 96, c8 = (idx - 96 * j) * 8, tj = t0 - 2 + j; const int jc = min(max(tj, 0), len - 1) - t0;
            v[k] = (u32x4){0u, 0u, 0u, 0u};
            if (idx < 36 * 96) { v[k] = *(const u32x4*)(F.pbuf() + (size_t)((long)r0 + jc) * NP + C_XBC + c8); if (tj < 0 || tj >= len) v[k] = (u32x4){0u, 0u, 0u, 0u}; } }
#pragma unroll
        for (int k = 0; k < 7; ++k) { const int idx = tid + 512 * k, j = idx / 96, c8 = (idx - 96 * j) * 8; if (idx < 36 * 96) *(LAS u32x4*)(Lc + j * 768 + c8) = v[k]; }
    }
    __syncthreads();
    if (VC_MASK & 2)
#pragma unroll 1
    for (int pass = 0; pass < 2; ++pass) {
        const int cg = pass == 0 ? tid : 512 + tid;
        if (cg < 768) {
            float w[5];
#pragma unroll
            for (int j = 0; j < 5; ++j) w[j] = F.conv_w()[(L * 5 + j) * 768 + cg];
            const float bias = F.conv_b()[L * 768 + cg];
            const LAS bf16* lp = Lc + cg;
            float x0 = bf2f(lp[0]), x1 = bf2f(lp[768]), x2 = bf2f(lp[2 * 768]), x3 = bf2f(lp[3 * 768]);
            const int gch = cg >> 8, ch = cg & 255;
            bf16* tm = (gch == 1 ? F.btm() : F.ctm()) + ((size_t)b * SQ + s0) * 256 + ch;
            bf16* cm = (gch == 0 ? F.xT() : F.bT()) + ((size_t)b * 256 + ch) * SQ + s0;
#pragma unroll
            for (int g8 = 0; g8 < 4; ++g8) { unsigned pk[4];
#pragma unroll
                for (int e = 0; e < 8; ++e) { const int i = 8 * g8 + e; const float x4 = bf2f(lp[(i + 4) * 768]);
                    const float acc = bias + w[0] * x0 + w[1] * x1 + w[2] * x2 + w[3] * x3 + w[4] * x4; const unsigned o = f2bf(siluf(acc));
                    if (gch >= 1) tm[(size_t)i * 256] = (bf16)o;
                    if (e & 1) pk[e >> 1] |= o << 16; else pk[e >> 1] = o;
                    x0 = x1; x1 = x2; x2 = x3; x3 = x4; }
                if (gch <= 1) { u32x4 v; v.x = pk[0]; v.y = pk[1]; v.z = pk[2]; v.w = pk[3]; *(u32x4*)(cm + 8 * g8) = v; } }
        }
    }
    if ((VC_MASK & 4) && tid < 256) { const int tok = tid >> 3, i = tid & 7; const float raw = bf2f(F.pbuf()[(r0 + tok) * NP + C_DT + i]) + F.dt_bias()[L * 8 + i]; const float ex = __expf(raw);
      F.dtv()[((size_t)b * 8 + i) * SQ + s0 + tok] = raw > 20.f ? raw : (ex < 0.03f ? ex * (1.f - ex * (0.5f - ex * (0.33333334f - 0.25f * ex))) : __logf(1.f + ex)); }
    __syncthreads();
    asm volatile("; VCONV_END" ::: "memory");
}
__device__ __forceinline__ void phase_prep(const Fr& F0_, int L) {
    unsigned* ctr = F0_.ctl() + CW_QUEUE + (L * 16 + 0) * 64;
    for (;;) {
        const int u = grab_unit(F0_, ctr); if (u >= NB * 72) break;
        const int b = u / 72, j32 = u - 72 * b;
        { const Fr F = refresh(F0_); prep_qk(F, L, b, j32); }
        { const Fr F = refresh(F0_); mla_prep_block(F, L, b, j32); }
        __syncthreads();
    }
    __syncthreads();
    { const Fr F3 = refresh(F0_); for (int u = F3.G - 1 - F3.vcu; u < NB * 36; u += F3.G) prep_tile(F3, L, u / 36, u % 36); }
}

__device__ __forceinline__ void phase_ssd_naive(const Fr& F, int L) {
    if (F.wave != 0 || blockIdx.x >= 64) return;
    const int w = blockIdx.x, b = w >> 3, d = (w >> 2) & 1, h = w & 3, g = h >> 1, p = F.lane;
    const float a = -expf(F.a_log()[L * 8 + d * 4 + h]);
    float hs[128];
#pragma unroll
    for (int n = 0; n < 128; ++n) hs[n] = 0.f;
    const float* dtp = F.dtv() + ((size_t)b * 8 + d * 4 + h) * SQ;
    const bf16* xp = F.xT() + ((size_t)b * 256 + h * 64 + p) * SQ;
    for (int step = 0; step < SQ; ++step) {
        const int s = d == 0 ? step : (step < 256 ? 255 - step : SQ - 1 - (step - 256));
        const float dtv = dtp[s], dA = __expf(dtv * a), xv = bf2f(xp[s]) * dtv;
        const u32x4* Bp = (const u32x4*)(F.btm() + ((size_t)b * SQ + s) * 256 + g * 128);
        const u32x4* Cp = (const u32x4*)(F.ctm() + ((size_t)b * SQ + s) * 256 + g * 128);
        float y = 0.f;
#pragma unroll
        for (int n8 = 0; n8 < 16; ++n8) { const u32x4 bv = Bp[n8], cv = Cp[n8];
#pragma unroll
            for (int j = 0; j < 4; ++j) { const int n = n8 * 8 + 2 * j;
                hs[n] = hs[n] * dA + xv * __uint_as_float(bv[j] << 16); hs[n + 1] = hs[n + 1] * dA + xv * __uint_as_float(bv[j] & 0xffff0000u);
                y += __uint_as_float(cv[j] << 16) * hs[n] + __uint_as_float(cv[j] & 0xffff0000u) * hs[n + 1]; } }
        F.ydir()[((size_t)d * NROW + bs2row(b, s)) * 256 + h * 64 + p] = y;
    }
}

template <int KIND>
__device__ __forceinline__ void naive_attn_job(const Fr& F, int L, int r, int h, LAS float* scr) {
    constexpr int DQ = KIND == 1 ? 96 : (KIND == 0 ? 64 : 32), QS = KIND == 1 ? 96 : 64;
    const int lane = F.lane; int b, s; row2bs(r, b, s); const bool lat = r < NLAT; const int t = s - 256;
    const bf16* Qb = (KIND == 0 ? F.qna() : KIND == 1 ? F.qml() : F.qdf()) + ((size_t)(b * 4 + h) * SQ + s) * QS;
    const bf16* Kb = (KIND == 0 ? F.kna() : KIND == 1 ? F.kml() : F.kdf()) + (size_t)(b * 4 + h) * SQ * QS;
    const bf16* Vt = (KIND == 0 ? F.vna() : KIND == 1 ? F.vml() : F.vdf()) + ((size_t)(b * 4 + h) * 64 + lane) * SQ;
    const float scale = KIND == 1 ? 0.10206207261596577f : (KIND == 0 ? 0.125f : 0.17677669529663687f);
    const int qr = t >> 6, qc = t & 63, row_lo = min(max(qr - 4, 0), 24), col_lo = min(max(qc - 8, 0), 48);
    const bool nb = (KIND == 0) && lat;
    const int nk = lat ? (KIND == 0 ? 768 : SQ) : 256;
    const int koff = nb ? row_lo * 64 : 0;
    float oc[2] = {0.f, 0.f};
#pragma unroll
    for (int comp = 0; comp < (KIND == 2 ? 2 : 1); ++comp) {
        for (int i = lane; i < DQ; i += 64) scr[i] = bf2f(Qb[comp * 32 + i]);
        LDS_WAIT();
        float m = -INFINITY;
        for (int kk = lane; kk < nk; kk += 64) {
            const int sk = kk < 256 ? kk : kk + koff; float bias = 0.f; bool valid = true;
            if (nb && kk >= 256) { const int w = kk - 256, kr = w >> 6, kc = w & 63; valid = kc >= col_lo && kc < col_lo + 16;
                const int ro = row_lo + kr - qr + 7, co = min(max(kc - qc, -15), 15) + 15; bias = F.na_rb()[((L * 4 + h) * 15 + ro) * 31 + co]; }
            const u32x4* kp = (const u32x4*)(Kb + (size_t)sk * QS + (KIND == 2 ? comp * 32 : 0));
            float dot = 0.f;
#pragma unroll
            for (int i8 = 0; i8 < DQ / 8; ++i8) { const u32x4 kv = kp[i8];
#pragma unroll
                for (int j = 0; j < 4; ++j) dot += scr[i8 * 8 + 2 * j] * __uint_as_float(kv[j] << 16) + scr[i8 * 8 + 2 * j + 1] * __uint_as_float(kv[j] & 0xffff0000u); }
            const float sc = valid ? dot * scale + bias : -INFINITY;
            scr[128 + kk] = sc; m = fmaxf(m, sc);
        }
        m = wmaxf(m);
        float sum = 0.f;
        for (int kk = lane; kk < nk; kk += 64) { const float pv = __expf(scr[128 + kk] - m); scr[128 + kk] = pv; sum += pv; }
        sum = wsum(sum);
        LDS_WAIT();
        float o = 0.f;
        for (int kb = 0; kb < nk; kb += 8) {
            const int sb = kb < 256 ? kb : kb + koff;
            const u32x4 vv = *(const u32x4*)(Vt + sb);
#pragma unroll
            for (int j = 0; j < 8; ++j) { const int kk = (kb & ~15) + vpos((kb & 15) + j); const unsigned wv = vv[j >> 1];
                o += scr[128 + kk] * ((j & 1) ? __uint_as_float(wv & 0xffff0000u) : __uint_as_float(wv << 16)); }
        }
        oc[comp] = o / sum;
        LDS_WAIT();
    }
    bf16* mo = F.mix() + (size_t)r * DM + (KIND == 0 ? 0 : KIND == 1 ? 256 : 512) + h * 64 + lane;
    if (KIND == 2) {
        const float* lv = F.df_lam() + L * 128; const float li = 0.8f - 0.6f * expf(-0.3f * (float)L);
        float d1 = 0.f, d2 = 0.f;
#pragma unroll
        for (int i = 0; i < 32; ++i) { d1 += lv[i] * lv[32 + i]; d2 += lv[64 + i] * lv[96 + i]; }
        const float lam = expf(d1) - expf(d2) + li;
        const float o = oc[0] - lam * oc[1];
        const float rs = rsqrtf(wsum(o * o) * (1.f / 64) + EPS);
        *mo = f2bf(o * rs * F.df_gsub()[L * 64 + lane] * (1.f - li));
    } else *mo = f2bf(oc[0]);
}
__device__ __forceinline__ void phase_mix_naive(const Fr& F, int L) {
    LAS float* scr = (LAS float*)(F.lds + F.wave * 16384);
    const int nrows = (L == DEPTH - 1) ? NLAT : NROW;
    for (int j = F.gw; j < nrows * 4; j += F.NGW) naive_attn_job<2>(F, L, j >> 2, j & 3, scr);
    for (int j = F.gw; j < nrows * 4; j += F.NGW) naive_attn_job<1>(F, L, j >> 2, j & 3, scr);
    for (int j = F.gw; j < nrows * 4; j += F.NGW) naive_attn_job<0>(F, L, j >> 2, j & 3, scr);
    for (int r = F.gw; r < nrows; r += F.NGW) {
        int b, s; row2bs(r, b, s); const int h = F.lane >> 4; const float dsk = F.ssd_d()[L * 8 + h] + F.ssd_d()[L * 8 + 4 + h];
        float y[4]; float ss = 0.f;
#pragma unroll
        for (int j = 0; j < 4; ++j) { const int ch = F.lane * 4 + j; const float xv = bf2f(F.xT()[((size_t)b * 256 + ch) * SQ + s]);
            const float z = bf2f(F.pbuf()[(size_t)r * NP + C_Z + ch]);
            y[j] = (F.ydir()[(size_t)r * 256 + ch] + F.ydir()[((size_t)NROW + r) * 256 + ch] + dsk * xv) * siluf(z); ss += y[j] * y[j]; }
        const float rs = rsqrtf(wsum(ss) * (1.f / 256) + EPS);
#pragma unroll
        for (int j = 0; j < 4; ++j) { const int ch = F.lane * 4 + j; F.mix()[(size_t)r * DM + 768 + ch] = f2bf(y[j] * rs * F.ssd_gn()[L * 256 + ch]); }
    }
}

template <int S8> __device__ __forceinline__ bf16x8 pack_step(const f32x16& x) {
    u32x4 p;
    asm volatile("v_cvt_pk_bf16_f32 %0, %4, %5\n\tv_cvt_pk_bf16_f32 %1, %6, %7\n\tv_cvt_pk_bf16_f32 %2, %8, %9\n\tv_cvt_pk_bf16_f32 %3, %10, %11\n\ts_nop 1"
                 : "=&v"(p[0]), "=&v"(p[1]), "=&v"(p[2]), "=&v"(p[3])
                 : "v"(x[S8]), "v"(x[S8 + 1]), "v"(x[S8 + 2]), "v"(x[S8 + 3]), "v"(x[S8 + 4]), "v"(x[S8 + 5]), "v"(x[S8 + 6]), "v"(x[S8 + 7]));
    return __builtin_bit_cast(bf16x8, p);
}
constexpr float LOG2E = 1.4426950408889634f;
template <int KIND>
__device__ __forceinline__ void attn_unit(const Fr& F, int L, int b, int h, int qb) {
    constexpr int QS = KIND == 1 ? 96 : 64, NKS = KIND == 1 ? 6 : (KIND == 0 ? 4 : 2);
    constexpr int PK = QS * 2 + 16, PV = 272, KBYTES = 128 * PK, VBYTES = 64 * PV, NKP = QS == 96 ? 3 : 2, PPR = QS / 8;
    LAS unsigned char* const Kl = F.lds; LAS unsigned char* const Vl = F.lds + 2 * KBYTES;
    LAS float* const biasl = (LAS float*)(F.lds + 2 * KBYTES + 2 * VBYTES);
    const int lane = F.lane, wave = F.wave, tid = F.tid, r = lane & 31, hh = lane >> 5;
    const bool isctx = qb < 0;
    const int comp = KIND == 2 ? (wave & 1) : 0, qg = KIND == 2 ? (wave >> 1) : wave;
    const bf16* Qg = (KIND == 0 ? F.qna() : KIND == 1 ? F.qml() : F.qdf()) + (size_t)(b * 4 + h) * SQ * QS;
    const bf16* Kg = (KIND == 0 ? F.kna() : KIND == 1 ? F.kml() : F.kdf()) + (size_t)(b * 4 + h) * SQ * QS;
    const bf16* Vg = (KIND == 0 ? F.vna() : KIND == 1 ? F.vml() : F.vdf()) + (size_t)(b * 4 + h) * 64 * SQ;
    const float cs = (KIND == 1 ? 0.10206207261596577f : (KIND == 0 ? 0.125f : 0.17677669529663687f)) * LOG2E;
    int sq, qrow = 0, qcol = 0;
    if (KIND == 2) sq = (isctx ? 128 * (-qb - 1) : 256 + 128 * qb) + 32 * qg + r;
    else if (isctx) sq = 32 * wave + r; else if (KIND == 0) { qrow = 4 * qb + (wave >> 1); qcol = 32 * (wave & 1) + r; sq = 256 + 64 * qrow + qcol; } else sq = 256 + 256 * qb + 32 * wave + r;
    int nt = 36, lo_u = 0;
    if (isctx) nt = 4; else if (KIND == 0) { lo_u = min(max(4 * qb - 4, 0), 24); nt = 4 + min(max(4 * qb - 1, 0), 24) + 8 - lo_u; }
    const int np = (nt + 1) >> 1;
    const int my_lo = min(max(qrow - 4, 0), 24), col_lo = min(max(qcol - 8, 0), 48);
    if (KIND == 0 && !isctx) for (int i = tid; i < 465; i += 512) biasl[i] = F.na_rb()[(L * 4 + h) * 465 + i] * LOG2E;
    bf16x8 Q[NKS];
    { const bf16* qp = Qg + (size_t)sq * QS + comp * 32 + 8 * hh;
#pragma unroll
      for (int kk = 0; kk < NKS; ++kk) Q[kk] = *(const bf16x8*)(qp + 16 * kk); }
    f32x16 O[2]; float l = 0.f;
#pragma unroll
    for (int mt = 0; mt < 2; ++mt)
#pragma unroll
        for (int i = 0; i < 16; ++i) O[mt][i] = 0.f;
    float m;
    {   float q2 = 0.f;
#pragma unroll
        for (int kk = 0; kk < NKS; ++kk)
#pragma unroll
            for (int j = 0; j < 8; ++j) { const float v = bf2f((bf16)Q[kk][j]); q2 += v * v; }
        q2 += __shfl_xor(q2, 32);
        const float k2 = __uint_as_float(__hip_atomic_load(F.ctl() + CW_KMAX + ((L * 3 + KIND) * 8 + b) * 8 + h * 2 + comp, __ATOMIC_RELAXED, __HIP_MEMORY_SCOPE_AGENT));
        m = sqrtf(q2 * k2) * cs;
        if (KIND == 0 && !isctx) { float bm = 0.f; for (int i = lane; i < 465; i += 64) bm = fmaxf(bm, F.na_rb()[(L * 4 + h) * 465 + i]); m += wmaxf(bm) * LOG2E; }
    }
    u32x4 rk_0[NKP], rv_0[2];
#define AT_SK0(t) ((isctx || KIND != 0) ? 64 * (t) : ((t) < 4 ? 64 * (t) : 256 + 64 * (lo_u + (t) - 4)))
#define AT_LOAD(p, S_) do { const int sk0_ = AT_SK0(2 * (p)); const char* kg_ = (const char*)(Kg + (size_t)sk0_ * QS); \
        _Pragma("unroll") for (int i_ = 0; i_ < NKP; ++i_) rk_##S_[i_] = *(const u32x4*)(kg_ + (tid + 512 * i_) * 16); \
        _Pragma("unroll") for (int i_ = 0; i_ < 2; ++i_) { const int pi_ = tid + 512 * i_; rv_##S_[i_] = *(const u32x4*)(Vg + (size_t)(pi_ >> 4) * SQ + sk0_ + (pi_ & 15) * 8); } } while (0)
#define AT_STORE(buf, S_) do { \
        _Pragma("unroll") for (int i_ = 0; i_ < NKP; ++i_) { const int pi_ = tid + 512 * i_; *(LAS u32x4*)(Kl + (buf) * KBYTES + (pi_ / PPR) * PK + (pi_ % PPR) * 16) = rk_##S_[i_]; } \
        _Pragma("unroll") for (int i_ = 0; i_ < 2; ++i_) { const int pi_ = tid + 512 * i_; *(LAS u32x4*)(Vl + (buf) * VBYTES + (pi_ >> 4) * PV + (pi_ & 15) * 16) = rv_##S_[i_]; } } while (0)
#define AT_QK(SA, SB, kb_) do { \
        _Pragma("unroll") for (int i = 0; i < 16; ++i) { SA[i] = 0.f; SB[i] = 0.f; } \
        _Pragma("unroll") for (int kk = 0; kk < NKS; ++kk) { const bf16x8 a0 = *(const LAS bf16x8*)((kb_) + 32 * kk), a1 = *(const LAS bf16x8*)((kb_) + 32 * PK + 32 * kk); \
            SA = MFMA32(a0, Q[kk], SA); SB = MFMA32(a1, Q[kk], SB); } } while (0)
#define AT_SMPV(S0, S1, t_, vb_) do { \
        const int krow = lo_u + (t_) - 4; const bool nbt = (KIND == 0) && !isctx && (t_) >= 4; \
        float ps = 0.f; \
        if (nbt) { const int drow = (krow - qrow + 7) * 31 - qcol + 15; const float nm = -m; \
            _Pragma("unroll") for (int i = 0; i < 16; ++i) { const int kc = (i & 3) + 8 * (i >> 2) + 4 * hh; \
                { const bool v = (unsigned)(kc - col_lo) < 16u; const float bb = biasl[v ? drow + kc : 0]; S0[i] = v ? __builtin_amdgcn_exp2f(__builtin_fmaf(S0[i], cs, bb + nm)) : 0.f; } \
                { const bool v = (unsigned)(kc + 32 - col_lo) < 16u; const float bb = biasl[v ? drow + kc + 32 : 0]; S1[i] = v ? __builtin_amdgcn_exp2f(__builtin_fmaf(S1[i], cs, bb + nm)) : 0.f; } \
                ps += S0[i] + S1[i]; } \
        } else { const float nm = -m; \
            _Pragma("unroll") for (int i = 0; i < 16; ++i) { S0[i] = __builtin_amdgcn_exp2f(__builtin_fmaf(S0[i], cs, nm)); S1[i] = __builtin_amdgcn_exp2f(__builtin_fmaf(S1[i], cs, nm)); ps += S0[i] + S1[i]; } } \
        l += ps; \
        const bf16x8 p00 = pack_step<0>(S0), p01 = pack_step<8>(S0), p10 = pack_step<0>(S1), p11 = pack_step<8>(S1); \
        _Pragma("unroll") for (int mt = 0; mt < 2; ++mt) { \
            const LAS unsigned char* vb = (vb_) + mt * 32 * PV; \
            O[mt] = MFMA32(*(const LAS bf16x8*)(vb + 0), p00, O[mt]); O[mt] = MFMA32(*(const LAS bf16x8*)(vb + 32), p01, O[mt]); \
            O[mt] = MFMA32(*(const LAS bf16x8*)(vb + 64), p10, O[mt]); O[mt] = MFMA32(*(const LAS bf16x8*)(vb + 96), p11, O[mt]); } } while (0)
#define AT_COMPUTE(p_, buf_) do { \
        const int t0_ = 2 * (p_), t1_ = t0_ + 1; \
        const bool g0_ = (KIND != 0) || isctx || t0_ < 4 || (lo_u + t0_ - 4 >= my_lo && lo_u + t0_ - 4 < my_lo + 8); \
        const bool g1_ = (t1_ < nt) && ((KIND != 0) || isctx || t1_ < 4 || (lo_u + t1_ - 4 >= my_lo && lo_u + t1_ - 4 < my_lo + 8)); \
        const LAS unsigned char* Kb = Kl + (buf_) * KBYTES + r * PK + (comp * 32 + 8 * hh) * 2; const LAS unsigned char* Vb = Vl + (buf_) * VBYTES + r * PV + 16 * hh; \
        if (KIND == 0) { f32x16 S00, S01; \
            if (g0_) { AT_QK(S00, S01, Kb); AT_SMPV(S00, S01, t0_, Vb); } \
            if (g1_) { AT_QK(S00, S01, Kb + 64 * PK); AT_SMPV(S00, S01, t1_, Vb + 128); } \
        } else { f32x16 S00, S01, S10, S11; \
            AT_QK(S00, S01, Kb); \
            AT_QK(S10, S11, Kb + 64 * PK); \
            AT_SMPV(S00, S01, t0_, Vb); \
            AT_SMPV(S10, S11, t1_, Vb + 128); } } while (0)
    AT_LOAD(0, 0);
    AT_STORE(0, 0);
    __syncthreads();
    for (int p = 0; p < np; ++p) {
        const int buf = p & 1;
        if (p + 1 < np) AT_LOAD(p + 1, 0);
        AT_COMPUTE(p, buf);
        if (p + 1 < np) AT_STORE(buf ^ 1, 0);
        __syncthreads();
    }
#undef AT_COMPUTE
#undef AT_SMPV
#undef AT_QK
#undef AT_SK0
#undef AT_LOAD
#undef AT_STORE
    const float inv = 1.f / (l + __shfl_xor(l, 32));
    bf16* mo = F.mix() + (size_t)bs2row(b, sq) * DM + (KIND == 0 ? 0 : KIND == 1 ? 256 : 512) + h * 64 + 4 * hh;
    if (KIND == 2) {
        LAS float* xo = (LAS float*)F.lds + qg * 2048;
        if (comp == 1) {
#pragma unroll
            for (int mt = 0; mt < 2; ++mt)
#pragma unroll
                for (int i = 0; i < 16; ++i) xo[(mt * 16 + i) * 64 + lane] = O[mt][i] * inv; }
        __syncthreads();
        if (comp == 0) {
            const float* lv = F.df_lam() + L * 128; const float li = 0.8f - 0.6f * expf(-0.3f * (float)L);
            float d1 = 0.f, d2 = 0.f;
#pragma unroll
            for (int i = 0; i < 32; ++i) { d1 += lv[i] * lv[32 + i]; d2 += lv[64 + i] * lv[96 + i]; }
            const float lam = expf(d1) - expf(d2) + li;
            float ss = 0.f;
#pragma unroll
            for (int mt = 0; mt < 2; ++mt)
#pragma unroll
                for (int i = 0; i < 16; ++i) { const float o = O[mt][i] * inv - lam * xo[(mt * 16 + i) * 64 + lane]; O[mt][i] = o; ss += o * o; }
            ss += __shfl_xor(ss, 32);
            const float rs = rsqrtf(ss * (1.f / 64) + EPS) * (1.f - li);
#pragma unroll
            for (int mt = 0; mt < 2; ++mt)
#pragma unroll
                for (int g = 0; g < 4; ++g) { const f32x4 gs = *(const f32x4*)(F.df_gsub() + L * 64 + 32 * mt + 8 * g + 4 * hh);
                    u32x2 w; w.x = pk2(O[mt][4 * g] * rs * gs[0], O[mt][4 * g + 1] * rs * gs[1]); w.y = pk2(O[mt][4 * g + 2] * rs * gs[2], O[mt][4 * g + 3] * rs * gs[3]);
                    *(u32x2*)(mo + 32 * mt + 8 * g) = w; }
        }
        __syncthreads();
    } else {
#pragma unroll
        for (int mt = 0; mt < 2; ++mt)
#pragma unroll
            for (int g = 0; g < 4; ++g) { u32x2 w; w.x = pk2(O[mt][4 * g] * inv, O[mt][4 * g + 1] * inv); w.y = pk2(O[mt][4 * g + 2] * inv, O[mt][4 * g + 3] * inv);
                *(u32x2*)(mo + 32 * mt + 8 * g) = w; }
    }
}
__device__ __forceinline__ float ssd_cum(const Fr& F, int L, int b, int h, int d, int s0, float& dt, float& cum) {
    const int lane = F.lane;
    dt = F.dtv()[((size_t)b * 8 + d * 4 + h) * SQ + s0 + lane];
    const float la = dt * -__expf(F.a_log()[L * 8 + d * 4 + h]);
    float v = la;
#pragma unroll
    for (int o = 1; o < 64; o <<= 1) { const float t = __shfl_up(v, o); if (lane >= o) v += t; }
    const float total = __shfl(v, 63);
    cum = d == 0 ? v : total - v + la;
    return total;
}
__device__ __forceinline__ void ssd_s1_job(const Fr& F, int L, int b, int c, int h, LAS float* scr) {
    const int lane = F.lane, r = lane & 31, hh = lane >> 5, s0 = 64 * c, g = h >> 1;
#pragma unroll
    for (int d = 0; d < 2; ++d) { float dt, cum; const float tot = ssd_cum(F, L, b, h, d, s0, dt, cum); scr[d * 64 + lane] = dt * __expf(tot - cum);
        if (lane == 0) F.cdec()[((b * 2 + d) * 4 + h) * 36 + c] = __expf(tot); }
    LDS_WAIT();
    bf16x8 A[2][2][4];
#pragma unroll
    for (int mt = 0; mt < 2; ++mt)
#pragma unroll
        for (int kk = 0; kk < 4; ++kk) { const bf16x8 raw = *(const bf16x8*)(F.xT() + ((size_t)b * 256 + h * 64 + 32 * mt + r) * SQ + s0 + 16 * kk + 8 * hh);
#pragma unroll
            for (int d = 0; d < 2; ++d) { u32x4 o;
#pragma unroll
                for (int j = 0; j < 4; ++j) { const float w0 = scr[d * 64 + 16 * kk + 8 * hh + 2 * j], w1 = scr[d * 64 + 16 * kk + 8 * hh + 2 * j + 1];
                    o[j] = pk2(bf2f((bf16)raw[2 * j]) * w0, bf2f((bf16)raw[2 * j + 1]) * w1); }
                A[d][mt][kk] = __builtin_bit_cast(bf16x8, o); } }
#pragma unroll
    for (int nt = 0; nt < 4; ++nt) {
        bf16x8 Bf[4];
#pragma unroll
        for (int kk = 0; kk < 4; ++kk) Bf[kk] = *(const bf16x8*)(F.bT() + ((size_t)b * 256 + g * 128 + 32 * nt + r) * SQ + s0 + 16 * kk + 8 * hh);
#pragma unroll
        for (int d = 0; d < 2; ++d)
#pragma unroll
            for (int mt = 0; mt < 2; ++mt) { f32x16 acc;
#pragma unroll
                for (int i = 0; i < 16; ++i) acc[i] = 0.f;
#pragma unroll
                for (int kk = 0; kk < 4; ++kk) acc = MFMA32(A[d][mt][kk], Bf[kk], acc);
                float* dst = F.cst() + ((((size_t)(b * 2 + d) * 4 + h) * 36 + c) * 64 + 32 * mt) * 128 + 32 * nt + r;
#pragma unroll
                for (int i = 0; i < 16; ++i) dst[crow16(i, hh) * 128] = acc[i]; }
    }
    LDS_WAIT();
}
__device__ __forceinline__ void phase_ssd_s1(const Fr& F, int L) {
    LAS float* scr = (LAS float*)(F.lds + F.wave * 16384);
    for (int j = F.gw; j < NB * 36 * 4; j += F.NGW) ssd_s1_job(F, L, j / 144, (j / 4) % 36, j & 3, scr);
}
__device__ __forceinline__ void phase_ssd_scan(const Fr& F, int L) {
    for (int e4 = blockIdx.x * 512 + F.tid; e4 < NB * 2 * 4 * 2048; e4 += F.G * 512) {
        const int bdh = e4 >> 11, pn = (e4 & 2047) * 4, d = (bdh >> 2) & 1;
        f32x4 hst = (f32x4){0.f, 0.f, 0.f, 0.f};
        const float* cs_ = F.cst() + (size_t)bdh * 36 * 8192 + pn; bf16* he_ = F.hent() + (size_t)bdh * 36 * 8192 + pn; const float* cd_ = F.cdec() + bdh * 36;
#pragma unroll 1
        for (int s6 = 0; s6 < 36; s6 += 6) {
            f32x4 v[6]; float dc[6]; int cc[6];
#pragma unroll
            for (int j = 0; j < 6; ++j) { const int step = s6 + j; cc[j] = d == 0 ? step : (step < 4 ? 3 - step : 39 - step); v[j] = *(const f32x4*)(cs_ + (size_t)cc[j] * 8192); dc[j] = cd_[cc[j]]; }
#pragma unroll
            for (int j = 0; j < 6; ++j) { u32x2 o; o.x = pk2(hst[0], hst[1]); o.y = pk2(hst[2], hst[3]); *(u32x2*)(he_ + (size_t)cc[j] * 8192) = o; hst = hst * dc[j] + v[j]; }
        }
    }
}
__device__ __forceinline__ void ssd_s3_unit(const Fr& F, int L, int b, int c) {
    const int lane = F.lane, wave = F.wave, r = lane & 31, hh = lane >> 5, s0 = 64 * c, h = wave >> 1, it = wave & 1, g = h >> 1, itok = 32 * it + r;
    LAS float* scr = (LAS float*)(F.lds + wave * 16384);
    LAS float* red = (LAS float*)(F.lds + 8192);
#pragma unroll
    for (int d = 0; d < 2; ++d) { float dt, cum; (void)ssd_cum(F, L, b, h, d, s0, dt, cum); scr[d * 128 + lane] = cum; scr[d * 128 + 64 + lane] = dt; }
    LDS_WAIT();
    bf16x8 Cf[8];
#pragma unroll
    for (int kk = 0; kk < 8; ++kk) Cf[kk] = *(const bf16x8*)(F.ctm() + ((size_t)b * SQ + s0 + itok) * 256 + g * 128 + 16 * kk + 8 * hh);
    f32x16 G[2];
#pragma unroll
    for (int jt = 0; jt < 2; ++jt) {
#pragma unroll
        for (int i = 0; i < 16; ++i) G[jt][i] = 0.f;
#pragma unroll
        for (int kk = 0; kk < 8; ++kk) { const bf16x8 bf = *(const bf16x8*)(F.btm() + ((size_t)b * SQ + s0 + 32 * jt + r) * 256 + g * 128 + 16 * kk + 8 * hh); G[jt] = MFMA32(bf, Cf[kk], G[jt]); } }
    bf16x8 X[2][4];
#pragma unroll
    for (int mt = 0; mt < 2; ++mt)
#pragma unroll
        for (int ks = 0; ks < 4; ++ks) { const bf16* xp = F.xT() + ((size_t)b * 256 + h * 64 + 32 * mt + r) * SQ + s0 + 16 * ks + 4 * hh;
            const u32x2 lo = *(const u32x2*)xp, hi = *(const u32x2*)(xp + 8); u32x4 o; o.x = lo.x; o.y = lo.y; o.z = hi.x; o.w = hi.y; X[mt][ks] = __builtin_bit_cast(bf16x8, o); }
    f32x16 Y[2];
#pragma unroll
    for (int mt = 0; mt < 2; ++mt)
#pragma unroll
        for (int i = 0; i < 16; ++i) Y[mt][i] = 0.f;
    const float Dsum = F.ssd_d()[L * 8 + h] + F.ssd_d()[L * 8 + 4 + h];
#pragma unroll 1
    for (int d = 0; d < 2; ++d) {
        const float cum_i = scr[d * 128 + itok];
        f32x16 Pm[2];
#pragma unroll
        for (int jt = 0; jt < 2; ++jt)
#pragma unroll
            for (int i = 0; i < 16; ++i) { const int j = 32 * jt + crow16(i, hh); const bool valid = d == 0 ? (j <= itok) : (j >= itok);
                const float arg = valid ? cum_i - scr[d * 128 + j] : -INFINITY;
                float pv = G[jt][i] * __expf(arg) * scr[d * 128 + 64 + j];
                if (d == 0 && j == itok) pv += Dsum;
                Pm[jt][i] = pv; }
        const bf16x8 p0 = pack_step<0>(Pm[0]), p1 = pack_step<8>(Pm[0]), p2 = pack_step<0>(Pm[1]), p3 = pack_step<8>(Pm[1]);
#pragma unroll
        for (int mt = 0; mt < 2; ++mt) { Y[mt] = MFMA32(X[mt][0], p0, Y[mt]); Y[mt] = MFMA32(X[mt][1], p1, Y[mt]); Y[mt] = MFMA32(X[mt][2], p2, Y[mt]); Y[mt] = MFMA32(X[mt][3], p3, Y[mt]); }
        const float ei = __expf(cum_i);
#pragma unroll
        for (int mt = 0; mt < 2; ++mt) { f32x16 T;
#pragma unroll
            for (int i = 0; i < 16; ++i) T[i] = 0.f;
#pragma unroll
            for (int kk = 0; kk < 8; ++kk) { const bf16x8 hf = *(const bf16x8*)(F.hent() + ((((size_t)(b * 2 + d) * 4 + h) * 36 + c) * 64 + 32 * mt + r) * 128 + 16 * kk + 8 * hh); T = MFMA32(hf, Cf[kk], T); }
#pragma unroll
            for (int i = 0; i < 16; ++i) Y[mt][i] += ei * T[i]; }
    }
    const size_t row = bs2row(b, s0 + itok);
    const bf16* zp = F.pbuf() + row * NP + C_Z + h * 64 + 4 * hh;
    float ss = 0.f;
#pragma unroll
    for (int mt = 0; mt < 2; ++mt)
#pragma unroll
        for (int gq = 0; gq < 4; ++gq) { const u32x2 z4 = *(const u32x2*)(zp + 32 * mt + 8 * gq);
            const float z0 = __uint_as_float(z4.x << 16), z1 = __uint_as_float(z4.x & 0xffff0000u), z2 = __uint_as_float(z4.y << 16), z3 = __uint_as_float(z4.y & 0xffff0000u);
            Y[mt][4 * gq] *= siluf(z0); Y[mt][4 * gq + 1] *= siluf(z1); Y[mt][4 * gq + 2] *= siluf(z2); Y[mt][4 * gq + 3] *= siluf(z3);
            ss += (Y[mt][4 * gq] * Y[mt][4 * gq] + Y[mt][4 * gq + 1] * Y[mt][4 * gq + 1]) + (Y[mt][4 * gq + 2] * Y[mt][4 * gq + 2] + Y[mt][4 * gq + 3] * Y[mt][4 * gq + 3]); }
    ss += __shfl_xor(ss, 32);
    if (hh == 0) red[(it * 4 + h) * 32 + r] = ss;
    __syncthreads();
    const float tot = (red[(it * 4 + 0) * 32 + r] + red[(it * 4 + 1) * 32 + r]) + (red[(it * 4 + 2) * 32 + r] + red[(it * 4 + 3) * 32 + r]);
    const float rs = rsqrtf(tot * (1.f / 256) + EPS);
    bf16* mo = F.mix() + row * DM + 768 + h * 64 + 4 * hh;
#pragma unroll
    for (int mt = 0; mt < 2; ++mt)
#pragma unroll
        for (int gq = 0; gq < 4; ++gq) { const f32x4 gn = *(const f32x4*)(F.ssd_gn() + L * 256 + h * 64 + 32 * mt + 8 * gq + 4 * hh);
            u32x2 w; w.x = pk2(Y[mt][4 * gq] * rs * gn[0], Y[mt][4 * gq + 1] * rs * gn[1]); w.y = pk2(Y[mt][4 * gq + 2] * rs * gn[2], Y[mt][4 * gq + 3] * rs * gn[3]);
            *(u32x2*)(mo + 32 * mt + 8 * gq) = w; }
    __syncthreads();
}
template <int KIND> __device__ __forceinline__ void attn_units(const Fr& F, int L) {
    if (KIND == 2) { const int nu = (L == DEPTH - 1) ? 512 : 576;
        for (int u = F.vcu; u < nu; u += F.G) { if (u < 512) attn_unit<2>(F, L, u >> 6, (u >> 4) & 3, u & 15); else attn_unit<2>(F, L, (u - 512) >> 3, ((u - 512) >> 1) & 3, -1 - (u & 1)); }
    } else { const int nu = (L == DEPTH - 1) ? 256 : 288;
        for (int u = F.vcu; u < nu; u += F.G) { if (u < 256) attn_unit<KIND>(F, L, u >> 5, (u >> 3) & 3, u & 7); else attn_unit<KIND>(F, L, (u - 256) >> 2, (u - 256) & 3, -1); } }
}
__device__ __forceinline__ void phase_mix_fast(const Fr& F, int L) {
#ifndef ATT_MASK
#define ATT_MASK 15
#endif
#ifndef ATT_DUP
#define ATT_DUP 0
#endif
#ifndef ATT_MASK
#define ATT_MASK 15
#endif
    if (ATT_MASK & 4) for (int rp = 0; rp < ((ATT_DUP & 4) ? 2 : 1); ++rp) { const Fr Fa = refresh(F); attn_units<2>(Fa, L); }
    if (ATT_MASK & 2) for (int rp = 0; rp < ((ATT_DUP & 2) ? 2 : 1); ++rp) { const Fr Fa = refresh(F); attn_units<1>(Fa, L); }
    if (ATT_MASK & 1) for (int rp = 0; rp < ((ATT_DUP & 1) ? 2 : 1); ++rp) { const Fr Fa = refresh(F); attn_units<0>(Fa, L); }
    const int c0 = (L == DEPTH - 1) ? 4 : 0;
    if (ATT_MASK & 8) for (int rp = 0; rp < ((ATT_DUP & 8) ? 2 : 1); ++rp) { const Fr Fa = refresh(F);
    for (int u = Fa.vcu; u < NB * (36 - c0); u += Fa.G) ssd_s3_unit(Fa, L, u / (36 - c0), c0 + u % (36 - c0)); }
}

__device__ __forceinline__ void phase_route(const Fr& F, int L, bool commit = true) {
    const int nrows = (L == DEPTH - 1) ? NLAT : NROW;
    LAS float* wl = (LAS float*)F.lds;
    {   const f32x4* wg4 = (const f32x4*)(F.w_grp() + (size_t)L * DM * 4); const f32x4* we4 = (const f32x4*)(F.w_exp() + (size_t)L * DM * 16);
        f32x4 tg[2], te[8];
#pragma unroll
        for (int n = 0; n < 2; ++n) tg[n] = wg4[F.tid + 512 * n];
#pragma unroll
        for (int n = 0; n < 8; ++n) te[n] = we4[F.tid + 512 * n];
#pragma unroll
        for (int n = 0; n < 2; ++n) { const int k = F.tid + 512 * n;
#pragma unroll
            for (int o = 0; o < 4; ++o) wl[o * DM + k] = tg[n][o]; }
#pragma unroll
        for (int n = 0; n < 8; ++n) { const int i = F.tid + 512 * n, k = i >> 2, q = i & 3;
#pragma unroll
            for (int o = 0; o < 4; ++o) wl[(4 + 4 * q + o) * DM + k] = te[n][o]; }
    }
    __syncthreads();
    float keep[20];
#pragma unroll
    for (int o = 0; o < 20; ++o) keep[o] = 0.f;
    f32x4 v[4], vn[4];
    { const int r = F.gw; if (r < nrows) { const float* hp = r < NLAT ? F.out() + (size_t)r * DM : F.hc() + (size_t)(r - NLAT) * DM;
#pragma unroll
        for (int j = 0; j < 4; ++j) vn[j] = *(const f32x4*)(hp + 4 * F.lane + 256 * j); } }
    int it = 0;
    for (int r = F.gw; r < nrows; r += F.NGW, ++it) {
        const bool lat = r < NLAT; const int bb = lat ? (r >> 11) : 8;
#pragma unroll
        for (int j = 0; j < 4; ++j) v[j] = vn[j];
        { const int rn = r + F.NGW; if (rn < nrows) { const float* hp = rn < NLAT ? F.out() + (size_t)rn * DM : F.hc() + (size_t)(rn - NLAT) * DM;
#pragma unroll
            for (int j = 0; j < 4; ++j) vn[j] = *(const f32x4*)(hp + 4 * F.lane + 256 * j); } }
        float ss = 0.f;
#pragma unroll
        for (int j = 0; j < 4; ++j) ss += (v[j][0] * v[j][0] + v[j][1] * v[j][1]) + (v[j][2] * v[j][2] + v[j][3] * v[j][3]);
        const float rstd = rsqrtf(wsum(ss) * (1.f / DM) + EPS);
        const float* md = F.modv() + ((size_t)L * 9 + bb) * 6144;
        float lg[20];
#pragma unroll
        for (int o = 0; o < 20; ++o) lg[o] = 0.f;
#pragma unroll
        for (int j = 0; j < 4; ++j) { const int c = 4 * F.lane + 256 * j; const f32x4 g = *(const f32x4*)(F.g_ffn() + L * DM + c), sh = *(const f32x4*)(md + 3 * 1024 + c), scl = *(const f32x4*)(md + 4 * 1024 + c);
            const f32x4 f = v[j] * rstd * g * (scl + 1.f) + sh; u32x2 o2; o2.x = pk2(f[0], f[1]); o2.y = pk2(f[2], f[3]); *(u32x2*)(F.abuf() + (size_t)r * DM + c) = o2;
#pragma unroll
            for (int o = 0; o < 20; ++o) { const f32x4 w = *(const LAS f32x4*)(wl + o * DM + c); lg[o] += (f[0] * w[0] + f[1] * w[1]) + (f[2] * w[2] + f[3] * w[3]); }
            asm volatile("" ::: "memory"); }
#pragma unroll
        for (int o = 0; o < 20; ++o) { const float t = wsum(lg[o]); keep[o] = (F.lane == it) ? t : keep[o]; }
    }
    if (F.lane < it) {
        const int r = F.gw + F.lane * F.NGW;
        float gl[4]; float gm = -INFINITY; int gt = 0;
#pragma unroll
        for (int o = 0; o < 4; ++o) { gl[o] = keep[o] + F.b_grp()[L * 4 + o]; if (gl[o] > gm) { gm = gl[o]; gt = o; } }
        float gs = 0.f;
#pragma unroll
        for (int o = 0; o < 4; ++o) gs += expf(gl[o] - gm);
        const float gp = 1.f / gs;
        float el[4];
#pragma unroll
        for (int o = 0; o < 4; ++o) { float v4 = 0.f;
#pragma unroll
            for (int q = 0; q < 4; ++q) v4 = (gt == q) ? keep[4 + 4 * q + o] + F.b_exp()[L * 16 + 4 * q + o] : v4;
            el[o] = v4; }
        int i0 = 0; float m0 = el[0];
#pragma unroll
        for (int o = 1; o < 4; ++o) if (el[o] > m0) { m0 = el[o]; i0 = o; }
        int i1 = i0 == 0 ? 1 : 0; float m1 = i0 == 0 ? el[1] : el[0];
#pragma unroll
        for (int o = 1; o < 4; ++o) if (o != i0 && el[o] > m1) { m1 = el[o]; i1 = o; }
        const float e1 = expf(m1 - m0), w0 = gp / (1.f + e1), w1 = gp * e1 / (1.f + e1);
        const int x0 = gt * 4 + i0, x1 = gt * 4 + i1;
        if (commit) {
            F.rtw()[2 * r] = w0; F.rtw()[2 * r + 1] = w1;
            const unsigned p0 = atomicAdd(F.ctl() + CW_ECNT + (L * 16 + x0) * 64, 1u), p1 = atomicAdd(F.ctl() + CW_ECNT + (L * 16 + x1) * 64, 1u);
            F.elist()[x0 * NROW + p0] = 2 * r; F.elist()[x1 * NROW + p1] = 2 * r + 1; }
        else if (w0 + w1 < -1.f) F.rtw()[0] = 0.f;
    }
    __syncthreads();
}
__device__ __forceinline__ void moe_table(const Fr& F, int L) {
    volatile LAS int* T = (volatile LAS int*)(F.lds + LDSCTL_OFF + 64);
    volatile LAS int* Cn = (volatile LAS int*)(F.lds + LDSCTL_OFF + 160);
    __syncthreads();
    if (F.tid == 0) { int acc = 0;
        for (int e = 0; e < 16; ++e) { int c = (int)__hip_atomic_load(F.ctl() + CW_ECNT + (L * 16 + e) * 64, __ATOMIC_RELAXED, __HIP_MEMORY_SCOPE_AGENT); c = min(max(c, 0), NROW); T[e] = acc; Cn[e] = c; acc += (c + 255) >> 8; }
        T[16] = acc; }
    __syncthreads();
}

__global__ void __launch_bounds__(512, 2) fwd_kernel(Args args) {
    extern __shared__ __attribute__((aligned(16))) unsigned char lds_raw[];
    Fr F0;
    F0.lds = (LAS unsigned char*)lds_raw; F0.tid = threadIdx.x; F0.lane = F0.tid & 63; F0.wave = __builtin_amdgcn_readfirstlane(F0.tid >> 6);
    F0.G = gridDim.x; { const int bx = blockIdx.x; F0.vcu = (F0.G % 8 == 0) ? (bx % 8) * (F0.G / 8) + bx / 8 : bx; }
    F0.gw = F0.vcu * 8 + F0.wave; F0.NGW = F0.G * 8;
    F0.A = (const __attribute__((address_space(4))) Args*)__builtin_amdgcn_kernarg_segment_ptr();
    for (int u = F0.tid; u < (LDS_BYTES - LDSCTL_OFF) / 4; u += 512) ((LAS unsigned*)(F0.lds + LDSCTL_OFF))[u] = 0u;
    __syncthreads();
    const int lo = args.ph_lo, hi = args.ph_hi;
    XcdBarrier bar; bar.bar = F0.ctl() + CW_BAR; bar.x = 0; bar.st = nullptr;
    if (hi - lo > 1) bar = xcd_barrier_post(F0.ctl() + CW_BAR, (volatile LAS unsigned*)(F0.lds + LDSCTL_OFF));
#ifndef PH_MASK
#define PH_MASK 0xFFFF
#endif
#define PM(b) ((PH_MASK >> (b)) & 1)
#ifndef DUP_MASK
#define DUP_MASK 0
#endif
#ifndef DBL_SEAM
#define DBL_SEAM 0
#endif
#define NREP(b) (((DUP_MASK >> (b)) & 1) ? 2 : 1)
#define IN(k) (lo <= (k) && (k) < hi)
#define SEAM(k) do { if (IN(k) && IN((k) + 1)) { const Fr Fb = refresh(F0); XcdBarrier b2 = bar; b2.bar = Fb.ctl() + CW_BAR; xcd_barrier(b2); if ((DUP_MASK & 0x10000) || ((DBL_SEAM >> (((k) + NPH_L - 1) % NPH_L)) & 1)) xcd_barrier(b2); } } while (0)

    if (PM(0) && IN(0)) { for (int rep_ = 0; rep_ < NREP(0); ++rep_) { if (rep_) __syncthreads(); const Fr F = refresh(F0); phase_prologue(F); } }
    SEAM(0);
    for (int L = 0; L < DEPTH; ++L) {
        const int pb = 1 + NPH_L * L;
        const bool lastL = (L == DEPTH - 1);
        if (PM(1) && IN(pb + 0)) { const Fr F = refresh(F0); phase_norm(F, L); if (DUP_MASK & 2048) { __syncthreads(); phase_norm(F, L, false); } for (int rp = 0; rp < NREP(10); ++rp) moe_weight_convert(F, L); }
        SEAM(pb + 0);
        if (PM(2) && IN(pb + 1)) { for (int rep_ = 0; rep_ < NREP(2); ++rep_) { if (rep_) __syncthreads(); const Fr F = refresh(F0); pg8::DenseSched S; S.init(F.abuf(), F.winT() + (size_t)L * NP * DM, DM, NROW, NP, F.G, (int)blockIdx.x); pg8::EpiP E{F.pbuf()}; pg8::gemm_phase(F.lds, F.tid, DM, S, E); } }
        SEAM(pb + 1);
        if (PM(3) && IN(pb + 2)) { for (int rep_ = 0; rep_ < NREP(3); ++rep_) { if (rep_) __syncthreads(); const Fr F = refresh(F0); phase_prep(F, L); } }
        SEAM(pb + 2);
        if (PM(4) && IN(pb + 3)) { for (int rep_ = 0; rep_ < NREP(4); ++rep_) { if (rep_) __syncthreads(); const Fr F = refresh(F0); phase_ssd_s1(F, L); } }
        SEAM(pb + 3);
        if (PM(4) && IN(pb + 4)) { for (int rep_ = 0; rep_ < NREP(6); ++rep_) { if (rep_) __syncthreads(); const Fr F = refresh(F0); phase_ssd_scan(F, L); } }
        SEAM(pb + 4);
        if (PM(5) && IN(pb + 5)) { for (int rep_ = 0; rep_ < NREP(5); ++rep_) { if (rep_) __syncthreads(); const Fr F = refresh(F0); phase_mix_fast(F, L); } }
        SEAM(pb + 5);
        if (PM(6) && IN(pb + 6)) { const Fr F = refresh(F0); pg8::DenseSched S; S.init(F.mix(), F.woutT() + (size_t)L * DM * DM, DM, lastL ? NLAT : NROW, DM, F.G, (int)blockIdx.x);
            pg8::EpiRes E{L == 0 ? F.x() : F.out(), L == 0 ? F.ctx() : F.hc(), F.out(), F.hc(), F.modv() + (size_t)L * 9 * 6144 + 2 * 1024, 1.f}; pg8::gemm_phase(F.lds, F.tid, DM, S, E);
            if (DUP_MASK & 8192) { __syncthreads(); pg8::EpiRes E2{F.out(), F.hc(), F.out(), F.hc(), F.modv() + (size_t)L * 9 * 6144 + 2 * 1024, 0.f}; pg8::gemm_phase(F.lds, F.tid, DM, S, E2); } }
        SEAM(pb + 6);
        if (PM(7) && IN(pb + 7)) { const Fr F = refresh(F0); phase_route(F, L); if (DUP_MASK & 4096) phase_route(F, L, false); }
        SEAM(pb + 7);
        if (PM(8) && IN(pb + 8)) { for (int rep_ = 0; rep_ < NREP(8); ++rep_) { if (rep_) __syncthreads(); const Fr F = refresh(F0); moe_table(F, L);
            pg8::MoeSched<true> S{(const char*)F.abuf(), (const char*)F.wgu(), (size_t)1024 * DM * 2, DM, F.G, F.vcu, F.elist(), (const volatile LAS int*)(F.lds + LDSCTL_OFF + 64), (const volatile LAS int*)(F.lds + LDSCTL_OFF + 160)};
            pg8::EpiAct E{F.act()}; pg8::gemm_phase(F.lds, F.tid, DM, S, E); } }
        SEAM(pb + 8);
        if (PM(9) && IN(pb + 9)) { for (int rep_ = 0; rep_ < NREP(9); ++rep_) { if (rep_) __syncthreads(); const Fr F = refresh(F0); moe_table(F, L);
            pg8::MoeSched<false> S{(const char*)F.act(), (const char*)F.wd(), (size_t)1024 * FF * 2, FF, F.G, F.vcu, F.elist(), (const volatile LAS int*)(F.lds + LDSCTL_OFF + 64), (const volatile LAS int*)(F.lds + LDSCTL_OFF + 160)};
            pg8::EpiDown E{F.yk(), F.elist(), F.rtw()}; pg8::gemm_phase(F.lds, F.tid, FF, S, E); } }
        SEAM(pb + 9);
    }
    if (PM(1) && IN(PH_FINAL)) { const Fr F = refresh(F0); phase_norm(F, DEPTH); }
#undef IN
#undef SEAM
}

extern "C" void kernel_launch(void* const* d_in, const int* in_sizes, int n_in, void* d_out, int out_size, void* d_ws, size_t ws_size, hipStream_t stream) {
    static int grid = 0;
    if (grid == 0) {
        if (n_in != 36 || out_size != NLAT * DM || ws_size < WS_END) { fprintf(stderr, "kernel_launch: unexpected shapes (n_in %d out %d ws %zu)\n", n_in, out_size, ws_size); grid = -1; return; }
        int dev = 0, cus = 0, per_cu = 0;
        if (hipGetDevice(&dev) != hipSuccess || hipDeviceGetAttribute(&cus, hipDeviceAttributeMultiprocessorCount, dev) != hipSuccess) { grid = -1; return; }
        if (hipFuncSetAttribute((const void*)fwd_kernel, hipFuncAttributeMaxDynamicSharedMemorySize, LDS_BYTES) != hipSuccess) { fprintf(stderr, "kernel_launch: hipFuncSetAttribute failed\n"); grid = -1; return; }
        if (hipOccupancyMaxActiveBlocksPerMultiprocessor(&per_cu, (const void*)fwd_kernel, 512, LDS_BYTES) != hipSuccess || per_cu < 1) { fprintf(stderr, "kernel_launch: occupancy query says %d\n", per_cu); }
        (void)hipGetLastError();
        grid = cus;
    }
    if (grid < 0) return;
    (void)hipMemsetAsync((char*)d_ws + WS_CTL, 0, CTL_BYTES, stream);
    Args a{};
    for (int i = 0; i < 36; ++i) a.in[i] = (const float*)d_in[i];
    a.out = (float*)d_out; a.ws = (unsigned char*)d_ws;
#if MK_ONE_LAUNCH
    a.ph_lo = 0; a.ph_hi = NPHASE;
    hipLaunchKernelGGL(fwd_kernel, dim3(grid), dim3(512), LDS_BYTES, stream, a);
#else
    for (int ph = 0; ph < NPHASE; ++ph) { a.ph_lo = ph; a.ph_hi = ph + 1; hipLaunchKernelGGL(fwd_kernel, dim3(grid), dim3(512), LDS_BYTES, stream, a); }
#endif
}
```

```cpp
#include <hip/hip_runtime.h>
#include <cstdio>
#include <cstdint>

#ifndef MK_ONE_LAUNCH
#define MK_ONE_LAUNCH 1
#endif

#define LAS __attribute__((address_space(3)))
typedef unsigned short bf16;
typedef short bf16x8 __attribute__((ext_vector_type(8)));
typedef float f32x4 __attribute__((ext_vector_type(4)));
typedef float f32x2 __attribute__((ext_vector_type(2)));
typedef unsigned u32x4 __attribute__((ext_vector_type(4)));
typedef unsigned u32x2 __attribute__((ext_vector_type(2)));

constexpr int NB = 8, TLAT = 2048, TCTX = 256, SQ = 2304, DM = 1024, DEPTH = 4;
constexpr int NLAT = NB * TLAT, NCTXR = NB * TCTX, NROW = NLAT + NCTXR;
constexpr int NIN = 2984, NP = 3072;
constexpr int C_NA = 0, C_MLA = 768, C_DF = 1184, C_SSD = 1952;
constexpr int C_Z = C_SSD, C_XBC = C_SSD + 256, C_DT = C_SSD + 1024;
constexpr float EPS = 1e-6f;
constexpr int NEXP = 16, FF = 512, ACT_ROWS = 40960;
constexpr int NPH_L = 10, PH_FINAL = 1 + NPH_L * DEPTH, NPHASE = PH_FINAL + 1;

constexpr size_t MiB = 1u << 20;
constexpr size_t WS_CTL = 0, CTL_BYTES = 1 * MiB;
constexpr size_t WS_MOD = 1 * MiB;
constexpr size_t WS_ROPE = 2 * MiB;
constexpr size_t WS_WIN = 4 * MiB;
constexpr size_t WS_WOUT = 28 * MiB;
constexpr size_t WS_WQB = 36 * MiB;
constexpr size_t WS_WKVB = 37 * MiB;
constexpr size_t WS_WGU = 38 * MiB;
constexpr size_t WS_WD = 70 * MiB;
constexpr size_t WS_HC = 86 * MiB;
constexpr size_t WS_A = 94 * MiB;
constexpr size_t WS_P = 130 * MiB;
constexpr size_t WS_ACT = 130 * MiB;
constexpr size_t WS_YK = 170 * MiB;
constexpr size_t WS_MIX = 238 * MiB;
constexpr size_t WS_QNA = 274 * MiB, WS_KNA = 283 * MiB, WS_VNA = 292 * MiB;
constexpr size_t WS_QML = 301 * MiB, WS_KML = 315 * MiB, WS_VML = 329 * MiB;
constexpr size_t WS_QDF = 338 * MiB, WS_KDF = 347 * MiB, WS_VDF = 356 * MiB;
constexpr size_t WS_XT = 365 * MiB, WS_BTM = 374 * MiB, WS_BT = 383 * MiB, WS_CTM = 392 * MiB;
constexpr size_t WS_DT = 401 * MiB;
constexpr size_t WS_CST = 402 * MiB;
constexpr size_t WS_CDEC = 474 * MiB;
constexpr size_t WS_HENT = 475 * MiB;
constexpr size_t WS_RT = 511 * MiB;
constexpr size_t WS_ELIST = 512 * MiB;
constexpr size_t WS_END = 514 * MiB;
constexpr int CW_BAR = 4096;
constexpr int CW_ECNT = 16384;
constexpr int CW_KMAX = 65536;
constexpr int CW_QUEUE = 32768;

constexpr int RING_BYTES = 131072, LDSCTL_OFF = RING_BYTES, LDS_BYTES = 147456;

typedef float f32x16 __attribute__((ext_vector_type(16)));
#define MFMA32(a, b, c) __builtin_amdgcn_mfma_f32_32x32x16_bf16((a), (b), (c), 0, 0, 0)
__device__ __forceinline__ int crow16(int reg, int hh) { return (reg & 3) + 8 * (reg >> 2) + 4 * hh; }
__device__ __forceinline__ float bf2f(bf16 v) { return __uint_as_float(((unsigned)v) << 16); }
__device__ __forceinline__ bf16 f2bf(float f) { unsigned u = __float_as_uint(f); return (bf16)((u + 0x7fffu + ((u >> 16) & 1u)) >> 16); }
__device__ __forceinline__ unsigned pk2(float lo, float hi) { return (unsigned)f2bf(lo) | ((unsigned)f2bf(hi) << 16); }
template <int CTRL> __device__ __forceinline__ float dppf(float v) { return __int_as_float(__builtin_amdgcn_update_dpp(0, __float_as_int(v), CTRL, 0xF, 0xF, true)); }
__device__ __forceinline__ float rlane(float v, int l) { return __int_as_float(__builtin_amdgcn_readlane(__float_as_int(v), l)); }
__device__ __forceinline__ float wsum(float v) {
    v += dppf<0xB1>(v); v += dppf<0x4E>(v); v += dppf<0x141>(v); v += dppf<0x140>(v);
    return (rlane(v, 0) + rlane(v, 16)) + (rlane(v, 32) + rlane(v, 48)); }
__device__ __forceinline__ float wmaxf(float v) {
    v = fmaxf(v, dppf<0xB1>(v)); v = fmaxf(v, dppf<0x4E>(v)); v = fmaxf(v, dppf<0x141>(v)); v = fmaxf(v, dppf<0x140>(v));
    return fmaxf(fmaxf(rlane(v, 0), rlane(v, 16)), fmaxf(rlane(v, 32), rlane(v, 48))); }
#define LDS_WAIT() asm volatile("s_waitcnt lgkmcnt(0)" ::: "memory")
__device__ __forceinline__ void row2bs(int r, int& b, int& s) { if (r < NLAT) { b = r >> 11; s = 256 + (r & 2047); } else { const int j = r - NLAT; b = j >> 8; s = j & 255; } }
__device__ __forceinline__ int bs2row(int b, int s) { return s < 256 ? NLAT + b * 256 + s : b * 2048 + s - 256; }
__device__ __forceinline__ int vpos(int s) { return (s & ~12) | ((s & 4) << 1) | ((s & 8) >> 1); }
__device__ __forceinline__ float siluf(float x) { return x / (1.f + __expf(-x)); }

#define XB_TMO      128
#define XB_XCNT(j)  (256  + 64 * (j))
#define XB_XSUB(j)  (1280 + 64 * (j))
#define XB_XGEN(j)  (2304 + 64 * (j))
#define XB_TOP      3328
#define XB_TOPGEN   3392
#define XCD_BAR_WORDS 3456
#define XB_SPIN_CAP (1u << 24)
__device__ __forceinline__ unsigned xb_ld(unsigned* p)              { return __hip_atomic_load(p, __ATOMIC_RELAXED, __HIP_MEMORY_SCOPE_AGENT); }
__device__ __forceinline__ unsigned xb_add(unsigned* p, unsigned v) { return __hip_atomic_fetch_add(p, v, __ATOMIC_RELAXED, __HIP_MEMORY_SCOPE_AGENT); }
__device__ __forceinline__ unsigned xb_xcc_id() { return (unsigned)__builtin_amdgcn_s_getreg((3 << 11) | 20) & 0xFu; }
#define XB_SPIN(cond, bar) do { unsigned _sp = 0; while (cond) { __builtin_amdgcn_s_sleep(1); \
    if ((++_sp & 255u) == 0u) { if (xb_ld(&(bar)[XB_TMO])) break; if (_sp > XB_SPIN_CAP) { atomicAdd(&(bar)[XB_TMO], 1u); break; } } } } while (0)
struct XcdBarrier { unsigned* bar; unsigned x; volatile LAS unsigned* st; };
__device__ __forceinline__ XcdBarrier xcd_barrier_post(unsigned* bar, volatile LAS unsigned* st) {
    XcdBarrier b; b.bar = bar; b.x = xb_xcc_id(); b.st = st;
    if (threadIdx.x == 0) (void)xb_add(&bar[XB_XCNT(b.x)], 1u);
    return b;
}
__device__ __forceinline__ void xcd_barrier_complete(unsigned* bar, unsigned x, unsigned& nloc, unsigned& nx) {
    const unsigned G = gridDim.x * gridDim.y * gridDim.z;
    unsigned sum, cnt, mine, sp = 0u;
    for (;;) {
        sum = 0u; cnt = 0u; mine = 0u;
#pragma unroll
        for (unsigned j = 0; j < 16; ++j) { const unsigned c = xb_ld(&bar[XB_XCNT(j)]); sum += c; cnt += (c > 0u) ? 1u : 0u; mine = (j == x) ? c : mine; }
        if (sum == G) break;
        __builtin_amdgcn_s_sleep(1);
        if ((++sp & 255u) == 0u) { if (xb_ld(&bar[XB_TMO])) break; if (sp > XB_SPIN_CAP) { atomicAdd(&bar[XB_TMO], 1u); break; } }
    }
    nloc = mine > 0u ? mine : 1u; nx = cnt > 0u ? cnt : 1u;
}
__device__ __forceinline__ void xcd_barrier(const XcdBarrier& b) {
    asm volatile("s_waitcnt vmcnt(0)" ::: "memory");
    __syncthreads();
    if (threadIdx.x == 0) {
        unsigned* bar = b.bar;
        __builtin_amdgcn_s_waitcnt(0);
        unsigned nloc = b.st[0], nx = b.st[1];
        if (nloc == 0u) { xcd_barrier_complete(bar, b.x, nloc, nx); b.st[0] = nloc; b.st[1] = nx; }
        const unsigned old = xb_add(&bar[XB_XSUB(b.x)], 1u);
        const unsigned gen = old / nloc;
        if (old + 1u == (gen + 1u) * nloc) {
            __builtin_amdgcn_fence(__ATOMIC_RELEASE, "agent");
            asm volatile("s_waitcnt vmcnt(0)" ::: "memory");
            const unsigned og = xb_add(&bar[XB_TOP], 1u);
            const unsigned tg = og / nx;
            if (og + 1u == (tg + 1u) * nx) xb_add(&bar[XB_TOPGEN], 1u);
            else XB_SPIN(xb_ld(&bar[XB_TOPGEN]) == tg, bar);
            __builtin_amdgcn_fence(__ATOMIC_ACQUIRE, "agent");
            xb_add(&bar[XB_XGEN(b.x)], 1u);
            asm volatile("s_waitcnt vmcnt(0)" ::: "memory");
        } else {
            XB_SPIN(xb_ld(&bar[XB_XGEN(b.x)]) == gen, bar);
            __builtin_amdgcn_fence(__ATOMIC_ACQUIRE, "agent");
            asm volatile("s_waitcnt vmcnt(0)" ::: "memory");
        }
    }
    __syncthreads();
}

namespace pg8 {
constexpr int BM = 256, BK = 64, HALF = 128, HTB = HALF * BK * 2, NXCD = 8, WGM = 8;
__device__ __forceinline__ int lds_byte(int r, int c) { const int st = (r >> 4) * 2 + (c >> 5), rr = r & 15, cc = c & 31, ob = rr * 64 + cc * 2; return st * 1024 + (ob ^ (((ob >> 9) & 1) << 5)); }
__device__ __forceinline__ void stage_rc(int b, int& R, int& C) { const int st = b / 1024, sb = b % 1024, swz = sb ^ (((sb >> 9) & 1) << 5); R = (st >> 1) * 16 + swz / 64; C = (st & 1) * 32 + (swz % 64) / 2; }
__device__ __forceinline__ int perm32(int rho) { const int n = rho >> 4, i = rho & 15; return 8 * (i >> 2) + 4 * n + (i & 3); }
struct Unit { int pm, pn, e, j, cnt; };

template <class Epi, class Sched>
__device__ __forceinline__ void gemm_phase(LAS unsigned char* lds, const int tid, const int K, const Sched& S, const Epi& E) {
    const int wid = __builtin_amdgcn_readfirstlane(tid >> 6), lane = tid & 63, wr = wid >> 2, wc = wid & 3, fr = lane & 15, fq = lane >> 4;
    const int nt = K / BK;
    int Rr[2]; unsigned Cb[2], voffB[2];
#pragma unroll
    for (int i = 0; i < 2; ++i) { int R, C; stage_rc(tid * 16 + i * 8192, R, C); const int Rb = Epi::PERM ? ((R & ~31) + perm32(R & 31)) : R;
        Rr[i] = R; Cb[i] = (unsigned)C * 2u; voffB[i] = (unsigned)(Rb * K + C) * 2u; }
    const size_t kstep = (size_t)(BK * 2);
    const size_t hstep = (size_t)HALF * K * 2;
    const unsigned ldsw = (unsigned)wid * 1024u;
    const int aoff = lds_byte(wr * 64 + fr, fq * 8), boff = lds_byte(wc * 32 + fr, fq * 8);
#define PG8_SA(b, h) (((b) * 2 + (h)) * HTB)
#define PG8_SB(b, h) ((4 + (b) * 2 + (h)) * HTB)
#define PG8_STAGE(bufoff, gbase, voff) do { _Pragma("unroll") for (int _i = 0; _i < 2; ++_i) \
        __builtin_amdgcn_global_load_lds((const unsigned*)((const char*)(gbase) + (voff)[_i]), (LAS unsigned*)(lds + (bufoff) + ldsw + _i * 8192), 16, 0, 0); } while (0)
#define PG8_LDA(dst, b, h) do { _Pragma("unroll") for (int m = 0; m < 4; ++m) _Pragma("unroll") for (int k = 0; k < 2; ++k) dst[m][k] = *(const LAS bf16x8*)(lds + PG8_SA(b, h) + aoff + m * 2048 + k * 1024); } while (0)
#define PG8_LDB(dst, b, h) do { _Pragma("unroll") for (int n = 0; n < 2; ++n) _Pragma("unroll") for (int k = 0; k < 2; ++k) dst[n][k] = *(const LAS bf16x8*)(lds + PG8_SB(b, h) + boff + n * 2048 + k * 1024); } while (0)
#define PG8_MMA(ai, bj, At, Bt) do { __builtin_amdgcn_s_setprio(1); _Pragma("unroll") for (int m = 0; m < 4; ++m) _Pragma("unroll") for (int n = 0; n < 2; ++n) _Pragma("unroll") for (int k = 0; k < 2; ++k) \
        acc[ai][bj][m][n] = __builtin_amdgcn_mfma_f32_16x16x32_bf16(Bt[n][k], At[m][k], acc[ai][bj][m][n], 0, 0, 0); __builtin_amdgcn_s_setprio(0); } while (0)
#define PG8_WAIT_V(n) asm volatile("s_waitcnt vmcnt(" #n ")" ::: "memory")
#define PG8_WAIT_L(n) asm volatile("s_waitcnt lgkmcnt(" #n ")" ::: "memory")
#define PG8_BAR __builtin_amdgcn_s_barrier()
#define PG8_SCHED __builtin_amdgcn_sched_barrier(0)
    Unit cur, nxt; int ui = 0;
    if (!S.next(0, cur)) return;
    f32x4 acc[2][2][4][2];
#pragma unroll
    for (int a = 0; a < 2; ++a)
#pragma unroll
        for (int b = 0; b < 2; ++b)
#pragma unroll
            for (int m = 0; m < 4; ++m)
#pragma unroll
                for (int n = 0; n < 2; ++n) acc[a][b][m][n] = (f32x4){0.f, 0.f, 0.f, 0.f};
    bf16x8 At[4][2], B0[2][2], B1[2][2];
    unsigned vA0[2], vA1[2];
    const char* cA = S.a_ptr(cur);
    if constexpr (Sched::GATHER) { S.a_offs(cur, Rr, vA0, vA1);
#pragma unroll
        for (int i = 0; i < 2; ++i) { vA0[i] += Cb[i]; vA1[i] += Cb[i]; }
        asm volatile("s_waitcnt vmcnt(0)" ::: "memory");
    } else {
#pragma unroll
        for (int i = 0; i < 2; ++i) { vA0[i] = (unsigned)(Rr[i] * K * 2) + Cb[i]; vA1[i] = vA0[i]; } }
    const size_t ahs = Sched::GATHER ? (size_t)0 : hstep;
    const char* cB = S.b_ptr(cur);
    PG8_STAGE(PG8_SB(0, 0), cB, voffB); PG8_STAGE(PG8_SB(0, 1), cB + hstep, voffB); PG8_STAGE(PG8_SA(0, 0), cA, vA0); PG8_STAGE(PG8_SA(0, 1), cA + ahs, vA1);
    if (wr == 1) PG8_BAR;
    PG8_WAIT_V(2); PG8_BAR;
    PG8_STAGE(PG8_SB(1, 0), cB + kstep, voffB); PG8_STAGE(PG8_SA(1, 0), cA + kstep, vA0); PG8_STAGE(PG8_SB(1, 1), cB + hstep + kstep, voffB);
    PG8_WAIT_V(6); PG8_BAR;
    for (;;) {
        const bool has_next = S.next(ui + 1, nxt);
        const char* nA = has_next ? S.a_ptr(nxt) : cA; const char* nB = has_next ? S.b_ptr(nxt) : cB;
        for (int t = 0; t < nt; t += 2) {
            const bool last = (t == nt - 2);
            const char* a1 = cA + (size_t)(t + 1) * kstep;
            const char* a2 = last ? nA : cA + (size_t)(t + 2) * kstep; const char* b2 = last ? nB : cB + (size_t)(t + 2) * kstep;
            const char* a3 = a2 + kstep; const char* b3 = b2 + kstep;
            PG8_LDB(B0, 0, 0); PG8_LDB(B1, 0, 1); PG8_SCHED; PG8_LDA(At, 0, 0); PG8_STAGE(PG8_SA(1, 1), a1 + ahs, vA1);
            if constexpr (Sched::GATHER) { if (last && has_next) { S.a_offs(nxt, Rr, vA0, vA1);
#pragma unroll
                for (int i = 0; i < 2; ++i) { vA0[i] += Cb[i]; vA1[i] += Cb[i]; }
                asm volatile("s_waitcnt vmcnt(0)" ::: "memory"); } }
            PG8_WAIT_V(8); PG8_WAIT_L(0); PG8_BAR; PG8_MMA(0, 0, At, B0); PG8_MMA(0, 1, At, B1); PG8_BAR; PG8_SCHED;
            PG8_LDA(At, 0, 1); PG8_STAGE(PG8_SB(0, 0), b2, voffB); PG8_STAGE(PG8_SB(0, 1), b2 + hstep, voffB); PG8_STAGE(PG8_SA(0, 0), a2, vA0);
            PG8_WAIT_V(8); PG8_WAIT_L(0); PG8_BAR; PG8_MMA(1, 0, At, B0); PG8_MMA(1, 1, At, B1); PG8_BAR; PG8_SCHED;
            PG8_LDB(B0, 1, 0); PG8_LDB(B1, 1, 1); PG8_SCHED; PG8_LDA(At, 1, 0); PG8_STAGE(PG8_SA(0, 1), a2 + ahs, vA1);
            PG8_WAIT_V(8); PG8_WAIT_L(0); PG8_BAR; PG8_MMA(0, 0, At, B0); PG8_MMA(0, 1, At, B1); PG8_BAR; PG8_SCHED;
            PG8_LDA(At, 1, 1); PG8_STAGE(PG8_SB(1, 0), b3, voffB); PG8_STAGE(PG8_SB(1, 1), b3 + hstep, voffB); PG8_STAGE(PG8_SA(1, 0), a3, vA0);
            PG8_WAIT_V(8); PG8_WAIT_L(0); PG8_BAR; PG8_MMA(1, 0, At, B0); PG8_MMA(1, 1, At, B1); PG8_BAR; PG8_SCHED;
        }
        if (wr == 0) PG8_BAR;
        E(acc, cur, wr, wc, fr, fq);
        if (!has_next) break;
#pragma unroll
        for (int a = 0; a < 2; ++a)
#pragma unroll
            for (int b = 0; b < 2; ++b)
#pragma unroll
                for (int m = 0; m < 4; ++m)
#pragma unroll
                    for (int n = 0; n < 2; ++n) acc[a][b][m][n] = (f32x4){0.f, 0.f, 0.f, 0.f};
        cur = nxt; cA = nA; cB = nB; ++ui;
        if (wr == 1) PG8_BAR;
    }
    PG8_WAIT_V(0);
    PG8_BAR;
#undef PG8_SA
#undef PG8_SB
#undef PG8_STAGE
#undef PG8_LDA
#undef PG8_LDB
#undef PG8_MMA
#undef PG8_WAIT_V
#undef PG8_WAIT_L
#undef PG8_BAR
#undef PG8_SCHED
}
__device__ __forceinline__ unsigned cvt_pk_bf16(float lo, float hi) { unsigned r; asm volatile("v_cvt_pk_bf16_f32 %0, %1, %2" : "=v"(r) : "v"(lo), "v"(hi)); return r; }

struct DenseSched {
    const char* A; const char* Bt; int K, nM, nN, nwg, G, c;
    __device__ void init(const void* A_, const void* Bt_, int K_, int M, int N, int G_, int c_) { A = (const char*)A_; Bt = (const char*)Bt_; K = K_; nM = M / BM; nN = N / BM; nwg = nM * nN; G = G_; c = c_; }
    __device__ __forceinline__ bool next(int i, Unit& u) const {
        const long L = (long)i * G + c; if (L >= nwg) return false;
        int wgid = (int)L; { const int q = nwg / NXCD, r = nwg % NXCD, xcd = wgid % NXCD, off = wgid / NXCD; wgid = (xcd < r ? xcd * (q + 1) : r * (q + 1) + (xcd - r) * q) + off; }
        const int nig = WGM * nN, gid = wgid / nig, fm = gid * WGM, gsz = (nM - fm) < WGM ? (nM - fm) : WGM;
        u.pm = fm + ((wgid % nig) % gsz); u.pn = (wgid % nig) / gsz; u.e = 0; u.j = 0; u.cnt = 256; return true;
    }
    static constexpr bool GATHER = false;
    __device__ __forceinline__ const char* a_ptr(const Unit& u) const { return A + (size_t)u.pm * BM * K * 2; }
    __device__ __forceinline__ void a_offs(const Unit&, const int (&)[2], unsigned (&)[2], unsigned (&)[2]) const {}
    __device__ __forceinline__ const char* b_ptr(const Unit& u) const { return Bt + (size_t)u.pn * BM * K * 2; }
};
template <bool GATHER_> struct MoeSched {
    static constexpr bool GATHER = GATHER_;
    const char* A; const char* W; size_t wstride; int K, G, c; const int* elist; const volatile LAS int* T; const volatile LAS int* Cn;
    __device__ __forceinline__ bool next(int i, Unit& u) const {
        const long L = (long)i * G + c; const int nT = T[16]; if (L >= 4L * nT) return false;
        const int tile = (int)(L >> 2); u.pn = (int)(L & 3); u.pm = tile;
        int e = 0;
#pragma unroll
        for (int k = 1; k < 16; ++k) e += (tile >= T[k]) ? 1 : 0;
        u.e = e; u.j = tile - T[e]; u.cnt = Cn[e]; return true;
    }
    __device__ __forceinline__ const char* a_ptr(const Unit& u) const { return GATHER ? A : A + (size_t)u.pm * BM * K * 2; }
    __device__ __forceinline__ void a_offs(const Unit& u, const int (&Rr)[2], unsigned (&v0)[2], unsigned (&v1)[2]) const {
#pragma unroll
        for (int i = 0; i < 2; ++i) {
            const int p0 = u.j * BM + Rr[i], p1 = p0 + HALF;
            int t0 = p0 < u.cnt ? (elist[u.e * NROW + p0] >> 1) : 0, t1 = p1 < u.cnt ? (elist[u.e * NROW + p1] >> 1) : 0;
            t0 = min(max(t0, 0), NROW - 1); t1 = min(max(t1, 0), NROW - 1);
            v0[i] = (unsigned)(t0 * K * 2); v1[i] = (unsigned)(t1 * K * 2);
        } }
    __device__ __forceinline__ const char* b_ptr(const Unit& u) const { return W + (size_t)u.e * wstride + (size_t)u.pn * BM * K * 2; }
};
struct EpiP {
    static constexpr bool PERM = true;
    bf16* O;
    __device__ __forceinline__ void operator()(const f32x4 (&acc)[2][2][4][2], const Unit& u, int wr, int wc, int fr, int fq) const {
        const int row0 = u.pm * BM + wr * 64 + fr, col0 = u.pn * BM + wc * 32 + 8 * fq;
#pragma unroll
        for (int ai = 0; ai < 2; ++ai)
#pragma unroll
            for (int m = 0; m < 4; ++m) { bf16* rowp = O + (size_t)(row0 + ai * HALF + m * 16) * NP + col0;
#pragma unroll
                for (int bj = 0; bj < 2; ++bj) { const f32x4 v0 = acc[ai][bj][m][0], v1 = acc[ai][bj][m][1];
                    u32x4 w; w.x = cvt_pk_bf16(v0[0], v0[1]); w.y = cvt_pk_bf16(v0[2], v0[3]); w.z = cvt_pk_bf16(v1[0], v1[1]); w.w = cvt_pk_bf16(v1[2], v1[3]);
                    *(u32x4*)(rowp + bj * HALF) = w; } }
    }
};
struct EpiRes {
    static constexpr bool PERM = false;
    const float* hin_l; const float* hin_c; float* hout_l; float* hout_c; const float* gate; float gsc;
    __device__ __forceinline__ void operator()(const f32x4 (&acc)[2][2][4][2], const Unit& u, int wr, int wc, int fr, int fq) const {
        const int row0 = u.pm * BM + wr * 64 + fr, col0 = u.pn * BM + wc * 32 + 4 * fq;
#pragma unroll
        for (int ai = 0; ai < 2; ++ai)
#pragma unroll
            for (int m = 0; m < 4; ++m) { const int r = row0 + ai * HALF + m * 16; const bool lat = r < NLAT; const int bb = lat ? (r >> 11) : 8;
                const float* hi = lat ? hin_l + (size_t)r * DM : hin_c + (size_t)(r - NLAT) * DM; float* ho = lat ? hout_l + (size_t)r * DM : hout_c + (size_t)(r - NLAT) * DM;
                const float* g = gate + (size_t)bb * 6144;
#pragma unroll
                for (int bj = 0; bj < 2; ++bj)
#pragma unroll
                    for (int n = 0; n < 2; ++n) { const int c = col0 + bj * HALF + n * 16; const f32x4 gv = *(const f32x4*)(g + c), hv = *(const f32x4*)(hi + c);
                        *(f32x4*)(ho + c) = hv + gv * gsc * acc[ai][bj][m][n]; } }
    }
};
struct EpiAct {
    static constexpr bool PERM = true;
    bf16* O;
    __device__ __forceinline__ void operator()(const f32x4 (&acc)[2][2][4][2], const Unit& u, int wr, int wc, int fr, int fq) const {
        const int row0 = u.pm * BM + wr * 64 + fr, col0 = u.pn * HALF + wc * 32 + 8 * fq;
#pragma unroll
        for (int ai = 0; ai < 2; ++ai)
#pragma unroll
            for (int m = 0; m < 4; ++m) { bf16* rowp = O + (size_t)(row0 + ai * HALF + m * 16) * FF + col0;
                float o[8];
#pragma unroll
                for (int n = 0; n < 2; ++n)
#pragma unroll
                    for (int j = 0; j < 4; ++j) { const float g = acc[ai][0][m][n][j], up = acc[ai][1][m][n][j]; o[n * 4 + j] = g / (1.f + __expf(-g)) * up; }
                u32x4 w; w.x = cvt_pk_bf16(o[0], o[1]); w.y = cvt_pk_bf16(o[2], o[3]); w.z = cvt_pk_bf16(o[4], o[5]); w.w = cvt_pk_bf16(o[6], o[7]);
                *(u32x4*)rowp = w; }
    }
};
struct EpiDown {
    static constexpr bool PERM = true;
    bf16* O; const int* elist; const float* rtw;
    __device__ __forceinline__ void operator()(const f32x4 (&acc)[2][2][4][2], const Unit& u, int wr, int wc, int fr, int fq) const {
        const int col0 = u.pn * BM + wc * 32 + 8 * fq;
#pragma unroll
        for (int ai = 0; ai < 2; ++ai)
#pragma unroll
            for (int m = 0; m < 4; ++m) { const int pos = u.j * BM + ai * HALF + wr * 64 + m * 16 + fr;
                if (pos < u.cnt) { const int a = min(max(elist[u.e * NROW + pos], 0), 2 * NROW - 1); const float w8 = rtw[a]; bf16* rowp = O + (size_t)a * DM + col0;
#pragma unroll
                    for (int bj = 0; bj < 2; ++bj) { const f32x4 v0 = acc[ai][bj][m][0] * w8, v1 = acc[ai][bj][m][1] * w8;
                        u32x4 w; w.x = cvt_pk_bf16(v0[0], v0[1]); w.y = cvt_pk_bf16(v0[2], v0[3]); w.z = cvt_pk_bf16(v1[0], v1[1]); w.w = cvt_pk_bf16(v1[2], v1[3]);
                        *(u32x4*)(rowp + bj * HALF) = w; } } }
    }
};
}

struct Args { const float* in[36]; float* out; unsigned char* ws; int ph_lo, ph_hi; };
struct Fr {
    LAS unsigned char* lds; int tid, lane, wave, G, vcu, gw, NGW; const __attribute__((address_space(4))) Args* A;
    __device__ __forceinline__ const float* x() const { return A->in[0]; }
    __device__ __forceinline__ const float* cvec() const { return A->in[1]; }
    __device__ __forceinline__ const float* ctx() const { return A->in[2]; }
    __device__ __forceinline__ const float* cctx() const { return A->in[3]; }
    __device__ __forceinline__ const float* w_mod() const { return A->in[4]; }
    __device__ __forceinline__ const float* b_mod() const { return A->in[5]; }
    __device__ __forceinline__ const float* g_mix() const { return A->in[6]; }
    __device__ __forceinline__ const float* w_in() const { return A->in[7]; }
    __device__ __forceinline__ const float* w_out() const { return A->in[8]; }
    __device__ __forceinline__ const float* na_gq() const { return A->in[9]; }
    __device__ __forceinline__ const float* na_gk() const { return A->in[10]; }
    __device__ __forceinline__ const float* na_rb() const { return A->in[11]; }
    __device__ __forceinline__ const float* mla_gqa() const { return A->in[12]; }
    __device__ __forceinline__ const float* mla_wqb() const { return A->in[13]; }
    __device__ __forceinline__ const float* mla_gkva() const { return A->in[14]; }
    __device__ __forceinline__ const float* mla_wkvb() const { return A->in[15]; }
    __device__ __forceinline__ const float* mla_gq() const { return A->in[16]; }
    __device__ __forceinline__ const float* mla_gk() const { return A->in[17]; }
    __device__ __forceinline__ const float* df_gq() const { return A->in[18]; }
    __device__ __forceinline__ const float* df_gk() const { return A->in[19]; }
    __device__ __forceinline__ const float* df_lam() const { return A->in[20]; }
    __device__ __forceinline__ const float* df_gsub() const { return A->in[21]; }
    __device__ __forceinline__ const float* conv_w() const { return A->in[22]; }
    __device__ __forceinline__ const float* conv_b() const { return A->in[23]; }
    __device__ __forceinline__ const float* dt_bias() const { return A->in[24]; }
    __device__ __forceinline__ const float* a_log() const { return A->in[25]; }
    __device__ __forceinline__ const float* ssd_d() const { return A->in[26]; }
    __device__ __forceinline__ const float* ssd_gn() const { return A->in[27]; }
    __device__ __forceinline__ const float* g_ffn() const { return A->in[28]; }
    __device__ __forceinline__ const float* w_grp() const { return A->in[29]; }
    __device__ __forceinline__ const float* b_grp() const { return A->in[30]; }
    __device__ __forceinline__ const float* w_exp() const { return A->in[31]; }
    __device__ __forceinline__ const float* b_exp() const { return A->in[32]; }
    __device__ __forceinline__ const float* w_gate() const { return A->in[33]; }
    __device__ __forceinline__ const float* w_up() const { return A->in[34]; }
    __device__ __forceinline__ const float* w_down() const { return A->in[35]; }
    __device__ __forceinline__ float* out() const { return A->out; }
    __device__ __forceinline__ unsigned* ctl() const { return (unsigned*)(A->ws + WS_CTL); }
    __device__ __forceinline__ float* modv() const { return (float*)(A->ws + WS_MOD); }
    __device__ __forceinline__ float* rcos() const { return (float*)(A->ws + WS_ROPE); }
    __device__ __forceinline__ float* rsin() const { return (float*)(A->ws + WS_ROPE + TLAT * 16 * 4); }
    __device__ __forceinline__ bf16* winT() const { return (bf16*)(A->ws + WS_WIN); }
    __device__ __forceinline__ bf16* woutT() const { return (bf16*)(A->ws + WS_WOUT); }
    __device__ __forceinline__ bf16* wqbT() const { return (bf16*)(A->ws + WS_WQB); }
    __device__ __forceinline__ bf16* wkvbT() const { return (bf16*)(A->ws + WS_WKVB); }
    __device__ __forceinline__ bf16* wgu() const { return (bf16*)(A->ws + WS_WGU); }
    __device__ __forceinline__ bf16* wd() const { return (bf16*)(A->ws + WS_WD); }
    __device__ __forceinline__ float* hc() const { return (float*)(A->ws + WS_HC); }
    __device__ __forceinline__ bf16* abuf() const { return (bf16*)(A->ws + WS_A); }
    __device__ __forceinline__ bf16* pbuf() const { return (bf16*)(A->ws + WS_P); }
    __device__ __forceinline__ bf16* act() const { return (bf16*)(A->ws + WS_ACT); }
    __device__ __forceinline__ bf16* yk() const { return (bf16*)(A->ws + WS_YK); }
    __device__ __forceinline__ bf16* mix() const { return (bf16*)(A->ws + WS_MIX); }
    __device__ __forceinline__ bf16* qna() const { return (bf16*)(A->ws + WS_QNA); }
    __device__ __forceinline__ bf16* kna() const { return (bf16*)(A->ws + WS_KNA); }
    __device__ __forceinline__ bf16* vna() const { return (bf16*)(A->ws + WS_VNA); }
    __device__ __forceinline__ bf16* qml() const { return (bf16*)(A->ws + WS_QML); }
    __device__ __forceinline__ bf16* kml() const { return (bf16*)(A->ws + WS_KML); }
    __device__ __forceinline__ bf16* vml() const { return (bf16*)(A->ws + WS_VML); }
    __device__ __forceinline__ bf16* qdf() const { return (bf16*)(A->ws + WS_QDF); }
    __device__ __forceinline__ bf16* kdf() const { return (bf16*)(A->ws + WS_KDF); }
    __device__ __forceinline__ bf16* vdf() const { return (bf16*)(A->ws + WS_VDF); }
    __device__ __forceinline__ bf16* xT() const { return (bf16*)(A->ws + WS_XT); }
    __device__ __forceinline__ bf16* btm() const { return (bf16*)(A->ws + WS_BTM); }
    __device__ __forceinline__ bf16* bT() const { return (bf16*)(A->ws + WS_BT); }
    __device__ __forceinline__ bf16* ctm() const { return (bf16*)(A->ws + WS_CTM); }
    __device__ __forceinline__ float* dtv() const { return (float*)(A->ws + WS_DT); }
    __device__ __forceinline__ float* cst() const { return (float*)(A->ws + WS_CST); }
    __device__ __forceinline__ float* cdec() const { return (float*)(A->ws + WS_CDEC); }
    __device__ __forceinline__ bf16* hent() const { return (bf16*)(A->ws + WS_HENT); }
    __device__ __forceinline__ float* ydir() const { return (float*)(A->ws + WS_CST); }
    __device__ __forceinline__ int* rte() const { return (int*)(A->ws + WS_RT); }
    __device__ __forceinline__ float* rtw() const { return (float*)(A->ws + WS_RT + 256 * 1024); }
    __device__ __forceinline__ int* elist() const { return (int*)(A->ws + WS_ELIST); }
};

__device__ __forceinline__ Fr refresh(const Fr& F0) { Fr F = F0; int w = F0.wave; asm volatile("" : "+s"(w)); asm volatile("" : "+s"(F.A));
    int l; asm volatile("v_mbcnt_lo_u32_b32 %0, -1, 0\n\tv_mbcnt_hi_u32_b32 %0, -1, %0" : "=v"(l)); F.wave = w; F.lane = l; F.tid = w * 64 + l; F.gw = F.vcu * 8 + w; return F; }
__device__ __forceinline__ void tr_item(const float* W, int ldw, int nvalid, int k0, int n0, bf16* dst, int ldd, LAS float* scr, int lane, const float* ksc = nullptr) {
    const int cn = n0 + (lane & 31), cnc = min(cn, nvalid - 1);
    float tv[32];
#pragma unroll
    for (int i = 0; i < 32; ++i) { const int kk = 2 * i + (lane >> 5); tv[i] = W[(size_t)(k0 + kk) * ldw + cnc]; }
#pragma unroll
    for (int i = 0; i < 32; ++i) { const int kk = 2 * i + (lane >> 5); const float sc1 = ksc ? ksc[k0 + kk] : 1.f; scr[kk * 33 + (lane & 31)] = cn < nvalid ? tv[i] * sc1 : 0.f; }
    LDS_WAIT();
    const int c = lane & 7;
#pragma unroll
    for (int j = 0; j < 4; ++j) { const int n = (lane >> 3) + 8 * j; const LAS float* s = scr + (8 * c) * 33 + n;
        u32x4 o; o.x = pk2(s[0 * 33], s[1 * 33]); o.y = pk2(s[2 * 33], s[3 * 33]); o.z = pk2(s[4 * 33], s[5 * 33]); o.w = pk2(s[6 * 33], s[7 * 33]);
        *(u32x4*)(dst + (size_t)n * ldd + k0 + 8 * c) = o; }
    LDS_WAIT();
}
__device__ __forceinline__ void moe_weight_convert(const Fr& F, int L) {
    LAS float* scr = (LAS float*)(F.lds + F.wave * 16384);
    constexpr int I_GU = 16 * 16, I_D = 8 * 32;
    for (int it = F.gw; it < NEXP * (2 * I_GU + I_D); it += F.NGW) {
        const int e = it / (2 * I_GU + I_D); int r = it % (2 * I_GU + I_D);
        if (r < 2 * I_GU) { const int bj = r / I_GU; r %= I_GU; const int kb = r / 16, nb = r % 16, n0 = nb * 32;
            const float* W = (bj ? F.w_up() : F.w_gate()) + ((size_t)L * NEXP + e) * DM * FF;
            tr_item(W, FF, FF, kb * 64, n0, F.wgu() + ((size_t)e * 1024 + (n0 >> 7) * 256 + bj * 128 + (n0 & 127)) * DM, DM, scr, F.lane);
        } else { r -= 2 * I_GU; const int kb = r / 32, nb = r % 32, n0 = nb * 32;
            const float* W = F.w_down() + ((size_t)L * NEXP + e) * FF * DM;
            tr_item(W, DM, DM, kb * 64, n0, F.wd() + ((size_t)e * 1024 + n0) * FF, FF, scr, F.lane); }
    }
}
__device__ __forceinline__ void phase_prologue(const Fr& F) {
    {   LAS float* sc = (LAS float*)F.lds;
        LAS float* part = (LAS float*)(F.lds + 40960);
        for (int i = F.tid; i < 9 * 1024; i += 512) { const float v = i < 8192 ? F.cvec()[i] : F.cctx()[i - 8192]; sc[i] = siluf(v); }
        __syncthreads();
        for (int u = F.vcu; u < 384; u += F.G) {
            const int col = u * 64 + F.lane, L = col / 6144, n = col - L * 6144;
            const float* w = F.w_mod() + ((size_t)L * 1024 + F.wave * 128) * 6144 + n;
            float acc[9];
#pragma unroll
            for (int b = 0; b < 9; ++b) acc[b] = 0.f;
#pragma unroll 1
            for (int k0 = 0; k0 < 128; k0 += 16) { float wv[16];
#pragma unroll
                for (int j = 0; j < 16; ++j) wv[j] = w[(size_t)(k0 + j) * 6144];
#pragma unroll
                for (int j = 0; j < 16; ++j)
#pragma unroll
                    for (int b = 0; b < 9; ++b) acc[b] += sc[b * 1024 + F.wave * 128 + k0 + j] * wv[j]; }
#pragma unroll
            for (int b = 0; b < 9; ++b) part[(F.wave * 9 + b) * 64 + F.lane] = acc[b];
            __syncthreads();
            for (int i = F.tid; i < 9 * 64; i += 512) { const int b = i >> 6, l = i & 63; float s = 0.f;
#pragma unroll
                for (int w8 = 0; w8 < 8; ++w8) s += part[(w8 * 9 + b) * 64 + l];
                const int c2 = u * 64 + l, L2 = c2 / 6144, n2 = c2 - L2 * 6144;
                F.modv()[((size_t)L2 * 9 + b) * 6144 + n2] = s + F.b_mod()[L2 * 6144 + n2]; }
            __syncthreads();
        }
    }
    if (blockIdx.x == 0 && F.wave < 4) {
#pragma unroll 1
        for (int q = 0; q < 4; ++q) { const int lh = F.wave * 4 + q; float bm = 0.f;
            for (int i = F.lane; i < 465; i += 64) bm = fmaxf(bm, F.na_rb()[lh * 465 + i]);
            bm = wmaxf(bm); if (F.lane == 0) (F.rcos() + 2 * TLAT * 16)[lh] = bm * 1.4426950408889634f; } }
    for (int i = blockIdx.x * 512 + F.tid; i < TLAT * 16; i += F.G * 512) { const int t = i >> 4, k = i & 15; const float inv = powf(10000.f, -(float)(k & 7) / 8.f);
        const float pos = (k < 8) ? (float)(t >> 6) : (float)(t & 63); const float ang = pos * inv; F.rcos()[i] = cosf(ang); F.rsin()[i] = sinf(ang); }
    __syncthreads();
    LAS float* scr = (LAS float*)(F.lds + F.wave * 16384);
    constexpr int I_IN = 16 * 96, I_OUT = 16 * 32, I_QB = 4 * 12, I_KVB = 2 * 16, I_L = I_IN + I_OUT + I_QB + I_KVB;
    for (int it = F.gw; it < DEPTH * I_L; it += F.NGW) {
        const int L = it / I_L; int r = it % I_L;
        if (r < I_IN) { const int kb = r / 96, nb = r % 96; tr_item(F.w_in() + (size_t)L * DM * NIN, NIN, NIN, kb * 64, nb * 32, F.winT() + ((size_t)L * NP + nb * 32) * DM, DM, scr, F.lane); continue; } r -= I_IN;
        if (r < I_OUT) { const int kb = r / 32, nb = r % 32; tr_item(F.w_out() + (size_t)L * DM * DM, DM, DM, kb * 64, nb * 32, F.woutT() + ((size_t)L * DM + nb * 32) * DM, DM, scr, F.lane); continue; } r -= I_OUT;
        if (r < I_QB) { const int kb = r / 12, nb = r % 12; tr_item(F.mla_wqb() + (size_t)L * 256 * 384, 384, 384, kb * 64, nb * 32, F.wqbT() + ((size_t)L * 384 + nb * 32) * 256, 256, scr, F.lane, F.mla_gqa() + L * 256); continue; } r -= I_QB;
        { const int kb = r / 16, nb = r % 16; tr_item(F.mla_wkvb() + (size_t)L * 128 * 512, 512, 512, kb * 64, nb * 32, F.wkvbT() + ((size_t)L * 512 + nb * 32) * 128, 128, scr, F.lane, F.mla_gkva() + L * 128); }
    }
}

__device__ __forceinline__ void phase_norm(const Fr& F, int L, bool combine = true) {
    const int nrows = (L == DEPTH) ? NLAT : NROW;
    for (int r = F.gw; r < nrows; r += F.NGW) {
        const bool lat = r < NLAT; const int bb = lat ? (r >> 11) : 8;
        const float* hin = (L == 0) ? (lat ? F.x() + (size_t)r * DM : F.ctx() + (size_t)(r - NLAT) * DM) : (lat ? F.out() + (size_t)r * DM : F.hc() + (size_t)(r - NLAT) * DM);
        float* hout = lat ? F.out() + (size_t)r * DM : F.hc() + (size_t)(r - NLAT) * DM;
        f32x4 v[4];
#pragma unroll
        for (int j = 0; j < 4; ++j) v[j] = *(const f32x4*)(hin + 4 * F.lane + 256 * j);
        if (L > 0 && combine) {
            const float* m5 = F.modv() + ((size_t)(L - 1) * 9 + bb) * 6144 + 5 * 1024;
#pragma unroll
            for (int j = 0; j < 4; ++j) { const int c = 4 * F.lane + 256 * j; const f32x4 g = *(const f32x4*)(m5 + c);
                const u32x2 y0 = *(const u32x2*)(F.yk() + (size_t)(2 * r) * DM + c), y1 = *(const u32x2*)(F.yk() + (size_t)(2 * r + 1) * DM + c);
                f32x4 ys; ys[0] = __uint_as_float(y0.x << 16) + __uint_as_float(y1.x << 16); ys[1] = __uint_as_float(y0.x & 0xffff0000u) + __uint_as_float(y1.x & 0xffff0000u);
                ys[2] = __uint_as_float(y0.y << 16) + __uint_as_float(y1.y << 16); ys[3] = __uint_as_float(y0.y & 0xffff0000u) + __uint_as_float(y1.y & 0xffff0000u);
                v[j] = v[j] + g * ys; *(f32x4*)(hout + c) = v[j]; }
        }
        if (L == DEPTH) continue;
        float ss = 0.f;
#pragma unroll
        for (int j = 0; j < 4; ++j) ss += (v[j][0] * v[j][0] + v[j][1] * v[j][1]) + (v[j][2] * v[j][2] + v[j][3] * v[j][3]);
        const float rstd = rsqrtf(wsum(ss) * (1.f / DM) + EPS);
        const float* md = F.modv() + ((size_t)L * 9 + bb) * 6144;
#pragma unroll
        for (int j = 0; j < 4; ++j) { const int c = 4 * F.lane + 256 * j; const f32x4 g = *(const f32x4*)(F.g_mix() + L * DM + c), sh = *(const f32x4*)(md + c), scl = *(const f32x4*)(md + 1024 + c);
            const f32x4 a = v[j] * rstd * g * (scl + 1.f) + sh; u32x2 o; o.x = pk2(a[0], a[1]); o.y = pk2(a[2], a[3]); *(u32x2*)(F.abuf() + (size_t)r * DM + c) = o; }
    }
}

__device__ __forceinline__ void prep_row(const Fr& F, int L, int r, LAS float* scr) {
    int lane_ = F.lane; asm volatile("" : "+v"(lane_)); const int lane = lane_; int b, s; row2bs(r, b, s); const bool lat = r < NLAT; const int t = s - 256;
    const bf16* p = F.pbuf() + (size_t)r * NP;
#pragma unroll
    for (int h = 0; h < 4; ++h) {
        const float q = bf2f(p[C_NA + h * 64 + lane]), k = bf2f(p[C_NA + 256 + h * 64 + lane]);
        const float rq = rsqrtf(wsum(q * q) * (1.f / 64) + EPS), rk = rsqrtf(wsum(k * k) * (1.f / 64) + EPS);
        const size_t o = ((size_t)(b * 4 + h) * SQ + s) * 64 + lane;
        F.qna()[o] = f2bf(q * rq * F.na_gq()[L * 64 + lane]); F.kna()[o] = f2bf(k * rk * F.na_gk()[L * 64 + lane]);
    }
    {
        const int idx = lane & 31; float cs = 1.f, sn = 0.f;
        if (lat) { cs = F.rcos()[t * 16 + (idx & 15)]; sn = F.rsin()[t * 16 + (idx & 15)]; }
#pragma unroll
        for (int h = 0; h < 4; ++h) {
            float q = bf2f(p[C_DF + h * 64 + lane]), k = bf2f(p[C_DF + 256 + h * 64 + lane]);
            float sq = q * q, sk = k * k;
#pragma unroll
            for (int o = 16; o >= 1; o >>= 1) { sq += __shfl_xor(sq, o); sk += __shfl_xor(sk, o); }
            q *= rsqrtf(sq * (1.f / 32) + EPS) * F.df_gq()[L * 32 + idx]; k *= rsqrtf(sk * (1.f / 32) + EPS) * F.df_gk()[L * 32 + idx];
            const float qp = __shfl_xor(q, 16), kp = __shfl_xor(k, 16);
            if (lat) { q = (idx < 16) ? q * cs - qp * sn : qp * sn + q * cs; k = (idx < 16) ? k * cs - kp * sn : kp * sn + k * cs; }
            const size_t o = ((size_t)(b * 4 + h) * SQ + s) * 64 + lane;
            F.qdf()[o] = f2bf(q); F.kdf()[o] = f2bf(k);
        }
    }
}
__device__ __forceinline__ void prep_tile(const Fr& F, int L, int b, int c) {
    int tid_ = F.tid; asm volatile("" : "+v"(tid_)); const int tid = tid_;
    const int s0 = 64 * c; const size_t r0 = bs2row(b, s0);
    LAS bf16* Lv = (LAS bf16*)F.lds;
#ifndef PT_MASK
#define PT_MASK 7
#endif
    if (PT_MASK & 1)
#pragma unroll 1
    for (int mx = 0; mx < 2; ++mx) {
        const int voff = mx == 0 ? C_NA + 512 : C_DF + 512; bf16* vt = mx == 0 ? F.vna() : F.vdf();
#pragma unroll
        for (int k = 0; k < 4; ++k) { const int idx = tid + 512 * k, tok = idx >> 5, d8 = (idx & 31) * 8;
            const u32x4 v = *(const u32x4*)(F.pbuf() + (r0 + tok) * NP + voff + d8); const int pc = vpos(tok);
#pragma unroll
            for (int e = 0; e < 4; ++e) { Lv[(d8 + 2 * e) * 72 + pc] = (bf16)(v[e] & 0xffffu); Lv[(d8 + 2 * e + 1) * 72 + pc] = (bf16)(v[e] >> 16); } }
        __syncthreads();
#pragma unroll
        for (int k = 0; k < 4; ++k) { const int idx = tid + 512 * k, dv = idx >> 3, pc = idx & 7;
            const u32x4 v = *(const LAS u32x4*)(Lv + dv * 72 + pc * 8);
#ifndef PT_NOSTORE
#define PT_NOSTORE 0
#endif
            if (!PT_NOSTORE || v.x == 0x12345678u) *(u32x4*)(vt + ((size_t)(b * 4 + (dv >> 6)) * 64 + (dv & 63)) * SQ + s0 + pc * 8) = v; }
        __syncthreads();
    }
    const int len = c < 4 ? TCTX : TLAT, t0 = c < 4 ? s0 : s0 - 256;
    LAS bf16* Lc = (LAS bf16*)F.lds;
    if (PT_MASK & 2)
#pragma unroll 1
    for (int gch = 0; gch < 3; ++gch) {
        {   u32x4 v[5];
#pragma unroll
            for (int k = 0; k < 5; ++k) { const int idx = min(tid + 512 * k, 68 * 32 - 1), j = idx >> 5, c8 = (idx & 31) * 8, tj = t0 - 2 + j, jc = min(max(tj, 0), len - 1) - t0;
                v[k] = *(const u32x4*)(F.pbuf() + (size_t)((long)r0 + jc) * NP + C_XBC + gch * 256 + c8);
                const unsigned keep = (tj >= 0 && tj < len) ? 0xffffffffu : 0u; v[k].x &= keep; v[k].y &= keep; v[k].z &= keep; v[k].w &= keep; }
#pragma unroll
            for (int k = 0; k < 5; ++k) { const int idx = tid + 512 * k, j = idx >> 5, c8 = (idx & 31) * 8; if (idx < 68 * 32) *(LAS u32x4*)(Lc + j * 256 + c8) = v[k]; }
        }
        __syncthreads();
        const int ch = tid & 255, tq = tid >> 8, cg = gch * 256 + ch;
        float w[5];
#pragma unroll
        for (int j = 0; j < 5; ++j) w[j] = F.conv_w()[(L * 5 + j) * 768 + cg];
        const float bias = F.conv_b()[L * 768 + cg];
        const LAS bf16* lp = Lc + (32 * tq) * 256 + ch;
        float x0 = bf2f(lp[0]), x1 = bf2f(lp[256]), x2 = bf2f(lp[512]), x3 = bf2f(lp[768]);
        bf16* tm = (gch == 1 ? F.btm() : F.ctm()) + ((size_t)b * SQ + s0 + 32 * tq) * 256 + ch;
        bf16* cm = (gch == 0 ? F.xT() : F.bT()) + ((size_t)b * 256 + ch) * SQ + s0 + 32 * tq;
#pragma unroll
        for (int g8 = 0; g8 < 4; ++g8) { unsigned pk[4];
#pragma unroll
            for (int e = 0; e < 8; ++e) { const int i = 8 * g8 + e; const float x4 = bf2f(lp[(i + 4) * 256]);
                const float acc = bias + w[0] * x0 + w[1] * x1 + w[2] * x2 + w[3] * x3 + w[4] * x4; const unsigned o = f2bf(siluf(acc));
                if (gch >= 1) tm[(size_t)i * 256] = (bf16)o;
                if (e & 1) pk[e >> 1] |= o << 16; else pk[e >> 1] = o;
                x0 = x1; x1 = x2; x2 = x3; x3 = x4; }
            if (gch <= 1) { u32x4 v; v.x = pk[0]; v.y = pk[1]; v.z = pk[2]; v.w = pk[3]; *(u32x4*)(cm + 8 * g8) = v; } }
        __syncthreads();
    }
    if (PT_MASK & 4) { const int tok = tid >> 3, i = tid & 7; const float raw = bf2f(F.pbuf()[(r0 + tok) * NP + C_DT + i]) + F.dt_bias()[L * 8 + i]; const float ex = __expf(raw);
      F.dtv()[((size_t)b * 8 + i) * SQ + s0 + tok] = raw > 20.f ? raw : (ex < 0.03f ? ex * (1.f - ex * (0.5f - ex * (0.33333334f - 0.25f * ex))) : __logf(1.f + ex)); }
}
__device__ __forceinline__ void mla_prep_block(const Fr& F, int L, int b, int j32) {
    int lane_ = F.lane; asm volatile("" : "+v"(lane_));
    const int lane = lane_, wave = F.wave, r = lane & 31, hh = lane >> 5, s = 32 * j32 + r, t = s - 256; const bool lat = s >= 256;
    const size_t row = bs2row(b, s);
    const bf16* p = F.pbuf() + row * NP + C_MLA;
    const int tt = lat ? t : 0; const float latf = lat ? 1.f : 0.f;
    if (wave < 4) {
        const int hq = wave;
        bf16x8 Bq[16]; float ss = 0.f;
#pragma unroll
        for (int kk = 0; kk < 16; ++kk) { Bq[kk] = *(const bf16x8*)(p + 16 * kk + 8 * hh);
#pragma unroll
            for (int j = 0; j < 8; ++j) { const float v = bf2f((bf16)Bq[kk][j]); ss += v * v; } }
        ss += __shfl_xor(ss, 32); const float rq = rsqrtf(ss * (1.f / 256) + EPS);
        f32x16 acc[3]; float hs = 0.f;
#pragma unroll
        for (int j3 = 0; j3 < 3; ++j3) {
#pragma unroll
            for (int i = 0; i < 16; ++i) acc[j3][i] = 0.f;
            const bf16* wp = F.wqbT() + ((size_t)L * 384 + 96 * hq + 32 * j3 + r) * 256 + 8 * hh;
#pragma unroll
            for (int kk = 0; kk < 16; ++kk) acc[j3] = MFMA32(*(const bf16x8*)(wp + 16 * kk), Bq[kk], acc[j3]);
            asm volatile("" ::: "memory");
#pragma unroll
            for (int i = 0; i < 16; ++i) hs += acc[j3][i] * acc[j3][i]; }
        hs = (hs + __shfl_xor(hs, 32)) * rq * rq; const float rs = rsqrtf(hs * (1.f / 96) + EPS) * rq;
        bf16* qo = F.qml() + ((size_t)(b * 4 + hq) * SQ + s) * 96 + 4 * hh;
#pragma unroll
        for (int j3 = 0; j3 < 3; ++j3) {
#pragma unroll
            for (int i = 0; i < 16; ++i) acc[j3][i] *= rs * F.mla_gq()[L * 96 + 32 * j3 + crow16(i, hh)];
            if (j3 == 2) {
#pragma unroll
                for (int i = 0; i < 8; ++i) { const float rc = lat ? F.rcos()[tt * 16 + crow16(i, hh)] : 1.f, rsn = F.rsin()[tt * 16 + crow16(i, hh)] * latf;
                    const float x1 = acc[2][i], x2 = acc[2][i + 8]; acc[2][i] = x1 * rc - x2 * rsn; acc[2][i + 8] = x1 * rsn + x2 * rc; } }
#pragma unroll
            for (int g = 0; g < 4; ++g) { u32x2 w; w.x = pk2(acc[j3][4 * g], acc[j3][4 * g + 1]); w.y = pk2(acc[j3][4 * g + 2], acc[j3][4 * g + 3]); *(u32x2*)(qo + 32 * j3 + 8 * g) = w; } }
    } else {
        const int hk = wave - 4;
        LAS unsigned char* wl = F.lds + wave * 16384;
        bf16x8 Bkv[8]; float ss = 0.f;
#pragma unroll
        for (int kk = 0; kk < 8; ++kk) { Bkv[kk] = *(const bf16x8*)(p + 256 + 16 * kk + 8 * hh);
#pragma unroll
            for (int j = 0; j < 8; ++j) { const float v = bf2f((bf16)Bkv[kk][j]); ss += v * v; } }
        ss += __shfl_xor(ss, 32); const float rk = rsqrtf(ss * (1.f / 128) + EPS);
        float kr[16]; float hs = 0.f;
#pragma unroll
        for (int g = 0; g < 4; ++g) { const u32x2 k4 = *(const u32x2*)(p + 384 + 8 * g + 4 * hh);
            kr[4 * g] = __uint_as_float(k4.x << 16); kr[4 * g + 1] = __uint_as_float(k4.x & 0xffff0000u); kr[4 * g + 2] = __uint_as_float(k4.y << 16); kr[4 * g + 3] = __uint_as_float(k4.y & 0xffff0000u); }
#pragma unroll
        for (int i = 0; i < 16; ++i) hs += kr[i] * kr[i];
        f32x16 acc[4]; float ks = 0.f;
#pragma unroll
        for (int j4 = 0; j4 < 4; ++j4) {
#pragma unroll
            for (int i = 0; i < 16; ++i) acc[j4][i] = 0.f;
            const bf16* wp = F.wkvbT() + ((size_t)L * 512 + 128 * hk + 32 * j4 + r) * 128 + 8 * hh;
#pragma unroll
            for (int kk = 0; kk < 8; ++kk) acc[j4] = MFMA32(*(const bf16x8*)(wp + 16 * kk), Bkv[kk], acc[j4]);
            asm volatile("" ::: "memory");
            if (j4 < 2) {
#pragma unroll
                for (int i = 0; i < 16; ++i) ks += acc[j4][i] * acc[j4][i]; } }
        hs += ks * rk * rk; hs += __shfl_xor(hs, 32); const float rs = rsqrtf(hs * (1.f / 96) + EPS);
        bf16* ko = F.kml() + ((size_t)(b * 4 + hk) * SQ + s) * 96 + 4 * hh;
#pragma unroll
        for (int j2 = 0; j2 < 2; ++j2) {
#pragma unroll
            for (int i = 0; i < 16; ++i) acc[j2][i] *= rs * rk * F.mla_gk()[L * 96 + 32 * j2 + crow16(i, hh)];
#pragma unroll
            for (int g = 0; g < 4; ++g) { u32x2 w; w.x = pk2(acc[j2][4 * g], acc[j2][4 * g + 1]); w.y = pk2(acc[j2][4 * g + 2], acc[j2][4 * g + 3]); *(u32x2*)(ko + 32 * j2 + 8 * g) = w; } }
#pragma unroll
        for (int i = 0; i < 16; ++i) kr[i] *= rs * F.mla_gk()[L * 96 + 64 + crow16(i, hh)];
#pragma unroll
        for (int i = 0; i < 8; ++i) { const float rc = lat ? F.rcos()[tt * 16 + crow16(i, hh)] : 1.f, rsn = F.rsin()[tt * 16 + crow16(i, hh)] * latf;
            const float x1 = kr[i], x2 = kr[i + 8]; kr[i] = x1 * rc - x2 * rsn; kr[i + 8] = x1 * rsn + x2 * rc; }
#pragma unroll
        for (int g = 0; g < 4; ++g) { u32x2 w; w.x = pk2(kr[4 * g], kr[4 * g + 1]); w.y = pk2(kr[4 * g + 2], kr[4 * g + 3]); *(u32x2*)(ko + 64 + 8 * g) = w; }
        { float n2 = 0.f;
#pragma unroll
          for (int i = 0; i < 16; ++i) n2 += acc[0][i] * acc[0][i] + acc[1][i] * acc[1][i] + kr[i] * kr[i];
          n2 += __shfl_xor(n2, 32); n2 = wmaxf(n2);
          if (lane == 0) atomicMax(F.ctl() + CW_KMAX + ((L * 3 + 1) * 8 + b) * 8 + hk * 2, __float_as_uint(n2 * 1.02f)); }
        LAS bf16* vl = (LAS bf16*)wl;
#pragma unroll
        for (int mt = 0; mt < 2; ++mt)
#pragma unroll
            for (int i = 0; i < 16; ++i) vl[(32 * mt + crow16(i, hh)) * 40 + vpos(r)] = f2bf(acc[2 + mt][i] * rk);
        LDS_WAIT();
        { const LAS u32x4* src4 = (const LAS u32x4*)(wl + lane * 80); u32x4* dst = (u32x4*)(F.vml() + ((size_t)(b * 4 + hk) * 64 + lane) * SQ + 32 * j32);
#pragma unroll
          for (int q = 0; q < 4; ++q) dst[q] = src4[q]; }
        LDS_WAIT();
    }
}
__device__ __forceinline__ int grab_unit(const Fr& F, unsigned* ctr) {
    volatile LAS int* slot = (volatile LAS int*)(F.lds + LDSCTL_OFF + 256);
    __syncthreads();
    if (F.tid == 0) *slot = (int)__hip_atomic_fetch_add(ctr, 1u, __ATOMIC_RELAXED, __HIP_MEMORY_SCOPE_AGENT);
    __syncthreads();
    return __builtin_amdgcn_readfirstlane(*slot);
}
__device__ __forceinline__ void prep_qk(const Fr& F, int L, int b, int j32) {
    int lane_ = F.lane; asm volatile("" : "+v"(lane_)); const int l = lane_, h = l >> 4;
    u32x2 raw[4][4];
#pragma unroll
    for (int i = 0; i < 4; ++i) { const int s = 32 * j32 + 4 * F.wave + i; const bf16* p = F.pbuf() + (size_t)bs2row(b, s) * NP + 4 * l;
        raw[i][0] = *(const u32x2*)(p + C_NA); raw[i][1] = *(const u32x2*)(p + C_NA + 256); raw[i][2] = *(const u32x2*)(p + C_DF); raw[i][3] = *(const u32x2*)(p + C_DF + 256); }
    const f32x4 gnq = *(const f32x4*)(F.na_gq() + L * 64 + 4 * (l & 15)), gnk = *(const f32x4*)(F.na_gk() + L * 64 + 4 * (l & 15));
    const f32x4 gdq = *(const f32x4*)(F.df_gq() + L * 32 + 4 * (l & 7)), gdk = *(const f32x4*)(F.df_gk() + L * 32 + 4 * (l & 7));
    float kmx_na = 0.f, kmx_df = 0.f;
#pragma unroll
    for (int i = 0; i < 4; ++i) { const int s = 32 * j32 + 4 * F.wave + i, t = s - 256; const bool lat = s >= 256;
#pragma unroll
        for (int w = 0; w < 4; ++w) {
            f32x4 x; x[0] = __uint_as_float(raw[i][w].x << 16); x[1] = __uint_as_float(raw[i][w].x & 0xffff0000u); x[2] = __uint_as_float(raw[i][w].y << 16); x[3] = __uint_as_float(raw[i][w].y & 0xffff0000u);
            float ss = (x[0] * x[0] + x[1] * x[1]) + (x[2] * x[2] + x[3] * x[3]);
            ss += dppf<0xB1>(ss); ss += dppf<0x4E>(ss); ss += dppf<0x141>(ss);
            if (w < 2) { ss += dppf<0x140>(ss);
                const float rs = rsqrtf(ss * (1.f / 64) + EPS); const f32x4 g = w == 0 ? gnq : gnk; x = x * rs * g;
                u32x2 o; o.x = pk2(x[0], x[1]); o.y = pk2(x[2], x[3]);
                if (w == 1) { float n2 = (x[0] * x[0] + x[1] * x[1]) + (x[2] * x[2] + x[3] * x[3]); n2 += dppf<0xB1>(n2); n2 += dppf<0x4E>(n2); n2 += dppf<0x141>(n2); n2 += dppf<0x140>(n2); kmx_na = fmaxf(kmx_na, n2); }
                *(u32x2*)((w == 0 ? F.qna() : F.kna()) + ((size_t)(b * 4 + h) * SQ + s) * 64 + 4 * (l & 15)) = o;
            } else {
                const float rs = rsqrtf(ss * (1.f / 32) + EPS); const f32x4 g = w == 2 ? gdq : gdk; x = x * rs * g;
                f32x4 xp; xp[0] = __shfl_xor(x[0], 4); xp[1] = __shfl_xor(x[1], 4); xp[2] = __shfl_xor(x[2], 4); xp[3] = __shfl_xor(x[3], 4);
                if (lat) { const f32x4 cs = *(const f32x4*)(F.rcos() + t * 16 + 4 * (l & 3)), sn = *(const f32x4*)(F.rsin() + t * 16 + 4 * (l & 3));
                    x = (l & 4) ? xp * sn + x * cs : x * cs - xp * sn; }
                u32x2 o; o.x = pk2(x[0], x[1]); o.y = pk2(x[2], x[3]);
                if (w == 3) { float n2 = (x[0] * x[0] + x[1] * x[1]) + (x[2] * x[2] + x[3] * x[3]); n2 += dppf<0xB1>(n2); n2 += dppf<0x4E>(n2); n2 += dppf<0x141>(n2); kmx_df = fmaxf(kmx_df, n2); }
                *(u32x2*)((w == 2 ? F.qdf() : F.kdf()) + ((size_t)(b * 4 + h) * SQ + s) * 64 + 4 * (l & 15)) = o;
            } } }
    if ((l & 15) == 0) atomicMax(F.ctl() + CW_KMAX + ((L * 3 + 0) * 8 + b) * 8 + h * 2, __float_as_uint(kmx_na * 1.02f));
    if ((l & 7) == 0) atomicMax(F.ctl() + CW_KMAX + ((L * 3 + 2) * 8 + b) * 8 + h * 2 + ((l >> 3) & 1), __float_as_uint(kmx_df * 1.02f));
}
__device__ __forceinline__ void prep_vconv(const Fr& F, int L, int b, int j32) {
    int tid_ = F.tid; asm volatile("; VCONV_BEGIN" : "+v"(tid_)); const int tid = tid_;
    const int s0 = 32 * j32; const size_t r0 = bs2row(b, s0);
    LAS bf16* Lv = (LAS bf16*)F.lds;
#ifndef VC_MASK
#define VC_MASK 7
#endif
    if (VC_MASK & 1) {   u32x4 v[4];
#pragma unroll
        for (int k = 0; k < 4; ++k) { const int idx = tid + 512 * k, mx = idx >> 10, tok = (idx >> 5) & 31, d8 = (idx & 31) * 8;
            v[k] = *(const u32x4*)(F.pbuf() + (r0 + tok) * NP + (mx ? C_DF + 512 : C_NA + 512) + d8); }
#pragma unroll
        for (int k = 0; k < 4; ++k) { const int idx = tid + 512 * k, mx = idx >> 10, tok = (idx >> 5) & 31, d8 = (idx & 31) * 8, pc = vpos(tok);
#pragma unroll
            for (int e = 0; e < 4; ++e) { Lv[(mx * 256 + d8 + 2 * e) * 40 + pc] = (bf16)(v[k][e] & 0xffffu); Lv[(mx * 256 + d8 + 2 * e + 1) * 40 + pc] = (bf16)(v[k][e] >> 16); } }
        __syncthreads();
#pragma unroll
        for (int k = 0; k < 4; ++k) { const int idx = tid + 512 * k, mx = idx >> 10, dv = (idx >> 2) & 255, pc = idx & 3;
            const u32x4 w = *(const LAS u32x4*)(Lv + (mx * 256 + dv) * 40 + pc * 8);
            *(u32x4*)((mx ? F.vdf() : F.vna()) + ((size_t)(b * 4 + (dv >> 6)) * 64 + (dv & 63)) * SQ + s0 + pc * 8) = w; }
        __syncthreads();
    }
    const bool isctx = s0 < 256; const int len = isctx ? TCTX : TLAT, t0 = isctx ? s0 : s0 - 256;
    LAS bf16* Lc = (LAS bf16*)F.lds;
    if (VC_MASK & 2) {   u32x4 v[7];
#pragma unroll
        for (int k = 0; k < 7; ++k) { const int idx = tid + 512 * k, j = idx / 96, c8 = (idx - 96 * j) * 8, tj = t0 - 2 + j; const int jc = min(max(tj, 0), len - 1) - t0;
            v[k] = (u32x4){0u, 0u, 0u, 0u};
            if (idx < 36 * 96) { v[k] = *(const u32x4*)(F.pbuf() + (size_t)((long)r0 + jc) * NP + C_XBC + c8); if (tj < 0 || tj >= len) v[k] = (u32x4){0u, 0u, 0u, 0u}; } }
#pragma unroll
        for (int k = 0; k < 7; ++k) { const int idx = tid + 512 * k, j = idx / 96, c8 = (idx - 96 * j) * 8; if (idx < 36 * 96) *(LAS u32x4*)(Lc + j * 768 + c8) = v[k]; }
    }
    __syncthreads();
    if (VC_MASK & 2)
#pragma unroll 1
    for (int pass = 0; pass < 2; ++pass) {
        const int cg = pass == 0 ? tid : 512 + tid;
        if (cg < 768) {
            float w[5];
#pragma unroll
            for (int j = 0; j < 5; ++j) w[j] = F.conv_w()[(L * 5 + j) * 768 + cg];
            const float bias = F.conv_b()[L * 768 + cg];
            const LAS bf16* lp = Lc + cg;
            float x0 = bf2f(lp[0]), x1 = bf2f(lp[768]), x2 = bf2f(lp[2 * 768]), x3 = bf2f(lp[3 * 768]);
            const int gch = cg >> 8, ch = cg & 255;
            bf16* tm = (gch == 1 ? F.btm() : F.ctm()) + ((size_t)b * SQ + s0) * 256 + ch;
            bf16* cm = (gch == 0 ? F.xT() : F.bT()) + ((size_t)b * 256 + ch) * SQ + s0;
#pragma unroll
            for (int g8 = 0; g8 < 4; ++g8) { unsigned pk[4];
#pragma unroll
                for (int e = 0; e < 8; ++e) { const int i = 8 * g8 + e; const float x4 = bf2f(lp[(i + 4) * 768]);
                    const float acc = bias + w[0] * x0 + w[1] * x1 + w[2] * x2 + w[3] * x3 + w[4] * x4; const unsigned o = f2bf(siluf(acc));
                    if (gch >= 1) tm[(size_t)i * 256] = (bf16)o;
                    if (e & 1) pk[e >> 1] |= o << 16; else pk[e >> 1] = o;
                    x0 = x1; x1 = x2; x2 = x3; x3 = x4; }
                if (gch <= 1) { u32x4 v; v.x = pk[0]; v.y = pk[1]; v.z = pk[2]; v.w = pk[3]; *(u32x4*)(cm + 8 * g8) = v; } }
        }
    }
    if ((VC_MASK & 4) && tid < 256) { const int tok = tid >> 3, i = tid & 7; const float raw = bf2f(F.pbuf()[(r0 + tok) * NP + C_DT + i]) + F.dt_bias()[L * 8 + i]; const float ex = __expf(raw);
      F.dtv()[((size_t)b * 8 + i) * SQ + s0 + tok] = raw > 20.f ? raw : (ex < 0.03f ? ex * (1.f - ex * (0.5f - ex * (0.33333334f - 0.25f * ex))) : __logf(1.f + ex)); }
    __syncthreads();
    asm volatile("; VCONV_END" ::: "memory");
}
__device__ __forceinline__ void phase_prep(const Fr& F0_, int L) {
    unsigned* ctr = F0_.ctl() + CW_QUEUE + (L * 16 + 0) * 64;
    for (;;) {
        const int u = grab_unit(F0_, ctr); if (u >= NB * 72) break;
        const int b = u / 72, j32 = u - 72 * b;
        { const Fr F = refresh(F0_); prep_qk(F, L, b, j32); }
        { const Fr F = refresh(F0_); mla_prep_block(F, L, b, j32); }
        __syncthreads();
    }
    __syncthreads();
    { const Fr F3 = refresh(F0_); for (int u = F3.G - 1 - F3.vcu; u < NB * 36; u += F3.G) prep_tile(F3, L, u / 36, u % 36); }
}

__device__ __forceinline__ void phase_ssd_naive(const Fr& F, int L) {
    if (F.wave != 0 || blockIdx.x >= 64) return;
    const int w = blockIdx.x, b = w >> 3, d = (w >> 2) & 1, h = w & 3, g = h >> 1, p = F.lane;
    const float a = -expf(F.a_log()[L * 8 + d * 4 + h]);
    float hs[128];
#pragma unroll
    for (int n = 0; n < 128; ++n) hs[n] = 0.f;
    const float* dtp = F.dtv() + ((size_t)b * 8 + d * 4 + h) * SQ;
    const bf16* xp = F.xT() + ((size_t)b * 256 + h * 64 + p) * SQ;
    for (int step = 0; step < SQ; ++step) {
        const int s = d == 0 ? step : (step < 256 ? 255 - step : SQ - 1 - (step - 256));
        const float dtv = dtp[s], dA = __expf(dtv * a), xv = bf2f(xp[s]) * dtv;
        const u32x4* Bp = (const u32x4*)(F.btm() + ((size_t)b * SQ + s) * 256 + g * 128);
        const u32x4* Cp = (const u32x4*)(F.ctm() + ((size_t)b * SQ + s) * 256 + g * 128);
        float y = 0.f;
#pragma unroll
        for (int n8 = 0; n8 < 16; ++n8) { const u32x4 bv = Bp[n8], cv = Cp[n8];
#pragma unroll
            for (int j = 0; j < 4; ++j) { const int n = n8 * 8 + 2 * j;
                hs[n] = hs[n] * dA + xv * __uint_as_float(bv[j] << 16); hs[n + 1] = hs[n + 1] * dA + xv * __uint_as_float(bv[j] & 0xffff0000u);
                y += __uint_as_float(cv[j] << 16) * hs[n] + __uint_as_float(cv[j] & 0xffff0000u) * hs[n + 1]; } }
        F.ydir()[((size_t)d * NROW + bs2row(b, s)) * 256 + h * 64 + p] = y;
    }
}

template <int KIND>
__device__ __forceinline__ void naive_attn_job(const Fr& F, int L, int r, int h, LAS float* scr) {
    constexpr int DQ = KIND == 1 ? 96 : (KIND == 0 ? 64 : 32), QS = KIND == 1 ? 96 : 64;
    const int lane = F.lane; int b, s; row2bs(r, b, s); const bool lat = r < NLAT; const int t = s - 256;
    const bf16* Qb = (KIND == 0 ? F.qna() : KIND == 1 ? F.qml() : F.qdf()) + ((size_t)(b * 4 + h) * SQ + s) * QS;
    const bf16* Kb = (KIND == 0 ? F.kna() : KIND == 1 ? F.kml() : F.kdf()) + (size_t)(b * 4 + h) * SQ * QS;
    const bf16* Vt = (KIND == 0 ? F.vna() : KIND == 1 ? F.vml() : F.vdf()) + ((size_t)(b * 4 + h) * 64 + lane) * SQ;
    const float scale = KIND == 1 ? 0.10206207261596577f : (KIND == 0 ? 0.125f : 0.17677669529663687f);
    const int qr = t >> 6, qc = t & 63, row_lo = min(max(qr - 4, 0), 24), col_lo = min(max(qc - 8, 0), 48);
    const bool nb = (KIND == 0) && lat;
    const int nk = lat ? (KIND == 0 ? 768 : SQ) : 256;
    const int koff = nb ? row_lo * 64 : 0;
    float oc[2] = {0.f, 0.f};
#pragma unroll
    for (int comp = 0; comp < (KIND == 2 ? 2 : 1); ++comp) {
        for (int i = lane; i < DQ; i += 64) scr[i] = bf2f(Qb[comp * 32 + i]);
        LDS_WAIT();
        float m = -INFINITY;
        for (int kk = lane; kk < nk; kk += 64) {
            const int sk = kk < 256 ? kk : kk + koff; float bias = 0.f; bool valid = true;
            if (nb && kk >= 256) { const int w = kk - 256, kr = w >> 6, kc = w & 63; valid = kc >= col_lo && kc < col_lo + 16;
                const int ro = row_lo + kr - qr + 7, co = min(max(kc - qc, -15), 15) + 15; bias = F.na_rb()[((L * 4 + h) * 15 + ro) * 31 + co]; }
            const u32x4* kp = (const u32x4*)(Kb + (size_t)sk * QS + (KIND == 2 ? comp * 32 : 0));
            float dot = 0.f;
#pragma unroll
            for (int i8 = 0; i8 < DQ / 8; ++i8) { const u32x4 kv = kp[i8];
#pragma unroll
                for (int j = 0; j < 4; ++j) dot += scr[i8 * 8 + 2 * j] * __uint_as_float(kv[j] << 16) + scr[i8 * 8 + 2 * j + 1] * __uint_as_float(kv[j] & 0xffff0000u); }
            const float sc = valid ? dot * scale + bias : -INFINITY;
            scr[128 + kk] = sc; m = fmaxf(m, sc);
        }
        m = wmaxf(m);
        float sum = 0.f;
        for (int kk = lane; kk < nk; kk += 64) { const float pv = __expf(scr[128 + kk] - m); scr[128 + kk] = pv; sum += pv; }
        sum = wsum(sum);
        LDS_WAIT();
        float o = 0.f;
        for (int kb = 0; kb < nk; kb += 8) {
            const int sb = kb < 256 ? kb : kb + koff;
            const u32x4 vv = *(const u32x4*)(Vt + sb);
#pragma unroll
            for (int j = 0; j < 8; ++j) { const int kk = (kb & ~15) + vpos((kb & 15) + j); const unsigned wv = vv[j >> 1];
                o += scr[128 + kk] * ((j & 1) ? __uint_as_float(wv & 0xffff0000u) : __uint_as_float(wv << 16)); }
        }
        oc[comp] = o / sum;
        LDS_WAIT();
    }
    bf16* mo = F.mix() + (size_t)r * DM + (KIND == 0 ? 0 : KIND == 1 ? 256 : 512) + h * 64 + lane;
    if (KIND == 2) {
        const float* lv = F.df_lam() + L * 128; const float li = 0.8f - 0.6f * expf(-0.3f * (float)L);
        float d1 = 0.f, d2 = 0.f;
#pragma unroll
        for (int i = 0; i < 32; ++i) { d1 += lv[i] * lv[32 + i]; d2 += lv[64 + i] * lv[96 + i]; }
        const float lam = expf(d1) - expf(d2) + li;
        const float o = oc[0] - lam * oc[1];
        const float rs = rsqrtf(wsum(o * o) * (1.f / 64) + EPS);
        *mo = f2bf(o * rs * F.df_gsub()[L * 64 + lane] * (1.f - li));
    } else *mo = f2bf(oc[0]);
}
__device__ __forceinline__ void phase_mix_naive(const Fr& F, int L) {
    LAS float* scr = (LAS float*)(F.lds + F.wave * 16384);
    const int nrows = (L == DEPTH - 1) ? NLAT : NROW;
    for (int j = F.gw; j < nrows * 4; j += F.NGW) naive_attn_job<2>(F, L, j >> 2, j & 3, scr);
    for (int j = F.gw; j < nrows * 4; j += F.NGW) naive_attn_job<1>(F, L, j >> 2, j & 3, scr);
    for (int j = F.gw; j < nrows * 4; j += F.NGW) naive_attn_job<0>(F, L, j >> 2, j & 3, scr);
    for (int r = F.gw; r < nrows; r += F.NGW) {
        int b, s; row2bs(r, b, s); const int h = F.lane >> 4; const float dsk = F.ssd_d()[L * 8 + h] + F.ssd_d()[L * 8 + 4 + h];
        float y[4]; float ss = 0.f;
#pragma unroll
        for (int j = 0; j < 4; ++j) { const int ch = F.lane * 4 + j; const float xv = bf2f(F.xT()[((size_t)b * 256 + ch) * SQ + s]);
            const float z = bf2f(F.pbuf()[(size_t)r * NP + C_Z + ch]);
            y[j] = (F.ydir()[(size_t)r * 256 + ch] + F.ydir()[((size_t)NROW + r) * 256 + ch] + dsk * xv) * siluf(z); ss += y[j] * y[j]; }
        const float rs = rsqrtf(wsum(ss) * (1.f / 256) + EPS);
#pragma unroll
        for (int j = 0; j < 4; ++j) { const int ch = F.lane * 4 + j; F.mix()[(size_t)r * DM + 768 + ch] = f2bf(y[j] * rs * F.ssd_gn()[L * 256 + ch]); }
    }
}

template <int S8> __device__ __forceinline__ bf16x8 pack_step(const f32x16& x) {
    u32x4 p;
    asm volatile("v_cvt_pk_bf16_f32 %0, %4, %5\n\tv_cvt_pk_bf16_f32 %1, %6, %7\n\tv_cvt_pk_bf16_f32 %2, %8, %9\n\tv_cvt_pk_bf16_f32 %3, %10, %11\n\ts_nop 1"
                 : "=&v"(p[0]), "=&v"(p[1]), "=&v"(p[2]), "=&v"(p[3])
                 : "v"(x[S8]), "v"(x[S8 + 1]), "v"(x[S8 + 2]), "v"(x[S8 + 3]), "v"(x[S8 + 4]), "v"(x[S8 + 5]), "v"(x[S8 + 6]), "v"(x[S8 + 7]));
    return __builtin_bit_cast(bf16x8, p);
}
constexpr float LOG2E = 1.4426950408889634f;
template <int KIND>
__device__ __forceinline__ void attn_unit(const Fr& F, int L, int b, int h, int qb) {
    constexpr int QS = KIND == 1 ? 96 : 64, NKS = KIND == 1 ? 6 : (KIND == 0 ? 4 : 2);
    constexpr int PK = QS * 2 + 16, PV = 272, KBYTES = 128 * PK, VBYTES = 64 * PV, NKP = QS == 96 ? 3 : 2, PPR = QS / 8;
    LAS unsigned char* const Kl = F.lds; LAS unsigned char* const Vl = F.lds + 2 * KBYTES;
    LAS float* const biasl = (LAS float*)(F.lds + 2 * KBYTES + 2 * VBYTES);
    const int lane = F.lane, wave = F.wave, tid = F.tid, r = lane & 31, hh = lane >> 5;
    const bool isctx = qb < 0;
    const int comp = KIND == 2 ? (wave & 1) : 0, qg = KIND == 2 ? (wave >> 1) : wave;
    const bf16* Qg = (KIND == 0 ? F.qna() : KIND == 1 ? F.qml() : F.qdf()) + (size_t)(b * 4 + h) * SQ * QS;
    const bf16* Kg = (KIND == 0 ? F.kna() : KIND == 1 ? F.kml() : F.kdf()) + (size_t)(b * 4 + h) * SQ * QS;
    const bf16* Vg = (KIND == 0 ? F.vna() : KIND == 1 ? F.vml() : F.vdf()) + (size_t)(b * 4 + h) * 64 * SQ;
    const float cs = (KIND == 1 ? 0.10206207261596577f : (KIND == 0 ? 0.125f : 0.17677669529663687f)) * LOG2E;
    int sq, qrow = 0, qcol = 0;
    if (KIND == 2) sq = (isctx ? 128 * (-qb - 1) : 256 + 128 * qb) + 32 * qg + r;
    else if (isctx) sq = 32 * wave + r; else if (KIND == 0) { qrow = 4 * qb + (wave >> 1); qcol = 32 * (wave & 1) + r; sq = 256 + 64 * qrow + qcol; } else sq = 256 + 256 * qb + 32 * wave + r;
    int nt = 36, lo_u = 0;
    if (isctx) nt = 4; else if (KIND == 0) { lo_u = min(max(4 * qb - 4, 0), 24); nt = 4 + min(max(4 * qb - 1, 0), 24) + 8 - lo_u; }
    const int np = (nt + 1) >> 1;
    const int my_lo = min(max(qrow - 4, 0), 24), col_lo = min(max(qcol - 8, 0), 48);
    if (KIND == 0 && !isctx) for (int i = tid; i < 465; i += 512) biasl[i] = F.na_rb()[(L * 4 + h) * 465 + i] * LOG2E;
    bf16x8 Q[NKS];
    { const bf16* qp = Qg + (size_t)sq * QS + comp * 32 + 8 * hh;
#pragma unroll
      for (int kk = 0; kk < NKS; ++kk) Q[kk] = *(const bf16x8*)(qp + 16 * kk); }
    f32x16 O[2]; float l = 0.f;
#pragma unroll
    for (int mt = 0; mt < 2; ++mt)
#pragma unroll
        for (int i = 0; i < 16; ++i) O[mt][i] = 0.f;
    float m;
    {   float q2 = 0.f;
#pragma unroll
        for (int kk = 0; kk < NKS; ++kk)
#pragma unroll
            for (int j = 0; j < 8; ++j) { const float v = bf2f((bf16)Q[kk][j]); q2 += v * v; }
        q2 += __shfl_xor(q2, 32);
        const float k2 = __uint_as_float(__hip_atomic_load(F.ctl() + CW_KMAX + ((L * 3 + KIND) * 8 + b) * 8 + h * 2 + comp, __ATOMIC_RELAXED, __HIP_MEMORY_SCOPE_AGENT));
        m = sqrtf(q2 * k2) * cs;
        if (KIND == 0 && !isctx) m += (F.rcos() + 2 * TLAT * 16)[L * 4 + h];
    }
    u32x4 rk_0[NKP], rv_0[2];
#define AT_SK0(t) ((isctx || KIND != 0) ? 64 * (t) : ((t) < 4 ? 64 * (t) : 256 + 64 * (lo_u + (t) - 4)))
#define AT_LOAD(p, S_) do { const int sk0_ = AT_SK0(2 * (p)); const char* kg_ = (const char*)(Kg + (size_t)sk0_ * QS); \
        _Pragma("unroll") for (int i_ = 0; i_ < NKP; ++i_) rk_##S_[i_] = *(const u32x4*)(kg_ + (tid + 512 * i_) * 16); \
        _Pragma("unroll") for (int i_ = 0; i_ < 2; ++i_) { const int pi_ = tid + 512 * i_; rv_##S_[i_] = *(const u32x4*)(Vg + (size_t)(pi_ >> 4) * SQ + sk0_ + (pi_ & 15) * 8); } } while (0)
#define AT_STORE(buf, S_) do { \
        _Pragma("unroll") for (int i_ = 0; i_ < NKP; ++i_) { const int pi_ = tid + 512 * i_; *(LAS u32x4*)(Kl + (buf) * KBYTES + (pi_ / PPR) * PK + (pi_ % PPR) * 16) = rk_##S_[i_]; } \
        _Pragma("unroll") for (int i_ = 0; i_ < 2; ++i_) { const int pi_ = tid + 512 * i_; *(LAS u32x4*)(Vl + (buf) * VBYTES + (pi_ >> 4) * PV + (pi_ & 15) * 16) = rv_##S_[i_]; } } while (0)
#define AT_QK(SA, SB, kb_) do { \
        _Pragma("unroll") for (int i = 0; i < 16; ++i) { SA[i] = 0.f; SB[i] = 0.f; } \
        _Pragma("unroll") for (int kk = 0; kk < NKS; ++kk) { const bf16x8 a0 = *(const LAS bf16x8*)((kb_) + 32 * kk), a1 = *(const LAS bf16x8*)((kb_) + 32 * PK + 32 * kk); \
            SA = MFMA32(a0, Q[kk], SA); SB = MFMA32(a1, Q[kk], SB); } } while (0)
#define AT_SMPV(S0, S1, t_, vb_) do { \
        const int krow = lo_u + (t_) - 4; const bool nbt = (KIND == 0) && !isctx && (t_) >= 4; \
        float ps = 0.f; \
        if (nbt) { const int drow = (krow - qrow + 7) * 31 - qcol + 15; const float nm = -m; \
            _Pragma("unroll") for (int i = 0; i < 16; ++i) { const int kc = (i & 3) + 8 * (i >> 2) + 4 * hh; \
                { const bool v = (unsigned)(kc - col_lo) < 16u; const float bb = biasl[v ? drow + kc : 0]; S0[i] = v ? __builtin_amdgcn_exp2f(__builtin_fmaf(S0[i], cs, bb + nm)) : 0.f; } \
                { const bool v = (unsigned)(kc + 32 - col_lo) < 16u; const float bb = biasl[v ? drow + kc + 32 : 0]; S1[i] = v ? __builtin_amdgcn_exp2f(__builtin_fmaf(S1[i], cs, bb + nm)) : 0.f; } \
                ps += S0[i] + S1[i]; } \
        } else { const float nm = -m; \
            _Pragma("unroll") for (int i = 0; i < 16; ++i) { S0[i] = __builtin_amdgcn_exp2f(__builtin_fmaf(S0[i], cs, nm)); S1[i] = __builtin_amdgcn_exp2f(__builtin_fmaf(S1[i], cs, nm)); ps += S0[i] + S1[i]; } } \
        l += ps; \
        const bf16x8 p00 = pack_step<0>(S0), p01 = pack_step<8>(S0), p10 = pack_step<0>(S1), p11 = pack_step<8>(S1); \
        _Pragma("unroll") for (int mt = 0; mt < 2; ++mt) { \
            const LAS unsigned char* vb = (vb_) + mt * 32 * PV; \
            O[mt] = MFMA32(*(const LAS bf16x8*)(vb + 0), p00, O[mt]); O[mt] = MFMA32(*(const LAS bf16x8*)(vb + 32), p01, O[mt]); \
            O[mt] = MFMA32(*(const LAS bf16x8*)(vb + 64), p10, O[mt]); O[mt] = MFMA32(*(const LAS bf16x8*)(vb + 96), p11, O[mt]); } } while (0)
#define AT_COMPUTE(p_, buf_) do { \
        const int t0_ = 2 * (p_), t1_ = t0_ + 1; \
        const bool g0_ = (KIND != 0) || isctx || t0_ < 4 || (lo_u + t0_ - 4 >= my_lo && lo_u + t0_ - 4 < my_lo + 8); \
        const bool g1_ = (t1_ < nt) && ((KIND != 0) || isctx || t1_ < 4 || (lo_u + t1_ - 4 >= my_lo && lo_u + t1_ - 4 < my_lo + 8)); \
        const LAS unsigned char* Kb = Kl + (buf_) * KBYTES + r * PK + (comp * 32 + 8 * hh) * 2; const LAS unsigned char* Vb = Vl + (buf_) * VBYTES + r * PV + 16 * hh; \
        if (KIND == 0) { f32x16 S00, S01; \
            if (g0_) { AT_QK(S00, S01, Kb); AT_SMPV(S00, S01, t0_, Vb); } \
            if (g1_) { AT_QK(S00, S01, Kb + 64 * PK); AT_SMPV(S00, S01, t1_, Vb + 128); } \
        } else { f32x16 S00, S01, S10, S11; \
            AT_QK(S00, S01, Kb); \
            AT_QK(S10, S11, Kb + 64 * PK); \
            AT_SMPV(S00, S01, t0_, Vb); \
            AT_SMPV(S10, S11, t1_, Vb + 128); } } while (0)
    AT_LOAD(0, 0);
    AT_STORE(0, 0);
    __syncthreads();
    for (int p = 0; p < np; ++p) {
        const int buf = p & 1;
        if (p + 1 < np) AT_LOAD(p + 1, 0);
        AT_COMPUTE(p, buf);
        if (p + 1 < np) AT_STORE(buf ^ 1, 0);
        __syncthreads();
    }
#undef AT_COMPUTE
#undef AT_SMPV
#undef AT_QK
#undef AT_SK0
#undef AT_LOAD
#undef AT_STORE
    const float inv = 1.f / (l + __shfl_xor(l, 32));
    bf16* mo = F.mix() + (size_t)bs2row(b, sq) * DM + (KIND == 0 ? 0 : KIND == 1 ? 256 : 512) + h * 64 + 4 * hh;
    if (KIND == 2) {
        LAS float* xo = (LAS float*)F.lds + qg * 2048;
        if (comp == 1) {
#pragma unroll
            for (int mt = 0; mt < 2; ++mt)
#pragma unroll
                for (int i = 0; i < 16; ++i) xo[(mt * 16 + i) * 64 + lane] = O[mt][i] * inv; }
        __syncthreads();
        if (comp == 0) {
            const float* lv = F.df_lam() + L * 128; const float li = 0.8f - 0.6f * expf(-0.3f * (float)L);
            float d1 = 0.f, d2 = 0.f;
#pragma unroll
            for (int i = 0; i < 32; ++i) { d1 += lv[i] * lv[32 + i]; d2 += lv[64 + i] * lv[96 + i]; }
            const float lam = expf(d1) - expf(d2) + li;
            float ss = 0.f;
#pragma unroll
            for (int mt = 0; mt < 2; ++mt)
#pragma unroll
                for (int i = 0; i < 16; ++i) { const float o = O[mt][i] * inv - lam * xo[(mt * 16 + i) * 64 + lane]; O[mt][i] = o; ss += o * o; }
            ss += __shfl_xor(ss, 32);
            const float rs = rsqrtf(ss * (1.f / 64) + EPS) * (1.f - li);
#pragma unroll
            for (int mt = 0; mt < 2; ++mt)
#pragma unroll
                for (int g = 0; g < 4; ++g) { const f32x4 gs = *(const f32x4*)(F.df_gsub() + L * 64 + 32 * mt + 8 * g + 4 * hh);
                    u32x2 w; w.x = pk2(O[mt][4 * g] * rs * gs[0], O[mt][4 * g + 1] * rs * gs[1]); w.y = pk2(O[mt][4 * g + 2] * rs * gs[2], O[mt][4 * g + 3] * rs * gs[3]);
                    *(u32x2*)(mo + 32 * mt + 8 * g) = w; }
        }
        __syncthreads();
    } else {
#pragma unroll
        for (int mt = 0; mt < 2; ++mt)
#pragma unroll
            for (int g = 0; g < 4; ++g) { u32x2 w; w.x = pk2(O[mt][4 * g] * inv, O[mt][4 * g + 1] * inv); w.y = pk2(O[mt][4 * g + 2] * inv, O[mt][4 * g + 3] * inv);
                *(u32x2*)(mo + 32 * mt + 8 * g) = w; }
    }
}
__device__ __forceinline__ float ssd_cum(const Fr& F, int L, int b, int h, int d, int s0, float& dt, float& cum) {
    const int lane = F.lane;
    dt = F.dtv()[((size_t)b * 8 + d * 4 + h) * SQ + s0 + lane];
    const float la = dt * -__expf(F.a_log()[L * 8 + d * 4 + h]);
    float v = la;
#pragma unroll
    for (int o = 1; o < 64; o <<= 1) { const float t = __shfl_up(v, o); if (lane >= o) v += t; }
    const float total = __shfl(v, 63);
    cum = d == 0 ? v : total - v + la;
    return total;
}
__device__ __forceinline__ void ssd_s1_job(const Fr& F, int L, int b, int c, int h, LAS float* scr) {
    const int lane = F.lane, r = lane & 31, hh = lane >> 5, s0 = 64 * c, g = h >> 1;
#pragma unroll
    for (int d = 0; d < 2; ++d) { float dt, cum; const float tot = ssd_cum(F, L, b, h, d, s0, dt, cum); scr[d * 64 + lane] = dt * __expf(tot - cum);
        if (lane == 0) F.cdec()[((b * 2 + d) * 4 + h) * 36 + c] = __expf(tot); }
    LDS_WAIT();
    bf16x8 A[2][2][4];
#pragma unroll
    for (int mt = 0; mt < 2; ++mt)
#pragma unroll
        for (int kk = 0; kk < 4; ++kk) { const bf16x8 raw = *(const bf16x8*)(F.xT() + ((size_t)b * 256 + h * 64 + 32 * mt + r) * SQ + s0 + 16 * kk + 8 * hh);
#pragma unroll
            for (int d = 0; d < 2; ++d) { u32x4 o;
#pragma unroll
                for (int j = 0; j < 4; ++j) { const float w0 = scr[d * 64 + 16 * kk + 8 * hh + 2 * j], w1 = scr[d * 64 + 16 * kk + 8 * hh + 2 * j + 1];
                    o[j] = pk2(bf2f((bf16)raw[2 * j]) * w0, bf2f((bf16)raw[2 * j + 1]) * w1); }
                A[d][mt][kk] = __builtin_bit_cast(bf16x8, o); } }
#pragma unroll
    for (int nt = 0; nt < 4; ++nt) {
        bf16x8 Bf[4];
#pragma unroll
        for (int kk = 0; kk < 4; ++kk) Bf[kk] = *(const bf16x8*)(F.bT() + ((size_t)b * 256 + g * 128 + 32 * nt + r) * SQ + s0 + 16 * kk + 8 * hh);
#pragma unroll
        for (int d = 0; d < 2; ++d)
#pragma unroll
            for (int mt = 0; mt < 2; ++mt) { f32x16 acc;
#pragma unroll
                for (int i = 0; i < 16; ++i) acc[i] = 0.f;
#pragma unroll
                for (int kk = 0; kk < 4; ++kk) acc = MFMA32(A[d][mt][kk], Bf[kk], acc);
                float* dst = F.cst() + ((((size_t)(b * 2 + d) * 4 + h) * 36 + c) * 64 + 32 * mt) * 128 + 32 * nt + r;
#pragma unroll
                for (int i = 0; i < 16; ++i) dst[crow16(i, hh) * 128] = acc[i]; }
    }
    LDS_WAIT();
}
__device__ __forceinline__ void phase_ssd_s1(const Fr& F, int L) {
    LAS float* scr = (LAS float*)(F.lds + F.wave * 16384);
    for (int j = F.gw; j < NB * 36 * 4; j += F.NGW) ssd_s1_job(F, L, j / 144, (j / 4) % 36, j & 3, scr);
}
__device__ __forceinline__ void phase_ssd_scan(const Fr& F, int L) {
    for (int e4 = blockIdx.x * 512 + F.tid; e4 < NB * 2 * 4 * 2048; e4 += F.G * 512) {
        const int bdh = e4 >> 11, pn = (e4 & 2047) * 4, d = (bdh >> 2) & 1;
        f32x4 hst = (f32x4){0.f, 0.f, 0.f, 0.f};
        const float* cs_ = F.cst() + (size_t)bdh * 36 * 8192 + pn; bf16* he_ = F.hent() + (size_t)bdh * 36 * 8192 + pn; const float* cd_ = F.cdec() + bdh * 36;
#pragma unroll 1
        for (int s6 = 0; s6 < 36; s6 += 6) {
            f32x4 v[6]; float dc[6]; int cc[6];
#pragma unroll
            for (int j = 0; j < 6; ++j) { const int step = s6 + j; cc[j] = d == 0 ? step : (step < 4 ? 3 - step : 39 - step); v[j] = *(const f32x4*)(cs_ + (size_t)cc[j] * 8192); dc[j] = cd_[cc[j]]; }
#pragma unroll
            for (int j = 0; j < 6; ++j) { u32x2 o; o.x = pk2(hst[0], hst[1]); o.y = pk2(hst[2], hst[3]); *(u32x2*)(he_ + (size_t)cc[j] * 8192) = o; hst = hst * dc[j] + v[j]; }
        }
    }
}
__device__ __forceinline__ void ssd_s3_unit(const Fr& F, int L, int b, int c) {
    const int lane = F.lane, wave = F.wave, r = lane & 31, hh = lane >> 5, s0 = 64 * c, h = wave >> 1, it = wave & 1, g = h >> 1, itok = 32 * it + r;
    LAS float* scr = (LAS float*)(F.lds + wave * 16384);
    LAS float* red = (LAS float*)(F.lds + 8192);
#pragma unroll
    for (int d = 0; d < 2; ++d) { float dt, cum; (void)ssd_cum(F, L, b, h, d, s0, dt, cum); scr[d * 128 + lane] = cum; scr[d * 128 + 64 + lane] = dt; }
    LDS_WAIT();
    bf16x8 Cf[8];
#pragma unroll
    for (int kk = 0; kk < 8; ++kk) Cf[kk] = *(const bf16x8*)(F.ctm() + ((size_t)b * SQ + s0 + itok) * 256 + g * 128 + 16 * kk + 8 * hh);
    f32x16 G[2];
#pragma unroll
    for (int jt = 0; jt < 2; ++jt) {
#pragma unroll
        for (int i = 0; i < 16; ++i) G[jt][i] = 0.f;
#pragma unroll
        for (int kk = 0; kk < 8; ++kk) { const bf16x8 bf = *(const bf16x8*)(F.btm() + ((size_t)b * SQ + s0 + 32 * jt + r) * 256 + g * 128 + 16 * kk + 8 * hh); G[jt] = MFMA32(bf, Cf[kk], G[jt]); } }
    bf16x8 X[2][4];
#pragma unroll
    for (int mt = 0; mt < 2; ++mt)
#pragma unroll
        for (int ks = 0; ks < 4; ++ks) { const bf16* xp = F.xT() + ((size_t)b * 256 + h * 64 + 32 * mt + r) * SQ + s0 + 16 * ks + 4 * hh;
            const u32x2 lo = *(const u32x2*)xp, hi = *(const u32x2*)(xp + 8); u32x4 o; o.x = lo.x; o.y = lo.y; o.z = hi.x; o.w = hi.y; X[mt][ks] = __builtin_bit_cast(bf16x8, o); }
    f32x16 Y[2];
#pragma unroll
    for (int mt = 0; mt < 2; ++mt)
#pragma unroll
        for (int i = 0; i < 16; ++i) Y[mt][i] = 0.f;
    const float Dsum = F.ssd_d()[L * 8 + h] + F.ssd_d()[L * 8 + 4 + h];
#pragma unroll 1
    for (int d = 0; d < 2; ++d) {
        const float cum_i = scr[d * 128 + itok];
        f32x16 Pm[2];
#pragma unroll
        for (int jt = 0; jt < 2; ++jt)
#pragma unroll
            for (int i = 0; i < 16; ++i) { const int j = 32 * jt + crow16(i, hh); const bool valid = d == 0 ? (j <= itok) : (j >= itok);
                const float arg = valid ? cum_i - scr[d * 128 + j] : -INFINITY;
                float pv = G[jt][i] * __expf(arg) * scr[d * 128 + 64 + j];
                if (d == 0 && j == itok) pv += Dsum;
                Pm[jt][i] = pv; }
        const bf16x8 p0 = pack_step<0>(Pm[0]), p1 = pack_step<8>(Pm[0]), p2 = pack_step<0>(Pm[1]), p3 = pack_step<8>(Pm[1]);
#pragma unroll
        for (int mt = 0; mt < 2; ++mt) { Y[mt] = MFMA32(X[mt][0], p0, Y[mt]); Y[mt] = MFMA32(X[mt][1], p1, Y[mt]); Y[mt] = MFMA32(X[mt][2], p2, Y[mt]); Y[mt] = MFMA32(X[mt][3], p3, Y[mt]); }
        const float ei = __expf(cum_i);
#pragma unroll
        for (int mt = 0; mt < 2; ++mt) { f32x16 T;
#pragma unroll
            for (int i = 0; i < 16; ++i) T[i] = 0.f;
#pragma unroll
            for (int kk = 0; kk < 8; ++kk) { const bf16x8 hf = *(const bf16x8*)(F.hent() + ((((size_t)(b * 2 + d) * 4 + h) * 36 + c) * 64 + 32 * mt + r) * 128 + 16 * kk + 8 * hh); T = MFMA32(hf, Cf[kk], T); }
#pragma unroll
            for (int i = 0; i < 16; ++i) Y[mt][i] += ei * T[i]; }
    }
    const size_t row = bs2row(b, s0 + itok);
    const bf16* zp = F.pbuf() + row * NP + C_Z + h * 64 + 4 * hh;
    float ss = 0.f;
#pragma unroll
    for (int mt = 0; mt < 2; ++mt)
#pragma unroll
        for (int gq = 0; gq < 4; ++gq) { const u32x2 z4 = *(const u32x2*)(zp + 32 * mt + 8 * gq);
            const float z0 = __uint_as_float(z4.x << 16), z1 = __uint_as_float(z4.x & 0xffff0000u), z2 = __uint_as_float(z4.y << 16), z3 = __uint_as_float(z4.y & 0xffff0000u);
            Y[mt][4 * gq] *= siluf(z0); Y[mt][4 * gq + 1] *= siluf(z1); Y[mt][4 * gq + 2] *= siluf(z2); Y[mt][4 * gq + 3] *= siluf(z3);
            ss += (Y[mt][4 * gq] * Y[mt][4 * gq] + Y[mt][4 * gq + 1] * Y[mt][4 * gq + 1]) + (Y[mt][4 * gq + 2] * Y[mt][4 * gq + 2] + Y[mt][4 * gq + 3] * Y[mt][4 * gq + 3]); }
    ss += __shfl_xor(ss, 32);
    if (hh == 0) red[(it * 4 + h) * 32 + r] = ss;
    __syncthreads();
    const float tot = (red[(it * 4 + 0) * 32 + r] + red[(it * 4 + 1) * 32 + r]) + (red[(it * 4 + 2) * 32 + r] + red[(it * 4 + 3) * 32 + r]);
    const float rs = rsqrtf(tot * (1.f / 256) + EPS);
    bf16* mo = F.mix() + row * DM + 768 + h * 64 + 4 * hh;
#pragma unroll
    for (int mt = 0; mt < 2; ++mt)
#pragma unroll
        for (int gq = 0; gq < 4; ++gq) { const f32x4 gn = *(const f32x4*)(F.ssd_gn() + L * 256 + h * 64 + 32 * mt + 8 * gq + 4 * hh);
            u32x2 w; w.x = pk2(Y[mt][4 * gq] * rs * gn[0], Y[mt][4 * gq + 1] * rs * gn[1]); w.y = pk2(Y[mt][4 * gq + 2] * rs * gn[2], Y[mt][4 * gq + 3] * rs * gn[3]);
            *(u32x2*)(mo + 32 * mt + 8 * gq) = w; }
    __syncthreads();
}
template <int KIND> __device__ __forceinline__ void attn_units(const Fr& F, int L) {
    if (KIND == 2) { const int nu = (L == DEPTH - 1) ? 512 : 576;
        for (int u = F.vcu; u < nu; u += F.G) { if (u < 512) attn_unit<2>(F, L, u >> 6, (u >> 4) & 3, u & 15); else attn_unit<2>(F, L, (u - 512) >> 3, ((u - 512) >> 1) & 3, -1 - (u & 1)); }
    } else { const int nu = (L == DEPTH - 1) ? 256 : 288;
        for (int u = F.vcu; u < nu; u += F.G) { if (u < 256) attn_unit<KIND>(F, L, u >> 5, (u >> 3) & 3, u & 7); else attn_unit<KIND>(F, L, (u - 256) >> 2, (u - 256) & 3, -1); } }
}
__device__ __forceinline__ void phase_mix_fast(const Fr& F, int L) {
#ifndef ATT_MASK
#define ATT_MASK 15
#endif
#ifndef ATT_DUP
#define ATT_DUP 0
#endif
#ifndef ATT_MASK
#define ATT_MASK 15
#endif
    if (ATT_MASK & 4) for (int rp = 0; rp < ((ATT_DUP & 4) ? 2 : 1); ++rp) { const Fr Fa = refresh(F); attn_units<2>(Fa, L); }
    if (ATT_MASK & 2) for (int rp = 0; rp < ((ATT_DUP & 2) ? 2 : 1); ++rp) { const Fr Fa = refresh(F); attn_units<1>(Fa, L); }
    if (ATT_MASK & 1) for (int rp = 0; rp < ((ATT_DUP & 1) ? 2 : 1); ++rp) { const Fr Fa = refresh(F); attn_units<0>(Fa, L); }
    const int c0 = (L == DEPTH - 1) ? 4 : 0;
    if (ATT_MASK & 8) for (int rp = 0; rp < ((ATT_DUP & 8) ? 2 : 1); ++rp) { const Fr Fa = refresh(F);
    for (int u = Fa.vcu; u < NB * (36 - c0); u += Fa.G) ssd_s3_unit(Fa, L, u / (36 - c0), c0 + u % (36 - c0)); }
}

__device__ __forceinline__ void phase_route(const Fr& F, int L, bool commit = true) {
    const int nrows = (L == DEPTH - 1) ? NLAT : NROW;
    LAS float* wl = (LAS float*)F.lds;
    {   const f32x4* wg4 = (const f32x4*)(F.w_grp() + (size_t)L * DM * 4); const f32x4* we4 = (const f32x4*)(F.w_exp() + (size_t)L * DM * 16);
        f32x4 tg[2], te[8];
#pragma unroll
        for (int n = 0; n < 2; ++n) tg[n] = wg4[F.tid + 512 * n];
#pragma unroll
        for (int n = 0; n < 8; ++n) te[n] = we4[F.tid + 512 * n];
#pragma unroll
        for (int n = 0; n < 2; ++n) { const int k = F.tid + 512 * n;
#pragma unroll
            for (int o = 0; o < 4; ++o) wl[o * DM + k] = tg[n][o]; }
#pragma unroll
        for (int n = 0; n < 8; ++n) { const int i = F.tid + 512 * n, k = i >> 2, q = i & 3;
#pragma unroll
            for (int o = 0; o < 4; ++o) wl[(4 + 4 * q + o) * DM + k] = te[n][o]; }
    }
    __syncthreads();
    float keep[20];
#pragma unroll
    for (int o = 0; o < 20; ++o) keep[o] = 0.f;
    f32x4 v[4], vn[4];
    { const int r = F.gw; if (r < nrows) { const float* hp = r < NLAT ? F.out() + (size_t)r * DM : F.hc() + (size_t)(r - NLAT) * DM;
#pragma unroll
        for (int j = 0; j < 4; ++j) vn[j] = *(const f32x4*)(hp + 4 * F.lane + 256 * j); } }
    int it = 0;
    for (int r = F.gw; r < nrows; r += F.NGW, ++it) {
        const bool lat = r < NLAT; const int bb = lat ? (r >> 11) : 8;
#pragma unroll
        for (int j = 0; j < 4; ++j) v[j] = vn[j];
        { const int rn = r + F.NGW; if (rn < nrows) { const float* hp = rn < NLAT ? F.out() + (size_t)rn * DM : F.hc() + (size_t)(rn - NLAT) * DM;
#pragma unroll
            for (int j = 0; j < 4; ++j) vn[j] = *(const f32x4*)(hp + 4 * F.lane + 256 * j); } }
        float ss = 0.f;
#pragma unroll
        for (int j = 0; j < 4; ++j) ss += (v[j][0] * v[j][0] + v[j][1] * v[j][1]) + (v[j][2] * v[j][2] + v[j][3] * v[j][3]);
        const float rstd = rsqrtf(wsum(ss) * (1.f / DM) + EPS);
        const float* md = F.modv() + ((size_t)L * 9 + bb) * 6144;
        float lg[20];
#pragma unroll
        for (int o = 0; o < 20; ++o) lg[o] = 0.f;
#pragma unroll
        for (int j = 0; j < 4; ++j) { const int c = 4 * F.lane + 256 * j; const f32x4 g = *(const f32x4*)(F.g_ffn() + L * DM + c), sh = *(const f32x4*)(md + 3 * 1024 + c), scl = *(const f32x4*)(md + 4 * 1024 + c);
            const f32x4 f = v[j] * rstd * g * (scl + 1.f) + sh; u32x2 o2; o2.x = pk2(f[0], f[1]); o2.y = pk2(f[2], f[3]); *(u32x2*)(F.abuf() + (size_t)r * DM + c) = o2;
#pragma unroll
            for (int o = 0; o < 20; ++o) { const f32x4 w = *(const LAS f32x4*)(wl + o * DM + c); lg[o] += (f[0] * w[0] + f[1] * w[1]) + (f[2] * w[2] + f[3] * w[3]); }
            asm volatile("" ::: "memory"); }
#pragma unroll
        for (int o = 0; o < 20; ++o) { const float t = wsum(lg[o]); keep[o] = (F.lane == it) ? t : keep[o]; }
    }
    if (F.lane < it) {
        const int r = F.gw + F.lane * F.NGW;
        float gl[4]; float gm = -INFINITY; int gt = 0;
#pragma unroll
        for (int o = 0; o < 4; ++o) { gl[o] = keep[o] + F.b_grp()[L * 4 + o]; if (gl[o] > gm) { gm = gl[o]; gt = o; } }
        float gs = 0.f;
#pragma unroll
        for (int o = 0; o < 4; ++o) gs += expf(gl[o] - gm);
        const float gp = 1.f / gs;
        float el[4];
#pragma unroll
        for (int o = 0; o < 4; ++o) { float v4 = 0.f;
#pragma unroll
            for (int q = 0; q < 4; ++q) v4 = (gt == q) ? keep[4 + 4 * q + o] + F.b_exp()[L * 16 + 4 * q + o] : v4;
            el[o] = v4; }
        int i0 = 0; float m0 = el[0];
#pragma unroll
        for (int o = 1; o < 4; ++o) if (el[o] > m0) { m0 = el[o]; i0 = o; }
        int i1 = i0 == 0 ? 1 : 0; float m1 = i0 == 0 ? el[1] : el[0];
#pragma unroll
        for (int o = 1; o < 4; ++o) if (o != i0 && el[o] > m1) { m1 = el[o]; i1 = o; }
        const float e1 = expf(m1 - m0), w0 = gp / (1.f + e1), w1 = gp * e1 / (1.f + e1);
        const int x0 = gt * 4 + i0, x1 = gt * 4 + i1;
        if (commit) {
            F.rtw()[2 * r] = w0; F.rtw()[2 * r + 1] = w1;
            const unsigned p0 = atomicAdd(F.ctl() + CW_ECNT + (L * 16 + x0) * 64, 1u), p1 = atomicAdd(F.ctl() + CW_ECNT + (L * 16 + x1) * 64, 1u);
            F.elist()[x0 * NROW + p0] = 2 * r; F.elist()[x1 * NROW + p1] = 2 * r + 1; }
        else if (w0 + w1 < -1.f) F.rtw()[0] = 0.f;
    }
    __syncthreads();
}
__device__ __forceinline__ void moe_table(const Fr& F, int L) {
    volatile LAS int* T = (volatile LAS int*)(F.lds + LDSCTL_OFF + 64);
    volatile LAS int* Cn = (volatile LAS int*)(F.lds + LDSCTL_OFF + 160);
    __syncthreads();
    if (F.tid == 0) { int acc = 0;
        for (int e = 0; e < 16; ++e) { int c = (int)__hip_atomic_load(F.ctl() + CW_ECNT + (L * 16 + e) * 64, __ATOMIC_RELAXED, __HIP_MEMORY_SCOPE_AGENT); c = min(max(c, 0), NROW); T[e] = acc; Cn[e] = c; acc += (c + 255) >> 8; }
        T[16] = acc; }
    __syncthreads();
}

__global__ void __launch_bounds__(512, 2) fwd_kernel(Args args) {
    extern __shared__ __attribute__((aligned(16))) unsigned char lds_raw[];
    Fr F0;
    F0.lds = (LAS unsigned char*)lds_raw; F0.tid = threadIdx.x; F0.lane = F0.tid & 63; F0.wave = __builtin_amdgcn_readfirstlane(F0.tid >> 6);
    F0.G = gridDim.x; { const int bx = blockIdx.x; F0.vcu = (F0.G % 8 == 0) ? (bx % 8) * (F0.G / 8) + bx / 8 : bx; }
    F0.gw = F0.vcu * 8 + F0.wave; F0.NGW = F0.G * 8;
    F0.A = (const __attribute__((address_space(4))) Args*)__builtin_amdgcn_kernarg_segment_ptr();
    for (int u = F0.tid; u < (LDS_BYTES - LDSCTL_OFF) / 4; u += 512) ((LAS unsigned*)(F0.lds + LDSCTL_OFF))[u] = 0u;
    __syncthreads();
    const int lo = args.ph_lo, hi = args.ph_hi;
    XcdBarrier bar; bar.bar = F0.ctl() + CW_BAR; bar.x = 0; bar.st = nullptr;
    if (hi - lo > 1) bar = xcd_barrier_post(F0.ctl() + CW_BAR, (volatile LAS unsigned*)(F0.lds + LDSCTL_OFF));
#ifndef PH_MASK
#define PH_MASK 0xFFFF
#endif
#define PM(b) ((PH_MASK >> (b)) & 1)
#ifndef DUP_MASK
#define DUP_MASK 0
#endif
#ifndef DBL_SEAM
#define DBL_SEAM 0
#endif
#define NREP(b) (((DUP_MASK >> (b)) & 1) ? 2 : 1)
#define IN(k) (lo <= (k) && (k) < hi)
#define SEAM(k) do { if (IN(k) && IN((k) + 1)) { const Fr Fb = refresh(F0); XcdBarrier b2 = bar; b2.bar = Fb.ctl() + CW_BAR; xcd_barrier(b2); if ((DUP_MASK & 0x10000) || ((DBL_SEAM >> (((k) + NPH_L - 1) % NPH_L)) & 1)) xcd_barrier(b2); } } while (0)

    if (PM(0) && IN(0)) { for (int rep_ = 0; rep_ < NREP(0); ++rep_) { if (rep_) __syncthreads(); const Fr F = refresh(F0); phase_prologue(F); } }
    SEAM(0);
    for (int L = 0; L < DEPTH; ++L) {
        const int pb = 1 + NPH_L * L;
        const bool lastL = (L == DEPTH - 1);
        if (PM(1) && IN(pb + 0)) { const Fr F = refresh(F0); phase_norm(F, L); if (DUP_MASK & 2048) { __syncthreads(); phase_norm(F, L, false); } for (int rp = 0; rp < NREP(10); ++rp) moe_weight_convert(F, L); }
        SEAM(pb + 0);
        if (PM(2) && IN(pb + 1)) { for (int rep_ = 0; rep_ < NREP(2); ++rep_) { if (rep_) __syncthreads(); const Fr F = refresh(F0); pg8::DenseSched S; S.init(F.abuf(), F.winT() + (size_t)L * NP * DM, DM, NROW, NP, F.G, (int)blockIdx.x); pg8::EpiP E{F.pbuf()}; pg8::gemm_phase(F.lds, F.tid, DM, S, E); } }
        SEAM(pb + 1);
        if (PM(3) && IN(pb + 2)) { for (int rep_ = 0; rep_ < NREP(3); ++rep_) { if (rep_) __syncthreads(); const Fr F = refresh(F0); phase_prep(F, L); } }
        SEAM(pb + 2);
        if (PM(4) && IN(pb + 3)) { for (int rep_ = 0; rep_ < NREP(4); ++rep_) { if (rep_) __syncthreads(); const Fr F = refresh(F0); phase_ssd_s1(F, L); } }
        SEAM(pb + 3);
        if (PM(4) && IN(pb + 4)) { for (int rep_ = 0; rep_ < NREP(6); ++rep_) { if (rep_) __syncthreads(); const Fr F = refresh(F0); phase_ssd_scan(F, L); } }
        SEAM(pb + 4);
        if (PM(5) && IN(pb + 5)) { for (int rep_ = 0; rep_ < NREP(5); ++rep_) { if (rep_) __syncthreads(); const Fr F = refresh(F0); phase_mix_fast(F, L); } }
        SEAM(pb + 5);
        if (PM(6) && IN(pb + 6)) { const Fr F = refresh(F0); pg8::DenseSched S; S.init(F.mix(), F.woutT() + (size_t)L * DM * DM, DM, lastL ? NLAT : NROW, DM, F.G, (int)blockIdx.x);
            pg8::EpiRes E{L == 0 ? F.x() : F.out(), L == 0 ? F.ctx() : F.hc(), F.out(), F.hc(), F.modv() + (size_t)L * 9 * 6144 + 2 * 1024, 1.f}; pg8::gemm_phase(F.lds, F.tid, DM, S, E);
            if (DUP_MASK & 8192) { __syncthreads(); pg8::EpiRes E2{F.out(), F.hc(), F.out(), F.hc(), F.modv() + (size_t)L * 9 * 6144 + 2 * 1024, 0.f}; pg8::gemm_phase(F.lds, F.tid, DM, S, E2); } }
        SEAM(pb + 6);
        if (PM(7) && IN(pb + 7)) { const Fr F = refresh(F0); phase_route(F, L); if (DUP_MASK & 4096) phase_route(F, L, false); }
        SEAM(pb + 7);
        if (PM(8) && IN(pb + 8)) { for (int rep_ = 0; rep_ < NREP(8); ++rep_) { if (rep_) __syncthreads(); const Fr F = refresh(F0); moe_table(F, L);
            pg8::MoeSched<true> S{(const char*)F.abuf(), (const char*)F.wgu(), (size_t)1024 * DM * 2, DM, F.G, F.vcu, F.elist(), (const volatile LAS int*)(F.lds + LDSCTL_OFF + 64), (const volatile LAS int*)(F.lds + LDSCTL_OFF + 160)};
            pg8::EpiAct E{F.act()}; pg8::gemm_phase(F.lds, F.tid, DM, S, E); } }
        SEAM(pb + 8);
        if (PM(9) && IN(pb + 9)) { for (int rep_ = 0; rep_ < NREP(9); ++rep_) { if (rep_) __syncthreads(); const Fr F = refresh(F0); moe_table(F, L);
            pg8::MoeSched<false> S{(const char*)F.act(), (const char*)F.wd(), (size_t)1024 * FF * 2, FF, F.G, F.vcu, F.elist(), (const volatile LAS int*)(F.lds + LDSCTL_OFF + 64), (const volatile LAS int*)(F.lds + LDSCTL_OFF + 160)};
            pg8::EpiDown E{F.yk(), F.elist(), F.rtw()}; pg8::gemm_phase(F.lds, F.tid, FF, S, E); } }
        SEAM(pb + 9);
    }
    if (PM(1) && IN(PH_FINAL)) { const Fr F = refresh(F0); phase_norm(F, DEPTH); }
#undef IN
#undef SEAM
}

extern "C" void kernel_launch(void* const* d_in, const int* in_sizes, int n_in, void* d_out, int out_size, void* d_ws, size_t ws_size, hipStream_t stream) {
    static int grid = 0;
    if (grid == 0) {
        if (n_in != 36 || out_size != NLAT * DM || ws_size < WS_END) { fprintf(stderr, "kernel_launch: unexpected shapes (n_in %d out %d ws %zu)\n", n_in, out_size, ws_size); grid = -1; return; }
        int dev = 0, cus = 0, per_cu = 0;
        if (hipGetDevice(&dev) != hipSuccess || hipDeviceGetAttribute(&cus, hipDeviceAttributeMultiprocessorCount, dev) != hipSuccess) { grid = -1; return; }
        if (hipFuncSetAttribute((const void*)fwd_kernel, hipFuncAttributeMaxDynamicSharedMemorySize, LDS_BYTES) != hipSuccess) { fprintf(stderr, "kernel_launch: hipFuncSetAttribute failed\n"); grid = -1; return; }
        if (hipOccupancyMaxActiveBlocksPerMultiprocessor(&per_cu, (const void*)fwd_kernel, 512, LDS_BYTES) != hipSuccess || per_cu < 1) { fprintf(stderr, "kernel_launch: occupancy query says %d\n", per_cu); }
        (void)hipGetLastError();
        grid = cus;
    }
    if (grid < 0) return;
    (void)hipMemsetAsync((char*)d_ws + WS_CTL, 0, CTL_BYTES, stream);
    Args a{};
    for (int i = 0; i < 36; ++i) a.in[i] = (const float*)d_in[i];
    a.out = (float*)d_out; a.ws = (unsigned char*)d_ws;
#if MK_ONE_LAUNCH
    a.ph_lo = 0; a.ph_hi = NPHASE;
    hipLaunchKernelGGL(fwd_kernel, dim3(grid), dim3(512), LDS_BYTES, stream, a);
#else
    for (int ph = 0; ph < NPHASE; ++ph) { a.ph_lo = ph; a.ph_hi = ph + 1; hipLaunchKernelGGL(fwd_kernel, dim3(grid), dim3(512), LDS_BYTES, stream, a); }
#endif
}
```

```cpp
#include <hip/hip_runtime.h>
#include <cstdio>
#include <cstdint>

#ifndef MK_ONE_LAUNCH
#define MK_ONE_LAUNCH 1
#endif

#define LAS __attribute__((address_space(3)))
typedef unsigned short bf16;
typedef short bf16x8 __attribute__((ext_vector_type(8)));
typedef float f32x4 __attribute__((ext_vector_type(4)));
typedef float f32x2 __attribute__((ext_vector_type(2)));
typedef unsigned u32x4 __attribute__((ext_vector_type(4)));
typedef unsigned u32x2 __attribute__((ext_vector_type(2)));

constexpr int NB = 8, TLAT = 2048, TCTX = 256, SQ = 2304, DM = 1024, DEPTH = 4;
constexpr int NLAT = NB * TLAT, NCTXR = NB * TCTX, NROW = NLAT + NCTXR;
constexpr int NIN = 2984, NP = 3072;
constexpr int C_NA = 0, C_MLA = 768, C_DF = 1184, C_SSD = 1952;
constexpr int C_Z = C_SSD, C_XBC = C_SSD + 256, C_DT = C_SSD + 1024;
constexpr float EPS = 1e-6f;
constexpr int NEXP = 16, FF = 512, ACT_ROWS = 40960;
constexpr int NPH_L = 10, PH_FINAL = 1 + NPH_L * DEPTH, NPHASE = PH_FINAL + 1;

constexpr size_t MiB = 1u << 20;
constexpr size_t WS_CTL = 0, CTL_BYTES = 1 * MiB;
constexpr size_t WS_MOD = 1 * MiB;
constexpr size_t WS_ROPE = 2 * MiB;
constexpr size_t WS_WIN = 4 * MiB;
constexpr size_t WS_WOUT = 28 * MiB;
constexpr size_t WS_WQB = 36 * MiB;
constexpr size_t WS_WKVB = 37 * MiB;
constexpr size_t WS_WGU = 38 * MiB;
constexpr size_t WS_WD = 70 * MiB;
constexpr size_t WS_HC = 86 * MiB;
constexpr size_t WS_A = 94 * MiB;
constexpr size_t WS_P = 130 * MiB;
constexpr size_t WS_ACT = 130 * MiB;
constexpr size_t WS_YK = 170 * MiB;
constexpr size_t WS_MIX = 238 * MiB;
constexpr size_t WS_QNA = 274 * MiB, WS_KNA = 283 * MiB, WS_VNA = 292 * MiB;
constexpr size_t WS_QML = 301 * MiB, WS_KML = 315 * MiB, WS_VML = 329 * MiB;
constexpr size_t WS_QDF = 338 * MiB, WS_KDF = 347 * MiB, WS_VDF = 356 * MiB;
constexpr size_t WS_XT = 365 * MiB, WS_BTM = 374 * MiB, WS_BT = 383 * MiB, WS_CTM = 392 * MiB;
constexpr size_t WS_DT = 401 * MiB;
constexpr size_t WS_CST = 402 * MiB;
constexpr size_t WS_CDEC = 474 * MiB;
constexpr size_t WS_HENT = 475 * MiB;
constexpr size_t WS_RT = 511 * MiB;
constexpr size_t WS_ELIST = 512 * MiB;
constexpr size_t WS_END = 514 * MiB;
constexpr int CW_BAR = 4096;
constexpr int CW_ECNT = 16384;
constexpr int CW_KMAX = 65536;
constexpr int CW_QUEUE = 32768;

constexpr int RING_BYTES = 131072, LDSCTL_OFF = RING_BYTES, LDS_BYTES = 147456;

typedef float f32x16 __attribute__((ext_vector_type(16)));
#define MFMA32(a, b, c) __builtin_amdgcn_mfma_f32_32x32x16_bf16((a), (b), (c), 0, 0, 0)
__device__ __forceinline__ int crow16(int reg, int hh) { return (reg & 3) + 8 * (reg >> 2) + 4 * hh; }
__device__ __forceinline__ float bf2f(bf16 v) { return __uint_as_float(((unsigned)v) << 16); }
__device__ __forceinline__ bf16 f2bf(float f) { unsigned u = __float_as_uint(f); return (bf16)((u + 0x7fffu + ((u >> 16) & 1u)) >> 16); }
__device__ __forceinline__ unsigned pk2(float lo, float hi) { return (unsigned)f2bf(lo) | ((unsigned)f2bf(hi) << 16); }
template <int CTRL> __device__ __forceinline__ float dppf(float v) { return __int_as_float(__builtin_amdgcn_update_dpp(0, __float_as_int(v), CTRL, 0xF, 0xF, true)); }
__device__ __forceinline__ float rlane(float v, int l) { return __int_as_float(__builtin_amdgcn_readlane(__float_as_int(v), l)); }
__device__ __forceinline__ float wsum(float v) {
    v += dppf<0xB1>(v); v += dppf<0x4E>(v); v += dppf<0x141>(v); v += dppf<0x140>(v);
    return (rlane(v, 0) + rlane(v, 16)) + (rlane(v, 32) + rlane(v, 48)); }
__device__ __forceinline__ float wmaxf(float v) {
    v = fmaxf(v, dppf<0xB1>(v)); v = fmaxf(v, dppf<0x4E>(v)); v = fmaxf(v, dppf<0x141>(v)); v = fmaxf(v, dppf<0x140>(v));
    return fmaxf(fmaxf(rlane(v, 0), rlane(v, 16)), fmaxf(rlane(v, 32), rlane(v, 48))); }
#define LDS_WAIT() asm volatile("s_waitcnt lgkmcnt(0)" ::: "memory")
__device__ __forceinline__ void row2bs(int r, int& b, int& s) { if (r < NLAT) { b = r >> 11; s = 256 + (r & 2047); } else { const int j = r - NLAT; b = j >> 8; s = j & 255; } }
__device__ __forceinline__ int bs2row(int b, int s) { return s < 256 ? NLAT + b * 256 + s : b * 2048 + s - 256; }
__device__ __forceinline__ int vpos(int s) { return (s & ~12) | ((s & 4) << 1) | ((s & 8) >> 1); }
__device__ __forceinline__ float siluf(float x) { return x / (1.f + __expf(-x)); }

#define XB_TMO      128
#define XB_XCNT(j)  (256  + 64 * (j))
#define XB_XSUB(j)  (1280 + 64 * (j))
#define XB_XGEN(j)  (2304 + 64 * (j))
#define XB_TOP      3328
#define XB_TOPGEN   3392
#define XCD_BAR_WORDS 3456
#define XB_SPIN_CAP (1u << 24)
__device__ __forceinline__ unsigned xb_ld(unsigned* p)              { return __hip_atomic_load(p, __ATOMIC_RELAXED, __HIP_MEMORY_SCOPE_AGENT); }
__device__ __forceinline__ unsigned xb_add(unsigned* p, unsigned v) { return __hip_atomic_fetch_add(p, v, __ATOMIC_RELAXED, __HIP_MEMORY_SCOPE_AGENT); }
__device__ __forceinline__ unsigned xb_xcc_id() { return (unsigned)__builtin_amdgcn_s_getreg((3 << 11) | 20) & 0xFu; }
#define XB_SPIN(cond, bar) do { unsigned _sp = 0; while (cond) { __builtin_amdgcn_s_sleep(1); \
    if ((++_sp & 255u) == 0u) { if (xb_ld(&(bar)[XB_TMO])) break; if (_sp > XB_SPIN_CAP) { atomicAdd(&(bar)[XB_TMO], 1u); break; } } } } while (0)
struct XcdBarrier { unsigned* bar; unsigned x; volatile LAS unsigned* st; };
__device__ __forceinline__ XcdBarrier xcd_barrier_post(unsigned* bar, volatile LAS unsigned* st) {
    XcdBarrier b; b.bar = bar; b.x = xb_xcc_id(); b.st = st;
    if (threadIdx.x == 0) (void)xb_add(&bar[XB_XCNT(b.x)], 1u);
    return b;
}
__device__ __forceinline__ void xcd_barrier_complete(unsigned* bar, unsigned x, unsigned& nloc, unsigned& nx) {
    const unsigned G = gridDim.x * gridDim.y * gridDim.z;
    unsigned sum, cnt, mine, sp = 0u;
    for (;;) {
        sum = 0u; cnt = 0u; mine = 0u;
#pragma unroll
        for (unsigned j = 0; j < 16; ++j) { const unsigned c = xb_ld(&bar[XB_XCNT(j)]); sum += c; cnt += (c > 0u) ? 1u : 0u; mine = (j == x) ? c : mine; }
        if (sum == G) break;
        __builtin_amdgcn_s_sleep(1);
        if ((++sp & 255u) == 0u) { if (xb_ld(&bar[XB_TMO])) break; if (sp > XB_SPIN_CAP) { atomicAdd(&bar[XB_TMO], 1u); break; } }
    }
    nloc = mine > 0u ? mine : 1u; nx = cnt > 0u ? cnt : 1u;
}
__device__ __forceinline__ void xcd_barrier(const XcdBarrier& b) {
    asm volatile("s_waitcnt vmcnt(0)" ::: "memory");
    __syncthreads();
    if (threadIdx.x == 0) {
        unsigned* bar = b.bar;
        __builtin_amdgcn_s_waitcnt(0);
        unsigned nloc = b.st[0], nx = b.st[1];
        if (nloc == 0u) { xcd_barrier_complete(bar, b.x, nloc, nx); b.st[0] = nloc; b.st[1] = nx; }
        const unsigned old = xb_add(&bar[XB_XSUB(b.x)], 1u);
        const unsigned gen = old / nloc;
        if (old + 1u == (gen + 1u) * nloc) {
            __builtin_amdgcn_fence(__ATOMIC_RELEASE, "agent");
            asm volatile("s_waitcnt vmcnt(0)" ::: "memory");
            const unsigned og = xb_add(&bar[XB_TOP], 1u);
            const unsigned tg = og / nx;
            if (og + 1u == (tg + 1u) * nx) xb_add(&bar[XB_TOPGEN], 1u);
            else XB_SPIN(xb_ld(&bar[XB_TOPGEN]) == tg, bar);
            __builtin_amdgcn_fence(__ATOMIC_ACQUIRE, "agent");
            xb_add(&bar[XB_XGEN(b.x)], 1u);
            asm volatile("s_waitcnt vmcnt(0)" ::: "memory");
        } else {
            XB_SPIN(xb_ld(&bar[XB_XGEN(b.x)]) == gen, bar);
            __builtin_amdgcn_fence(__ATOMIC_ACQUIRE, "agent");
            asm volatile("s_waitcnt vmcnt(0)" ::: "memory");
        }
    }
    __syncthreads();
}

namespace pg8 {
constexpr int BM = 256, BK = 64, HALF = 128, HTB = HALF * BK * 2, NXCD = 8, WGM = 8;
__device__ __forceinline__ int lds_byte(int r, int c) { const int st = (r >> 4) * 2 + (c >> 5), rr = r & 15, cc = c & 31, ob = rr * 64 + cc * 2; return st * 1024 + (ob ^ (((ob >> 9) & 1) << 5)); }
__device__ __forceinline__ void stage_rc(int b, int& R, int& C) { const int st = b / 1024, sb = b % 1024, swz = sb ^ (((sb >> 9) & 1) << 5); R = (st >> 1) * 16 + swz / 64; C = (st & 1) * 32 + (swz % 64) / 2; }
__device__ __forceinline__ int perm32(int rho) { const int n = rho >> 4, i = rho & 15; return 8 * (i >> 2) + 4 * n + (i & 3); }
struct Unit { int pm, pn, e, j, cnt; };

template <class Epi, class Sched>
__device__ __forceinline__ void gemm_phase(LAS unsigned char* lds, const int tid, const int K, const Sched& S, const Epi& E) {
    const int wid = __builtin_amdgcn_readfirstlane(tid >> 6), lane = tid & 63, wr = wid >> 2, wc = wid & 3, fr = lane & 15, fq = lane >> 4;
    const int nt = K / BK;
    int Rr[2]; unsigned Cb[2], voffB[2];
#pragma unroll
    for (int i = 0; i < 2; ++i) { int R, C; stage_rc(tid * 16 + i * 8192, R, C); const int Rb = Epi::PERM ? ((R & ~31) + perm32(R & 31)) : R;
        Rr[i] = R; Cb[i] = (unsigned)C * 2u; voffB[i] = (unsigned)(Rb * K + C) * 2u; }
    const size_t kstep = (size_t)(BK * 2);
    const size_t hstep = (size_t)HALF * K * 2;
    const unsigned ldsw = (unsigned)wid * 1024u;
    const int aoff = lds_byte(wr * 64 + fr, fq * 8), boff = lds_byte(wc * 32 + fr, fq * 8);
#define PG8_SA(b, h) (((b) * 2 + (h)) * HTB)
#define PG8_SB(b, h) ((4 + (b) * 2 + (h)) * HTB)
#define PG8_STAGE(bufoff, gbase, voff) do { _Pragma("unroll") for (int _i = 0; _i < 2; ++_i) \
        __builtin_amdgcn_global_load_lds((const unsigned*)((const char*)(gbase) + (voff)[_i]), (LAS unsigned*)(lds + (bufoff) + ldsw + _i * 8192), 16, 0, 0); } while (0)
#define PG8_LDA(dst, b, h) do { _Pragma("unroll") for (int m = 0; m < 4; ++m) _Pragma("unroll") for (int k = 0; k < 2; ++k) dst[m][k] = *(const LAS bf16x8*)(lds + PG8_SA(b, h) + aoff + m * 2048 + k * 1024); } while (0)
#define PG8_LDB(dst, b, h) do { _Pragma("unroll") for (int n = 0; n < 2; ++n) _Pragma("unroll") for (int k = 0; k < 2; ++k) dst[n][k] = *(const LAS bf16x8*)(lds + PG8_SB(b, h) + boff + n * 2048 + k * 1024); } while (0)
#define PG8_MMA(ai, bj, At, Bt) do { __builtin_amdgcn_s_setprio(1); _Pragma("unroll") for (int m = 0; m < 4; ++m) _Pragma("unroll") for (int n = 0; n < 2; ++n) _Pragma("unroll") for (int k = 0; k < 2; ++k) \
        acc[ai][bj][m][n] = __builtin_amdgcn_mfma_f32_16x16x32_bf16(Bt[n][k], At[m][k], acc[ai][bj][m][n], 0, 0, 0); __builtin_amdgcn_s_setprio(0); } while (0)
#define PG8_WAIT_V(n) asm volatile("s_waitcnt vmcnt(" #n ")" ::: "memory")
#define PG8_WAIT_L(n) asm volatile("s_waitcnt lgkmcnt(" #n ")" ::: "memory")
#define PG8_BAR __builtin_amdgcn_s_barrier()
#define PG8_SCHED __builtin_amdgcn_sched_barrier(0)
    Unit cur, nxt; int ui = 0;
    if (!S.next(0, cur)) return;
    f32x4 acc[2][2][4][2];
#pragma unroll
    for (int a = 0; a < 2; ++a)
#pragma unroll
        for (int b = 0; b < 2; ++b)
#pragma unroll
            for (int m = 0; m < 4; ++m)
#pragma unroll
                for (int n = 0; n < 2; ++n) acc[a][b][m][n] = (f32x4){0.f, 0.f, 0.f, 0.f};
    bf16x8 At[4][2], B0[2][2], B1[2][2];
    unsigned vA0[2], vA1[2];
    const char* cA = S.a_ptr(cur);
    if constexpr (Sched::GATHER) { S.a_offs(cur, Rr, vA0, vA1);
#pragma unroll
        for (int i = 0; i < 2; ++i) { vA0[i] += Cb[i]; vA1[i] += Cb[i]; }
        asm volatile("s_waitcnt vmcnt(0)" ::: "memory");
    } else {
#pragma unroll
        for (int i = 0; i < 2; ++i) { vA0[i] = (unsigned)(Rr[i] * K * 2) + Cb[i]; vA1[i] = vA0[i]; } }
    const size_t ahs = Sched::GATHER ? (size_t)0 : hstep;
    const char* cB = S.b_ptr(cur);
    PG8_STAGE(PG8_SB(0, 0), cB, voffB); PG8_STAGE(PG8_SB(0, 1), cB + hstep, voffB); PG8_STAGE(PG8_SA(0, 0), cA, vA0); PG8_STAGE(PG8_SA(0, 1), cA + ahs, vA1);
    if (wr == 1) PG8_BAR;
    PG8_WAIT_V(2); PG8_BAR;
    PG8_STAGE(PG8_SB(1, 0), cB + kstep, voffB); PG8_STAGE(PG8_SA(1, 0), cA + kstep, vA0); PG8_STAGE(PG8_SB(1, 1), cB + hstep + kstep, voffB);
    PG8_WAIT_V(6); PG8_BAR;
    for (;;) {
        const bool has_next = S.next(ui + 1, nxt);
        const char* nA = has_next ? S.a_ptr(nxt) : cA; const char* nB = has_next ? S.b_ptr(nxt) : cB;
        for (int t = 0; t < nt; t += 2) {
            const bool last = (t == nt - 2);
            const char* a1 = cA + (size_t)(t + 1) * kstep;
            const char* a2 = last ? nA : cA + (size_t)(t + 2) * kstep; const char* b2 = last ? nB : cB + (size_t)(t + 2) * kstep;
            const char* a3 = a2 + kstep; const char* b3 = b2 + kstep;
            PG8_LDB(B0, 0, 0); PG8_LDB(B1, 0, 1); PG8_SCHED; PG8_LDA(At, 0, 0); PG8_STAGE(PG8_SA(1, 1), a1 + ahs, vA1);
            if constexpr (Sched::GATHER) { if (last && has_next) { S.a_offs(nxt, Rr, vA0, vA1);
#pragma unroll
                for (int i = 0; i < 2; ++i) { vA0[i] += Cb[i]; vA1[i] += Cb[i]; }
                asm volatile("s_waitcnt vmcnt(0)" ::: "memory"); } }
            PG8_WAIT_V(8); PG8_WAIT_L(0); PG8_BAR; PG8_MMA(0, 0, At, B0); PG8_MMA(0, 1, At, B1); PG8_BAR; PG8_SCHED;
            PG8_LDA(At, 0, 1); PG8_STAGE(PG8_SB(0, 0), b2, voffB); PG8_STAGE(PG8_SB(0, 1), b2 + hstep, voffB); PG8_STAGE(PG8_SA(0, 0), a2, vA0);
            PG8_WAIT_V(8); PG8_WAIT_L(0); PG8_BAR; PG8_MMA(1, 0, At, B0); PG8_MMA(1, 1, At, B1); PG8_BAR; PG8_SCHED;
            PG8_LDB(B0, 1, 0); PG8_LDB(B1, 1, 1); PG8_SCHED; PG8_LDA(At, 1, 0); PG8_STAGE(PG8_SA(0, 1), a2 + ahs, vA1);
            PG8_WAIT_V(8); PG8_WAIT_L(0); PG8_BAR; PG8_MMA(0, 0, At, B0); PG8_MMA(0, 1, At, B1); PG8_BAR; PG8_SCHED;
            PG8_LDA(At, 1, 1); PG8_STAGE(PG8_SB(1, 0), b3, voffB); PG8_STAGE(PG8_SB(1, 1), b3 + hstep, voffB); PG8_STAGE(PG8_SA(1, 0), a3, vA0);
            PG8_WAIT_V(8); PG8_WAIT_L(0); PG8_BAR; PG8_MMA(1, 0, At, B0); PG8_MMA(1, 1, At, B1); PG8_BAR; PG8_SCHED;
        }
        if (wr == 0) PG8_BAR;
        E(acc, cur, wr, wc, fr, fq);
        if (!has_next) break;
#pragma unroll
        for (int a = 0; a < 2; ++a)
#pragma unroll
            for (int b = 0; b < 2; ++b)
#pragma unroll
                for (int m = 0; m < 4; ++m)
#pragma unroll
                    for (int n = 0; n < 2; ++n) acc[a][b][m][n] = (f32x4){0.f, 0.f, 0.f, 0.f};
        cur = nxt; cA = nA; cB = nB; ++ui;
        if (wr == 1) PG8_BAR;
    }
    PG8_WAIT_V(0);
    PG8_BAR;
#undef PG8_SA
#undef PG8_SB
#undef PG8_STAGE
#undef PG8_LDA
#undef PG8_LDB
#undef PG8_MMA
#undef PG8_WAIT_V
#undef PG8_WAIT_L
#undef PG8_BAR
#undef PG8_SCHED
}
__device__ __forceinline__ unsigned cvt_pk_bf16(float lo, float hi) { unsigned r; asm volatile("v_cvt_pk_bf16_f32 %0, %1, %2" : "=v"(r) : "v"(lo), "v"(hi)); return r; }

struct DenseSched {
    const char* A; const char* Bt; int K, nM, nN, nwg, G, c;
    __device__ void init(const void* A_, const void* Bt_, int K_, int M, int N, int G_, int c_) { A = (const char*)A_; Bt = (const char*)Bt_; K = K_; nM = M / BM; nN = N / BM; nwg = nM * nN; G = G_; c = c_; }
    __device__ __forceinline__ bool next(int i, Unit& u) const {
        const long L = (long)i * G + c; if (L >= nwg) return false;
        int wgid = (int)L; { const int q = nwg / NXCD, r = nwg % NXCD, xcd = wgid % NXCD, off = wgid / NXCD; wgid = (xcd < r ? xcd * (q + 1) : r * (q + 1) + (xcd - r) * q) + off; }
        const int nig = WGM * nN, gid = wgid / nig, fm = gid * WGM, gsz = (nM - fm) < WGM ? (nM - fm) : WGM;
        u.pm = fm + ((wgid % nig) % gsz); u.pn = (wgid % nig) / gsz; u.e = 0; u.j = 0; u.cnt = 256; return true;
    }
    static constexpr bool GATHER = false;
    __device__ __forceinline__ const char* a_ptr(const Unit& u) const { return A + (size_t)u.pm * BM * K * 2; }
    __device__ __forceinline__ void a_offs(const Unit&, const int (&)[2], unsigned (&)[2], unsigned (&)[2]) const {}
    __device__ __forceinline__ const char* b_ptr(const Unit& u) const { return Bt + (size_t)u.pn * BM * K * 2; }
};
template <bool GATHER_> struct MoeSched {
    static constexpr bool GATHER = GATHER_;
    const char* A; const char* W; size_t wstride; int K, G, c; const int* elist; const volatile LAS int* T; const volatile LAS int* Cn;
    __device__ __forceinline__ bool next(int i, Unit& u) const {
        const long L = (long)i * G + c; const int nT = T[16]; if (L >= 4L * nT) return false;
        const int tile = (int)(L >> 2); u.pn = (int)(L & 3); u.pm = tile;
        int e = 0;
#pragma unroll
        for (int k = 1; k < 16; ++k) e += (tile >= T[k]) ? 1 : 0;
        u.e = e; u.j = tile - T[e]; u.cnt = Cn[e]; return true;
    }
    __device__ __forceinline__ const char* a_ptr(const Unit& u) const { return GATHER ? A : A + (size_t)u.pm * BM * K * 2; }
    __device__ __forceinline__ void a_offs(const Unit& u, const int (&Rr)[2], unsigned (&v0)[2], unsigned (&v1)[2]) const {
#pragma unroll
        for (int i = 0; i < 2; ++i) {
            const int p0 = u.j * BM + Rr[i], p1 = p0 + HALF;
            int t0 = p0 < u.cnt ? (elist[u.e * NROW + p0] >> 1) : 0, t1 = p1 < u.cnt ? (elist[u.e * NROW + p1] >> 1) : 0;
            t0 = min(max(t0, 0), NROW - 1); t1 = min(max(t1, 0), NROW - 1);
            v0[i] = (unsigned)(t0 * K * 2); v1[i] = (unsigned)(t1 * K * 2);
        } }
    __device__ __forceinline__ const char* b_ptr(const Unit& u) const { return W + (size_t)u.e * wstride + (size_t)u.pn * BM * K * 2; }
};
struct EpiP {
    static constexpr bool PERM = true;
    bf16* O;
    __device__ __forceinline__ void operator()(const f32x4 (&acc)[2][2][4][2], const Unit& u, int wr, int wc, int fr, int fq) const {
        const int row0 = u.pm * BM + wr * 64 + fr, col0 = u.pn * BM + wc * 32 + 8 * fq;
#pragma unroll
        for (int ai = 0; ai < 2; ++ai)
#pragma unroll
            for (int m = 0; m < 4; ++m) { bf16* rowp = O + (size_t)(row0 + ai * HALF + m * 16) * NP + col0;
#pragma unroll
                for (int bj = 0; bj < 2; ++bj) { const f32x4 v0 = acc[ai][bj][m][0], v1 = acc[ai][bj][m][1];
                    u32x4 w; w.x = cvt_pk_bf16(v0[0], v0[1]); w.y = cvt_pk_bf16(v0[2], v0[3]); w.z = cvt_pk_bf16(v1[0], v1[1]); w.w = cvt_pk_bf16(v1[2], v1[3]);
                    *(u32x4*)(rowp + bj * HALF) = w; } }
    }
};
struct EpiRes {
    static constexpr bool PERM = false;
    const float* hin_l; const float* hin_c; float* hout_l; float* hout_c; const float* gate; float gsc;
    __device__ __forceinline__ void operator()(const f32x4 (&acc)[2][2][4][2], const Unit& u, int wr, int wc, int fr, int fq) const {
        const int row0 = u.pm * BM + wr * 64 + fr, col0 = u.pn * BM + wc * 32 + 4 * fq;
#pragma unroll
        for (int ai = 0; ai < 2; ++ai)
#pragma unroll
            for (int m = 0; m < 4; ++m) { const int r = row0 + ai * HALF + m * 16; const bool lat = r < NLAT; const int bb = lat ? (r >> 11) : 8;
                const float* hi = lat ? hin_l + (size_t)r * DM : hin_c + (size_t)(r - NLAT) * DM; float* ho = lat ? hout_l + (size_t)r * DM : hout_c + (size_t)(r - NLAT) * DM;
                const float* g = gate + (size_t)bb * 6144;
#pragma unroll
                for (int bj = 0; bj < 2; ++bj)
#pragma unroll
                    for (int n = 0; n < 2; ++n) { const int c = col0 + bj * HALF + n * 16; const f32x4 gv = *(const f32x4*)(g + c), hv = *(const f32x4*)(hi + c);
                        *(f32x4*)(ho + c) = hv + gv * gsc * acc[ai][bj][m][n]; } }
    }
};
struct EpiAct {
    static constexpr bool PERM = true;
    bf16* O;
    __device__ __forceinline__ void operator()(const f32x4 (&acc)[2][2][4][2], const Unit& u, int wr, int wc, int fr, int fq) const {
        const int row0 = u.pm * BM + wr * 64 + fr, col0 = u.pn * HALF + wc * 32 + 8 * fq;
#pragma unroll
        for (int ai = 0; ai < 2; ++ai)
#pragma unroll
            for (int m = 0; m < 4; ++m) { bf16* rowp = O + (size_t)(row0 + ai * HALF + m * 16) * FF + col0;
                float o[8];
#pragma unroll
                for (int n = 0; n < 2; ++n)
#pragma unroll
                    for (int j = 0; j < 4; ++j) { const float g = acc[ai][0][m][n][j], up = acc[ai][1][m][n][j]; o[n * 4 + j] = g / (1.f + __expf(-g)) * up; }
                u32x4 w; w.x = cvt_pk_bf16(o[0], o[1]); w.y = cvt_pk_bf16(o[2], o[3]); w.z = cvt_pk_bf16(o[4], o[5]); w.w = cvt_pk_bf16(o[6], o[7]);
                *(u32x4*)rowp = w; }
    }
};
struct EpiDown {
    static constexpr bool PERM = true;
    bf16* O; const int* elist; const float* rtw;
    __device__ __forceinline__ void operator()(const f32x4 (&acc)[2][2][4][2], const Unit& u, int wr, int wc, int fr, int fq) const {
        const int col0 = u.pn * BM + wc * 32 + 8 * fq;
#pragma unroll
        for (int ai = 0; ai < 2; ++ai)
#pragma unroll
            for (int m = 0; m < 4; ++m) { const int pos = u.j * BM + ai * HALF + wr * 64 + m * 16 + fr;
                if (pos < u.cnt) { const int a = min(max(elist[u.e * NROW + pos], 0), 2 * NROW - 1); const float w8 = rtw[a]; bf16* rowp = O + (size_t)a * DM + col0;
#pragma unroll
                    for (int bj = 0; bj < 2; ++bj) { const f32x4 v0 = acc[ai][bj][m][0] * w8, v1 = acc[ai][bj][m][1] * w8;
                        u32x4 w; w.x = cvt_pk_bf16(v0[0], v0[1]); w.y = cvt_pk_bf16(v0[2], v0[3]); w.z = cvt_pk_bf16(v1[0], v1[1]); w.w = cvt_pk_bf16(v1[2], v1[3]);
                        *(u32x4*)(rowp + bj * HALF) = w; } } }
    }
};
}

struct Args { const float* in[36]; float* out; unsigned char* ws; int ph_lo, ph_hi; };
struct Fr {
    LAS unsigned char* lds; int tid, lane, wave, G, vcu, gw, NGW; const __attribute__((address_space(4))) Args* A;
    __device__ __forceinline__ const float* x() const { return A->in[0]; }
    __device__ __forceinline__ const float* cvec() const { return A->in[1]; }
    __device__ __forceinline__ const float* ctx() const { return A->in[2]; }
    __device__ __forceinline__ const float* cctx() const { return A->in[3]; }
    __device__ __forceinline__ const float* w_mod() const { return A->in[4]; }
    __device__ __forceinline__ const float* b_mod() const { return A->in[5]; }
    __device__ __forceinline__ const float* g_mix() const { return A->in[6]; }
    __device__ __forceinline__ const float* w_in() const { return A->in[7]; }
    __device__ __forceinline__ const float* w_out() const { return A->in[8]; }
    __device__ __forceinline__ const float* na_gq() const { return A->in[9]; }
    __device__ __forceinline__ const float* na_gk() const { return A->in[10]; }
    __device__ __forceinline__ const float* na_rb() const { return A->in[11]; }
    __device__ __forceinline__ const float* mla_gqa() const { return A->in[12]; }
    __device__ __forceinline__ const float* mla_wqb() const { return A->in[13]; }
    __device__ __forceinline__ const float* mla_gkva() const { return A->in[14]; }
    __device__ __forceinline__ const float* mla_wkvb() const { return A->in[15]; }
    __device__ __forceinline__ const float* mla_gq() const { return A->in[16]; }
    __device__ __forceinline__ const float* mla_gk() const { return A->in[17]; }
    __device__ __forceinline__ const float* df_gq() const { return A->in[18]; }
    __device__ __forceinline__ const float* df_gk() const { return A->in[19]; }
    __device__ __forceinline__ const float* df_lam() const { return A->in[20]; }
    __device__ __forceinline__ const float* df_gsub() const { return A->in[21]; }
    __device__ __forceinline__ const float* conv_w() const { return A->in[22]; }
    __device__ __forceinline__ const float* conv_b() const { return A->in[23]; }
    __device__ __forceinline__ const float* dt_bias() const { return A->in[24]; }
    __device__ __forceinline__ const float* a_log() const { return A->in[25]; }
    __device__ __forceinline__ const float* ssd_d() const { return A->in[26]; }
    __device__ __forceinline__ const float* ssd_gn() const { return A->in[27]; }
    __device__ __forceinline__ const float* g_ffn() const { return A->in[28]; }
    __device__ __forceinline__ const float* w_grp() const { return A->in[29]; }
    __device__ __forceinline__ const float* b_grp() const { return A->in[30]; }
    __device__ __forceinline__ const float* w_exp() const { return A->in[31]; }
    __device__ __forceinline__ const float* b_exp() const { return A->in[32]; }
    __device__ __forceinline__ const float* w_gate() const { return A->in[33]; }
    __device__ __forceinline__ const float* w_up() const { return A->in[34]; }
    __device__ __forceinline__ const float* w_down() const { return A->in[35]; }
    __device__ __forceinline__ float* out() const { return A->out; }
    __device__ __forceinline__ unsigned* ctl() const { return (unsigned*)(A->ws + WS_CTL); }
    __device__ __forceinline__ float* modv() const { return (float*)(A->ws + WS_MOD); }
    __device__ __forceinline__ float* rcos() const { return (float*)(A->ws + WS_ROPE); }
    __device__ __forceinline__ float* rsin() const { return (float*)(A->ws + WS_ROPE + TLAT * 16 * 4); }
    __device__ __forceinline__ bf16* winT() const { return (bf16*)(A->ws + WS_WIN); }
    __device__ __forceinline__ bf16* woutT() const { return (bf16*)(A->ws + WS_WOUT); }
    __device__ __forceinline__ bf16* wqbT() const { return (bf16*)(A->ws + WS_WQB); }
    __device__ __forceinline__ bf16* wkvbT() const { return (bf16*)(A->ws + WS_WKVB); }
    __device__ __forceinline__ bf16* wgu() const { return (bf16*)(A->ws + WS_WGU); }
    __device__ __forceinline__ bf16* wd() const { return (bf16*)(A->ws + WS_WD); }
    __device__ __forceinline__ float* hc() const { return (float*)(A->ws + WS_HC); }
    __device__ __forceinline__ bf16* abuf() const { return (bf16*)(A->ws + WS_A); }
    __device__ __forceinline__ bf16* pbuf() const { return (bf16*)(A->ws + WS_P); }
    __device__ __forceinline__ bf16* act() const { return (bf16*)(A->ws + WS_ACT); }
    __device__ __forceinline__ bf16* yk() const { return (bf16*)(A->ws + WS_YK); }
    __device__ __forceinline__ bf16* mix() const { return (bf16*)(A->ws + WS_MIX); }
    __device__ __forceinline__ bf16* qna() const { return (bf16*)(A->ws + WS_QNA); }
    __device__ __forceinline__ bf16* kna() const { return (bf16*)(A->ws + WS_KNA); }
    __device__ __forceinline__ bf16* vna() const { return (bf16*)(A->ws + WS_VNA); }
    __device__ __forceinline__ bf16* qml() const { return (bf16*)(A->ws + WS_QML); }
    __device__ __forceinline__ bf16* kml() const { return (bf16*)(A->ws + WS_KML); }
    __device__ __forceinline__ bf16* vml() const { return (bf16*)(A->ws + WS_VML); }
    __device__ __forceinline__ bf16* qdf() const { return (bf16*)(A->ws + WS_QDF); }
    __device__ __forceinline__ bf16* kdf() const { return (bf16*)(A->ws + WS_KDF); }
    __device__ __forceinline__ bf16* vdf() const { return (bf16*)(A->ws + WS_VDF); }
    __device__ __forceinline__ bf16* xT() const { return (bf16*)(A->ws + WS_XT); }
    __device__ __forceinline__ bf16* btm() const { return (bf16*)(A->ws + WS_BTM); }
    __device__ __forceinline__ bf16* bT() const { return (bf16*)(A->ws + WS_BT); }
    __device__ __forceinline__ bf16* ctm() const { return (bf16*)(A->ws + WS_CTM); }
    __device__ __forceinline__ float* dtv() const { return (float*)(A->ws + WS_DT); }
    __device__ __forceinline__ float* cst() const { return (float*)(A->ws + WS_CST); }
    __device__ __forceinline__ float* cdec() const { return (float*)(A->ws + WS_CDEC); }
    __device__ __forceinline__ bf16* hent() const { return (bf16*)(A->ws + WS_HENT); }
    __device__ __forceinline__ float* ydir() const { return (float*)(A->ws + WS_CST); }
    __device__ __forceinline__ int* rte() const { return (int*)(A->ws + WS_RT); }
    __device__ __forceinline__ float* rtw() const { return (float*)(A->ws + WS_RT + 256 * 1024); }
    __device__ __forceinline__ int* elist() const { return (int*)(A->ws + WS_ELIST); }
};

__device__ __forceinline__ Fr refresh(const Fr& F0) { Fr F = F0; int w = F0.wave; asm volatile("" : "+s"(w)); asm volatile("" : "+s"(F.A));
    int l; asm volatile("v_mbcnt_lo_u32_b32 %0, -1, 0\n\tv_mbcnt_hi_u32_b32 %0, -1, %0" : "=v"(l)); F.wave = w; F.lane = l; F.tid = w * 64 + l; F.gw = F.vcu * 8 + w; return F; }
__device__ __forceinline__ void tr_item(const float* W, int ldw, int nvalid, int k0, int n0, bf16* dst, int ldd, LAS float* scr, int lane, const float* ksc = nullptr) {
    const int cn = n0 + (lane & 31), cnc = min(cn, nvalid - 1);
    float tv[32];
#pragma unroll
    for (int i = 0; i < 32; ++i) { const int kk = 2 * i + (lane >> 5); tv[i] = W[(size_t)(k0 + kk) * ldw + cnc]; }
#pragma unroll
    for (int i = 0; i < 32; ++i) { const int kk = 2 * i + (lane >> 5); const float sc1 = ksc ? ksc[k0 + kk] : 1.f; scr[kk * 33 + (lane & 31)] = cn < nvalid ? tv[i] * sc1 : 0.f; }
    LDS_WAIT();
    const int c = lane & 7;
#pragma unroll
    for (int j = 0; j < 4; ++j) { const int n = (lane >> 3) + 8 * j; const LAS float* s = scr + (8 * c) * 33 + n;
        u32x4 o; o.x = pk2(s[0 * 33], s[1 * 33]); o.y = pk2(s[2 * 33], s[3 * 33]); o.z = pk2(s[4 * 33], s[5 * 33]); o.w = pk2(s[6 * 33], s[7 * 33]);
        *(u32x4*)(dst + (size_t)n * ldd + k0 + 8 * c) = o; }
    LDS_WAIT();
}
__device__ __forceinline__ void moe_weight_convert(const Fr& F, int L) {
    LAS float* scr = (LAS float*)(F.lds + F.wave * 16384);
    constexpr int I_GU = 16 * 16, I_D = 8 * 32;
    for (int it = F.gw; it < NEXP * (2 * I_GU + I_D); it += F.NGW) {
        const int e = it / (2 * I_GU + I_D); int r = it % (2 * I_GU + I_D);
        if (r < 2 * I_GU) { const int bj = r / I_GU; r %= I_GU; const int kb = r / 16, nb = r % 16, n0 = nb * 32;
            const float* W = (bj ? F.w_up() : F.w_gate()) + ((size_t)L * NEXP + e) * DM * FF;
            tr_item(W, FF, FF, kb * 64, n0, F.wgu() + ((size_t)e * 1024 + (n0 >> 7) * 256 + bj * 128 + (n0 & 127)) * DM, DM, scr, F.lane);
        } else { r -= 2 * I_GU; const int kb = r / 32, nb = r % 32, n0 = nb * 32;
            const float* W = F.w_down() + ((size_t)L * NEXP + e) * FF * DM;
            tr_item(W, DM, DM, kb * 64, n0, F.wd() + ((size_t)e * 1024 + n0) * FF, FF, scr, F.lane); }
    }
}
__device__ __forceinline__ void phase_prologue(const Fr& F) {
    {   LAS float* sc = (LAS float*)F.lds;
        LAS float* part = (LAS float*)(F.lds + 40960);
        for (int i = F.tid; i < 9 * 1024; i += 512) { const float v = i < 8192 ? F.cvec()[i] : F.cctx()[i - 8192]; sc[i] = siluf(v); }
        __syncthreads();
        for (int u = F.vcu; u < 384; u += F.G) {
            const int col = u * 64 + F.lane, L = col / 6144, n = col - L * 6144;
            const float* w = F.w_mod() + ((size_t)L * 1024 + F.wave * 128) * 6144 + n;
            float acc[9];
#pragma unroll
            for (int b = 0; b < 9; ++b) acc[b] = 0.f;
#pragma unroll 1
            for (int k0 = 0; k0 < 128; k0 += 16) { float wv[16];
#pragma unroll
                for (int j = 0; j < 16; ++j) wv[j] = w[(size_t)(k0 + j) * 6144];
#pragma unroll
                for (int j = 0; j < 16; ++j)
#pragma unroll
                    for (int b = 0; b < 9; ++b) acc[b] += sc[b * 1024 + F.wave * 128 + k0 + j] * wv[j]; }
#pragma unroll
            for (int b = 0; b < 9; ++b) part[(F.wave * 9 + b) * 64 + F.lane] = acc[b];
            __syncthreads();
            for (int i = F.tid; i < 9 * 64; i += 512) { const int b = i >> 6, l = i & 63; float s = 0.f;
#pragma unroll
                for (int w8 = 0; w8 < 8; ++w8) s += part[(w8 * 9 + b) * 64 + l];
                const int c2 = u * 64 + l, L2 = c2 / 6144, n2 = c2 - L2 * 6144;
                F.modv()[((size_t)L2 * 9 + b) * 6144 + n2] = s + F.b_mod()[L2 * 6144 + n2]; }
            __syncthreads();
        }
    }
    if (blockIdx.x == 0 && F.wave < 4) {
#pragma unroll 1
        for (int q = 0; q < 4; ++q) { const int lh = F.wave * 4 + q; float bm = 0.f;
            for (int i = F.lane; i < 465; i += 64) bm = fmaxf(bm, F.na_rb()[lh * 465 + i]);
            bm = wmaxf(bm); if (F.lane == 0) (F.rcos() + 2 * TLAT * 16)[lh] = bm * 1.4426950408889634f; } }
    for (int i = blockIdx.x * 512 + F.tid; i < TLAT * 16; i += F.G * 512) { const int t = i >> 4, k = i & 15; const float inv = powf(10000.f, -(float)(k & 7) / 8.f);
        const float pos = (k < 8) ? (float)(t >> 6) : (float)(t & 63); const float ang = pos * inv; F.rcos()[i] = cosf(ang); F.rsin()[i] = sinf(ang); }
    __syncthreads();
    LAS float* scr = (LAS float*)(F.lds + F.wave * 16384);
    constexpr int I_IN = 16 * 96, I_OUT = 16 * 32, I_QB = 4 * 12, I_KVB = 2 * 16, I_L = I_IN + I_OUT + I_QB + I_KVB;
    for (int it = F.gw; it < DEPTH * I_L; it += F.NGW) {
        const int L = it / I_L; int r = it % I_L;
        if (r < I_IN) { const int kb = r / 96, nb = r % 96; tr_item(F.w_in() + (size_t)L * DM * NIN, NIN, NIN, kb * 64, nb * 32, F.winT() + ((size_t)L * NP + nb * 32) * DM, DM, scr, F.lane); continue; } r -= I_IN;
        if (r < I_OUT) { const int kb = r / 32, nb = r % 32; tr_item(F.w_out() + (size_t)L * DM * DM, DM, DM, kb * 64, nb * 32, F.woutT() + ((size_t)L * DM + nb * 32) * DM, DM, scr, F.lane); continue; } r -= I_OUT;
        if (r < I_QB) { const int kb = r / 12, nb = r % 12; tr_item(F.mla_wqb() + (size_t)L * 256 * 384, 384, 384, kb * 64, nb * 32, F.wqbT() + ((size_t)L * 384 + nb * 32) * 256, 256, scr, F.lane, F.mla_gqa() + L * 256); continue; } r -= I_QB;
        { const int kb = r / 16, nb = r % 16; tr_item(F.mla_wkvb() + (size_t)L * 128 * 512, 512, 512, kb * 64, nb * 32, F.wkvbT() + ((size_t)L * 512 + nb * 32) * 128, 128, scr, F.lane, F.mla_gkva() + L * 128); }
    }
}

__device__ __forceinline__ void phase_norm(const Fr& F, int L, bool combine = true) {
    const int nrows = (L == DEPTH) ? NLAT : NROW;
    for (int r = F.gw; r < nrows; r += F.NGW) {
        const bool lat = r < NLAT; const int bb = lat ? (r >> 11) : 8;
        const float* hin = (L == 0) ? (lat ? F.x() + (size_t)r * DM : F.ctx() + (size_t)(r - NLAT) * DM) : (lat ? F.out() + (size_t)r * DM : F.hc() + (size_t)(r - NLAT) * DM);
        float* hout = lat ? F.out() + (size_t)r * DM : F.hc() + (size_t)(r - NLAT) * DM;
        f32x4 v[4];
#pragma unroll
        for (int j = 0; j < 4; ++j) v[j] = *(const f32x4*)(hin + 4 * F.lane + 256 * j);
        if (L > 0 && combine) {
            const float* m5 = F.modv() + ((size_t)(L - 1) * 9 + bb) * 6144 + 5 * 1024;
#pragma unroll
            for (int j = 0; j < 4; ++j) { const int c = 4 * F.lane + 256 * j; const f32x4 g = *(const f32x4*)(m5 + c);
                const u32x2 y0 = *(const u32x2*)(F.yk() + (size_t)(2 * r) * DM + c), y1 = *(const u32x2*)(F.yk() + (size_t)(2 * r + 1) * DM + c);
                f32x4 ys; ys[0] = __uint_as_float(y0.x << 16) + __uint_as_float(y1.x << 16); ys[1] = __uint_as_float(y0.x & 0xffff0000u) + __uint_as_float(y1.x & 0xffff0000u);
                ys[2] = __uint_as_float(y0.y << 16) + __uint_as_float(y1.y << 16); ys[3] = __uint_as_float(y0.y & 0xffff0000u) + __uint_as_float(y1.y & 0xffff0000u);
                v[j] = v[j] + g * ys; *(f32x4*)(hout + c) = v[j]; }
        }
        if (L == DEPTH) continue;
        float ss = 0.f;
#pragma unroll
        for (int j = 0; j < 4; ++j) ss += (v[j][0] * v[j][0] + v[j][1] * v[j][1]) + (v[j][2] * v[j][2] + v[j][3] * v[j][3]);
        const float rstd = rsqrtf(wsum(ss) * (1.f / DM) + EPS);
        const float* md = F.modv() + ((size_t)L * 9 + bb) * 6144;
#pragma unroll
        for (int j = 0; j < 4; ++j) { const int c = 4 * F.lane + 256 * j; const f32x4 g = *(const f32x4*)(F.g_mix() + L * DM + c), sh = *(const f32x4*)(md + c), scl = *(const f32x4*)(md + 1024 + c);
            const f32x4 a = v[j] * rstd * g * (scl + 1.f) + sh; u32x2 o; o.x = pk2(a[0], a[1]); o.y = pk2(a[2], a[3]); *(u32x2*)(F.abuf() + (size_t)r * DM + c) = o; }
    }
}

__device__ __forceinline__ void prep_row(const Fr& F, int L, int r, LAS float* scr) {
    int lane_ = F.lane; asm volatile("" : "+v"(lane_)); const int lane = lane_; int b, s; row2bs(r, b, s); const bool lat = r < NLAT; const int t = s - 256;
    const bf16* p = F.pbuf() + (size_t)r * NP;
#pragma unroll
    for (int h = 0; h < 4; ++h) {
        const float q = bf2f(p[C_NA + h * 64 + lane]), k = bf2f(p[C_NA + 256 + h * 64 + lane]);
        const float rq = rsqrtf(wsum(q * q) * (1.f / 64) + EPS), rk = rsqrtf(wsum(k * k) * (1.f / 64) + EPS);
        const size_t o = ((size_t)(b * 4 + h) * SQ + s) * 64 + lane;
        F.qna()[o] = f2bf(q * rq * F.na_gq()[L * 64 + lane]); F.kna()[o] = f2bf(k * rk * F.na_gk()[L * 64 + lane]);
    }
    {
        const int idx = lane & 31; float cs = 1.f, sn = 0.f;
        if (lat) { cs = F.rcos()[t * 16 + (idx & 15)]; sn = F.rsin()[t * 16 + (idx & 15)]; }
#pragma unroll
        for (int h = 0; h < 4; ++h) {
            float q = bf2f(p[C_DF + h * 64 + lane]), k = bf2f(p[C_DF + 256 + h * 64 + lane]);
            float sq = q * q, sk = k * k;
#pragma unroll
            for (int o = 16; o >= 1; o >>= 1) { sq += __shfl_xor(sq, o); sk += __shfl_xor(sk, o); }
            q *= rsqrtf(sq * (1.f / 32) + EPS) * F.df_gq()[L * 32 + idx]; k *= rsqrtf(sk * (1.f / 32) + EPS) * F.df_gk()[L * 32 + idx];
            const float qp = __shfl_xor(q, 16), kp = __shfl_xor(k, 16);
            if (lat) { q = (idx < 16) ? q * cs - qp * sn : qp * sn + q * cs; k = (idx < 16) ? k * cs - kp * sn : kp * sn + k * cs; }
            const size_t o = ((size_t)(b * 4 + h) * SQ + s) * 64 + lane;
            F.qdf()[o] = f2bf(q); F.kdf()[o] = f2bf(k);
        }
    }
}
__device__ __forceinline__ void prep_tile(const Fr& F, int L, int b, int c) {
    int tid_ = F.tid; asm volatile("" : "+v"(tid_)); const int tid = tid_;
    const int s0 = 64 * c; const size_t r0 = bs2row(b, s0);
    LAS bf16* Lv = (LAS bf16*)F.lds;
#ifndef PT_MASK
#define PT_MASK 7
#endif
    if (PT_MASK & 1)
#pragma unroll 1
    for (int mx = 0; mx < 2; ++mx) {
        const int voff = mx == 0 ? C_NA + 512 : C_DF + 512; bf16* vt = mx == 0 ? F.vna() : F.vdf();
#pragma unroll
        for (int k = 0; k < 4; ++k) { const int idx = tid + 512 * k, tok = idx >> 5, d8 = (idx & 31) * 8;
            const u32x4 v = *(const u32x4*)(F.pbuf() + (r0 + tok) * NP + voff + d8); const int pc = vpos(tok);
#pragma unroll
            for (int e = 0; e < 4; ++e) { Lv[(d8 + 2 * e) * 72 + pc] = (bf16)(v[e] & 0xffffu); Lv[(d8 + 2 * e + 1) * 72 + pc] = (bf16)(v[e] >> 16); } }
        __syncthreads();
#pragma unroll
        for (int k = 0; k < 4; ++k) { const int idx = tid + 512 * k, dv = idx >> 3, pc = idx & 7;
            const u32x4 v = *(const LAS u32x4*)(Lv + dv * 72 + pc * 8);
#ifndef PT_NOSTORE
#define PT_NOSTORE 0
#endif
            if (!PT_NOSTORE || v.x == 0x12345678u) *(u32x4*)(vt + ((size_t)(b * 4 + (dv >> 6)) * 64 + (dv & 63)) * SQ + s0 + pc * 8) = v; }
        __syncthreads();
    }
    const int len = c < 4 ? TCTX : TLAT, t0 = c < 4 ? s0 : s0 - 256;
    LAS bf16* Lc = (LAS bf16*)F.lds;
    if (PT_MASK & 2)
#pragma unroll 1
    for (int gch = 0; gch < 3; ++gch) {
        {   u32x4 v[5];
#pragma unroll
            for (int k = 0; k < 5; ++k) { const int idx = min(tid + 512 * k, 68 * 32 - 1), j = idx >> 5, c8 = (idx & 31) * 8, tj = t0 - 2 + j, jc = min(max(tj, 0), len - 1) - t0;
                v[k] = *(const u32x4*)(F.pbuf() + (size_t)((long)r0 + jc) * NP + C_XBC + gch * 256 + c8);
                const unsigned keep = (tj >= 0 && tj < len) ? 0xffffffffu : 0u; v[k].x &= keep; v[k].y &= keep; v[k].z &= keep; v[k].w &= keep; }
#pragma unroll
            for (int k = 0; k < 5; ++k) { const int idx = tid + 512 * k, j = idx >> 5, c8 = (idx & 31) * 8; if (idx < 68 * 32) *(LAS u32x4*)(Lc + j * 256 + c8) = v[k]; }
        }
        __syncthreads();
        const int ch = tid & 255, tq = tid >> 8, cg = gch * 256 + ch;
        float w[5];
#pragma unroll
        for (int j = 0; j < 5; ++j) w[j] = F.conv_w()[(L * 5 + j) * 768 + cg];
        const float bias = F.conv_b()[L * 768 + cg];
        const LAS bf16* lp = Lc + (32 * tq) * 256 + ch;
        float x0 = bf2f(lp[0]), x1 = bf2f(lp[256]), x2 = bf2f(lp[512]), x3 = bf2f(lp[768]);
        bf16* tm = (gch == 1 ? F.btm() : F.ctm()) + ((size_t)b * SQ + s0 + 32 * tq) * 256 + ch;
        bf16* cm = (gch == 0 ? F.xT() : F.bT()) + ((size_t)b * 256 + ch) * SQ + s0 + 32 * tq;
#pragma unroll
        for (int g8 = 0; g8 < 4; ++g8) { unsigned pk[4];
#pragma unroll
            for (int e = 0; e < 8; ++e) { const int i = 8 * g8 + e; const float x4 = bf2f(lp[(i + 4) * 256]);
                const float acc = bias + w[0] * x0 + w[1] * x1 + w[2] * x2 + w[3] * x3 + w[4] * x4; const unsigned o = f2bf(siluf(acc));
                if (gch >= 1) tm[(size_t)i * 256] = (bf16)o;
                if (e & 1) pk[e >> 1] |= o << 16; else pk[e >> 1] = o;
                x0 = x1; x1 = x2; x2 = x3; x3 = x4; }
            if (gch <= 1) { u32x4 v; v.x = pk[0]; v.y = pk[1]; v.z = pk[2]; v.w = pk[3]; *(u32x4*)(cm + 8 * g8) = v; } }
        __syncthreads();
    }
    if (PT_MASK & 4) { const int tok = tid >> 3, i = tid & 7; const float raw = bf2f(F.pbuf()[(r0 + tok) * NP + C_DT + i]) + F.dt_bias()[L * 8 + i]; const float ex = __expf(raw);
      F.dtv()[((size_t)b * 8 + i) * SQ + s0 + tok] = raw > 20.f ? raw : (ex < 0.03f ? ex * (1.f - ex * (0.5f - ex * (0.33333334f - 0.25f * ex))) : __logf(1.f + ex)); }
}
__device__ __forceinline__ void mla_prep_block(const Fr& F, int L, int b, int j32) {
    int lane_ = F.lane; asm volatile("" : "+v"(lane_));
    const int lane = lane_, wave = F.wave, r = lane & 31, hh = lane >> 5, s = 32 * j32 + r, t = s - 256; const bool lat = s >= 256;
    const size_t row = bs2row(b, s);
    const bf16* p = F.pbuf() + row * NP + C_MLA;
    const int tt = lat ? t : 0; const float latf = lat ? 1.f : 0.f;
    if (wave < 4) {
        const int hq = wave;
        bf16x8 Bq[16]; float ss = 0.f;
#pragma unroll
        for (int kk = 0; kk < 16; ++kk) { Bq[kk] = *(const bf16x8*)(p + 16 * kk + 8 * hh);
#pragma unroll
            for (int j = 0; j < 8; ++j) { const float v = bf2f((bf16)Bq[kk][j]); ss += v * v; } }
        ss += __shfl_xor(ss, 32); const float rq = rsqrtf(ss * (1.f / 256) + EPS);
        f32x16 acc[3]; float hs = 0.f;
#pragma unroll
        for (int j3 = 0; j3 < 3; ++j3) {
#pragma unroll
            for (int i = 0; i < 16; ++i) acc[j3][i] = 0.f;
            const bf16* wp = F.wqbT() + ((size_t)L * 384 + 96 * hq + 32 * j3 + r) * 256 + 8 * hh;
#pragma unroll
            for (int kk = 0; kk < 16; ++kk) acc[j3] = MFMA32(*(const bf16x8*)(wp + 16 * kk), Bq[kk], acc[j3]);
            asm volatile("" ::: "memory");
#pragma unroll
            for (int i = 0; i < 16; ++i) hs += acc[j3][i] * acc[j3][i]; }
        hs = (hs + __shfl_xor(hs, 32)) * rq * rq; const float rs = rsqrtf(hs * (1.f / 96) + EPS) * rq;
        bf16* qo = F.qml() + ((size_t)(b * 4 + hq) * SQ + s) * 96 + 4 * hh;
#pragma unroll
        for (int j3 = 0; j3 < 3; ++j3) {
#pragma unroll
            for (int i = 0; i < 16; ++i) acc[j3][i] *= rs * F.mla_gq()[L * 96 + 32 * j3 + crow16(i, hh)];
            if (j3 == 2) {
#pragma unroll
                for (int i = 0; i < 8; ++i) { const float rc = lat ? F.rcos()[tt * 16 + crow16(i, hh)] : 1.f, rsn = F.rsin()[tt * 16 + crow16(i, hh)] * latf;
                    const float x1 = acc[2][i], x2 = acc[2][i + 8]; acc[2][i] = x1 * rc - x2 * rsn; acc[2][i + 8] = x1 * rsn + x2 * rc; } }
#pragma unroll
            for (int g = 0; g < 4; ++g) { u32x2 w; w.x = pk2(acc[j3][4 * g], acc[j3][4 * g + 1]); w.y = pk2(acc[j3][4 * g + 2], acc[j3][4 * g + 3]); *(u32x2*)(qo + 32 * j3 + 8 * g) = w; } }
    } else {
        const int hk = wave - 4;
        LAS unsigned char* wl = F.lds + wave * 16384;
        bf16x8 Bkv[8]; float ss = 0.f;
#pragma unroll
        for (int kk = 0; kk < 8; ++kk) { Bkv[kk] = *(const bf16x8*)(p + 256 + 16 * kk + 8 * hh);
#pragma unroll
            for (int j = 0; j < 8; ++j) { const float v = bf2f((bf16)Bkv[kk][j]); ss += v * v; } }
        ss += __shfl_xor(ss, 32); const float rk = rsqrtf(ss * (1.f / 128) + EPS);
        float kr[16]; float hs = 0.f;
#pragma unroll
        for (int g = 0; g < 4; ++g) { const u32x2 k4 = *(const u32x2*)(p + 384 + 8 * g + 4 * hh);
            kr[4 * g] = __uint_as_float(k4.x << 16); kr[4 * g + 1] = __uint_as_float(k4.x & 0xffff0000u); kr[4 * g + 2] = __uint_as_float(k4.y << 16); kr[4 * g + 3] = __uint_as_float(k4.y & 0xffff0000u); }
#pragma unroll
        for (int i = 0; i < 16; ++i) hs += kr[i] * kr[i];
        f32x16 acc[4]; float ks = 0.f;
#pragma unroll
        for (int j4 = 0; j4 < 4; ++j4) {
#pragma unroll
            for (int i = 0; i < 16; ++i) acc[j4][i] = 0.f;
            const bf16* wp = F.wkvbT() + ((size_t)L * 512 + 128 * hk + 32 * j4 + r) * 128 + 8 * hh;
#pragma unroll
            for (int kk = 0; kk < 8; ++kk) acc[j4] = MFMA32(*(const bf16x8*)(wp + 16 * kk), Bkv[kk], acc[j4]);
            asm volatile("" ::: "memory");
            if (j4 < 2) {
#pragma unroll
                for (int i = 0; i < 16; ++i) ks += acc[j4][i] * acc[j4][i]; } }
        hs += ks * rk * rk; hs += __shfl_xor(hs, 32); const float rs = rsqrtf(hs * (1.f / 96) + EPS);
        bf16* ko = F.kml() + ((size_t)(b * 4 + hk) * SQ + s) * 96 + 4 * hh;
#pragma unroll
        for (int j2 = 0; j2 < 2; ++j2) {
#pragma unroll
            for (int i = 0; i < 16; ++i) acc[j2][i] *= rs * rk * F.mla_gk()[L * 96 + 32 * j2 + crow16(i, hh)];
#pragma unroll
            for (int g = 0; g < 4; ++g) { u32x2 w; w.x = pk2(acc[j2][4 * g], acc[j2][4 * g + 1]); w.y = pk2(acc[j2][4 * g + 2], acc[j2][4 * g + 3]); *(u32x2*)(ko + 32 * j2 + 8 * g) = w; } }
#pragma unroll
        for (int i = 0; i < 16; ++i) kr[i] *= rs * F.mla_gk()[L * 96 + 64 + crow16(i, hh)];
#pragma unroll
        for (int i = 0; i < 8; ++i) { const float rc = lat ? F.rcos()[tt * 16 + crow16(i, hh)] : 1.f, rsn = F.rsin()[tt * 16 + crow16(i, hh)] * latf;
            const float x1 = kr[i], x2 = kr[i + 8]; kr[i] = x1 * rc - x2 * rsn; kr[i + 8] = x1 * rsn + x2 * rc; }
#pragma unroll
        for (int g = 0; g < 4; ++g) { u32x2 w; w.x = pk2(kr[4 * g], kr[4 * g + 1]); w.y = pk2(kr[4 * g + 2], kr[4 * g + 3]); *(u32x2*)(ko + 64 + 8 * g) = w; }
        { float n2 = 0.f;
#pragma unroll
          for (int i = 0; i < 16; ++i) n2 += acc[0][i] * acc[0][i] + acc[1][i] * acc[1][i] + kr[i] * kr[i];
          n2 += __shfl_xor(n2, 32); n2 = wmaxf(n2);
          if (lane == 0) atomicMax(F.ctl() + CW_KMAX + ((L * 3 + 1) * 8 + b) * 8 + hk * 2, __float_as_uint(n2 * 1.02f)); }
        LAS bf16* vl = (LAS bf16*)wl;
#pragma unroll
        for (int mt = 0; mt < 2; ++mt)
#pragma unroll
            for (int i = 0; i < 16; ++i) vl[(32 * mt + crow16(i, hh)) * 40 + vpos(r)] = f2bf(acc[2 + mt][i] * rk);
        LDS_WAIT();
        { const LAS u32x4* src4 = (const LAS u32x4*)(wl + lane * 80); u32x4* dst = (u32x4*)(F.vml() + ((size_t)(b * 4 + hk) * 64 + lane) * SQ + 32 * j32);
#pragma unroll
          for (int q = 0; q < 4; ++q) dst[q] = src4[q]; }
        LDS_WAIT();
    }
}
__device__ __forceinline__ int grab_unit(const Fr& F, unsigned* ctr) {
    volatile LAS int* slot = (volatile LAS int*)(F.lds + LDSCTL_OFF + 256);
    __syncthreads();
    if (F.tid == 0) *slot = (int)__hip_atomic_fetch_add(ctr, 1u, __ATOMIC_RELAXED, __HIP_MEMORY_SCOPE_AGENT);
    __syncthreads();
    return __builtin_amdgcn_readfirstlane(*slot);
}
__device__ __forceinline__ void prep_qk(const Fr& F, int L, int b, int j32) {
    int lane_ = F.lane; asm volatile("" : "+v"(lane_)); const int l = lane_, h = l >> 4;
    u32x2 raw[4][4];
#pragma unroll
    for (int i = 0; i < 4; ++i) { const int s = 32 * j32 + 4 * F.wave + i; const bf16* p = F.pbuf() + (size_t)bs2row(b, s) * NP + 4 * l;
        raw[i][0] = *(const u32x2*)(p + C_NA); raw[i][1] = *(const u32x2*)(p + C_NA + 256); raw[i][2] = *(const u32x2*)(p + C_DF); raw[i][3] = *(const u32x2*)(p + C_DF + 256); }
    const f32x4 gnq = *(const f32x4*)(F.na_gq() + L * 64 + 4 * (l & 15)), gnk = *(const f32x4*)(F.na_gk() + L * 64 + 4 * (l & 15));
    const f32x4 gdq = *(const f32x4*)(F.df_gq() + L * 32 + 4 * (l & 7)), gdk = *(const f32x4*)(F.df_gk() + L * 32 + 4 * (l & 7));
    float kmx_na = 0.f, kmx_df = 0.f;
#pragma unroll
    for (int i = 0; i < 4; ++i) { const int s = 32 * j32 + 4 * F.wave + i, t = s - 256; const bool lat = s >= 256;
#pragma unroll
        for (int w = 0; w < 4; ++w) {
            f32x4 x; x[0] = __uint_as_float(raw[i][w].x << 16); x[1] = __uint_as_float(raw[i][w].x & 0xffff0000u); x[2] = __uint_as_float(raw[i][w].y << 16); x[3] = __uint_as_float(raw[i][w].y & 0xffff0000u);
            float ss = (x[0] * x[0] + x[1] * x[1]) + (x[2] * x[2] + x[3] * x[3]);
            ss += dppf<0xB1>(ss); ss += dppf<0x4E>(ss); ss += dppf<0x141>(ss);
            if (w < 2) { ss += dppf<0x140>(ss);
                const float rs = rsqrtf(ss * (1.f / 64) + EPS); const f32x4 g = w == 0 ? gnq : gnk; x = x * rs * g;
                u32x2 o; o.x = pk2(x[0], x[1]); o.y = pk2(x[2], x[3]);
                if (w == 1) { float n2 = (x[0] * x[0] + x[1] * x[1]) + (x[2] * x[2] + x[3] * x[3]); n2 += dppf<0xB1>(n2); n2 += dppf<0x4E>(n2); n2 += dppf<0x141>(n2); n2 += dppf<0x140>(n2); kmx_na = fmaxf(kmx_na, n2); }
                *(u32x2*)((w == 0 ? F.qna() : F.kna()) + ((size_t)(b * 4 + h) * SQ + s) * 64 + 4 * (l & 15)) = o;
            } else {
                const float rs = rsqrtf(ss * (1.f / 32) + EPS); const f32x4 g = w == 2 ? gdq : gdk; x = x * rs * g;
                f32x4 xp; xp[0] = __shfl_xor(x[0], 4); xp[1] = __shfl_xor(x[1], 4); xp[2] = __shfl_xor(x[2], 4); xp[3] = __shfl_xor(x[3], 4);
                if (lat) { const f32x4 cs = *(const f32x4*)(F.rcos() + t * 16 + 4 * (l & 3)), sn = *(const f32x4*)(F.rsin() + t * 16 + 4 * (l & 3));
                    x = (l & 4) ? xp * sn + x * cs : x * cs - xp * sn; }
                u32x2 o; o.x = pk2(x[0], x[1]); o.y = pk2(x[2], x[3]);
                if (w == 3) { float n2 = (x[0] * x[0] + x[1] * x[1]) + (x[2] * x[2] + x[3] * x[3]); n2 += dppf<0xB1>(n2); n2 += dppf<0x4E>(n2); n2 += dppf<0x141>(n2); kmx_df = fmaxf(kmx_df, n2); }
                *(u32x2*)((w == 2 ? F.qdf() : F.kdf()) + ((size_t)(b * 4 + h) * SQ + s) * 64 + 4 * (l & 15)) = o;
            } } }
    if ((l & 15) == 0) atomicMax(F.ctl() + CW_KMAX + ((L * 3 + 0) * 8 + b) * 8 + h * 2, __float_as_uint(kmx_na * 1.02f));
    if ((l & 7) == 0) atomicMax(F.ctl() + CW_KMAX + ((L * 3 + 2) * 8 + b) * 8 + h * 2 + ((l >> 3) & 1), __float_as_uint(kmx_df * 1.02f));
}
__device__ __forceinline__ void prep_vconv(const Fr& F, int L, int b, int j32) {
    int tid_ = F.tid; asm volatile("; VCONV_BEGIN" : "+v"(tid_)); const int tid = tid_;
    const int s0 = 32 * j32; const size_t r0 = bs2row(b, s0);
    LAS bf16* Lv = (LAS bf16*)F.lds;
#ifndef VC_MASK
#define VC_MASK 7
#endif
    if (VC_MASK & 1) {   u32x4 v[4];
#pragma unroll
        for (int k = 0; k < 4; ++k) { const int idx = tid + 512 * k, mx = idx >> 10, tok = (idx >> 5) & 31, d8 = (idx & 31) * 8;
            v[k] = *(const u32x4*)(F.pbuf() + (r0 + tok) * NP + (mx ? C_DF + 512 : C_NA + 512) + d8); }
#pragma unroll
        for (int k = 0; k < 4; ++k) { const int idx = tid + 512 * k, mx = idx >> 10, tok = (idx >> 5) & 31, d8 = (idx & 31) * 8, pc = vpos(tok);
#pragma unroll
            for (int e = 0; e < 4; ++e) { Lv[(mx * 256 + d8 + 2 * e) * 40 + pc] = (bf16)(v[k][e] & 0xffffu); Lv[(mx * 256 + d8 + 2 * e + 1) * 40 + pc] = (bf16)(v[k][e] >> 16); } }
        __syncthreads();
#pragma unroll
        for (int k = 0; k < 4; ++k) { const int idx = tid + 512 * k, mx = idx >> 10, dv = (idx >> 2) & 255, pc = idx & 3;
            const u32x4 w = *(const LAS u32x4*)(Lv + (mx * 256 + dv) * 40 + pc * 8);
            *(u32x4*)((mx ? F.vdf() : F.vna()) + ((size_t)(b * 4 + (dv >> 6)) * 64 + (dv & 63)) * SQ + s0 + pc * 8) = w; }
        __syncthreads();
    }
    const bool isctx = s0 < 256; const int len = isctx ? TCTX : TLAT, t0 = isctx ? s0 : s0 - 256;
    LAS bf16* Lc = (LAS bf16*)F.lds;
    if (VC_MASK & 2) {   u32x4 v[7];
#pragma unroll
        for (int k = 0; k < 7; ++k) { const int idx = tid + 512 * k, j = idx / 96, c8 = (idx - 96 * j) * 8, tj = t0 - 2 + j; const int jc = min(max(tj, 0), len - 1) - t0;
            v[k] = (u32x4){0u, 0u, 0u, 0u};
            if (idx < 36 * 96) { v[k] = *(const u32x4*)(F.pbuf() + (size_t)((long)r0 + jc) * NP + C_XBC + c8); if (tj < 0 || tj >= len) v[k] = (u32x4){0u, 0u, 0u, 0u}; } }
#pragma unroll
        for (int k = 0; k < 7; ++k) { const int idx = tid + 512 * k, j = idx / 96, c8 = (idx - 96 * j) * 8; if (idx < 36 * 96) *(LAS u32x4*)(Lc + j * 768 + c8) = v[k]; }
    }
    __syncthreads();
    if (VC_MASK & 2)
#pragma unroll 1
    for (int pass = 0; pass < 2; ++pass) {
        const int cg = pass == 0 ? tid : 512 + tid;
        if (cg < 768) {
            float w[5];
#pragma unroll
            for (int j = 0; j < 5; ++j) w[j] = F.conv_w()[(L * 5 + j) * 768 + cg];
            const float bias = F.conv_b()[L * 768 + cg];
            const LAS bf16* lp = Lc + cg;
            float x0 = bf2f(lp[0]), x1 = bf2f(lp[768]), x2 = bf2f(lp[2 * 768]), x3 = bf2f(lp[3 * 768]);
            const int gch = cg >> 8, ch = cg & 255;
            bf16* tm = (gch == 1 ? F.btm() : F.ctm()) + ((size_t)b * SQ + s0) * 256 + ch;
            bf16* cm = (gch == 0 ? F.xT() : F.bT()) + ((size_t)b * 256 + ch) * SQ + s0;
#pragma unroll
            for (int g8 = 0; g8 < 4; ++g8) { unsigned pk[4];
#pragma unroll
                for (int e = 0; e < 8; ++e) { const int i = 8 * g8 + e; const float x4 = bf2f(lp[(i + 4) * 768]);
                    const float acc = bias + w[0] * x0 + w[1] * x1 + w[2] * x2 + w[3] * x3 + w[4] * x4; const unsigned o = f2bf(siluf(acc));
                    if (gch >= 1) tm[(size_t)i * 256] = (bf16)o;
                    if (e & 1) pk[e >> 1] |= o << 16; else pk[e >> 1] = o;
                    x0 = x1; x1 = x2; x2 = x3; x3 = x4; }
                if (gch <= 1) { u32x4 v; v.x = pk[0]; v.y = pk[1]; v.z = pk[2]; v.w = pk[3]; *(u32x4*)(cm + 8 * g8) = v; } }
        }
    }
    if ((VC_MASK & 4) && tid < 256) { const int tok = tid >> 3, i = tid & 7; const float raw = bf2f(F.pbuf()[(r0 + tok) * NP + C_DT + i]) + F.dt_bias()[L * 8 + i]; const float ex = __expf(raw);
      F.dtv()[((size_t)b * 8 + i) * SQ + s0 + tok] = raw > 20.f ? raw : (ex < 0.03f ? ex * (1.f - ex * (0.5f - ex * (0.33333334f - 0.25f * ex))) : __logf(1.f + ex)); }
    __syncthreads();
    asm volatile("; VCONV_END" ::: "memory");
}
__device__ __forceinline__ void phase_prep(const Fr& F0_, int L) {
    unsigned* ctr = F0_.ctl() + CW_QUEUE + (L * 16 + 0) * 64;
    for (;;) {
        const int u = grab_unit(F0_, ctr); if (u >= NB * 72) break;
        const int b = u / 72, j32 = u - 72 * b;
        { const Fr F = refresh(F0_); prep_qk(F, L, b, j32); }
        { const Fr F = refresh(F0_); mla_prep_block(F, L, b, j32); }
        __syncthreads();
    }
    __syncthreads();
    { const Fr F3 = refresh(F0_); for (int u = F3.G - 1 - F3.vcu; u < NB * 36; u += F3.G) prep_tile(F3, L, u / 36, u % 36); }
}

__device__ __forceinline__ void phase_ssd_naive(const Fr& F, int L) {
    if (F.wave != 0 || blockIdx.x >= 64) return;
    const int w = blockIdx.x, b = w >> 3, d = (w >> 2) & 1, h = w & 3, g = h >> 1, p = F.lane;
    const float a = -expf(F.a_log()[L * 8 + d * 4 + h]);
    float hs[128];
#pragma unroll
    for (int n = 0; n < 128; ++n) hs[n] = 0.f;
    const float* dtp = F.dtv() + ((size_t)b * 8 + d * 4 + h) * SQ;
    const bf16* xp = F.xT() + ((size_t)b * 256 + h * 64 + p) * SQ;
    for (int step = 0; step < SQ; ++step) {
        const int s = d == 0 ? step : (step < 256 ? 255 - step : SQ - 1 - (step - 256));
        const float dtv = dtp[s], dA = __expf(dtv * a), xv = bf2f(xp[s]) * dtv;
        const u32x4* Bp = (const u32x4*)(F.btm() + ((size_t)b * SQ + s) * 256 + g * 128);
        const u32x4* Cp = (const u32x4*)(F.ctm() + ((size_t)b * SQ + s) * 256 + g * 128);
        float y = 0.f;
#pragma unroll
        for (int n8 = 0; n8 < 16; ++n8) { const u32x4 bv = Bp[n8], cv = Cp[n8];
#pragma unroll
            for (int j = 0; j < 4; ++j) { const int n = n8 * 8 + 2 * j;
                hs[n] = hs[n] * dA + xv * __uint_as_float(bv[j] << 16); hs[n + 1] = hs[n + 1] * dA + xv * __uint_as_float(bv[j] & 0xffff0000u);
                y += __uint_as_float(cv[j] << 16) * hs[n] + __uint_as_float(cv[j] & 0xffff0000u) * hs[n + 1]; } }
        F.ydir()[((size_t)d * NROW + bs2row(b, s)) * 256 + h * 64 + p] = y;
    }
}

template <int KIND>
__device__ __forceinline__ void naive_attn_job(const Fr& F, int L, int r, int h, LAS float* scr) {
    constexpr int DQ = KIND == 1 ? 96 : (KIND == 0 ? 64 : 32), QS = KIND == 1 ? 96 : 64;
    const int lane = F.lane; int b, s; row2bs(r, b, s); const bool lat = r < NLAT; const int t = s - 256;
    const bf16* Qb = (KIND == 0 ? F.qna() : KIND == 1 ? F.qml() : F.qdf()) + ((size_t)(b * 4 + h) * SQ + s) * QS;
    const bf16* Kb = (KIND == 0 ? F.kna() : KIND == 1 ? F.kml() : F.kdf()) + (size_t)(b * 4 + h) * SQ * QS;
    const bf16* Vt = (KIND == 0 ? F.vna() : KIND == 1 ? F.vml() : F.vdf()) + ((size_t)(b * 4 + h) * 64 + lane) * SQ;
    const float scale = KIND == 1 ? 0.10206207261596577f : (KIND == 0 ? 0.125f : 0.17677669529663687f);
    const int qr = t >> 6, qc = t & 63, row_lo = min(max(qr - 4, 0), 24), col_lo = min(max(qc - 8, 0), 48);
    const bool nb = (KIND == 0) && lat;
    const int nk = lat ? (KIND == 0 ? 768 : SQ) : 256;
    const int koff = nb ? row_lo * 64 : 0;
    float oc[2] = {0.f, 0.f};
#pragma unroll
    for (int comp = 0; comp < (KIND == 2 ? 2 : 1); ++comp) {
        for (int i = lane; i < DQ; i += 64) scr[i] = bf2f(Qb[comp * 32 + i]);
        LDS_WAIT();
        float m = -INFINITY;
        for (int kk = lane; kk < nk; kk += 64) {
            const int sk = kk < 256 ? kk : kk + koff; float bias = 0.f; bool valid = true;
            if (nb && kk >= 256) { const int w = kk - 256, kr = w >> 6, kc = w & 63; valid = kc >= col_lo && kc < col_lo + 16;
                const int ro = row_lo + kr - qr + 7, co = min(max(kc - qc, -15), 15) + 15; bias = F.na_rb()[((L * 4 + h) * 15 + ro) * 31 + co]; }
            const u32x4* kp = (const u32x4*)(Kb + (size_t)sk * QS + (KIND == 2 ? comp * 32 : 0));
            float dot = 0.f;
#pragma unroll
            for (int i8 = 0; i8 < DQ / 8; ++i8) { const u32x4 kv = kp[i8];
#pragma unroll
                for (int j = 0; j < 4; ++j) dot += scr[i8 * 8 + 2 * j] * __uint_as_float(kv[j] << 16) + scr[i8 * 8 + 2 * j + 1] * __uint_as_float(kv[j] & 0xffff0000u); }
            const float sc = valid ? dot * scale + bias : -INFINITY;
            scr[128 + kk] = sc; m = fmaxf(m, sc);
        }
        m = wmaxf(m);
        float sum = 0.f;
        for (int kk = lane; kk < nk; kk += 64) { const float pv = __expf(scr[128 + kk] - m); scr[128 + kk] = pv; sum += pv; }
        sum = wsum(sum);
        LDS_WAIT();
        float o = 0.f;
        for (int kb = 0; kb < nk; kb += 8) {
            const int sb = kb < 256 ? kb : kb + koff;
            const u32x4 vv = *(const u32x4*)(Vt + sb);
#pragma unroll
            for (int j = 0; j < 8; ++j) { const int kk = (kb & ~15) + vpos((kb & 15) + j); const unsigned wv = vv[j >> 1];
                o += scr[128 + kk] * ((j & 1) ? __uint_as_float(wv & 0xffff0000u) : __uint_as_float(wv << 16)); }
        }
        oc[comp] = o / sum;
        LDS_WAIT();
    }
    bf16* mo = F.mix() + (size_t)r * DM + (KIND == 0 ? 0 : KIND == 1 ? 256 : 512) + h * 64 + lane;
    if (KIND == 2) {
        const float* lv = F.df_lam() + L * 128; const float li = 0.8f - 0.6f * expf(-0.3f * (float)L);
        float d1 = 0.f, d2 = 0.f;
#pragma unroll
        for (int i = 0; i < 32; ++i) { d1 += lv[i] * lv[32 + i]; d2 += lv[64 + i] * lv[96 + i]; }
        const float lam = expf(d1) - expf(d2) + li;
        const float o = oc[0] - lam * oc[1];
        const float rs = rsqrtf(wsum(o * o) * (1.f / 64) + EPS);
        *mo = f2bf(o * rs * F.df_gsub()[L * 64 + lane] * (1.f - li));
    } else *mo = f2bf(oc[0]);
}
__device__ __forceinline__ void phase_mix_naive(const Fr& F, int L) {
    LAS float* scr = (LAS float*)(F.lds + F.wave * 16384);
    const int nrows = (L == DEPTH - 1) ? NLAT : NROW;
    for (int j = F.gw; j < nrows * 4; j += F.NGW) naive_attn_job<2>(F, L, j >> 2, j & 3, scr);
    for (int j = F.gw; j < nrows * 4; j += F.NGW) naive_attn_job<1>(F, L, j >> 2, j & 3, scr);
    for (int j = F.gw; j < nrows * 4; j += F.NGW) naive_attn_job<0>(F, L, j >> 2, j & 3, scr);
    for (int r = F.gw; r < nrows; r += F.NGW) {
        int b, s; row2bs(r, b, s); const int h = F.lane >> 4; const float dsk = F.ssd_d()[L * 8 + h] + F.ssd_d()[L * 8 + 4 + h];
        float y[4]; float ss = 0.f;
#pragma unroll
        for (int j = 0; j < 4; ++j) { const int ch = F.lane * 4 + j; const float xv = bf2f(F.xT()[((size_t)b * 256 + ch) * SQ + s]);
            const float z = bf2f(F.pbuf()[(size_t)r * NP + C_Z + ch]);
            y[j] = (F.ydir()[(size_t)r * 256 + ch] + F.ydir()[((size_t)NROW + r) * 256 + ch] + dsk * xv) * siluf(z); ss += y[j] * y[j]; }
        const float rs = rsqrtf(wsum(ss) * (1.f / 256) + EPS);
#pragma unroll
        for (int j = 0; j < 4; ++j) { const int ch = F.lane * 4 + j; F.mix()[(size_t)r * DM + 768 + ch] = f2bf(y[j] * rs * F.ssd_gn()[L * 256 + ch]); }
    }
}

template <int S8> __device__ __forceinline__ bf16x8 pack_step(const f32x16& x) {
    u32x4 p;
    asm volatile("v_cvt_pk_bf16_f32 %0, %4, %5\n\tv_cvt_pk_bf16_f32 %1, %6, %7\n\tv_cvt_pk_bf16_f32 %2, %8, %9\n\tv_cvt_pk_bf16_f32 %3, %10, %11\n\ts_nop 1"
                 : "=&v"(p[0]), "=&v"(p[1]), "=&v"(p[2]), "=&v"(p[3])
                 : "v"(x[S8]), "v"(x[S8 + 1]), "v"(x[S8 + 2]), "v"(x[S8 + 3]), "v"(x[S8 + 4]), "v"(x[S8 + 5]), "v"(x[S8 + 6]), "v"(x[S8 + 7]));
    return __builtin_bit_cast(bf16x8, p);
}
constexpr float LOG2E = 1.4426950408889634f;
template <int KIND>
__device__ __forceinline__ void attn_unit(const Fr& F, int L, int b, int h, int qb) {
    constexpr int QS = KIND == 1 ? 96 : 64, NKS = KIND == 1 ? 6 : (KIND == 0 ? 4 : 2);
    constexpr int PK = QS * 2 + 16, PV = 272, KBYTES = 128 * PK, VBYTES = 64 * PV, NKP = QS == 96 ? 3 : 2, PPR = QS / 8;
    LAS unsigned char* const Kl = F.lds; LAS unsigned char* const Vl = F.lds + 2 * KBYTES;
    LAS float* const biasl = (LAS float*)(F.lds + 2 * KBYTES + 2 * VBYTES);
    const int lane = F.lane, wave = F.wave, tid = F.tid, r = lane & 31, hh = lane >> 5;
    const bool isctx = qb < 0;
    const int comp = KIND == 2 ? (wave & 1) : 0, qg = KIND == 2 ? (wave >> 1) : wave;
    const bf16* Qg = (KIND == 0 ? F.qna() : KIND == 1 ? F.qml() : F.qdf()) + (size_t)(b * 4 + h) * SQ * QS;
    const bf16* Kg = (KIND == 0 ? F.kna() : KIND == 1 ? F.kml() : F.kdf()) + (size_t)(b * 4 + h) * SQ * QS;
    const bf16* Vg = (KIND == 0 ? F.vna() : KIND == 1 ? F.vml() : F.vdf()) + (size_t)(b * 4 + h) * 64 * SQ;
    const float cs = (KIND == 1 ? 0.10206207261596577f : (KIND == 0 ? 0.125f : 0.17677669529663687f)) * LOG2E;
    int sq, qrow = 0, qcol = 0;
    if (KIND == 2) sq = (isctx ? 128 * (-qb - 1) : 256 + 128 * qb) + 32 * qg + r;
    else if (isctx) sq = 32 * wave + r; else if (KIND == 0) { qrow = 4 * qb + (wave >> 1); qcol = 32 * (wave & 1) + r; sq = 256 + 64 * qrow + qcol; } else sq = 256 + 256 * qb + 32 * wave + r;
    int nt = 36, lo_u = 0;
    if (isctx) nt = 4; else if (KIND == 0) { lo_u = min(max(4 * qb - 4, 0), 24); nt = 4 + min(max(4 * qb - 1, 0), 24) + 8 - lo_u; }
    const int np = (nt + 1) >> 1;
    const int my_lo = min(max(qrow - 4, 0), 24), col_lo = min(max(qcol - 8, 0), 48);
    if (KIND == 0 && !isctx) for (int i = tid; i < 465; i += 512) biasl[i] = F.na_rb()[(L * 4 + h) * 465 + i] * LOG2E;
    bf16x8 Q[NKS];
    { const bf16* qp = Qg + (size_t)sq * QS + comp * 32 + 8 * hh;
#pragma unroll
      for (int kk = 0; kk < NKS; ++kk) Q[kk] = *(const bf16x8*)(qp + 16 * kk); }
    f32x16 O[2]; float l = 0.f;
#pragma unroll
    for (int mt = 0; mt < 2; ++mt)
#pragma unroll
        for (int i = 0; i < 16; ++i) O[mt][i] = 0.f;
    float m;
    {   float q2 = 0.f;
#pragma unroll
        for (int kk = 0; kk < NKS; ++kk)
#pragma unroll
            for (int j = 0; j < 8; ++j) { const float v = bf2f((bf16)Q[kk][j]); q2 += v * v; }
        q2 += __shfl_xor(q2, 32);
        const float k2 = __uint_as_float(__hip_atomic_load(F.ctl() + CW_KMAX + ((L * 3 + KIND) * 8 + b) * 8 + h * 2 + comp, __ATOMIC_RELAXED, __HIP_MEMORY_SCOPE_AGENT));
        m = sqrtf(q2 * k2) * cs;
        if (KIND == 0 && !isctx) m += (F.rcos() + 2 * TLAT * 16)[L * 4 + h];
    }
    u32x4 rk_0[NKP], rv_0[2];
#define AT_SK0(t) ((isctx || KIND != 0) ? 64 * (t) : ((t) < 4 ? 64 * (t) : 256 + 64 * (lo_u + (t) - 4)))
#define AT_LOAD(p, S_) do { const int sk0_ = AT_SK0(2 * (p)); const char* kg_ = (const char*)(Kg + (size_t)sk0_ * QS); \
        _Pragma("unroll") for (int i_ = 0; i_ < NKP; ++i_) rk_##S_[i_] = *(const u32x4*)(kg_ + (tid + 512 * i_) * 16); \
        _Pragma("unroll") for (int i_ = 0; i_ < 2; ++i_) { const int pi_ = tid + 512 * i_; rv_##S_[i_] = *(const u32x4*)(Vg + (size_t)(pi_ >> 4) * SQ + sk0_ + (pi_ & 15) * 8); } } while (0)
#define AT_STORE(buf, S_) do { \
        _Pragma("unroll") for (int i_ = 0; i_ < NKP; ++i_) { const int pi_ = tid + 512 * i_; *(LAS u32x4*)(Kl + (buf) * KBYTES + (pi_ / PPR) * PK + (pi_ % PPR) * 16) = rk_##S_[i_]; } \
        _Pragma("unroll") for (int i_ = 0; i_ < 2; ++i_) { const int pi_ = tid + 512 * i_; *(LAS u32x4*)(Vl + (buf) * VBYTES + (pi_ >> 4) * PV + (pi_ & 15) * 16) = rv_##S_[i_]; } } while (0)
#define AT_QK(SA, SB, kb_) do { \
        _Pragma("unroll") for (int i = 0; i < 16; ++i) { SA[i] = 0.f; SB[i] = 0.f; } \
        _Pragma("unroll") for (int kk = 0; kk < NKS; ++kk) { const bf16x8 a0 = *(const LAS bf16x8*)((kb_) + 32 * kk), a1 = *(const LAS bf16x8*)((kb_) + 32 * PK + 32 * kk); \
            SA = MFMA32(a0, Q[kk], SA); SB = MFMA32(a1, Q[kk], SB); } } while (0)
#define AT_SMPV(S0, S1, t_, vb_) do { \
        const int krow = lo_u + (t_) - 4; const bool nbt = (KIND == 0) && !isctx && (t_) >= 4; \
        float ps = 0.f; \
        if (nbt) { const int drow = (krow - qrow + 7) * 31 - qcol + 15; const float nm = -m; \
            _Pragma("unroll") for (int i = 0; i < 16; ++i) { const int kc = (i & 3) + 8 * (i >> 2) + 4 * hh; \
                { const bool v = (unsigned)(kc - col_lo) < 16u; const float bb = biasl[v ? drow + kc : 0]; S0[i] = v ? __builtin_amdgcn_exp2f(__builtin_fmaf(S0[i], cs, bb + nm)) : 0.f; } \
                { const bool v = (unsigned)(kc + 32 - col_lo) < 16u; const float bb = biasl[v ? drow + kc + 32 : 0]; S1[i] = v ? __builtin_amdgcn_exp2f(__builtin_fmaf(S1[i], cs, bb + nm)) : 0.f; } \
                ps += S0[i] + S1[i]; } \
        } else { const float nm = -m; \
            _Pragma("unroll") for (int i = 0; i < 16; ++i) { S0[i] = __builtin_amdgcn_exp2f(__builtin_fmaf(S0[i], cs, nm)); S1[i] = __builtin_amdgcn_exp2f(__builtin_fmaf(S1[i], cs, nm)); ps += S0[i] + S1[i]; } } \
        l += ps; \
        const bf16x8 p00 = pack_step<0>(S0), p01 = pack_step<8>(S0), p10 = pack_step<0>(S1), p11 = pack_step<8>(S1); \
        _Pragma("unroll") for (int mt = 0; mt < 2; ++mt) { \
            const LAS unsigned char* vb = (vb_) + mt * 32 * PV; \
            O[mt] = MFMA32(*(const LAS bf16x8*)(vb + 0), p00, O[mt]); O[mt] = MFMA32(*(const LAS bf16x8*)(vb + 32), p01, O[mt]); \
            O[mt] = MFMA32(*(const LAS bf16x8*)(vb + 64), p10, O[mt]); O[mt] = MFMA32(*(const LAS bf16x8*)(vb + 96), p11, O[mt]); } } while (0)
#define AT_COMPUTE(p_, buf_) do { \
        const int t0_ = 2 * (p_), t1_ = t0_ + 1; \
        const bool g0_ = (KIND != 0) || isctx || t0_ < 4 || (lo_u + t0_ - 4 >= my_lo && lo_u + t0_ - 4 < my_lo + 8); \
        const bool g1_ = (t1_ < nt) && ((KIND != 0) || isctx || t1_ < 4 || (lo_u + t1_ - 4 >= my_lo && lo_u + t1_ - 4 < my_lo + 8)); \
        const LAS unsigned char* Kb = Kl + (buf_) * KBYTES + r * PK + (comp * 32 + 8 * hh) * 2; const LAS unsigned char* Vb = Vl + (buf_) * VBYTES + r * PV + 16 * hh; \
        if (KIND == 0) { f32x16 S00, S01; \
            if (g0_) { AT_QK(S00, S01, Kb); AT_SMPV(S00, S01, t0_, Vb); } \
            if (g1_) { AT_QK(S00, S01, Kb + 64 * PK); AT_SMPV(S00, S01, t1_, Vb + 128); } \
        } else { f32x16 S00, S01, S10, S11; \
            AT_QK(S00, S01, Kb); \
            AT_QK(S10, S11, Kb + 64 * PK); \
            AT_SMPV(S00, S01, t0_, Vb); \
            AT_SMPV(S10, S11, t1_, Vb + 128); } } while (0)
    AT_LOAD(0, 0);
    AT_STORE(0, 0);
    __syncthreads();
    for (int p = 0; p < np; ++p) {
        const int buf = p & 1;
        if (p + 1 < np) AT_LOAD(p + 1, 0);
        AT_COMPUTE(p, buf);
        if (p + 1 < np) AT_STORE(buf ^ 1, 0);
        __syncthreads();
    }
#undef AT_COMPUTE
#undef AT_SMPV
#undef AT_QK
#undef AT_SK0
#undef AT_LOAD
#undef AT_STORE
    const float inv = 1.f / (l + __shfl_xor(l, 32));
    bf16* mo = F.mix() + (size_t)bs2row(b, sq) * DM + (KIND == 0 ? 0 : KIND == 1 ? 256 : 512) + h * 64 + 4 * hh;
    if (KIND == 2) {
        LAS float* xo = (LAS float*)F.lds + qg * 2048;
        if (comp == 1) {
#pragma unroll
            for (int mt = 0; mt < 2; ++mt)
#pragma unroll
                for (int i = 0; i < 16; ++i) xo[(mt * 16 + i) * 64 + lane] = O[mt][i] * inv; }
        __syncthreads();
        if (comp == 0) {
            const float* lv = F.df_lam() + L * 128; const float li = 0.8f - 0.6f * expf(-0.3f * (float)L);
            float d1 = 0.f, d2 = 0.f;
#pragma unroll
            for (int i = 0; i < 32; ++i) { d1 += lv[i] * lv[32 + i]; d2 += lv[64 + i] * lv[96 + i]; }
            const float lam = expf(d1) - expf(d2) + li;
            float ss = 0.f;
#pragma unroll
            for (int mt = 0; mt < 2; ++mt)
#pragma unroll
                for (int i = 0; i < 16; ++i) { const float o = O[mt][i] * inv - lam * xo[(mt * 16 + i) * 64 + lane]; O[mt][i] = o; ss += o * o; }
            ss += __shfl_xor(ss, 32);
            const float rs = rsqrtf(ss * (1.f / 64) + EPS) * (1.f - li);
#pragma unroll
            for (int mt = 0; mt < 2; ++mt)
#pragma unroll
                for (int g = 0; g < 4; ++g) { const f32x4 gs = *(const f32x4*)(F.df_gsub() + L * 64 + 32 * mt + 8 * g + 4 * hh);
                    u32x2 w; w.x = pk2(O[mt][4 * g] * rs * gs[0], O[mt][4 * g + 1] * rs * gs[1]); w.y = pk2(O[mt][4 * g + 2] * rs * gs[2], O[mt][4 * g + 3] * rs * gs[3]);
                    *(u32x2*)(mo + 32 * mt + 8 * g) = w; }
        }
        __syncthreads();
    } else {
#pragma unroll
        for (int mt = 0; mt < 2; ++mt)
#pragma unroll
            for (int g = 0; g < 4; ++g) { u32x2 w; w.x = pk2(O[mt][4 * g] * inv, O[mt][4 * g + 1] * inv); w.y = pk2(O[mt][4 * g + 2] * inv, O[mt][4 * g + 3] * inv);
                *(u32x2*)(mo + 32 * mt + 8 * g) = w; }
    }
}
__device__ __forceinline__ float ssd_cum(const Fr& F, int L, int b, int h, int d, int s0, float& dt, float& cum) {
    const int lane = F.lane;
    dt = F.dtv()[((size_t)b * 8 + d * 4 + h) * SQ + s0 + lane];
    const float la = dt * -__expf(F.a_log()[L * 8 + d * 4 + h]);
    float v = la;
#pragma unroll
    for (int o = 1; o < 64; o <<= 1) { const float t = __shfl_up(v, o); if (lane >= o) v += t; }
    const float total = __shfl(v, 63);
    cum = d == 0 ? v : total - v + la;
    return total;
}
__device__ __forceinline__ void ssd_s1_job(const Fr& F, int L, int b, int c, int h, LAS float* scr) {
    const int lane = F.lane, r = lane & 31, hh = lane >> 5, s0 = 64 * c, g = h >> 1;
#pragma unroll
    for (int d = 0; d < 2; ++d) { float dt, cum; const float tot = ssd_cum(F, L, b, h, d, s0, dt, cum); scr[d * 64 + lane] = dt * __expf(tot - cum);
        if (lane == 0) F.cdec()[((b * 2 + d) * 4 + h) * 36 + c] = __expf(tot); }
    LDS_WAIT();
    bf16x8 A[2][2][4];
#pragma unroll
    for (int mt = 0; mt < 2; ++mt)
#pragma unroll
        for (int kk = 0; kk < 4; ++kk) { const bf16x8 raw = *(const bf16x8*)(F.xT() + ((size_t)b * 256 + h * 64 + 32 * mt + r) * SQ + s0 + 16 * kk + 8 * hh);
#pragma unroll
            for (int d = 0; d < 2; ++d) { u32x4 o;
#pragma unroll
                for (int j = 0; j < 4; ++j) { const float w0 = scr[d * 64 + 16 * kk + 8 * hh + 2 * j], w1 = scr[d * 64 + 16 * kk + 8 * hh + 2 * j + 1];
                    o[j] = pk2(bf2f((bf16)raw[2 * j]) * w0, bf2f((bf16)raw[2 * j + 1]) * w1); }
                A[d][mt][kk] = __builtin_bit_cast(bf16x8, o); } }
#pragma unroll
    for (int nt = 0; nt < 4; ++nt) {
        bf16x8 Bf[4];
#pragma unroll
        for (int kk = 0; kk < 4; ++kk) Bf[kk] = *(const bf16x8*)(F.bT() + ((size_t)b * 256 + g * 128 + 32 * nt + r) * SQ + s0 + 16 * kk + 8 * hh);
#pragma unroll
        for (int d = 0; d < 2; ++d)
#pragma unroll
            for (int mt = 0; mt < 2; ++mt) { f32x16 acc;
#pragma unroll
                for (int i = 0; i < 16; ++i) acc[i] = 0.f;
#pragma unroll
                for (int kk = 0; kk < 4; ++kk) acc = MFMA32(A[d][mt][kk], Bf[kk], acc);
                float* dst = F.cst() + ((((size_t)(b * 2 + d) * 4 + h) * 36 + c) * 64 + 32 * mt) * 128 + 32 * nt + r;
#pragma unroll
                for (int i = 0; i < 16; ++i) dst[crow16(i, hh) * 128] = acc[i]; }
    }
    LDS_WAIT();
}
__device__ __forceinline__ void phase_ssd_s1(const Fr& F, int L) {
    LAS float* scr = (LAS float*)(F.lds + F.wave * 16384);
    for (int j = F.gw; j < NB * 36 * 4; j += F.NGW) ssd_s1_job(F, L, j / 144, (j / 4) % 36, j & 3, scr);
}
__device__ __forceinline__ void phase_ssd_scan(const Fr& F, int L) {
    for (int e4 = blockIdx.x * 512 + F.tid; e4 < NB * 2 * 4 * 2048; e4 += F.G * 512) {
        const int bdh = e4 >> 11, pn = (e4 & 2047) * 4, d = (bdh >> 2) & 1;
        f32x4 hst = (f32x4){0.f, 0.f, 0.f, 0.f};
        const float* cs_ = F.cst() + (size_t)bdh * 36 * 8192 + pn; bf16* he_ = F.hent() + (size_t)bdh * 36 * 8192 + pn; const float* cd_ = F.cdec() + bdh * 36;
#pragma unroll 1
        for (int s6 = 0; s6 < 36; s6 += 6) {
            f32x4 v[6]; float dc[6]; int cc[6];
#pragma unroll
            for (int j = 0; j < 6; ++j) { const int step = s6 + j; cc[j] = d == 0 ? step : (step < 4 ? 3 - step : 39 - step); v[j] = *(const f32x4*)(cs_ + (size_t)cc[j] * 8192); dc[j] = cd_[cc[j]]; }
#pragma unroll
            for (int j = 0; j < 6; ++j) { u32x2 o; o.x = pk2(hst[0], hst[1]); o.y = pk2(hst[2], hst[3]); *(u32x2*)(he_ + (size_t)cc[j] * 8192) = o; hst = hst * dc[j] + v[j]; }
        }
    }
}
__device__ __forceinline__ void ssd_s3_unit(const Fr& F, int L, int b, int c) {
    const int lane = F.lane, wave = F.wave, r = lane & 31, hh = lane >> 5, s0 = 64 * c, h = wave >> 1, it = wave & 1, g = h >> 1, itok = 32 * it + r;
    LAS float* scr = (LAS float*)(F.lds + wave * 16384);
    LAS float* red = (LAS float*)(F.lds + 8192);
#pragma unroll
    for (int d = 0; d < 2; ++d) { float dt, cum; (void)ssd_cum(F, L, b, h, d, s0, dt, cum); scr[d * 128 + lane] = cum; scr[d * 128 + 64 + lane] = dt; }
    LDS_WAIT();
    bf16x8 Cf[8];
#pragma unroll
    for (int kk = 0; kk < 8; ++kk) Cf[kk] = *(const bf16x8*)(F.ctm() + ((size_t)b * SQ + s0 + itok) * 256 + g * 128 + 16 * kk + 8 * hh);
    f32x16 G[2];
#pragma unroll
    for (int jt = 0; jt < 2; ++jt) {
#pragma unroll
        for (int i = 0; i < 16; ++i) G[jt][i] = 0.f;
#pragma unroll
        for (int kk = 0; kk < 8; ++kk) { const bf16x8 bf = *(const bf16x8*)(F.btm() + ((size_t)b * SQ + s0 + 32 * jt + r) * 256 + g * 128 + 16 * kk + 8 * hh); G[jt] = MFMA32(bf, Cf[kk], G[jt]); } }
    bf16x8 X[2][4];
#pragma unroll
    for (int mt = 0; mt < 2; ++mt)
#pragma unroll
        for (int ks = 0; ks < 4; ++ks) { const bf16* xp = F.xT() + ((size_t)b * 256 + h * 64 + 32 * mt + r) * SQ + s0 + 16 * ks + 4 * hh;
            const u32x2 lo = *(const u32x2*)xp, hi = *(const u32x2*)(xp + 8); u32x4 o; o.x = lo.x; o.y = lo.y; o.z = hi.x; o.w = hi.y; X[mt][ks] = __builtin_bit_cast(bf16x8, o); }
    f32x16 Y[2];
#pragma unroll
    for (int mt = 0; mt < 2; ++mt)
#pragma unroll
        for (int i = 0; i < 16; ++i) Y[mt][i] = 0.f;
    const float Dsum = F.ssd_d()[L * 8 + h] + F.ssd_d()[L * 8 + 4 + h];
#pragma unroll 1
    for (int d = 0; d < 2; ++d) {
        const float cum_i = scr[d * 128 + itok];
        f32x16 Pm[2];
#pragma unroll
        for (int jt = 0; jt < 2; ++jt)
#pragma unroll
            for (int i = 0; i < 16; ++i) { const int j = 32 * jt + crow16(i, hh); const bool valid = d == 0 ? (j <= itok) : (j >= itok);
                const float arg = valid ? cum_i - scr[d * 128 + j] : -INFINITY;
                float pv = G[jt][i] * __expf(arg) * scr[d * 128 + 64 + j];
                if (d == 0 && j == itok) pv += Dsum;
                Pm[jt][i] = pv; }
        const bf16x8 p0 = pack_step<0>(Pm[0]), p1 = pack_step<8>(Pm[0]), p2 = pack_step<0>(Pm[1]), p3 = pack_step<8>(Pm[1]);
#pragma unroll
        for (int mt = 0; mt < 2; ++mt) { Y[mt] = MFMA32(X[mt][0], p0, Y[mt]); Y[mt] = MFMA32(X[mt][1], p1, Y[mt]); Y[mt] = MFMA32(X[mt][2], p2, Y[mt]); Y[mt] = MFMA32(X[mt][3], p3, Y[mt]); }
        const float ei = __expf(cum_i);
#pragma unroll
        for (int mt = 0; mt < 2; ++mt) { f32x16 T;
#pragma unroll
            for (int i = 0; i < 16; ++i) T[i] = 0.f;
#pragma unroll
            for (int kk = 0; kk < 8; ++kk) { const bf16x8 hf = *(const bf16x8*)(F.hent() + ((((size_t)(b * 2 + d) * 4 + h) * 36 + c) * 64 + 32 * mt + r) * 128 + 16 * kk + 8 * hh); T = MFMA32(hf, Cf[kk], T); }
#pragma unroll
            for (int i = 0; i < 16; ++i) Y[mt][i] += ei * T[i]; }
    }
    const size_t row = bs2row(b, s0 + itok);
    const bf16* zp = F.pbuf() + row * NP + C_Z + h * 64 + 4 * hh;
    float ss = 0.f;
#pragma unroll
    for (int mt = 0; mt < 2; ++mt)
#pragma unroll
        for (int gq = 0; gq < 4; ++gq) { const u32x2 z4 = *(const u32x2*)(zp + 32 * mt + 8 * gq);
            const float z0 = __uint_as_float(z4.x << 16), z1 = __uint_as_float(z4.x & 0xffff0000u), z2 = __uint_as_float(z4.y << 16), z3 = __uint_as_float(z4.y & 0xffff0000u);
            Y[mt][4 * gq] *= siluf(z0); Y[mt][4 * gq + 1] *= siluf(z1); Y[mt][4 * gq + 2] *= siluf(z2); Y[mt][4 * gq + 3] *= siluf(z3);
            ss += (Y[mt][4 * gq] * Y[mt][4 * gq] + Y[mt][4 * gq + 1] * Y[mt][4 * gq + 1]) + (Y[mt][4 * gq + 2] * Y[mt][4 * gq + 2] + Y[mt][4 * gq + 3] * Y[mt][4 * gq + 3]); }
    ss += __shfl_xor(ss, 32);
    if (hh == 0) red[(it * 4 + h) * 32 + r] = ss;
    __syncthreads();
    const float tot = (red[(it * 4 + 0) * 32 + r] + red[(it * 4 + 1) * 32 + r]) + (red[(it * 4 + 2) * 32 + r] + red[(it * 4 + 3) * 32 + r]);
    const float rs = rsqrtf(tot * (1.f / 256) + EPS);
    bf16* mo = F.mix() + row * DM + 768 + h * 64 + 4 * hh;
#pragma unroll
    for (int mt = 0; mt < 2; ++mt)
#pragma unroll
        for (int gq = 0; gq < 4; ++gq) { const f32x4 gn = *(const f32x4*)(F.ssd_gn() + L * 256 + h * 64 + 32 * mt + 8 * gq + 4 * hh);
            u32x2 w; w.x = pk2(Y[mt][4 * gq] * rs * gn[0], Y[mt][4 * gq + 1] * rs * gn[1]); w.y = pk2(Y[mt][4 * gq + 2] * rs * gn[2], Y[mt][4 * gq + 3] * rs * gn[3]);
            *(u32x2*)(mo + 32 * mt + 8 * gq) = w; }
    __syncthreads();
}
template <int KIND> __device__ __forceinline__ void attn_units(const Fr& F, int L) {
    if (KIND == 2) { const int nu = (L == DEPTH - 1) ? 512 : 576;
        for (int u = F.vcu; u < nu; u += F.G) { if (u < 512) attn_unit<2>(F, L, u >> 6, (u >> 4) & 3, u & 15); else attn_unit<2>(F, L, (u - 512) >> 3, ((u - 512) >> 1) & 3, -1 - (u & 1)); }
    } else { const int nu = (L == DEPTH - 1) ? 256 : 288;
        for (int u = F.vcu; u < nu; u += F.G) { if (u < 256) attn_unit<KIND>(F, L, u >> 5, (u >> 3) & 3, u & 7); else attn_unit<KIND>(F, L, (u - 256) >> 2, (u - 256) & 3, -1); } }
}
__device__ __forceinline__ void phase_mix_fast(const Fr& F, int L) {
#ifndef ATT_MASK
#define ATT_MASK 15
#endif
#ifndef ATT_DUP
#define ATT_DUP 0
#endif
#ifndef ATT_MASK
#define ATT_MASK 15
#endif
    if (ATT_MASK & 4) for (int rp = 0; rp < ((ATT_DUP & 4) ? 2 : 1); ++rp) { const Fr Fa = refresh(F); attn_units<2>(Fa, L); }
    if (ATT_MASK & 2) for (int rp = 0; rp < ((ATT_DUP & 2) ? 2 : 1); ++rp) { const Fr Fa = refresh(F); attn_units<1>(Fa, L); }
    if (ATT_MASK & 1) for (int rp = 0; rp < ((ATT_DUP & 1) ? 2 : 1); ++rp) { const Fr Fa = refresh(F); attn_units<0>(Fa, L); }
    const int c0 = (L == DEPTH - 1) ? 4 : 0;
    if (ATT_MASK & 8) { const Fr Fa = refresh(F); unsigned* ctr = Fa.ctl() + CW_QUEUE + (L * 16 + 1) * 64;
        for (;;) { const int u = grab_unit(Fa, ctr); if (u >= NB * (36 - c0)) break; ssd_s3_unit(Fa, L, u / (36 - c0), c0 + u % (36 - c0)); } }
}

__device__ __forceinline__ void phase_route(const Fr& F, int L, bool commit = true) {
    const int nrows = (L == DEPTH - 1) ? NLAT : NROW;
    LAS float* wl = (LAS float*)F.lds;
    {   const f32x4* wg4 = (const f32x4*)(F.w_grp() + (size_t)L * DM * 4); const f32x4* we4 = (const f32x4*)(F.w_exp() + (size_t)L * DM * 16);
        f32x4 tg[2], te[8];
#pragma unroll
        for (int n = 0; n < 2; ++n) tg[n] = wg4[F.tid + 512 * n];
#pragma unroll
        for (int n = 0; n < 8; ++n) te[n] = we4[F.tid + 512 * n];
#pragma unroll
        for (int n = 0; n < 2; ++n) { const int k = F.tid + 512 * n;
#pragma unroll
            for (int o = 0; o < 4; ++o) wl[o * DM + k] = tg[n][o]; }
#pragma unroll
        for (int n = 0; n < 8; ++n) { const int i = F.tid + 512 * n, k = i >> 2, q = i & 3;
#pragma unroll
            for (int o = 0; o < 4; ++o) wl[(4 + 4 * q + o) * DM + k] = te[n][o]; }
    }
    __syncthreads();
    float keep[20];
#pragma unroll
    for (int o = 0; o < 20; ++o) keep[o] = 0.f;
    f32x4 v[4], vn[4];
    { const int r = F.gw; if (r < nrows) { const float* hp = r < NLAT ? F.out() + (size_t)r * DM : F.hc() + (size_t)(r - NLAT) * DM;
#pragma unroll
        for (int j = 0; j < 4; ++j) vn[j] = *(const f32x4*)(hp + 4 * F.lane + 256 * j); } }
    int it = 0;
    for (int r = F.gw; r < nrows; r += F.NGW, ++it) {
        const bool lat = r < NLAT; const int bb = lat ? (r >> 11) : 8;
#pragma unroll
        for (int j = 0; j < 4; ++j) v[j] = vn[j];
        { const int rn = r + F.NGW; if (rn < nrows) { const float* hp = rn < NLAT ? F.out() + (size_t)rn * DM : F.hc() + (size_t)(rn - NLAT) * DM;
#pragma unroll
            for (int j = 0; j < 4; ++j) vn[j] = *(const f32x4*)(hp + 4 * F.lane + 256 * j); } }
        float ss = 0.f;
#pragma unroll
        for (int j = 0; j < 4; ++j) ss += (v[j][0] * v[j][0] + v[j][1] * v[j][1]) + (v[j][2] * v[j][2] + v[j][3] * v[j][3]);
        const float rstd = rsqrtf(wsum(ss) * (1.f / DM) + EPS);
        const float* md = F.modv() + ((size_t)L * 9 + bb) * 6144;
        float lg[20];
#pragma unroll
        for (int o = 0; o < 20; ++o) lg[o] = 0.f;
#pragma unroll
        for (int j = 0; j < 4; ++j) { const int c = 4 * F.lane + 256 * j; const f32x4 g = *(const f32x4*)(F.g_ffn() + L * DM + c), sh = *(const f32x4*)(md + 3 * 1024 + c), scl = *(const f32x4*)(md + 4 * 1024 + c);
            const f32x4 f = v[j] * rstd * g * (scl + 1.f) + sh; u32x2 o2; o2.x = pk2(f[0], f[1]); o2.y = pk2(f[2], f[3]); *(u32x2*)(F.abuf() + (size_t)r * DM + c) = o2;
#pragma unroll
            for (int o = 0; o < 20; ++o) { const f32x4 w = *(const LAS f32x4*)(wl + o * DM + c); lg[o] += (f[0] * w[0] + f[1] * w[1]) + (f[2] * w[2] + f[3] * w[3]); }
            asm volatile("" ::: "memory"); }
#pragma unroll
        for (int o = 0; o < 20; ++o) { const float t = wsum(lg[o]); keep[o] = (F.lane == it) ? t : keep[o]; }
    }
    if (F.lane < it) {
        const int r = F.gw + F.lane * F.NGW;
        float gl[4]; float gm = -INFINITY; int gt = 0;
#pragma unroll
        for (int o = 0; o < 4; ++o) { gl[o] = keep[o] + F.b_grp()[L * 4 + o]; if (gl[o] > gm) { gm = gl[o]; gt = o; } }
        float gs = 0.f;
#pragma unroll
        for (int o = 0; o < 4; ++o) gs += expf(gl[o] - gm);
        const float gp = 1.f / gs;
        float el[4];
#pragma unroll
        for (int o = 0; o < 4; ++o) { float v4 = 0.f;
#pragma unroll
            for (int q = 0; q < 4; ++q) v4 = (gt == q) ? keep[4 + 4 * q + o] + F.b_exp()[L * 16 + 4 * q + o] : v4;
            el[o] = v4; }
        int i0 = 0; float m0 = el[0];
#pragma unroll
        for (int o = 1; o < 4; ++o) if (el[o] > m0) { m0 = el[o]; i0 = o; }
        int i1 = i0 == 0 ? 1 : 0; float m1 = i0 == 0 ? el[1] : el[0];
#pragma unroll
        for (int o = 1; o < 4; ++o) if (o != i0 && el[o] > m1) { m1 = el[o]; i1 = o; }
        const float e1 = expf(m1 - m0), w0 = gp / (1.f + e1), w1 = gp * e1 / (1.f + e1);
        const int x0 = gt * 4 + i0, x1 = gt * 4 + i1;
        if (commit) {
            F.rtw()[2 * r] = w0; F.rtw()[2 * r + 1] = w1;
            const unsigned p0 = atomicAdd(F.ctl() + CW_ECNT + (L * 16 + x0) * 64, 1u), p1 = atomicAdd(F.ctl() + CW_ECNT + (L * 16 + x1) * 64, 1u);
            F.elist()[x0 * NROW + p0] = 2 * r; F.elist()[x1 * NROW + p1] = 2 * r + 1; }
        else if (w0 + w1 < -1.f) F.rtw()[0] = 0.f;
    }
    __syncthreads();
}
__device__ __forceinline__ void moe_table(const Fr& F, int L) {
    volatile LAS int* T = (volatile LAS int*)(F.lds + LDSCTL_OFF + 64);
    volatile LAS int* Cn = (volatile LAS int*)(F.lds + LDSCTL_OFF + 160);
    __syncthreads();
    if (F.tid == 0) { int acc = 0;
        for (int e = 0; e < 16; ++e) { int c = (int)__hip_atomic_load(F.ctl() + CW_ECNT + (L * 16 + e) * 64, __ATOMIC_RELAXED, __HIP_MEMORY_SCOPE_AGENT); c = min(max(c, 0), NROW); T[e] = acc; Cn[e] = c; acc += (c + 255) >> 8; }
        T[16] = acc; }
    __syncthreads();
}

__global__ void __launch_bounds__(512, 2) fwd_kernel(Args args) {
    extern __shared__ __attribute__((aligned(16))) unsigned char lds_raw[];
    Fr F0;
    F0.lds = (LAS unsigned char*)lds_raw; F0.tid = threadIdx.x; F0.lane = F0.tid & 63; F0.wave = __builtin_amdgcn_readfirstlane(F0.tid >> 6);
    F0.G = gridDim.x; { const int bx = blockIdx.x; F0.vcu = (F0.G % 8 == 0) ? (bx % 8) * (F0.G / 8) + bx / 8 : bx; }
    F0.gw = F0.vcu * 8 + F0.wave; F0.NGW = F0.G * 8;
    F0.A = (const __attribute__((address_space(4))) Args*)__builtin_amdgcn_kernarg_segment_ptr();
    for (int u = F0.tid; u < (LDS_BYTES - LDSCTL_OFF) / 4; u += 512) ((LAS unsigned*)(F0.lds + LDSCTL_OFF))[u] = 0u;
    __syncthreads();
    const int lo = args.ph_lo, hi = args.ph_hi;
    XcdBarrier bar; bar.bar = F0.ctl() + CW_BAR; bar.x = 0; bar.st = nullptr;
    if (hi - lo > 1) bar = xcd_barrier_post(F0.ctl() + CW_BAR, (volatile LAS unsigned*)(F0.lds + LDSCTL_OFF));
#ifndef PH_MASK
#define PH_MASK 0xFFFF
#endif
#define PM(b) ((PH_MASK >> (b)) & 1)
#ifndef DUP_MASK
#define DUP_MASK 0
#endif
#ifndef DBL_SEAM
#define DBL_SEAM 0
#endif
#define NREP(b) (((DUP_MASK >> (b)) & 1) ? 2 : 1)
#define IN(k) (lo <= (k) && (k) < hi)
#define SEAM(k) do { if (IN(k) && IN((k) + 1)) { const Fr Fb = refresh(F0); XcdBarrier b2 = bar; b2.bar = Fb.ctl() + CW_BAR; xcd_barrier(b2); if ((DUP_MASK & 0x10000) || ((DBL_SEAM >> (((k) + NPH_L - 1) % NPH_L)) & 1)) xcd_barrier(b2); } } while (0)

    if (PM(0) && IN(0)) { for (int rep_ = 0; rep_ < NREP(0); ++rep_) { if (rep_) __syncthreads(); const Fr F = refresh(F0); phase_prologue(F); } }
    SEAM(0);
    for (int L = 0; L < DEPTH; ++L) {
        const int pb = 1 + NPH_L * L;
        const bool lastL = (L == DEPTH - 1);
        if (PM(1) && IN(pb + 0)) { const Fr F = refresh(F0); phase_norm(F, L); if (DUP_MASK & 2048) { __syncthreads(); phase_norm(F, L, false); } for (int rp = 0; rp < NREP(10); ++rp) moe_weight_convert(F, L); }
        SEAM(pb + 0);
        if (PM(2) && IN(pb + 1)) { for (int rep_ = 0; rep_ < NREP(2); ++rep_) { if (rep_) __syncthreads(); const Fr F = refresh(F0); pg8::DenseSched S; S.init(F.abuf(), F.winT() + (size_t)L * NP * DM, DM, NROW, NP, F.G, (int)blockIdx.x); pg8::EpiP E{F.pbuf()}; pg8::gemm_phase(F.lds, F.tid, DM, S, E); } }
        SEAM(pb + 1);
        if (PM(3) && IN(pb + 2)) { for (int rep_ = 0; rep_ < NREP(3); ++rep_) { if (rep_) __syncthreads(); const Fr F = refresh(F0); phase_prep(F, L); } }
        SEAM(pb + 2);
        if (PM(4) && IN(pb + 3)) { for (int rep_ = 0; rep_ < NREP(4); ++rep_) { if (rep_) __syncthreads(); const Fr F = refresh(F0); phase_ssd_s1(F, L); } }
        SEAM(pb + 3);
        if (PM(4) && IN(pb + 4)) { for (int rep_ = 0; rep_ < NREP(6); ++rep_) { if (rep_) __syncthreads(); const Fr F = refresh(F0); phase_ssd_scan(F, L); } }
        SEAM(pb + 4);
        if (PM(5) && IN(pb + 5)) { for (int rep_ = 0; rep_ < NREP(5); ++rep_) { if (rep_) __syncthreads(); const Fr F = refresh(F0); phase_mix_fast(F, L); } }
        SEAM(pb + 5);
        if (PM(6) && IN(pb + 6)) { const Fr F = refresh(F0); pg8::DenseSched S; S.init(F.mix(), F.woutT() + (size_t)L * DM * DM, DM, lastL ? NLAT : NROW, DM, F.G, (int)blockIdx.x);
            pg8::EpiRes E{L == 0 ? F.x() : F.out(), L == 0 ? F.ctx() : F.hc(), F.out(), F.hc(), F.modv() + (size_t)L * 9 * 6144 + 2 * 1024, 1.f}; pg8::gemm_phase(F.lds, F.tid, DM, S, E);
            if (DUP_MASK & 8192) { __syncthreads(); pg8::EpiRes E2{F.out(), F.hc(), F.out(), F.hc(), F.modv() + (size_t)L * 9 * 6144 + 2 * 1024, 0.f}; pg8::gemm_phase(F.lds, F.tid, DM, S, E2); } }
        SEAM(pb + 6);
        if (PM(7) && IN(pb + 7)) { const Fr F = refresh(F0); phase_route(F, L); if (DUP_MASK & 4096) phase_route(F, L, false); }
        SEAM(pb + 7);
        if (PM(8) && IN(pb + 8)) { for (int rep_ = 0; rep_ < NREP(8); ++rep_) { if (rep_) __syncthreads(); const Fr F = refresh(F0); moe_table(F, L);
            pg8::MoeSched<true> S{(const char*)F.abuf(), (const char*)F.wgu(), (size_t)1024 * DM * 2, DM, F.G, F.vcu, F.elist(), (const volatile LAS int*)(F.lds + LDSCTL_OFF + 64), (const volatile LAS int*)(F.lds + LDSCTL_OFF + 160)};
            pg8::EpiAct E{F.act()}; pg8::gemm_phase(F.lds, F.tid, DM, S, E); } }
        SEAM(pb + 8);
        if (PM(9) && IN(pb + 9)) { for (int rep_ = 0; rep_ < NREP(9); ++rep_) { if (rep_) __syncthreads(); const Fr F = refresh(F0); moe_table(F, L);
            pg8::MoeSched<false> S{(const char*)F.act(), (const char*)F.wd(), (size_t)1024 * FF * 2, FF, F.G, F.vcu, F.elist(), (const volatile LAS int*)(F.lds + LDSCTL_OFF + 64), (const volatile LAS int*)(F.lds + LDSCTL_OFF + 160)};
            pg8::EpiDown E{F.yk(), F.elist(), F.rtw()}; pg8::gemm_phase(F.lds, F.tid, FF, S, E); } }
        SEAM(pb + 9);
    }
    if (PM(1) && IN(PH_FINAL)) { const Fr F = refresh(F0); phase_norm(F, DEPTH); }
#undef IN
#undef SEAM
}

extern "C" void kernel_launch(void* const* d_in, const int* in_sizes, int n_in, void* d_out, int out_size, void* d_ws, size_t ws_size, hipStream_t stream) {
    static int grid = 0;
    if (grid == 0) {
        if (n_in != 36 || out_size != NLAT * DM || ws_size < WS_END) { fprintf(stderr, "kernel_launch: unexpected shapes (n_in %d out %d ws %zu)\n", n_in, out_size, ws_size); grid = -1; return; }
        int dev = 0, cus = 0, per_cu = 0;
        if (hipGetDevice(&dev) != hipSuccess || hipDeviceGetAttribute(&cus, hipDeviceAttributeMultiprocessorCount, dev) != hipSuccess) { grid = -1; return; }
        if (hipFuncSetAttribute((const void*)fwd_kernel, hipFuncAttributeMaxDynamicSharedMemorySize, LDS_BYTES) != hipSuccess) { fprintf(stderr, "kernel_launch: hipFuncSetAttribute failed\n"); grid = -1; return; }
        if (hipOccupancyMaxActiveBlocksPerMultiprocessor(&per_cu, (const void*)fwd_kernel, 512, LDS_BYTES) != hipSuccess || per_cu < 1) { fprintf(stderr, "kernel_launch: occupancy query says %d\n", per_cu); }
        (void)hipGetLastError();
        grid = cus;
    }
    if (grid < 0) return;
    (void)hipMemsetAsync((char*)d_ws + WS_CTL, 0, CTL_BYTES, stream);
    Args a{};
    for (int i = 0; i < 36; ++i) a.in[i] = (const float*)d_in[i];
    a.out = (float*)d_out; a.ws = (unsigned char*)d_ws;
#if MK_ONE_LAUNCH
    a.ph_lo = 0; a.ph_hi = NPHASE;
    hipLaunchKernelGGL(fwd_kernel, dim3(grid), dim3(512), LDS_BYTES, stream, a);
#else
    for (int ph = 0; ph < NPHASE; ++ph) { a.ph_lo = ph; a.ph_hi = ph + 1; hipLaunchKernelGGL(fwd_kernel, dim3(grid), dim3(512), LDS_BYTES, stream, a); }
#endif
}
```

```cpp
#include <hip/hip_runtime.h>
#include <cstdio>
#include <cstdint>

#ifndef MK_ONE_LAUNCH
#define MK_ONE_LAUNCH 1
#endif

#define LAS __attribute__((address_space(3)))
typedef unsigned short bf16;
typedef short bf16x8 __attribute__((ext_vector_type(8)));
typedef float f32x4 __attribute__((ext_vector_type(4)));
typedef float f32x2 __attribute__((ext_vector_type(2)));
typedef unsigned u32x4 __attribute__((ext_vector_type(4)));
typedef unsigned u32x2 __attribute__((ext_vector_type(2)));

constexpr int NB = 8, TLAT = 2048, TCTX = 256, SQ = 2304, DM = 1024, DEPTH = 4;
constexpr int NLAT = NB * TLAT, NCTXR = NB * TCTX, NROW = NLAT + NCTXR;
constexpr int NIN = 2984, NP = 3072;
constexpr int C_NA = 0, C_MLA = 768, C_DF = 1184, C_SSD = 1952;
constexpr int C_Z = C_SSD, C_XBC = C_SSD + 256, C_DT = C_SSD + 1024;
constexpr float EPS = 1e-6f;
constexpr int NEXP = 16, FF = 512, ACT_ROWS = 40960;
constexpr int NPH_L = 10, PH_FINAL = 1 + NPH_L * DEPTH, NPHASE = PH_FINAL + 1;

constexpr size_t MiB = 1u << 20;
constexpr size_t WS_CTL = 0, CTL_BYTES = 1 * MiB;
constexpr size_t WS_MOD = 1 * MiB;
constexpr size_t WS_ROPE = 2 * MiB;
constexpr size_t WS_WIN = 4 * MiB;
constexpr size_t WS_WOUT = 28 * MiB;
constexpr size_t WS_WQB = 36 * MiB;
constexpr size_t WS_WKVB = 37 * MiB;
constexpr size_t WS_WGU = 38 * MiB;
constexpr size_t WS_WD = 70 * MiB;
constexpr size_t WS_HC = 86 * MiB;
constexpr size_t WS_A = 94 * MiB;
constexpr size_t WS_P = 130 * MiB;
constexpr size_t WS_ACT = 130 * MiB;
constexpr size_t WS_YK = 170 * MiB;
constexpr size_t WS_MIX = 238 * MiB;
constexpr size_t WS_QNA = 274 * MiB, WS_KNA = 283 * MiB, WS_VNA = 292 * MiB;
constexpr size_t WS_QML = 301 * MiB, WS_KML = 315 * MiB, WS_VML = 329 * MiB;
constexpr size_t WS_QDF = 338 * MiB, WS_KDF = 347 * MiB, WS_VDF = 356 * MiB;
constexpr size_t WS_XT = 365 * MiB, WS_BTM = 374 * MiB, WS_BT = 383 * MiB, WS_CTM = 392 * MiB;
constexpr size_t WS_DT = 401 * MiB;
constexpr size_t WS_CST = 402 * MiB;
constexpr size_t WS_CDEC = 474 * MiB;
constexpr size_t WS_HENT = 475 * MiB;
constexpr size_t WS_RT = 511 * MiB;
constexpr size_t WS_ELIST = 512 * MiB;
constexpr size_t WS_END = 514 * MiB;
constexpr int CW_BAR = 4096;
constexpr int CW_ECNT = 16384;
constexpr int CW_KMAX = 65536;
constexpr int CW_QUEUE = 32768;

constexpr int RING_BYTES = 131072, LDSCTL_OFF = RING_BYTES, LDS_BYTES = 147456;

typedef float f32x16 __attribute__((ext_vector_type(16)));
#define MFMA32(a, b, c) __builtin_amdgcn_mfma_f32_32x32x16_bf16((a), (b), (c), 0, 0, 0)
__device__ __forceinline__ int crow16(int reg, int hh) { return (reg & 3) + 8 * (reg >> 2) + 4 * hh; }
__device__ __forceinline__ float bf2f(bf16 v) { return __uint_as_float(((unsigned)v) << 16); }
__device__ __forceinline__ bf16 f2bf(float f) { unsigned u = __float_as_uint(f); return (bf16)((u + 0x7fffu + ((u >> 16) & 1u)) >> 16); }
__device__ __forceinline__ unsigned pk2(float lo, float hi) { return (unsigned)f2bf(lo) | ((unsigned)f2bf(hi) << 16); }
template <int CTRL> __device__ __forceinline__ float dppf(float v) { return __int_as_float(__builtin_amdgcn_update_dpp(0, __float_as_int(v), CTRL, 0xF, 0xF, true)); }
__device__ __forceinline__ float rlane(float v, int l) { return __int_as_float(__builtin_amdgcn_readlane(__float_as_int(v), l)); }
__device__ __forceinline__ float wsum(float v) {
    v += dppf<0xB1>(v); v += dppf<0x4E>(v); v += dppf<0x141>(v); v += dppf<0x140>(v);
    return (rlane(v, 0) + rlane(v, 16)) + (rlane(v, 32) + rlane(v, 48)); }
__device__ __forceinline__ float wmaxf(float v) {
    v = fmaxf(v, dppf<0xB1>(v)); v = fmaxf(v, dppf<0x4E>(v)); v = fmaxf(v, dppf<0x141>(v)); v = fmaxf(v, dppf<0x140>(v));
    return fmaxf(fmaxf(rlane(v, 0), rlane(v, 16)), fmaxf(rlane(v, 32), rlane(v, 48))); }
#define LDS_WAIT() asm volatile("s_waitcnt lgkmcnt(0)" ::: "memory")
__device__ __forceinline__ void row2bs(int r, int& b, int& s) { if (r < NLAT) { b = r >> 11; s = 256 + (r & 2047); } else { const int j = r - NLAT; b = j >> 8; s = j & 255; } }
__device__ __forceinline__ int bs2row(int b, int s) { return s < 256 ? NLAT + b * 256 + s : b * 2048 + s - 256; }
__device__ __forceinline__ int vpos(int s) { return (s & ~12) | ((s & 4) << 1) | ((s & 8) >> 1); }
__device__ __forceinline__ float siluf(float x) { return x / (1.f + __expf(-x)); }

#define XB_TMO      128
#define XB_XCNT(j)  (256  + 64 * (j))
#define XB_XSUB(j)  (1280 + 64 * (j))
#define XB_XGEN(j)  (2304 + 64 * (j))
#define XB_TOP      3328
#define XB_TOPGEN   3392
#define XCD_BAR_WORDS 3456
#define XB_SPIN_CAP (1u << 24)
__device__ __forceinline__ unsigned xb_ld(unsigned* p)              { return __hip_atomic_load(p, __ATOMIC_RELAXED, __HIP_MEMORY_SCOPE_AGENT); }
__device__ __forceinline__ unsigned xb_add(unsigned* p, unsigned v) { return __hip_atomic_fetch_add(p, v, __ATOMIC_RELAXED, __HIP_MEMORY_SCOPE_AGENT); }
__device__ __forceinline__ unsigned xb_xcc_id() { return (unsigned)__builtin_amdgcn_s_getreg((3 << 11) | 20) & 0xFu; }
#define XB_SPIN(cond, bar) do { unsigned _sp = 0; while (cond) { __builtin_amdgcn_s_sleep(1); \
    if ((++_sp & 255u) == 0u) { if (xb_ld(&(bar)[XB_TMO])) break; if (_sp > XB_SPIN_CAP) { atomicAdd(&(bar)[XB_TMO], 1u); break; } } } } while (0)
struct XcdBarrier { unsigned* bar; unsigned x; volatile LAS unsigned* st; };
__device__ __forceinline__ XcdBarrier xcd_barrier_post(unsigned* bar, volatile LAS unsigned* st) {
    XcdBarrier b; b.bar = bar; b.x = xb_xcc_id(); b.st = st;
    if (threadIdx.x == 0) (void)xb_add(&bar[XB_XCNT(b.x)], 1u);
    return b;
}
__device__ __forceinline__ void xcd_barrier_complete(unsigned* bar, unsigned x, unsigned& nloc, unsigned& nx) {
    const unsigned G = gridDim.x * gridDim.y * gridDim.z;
    unsigned sum, cnt, mine, sp = 0u;
    for (;;) {
        sum = 0u; cnt = 0u; mine = 0u;
#pragma unroll
        for (unsigned j = 0; j < 16; ++j) { const unsigned c = xb_ld(&bar[XB_XCNT(j)]); sum += c; cnt += (c > 0u) ? 1u : 0u; mine = (j == x) ? c : mine; }
        if (sum == G) break;
        __builtin_amdgcn_s_sleep(1);
        if ((++sp & 255u) == 0u) { if (xb_ld(&bar[XB_TMO])) break; if (sp > XB_SPIN_CAP) { atomicAdd(&bar[XB_TMO], 1u); break; } }
    }
    nloc = mine > 0u ? mine : 1u; nx = cnt > 0u ? cnt : 1u;
}
__device__ __forceinline__ void xcd_barrier(const XcdBarrier& b) {
    asm volatile("s_waitcnt vmcnt(0)" ::: "memory");
    __syncthreads();
    if (threadIdx.x == 0) {
        unsigned* bar = b.bar;
        __builtin_amdgcn_s_waitcnt(0);
        unsigned nloc = b.st[0], nx = b.st[1];
        if (nloc == 0u) { xcd_barrier_complete(bar, b.x, nloc, nx); b.st[0] = nloc; b.st[1] = nx; }
        const unsigned old = xb_add(&bar[XB_XSUB(b.x)], 1u);
        const unsigned gen = old / nloc;
        if (old + 1u == (gen + 1u) * nloc) {
            __builtin_amdgcn_fence(__ATOMIC_RELEASE, "agent");
            asm volatile("s_waitcnt vmcnt(0)" ::: "memory");
            const unsigned og = xb_add(&bar[XB_TOP], 1u);
            const unsigned tg = og / nx;
            if (og + 1u == (tg + 1u) * nx) xb_add(&bar[XB_TOPGEN], 1u);
            else XB_SPIN(xb_ld(&bar[XB_TOPGEN]) == tg, bar);
            __builtin_amdgcn_fence(__ATOMIC_ACQUIRE, "agent");
            xb_add(&bar[XB_XGEN(b.x)], 1u);
            asm volatile("s_waitcnt vmcnt(0)" ::: "memory");
        } else {
            XB_SPIN(xb_ld(&bar[XB_XGEN(b.x)]) == gen, bar);
            __builtin_amdgcn_fence(__ATOMIC_ACQUIRE, "agent");
            asm volatile("s_waitcnt vmcnt(0)" ::: "memory");
        }
    }
    __syncthreads();
}

namespace pg8 {
constexpr int BM = 256, BK = 64, HALF = 128, HTB = HALF * BK * 2, NXCD = 8, WGM = 8;
__device__ __forceinline__ int lds_byte(int r, int c) { const int st = (r >> 4) * 2 + (c >> 5), rr = r & 15, cc = c & 31, ob = rr * 64 + cc * 2; return st * 1024 + (ob ^ (((ob >> 9) & 1) << 5)); }
__device__ __forceinline__ void stage_rc(int b, int& R, int& C) { const int st = b / 1024, sb = b % 1024, swz = sb ^ (((sb >> 9) & 1) << 5); R = (st >> 1) * 16 + swz / 64; C = (st & 1) * 32 + (swz % 64) / 2; }
__device__ __forceinline__ int perm32(int rho) { const int n = rho >> 4, i = rho & 15; return 8 * (i >> 2) + 4 * n + (i & 3); }
struct Unit { int pm, pn, e, j, cnt; };

template <class Epi, class Sched>
__device__ __forceinline__ void gemm_phase(LAS unsigned char* lds, const int tid, const int K, const Sched& S, const Epi& E) {
    const int wid = __builtin_amdgcn_readfirstlane(tid >> 6), lane = tid & 63, wr = wid >> 2, wc = wid & 3, fr = lane & 15, fq = lane >> 4;
    const int nt = K / BK;
    int Rr[2]; unsigned Cb[2], voffB[2];
#pragma unroll
    for (int i = 0; i < 2; ++i) { int R, C; stage_rc(tid * 16 + i * 8192, R, C); const int Rb = Epi::PERM ? ((R & ~31) + perm32(R & 31)) : R;
        Rr[i] = R; Cb[i] = (unsigned)C * 2u; voffB[i] = (unsigned)(Rb * K + C) * 2u; }
    const size_t kstep = (size_t)(BK * 2);
    const size_t hstep = (size_t)HALF * K * 2;
    const unsigned ldsw = (unsigned)wid * 1024u;
    const int aoff = lds_byte(wr * 64 + fr, fq * 8), boff = lds_byte(wc * 32 + fr, fq * 8);
#define PG8_SA(b, h) (((b) * 2 + (h)) * HTB)
#define PG8_SB(b, h) ((4 + (b) * 2 + (h)) * HTB)
#define PG8_STAGE(bufoff, gbase, voff) do { _Pragma("unroll") for (int _i = 0; _i < 2; ++_i) \
        __builtin_amdgcn_global_load_lds((const unsigned*)((const char*)(gbase) + (voff)[_i]), (LAS unsigned*)(lds + (bufoff) + ldsw + _i * 8192), 16, 0, 0); } while (0)
#define PG8_LDA(dst, b, h) do { _Pragma("unroll") for (int m = 0; m < 4; ++m) _Pragma("unroll") for (int k = 0; k < 2; ++k) dst[m][k] = *(const LAS bf16x8*)(lds + PG8_SA(b, h) + aoff + m * 2048 + k * 1024); } while (0)
#define PG8_LDB(dst, b, h) do { _Pragma("unroll") for (int n = 0; n < 2; ++n) _Pragma("unroll") for (int k = 0; k < 2; ++k) dst[n][k] = *(const LAS bf16x8*)(lds + PG8_SB(b, h) + boff + n * 2048 + k * 1024); } while (0)
#define PG8_MMA(ai, bj, At, Bt) do { __builtin_amdgcn_s_setprio(1); _Pragma("unroll") for (int m = 0; m < 4; ++m) _Pragma("unroll") for (int n = 0; n < 2; ++n) _Pragma("unroll") for (int k = 0; k < 2; ++k) \
        acc[ai][bj][m][n] = __builtin_amdgcn_mfma_f32_16x16x32_bf16(Bt[n][k], At[m][k], acc[ai][bj][m][n], 0, 0, 0); __builtin_amdgcn_s_setprio(0); } while (0)
#define PG8_WAIT_V(n) asm volatile("s_waitcnt vmcnt(" #n ")" ::: "memory")
#define PG8_WAIT_L(n) asm volatile("s_waitcnt lgkmcnt(" #n ")" ::: "memory")
#define PG8_BAR __builtin_amdgcn_s_barrier()
#define PG8_SCHED __builtin_amdgcn_sched_barrier(0)
    Unit cur, nxt; int ui = 0;
    if (!S.next(0, cur)) return;
    f32x4 acc[2][2][4][2];
#pragma unroll
    for (int a = 0; a < 2; ++a)
#pragma unroll
        for (int b = 0; b < 2; ++b)
#pragma unroll
            for (int m = 0; m < 4; ++m)
#pragma unroll
                for (int n = 0; n < 2; ++n) acc[a][b][m][n] = (f32x4){0.f, 0.f, 0.f, 0.f};
    bf16x8 At[4][2], B0[2][2], B1[2][2];
    unsigned vA0[2], vA1[2];
    const char* cA = S.a_ptr(cur);
    if constexpr (Sched::GATHER) { S.a_offs(cur, Rr, vA0, vA1);
#pragma unroll
        for (int i = 0; i < 2; ++i) { vA0[i] += Cb[i]; vA1[i] += Cb[i]; }
        asm volatile("s_waitcnt vmcnt(0)" ::: "memory");
    } else {
#pragma unroll
        for (int i = 0; i < 2; ++i) { vA0[i] = (unsigned)(Rr[i] * K * 2) + Cb[i]; vA1[i] = vA0[i]; } }
    const size_t ahs = Sched::GATHER ? (size_t)0 : hstep;
    const char* cB = S.b_ptr(cur);
    PG8_STAGE(PG8_SB(0, 0), cB, voffB); PG8_STAGE(PG8_SB(0, 1), cB + hstep, voffB); PG8_STAGE(PG8_SA(0, 0), cA, vA0); PG8_STAGE(PG8_SA(0, 1), cA + ahs, vA1);
    if (wr == 1) PG8_BAR;
    PG8_WAIT_V(2); PG8_BAR;
    PG8_STAGE(PG8_SB(1, 0), cB + kstep, voffB); PG8_STAGE(PG8_SA(1, 0), cA + kstep, vA0); PG8_STAGE(PG8_SB(1, 1), cB + hstep + kstep, voffB);
    PG8_WAIT_V(6); PG8_BAR;
    for (;;) {
        const bool has_next = S.next(ui + 1, nxt);
        const char* nA = has_next ? S.a_ptr(nxt) : cA; const char* nB = has_next ? S.b_ptr(nxt) : cB;
        for (int t = 0; t < nt; t += 2) {
            const bool last = (t == nt - 2);
            const char* a1 = cA + (size_t)(t + 1) * kstep;
            const char* a2 = last ? nA : cA + (size_t)(t + 2) * kstep; const char* b2 = last ? nB : cB + (size_t)(t + 2) * kstep;
            const char* a3 = a2 + kstep; const char* b3 = b2 + kstep;
            PG8_LDB(B0, 0, 0); PG8_LDB(B1, 0, 1); PG8_SCHED; PG8_LDA(At, 0, 0); PG8_STAGE(PG8_SA(1, 1), a1 + ahs, vA1);
            if constexpr (Sched::GATHER) { if (last && has_next) { S.a_offs(nxt, Rr, vA0, vA1);
#pragma unroll
                for (int i = 0; i < 2; ++i) { vA0[i] += Cb[i]; vA1[i] += Cb[i]; }
                asm volatile("s_waitcnt vmcnt(0)" ::: "memory"); } }
            PG8_WAIT_V(8); PG8_WAIT_L(0); PG8_BAR; PG8_MMA(0, 0, At, B0); PG8_MMA(0, 1, At, B1); PG8_BAR; PG8_SCHED;
            PG8_LDA(At, 0, 1); PG8_STAGE(PG8_SB(0, 0), b2, voffB); PG8_STAGE(PG8_SB(0, 1), b2 + hstep, voffB); PG8_STAGE(PG8_SA(0, 0), a2, vA0);
            PG8_WAIT_V(8); PG8_WAIT_L(0); PG8_BAR; PG8_MMA(1, 0, At, B0); PG8_MMA(1, 1, At, B1); PG8_BAR; PG8_SCHED;
            PG8_LDB(B0, 1, 0); PG8_LDB(B1, 1, 1); PG8_SCHED; PG8_LDA(At, 1, 0); PG8_STAGE(PG8_SA(0, 1), a2 + ahs, vA1);
            PG8_WAIT_V(8); PG8_WAIT_L(0); PG8_BAR; PG8_MMA(0, 0, At, B0); PG8_MMA(0, 1, At, B1); PG8_BAR; PG8_SCHED;
            PG8_LDA(At, 1, 1); PG8_STAGE(PG8_SB(1, 0), b3, voffB); PG8_STAGE(PG8_SB(1, 1), b3 + hstep, voffB); PG8_STAGE(PG8_SA(1, 0), a3, vA0);
            PG8_WAIT_V(8); PG8_WAIT_L(0); PG8_BAR; PG8_MMA(1, 0, At, B0); PG8_MMA(1, 1, At, B1); PG8_BAR; PG8_SCHED;
        }
        if (wr == 0) PG8_BAR;
        E(acc, cur, wr, wc, fr, fq);
        if (!has_next) break;
#pragma unroll
        for (int a = 0; a < 2; ++a)
#pragma unroll
            for (int b = 0; b < 2; ++b)
#pragma unroll
                for (int m = 0; m < 4; ++m)
#pragma unroll
                    for (int n = 0; n < 2; ++n) acc[a][b][m][n] = (f32x4){0.f, 0.f, 0.f, 0.f};
        cur = nxt; cA = nA; cB = nB; ++ui;
        if (wr == 1) PG8_BAR;
    }
    PG8_WAIT_V(0);
    PG8_BAR;
#undef PG8_SA
#undef PG8_SB
#undef PG8_STAGE
#undef PG8_LDA
#undef PG8_LDB
#undef PG8_MMA
#undef PG8_WAIT_V
#undef PG8_WAIT_L
#undef PG8_BAR
#undef PG8_SCHED
}
__device__ __forceinline__ unsigned cvt_pk_bf16(float lo, float hi) { unsigned r; asm volatile("v_cvt_pk_bf16_f32 %0, %1, %2" : "=v"(r) : "v"(lo), "v"(hi)); return r; }

struct DenseSched {
    const char* A; const char* Bt; int K, nM, nN, nwg, G, c;
    __device__ void init(const void* A_, const void* Bt_, int K_, int M, int N, int G_, int c_) { A = (const char*)A_; Bt = (const char*)Bt_; K = K_; nM = M / BM; nN = N / BM; nwg = nM * nN; G = G_; c = c_; }
    __device__ __forceinline__ bool next(int i, Unit& u) const {
        const long L = (long)i * G + c; if (L >= nwg) return false;
        int wgid = (int)L; { const int q = nwg / NXCD, r = nwg % NXCD, xcd = wgid % NXCD, off = wgid / NXCD; wgid = (xcd < r ? xcd * (q + 1) : r * (q + 1) + (xcd - r) * q) + off; }
        const int nig = WGM * nN, gid = wgid / nig, fm = gid * WGM, gsz = (nM - fm) < WGM ? (nM - fm) : WGM;
        u.pm = fm + ((wgid % nig) % gsz); u.pn = (wgid % nig) / gsz; u.e = 0; u.j = 0; u.cnt = 256; return true;
    }
    static constexpr bool GATHER = false;
    __device__ __forceinline__ const char* a_ptr(const Unit& u) const { return A + (size_t)u.pm * BM * K * 2; }
    __device__ __forceinline__ void a_offs(const Unit&, const int (&)[2], unsigned (&)[2], unsigned (&)[2]) const {}
    __device__ __forceinline__ const char* b_ptr(const Unit& u) const { return Bt + (size_t)u.pn * BM * K * 2; }
};
template <bool GATHER_> struct MoeSched {
    static constexpr bool GATHER = GATHER_;
    const char* A; const char* W; size_t wstride; int K, G, c; const int* elist; const volatile LAS int* T; const volatile LAS int* Cn;
    __device__ __forceinline__ bool next(int i, Unit& u) const {
        const long L = (long)i * G + c; const int nT = T[16]; if (L >= 4L * nT) return false;
        const int tile = (int)(L >> 2); u.pn = (int)(L & 3); u.pm = tile;
        int e = 0;
#pragma unroll
        for (int k = 1; k < 16; ++k) e += (tile >= T[k]) ? 1 : 0;
        u.e = e; u.j = tile - T[e]; u.cnt = Cn[e]; return true;
    }
    __device__ __forceinline__ const char* a_ptr(const Unit& u) const { return GATHER ? A : A + (size_t)u.pm * BM * K * 2; }
    __device__ __forceinline__ void a_offs(const Unit& u, const int (&Rr)[2], unsigned (&v0)[2], unsigned (&v1)[2]) const {
#pragma unroll
        for (int i = 0; i < 2; ++i) {
            const int p0 = u.j * BM + Rr[i], p1 = p0 + HALF;
            int t0 = p0 < u.cnt ? (elist[u.e * NROW + p0] >> 1) : 0, t1 = p1 < u.cnt ? (elist[u.e * NROW + p1] >> 1) : 0;
            t0 = min(max(t0, 0), NROW - 1); t1 = min(max(t1, 0), NROW - 1);
            v0[i] = (unsigned)(t0 * K * 2); v1[i] = (unsigned)(t1 * K * 2);
        } }
    __device__ __forceinline__ const char* b_ptr(const Unit& u) const { return W + (size_t)u.e * wstride + (size_t)u.pn * BM * K * 2; }
};
struct EpiP {
    static constexpr bool PERM = true;
    bf16* O;
    __device__ __forceinline__ void operator()(const f32x4 (&acc)[2][2][4][2], const Unit& u, int wr, int wc, int fr, int fq) const {
        const int row0 = u.pm * BM + wr * 64 + fr, col0 = u.pn * BM + wc * 32 + 8 * fq;
#pragma unroll
        for (int ai = 0; ai < 2; ++ai)
#pragma unroll
            for (int m = 0; m < 4; ++m) { bf16* rowp = O + (size_t)(row0 + ai * HALF + m * 16) * NP + col0;
#pragma unroll
                for (int bj = 0; bj < 2; ++bj) { const f32x4 v0 = acc[ai][bj][m][0], v1 = acc[ai][bj][m][1];
                    u32x4 w; w.x = cvt_pk_bf16(v0[0], v0[1]); w.y = cvt_pk_bf16(v0[2], v0[3]); w.z = cvt_pk_bf16(v1[0], v1[1]); w.w = cvt_pk_bf16(v1[2], v1[3]);
                    *(u32x4*)(rowp + bj * HALF) = w; } }
    }
};
struct EpiRes {
    static constexpr bool PERM = false;
    const float* hin_l; const float* hin_c; float* hout_l; float* hout_c; const float* gate; float gsc;
    __device__ __forceinline__ void operator()(const f32x4 (&acc)[2][2][4][2], const Unit& u, int wr, int wc, int fr, int fq) const {
        const int row0 = u.pm * BM + wr * 64 + fr, col0 = u.pn * BM + wc * 32 + 4 * fq;
#pragma unroll
        for (int ai = 0; ai < 2; ++ai)
#pragma unroll
            for (int m = 0; m < 4; ++m) { const int r = row0 + ai * HALF + m * 16; const bool lat = r < NLAT; const int bb = lat ? (r >> 11) : 8;
                const float* hi = lat ? hin_l + (size_t)r * DM : hin_c + (size_t)(r - NLAT) * DM; float* ho = lat ? hout_l + (size_t)r * DM : hout_c + (size_t)(r - NLAT) * DM;
                const float* g = gate + (size_t)bb * 6144;
#pragma unroll
                for (int bj = 0; bj < 2; ++bj)
#pragma unroll
                    for (int n = 0; n < 2; ++n) { const int c = col0 + bj * HALF + n * 16; const f32x4 gv = *(const f32x4*)(g + c), hv = *(const f32x4*)(hi + c);
                        *(f32x4*)(ho + c) = hv + gv * gsc * acc[ai][bj][m][n]; } }
    }
};
struct EpiAct {
    static constexpr bool PERM = true;
    bf16* O;
    __device__ __forceinline__ void operator()(const f32x4 (&acc)[2][2][4][2], const Unit& u, int wr, int wc, int fr, int fq) const {
        const int row0 = u.pm * BM + wr * 64 + fr, col0 = u.pn * HALF + wc * 32 + 8 * fq;
#pragma unroll
        for (int ai = 0; ai < 2; ++ai)
#pragma unroll
            for (int m = 0; m < 4; ++m) { bf16* rowp = O + (size_t)(row0 + ai * HALF + m * 16) * FF + col0;
                float o[8];
#pragma unroll
                for (int n = 0; n < 2; ++n)
#pragma unroll
                    for (int j = 0; j < 4; ++j) { const float g = acc[ai][0][m][n][j], up = acc[ai][1][m][n][j]; o[n * 4 + j] = g / (1.f + __expf(-g)) * up; }
                u32x4 w; w.x = cvt_pk_bf16(o[0], o[1]); w.y = cvt_pk_bf16(o[2], o[3]); w.z = cvt_pk_bf16(o[4], o[5]); w.w = cvt_pk_bf16(o[6], o[7]);
                *(u32x4*)rowp = w; }
    }
};
struct EpiDown {
    static constexpr bool PERM = true;
    bf16* O; const int* elist; const float* rtw;
    __device__ __forceinline__ void operator()(const f32x4 (&acc)[2][2][4][2], const Unit& u, int wr, int wc, int fr, int fq) const {
        const int col0 = u.pn * BM + wc * 32 + 8 * fq;
#pragma unroll
        for (int ai = 0; ai < 2; ++ai)
#pragma unroll
            for (int m = 0; m < 4; ++m) { const int pos = u.j * BM + ai * HALF + wr * 64 + m * 16 + fr;
                if (pos < u.cnt) { const int a = min(max(elist[u.e * NROW + pos], 0), 2 * NROW - 1); const float w8 = rtw[a]; bf16* rowp = O + (size_t)a * DM + col0;
#pragma unroll
                    for (int bj = 0; bj < 2; ++bj) { const f32x4 v0 = acc[ai][bj][m][0] * w8, v1 = acc[ai][bj][m][1] * w8;
                        u32x4 w; w.x = cvt_pk_bf16(v0[0], v0[1]); w.y = cvt_pk_bf16(v0[2], v0[3]); w.z = cvt_pk_bf16(v1[0], v1[1]); w.w = cvt_pk_bf16(v1[2], v1[3]);
                        *(u32x4*)(rowp + bj * HALF) = w; } } }
    }
};
}

struct Args { const float* in[36]; float* out; unsigned char* ws; int ph_lo, ph_hi; };
struct Fr {
    LAS unsigned char* lds; int tid, lane, wave, G, vcu, gw, NGW; const __attribute__((address_space(4))) Args* A;
    __device__ __forceinline__ const float* x() const { return A->in[0]; }
    __device__ __forceinline__ const float* cvec() const { return A->in[1]; }
    __device__ __forceinline__ const float* ctx() const { return A->in[2]; }
    __device__ __forceinline__ const float* cctx() const { return A->in[3]; }
    __device__ __forceinline__ const float* w_mod() const { return A->in[4]; }
    __device__ __forceinline__ const float* b_mod() const { return A->in[5]; }
    __device__ __forceinline__ const float* g_mix() const { return A->in[6]; }
    __device__ __forceinline__ const float* w_in() const { return A->in[7]; }
    __device__ __forceinline__ const float* w_out() const { return A->in[8]; }
    __device__ __forceinline__ const float* na_gq() const { return A->in[9]; }
    __device__ __forceinline__ const float* na_gk() const { return A->in[10]; }
    __device__ __forceinline__ const float* na_rb() const { return A->in[11]; }
    __device__ __forceinline__ const float* mla_gqa() const { return A->in[12]; }
    __device__ __forceinline__ const float* mla_wqb() const { return A->in[13]; }
    __device__ __forceinline__ const float* mla_gkva() const { return A->in[14]; }
    __device__ __forceinline__ const float* mla_wkvb() const { return A->in[15]; }
    __device__ __forceinline__ const float* mla_gq() const { return A->in[16]; }
    __device__ __forceinline__ const float* mla_gk() const { return A->in[17]; }
    __device__ __forceinline__ const float* df_gq() const { return A->in[18]; }
    __device__ __forceinline__ const float* df_gk() const { return A->in[19]; }
    __device__ __forceinline__ const float* df_lam() const { return A->in[20]; }
    __device__ __forceinline__ const float* df_gsub() const { return A->in[21]; }
    __device__ __forceinline__ const float* conv_w() const { return A->in[22]; }
    __device__ __forceinline__ const float* conv_b() const { return A->in[23]; }
    __device__ __forceinline__ const float* dt_bias() const { return A->in[24]; }
    __device__ __forceinline__ const float* a_log() const { return A->in[25]; }
    __device__ __forceinline__ const float* ssd_d() const { return A->in[26]; }
    __device__ __forceinline__ const float* ssd_gn() const { return A->in[27]; }
    __device__ __forceinline__ const float* g_ffn() const { return A->in[28]; }
    __device__ __forceinline__ const float* w_grp() const { return A->in[29]; }
    __device__ __forceinline__ const float* b_grp() const { return A->in[30]; }
    __device__ __forceinline__ const float* w_exp() const { return A->in[31]; }
    __device__ __forceinline__ const float* b_exp() const { return A->in[32]; }
    __device__ __forceinline__ const float* w_gate() const { return A->in[33]; }
    __device__ __forceinline__ const float* w_up() const { return A->in[34]; }
    __device__ __forceinline__ const float* w_down() const { return A->in[35]; }
    __device__ __forceinline__ float* out() const { return A->out; }
    __device__ __forceinline__ unsigned* ctl() const { return (unsigned*)(A->ws + WS_CTL); }
    __device__ __forceinline__ float* modv() const { return (float*)(A->ws + WS_MOD); }
    __device__ __forceinline__ float* rcos() const { return (float*)(A->ws + WS_ROPE); }
    __device__ __forceinline__ float* rsin() const { return (float*)(A->ws + WS_ROPE + TLAT * 16 * 4); }
    __device__ __forceinline__ bf16* winT() const { return (bf16*)(A->ws + WS_WIN); }
    __device__ __forceinline__ bf16* woutT() const { return (bf16*)(A->ws + WS_WOUT); }
    __device__ __forceinline__ bf16* wqbT() const { return (bf16*)(A->ws + WS_WQB); }
    __device__ __forceinline__ bf16* wkvbT() const { return (bf16*)(A->ws + WS_WKVB); }
    __device__ __forceinline__ bf16* wgu() const { return (bf16*)(A->ws + WS_WGU); }
    __device__ __forceinline__ bf16* wd() const { return (bf16*)(A->ws + WS_WD); }
    __device__ __forceinline__ float* hc() const { return (float*)(A->ws + WS_HC); }
    __device__ __forceinline__ bf16* abuf() const { return (bf16*)(A->ws + WS_A); }
    __device__ __forceinline__ bf16* pbuf() const { return (bf16*)(A->ws + WS_P); }
    __device__ __forceinline__ bf16* act() const { return (bf16*)(A->ws + WS_ACT); }
    __device__ __forceinline__ bf16* yk() const { return (bf16*)(A->ws + WS_YK); }
    __device__ __forceinline__ bf16* mix() const { return (bf16*)(A->ws + WS_MIX); }
    __device__ __forceinline__ bf16* qna() const { return (bf16*)(A->ws + WS_QNA); }
    __device__ __forceinline__ bf16* kna() const { return (bf16*)(A->ws + WS_KNA); }
    __device__ __forceinline__ bf16* vna() const { return (bf16*)(A->ws + WS_VNA); }
    __device__ __forceinline__ bf16* qml() const { return (bf16*)(A->ws + WS_QML); }
    __device__ __forceinline__ bf16* kml() const { return (bf16*)(A->ws + WS_KML); }
    __device__ __forceinline__ bf16* vml() const { return (bf16*)(A->ws + WS_VML); }
    __device__ __forceinline__ bf16* qdf() const { return (bf16*)(A->ws + WS_QDF); }
    __device__ __forceinline__ bf16* kdf() const { return (bf16*)(A->ws + WS_KDF); }
    __device__ __forceinline__ bf16* vdf() const { return (bf16*)(A->ws + WS_VDF); }
    __device__ __forceinline__ bf16* xT() const { return (bf16*)(A->ws + WS_XT); }
    __device__ __forceinline__ bf16* btm() const { return (bf16*)(A->ws + WS_BTM); }
    __device__ __forceinline__ bf16* bT() const { return (bf16*)(A->ws + WS_BT); }
    __device__ __forceinline__ bf16* ctm() const { return (bf16*)(A->ws + WS_CTM); }
    __device__ __forceinline__ float* dtv() const { return (float*)(A->ws + WS_DT); }
    __device__ __forceinline__ float* cst() const { return (float*)(A->ws + WS_CST); }
    __device__ __forceinline__ float* cdec() const { return (float*)(A->ws + WS_CDEC); }
    __device__ __forceinline__ bf16* hent() const { return (bf16*)(A->ws + WS_HENT); }
    __device__ __forceinline__ float* ydir() const { return (float*)(A->ws + WS_CST); }
    __device__ __forceinline__ int* rte() const { return (int*)(A->ws + WS_RT); }
    __device__ __forceinline__ float* rtw() const { return (float*)(A->ws + WS_RT + 256 * 1024); }
    __device__ __forceinline__ int* elist() const { return (int*)(A->ws + WS_ELIST); }
};

__device__ __forceinline__ Fr refresh(const Fr& F0) { Fr F = F0; int w = F0.wave; asm volatile("" : "+s"(w)); asm volatile("" : "+s"(F.A));
    int l; asm volatile("v_mbcnt_lo_u32_b32 %0, -1, 0\n\tv_mbcnt_hi_u32_b32 %0, -1, %0" : "=v"(l)); F.wave = w; F.lane = l; F.tid = w * 64 + l; F.gw = F.vcu * 8 + w; return F; }
__device__ __forceinline__ void tr_item(const float* W, int ldw, int nvalid, int k0, int n0, bf16* dst, int ldd, LAS float* scr, int lane, const float* ksc = nullptr) {
    const int cn = n0 + (lane & 31), cnc = min(cn, nvalid - 1);
    float tv[32];
#pragma unroll
    for (int i = 0; i < 32; ++i) { const int kk = 2 * i + (lane >> 5); tv[i] = W[(size_t)(k0 + kk) * ldw + cnc]; }
#pragma unroll
    for (int i = 0; i < 32; ++i) { const int kk = 2 * i + (lane >> 5); const float sc1 = ksc ? ksc[k0 + kk] : 1.f; scr[kk * 33 + (lane & 31)] = cn < nvalid ? tv[i] * sc1 : 0.f; }
    LDS_WAIT();
    const int c = lane & 7;
#pragma unroll
    for (int j = 0; j < 4; ++j) { const int n = (lane >> 3) + 8 * j; const LAS float* s = scr + (8 * c) * 33 + n;
        u32x4 o; o.x = pk2(s[0 * 33], s[1 * 33]); o.y = pk2(s[2 * 33], s[3 * 33]); o.z = pk2(s[4 * 33], s[5 * 33]); o.w = pk2(s[6 * 33], s[7 * 33]);
        *(u32x4*)(dst + (size_t)n * ldd + k0 + 8 * c) = o; }
    LDS_WAIT();
}
__device__ __forceinline__ void moe_weight_convert(const Fr& F, int L) {
    LAS float* scr = (LAS float*)(F.lds + F.wave * 16384);
    constexpr int I_GU = 16 * 16, I_D = 8 * 32;
    for (int it = F.gw; it < NEXP * (2 * I_GU + I_D); it += F.NGW) {
        const int e = it / (2 * I_GU + I_D); int r = it % (2 * I_GU + I_D);
        if (r < 2 * I_GU) { const int bj = r / I_GU; r %= I_GU; const int kb = r / 16, nb = r % 16, n0 = nb * 32;
            const float* W = (bj ? F.w_up() : F.w_gate()) + ((size_t)L * NEXP + e) * DM * FF;
            tr_item(W, FF, FF, kb * 64, n0, F.wgu() + ((size_t)e * 1024 + (n0 >> 7) * 256 + bj * 128 + (n0 & 127)) * DM, DM, scr, F.lane);
        } else { r -= 2 * I_GU; const int kb = r / 32, nb = r % 32, n0 = nb * 32;
            const float* W = F.w_down() + ((size_t)L * NEXP + e) * FF * DM;
            tr_item(W, DM, DM, kb * 64, n0, F.wd() + ((size_t)e * 1024 + n0) * FF, FF, scr, F.lane); }
    }
}
__device__ __forceinline__ void phase_prologue(const Fr& F) {
    {   LAS float* sc = (LAS float*)F.lds;
        LAS float* part = (LAS float*)(F.lds + 40960);
        for (int i = F.tid; i < 9 * 1024; i += 512) { const float v = i < 8192 ? F.cvec()[i] : F.cctx()[i - 8192]; sc[i] = siluf(v); }
        __syncthreads();
        for (int u = F.vcu; u < 384; u += F.G) {
            const int col = u * 64 + F.lane, L = col / 6144, n = col - L * 6144;
            const float* w = F.w_mod() + ((size_t)L * 1024 + F.wave * 128) * 6144 + n;
            float acc[9];
#pragma unroll
            for (int b = 0; b < 9; ++b) acc[b] = 0.f;
#pragma unroll 1
            for (int k0 = 0; k0 < 128; k0 += 16) { float wv[16];
#pragma unroll
                for (int j = 0; j < 16; ++j) wv[j] = w[(size_t)(k0 + j) * 6144];
#pragma unroll
                for (int j = 0; j < 16; ++j)
#pragma unroll
                    for (int b = 0; b < 9; ++b) acc[b] += sc[b * 1024 + F.wave * 128 + k0 + j] * wv[j]; }
#pragma unroll
            for (int b = 0; b < 9; ++b) part[(F.wave * 9 + b) * 64 + F.lane] = acc[b];
            __syncthreads();
            for (int i = F.tid; i < 9 * 64; i += 512) { const int b = i >> 6, l = i & 63; float s = 0.f;
#pragma unroll
                for (int w8 = 0; w8 < 8; ++w8) s += part[(w8 * 9 + b) * 64 + l];
                const int c2 = u * 64 + l, L2 = c2 / 6144, n2 = c2 - L2 * 6144;
                F.modv()[((size_t)L2 * 9 + b) * 6144 + n2] = s + F.b_mod()[L2 * 6144 + n2]; }
            __syncthreads();
        }
    }
    if (blockIdx.x == 0 && F.wave < 4) {
#pragma unroll 1
        for (int q = 0; q < 4; ++q) { const int lh = F.wave * 4 + q; float bm = 0.f;
            for (int i = F.lane; i < 465; i += 64) bm = fmaxf(bm, F.na_rb()[lh * 465 + i]);
            bm = wmaxf(bm); if (F.lane == 0) (F.rcos() + 2 * TLAT * 16)[lh] = bm * 1.4426950408889634f; } }
    for (int i = blockIdx.x * 512 + F.tid; i < TLAT * 16; i += F.G * 512) { const int t = i >> 4, k = i & 15; const float inv = powf(10000.f, -(float)(k & 7) / 8.f);
        const float pos = (k < 8) ? (float)(t >> 6) : (float)(t & 63); const float ang = pos * inv; F.rcos()[i] = cosf(ang); F.rsin()[i] = sinf(ang); }
    __syncthreads();
    LAS float* scr = (LAS float*)(F.lds + F.wave * 16384);
    constexpr int I_IN = 16 * 96, I_OUT = 16 * 32, I_QB = 4 * 12, I_KVB = 2 * 16, I_L = I_IN + I_OUT + I_QB + I_KVB;
    for (int it = F.gw; it < DEPTH * I_L; it += F.NGW) {
        const int L = it / I_L; int r = it % I_L;
        if (r < I_IN) { const int kb = r / 96, nb = r % 96; tr_item(F.w_in() + (size_t)L * DM * NIN, NIN, NIN, kb * 64, nb * 32, F.winT() + ((size_t)L * NP + nb * 32) * DM, DM, scr, F.lane); continue; } r -= I_IN;
        if (r < I_OUT) { const int kb = r / 32, nb = r % 32; tr_item(F.w_out() + (size_t)L * DM * DM, DM, DM, kb * 64, nb * 32, F.woutT() + ((size_t)L * DM + nb * 32) * DM, DM, scr, F.lane); continue; } r -= I_OUT;
        if (r < I_QB) { const int kb = r / 12, nb = r % 12; tr_item(F.mla_wqb() + (size_t)L * 256 * 384, 384, 384, kb * 64, nb * 32, F.wqbT() + ((size_t)L * 384 + nb * 32) * 256, 256, scr, F.lane, F.mla_gqa() + L * 256); continue; } r -= I_QB;
        { const int kb = r / 16, nb = r % 16; tr_item(F.mla_wkvb() + (size_t)L * 128 * 512, 512, 512, kb * 64, nb * 32, F.wkvbT() + ((size_t)L * 512 + nb * 32) * 128, 128, scr, F.lane, F.mla_gkva() + L * 128); }
    }
}

__device__ __forceinline__ void phase_norm(const Fr& F, int L, bool combine = true) {
    const int nrows = (L == DEPTH) ? NLAT : NROW;
    for (int r = F.gw; r < nrows; r += F.NGW) {
        const bool lat = r < NLAT; const int bb = lat ? (r >> 11) : 8;
        const float* hin = (L == 0) ? (lat ? F.x() + (size_t)r * DM : F.ctx() + (size_t)(r - NLAT) * DM) : (lat ? F.out() + (size_t)r * DM : F.hc() + (size_t)(r - NLAT) * DM);
        float* hout = lat ? F.out() + (size_t)r * DM : F.hc() + (size_t)(r - NLAT) * DM;
        f32x4 v[4];
#pragma unroll
        for (int j = 0; j < 4; ++j) v[j] = *(const f32x4*)(hin + 4 * F.lane + 256 * j);
        if (L > 0 && combine) {
            const float* m5 = F.modv() + ((size_t)(L - 1) * 9 + bb) * 6144 + 5 * 1024;
#pragma unroll
            for (int j = 0; j < 4; ++j) { const int c = 4 * F.lane + 256 * j; const f32x4 g = *(const f32x4*)(m5 + c);
                const u32x2 y0 = *(const u32x2*)(F.yk() + (size_t)(2 * r) * DM + c), y1 = *(const u32x2*)(F.yk() + (size_t)(2 * r + 1) * DM + c);
                f32x4 ys; ys[0] = __uint_as_float(y0.x << 16) + __uint_as_float(y1.x << 16); ys[1] = __uint_as_float(y0.x & 0xffff0000u) + __uint_as_float(y1.x & 0xffff0000u);
                ys[2] = __uint_as_float(y0.y << 16) + __uint_as_float(y1.y << 16); ys[3] = __uint_as_float(y0.y & 0xffff0000u) + __uint_as_float(y1.y & 0xffff0000u);
                v[j] = v[j] + g * ys; *(f32x4*)(hout + c) = v[j]; }
        }
        if (L == DEPTH) continue;
        float ss = 0.f;
#pragma unroll
        for (int j = 0; j < 4; ++j) ss += (v[j][0] * v[j][0] + v[j][1] * v[j][1]) + (v[j][2] * v[j][2] + v[j][3] * v[j][3]);
        const float rstd = rsqrtf(wsum(ss) * (1.f / DM) + EPS);
        const float* md = F.modv() + ((size_t)L * 9 + bb) * 6144;
#pragma unroll
        for (int j = 0; j < 4; ++j) { const int c = 4 * F.lane + 256 * j; const f32x4 g = *(const f32x4*)(F.g_mix() + L * DM + c), sh = *(const f32x4*)(md + c), scl = *(const f32x4*)(md + 1024 + c);
            const f32x4 a = v[j] * rstd * g * (scl + 1.f) + sh; u32x2 o; o.x = pk2(a[0], a[1]); o.y = pk2(a[2], a[3]); *(u32x2*)(F.abuf() + (size_t)r * DM + c) = o; }
    }
}

__device__ __forceinline__ void prep_row(const Fr& F, int L, int r, LAS float* scr) {
    int lane_ = F.lane; asm volatile("" : "+v"(lane_)); const int lane = lane_; int b, s; row2bs(r, b, s); const bool lat = r < NLAT; const int t = s - 256;
    const bf16* p = F.pbuf() + (size_t)r * NP;
#pragma unroll
    for (int h = 0; h < 4; ++h) {
        const float q = bf2f(p[C_NA + h * 64 + lane]), k = bf2f(p[C_NA + 256 + h * 64 + lane]);
        const float rq = rsqrtf(wsum(q * q) * (1.f / 64) + EPS), rk = rsqrtf(wsum(k * k) * (1.f / 64) + EPS);
        const size_t o = ((size_t)(b * 4 + h) * SQ + s) * 64 + lane;
        F.qna()[o] = f2bf(q * rq * F.na_gq()[L * 64 + lane]); F.kna()[o] = f2bf(k * rk * F.na_gk()[L * 64 + lane]);
    }
    {
        const int idx = lane & 31; float cs = 1.f, sn = 0.f;
        if (lat) { cs = F.rcos()[t * 16 + (idx & 15)]; sn = F.rsin()[t * 16 + (idx & 15)]; }
#pragma unroll
        for (int h = 0; h < 4; ++h) {
            float q = bf2f(p[C_DF + h * 64 + lane]), k = bf2f(p[C_DF + 256 + h * 64 + lane]);
            float sq = q * q, sk = k * k;
#pragma unroll
            for (int o = 16; o >= 1; o >>= 1) { sq += __shfl_xor(sq, o); sk += __shfl_xor(sk, o); }
            q *= rsqrtf(sq * (1.f / 32) + EPS) * F.df_gq()[L * 32 + idx]; k *= rsqrtf(sk * (1.f / 32) + EPS) * F.df_gk()[L * 32 + idx];
            const float qp = __shfl_xor(q, 16), kp = __shfl_xor(k, 16);
            if (lat) { q = (idx < 16) ? q * cs - qp * sn : qp * sn + q * cs; k = (idx < 16) ? k * cs - kp * sn : kp * sn + k * cs; }
            const size_t o = ((size_t)(b * 4 + h) * SQ + s) * 64 + lane;
            F.qdf()[o] = f2bf(q); F.kdf()[o] = f2bf(k);
        }
    }
}
__device__ __forceinline__ void prep_tile(const Fr& F, int L, int b, int c) {
    int tid_ = F.tid; asm volatile("" : "+v"(tid_)); const int tid = tid_;
    const int s0 = 64 * c; const size_t r0 = bs2row(b, s0);
    LAS bf16* Lv = (LAS bf16*)F.lds;
#ifndef PT_MASK
#define PT_MASK 7
#endif
    if (PT_MASK & 1)
#pragma unroll 1
    for (int mx = 0; mx < 2; ++mx) {
        const int voff = mx == 0 ? C_NA + 512 : C_DF + 512; bf16* vt = mx == 0 ? F.vna() : F.vdf();
#pragma unroll
        for (int k = 0; k < 4; ++k) { const int idx = tid + 512 * k, tok = idx >> 5, d8 = (idx & 31) * 8;
            const u32x4 v = *(const u32x4*)(F.pbuf() + (r0 + tok) * NP + voff + d8); const int pc = vpos(tok);
#pragma unroll
            for (int e = 0; e < 4; ++e) { Lv[(d8 + 2 * e) * 72 + pc] = (bf16)(v[e] & 0xffffu); Lv[(d8 + 2 * e + 1) * 72 + pc] = (bf16)(v[e] >> 16); } }
        __syncthreads();
#pragma unroll
        for (int k = 0; k < 4; ++k) { const int idx = tid + 512 * k, dv = idx >> 3, pc = idx & 7;
            const u32x4 v = *(const LAS u32x4*)(Lv + dv * 72 + pc * 8);
#ifndef PT_NOSTORE
#define PT_NOSTORE 0
#endif
            if (!PT_NOSTORE || v.x == 0x12345678u) *(u32x4*)(vt + ((size_t)(b * 4 + (dv >> 6)) * 64 + (dv & 63)) * SQ + s0 + pc * 8) = v; }
        __syncthreads();
    }
    const int len = c < 4 ? TCTX : TLAT, t0 = c < 4 ? s0 : s0 - 256;
    LAS bf16* Lc = (LAS bf16*)F.lds;
    if (PT_MASK & 2)
#pragma unroll 1
    for (int gch = 0; gch < 3; ++gch) {
        {   u32x4 v[5];
#pragma unroll
            for (int k = 0; k < 5; ++k) { const int idx = min(tid + 512 * k, 68 * 32 - 1), j = idx >> 5, c8 = (idx & 31) * 8, tj = t0 - 2 + j, jc = min(max(tj, 0), len - 1) - t0;
                v[k] = *(const u32x4*)(F.pbuf() + (size_t)((long)r0 + jc) * NP + C_XBC + gch * 256 + c8);
                const unsigned keep = (tj >= 0 && tj < len) ? 0xffffffffu : 0u; v[k].x &= keep; v[k].y &= keep; v[k].z &= keep; v[k].w &= keep; }
#pragma unroll
            for (int k = 0; k < 5; ++k) { const int idx = tid + 512 * k, j = idx >> 5, c8 = (idx & 31) * 8; if (idx < 68 * 32) *(LAS u32x4*)(Lc + j * 256 + c8) = v[k]; }
        }
        __syncthreads();
        const int ch = tid & 255, tq = tid >> 8, cg = gch * 256 + ch;
        float w[5];
#pragma unroll
        for (int j = 0; j < 5; ++j) w[j] = F.conv_w()[(L * 5 + j) * 768 + cg];
        const float bias = F.conv_b()[L * 768 + cg];
        const LAS bf16* lp = Lc + (32 * tq) * 256 + ch;
        float x0 = bf2f(lp[0]), x1 = bf2f(lp[256]), x2 = bf2f(lp[512]), x3 = bf2f(lp[768]);
        bf16* tm = (gch == 1 ? F.btm() : F.ctm()) + ((size_t)b * SQ + s0 + 32 * tq) * 256 + ch;
        bf16* cm = (gch == 0 ? F.xT() : F.bT()) + ((size_t)b * 256 + ch) * SQ + s0 + 32 * tq;
#pragma unroll
        for (int g8 = 0; g8 < 4; ++g8) { unsigned pk[4];
#pragma unroll
            for (int e = 0; e < 8; ++e) { const int i = 8 * g8 + e; const float x4 = bf2f(lp[(i + 4) * 256]);
                const float acc = bias + w[0] * x0 + w[1] * x1 + w[2] * x2 + w[3] * x3 + w[4] * x4; const unsigned o = f2bf(siluf(acc));
                if (gch >= 1) tm[(size_t)i * 256] = (bf16)o;
                if (e & 1) pk[e >> 1] |= o << 16; else pk[e >> 1] = o;
                x0 = x1; x1 = x2; x2 = x3; x3 = x4; }
            if (gch <= 1) { u32x4 v; v.x = pk[0]; v.y = pk[1]; v.z = pk[2]; v.w = pk[3]; *(u32x4*)(cm + 8 * g8) = v; } }
        __syncthreads();
    }
    if (PT_MASK & 4) { const int tok = tid >> 3, i = tid & 7; const float raw = bf2f(F.pbuf()[(r0 + tok) * NP + C_DT + i]) + F.dt_bias()[L * 8 + i]; const float ex = __expf(raw);
      F.dtv()[((size_t)b * 8 + i) * SQ + s0 + tok] = raw > 20.f ? raw : (ex < 0.03f ? ex * (1.f - ex * (0.5f - ex * (0.33333334f - 0.25f * ex))) : __logf(1.f + ex)); }
}
__device__ __forceinline__ void mla_prep_block(const Fr& F, int L, int b, int j32) {
    int lane_ = F.lane; asm volatile("" : "+v"(lane_));
    const int lane = lane_, wave = F.wave, r = lane & 31, hh = lane >> 5, s = 32 * j32 + r, t = s - 256; const bool lat = s >= 256;
    const size_t row = bs2row(b, s);
    const bf16* p = F.pbuf() + row * NP + C_MLA;
    const int tt = lat ? t : 0; const float latf = lat ? 1.f : 0.f;
    if (wave < 4) {
        const int hq = wave;
        bf16x8 Bq[16]; float ss = 0.f;
#pragma unroll
        for (int kk = 0; kk < 16; ++kk) { Bq[kk] = *(const bf16x8*)(p + 16 * kk + 8 * hh);
#pragma unroll
            for (int j = 0; j < 8; ++j) { const float v = bf2f((bf16)Bq[kk][j]); ss += v * v; } }
        ss += __shfl_xor(ss, 32); const float rq = rsqrtf(ss * (1.f / 256) + EPS);
        f32x16 acc[3]; float hs = 0.f;
#pragma unroll
        for (int j3 = 0; j3 < 3; ++j3) {
#pragma unroll
            for (int i = 0; i < 16; ++i) acc[j3][i] = 0.f;
            const bf16* wp = F.wqbT() + ((size_t)L * 384 + 96 * hq + 32 * j3 + r) * 256 + 8 * hh;
#pragma unroll
            for (int kk = 0; kk < 16; ++kk) acc[j3] = MFMA32(*(const bf16x8*)(wp + 16 * kk), Bq[kk], acc[j3]);
            asm volatile("" ::: "memory");
#pragma unroll
            for (int i = 0; i < 16; ++i) hs += acc[j3][i] * acc[j3][i]; }
        hs = (hs + __shfl_xor(hs, 32)) * rq * rq; const float rs = rsqrtf(hs * (1.f / 96) + EPS) * rq;
        bf16* qo = F.qml() + ((size_t)(b * 4 + hq) * SQ + s) * 96 + 4 * hh;
#pragma unroll
        for (int j3 = 0; j3 < 3; ++j3) {
#pragma unroll
            for (int i = 0; i < 16; ++i) acc[j3][i] *= rs * F.mla_gq()[L * 96 + 32 * j3 + crow16(i, hh)];
            if (j3 == 2) {
#pragma unroll
                for (int i = 0; i < 8; ++i) { const float rc = lat ? F.rcos()[tt * 16 + crow16(i, hh)] : 1.f, rsn = F.rsin()[tt * 16 + crow16(i, hh)] * latf;
                    const float x1 = acc[2][i], x2 = acc[2][i + 8]; acc[2][i] = x1 * rc - x2 * rsn; acc[2][i + 8] = x1 * rsn + x2 * rc; } }
#pragma unroll
            for (int g = 0; g < 4; ++g) { u32x2 w; w.x = pk2(acc[j3][4 * g], acc[j3][4 * g + 1]); w.y = pk2(acc[j3][4 * g + 2], acc[j3][4 * g + 3]); *(u32x2*)(qo + 32 * j3 + 8 * g) = w; } }
    } else {
        const int hk = wave - 4;
        LAS unsigned char* wl = F.lds + wave * 16384;
        bf16x8 Bkv[8]; float ss = 0.f;
#pragma unroll
        for (int kk = 0; kk < 8; ++kk) { Bkv[kk] = *(const bf16x8*)(p + 256 + 16 * kk + 8 * hh);
#pragma unroll
            for (int j = 0; j < 8; ++j) { const float v = bf2f((bf16)Bkv[kk][j]); ss += v * v; } }
        ss += __shfl_xor(ss, 32); const float rk = rsqrtf(ss * (1.f / 128) + EPS);
        float kr[16]; float hs = 0.f;
#pragma unroll
        for (int g = 0; g < 4; ++g) { const u32x2 k4 = *(const u32x2*)(p + 384 + 8 * g + 4 * hh);
            kr[4 * g] = __uint_as_float(k4.x << 16); kr[4 * g + 1] = __uint_as_float(k4.x & 0xffff0000u); kr[4 * g + 2] = __uint_as_float(k4.y << 16); kr[4 * g + 3] = __uint_as_float(k4.y & 0xffff0000u); }
#pragma unroll
        for (int i = 0; i < 16; ++i) hs += kr[i] * kr[i];
        f32x16 acc[4]; float ks = 0.f;
#pragma unroll
        for (int j4 = 0; j4 < 4; ++j4) {
#pragma unroll
            for (int i = 0; i < 16; ++i) acc[j4][i] = 0.f;
            const bf16* wp = F.wkvbT() + ((size_t)L * 512 + 128 * hk + 32 * j4 + r) * 128 + 8 * hh;
#pragma unroll
            for (int kk = 0; kk < 8; ++kk) acc[j4] = MFMA32(*(const bf16x8*)(wp + 16 * kk), Bkv[kk], acc[j4]);
            asm volatile("" ::: "memory");
            if (j4 < 2) {
#pragma unroll
                for (int i = 0; i < 16; ++i) ks += acc[j4][i] * acc[j4][i]; } }
        hs += ks * rk * rk; hs += __shfl_xor(hs, 32); const float rs = rsqrtf(hs * (1.f / 96) + EPS);
        bf16* ko = F.kml() + ((size_t)(b * 4 + hk) * SQ + s) * 96 + 4 * hh;
#pragma unroll
        for (int j2 = 0; j2 < 2; ++j2) {
#pragma unroll
            for (int i = 0; i < 16; ++i) acc[j2][i] *= rs * rk * F.mla_gk()[L * 96 + 32 * j2 + crow16(i, hh)];
#pragma unroll
            for (int g = 0; g < 4; ++g) { u32x2 w; w.x = pk2(acc[j2][4 * g], acc[j2][4 * g + 1]); w.y = pk2(acc[j2][4 * g + 2], acc[j2][4 * g + 3]); *(u32x2*)(ko + 32 * j2 + 8 * g) = w; } }
#pragma unroll
        for (int i = 0; i < 16; ++i) kr[i] *= rs * F.mla_gk()[L * 96 + 64 + crow16(i, hh)];
#pragma unroll
        for (int i = 0; i < 8; ++i) { const float rc = lat ? F.rcos()[tt * 16 + crow16(i, hh)] : 1.f, rsn = F.rsin()[tt * 16 + crow16(i, hh)] * latf;
            const float x1 = kr[i], x2 = kr[i + 8]; kr[i] = x1 * rc - x2 * rsn; kr[i + 8] = x1 * rsn + x2 * rc; }
#pragma unroll
        for (int g = 0; g < 4; ++g) { u32x2 w; w.x = pk2(kr[4 * g], kr[4 * g + 1]); w.y = pk2(kr[4 * g + 2], kr[4 * g + 3]); *(u32x2*)(ko + 64 + 8 * g) = w; }
        { float n2 = 0.f;
#pragma unroll
          for (int i = 0; i < 16; ++i) n2 += acc[0][i] * acc[0][i] + acc[1][i] * acc[1][i] + kr[i] * kr[i];
          n2 += __shfl_xor(n2, 32); n2 = wmaxf(n2);
          if (lane == 0) atomicMax(F.ctl() + CW_KMAX + ((L * 3 + 1) * 8 + b) * 8 + hk * 2, __float_as_uint(n2 * 1.02f)); }
        LAS bf16* vl = (LAS bf16*)wl;
#pragma unroll
        for (int mt = 0; mt < 2; ++mt)
#pragma unroll
            for (int i = 0; i < 16; ++i) vl[(32 * mt + crow16(i, hh)) * 40 + vpos(r)] = f2bf(acc[2 + mt][i] * rk);
        LDS_WAIT();
        { const LAS u32x4* src4 = (const LAS u32x4*)(wl + lane * 80); u32x4* dst = (u32x4*)(F.vml() + ((size_t)(b * 4 + hk) * 64 + lane) * SQ + 32 * j32);
#pragma unroll
          for (int q = 0; q < 4; ++q) dst[q] = src4[q]; }
        LDS_WAIT();
    }
}
__device__ __forceinline__ int grab_unit(const Fr& F, unsigned* ctr) {
    volatile LAS int* slot = (volatile LAS int*)(F.lds + LDSCTL_OFF + 256);
    __syncthreads();
    if (F.tid == 0) *slot = (int)__hip_atomic_fetch_add(ctr, 1u, __ATOMIC_RELAXED, __HIP_MEMORY_SCOPE_AGENT);
    __syncthreads();
    return __builtin_amdgcn_readfirstlane(*slot);
}
__device__ __forceinline__ void prep_qk(const Fr& F, int L, int b, int j32) {
    int lane_ = F.lane; asm volatile("" : "+v"(lane_)); const int l = lane_, h = l >> 4;
    u32x2 raw[4][4];
#pragma unroll
    for (int i = 0; i < 4; ++i) { const int s = 32 * j32 + 4 * F.wave + i; const bf16* p = F.pbuf() + (size_t)bs2row(b, s) * NP + 4 * l;
        raw[i][0] = *(const u32x2*)(p + C_NA); raw[i][1] = *(const u32x2*)(p + C_NA + 256); raw[i][2] = *(const u32x2*)(p + C_DF); raw[i][3] = *(const u32x2*)(p + C_DF + 256); }
    const f32x4 gnq = *(const f32x4*)(F.na_gq() + L * 64 + 4 * (l & 15)), gnk = *(const f32x4*)(F.na_gk() + L * 64 + 4 * (l & 15));
    const f32x4 gdq = *(const f32x4*)(F.df_gq() + L * 32 + 4 * (l & 7)), gdk = *(const f32x4*)(F.df_gk() + L * 32 + 4 * (l & 7));
    float kmx_na = 0.f, kmx_df = 0.f;
#pragma unroll
    for (int i = 0; i < 4; ++i) { const int s = 32 * j32 + 4 * F.wave + i, t = s - 256; const bool lat = s >= 256;
#pragma unroll
        for (int w = 0; w < 4; ++w) {
            f32x4 x; x[0] = __uint_as_float(raw[i][w].x << 16); x[1] = __uint_as_float(raw[i][w].x & 0xffff0000u); x[2] = __uint_as_float(raw[i][w].y << 16); x[3] = __uint_as_float(raw[i][w].y & 0xffff0000u);
            float ss = (x[0] * x[0] + x[1] * x[1]) + (x[2] * x[2] + x[3] * x[3]);
            ss += dppf<0xB1>(ss); ss += dppf<0x4E>(ss); ss += dppf<0x141>(ss);
            if (w < 2) { ss += dppf<0x140>(ss);
                const float rs = rsqrtf(ss * (1.f / 64) + EPS); const f32x4 g = w == 0 ? gnq : gnk; x = x * rs * g;
                u32x2 o; o.x = pk2(x[0], x[1]); o.y = pk2(x[2], x[3]);
                if (w == 1) { float n2 = (x[0] * x[0] + x[1] * x[1]) + (x[2] * x[2] + x[3] * x[3]); n2 += dppf<0xB1>(n2); n2 += dppf<0x4E>(n2); n2 += dppf<0x141>(n2); n2 += dppf<0x140>(n2); kmx_na = fmaxf(kmx_na, n2); }
                *(u32x2*)((w == 0 ? F.qna() : F.kna()) + ((size_t)(b * 4 + h) * SQ + s) * 64 + 4 * (l & 15)) = o;
            } else {
                const float rs = rsqrtf(ss * (1.f / 32) + EPS); const f32x4 g = w == 2 ? gdq : gdk; x = x * rs * g;
                f32x4 xp; xp[0] = __shfl_xor(x[0], 4); xp[1] = __shfl_xor(x[1], 4); xp[2] = __shfl_xor(x[2], 4); xp[3] = __shfl_xor(x[3], 4);
                if (lat) { const f32x4 cs = *(const f32x4*)(F.rcos() + t * 16 + 4 * (l & 3)), sn = *(const f32x4*)(F.rsin() + t * 16 + 4 * (l & 3));
                    x = (l & 4) ? xp * sn + x * cs : x * cs - xp * sn; }
                u32x2 o; o.x = pk2(x[0], x[1]); o.y = pk2(x[2], x[3]);
                if (w == 3) { float n2 = (x[0] * x[0] + x[1] * x[1]) + (x[2] * x[2] + x[3] * x[3]); n2 += dppf<0xB1>(n2); n2 += dppf<0x4E>(n2); n2 += dppf<0x141>(n2); kmx_df = fmaxf(kmx_df, n2); }
                *(u32x2*)((w == 2 ? F.qdf() : F.kdf()) + ((size_t)(b * 4 + h) * SQ + s) * 64 + 4 * (l & 15)) = o;
            } } }
    if ((l & 15) == 0) atomicMax(F.ctl() + CW_KMAX + ((L * 3 + 0) * 8 + b) * 8 + h * 2, __float_as_uint(kmx_na * 1.02f));
    if ((l & 7) == 0) atomicMax(F.ctl() + CW_KMAX + ((L * 3 + 2) * 8 + b) * 8 + h * 2 + ((l >> 3) & 1), __float_as_uint(kmx_df * 1.02f));
}
__device__ __forceinline__ void prep_vconv(const Fr& F, int L, int b, int j32) {
    int tid_ = F.tid; asm volatile("; VCONV_BEGIN" : "+v"(tid_)); const int tid = tid_;
    const int s0 = 32 * j32; const size_t r0 = bs2row(b, s0);
    LAS bf16* Lv = (LAS bf16*)F.lds;
#ifndef VC_MASK
#define VC_MASK 7
#endif
    if (VC_MASK & 1) {   u32x4 v[4];
#pragma unroll
        for (int k = 0; k < 4; ++k) { const int idx = tid + 512 * k, mx = idx >> 10, tok = (idx >> 5) & 31, d8 = (idx & 31) * 8;
            v[k] = *(const u32x4*)(F.pbuf() + (r0 + tok) * NP + (mx ? C_DF + 512 : C_NA + 512) + d8); }
#pragma unroll
        for (int k = 0; k < 4; ++k) { const int idx = tid + 512 * k, mx = idx >> 10, tok = (idx >> 5) & 31, d8 = (idx & 31) * 8, pc = vpos(tok);
#pragma unroll
            for (int e = 0; e < 4; ++e) { Lv[(mx * 256 + d8 + 2 * e) * 40 + pc] = (bf16)(v[k][e] & 0xffffu); Lv[(mx * 256 + d8 + 2 * e + 1) * 40 + pc] = (bf16)(v[k][e] >> 16); } }
        __syncthreads();
#pragma unroll
        for (int k = 0; k < 4; ++k) { const int idx = tid + 512 * k, mx = idx >> 10, dv = (idx >> 2) & 255, pc = idx & 3;
            const u32x4 w = *(const LAS u32x4*)(Lv + (mx * 256 + dv) * 40 + pc * 8);
            *(u32x4*)((mx ? F.vdf() : F.vna()) + ((size_t)(b * 4 + (dv >> 6)) * 64 + (dv & 63)) * SQ + s0 + pc * 8) = w; }
        __syncthreads();
    }
    const bool isctx = s0 < 256; const int len = isctx ? TCTX : TLAT, t0 = isctx ? s0 : s0 - 256;
    LAS bf16* Lc = (LAS bf16*)F.lds;
    if (VC_MASK & 2) {   u32x4 v[7];
#pragma unroll
        for (int k = 0; k < 7; ++k) { const int idx = tid + 512 * k, j = idx / 96, c8 = (idx - 96 * j) * 8, tj = t0 - 2 + j; const int jc = min(max(tj, 0), len - 1) - t0;
            v[k] = (u32x4){0u, 0u, 0u, 0u};
            if (idx < 36 * 96) { v[k] = *(const u32x4*)(F.pbuf() + (size_t)((long)r0 + jc) * NP + C_XBC + c8); if (tj < 0 || tj >= len) v[k] = (u32x4){0u, 0u, 0u, 0u}; } }
#pragma unroll
        for (int k = 0; k < 7; ++k) { const int idx = tid + 512 * k, j = idx / 96, c8 = (idx - 96 * j) * 8; if (idx < 36 * 96) *(LAS u32x4*)(Lc + j * 768 + c8) = v[k]; }
    }
    __syncthreads();
    if (VC_MASK & 2)
#pragma unroll 1
    for (int pass = 0; pass < 2; ++pass) {
        const int cg = pass == 0 ? tid : 512 + tid;
        if (cg < 768) {
            float w[5];
#pragma unroll
            for (int j = 0; j < 5; ++j) w[j] = F.conv_w()[(L * 5 + j) * 768 + cg];
            const float bias = F.conv_b()[L * 768 + cg];
            const LAS bf16* lp = Lc + cg;
            float x0 = bf2f(lp[0]), x1 = bf2f(lp[768]), x2 = bf2f(lp[2 * 768]), x3 = bf2f(lp[3 * 768]);
            const int gch = cg >> 8, ch = cg & 255;
            bf16* tm = (gch == 1 ? F.btm() : F.ctm()) + ((size_t)b * SQ + s0) * 256 + ch;
            bf16* cm = (gch == 0 ? F.xT() : F.bT()) + ((size_t)b * 256 + ch) * SQ + s0;
#pragma unroll
            for (int g8 = 0; g8 < 4; ++g8) { unsigned pk[4];
#pragma unroll
                for (int e = 0; e < 8; ++e) { const int i = 8 * g8 + e; const float x4 = bf2f(lp[(i + 4) * 768]);
                    const float acc = bias + w[0] * x0 + w[1] * x1 + w[2] * x2 + w[3] * x3 + w[4] * x4; const unsigned o = f2bf(siluf(acc));
                    if (gch >= 1) tm[(size_t)i * 256] = (bf16)o;
                    if (e & 1) pk[e >> 1] |= o << 16; else pk[e >> 1] = o;
                    x0 = x1; x1 = x2; x2 = x3; x3 = x4; }
                if (gch <= 1) { u32x4 v; v.x = pk[0]; v.y = pk[1]; v.z = pk[2]; v.w = pk[3]; *(u32x4*)(cm + 8 * g8) = v; } }
        }
    }
    if ((VC_MASK & 4) && tid < 256) { const int tok = tid >> 3, i = tid & 7; const float raw = bf2f(F.pbuf()[(r0 + tok) * NP + C_DT + i]) + F.dt_bias()[L * 8 + i]; const float ex = __expf(raw);
      F.dtv()[((size_t)b * 8 + i) * SQ + s0 + tok] = raw > 20.f ? raw : (ex < 0.03f ? ex * (1.f - ex * (0.5f - ex * (0.33333334f - 0.25f * ex))) : __logf(1.f + ex)); }
    __syncthreads();
    asm volatile("; VCONV_END" ::: "memory");
}
__device__ __forceinline__ void phase_prep(const Fr& F0_, int L) {
    unsigned* ctr = F0_.ctl() + CW_QUEUE + (L * 16 + 0) * 64;
    for (;;) {
        const int u = grab_unit(F0_, ctr); if (u >= NB * 72) break;
        const int b = u / 72, j32 = u - 72 * b;
        { const Fr F = refresh(F0_); prep_qk(F, L, b, j32); }
        { const Fr F = refresh(F0_); mla_prep_block(F, L, b, j32); }
        __syncthreads();
    }
    { unsigned* ctr2 = F0_.ctl() + CW_QUEUE + (L * 16 + 2) * 64;
      for (;;) { const int u = grab_unit(F0_, ctr2); if (u >= NB * 36) break; const Fr F3 = refresh(F0_); prep_tile(F3, L, u / 36, u % 36); } }
}

__device__ __forceinline__ void phase_ssd_naive(const Fr& F, int L) {
    if (F.wave != 0 || blockIdx.x >= 64) return;
    const int w = blockIdx.x, b = w >> 3, d = (w >> 2) & 1, h = w & 3, g = h >> 1, p = F.lane;
    const float a = -expf(F.a_log()[L * 8 + d * 4 + h]);
    float hs[128];
#pragma unroll
    for (int n = 0; n < 128; ++n) hs[n] = 0.f;
    const float* dtp = F.dtv() + ((size_t)b * 8 + d * 4 + h) * SQ;
    const bf16* xp = F.xT() + ((size_t)b * 256 + h * 64 + p) * SQ;
    for (int step = 0; step < SQ; ++step) {
        const int s = d == 0 ? step : (step < 256 ? 255 - step : SQ - 1 - (step - 256));
        const float dtv = dtp[s], dA = __expf(dtv * a), xv = bf2f(xp[s]) * dtv;
        const u32x4* Bp = (const u32x4*)(F.btm() + ((size_t)b * SQ + s) * 256 + g * 128);
        const u32x4* Cp = (const u32x4*)(F.ctm() + ((size_t)b * SQ + s) * 256 + g * 128);
        float y = 0.f;
#pragma unroll
        for (int n8 = 0; n8 < 16; ++n8) { const u32x4 bv = Bp[n8], cv = Cp[n8];
#pragma unroll
            for (int j = 0; j < 4; ++j) { const int n = n8 * 8 + 2 * j;
                hs[n] = hs[n] * dA + xv * __uint_as_float(bv[j] << 16); hs[n + 1] = hs[n + 1] * dA + xv * __uint_as_float(bv[j] & 0xffff0000u);
                y += __uint_as_float(cv[j] << 16) * hs[n] + __uint_as_float(cv[j] & 0xffff0000u) * hs[n + 1]; } }
        F.ydir()[((size_t)d * NROW + bs2row(b, s)) * 256 + h * 64 + p] = y;
    }
}

template <int KIND>
__device__ __forceinline__ void naive_attn_job(const Fr& F, int L, int r, int h, LAS float* scr) {
    constexpr int DQ = KIND == 1 ? 96 : (KIND == 0 ? 64 : 32), QS = KIND == 1 ? 96 : 64;
    const int lane = F.lane; int b, s; row2bs(r, b, s); const bool lat = r < NLAT; const int t = s - 256;
    const bf16* Qb = (KIND == 0 ? F.qna() : KIND == 1 ? F.qml() : F.qdf()) + ((size_t)(b * 4 + h) * SQ + s) * QS;
    const bf16* Kb = (KIND == 0 ? F.kna() : KIND == 1 ? F.kml() : F.kdf()) + (size_t)(b * 4 + h) * SQ * QS;
    const bf16* Vt = (KIND == 0 ? F.vna() : KIND == 1 ? F.vml() : F.vdf()) + ((size_t)(b * 4 + h) * 64 + lane) * SQ;
    const float scale = KIND == 1 ? 0.10206207261596577f : (KIND == 0 ? 0.125f : 0.17677669529663687f);
    const int qr = t >> 6, qc = t & 63, row_lo = min(max(qr - 4, 0), 24), col_lo = min(max(qc - 8, 0), 48);
    const bool nb = (KIND == 0) && lat;
    const int nk = lat ? (KIND == 0 ? 768 : SQ) : 256;
    const int koff = nb ? row_lo * 64 : 0;
    float oc[2] = {0.f, 0.f};
#pragma unroll
    for (int comp = 0; comp < (KIND == 2 ? 2 : 1); ++comp) {
        for (int i = lane; i < DQ; i += 64) scr[i] = bf2f(Qb[comp * 32 + i]);
        LDS_WAIT();
        float m = -INFINITY;
        for (int kk = lane; kk < nk; kk += 64) {
            const int sk = kk < 256 ? kk : kk + koff; float bias = 0.f; bool valid = true;
            if (nb && kk >= 256) { const int w = kk - 256, kr = w >> 6, kc = w & 63; valid = kc >= col_lo && kc < col_lo + 16;
                const int ro = row_lo + kr - qr + 7, co = min(max(kc - qc, -15), 15) + 15; bias = F.na_rb()[((L * 4 + h) * 15 + ro) * 31 + co]; }
            const u32x4* kp = (const u32x4*)(Kb + (size_t)sk * QS + (KIND == 2 ? comp * 32 : 0));
            float dot = 0.f;
#pragma unroll
            for (int i8 = 0; i8 < DQ / 8; ++i8) { const u32x4 kv = kp[i8];
#pragma unroll
                for (int j = 0; j < 4; ++j) dot += scr[i8 * 8 + 2 * j] * __uint_as_float(kv[j] << 16) + scr[i8 * 8 + 2 * j + 1] * __uint_as_float(kv[j] & 0xffff0000u); }
            const float sc = valid ? dot * scale + bias : -INFINITY;
            scr[128 + kk] = sc; m = fmaxf(m, sc);
        }
        m = wmaxf(m);
        float sum = 0.f;
        for (int kk = lane; kk < nk; kk += 64) { const float pv = __expf(scr[128 + kk] - m); scr[128 + kk] = pv; sum += pv; }
        sum = wsum(sum);
        LDS_WAIT();
        float o = 0.f;
        for (int kb = 0; kb < nk; kb += 8) {
            const int sb = kb < 256 ? kb : kb + koff;
            const u32x4 vv = *(const u32x4*)(Vt + sb);
#pragma unroll
            for (int j = 0; j < 8; ++j) { const int kk = (kb & ~15) + vpos((kb & 15) + j); const unsigned wv = vv[j >> 1];
                o += scr[128 + kk] * ((j & 1) ? __uint_as_float(wv & 0xffff0000u) : __uint_as_float(wv << 16)); }
        }
        oc[comp] = o / sum;
        LDS_WAIT();
    }
    bf16* mo = F.mix() + (size_t)r * DM + (KIND == 0 ? 0 : KIND == 1 ? 256 : 512) + h * 64 + lane;
    if (KIND == 2) {
        const float* lv = F.df_lam() + L * 128; const float li = 0.8f - 0.6f * expf(-0.3f * (float)L);
        float d1 = 0.f, d2 = 0.f;
#pragma unroll
        for (int i = 0; i < 32; ++i) { d1 += lv[i] * lv[32 + i]; d2 += lv[64 + i] * lv[96 + i]; }
        const float lam = expf(d1) - expf(d2) + li;
        const float o = oc[0] - lam * oc[1];
        const float rs = rsqrtf(wsum(o * o) * (1.f / 64) + EPS);
        *mo = f2bf(o * rs * F.df_gsub()[L * 64 + lane] * (1.f - li));
    } else *mo = f2bf(oc[0]);
}
__device__ __forceinline__ void phase_mix_naive(const Fr& F, int L) {
    LAS float* scr = (LAS float*)(F.lds + F.wave * 16384);
    const int nrows = (L == DEPTH - 1) ? NLAT : NROW;
    for (int j = F.gw; j < nrows * 4; j += F.NGW) naive_attn_job<2>(F, L, j >> 2, j & 3, scr);
    for (int j = F.gw; j < nrows * 4; j += F.NGW) naive_attn_job<1>(F, L, j >> 2, j & 3, scr);
    for (int j = F.gw; j < nrows * 4; j += F.NGW) naive_attn_job<0>(F, L, j >> 2, j & 3, scr);
    for (int r = F.gw; r < nrows; r += F.NGW) {
        int b, s; row2bs(r, b, s); const int h = F.lane >> 4; const float dsk = F.ssd_d()[L * 8 + h] + F.ssd_d()[L * 8 + 4 + h];
        float y[4]; float ss = 0.f;
#pragma unroll
        for (int j = 0; j < 4; ++j) { const int ch = F.lane * 4 + j; const float xv = bf2f(F.xT()[((size_t)b * 256 + ch) * SQ + s]);
            const float z = bf2f(F.pbuf()[(size_t)r * NP + C_Z + ch]);
            y[j] = (F.ydir()[(size_t)r * 256 + ch] + F.ydir()[((size_t)NROW + r) * 256 + ch] + dsk * xv) * siluf(z); ss += y[j] * y[j]; }
        const float rs = rsqrtf(wsum(ss) * (1.f / 256) + EPS);
#pragma unroll
        for (int j = 0; j < 4; ++j) { const int ch = F.lane * 4 + j; F.mix()[(size_t)r * DM + 768 + ch] = f2bf(y[j] * rs * F.ssd_gn()[L * 256 + ch]); }
    }
}

template <int S8> __device__ __forceinline__ bf16x8 pack_step(const f32x16& x) {
    u32x4 p;
    asm volatile("v_cvt_pk_bf16_f32 %0, %4, %5\n\tv_cvt_pk_bf16_f32 %1, %6, %7\n\tv_cvt_pk_bf16_f32 %2, %8, %9\n\tv_cvt_pk_bf16_f32 %3, %10, %11\n\ts_nop 1"
                 : "=&v"(p[0]), "=&v"(p[1]), "=&v"(p[2]), "=&v"(p[3])
                 : "v"(x[S8]), "v"(x[S8 + 1]), "v"(x[S8 + 2]), "v"(x[S8 + 3]), "v"(x[S8 + 4]), "v"(x[S8 + 5]), "v"(x[S8 + 6]), "v"(x[S8 + 7]));
    return __builtin_bit_cast(bf16x8, p);
}
constexpr float LOG2E = 1.4426950408889634f;
template <int KIND>
__device__ __forceinline__ void attn_unit(const Fr& F, int L, int b, int h, int qb) {
    constexpr int QS = KIND == 1 ? 96 : 64, NKS = KIND == 1 ? 6 : (KIND == 0 ? 4 : 2);
    constexpr int PK = QS * 2 + 16, PV = 272, KBYTES = 128 * PK, VBYTES = 64 * PV, NKP = QS == 96 ? 3 : 2, PPR = QS / 8;
    LAS unsigned char* const Kl = F.lds; LAS unsigned char* const Vl = F.lds + 2 * KBYTES;
    LAS float* const biasl = (LAS float*)(F.lds + 2 * KBYTES + 2 * VBYTES);
    const int lane = F.lane, wave = F.wave, tid = F.tid, r = lane & 31, hh = lane >> 5;
    const bool isctx = qb < 0;
    const int comp = KIND == 2 ? (wave & 1) : 0, qg = KIND == 2 ? (wave >> 1) : wave;
    const bf16* Qg = (KIND == 0 ? F.qna() : KIND == 1 ? F.qml() : F.qdf()) + (size_t)(b * 4 + h) * SQ * QS;
    const bf16* Kg = (KIND == 0 ? F.kna() : KIND == 1 ? F.kml() : F.kdf()) + (size_t)(b * 4 + h) * SQ * QS;
    const bf16* Vg = (KIND == 0 ? F.vna() : KIND == 1 ? F.vml() : F.vdf()) + (size_t)(b * 4 + h) * 64 * SQ;
    const float cs = (KIND == 1 ? 0.10206207261596577f : (KIND == 0 ? 0.125f : 0.17677669529663687f)) * LOG2E;
    int sq, qrow = 0, qcol = 0;
    if (KIND == 2) sq = (isctx ? 128 * (-qb - 1) : 256 + 128 * qb) + 32 * qg + r;
    else if (isctx) sq = 32 * wave + r; else if (KIND == 0) { qrow = 4 * qb + (wave >> 1); qcol = 32 * (wave & 1) + r; sq = 256 + 64 * qrow + qcol; } else sq = 256 + 256 * qb + 32 * wave + r;
    int nt = 36, lo_u = 0;
    if (isctx) nt = 4; else if (KIND == 0) { lo_u = min(max(4 * qb - 4, 0), 24); nt = 4 + min(max(4 * qb - 1, 0), 24) + 8 - lo_u; }
    const int np = (nt + 1) >> 1;
    const int my_lo = min(max(qrow - 4, 0), 24), col_lo = min(max(qcol - 8, 0), 48);
    if (KIND == 0 && !isctx) for (int i = tid; i < 465; i += 512) biasl[i] = F.na_rb()[(L * 4 + h) * 465 + i] * LOG2E;
    bf16x8 Q[NKS];
    { const bf16* qp = Qg + (size_t)sq * QS + comp * 32 + 8 * hh;
#pragma unroll
      for (int kk = 0; kk < NKS; ++kk) Q[kk] = *(const bf16x8*)(qp + 16 * kk); }
    f32x16 O[2]; float l = 0.f;
#pragma unroll
    for (int mt = 0; mt < 2; ++mt)
#pragma unroll
        for (int i = 0; i < 16; ++i) O[mt][i] = 0.f;
    float m;
    {   float q2 = 0.f;
#pragma unroll
        for (int kk = 0; kk < NKS; ++kk)
#pragma unroll
            for (int j = 0; j < 8; ++j) { const float v = bf2f((bf16)Q[kk][j]); q2 += v * v; }
        q2 += __shfl_xor(q2, 32);
        const float k2 = __uint_as_float(__hip_atomic_load(F.ctl() + CW_KMAX + ((L * 3 + KIND) * 8 + b) * 8 + h * 2 + comp, __ATOMIC_RELAXED, __HIP_MEMORY_SCOPE_AGENT));
        m = sqrtf(q2 * k2) * cs;
        if (KIND == 0 && !isctx) m += (F.rcos() + 2 * TLAT * 16)[L * 4 + h];
    }
    u32x4 rk_0[NKP], rv_0[2];
#define AT_SK0(t) ((isctx || KIND != 0) ? 64 * (t) : ((t) < 4 ? 64 * (t) : 256 + 64 * (lo_u + (t) - 4)))
#define AT_LOAD(p, S_) do { const int sk0_ = AT_SK0(2 * (p)); const char* kg_ = (const char*)(Kg + (size_t)sk0_ * QS); \
        _Pragma("unroll") for (int i_ = 0; i_ < NKP; ++i_) rk_##S_[i_] = *(const u32x4*)(kg_ + (tid + 512 * i_) * 16); \
        _Pragma("unroll") for (int i_ = 0; i_ < 2; ++i_) { const int pi_ = tid + 512 * i_; rv_##S_[i_] = *(const u32x4*)(Vg + (size_t)(pi_ >> 4) * SQ + sk0_ + (pi_ & 15) * 8); } } while (0)
#define AT_STORE(buf, S_) do { \
        _Pragma("unroll") for (int i_ = 0; i_ < NKP; ++i_) { const int pi_ = tid + 512 * i_; *(LAS u32x4*)(Kl + (buf) * KBYTES + (pi_ / PPR) * PK + (pi_ % PPR) * 16) = rk_##S_[i_]; } \
        _Pragma("unroll") for (int i_ = 0; i_ < 2; ++i_) { const int pi_ = tid + 512 * i_; *(LAS u32x4*)(Vl + (buf) * VBYTES + (pi_ >> 4) * PV + (pi_ & 15) * 16) = rv_##S_[i_]; } } while (0)
#define AT_QK(SA, SB, kb_) do { \
        _Pragma("unroll") for (int i = 0; i < 16; ++i) { SA[i] = 0.f; SB[i] = 0.f; } \
        _Pragma("unroll") for (int kk = 0; kk < NKS; ++kk) { const bf16x8 a0 = *(const LAS bf16x8*)((kb_) + 32 * kk), a1 = *(const LAS bf16x8*)((kb_) + 32 * PK + 32 * kk); \
            SA = MFMA32(a0, Q[kk], SA); SB = MFMA32(a1, Q[kk], SB); } } while (0)
#define AT_SMPV(S0, S1, t_, vb_) do { \
        const int krow = lo_u + (t_) - 4; const bool nbt = (KIND == 0) && !isctx && (t_) >= 4; \
        float ps = 0.f; \
        if (nbt) { const int drow = (krow - qrow + 7) * 31 - qcol + 15; const float nm = -m; \
            _Pragma("unroll") for (int i = 0; i < 16; ++i) { const int kc = (i & 3) + 8 * (i >> 2) + 4 * hh; \
                { const bool v = (unsigned)(kc - col_lo) < 16u; const float bb = biasl[v ? drow + kc : 0]; S0[i] = v ? __builtin_amdgcn_exp2f(__builtin_fmaf(S0[i], cs, bb + nm)) : 0.f; } \
                { const bool v = (unsigned)(kc + 32 - col_lo) < 16u; const float bb = biasl[v ? drow + kc + 32 : 0]; S1[i] = v ? __builtin_amdgcn_exp2f(__builtin_fmaf(S1[i], cs, bb + nm)) : 0.f; } \
                ps += S0[i] + S1[i]; } \
        } else { const float nm = -m; \
            _Pragma("unroll") for (int i = 0; i < 16; ++i) { S0[i] = __builtin_amdgcn_exp2f(__builtin_fmaf(S0[i], cs, nm)); S1[i] = __builtin_amdgcn_exp2f(__builtin_fmaf(S1[i], cs, nm)); ps += S0[i] + S1[i]; } } \
        l += ps; \
        const bf16x8 p00 = pack_step<0>(S0), p01 = pack_step<8>(S0), p10 = pack_step<0>(S1), p11 = pack_step<8>(S1); \
        _Pragma("unroll") for (int mt = 0; mt < 2; ++mt) { \
            const LAS unsigned char* vb = (vb_) + mt * 32 * PV; \
            O[mt] = MFMA32(*(const LAS bf16x8*)(vb + 0), p00, O[mt]); O[mt] = MFMA32(*(const LAS bf16x8*)(vb + 32), p01, O[mt]); \
            O[mt] = MFMA32(*(const LAS bf16x8*)(vb + 64), p10, O[mt]); O[mt] = MFMA32(*(const LAS bf16x8*)(vb + 96), p11, O[mt]); } } while (0)
#define AT_COMPUTE(p_, buf_) do { \
        const int t0_ = 2 * (p_), t1_ = t0_ + 1; \
        const bool g0_ = (KIND != 0) || isctx || t0_ < 4 || (lo_u + t0_ - 4 >= my_lo && lo_u + t0_ - 4 < my_lo + 8); \
        const bool g1_ = (t1_ < nt) && ((KIND != 0) || isctx || t1_ < 4 || (lo_u + t1_ - 4 >= my_lo && lo_u + t1_ - 4 < my_lo + 8)); \
        const LAS unsigned char* Kb = Kl + (buf_) * KBYTES + r * PK + (comp * 32 + 8 * hh) * 2; const LAS unsigned char* Vb = Vl + (buf_) * VBYTES + r * PV + 16 * hh; \
        if (KIND == 0) { f32x16 S00, S01; \
            if (g0_) { AT_QK(S00, S01, Kb); AT_SMPV(S00, S01, t0_, Vb); } \
            if (g1_) { AT_QK(S00, S01, Kb + 64 * PK); AT_SMPV(S00, S01, t1_, Vb + 128); } \
        } else { f32x16 S00, S01, S10, S11; \
            AT_QK(S00, S01, Kb); \
            AT_QK(S10, S11, Kb + 64 * PK); \
            AT_SMPV(S00, S01, t0_, Vb); \
            AT_SMPV(S10, S11, t1_, Vb + 128); } } while (0)
    AT_LOAD(0, 0);
    AT_STORE(0, 0);
    __syncthreads();
    for (int p = 0; p < np; ++p) {
        const int buf = p & 1;
        if (p + 1 < np) AT_LOAD(p + 1, 0);
        AT_COMPUTE(p, buf);
        if (p + 1 < np) AT_STORE(buf ^ 1, 0);
        __syncthreads();
    }
#undef AT_COMPUTE
#undef AT_SMPV
#undef AT_QK
#undef AT_SK0
#undef AT_LOAD
#undef AT_STORE
    const float inv = 1.f / (l + __shfl_xor(l, 32));
    bf16* mo = F.mix() + (size_t)bs2row(b, sq) * DM + (KIND == 0 ? 0 : KIND == 1 ? 256 : 512) + h * 64 + 4 * hh;
    if (KIND == 2) {
        LAS float* xo = (LAS float*)F.lds + qg * 2048;
        if (comp == 1) {
#pragma unroll
            for (int mt = 0; mt < 2; ++mt)
#pragma unroll
                for (int i = 0; i < 16; ++i) xo[(mt * 16 + i) * 64 + lane] = O[mt][i] * inv; }
        __syncthreads();
        if (comp == 0) {
            const float* lv = F.df_lam() + L * 128; const float li = 0.8f - 0.6f * expf(-0.3f * (float)L);
            float d1 = 0.f, d2 = 0.f;
#pragma unroll
            for (int i = 0; i < 32; ++i) { d1 += lv[i] * lv[32 + i]; d2 += lv[64 + i] * lv[96 + i]; }
            const float lam = expf(d1) - expf(d2) + li;
            float ss = 0.f;
#pragma unroll
            for (int mt = 0; mt < 2; ++mt)
#pragma unroll
                for (int i = 0; i < 16; ++i) { const float o = O[mt][i] * inv - lam * xo[(mt * 16 + i) * 64 + lane]; O[mt][i] = o; ss += o * o; }
            ss += __shfl_xor(ss, 32);
            const float rs = rsqrtf(ss * (1.f / 64) + EPS) * (1.f - li);
#pragma unroll
            for (int mt = 0; mt < 2; ++mt)
#pragma unroll
                for (int g = 0; g < 4; ++g) { const f32x4 gs = *(const f32x4*)(F.df_gsub() + L * 64 + 32 * mt + 8 * g + 4 * hh);
                    u32x2 w; w.x = pk2(O[mt][4 * g] * rs * gs[0], O[mt][4 * g + 1] * rs * gs[1]); w.y = pk2(O[mt][4 * g + 2] * rs * gs[2], O[mt][4 * g + 3] * rs * gs[3]);
                    *(u32x2*)(mo + 32 * mt + 8 * g) = w; }
        }
        __syncthreads();
    } else {
#pragma unroll
        for (int mt = 0; mt < 2; ++mt)
#pragma unroll
            for (int g = 0; g < 4; ++g) { u32x2 w; w.x = pk2(O[mt][4 * g] * inv, O[mt][4 * g + 1] * inv); w.y = pk2(O[mt][4 * g + 2] * inv, O[mt][4 * g + 3] * inv);
                *(u32x2*)(mo + 32 * mt + 8 * g) = w; }
    }
}
__device__ __forceinline__ float ssd_cum(const Fr& F, int L, int b, int h, int d, int s0, float& dt, float& cum) {
    const int lane = F.lane;
    dt = F.dtv()[((size_t)b * 8 + d * 4 + h) * SQ + s0 + lane];
    const float la = dt * -__expf(F.a_log()[L * 8 + d * 4 + h]);
    float v = la;
#pragma unroll
    for (int o = 1; o < 64; o <<= 1) { const float t = __shfl_up(v, o); if (lane >= o) v += t; }
    const float total = __shfl(v, 63);
    cum = d == 0 ? v : total - v + la;
    return total;
}
__device__ __forceinline__ void ssd_s1_job(const Fr& F, int L, int b, int c, int h, LAS float* scr) {
    const int lane = F.lane, r = lane & 31, hh = lane >> 5, s0 = 64 * c, g = h >> 1;
#pragma unroll
    for (int d = 0; d < 2; ++d) { float dt, cum; const float tot = ssd_cum(F, L, b, h, d, s0, dt, cum); scr[d * 64 + lane] = dt * __expf(tot - cum);
        if (lane == 0) F.cdec()[((b * 2 + d) * 4 + h) * 36 + c] = __expf(tot); }
    LDS_WAIT();
    bf16x8 A[2][2][4];
#pragma unroll
    for (int mt = 0; mt < 2; ++mt)
#pragma unroll
        for (int kk = 0; kk < 4; ++kk) { const bf16x8 raw = *(const bf16x8*)(F.xT() + ((size_t)b * 256 + h * 64 + 32 * mt + r) * SQ + s0 + 16 * kk + 8 * hh);
#pragma unroll
            for (int d = 0; d < 2; ++d) { u32x4 o;
#pragma unroll
                for (int j = 0; j < 4; ++j) { const float w0 = scr[d * 64 + 16 * kk + 8 * hh + 2 * j], w1 = scr[d * 64 + 16 * kk + 8 * hh + 2 * j + 1];
                    o[j] = pk2(bf2f((bf16)raw[2 * j]) * w0, bf2f((bf16)raw[2 * j + 1]) * w1); }
                A[d][mt][kk] = __builtin_bit_cast(bf16x8, o); } }
#pragma unroll
    for (int nt = 0; nt < 4; ++nt) {
        bf16x8 Bf[4];
#pragma unroll
        for (int kk = 0; kk < 4; ++kk) Bf[kk] = *(const bf16x8*)(F.bT() + ((size_t)b * 256 + g * 128 + 32 * nt + r) * SQ + s0 + 16 * kk + 8 * hh);
#pragma unroll
        for (int d = 0; d < 2; ++d)
#pragma unroll
            for (int mt = 0; mt < 2; ++mt) { f32x16 acc;
#pragma unroll
                for (int i = 0; i < 16; ++i) acc[i] = 0.f;
#pragma unroll
                for (int kk = 0; kk < 4; ++kk) acc = MFMA32(A[d][mt][kk], Bf[kk], acc);
                float* dst = F.cst() + ((((size_t)(b * 2 + d) * 4 + h) * 36 + c) * 64 + 32 * mt) * 128 + 32 * nt + r;
#pragma unroll
                for (int i = 0; i < 16; ++i) dst[crow16(i, hh) * 128] = acc[i]; }
    }
    LDS_WAIT();
}
__device__ __forceinline__ void phase_ssd_s1(const Fr& F, int L) {
    LAS float* scr = (LAS float*)(F.lds + F.wave * 16384);
    for (int j = F.gw; j < NB * 36 * 4; j += F.NGW) ssd_s1_job(F, L, j / 144, (j / 4) % 36, j & 3, scr);
}
__device__ __forceinline__ void phase_ssd_scan(const Fr& F, int L) {
    for (int e4 = blockIdx.x * 512 + F.tid; e4 < NB * 2 * 4 * 2048; e4 += F.G * 512) {
        const int bdh = e4 >> 11, pn = (e4 & 2047) * 4, d = (bdh >> 2) & 1;
        f32x4 hst = (f32x4){0.f, 0.f, 0.f, 0.f};
        const float* cs_ = F.cst() + (size_t)bdh * 36 * 8192 + pn; bf16* he_ = F.hent() + (size_t)bdh * 36 * 8192 + pn; const float* cd_ = F.cdec() + bdh * 36;
#pragma unroll 1
        for (int s6 = 0; s6 < 36; s6 += 6) {
            f32x4 v[6]; float dc[6]; int cc[6];
#pragma unroll
            for (int j = 0; j < 6; ++j) { const int step = s6 + j; cc[j] = d == 0 ? step : (step < 4 ? 3 - step : 39 - step); v[j] = *(const f32x4*)(cs_ + (size_t)cc[j] * 8192); dc[j] = cd_[cc[j]]; }
#pragma unroll
            for (int j = 0; j < 6; ++j) { u32x2 o; o.x = pk2(hst[0], hst[1]); o.y = pk2(hst[2], hst[3]); *(u32x2*)(he_ + (size_t)cc[j] * 8192) = o; hst = hst * dc[j] + v[j]; }
        }
    }
}
__device__ __forceinline__ void ssd_s3_unit(const Fr& F, int L, int b, int c) {
    const int lane = F.lane, wave = F.wave, r = lane & 31, hh = lane >> 5, s0 = 64 * c, h = wave >> 1, it = wave & 1, g = h >> 1, itok = 32 * it + r;
    LAS float* scr = (LAS float*)(F.lds + wave * 16384);
    LAS float* red = (LAS float*)(F.lds + 8192);
#pragma unroll
    for (int d = 0; d < 2; ++d) { float dt, cum; (void)ssd_cum(F, L, b, h, d, s0, dt, cum); scr[d * 128 + lane] = cum; scr[d * 128 + 64 + lane] = dt; }
    LDS_WAIT();
    bf16x8 Cf[8];
#pragma unroll
    for (int kk = 0; kk < 8; ++kk) Cf[kk] = *(const bf16x8*)(F.ctm() + ((size_t)b * SQ + s0 + itok) * 256 + g * 128 + 16 * kk + 8 * hh);
    f32x16 G[2];
#pragma unroll
    for (int jt = 0; jt < 2; ++jt) {
#pragma unroll
        for (int i = 0; i < 16; ++i) G[jt][i] = 0.f;
#pragma unroll
        for (int kk = 0; kk < 8; ++kk) { const bf16x8 bf = *(const bf16x8*)(F.btm() + ((size_t)b * SQ + s0 + 32 * jt + r) * 256 + g * 128 + 16 * kk + 8 * hh); G[jt] = MFMA32(bf, Cf[kk], G[jt]); } }
    bf16x8 X[2][4];
#pragma unroll
    for (int mt = 0; mt < 2; ++mt)
#pragma unroll
        for (int ks = 0; ks < 4; ++ks) { const bf16* xp = F.xT() + ((size_t)b * 256 + h * 64 + 32 * mt + r) * SQ + s0 + 16 * ks + 4 * hh;
            const u32x2 lo = *(const u32x2*)xp, hi = *(const u32x2*)(xp + 8); u32x4 o; o.x = lo.x; o.y = lo.y; o.z = hi.x; o.w = hi.y; X[mt][ks] = __builtin_bit_cast(bf16x8, o); }
    f32x16 Y[2];
#pragma unroll
    for (int mt = 0; mt < 2; ++mt)
#pragma unroll
        for (int i = 0; i < 16; ++i) Y[mt][i] = 0.f;
    const float Dsum = F.ssd_d()[L * 8 + h] + F.ssd_d()[L * 8 + 4 + h];
#pragma unroll 1
    for (int d = 0; d < 2; ++d) {
        const float cum_i = scr[d * 128 + itok];
        f32x16 Pm[2];
#pragma unroll
        for (int jt = 0; jt < 2; ++jt)
#pragma unroll
            for (int i = 0; i < 16; ++i) { const int j = 32 * jt + crow16(i, hh); const bool valid = d == 0 ? (j <= itok) : (j >= itok);
                const float arg = valid ? cum_i - scr[d * 128 + j] : -INFINITY;
                float pv = G[jt][i] * __expf(arg) * scr[d * 128 + 64 + j];
                if (d == 0 && j == itok) pv += Dsum;
                Pm[jt][i] = pv; }
        const bf16x8 p0 = pack_step<0>(Pm[0]), p1 = pack_step<8>(Pm[0]), p2 = pack_step<0>(Pm[1]), p3 = pack_step<8>(Pm[1]);
#pragma unroll
        for (int mt = 0; mt < 2; ++mt) { Y[mt] = MFMA32(X[mt][0], p0, Y[mt]); Y[mt] = MFMA32(X[mt][1], p1, Y[mt]); Y[mt] = MFMA32(X[mt][2], p2, Y[mt]); Y[mt] = MFMA32(X[mt][3], p3, Y[mt]); }
        const float ei = __expf(cum_i);
#pragma unroll
        for (int mt = 0; mt < 2; ++mt) { f32x16 T;
#pragma unroll
            for (int i = 0; i < 16; ++i) T[i] = 0.f;
#pragma unroll
            for (int kk = 0; kk < 8; ++kk) { const bf16x8 hf = *(const bf16x8*)(F.hent() + ((((size_t)(b * 2 + d) * 4 + h) * 36 + c) * 64 + 32 * mt + r) * 128 + 16 * kk + 8 * hh); T = MFMA32(hf, Cf[kk], T); }
#pragma unroll
            for (int i = 0; i < 16; ++i) Y[mt][i] += ei * T[i]; }
    }
    const size_t row = bs2row(b, s0 + itok);
    const bf16* zp = F.pbuf() + row * NP + C_Z + h * 64 + 4 * hh;
    float ss = 0.f;
#pragma unroll
    for (int mt = 0; mt < 2; ++mt)
#pragma unroll
        for (int gq = 0; gq < 4; ++gq) { const u32x2 z4 = *(const u32x2*)(zp + 32 * mt + 8 * gq);
            const float z0 = __uint_as_float(z4.x << 16), z1 = __uint_as_float(z4.x & 0xffff0000u), z2 = __uint_as_float(z4.y << 16), z3 = __uint_as_float(z4.y & 0xffff0000u);
            Y[mt][4 * gq] *= siluf(z0); Y[mt][4 * gq + 1] *= siluf(z1); Y[mt][4 * gq + 2] *= siluf(z2); Y[mt][4 * gq + 3] *= siluf(z3);
            ss += (Y[mt][4 * gq] * Y[mt][4 * gq] + Y[mt][4 * gq + 1] * Y[mt][4 * gq + 1]) + (Y[mt][4 * gq + 2] * Y[mt][4 * gq + 2] + Y[mt][4 * gq + 3] * Y[mt][4 * gq + 3]); }
    ss += __shfl_xor(ss, 32);
    if (hh == 0) red[(it * 4 + h) * 32 + r] = ss;
    __syncthreads();
    const float tot = (red[(it * 4 + 0) * 32 + r] + red[(it * 4 + 1) * 32 + r]) + (red[(it * 4 + 2) * 32 + r] + red[(it * 4 + 3) * 32 + r]);
    const float rs = rsqrtf(tot * (1.f / 256) + EPS);
    bf16* mo = F.mix() + row * DM + 768 + h * 64 + 4 * hh;
#pragma unroll
    for (int mt = 0; mt < 2; ++mt)
#pragma unroll
        for (int gq = 0; gq < 4; ++gq) { const f32x4 gn = *(const f32x4*)(F.ssd_gn() + L * 256 + h * 64 + 32 * mt + 8 * gq + 4 * hh);
            u32x2 w; w.x = pk2(Y[mt][4 * gq] * rs * gn[0], Y[mt][4 * gq + 1] * rs * gn[1]); w.y = pk2(Y[mt][4 * gq + 2] * rs * gn[2], Y[mt][4 * gq + 3] * rs * gn[3]);
            *(u32x2*)(mo + 32 * mt + 8 * gq) = w; }
    __syncthreads();
}
template <int KIND> __device__ __forceinline__ void attn_units(const Fr& F, int L) {
    if (KIND == 2) { const int nu = (L == DEPTH - 1) ? 512 : 576;
        for (int u = F.vcu; u < nu; u += F.G) { if (u < 512) attn_unit<2>(F, L, u >> 6, (u >> 4) & 3, u & 15); else attn_unit<2>(F, L, (u - 512) >> 3, ((u - 512) >> 1) & 3, -1 - (u & 1)); }
    } else { const int nu = (L == DEPTH - 1) ? 256 : 288;
        for (int u = F.vcu; u < nu; u += F.G) { if (u < 256) attn_unit<KIND>(F, L, u >> 5, (u >> 3) & 3, u & 7); else attn_unit<KIND>(F, L, (u - 256) >> 2, (u - 256) & 3, -1); } }
}
__device__ __forceinline__ void phase_mix_fast(const Fr& F, int L) {
#ifndef ATT_MASK
#define ATT_MASK 15
#endif
#ifndef ATT_DUP
#define ATT_DUP 0
#endif
#ifndef ATT_MASK
#define ATT_MASK 15
#endif
    if (ATT_MASK & 4) for (int rp = 0; rp < ((ATT_DUP & 4) ? 2 : 1); ++rp) { const Fr Fa = refresh(F); attn_units<2>(Fa, L); }
    if (ATT_MASK & 2) for (int rp = 0; rp < ((ATT_DUP & 2) ? 2 : 1); ++rp) { const Fr Fa = refresh(F); attn_units<1>(Fa, L); }
    if (ATT_MASK & 1) for (int rp = 0; rp < ((ATT_DUP & 1) ? 2 : 1); ++rp) { const Fr Fa = refresh(F); attn_units<0>(Fa, L); }
    const int c0 = (L == DEPTH - 1) ? 4 : 0;
    if (ATT_MASK & 8) { const Fr Fa = refresh(F); unsigned* ctr = Fa.ctl() + CW_QUEUE + (L * 16 + 1) * 64;
        for (;;) { const int u = grab_unit(Fa, ctr); if (u >= NB * (36 - c0)) break; ssd_s3_unit(Fa, L, u / (36 - c0), c0 + u % (36 - c0)); } }
}

__device__ __forceinline__ void phase_route(const Fr& F, int L, bool commit = true) {
    const int nrows = (L == DEPTH - 1) ? NLAT : NROW;
    LAS float* wl = (LAS float*)F.lds;
    {   const f32x4* wg4 = (const f32x4*)(F.w_grp() + (size_t)L * DM * 4); const f32x4* we4 = (const f32x4*)(F.w_exp() + (size_t)L * DM * 16);
        f32x4 tg[2], te[8];
#pragma unroll
        for (int n = 0; n < 2; ++n) tg[n] = wg4[F.tid + 512 * n];
#pragma unroll
        for (int n = 0; n < 8; ++n) te[n] = we4[F.tid + 512 * n];
#pragma unroll
        for (int n = 0; n < 2; ++n) { const int k = F.tid + 512 * n;
#pragma unroll
            for (int o = 0; o < 4; ++o) wl[o * DM + k] = tg[n][o]; }
#pragma unroll
        for (int n = 0; n < 8; ++n) { const int i = F.tid + 512 * n, k = i >> 2, q = i & 3;
#pragma unroll
            for (int o = 0; o < 4; ++o) wl[(4 + 4 * q + o) * DM + k] = te[n][o]; }
    }
    __syncthreads();
    float keep[20];
#pragma unroll
    for (int o = 0; o < 20; ++o) keep[o] = 0.f;
    f32x4 v[4], vn[4];
    { const int r = F.gw; if (r < nrows) { const float* hp = r < NLAT ? F.out() + (size_t)r * DM : F.hc() + (size_t)(r - NLAT) * DM;
#pragma unroll
        for (int j = 0; j < 4; ++j) vn[j] = *(const f32x4*)(hp + 4 * F.lane + 256 * j); } }
    int it = 0;
    for (int r = F.gw; r < nrows; r += F.NGW, ++it) {
        const bool lat = r < NLAT; const int bb = lat ? (r >> 11) : 8;
#pragma unroll
        for (int j = 0; j < 4; ++j) v[j] = vn[j];
        { const int rn = r + F.NGW; if (rn < nrows) { const float* hp = rn < NLAT ? F.out() + (size_t)rn * DM : F.hc() + (size_t)(rn - NLAT) * DM;
#pragma unroll
            for (int j = 0; j < 4; ++j) vn[j] = *(const f32x4*)(hp + 4 * F.lane + 256 * j); } }
        float ss = 0.f;
#pragma unroll
        for (int j = 0; j < 4; ++j) ss += (v[j][0] * v[j][0] + v[j][1] * v[j][1]) + (v[j][2] * v[j][2] + v[j][3] * v[j][3]);
        const float rstd = rsqrtf(wsum(ss) * (1.f / DM) + EPS);
        const float* md = F.modv() + ((size_t)L * 9 + bb) * 6144;
        float lg[20];
#pragma unroll
        for (int o = 0; o < 20; ++o) lg[o] = 0.f;
#pragma unroll
        for (int j = 0; j < 4; ++j) { const int c = 4 * F.lane + 256 * j; const f32x4 g = *(const f32x4*)(F.g_ffn() + L * DM + c), sh = *(const f32x4*)(md + 3 * 1024 + c), scl = *(const f32x4*)(md + 4 * 1024 + c);
            const f32x4 f = v[j] * rstd * g * (scl + 1.f) + sh; u32x2 o2; o2.x = pk2(f[0], f[1]); o2.y = pk2(f[2], f[3]); *(u32x2*)(F.abuf() + (size_t)r * DM + c) = o2;
#pragma unroll
            for (int o = 0; o < 20; ++o) { const f32x4 w = *(const LAS f32x4*)(wl + o * DM + c); lg[o] += (f[0] * w[0] + f[1] * w[1]) + (f[2] * w[2] + f[3] * w[3]); }
            asm volatile("" ::: "memory"); }
#pragma unroll
        for (int o = 0; o < 20; ++o) { const float t = wsum(lg[o]); keep[o] = (F.lane == it) ? t : keep[o]; }
    }
    if (F.lane < it) {
        const int r = F.gw + F.lane * F.NGW;
        float gl[4]; float gm = -INFINITY; int gt = 0;
#pragma unroll
        for (int o = 0; o < 4; ++o) { gl[o] = keep[o] + F.b_grp()[L * 4 + o]; if (gl[o] > gm) { gm = gl[o]; gt = o; } }
        float gs = 0.f;
#pragma unroll
        for (int o = 0; o < 4; ++o) gs += expf(gl[o] - gm);
        const float gp = 1.f / gs;
        float el[4];
#pragma unroll
        for (int o = 0; o < 4; ++o) { float v4 = 0.f;
#pragma unroll
            for (int q = 0; q < 4; ++q) v4 = (gt == q) ? keep[4 + 4 * q + o] + F.b_exp()[L * 16 + 4 * q + o] : v4;
            el[o] = v4; }
        int i0 = 0; float m0 = el[0];
#pragma unroll
        for (int o = 1; o < 4; ++o) if (el[o] > m0) { m0 = el[o]; i0 = o; }
        int i1 = i0 == 0 ? 1 : 0; float m1 = i0 == 0 ? el[1] : el[0];
#pragma unroll
        for (int o = 1; o < 4; ++o) if (o != i0 && el[o] > m1) { m1 = el[o]; i1 = o; }
        const float e1 = expf(m1 - m0), w0 = gp / (1.f + e1), w1 = gp * e1 / (1.f + e1);
        const int x0 = gt * 4 + i0, x1 = gt * 4 + i1;
        if (commit) {
            F.rtw()[2 * r] = w0; F.rtw()[2 * r + 1] = w1;
            const unsigned p0 = atomicAdd(F.ctl() + CW_ECNT + (L * 16 + x0) * 64, 1u), p1 = atomicAdd(F.ctl() + CW_ECNT + (L * 16 + x1) * 64, 1u);
            F.elist()[x0 * NROW + p0] = 2 * r; F.elist()[x1 * NROW + p1] = 2 * r + 1; }
        else if (w0 + w1 < -1.f) F.rtw()[0] = 0.f;
    }
    __syncthreads();
}
__device__ __forceinline__ void moe_table(const Fr& F, int L) {
    volatile LAS int* T = (volatile LAS int*)(F.lds + LDSCTL_OFF + 64);
    volatile LAS int* Cn = (volatile LAS int*)(F.lds + LDSCTL_OFF + 160);
    __syncthreads();
    if (F.tid == 0) { int acc = 0;
        for (int e = 0; e < 16; ++e) { int c = (int)__hip_atomic_load(F.ctl() + CW_ECNT + (L * 16 + e) * 64, __ATOMIC_RELAXED, __HIP_MEMORY_SCOPE_AGENT); c = min(max(c, 0), NROW); T[e] = acc; Cn[e] = c; acc += (c + 255) >> 8; }
        T[16] = acc; }
    __syncthreads();
}

__global__ void __launch_bounds__(512, 2) fwd_kernel(Args args) {
    extern __shared__ __attribute__((aligned(16))) unsigned char lds_raw[];
    Fr F0;
    F0.lds = (LAS unsigned char*)lds_raw; F0.tid = threadIdx.x; F0.lane = F0.tid & 63; F0.wave = __builtin_amdgcn_readfirstlane(F0.tid >> 6);
    F0.G = gridDim.x; { const int bx = blockIdx.x; F0.vcu = (F0.G % 8 == 0) ? (bx % 8) * (F0.G / 8) + bx / 8 : bx; }
    F0.gw = F0.vcu * 8 + F0.wave; F0.NGW = F0.G * 8;
    F0.A = (const __attribute__((address_space(4))) Args*)__builtin_amdgcn_kernarg_segment_ptr();
    for (int u = F0.tid; u < (LDS_BYTES - LDSCTL_OFF) / 4; u += 512) ((LAS unsigned*)(F0.lds + LDSCTL_OFF))[u] = 0u;
    __syncthreads();
    const int lo = args.ph_lo, hi = args.ph_hi;
    XcdBarrier bar; bar.bar = F0.ctl() + CW_BAR; bar.x = 0; bar.st = nullptr;
    if (hi - lo > 1) bar = xcd_barrier_post(F0.ctl() + CW_BAR, (volatile LAS unsigned*)(F0.lds + LDSCTL_OFF));
#ifndef PH_MASK
#define PH_MASK 0xFFFF
#endif
#define PM(b) ((PH_MASK >> (b)) & 1)
#ifndef DUP_MASK
#define DUP_MASK 0
#endif
#ifndef DBL_SEAM
#define DBL_SEAM 0
#endif
#define NREP(b) (((DUP_MASK >> (b)) & 1) ? 2 : 1)
#define IN(k) (lo <= (k) && (k) < hi)
#define SEAM(k) do { if (IN(k) && IN((k) + 1)) { const Fr Fb = refresh(F0); XcdBarrier b2 = bar; b2.bar = Fb.ctl() + CW_BAR; xcd_barrier(b2); if ((DUP_MASK & 0x10000) || ((DBL_SEAM >> (((k) + NPH_L - 1) % NPH_L)) & 1)) xcd_barrier(b2); } } while (0)

    if (PM(0) && IN(0)) { for (int rep_ = 0; rep_ < NREP(0); ++rep_) { if (rep_) __syncthreads(); const Fr F = refresh(F0); phase_prologue(F); } }
    SEAM(0);
    for (int L = 0; L < DEPTH; ++L) {
        const int pb = 1 + NPH_L * L;
        const bool lastL = (L == DEPTH - 1);
        if (PM(1) && IN(pb + 0)) { const Fr F = refresh(F0); phase_norm(F, L); if (DUP_MASK & 2048) { __syncthreads(); phase_norm(F, L, false); } for (int rp = 0; rp < NREP(10); ++rp) moe_weight_convert(F, L); }
        SEAM(pb + 0);
        if (PM(2) && IN(pb + 1)) { for (int rep_ = 0; rep_ < NREP(2); ++rep_) { if (rep_) __syncthreads(); const Fr F = refresh(F0); pg8::DenseSched S; S.init(F.abuf(), F.winT() + (size_t)L * NP * DM, DM, NROW, NP, F.G, (int)blockIdx.x); pg8::EpiP E{F.pbuf()}; pg8::gemm_phase(F.lds, F.tid, DM, S, E); } }
        SEAM(pb + 1);
        if (PM(3) && IN(pb + 2)) { for (int rep_ = 0; rep_ < NREP(3); ++rep_) { if (rep_) __syncthreads(); const Fr F = refresh(F0); phase_prep(F, L); } }
        SEAM(pb + 2);
        if (PM(4) && IN(pb + 3)) { for (int rep_ = 0; rep_ < NREP(4); ++rep_) { if (rep_) __syncthreads(); const Fr F = refresh(F0); phase_ssd_s1(F, L); } }
        SEAM(pb + 3);
        if (PM(4) && IN(pb + 4)) { for (int rep_ = 0; rep_ < NREP(6); ++rep_) { if (rep_) __syncthreads(); const Fr F = refresh(F0); phase_ssd_scan(F, L); } }
        SEAM(pb + 4);
        if (PM(5) && IN(pb + 5)) { for (int rep_ = 0; rep_ < NREP(5); ++rep_) { if (rep_) __syncthreads(); const Fr F = refresh(F0); phase_mix_fast(F, L); } }
        SEAM(pb + 5);
        if (PM(6) && IN(pb + 6)) { const Fr F = refresh(F0); pg8::DenseSched S; S.init(F.mix(), F.woutT() + (size_t)L * DM * DM, DM, lastL ? NLAT : NROW, DM, F.G, (int)blockIdx.x);
            pg8::EpiRes E{L == 0 ? F.x() : F.out(), L == 0 ? F.ctx() : F.hc(), F.out(), F.hc(), F.modv() + (size_t)L * 9 * 6144 + 2 * 1024, 1.f}; pg8::gemm_phase(F.lds, F.tid, DM, S, E);
            if (DUP_MASK & 8192) { __syncthreads(); pg8::EpiRes E2{F.out(), F.hc(), F.out(), F.hc(), F.modv() + (size_t)L * 9 * 6144 + 2 * 1024, 0.f}; pg8::gemm_phase(F.lds, F.tid, DM, S, E2); } }
        SEAM(pb + 6);
        if (PM(7) && IN(pb + 7)) { const Fr F = refresh(F0); phase_route(F, L); if (DUP_MASK & 4096) phase_route(F, L, false); }
        SEAM(pb + 7);
        if (PM(8) && IN(pb + 8)) { for (int rep_ = 0; rep_ < NREP(8); ++rep_) { if (rep_) __syncthreads(); const Fr F = refresh(F0); moe_table(F, L);
            pg8::MoeSched<true> S{(const char*)F.abuf(), (const char*)F.wgu(), (size_t)1024 * DM * 2, DM, F.G, F.vcu, F.elist(), (const volatile LAS int*)(F.lds + LDSCTL_OFF + 64), (const volatile LAS int*)(F.lds + LDSCTL_OFF + 160)};
            pg8::EpiAct E{F.act()}; pg8::gemm_phase(F.lds, F.tid, DM, S, E); } }
        SEAM(pb + 8);
        if (PM(9) && IN(pb + 9)) { for (int rep_ = 0; rep_ < NREP(9); ++rep_) { if (rep_) __syncthreads(); const Fr F = refresh(F0); moe_table(F, L);
            pg8::MoeSched<false> S{(const char*)F.act(), (const char*)F.wd(), (size_t)1024 * FF * 2, FF, F.G, F.vcu, F.elist(), (const volatile LAS int*)(F.lds + LDSCTL_OFF + 64), (const volatile LAS int*)(F.lds + LDSCTL_OFF + 160)};
            pg8::EpiDown E{F.yk(), F.elist(), F.rtw()}; pg8::gemm_phase(F.lds, F.tid, FF, S, E); } }
        SEAM(pb + 9);
    }
    if (PM(1) && IN(PH_FINAL)) { const Fr F = refresh(F0); phase_norm(F, DEPTH); }
#undef IN
#undef SEAM
}

extern "C" void kernel_launch(void* const* d_in, const int* in_sizes, int n_in, void* d_out, int out_size, void* d_ws, size_t ws_size, hipStream_t stream) {
    static int grid = 0;
    if (grid == 0) {
        if (n_in != 36 || out_size != NLAT * DM || ws_size < WS_END) { fprintf(stderr, "kernel_launch: unexpected shapes (n_in %d out %d ws %zu)\n", n_in, out_size, ws_size); grid = -1; return; }
        int dev = 0, cus = 0, per_cu = 0;
        if (hipGetDevice(&dev) != hipSuccess || hipDeviceGetAttribute(&cus, hipDeviceAttributeMultiprocessorCount, dev) != hipSuccess) { grid = -1; return; }
        if (hipFuncSetAttribute((const void*)fwd_kernel, hipFuncAttributeMaxDynamicSharedMemorySize, LDS_BYTES) != hipSuccess) { fprintf(stderr, "kernel_launch: hipFuncSetAttribute failed\n"); grid = -1; return; }
        if (hipOccupancyMaxActiveBlocksPerMultiprocessor(&per_cu, (const void*)fwd_kernel, 512, LDS_BYTES) != hipSuccess || per_cu < 1) { fprintf(stderr, "kernel_launch: occupancy query says %d\n", per_cu); }
        (void)hipGetLastError();
        grid = cus;
    }
    if (grid < 0) return;
    (void)hipMemsetAsync((char*)d_ws + WS_CTL, 0, CTL_BYTES, stream);
    Args a{};
    for (int i = 0; i < 36; ++i) a.in[i] = (const float*)d_in[i];
    a.out = (float*)d_out; a.ws = (unsigned char*)d_ws;
#if MK_ONE_LAUNCH
    a.ph_lo = 0; a.ph_hi = NPHASE;
    hipLaunchKernelGGL(fwd_kernel, dim3(grid), dim3(512), LDS_BYTES, stream, a);
#else
    for (int ph = 0; ph < NPHASE; ++ph) { a.ph_lo = ph; a.ph_hi = ph + 1; hipLaunchKernelGGL(fwd_kernel, dim3(grid), dim3(512), LDS_BYTES, stream, a); }
#endif
}
```

```cpp
#include <hip/hip_runtime.h>
#include <cstdio>
#include <cstdint>

#ifndef MK_ONE_LAUNCH
#define MK_ONE_LAUNCH 1
#endif

#define LAS __attribute__((address_space(3)))
typedef unsigned short bf16;
typedef short bf16x8 __attribute__((ext_vector_type(8)));
typedef float f32x4 __attribute__((ext_vector_type(4)));
typedef float f32x2 __attribute__((ext_vector_type(2)));
typedef unsigned u32x4 __attribute__((ext_vector_type(4)));
typedef unsigned u32x2 __attribute__((ext_vector_type(2)));

constexpr int NB = 8, TLAT = 2048, TCTX = 256, SQ = 2304, DM = 1024, DEPTH = 4;
constexpr int NLAT = NB * TLAT, NCTXR = NB * TCTX, NROW = NLAT + NCTXR;
constexpr int NIN = 2984, NP = 3072;
constexpr int C_NA = 0, C_MLA = 768, C_DF = 1184, C_SSD = 1952;
constexpr int C_Z = C_SSD, C_XBC = C_SSD + 256, C_DT = C_SSD + 1024;
constexpr float EPS = 1e-6f;
constexpr int NEXP = 16, FF = 512, ACT_ROWS = 40960;
constexpr int NPH_L = 10, PH_FINAL = 1 + NPH_L * DEPTH, NPHASE = PH_FINAL + 1;

constexpr size_t MiB = 1u << 20;
constexpr size_t WS_CTL = 0, CTL_BYTES = 1 * MiB;
constexpr size_t WS_MOD = 1 * MiB;
constexpr size_t WS_ROPE = 2 * MiB;
constexpr size_t WS_WIN = 4 * MiB;
constexpr size_t WS_WOUT = 28 * MiB;
constexpr size_t WS_WQB = 36 * MiB;
constexpr size_t WS_WKVB = 37 * MiB;
constexpr size_t WS_WGU = 38 * MiB;
constexpr size_t WS_WD = 70 * MiB;
constexpr size_t WS_HC = 86 * MiB;
constexpr size_t WS_A = 94 * MiB;
constexpr size_t WS_P = 130 * MiB;
constexpr size_t WS_ACT = 130 * MiB;
constexpr size_t WS_YK = 170 * MiB;
constexpr size_t WS_MIX = 238 * MiB;
constexpr size_t WS_QNA = 274 * MiB, WS_KNA = 283 * MiB, WS_VNA = 292 * MiB;
constexpr size_t WS_QML = 301 * MiB, WS_KML = 315 * MiB, WS_VML = 329 * MiB;
constexpr size_t WS_QDF = 338 * MiB, WS_KDF = 347 * MiB, WS_VDF = 356 * MiB;
constexpr size_t WS_XT = 365 * MiB, WS_BTM = 374 * MiB, WS_BT = 383 * MiB, WS_CTM = 392 * MiB;
constexpr size_t WS_DT = 401 * MiB;
constexpr size_t WS_CST = 402 * MiB;
constexpr size_t WS_CDEC = 474 * MiB;
constexpr size_t WS_HENT = 475 * MiB;
constexpr size_t WS_RT = 511 * MiB;
constexpr size_t WS_ELIST = 512 * MiB;
constexpr size_t WS_WGU2 = 514 * MiB;
constexpr size_t WS_WD2 = 546 * MiB;
constexpr size_t WS_END = 562 * MiB;
constexpr int CW_BAR = 4096;
constexpr int CW_ECNT = 16384;
constexpr int CW_KMAX = 65536;
constexpr int CW_QUEUE = 32768;

constexpr int RING_BYTES = 131072, LDSCTL_OFF = RING_BYTES, LDS_BYTES = 147456;

typedef float f32x16 __attribute__((ext_vector_type(16)));
#define MFMA32(a, b, c) __builtin_amdgcn_mfma_f32_32x32x16_bf16((a), (b), (c), 0, 0, 0)
__device__ __forceinline__ int crow16(int reg, int hh) { return (reg & 3) + 8 * (reg >> 2) + 4 * hh; }
__device__ __forceinline__ float bf2f(bf16 v) { return __uint_as_float(((unsigned)v) << 16); }
__device__ __forceinline__ bf16 f2bf(float f) { unsigned u = __float_as_uint(f); return (bf16)((u + 0x7fffu + ((u >> 16) & 1u)) >> 16); }
__device__ __forceinline__ unsigned pk2(float lo, float hi) { return (unsigned)f2bf(lo) | ((unsigned)f2bf(hi) << 16); }
template <int CTRL> __device__ __forceinline__ float dppf(float v) { return __int_as_float(__builtin_amdgcn_update_dpp(0, __float_as_int(v), CTRL, 0xF, 0xF, true)); }
__device__ __forceinline__ float rlane(float v, int l) { return __int_as_float(__builtin_amdgcn_readlane(__float_as_int(v), l)); }
__device__ __forceinline__ float wsum(float v) {
    v += dppf<0xB1>(v); v += dppf<0x4E>(v); v += dppf<0x141>(v); v += dppf<0x140>(v);
    return (rlane(v, 0) + rlane(v, 16)) + (rlane(v, 32) + rlane(v, 48)); }
__device__ __forceinline__ float wmaxf(float v) {
    v = fmaxf(v, dppf<0xB1>(v)); v = fmaxf(v, dppf<0x4E>(v)); v = fmaxf(v, dppf<0x141>(v)); v = fmaxf(v, dppf<0x140>(v));
    return fmaxf(fmaxf(rlane(v, 0), rlane(v, 16)), fmaxf(rlane(v, 32), rlane(v, 48))); }
#define LDS_WAIT() asm volatile("s_waitcnt lgkmcnt(0)" ::: "memory")
__device__ __forceinline__ void row2bs(int r, int& b, int& s) { if (r < NLAT) { b = r >> 11; s = 256 + (r & 2047); } else { const int j = r - NLAT; b = j >> 8; s = j & 255; } }
__device__ __forceinline__ int bs2row(int b, int s) { return s < 256 ? NLAT + b * 256 + s : b * 2048 + s - 256; }
__device__ __forceinline__ int vpos(int s) { return (s & ~12) | ((s & 4) << 1) | ((s & 8) >> 1); }
__device__ __forceinline__ float siluf(float x) { return x / (1.f + __expf(-x)); }

#define XB_TMO      128
#define XB_XCNT(j)  (256  + 64 * (j))
#define XB_XSUB(j)  (1280 + 64 * (j))
#define XB_XGEN(j)  (2304 + 64 * (j))
#define XB_TOP      3328
#define XB_TOPGEN   3392
#define XCD_BAR_WORDS 3456
#define XB_SPIN_CAP (1u << 24)
__device__ __forceinline__ unsigned xb_ld(unsigned* p)              { return __hip_atomic_load(p, __ATOMIC_RELAXED, __HIP_MEMORY_SCOPE_AGENT); }
__device__ __forceinline__ unsigned xb_add(unsigned* p, unsigned v) { return __hip_atomic_fetch_add(p, v, __ATOMIC_RELAXED, __HIP_MEMORY_SCOPE_AGENT); }
__device__ __forceinline__ unsigned xb_xcc_id() { return (unsigned)__builtin_amdgcn_s_getreg((3 << 11) | 20) & 0xFu; }
#define XB_SPIN(cond, bar) do { unsigned _sp = 0; while (cond) { __builtin_amdgcn_s_sleep(1); \
    if ((++_sp & 255u) == 0u) { if (xb_ld(&(bar)[XB_TMO])) break; if (_sp > XB_SPIN_CAP) { atomicAdd(&(bar)[XB_TMO], 1u); break; } } } } while (0)
struct XcdBarrier { unsigned* bar; unsigned x; volatile LAS unsigned* st; };
__device__ __forceinline__ XcdBarrier xcd_barrier_post(unsigned* bar, volatile LAS unsigned* st) {
    XcdBarrier b; b.bar = bar; b.x = xb_xcc_id(); b.st = st;
    if (threadIdx.x == 0) (void)xb_add(&bar[XB_XCNT(b.x)], 1u);
    return b;
}
__device__ __forceinline__ void xcd_barrier_complete(unsigned* bar, unsigned x, unsigned& nloc, unsigned& nx) {
    const unsigned G = gridDim.x * gridDim.y * gridDim.z;
    unsigned sum, cnt, mine, sp = 0u;
    for (;;) {
        sum = 0u; cnt = 0u; mine = 0u;
#pragma unroll
        for (unsigned j = 0; j < 16; ++j) { const unsigned c = xb_ld(&bar[XB_XCNT(j)]); sum += c; cnt += (c > 0u) ? 1u : 0u; mine = (j == x) ? c : mine; }
        if (sum == G) break;
        __builtin_amdgcn_s_sleep(1);
        if ((++sp & 255u) == 0u) { if (xb_ld(&bar[XB_TMO])) break; if (sp > XB_SPIN_CAP) { atomicAdd(&bar[XB_TMO], 1u); break; } }
    }
    nloc = mine > 0u ? mine : 1u; nx = cnt > 0u ? cnt : 1u;
}
__device__ __forceinline__ void xcd_barrier(const XcdBarrier& b) {
    asm volatile("s_waitcnt vmcnt(0)" ::: "memory");
    __syncthreads();
    if (threadIdx.x == 0) {
        unsigned* bar = b.bar;
        __builtin_amdgcn_s_waitcnt(0);
        unsigned nloc = b.st[0], nx = b.st[1];
        if (nloc == 0u) { xcd_barrier_complete(bar, b.x, nloc, nx); b.st[0] = nloc; b.st[1] = nx; }
        const unsigned old = xb_add(&bar[XB_XSUB(b.x)], 1u);
        const unsigned gen = old / nloc;
        if (old + 1u == (gen + 1u) * nloc) {
            __builtin_amdgcn_fence(__ATOMIC_RELEASE, "agent");
            asm volatile("s_waitcnt vmcnt(0)" ::: "memory");
            const unsigned og = xb_add(&bar[XB_TOP], 1u);
            const unsigned tg = og / nx;
            if (og + 1u == (tg + 1u) * nx) xb_add(&bar[XB_TOPGEN], 1u);
            else XB_SPIN(xb_ld(&bar[XB_TOPGEN]) == tg, bar);
            __builtin_amdgcn_fence(__ATOMIC_ACQUIRE, "agent");
            xb_add(&bar[XB_XGEN(b.x)], 1u);
            asm volatile("s_waitcnt vmcnt(0)" ::: "memory");
        } else {
            XB_SPIN(xb_ld(&bar[XB_XGEN(b.x)]) == gen, bar);
            __builtin_amdgcn_fence(__ATOMIC_ACQUIRE, "agent");
            asm volatile("s_waitcnt vmcnt(0)" ::: "memory");
        }
    }
    __syncthreads();
}

namespace pg8 {
constexpr int BM = 256, BK = 64, HALF = 128, HTB = HALF * BK * 2, NXCD = 8, WGM = 8;
__device__ __forceinline__ int lds_byte(int r, int c) { const int st = (r >> 4) * 2 + (c >> 5), rr = r & 15, cc = c & 31, ob = rr * 64 + cc * 2; return st * 1024 + (ob ^ (((ob >> 9) & 1) << 5)); }
__device__ __forceinline__ void stage_rc(int b, int& R, int& C) { const int st = b / 1024, sb = b % 1024, swz = sb ^ (((sb >> 9) & 1) << 5); R = (st >> 1) * 16 + swz / 64; C = (st & 1) * 32 + (swz % 64) / 2; }
__device__ __forceinline__ int perm32(int rho) { const int n = rho >> 4, i = rho & 15; return 8 * (i >> 2) + 4 * n + (i & 3); }
struct Unit { int pm, pn, e, j, cnt; };

template <class Epi, class Sched>
__device__ __forceinline__ void gemm_phase(LAS unsigned char* lds, const int tid, const int K, const Sched& S, const Epi& E) {
    const int wid = __builtin_amdgcn_readfirstlane(tid >> 6), lane = tid & 63, wr = wid >> 2, wc = wid & 3, fr = lane & 15, fq = lane >> 4;
    const int nt = K / BK;
    int Rr[2]; unsigned Cb[2], voffB[2];
#pragma unroll
    for (int i = 0; i < 2; ++i) { int R, C; stage_rc(tid * 16 + i * 8192, R, C); const int Rb = Epi::PERM ? ((R & ~31) + perm32(R & 31)) : R;
        Rr[i] = R; Cb[i] = (unsigned)C * 2u; voffB[i] = (unsigned)(Rb * K + C) * 2u; }
    const size_t kstep = (size_t)(BK * 2);
    const size_t hstep = (size_t)HALF * K * 2;
    const unsigned ldsw = (unsigned)wid * 1024u;
    const int aoff = lds_byte(wr * 64 + fr, fq * 8), boff = lds_byte(wc * 32 + fr, fq * 8);
#define PG8_SA(b, h) (((b) * 2 + (h)) * HTB)
#define PG8_SB(b, h) ((4 + (b) * 2 + (h)) * HTB)
#define PG8_STAGE(bufoff, gbase, voff) do { _Pragma("unroll") for (int _i = 0; _i < 2; ++_i) \
        __builtin_amdgcn_global_load_lds((const unsigned*)((const char*)(gbase) + (voff)[_i]), (LAS unsigned*)(lds + (bufoff) + ldsw + _i * 8192), 16, 0, 0); } while (0)
#define PG8_LDA(dst, b, h) do { _Pragma("unroll") for (int m = 0; m < 4; ++m) _Pragma("unroll") for (int k = 0; k < 2; ++k) dst[m][k] = *(const LAS bf16x8*)(lds + PG8_SA(b, h) + aoff + m * 2048 + k * 1024); } while (0)
#define PG8_LDB(dst, b, h) do { _Pragma("unroll") for (int n = 0; n < 2; ++n) _Pragma("unroll") for (int k = 0; k < 2; ++k) dst[n][k] = *(const LAS bf16x8*)(lds + PG8_SB(b, h) + boff + n * 2048 + k * 1024); } while (0)
#define PG8_MMA(ai, bj, At, Bt) do { __builtin_amdgcn_s_setprio(1); _Pragma("unroll") for (int m = 0; m < 4; ++m) _Pragma("unroll") for (int n = 0; n < 2; ++n) _Pragma("unroll") for (int k = 0; k < 2; ++k) \
        acc[ai][bj][m][n] = __builtin_amdgcn_mfma_f32_16x16x32_bf16(Bt[n][k], At[m][k], acc[ai][bj][m][n], 0, 0, 0); __builtin_amdgcn_s_setprio(0); } while (0)
#define PG8_WAIT_V(n) asm volatile("s_waitcnt vmcnt(" #n ")" ::: "memory")
#define PG8_WAIT_L(n) asm volatile("s_waitcnt lgkmcnt(" #n ")" ::: "memory")
#define PG8_BAR __builtin_amdgcn_s_barrier()
#define PG8_SCHED __builtin_amdgcn_sched_barrier(0)
    Unit cur, nxt; int ui = 0;
    if (!S.next(0, cur)) return;
    f32x4 acc[2][2][4][2];
#pragma unroll
    for (int a = 0; a < 2; ++a)
#pragma unroll
        for (int b = 0; b < 2; ++b)
#pragma unroll
            for (int m = 0; m < 4; ++m)
#pragma unroll
                for (int n = 0; n < 2; ++n) acc[a][b][m][n] = (f32x4){0.f, 0.f, 0.f, 0.f};
    bf16x8 At[4][2], B0[2][2], B1[2][2];
    unsigned vA0[2], vA1[2];
    const char* cA = S.a_ptr(cur);
    if constexpr (Sched::GATHER) { S.a_offs(cur, Rr, vA0, vA1);
#pragma unroll
        for (int i = 0; i < 2; ++i) { vA0[i] += Cb[i]; vA1[i] += Cb[i]; }
        asm volatile("s_waitcnt vmcnt(0)" ::: "memory");
    } else {
#pragma unroll
        for (int i = 0; i < 2; ++i) { vA0[i] = (unsigned)(Rr[i] * K * 2) + Cb[i]; vA1[i] = vA0[i]; } }
    const size_t ahs = Sched::GATHER ? (size_t)0 : hstep;
    const char* cB = S.b_ptr(cur);
    PG8_STAGE(PG8_SB(0, 0), cB, voffB); PG8_STAGE(PG8_SB(0, 1), cB + hstep, voffB); PG8_STAGE(PG8_SA(0, 0), cA, vA0); PG8_STAGE(PG8_SA(0, 1), cA + ahs, vA1);
    if (wr == 1) PG8_BAR;
    PG8_WAIT_V(2); PG8_BAR;
    PG8_STAGE(PG8_SB(1, 0), cB + kstep, voffB); PG8_STAGE(PG8_SA(1, 0), cA + kstep, vA0); PG8_STAGE(PG8_SB(1, 1), cB + hstep + kstep, voffB);
    PG8_WAIT_V(6); PG8_BAR;
    for (;;) {
        const bool has_next = S.next(ui + 1, nxt);
        const char* nA = has_next ? S.a_ptr(nxt) : cA; const char* nB = has_next ? S.b_ptr(nxt) : cB;
        for (int t = 0; t < nt; t += 2) {
            const bool last = (t == nt - 2);
            const char* a1 = cA + (size_t)(t + 1) * kstep;
            const char* a2 = last ? nA : cA + (size_t)(t + 2) * kstep; const char* b2 = last ? nB : cB + (size_t)(t + 2) * kstep;
            const char* a3 = a2 + kstep; const char* b3 = b2 + kstep;
            PG8_LDB(B0, 0, 0); PG8_LDB(B1, 0, 1); PG8_SCHED; PG8_LDA(At, 0, 0); PG8_STAGE(PG8_SA(1, 1), a1 + ahs, vA1);
            if constexpr (Sched::GATHER) { if (last && has_next) { S.a_offs(nxt, Rr, vA0, vA1);
#pragma unroll
                for (int i = 0; i < 2; ++i) { vA0[i] += Cb[i]; vA1[i] += Cb[i]; }
                asm volatile("s_waitcnt vmcnt(0)" ::: "memory"); } }
            PG8_WAIT_V(8); PG8_WAIT_L(0); PG8_BAR; PG8_MMA(0, 0, At, B0); PG8_MMA(0, 1, At, B1); PG8_BAR; PG8_SCHED;
            PG8_LDA(At, 0, 1); PG8_STAGE(PG8_SB(0, 0), b2, voffB); PG8_STAGE(PG8_SB(0, 1), b2 + hstep, voffB); PG8_STAGE(PG8_SA(0, 0), a2, vA0);
            PG8_WAIT_V(8); PG8_WAIT_L(0); PG8_BAR; PG8_MMA(1, 0, At, B0); PG8_MMA(1, 1, At, B1); PG8_BAR; PG8_SCHED;
            PG8_LDB(B0, 1, 0); PG8_LDB(B1, 1, 1); PG8_SCHED; PG8_LDA(At, 1, 0); PG8_STAGE(PG8_SA(0, 1), a2 + ahs, vA1);
            PG8_WAIT_V(8); PG8_WAIT_L(0); PG8_BAR; PG8_MMA(0, 0, At, B0); PG8_MMA(0, 1, At, B1); PG8_BAR; PG8_SCHED;
            PG8_LDA(At, 1, 1); PG8_STAGE(PG8_SB(1, 0), b3, voffB); PG8_STAGE(PG8_SB(1, 1), b3 + hstep, voffB); PG8_STAGE(PG8_SA(1, 0), a3, vA0);
            PG8_WAIT_V(8); PG8_WAIT_L(0); PG8_BAR; PG8_MMA(1, 0, At, B0); PG8_MMA(1, 1, At, B1); PG8_BAR; PG8_SCHED;
        }
        if (wr == 0) PG8_BAR;
        E(acc, cur, wr, wc, fr, fq);
        if (!has_next) break;
#pragma unroll
        for (int a = 0; a < 2; ++a)
#pragma unroll
            for (int b = 0; b < 2; ++b)
#pragma unroll
                for (int m = 0; m < 4; ++m)
#pragma unroll
                    for (int n = 0; n < 2; ++n) acc[a][b][m][n] = (f32x4){0.f, 0.f, 0.f, 0.f};
        cur = nxt; cA = nA; cB = nB; ++ui;
        if (wr == 1) PG8_BAR;
    }
    PG8_WAIT_V(0);
    PG8_BAR;
#undef PG8_SA
#undef PG8_SB
#undef PG8_STAGE
#undef PG8_LDA
#undef PG8_LDB
#undef PG8_MMA
#undef PG8_WAIT_V
#undef PG8_WAIT_L
#undef PG8_BAR
#undef PG8_SCHED
}
__device__ __forceinline__ unsigned cvt_pk_bf16(float lo, float hi) { unsigned r; asm volatile("v_cvt_pk_bf16_f32 %0, %1, %2" : "=v"(r) : "v"(lo), "v"(hi)); return r; }

struct DenseSched {
    const char* A; const char* Bt; int K, nM, nN, nwg, G, c;
    __device__ void init(const void* A_, const void* Bt_, int K_, int M, int N, int G_, int c_) { A = (const char*)A_; Bt = (const char*)Bt_; K = K_; nM = M / BM; nN = N / BM; nwg = nM * nN; G = G_; c = c_; }
    __device__ __forceinline__ bool next(int i, Unit& u) const {
        const long L = (long)i * G + c; if (L >= nwg) return false;
        int wgid = (int)L; { const int q = nwg / NXCD, r = nwg % NXCD, xcd = wgid % NXCD, off = wgid / NXCD; wgid = (xcd < r ? xcd * (q + 1) : r * (q + 1) + (xcd - r) * q) + off; }
        const int nig = WGM * nN, gid = wgid / nig, fm = gid * WGM, gsz = (nM - fm) < WGM ? (nM - fm) : WGM;
        u.pm = fm + ((wgid % nig) % gsz); u.pn = (wgid % nig) / gsz; u.e = 0; u.j = 0; u.cnt = 256; return true;
    }
    static constexpr bool GATHER = false;
    __device__ __forceinline__ const char* a_ptr(const Unit& u) const { return A + (size_t)u.pm * BM * K * 2; }
    __device__ __forceinline__ void a_offs(const Unit&, const int (&)[2], unsigned (&)[2], unsigned (&)[2]) const {}
    __device__ __forceinline__ const char* b_ptr(const Unit& u) const { return Bt + (size_t)u.pn * BM * K * 2; }
};
template <bool GATHER_> struct MoeSched {
    static constexpr bool GATHER = GATHER_;
    const char* A; const char* W; size_t wstride; int K, G, c; const int* elist; const volatile LAS int* T; const volatile LAS int* Cn;
    __device__ __forceinline__ bool next(int i, Unit& u) const {
        const long L = (long)i * G + c; const int nT = T[16]; if (L >= 4L * nT) return false;
        const int tile = (int)(L >> 2); u.pn = (int)(L & 3); u.pm = tile;
        int e = 0;
#pragma unroll
        for (int k = 1; k < 16; ++k) e += (tile >= T[k]) ? 1 : 0;
        u.e = e; u.j = tile - T[e]; u.cnt = Cn[e]; return true;
    }
    __device__ __forceinline__ const char* a_ptr(const Unit& u) const { return GATHER ? A : A + (size_t)u.pm * BM * K * 2; }
    __device__ __forceinline__ void a_offs(const Unit& u, const int (&Rr)[2], unsigned (&v0)[2], unsigned (&v1)[2]) const {
#pragma unroll
        for (int i = 0; i < 2; ++i) {
            const int p0 = u.j * BM + Rr[i], p1 = p0 + HALF;
            int t0 = p0 < u.cnt ? (elist[u.e * NROW + p0] >> 1) : 0, t1 = p1 < u.cnt ? (elist[u.e * NROW + p1] >> 1) : 0;
            t0 = min(max(t0, 0), NROW - 1); t1 = min(max(t1, 0), NROW - 1);
            v0[i] = (unsigned)(t0 * K * 2); v1[i] = (unsigned)(t1 * K * 2);
        } }
    __device__ __forceinline__ const char* b_ptr(const Unit& u) const { return W + (size_t)u.e * wstride + (size_t)u.pn * BM * K * 2; }
};
struct EpiP {
    static constexpr bool PERM = true;
    bf16* O;
    __device__ __forceinline__ void operator()(const f32x4 (&acc)[2][2][4][2], const Unit& u, int wr, int wc, int fr, int fq) const {
        const int row0 = u.pm * BM + wr * 64 + fr, col0 = u.pn * BM + wc * 32 + 8 * fq;
#pragma unroll
        for (int ai = 0; ai < 2; ++ai)
#pragma unroll
            for (int m = 0; m < 4; ++m) { bf16* rowp = O + (size_t)(row0 + ai * HALF + m * 16) * NP + col0;
#pragma unroll
                for (int bj = 0; bj < 2; ++bj) { const f32x4 v0 = acc[ai][bj][m][0], v1 = acc[ai][bj][m][1];
                    u32x4 w; w.x = cvt_pk_bf16(v0[0], v0[1]); w.y = cvt_pk_bf16(v0[2], v0[3]); w.z = cvt_pk_bf16(v1[0], v1[1]); w.w = cvt_pk_bf16(v1[2], v1[3]);
                    *(u32x4*)(rowp + bj * HALF) = w; } }
    }
};
struct EpiRes {
    static constexpr bool PERM = false;
    const float* hin_l; const float* hin_c; float* hout_l; float* hout_c; const float* gate; float gsc;
    __device__ __forceinline__ void operator()(const f32x4 (&acc)[2][2][4][2], const Unit& u, int wr, int wc, int fr, int fq) const {
        const int row0 = u.pm * BM + wr * 64 + fr, col0 = u.pn * BM + wc * 32 + 4 * fq;
#pragma unroll
        for (int ai = 0; ai < 2; ++ai)
#pragma unroll
            for (int m = 0; m < 4; ++m) { const int r = row0 + ai * HALF + m * 16; const bool lat = r < NLAT; const int bb = lat ? (r >> 11) : 8;
                const float* hi = lat ? hin_l + (size_t)r * DM : hin_c + (size_t)(r - NLAT) * DM; float* ho = lat ? hout_l + (size_t)r * DM : hout_c + (size_t)(r - NLAT) * DM;
                const float* g = gate + (size_t)bb * 6144;
#pragma unroll
                for (int bj = 0; bj < 2; ++bj)
#pragma unroll
                    for (int n = 0; n < 2; ++n) { const int c = col0 + bj * HALF + n * 16; const f32x4 gv = *(const f32x4*)(g + c), hv = *(const f32x4*)(hi + c);
                        *(f32x4*)(ho + c) = hv + gv * gsc * acc[ai][bj][m][n]; } }
    }
};
struct EpiAct {
    static constexpr bool PERM = true;
    bf16* O;
    __device__ __forceinline__ void operator()(const f32x4 (&acc)[2][2][4][2], const Unit& u, int wr, int wc, int fr, int fq) const {
        const int row0 = u.pm * BM + wr * 64 + fr, col0 = u.pn * HALF + wc * 32 + 8 * fq;
#pragma unroll
        for (int ai = 0; ai < 2; ++ai)
#pragma unroll
            for (int m = 0; m < 4; ++m) { bf16* rowp = O + (size_t)(row0 + ai * HALF + m * 16) * FF + col0;
                float o[8];
#pragma unroll
                for (int n = 0; n < 2; ++n)
#pragma unroll
                    for (int j = 0; j < 4; ++j) { const float g = acc[ai][0][m][n][j], up = acc[ai][1][m][n][j]; o[n * 4 + j] = g / (1.f + __expf(-g)) * up; }
                u32x4 w; w.x = cvt_pk_bf16(o[0], o[1]); w.y = cvt_pk_bf16(o[2], o[3]); w.z = cvt_pk_bf16(o[4], o[5]); w.w = cvt_pk_bf16(o[6], o[7]);
                *(u32x4*)rowp = w; }
    }
};
struct EpiDown {
    static constexpr bool PERM = true;
    bf16* O; const int* elist; const float* rtw;
    __device__ __forceinline__ void operator()(const f32x4 (&acc)[2][2][4][2], const Unit& u, int wr, int wc, int fr, int fq) const {
        const int col0 = u.pn * BM + wc * 32 + 8 * fq;
#pragma unroll
        for (int ai = 0; ai < 2; ++ai)
#pragma unroll
            for (int m = 0; m < 4; ++m) { const int pos = u.j * BM + ai * HALF + wr * 64 + m * 16 + fr;
                if (pos < u.cnt) { const int a = min(max(elist[u.e * NROW + pos], 0), 2 * NROW - 1); const float w8 = rtw[a]; bf16* rowp = O + (size_t)a * DM + col0;
#pragma unroll
                    for (int bj = 0; bj < 2; ++bj) { const f32x4 v0 = acc[ai][bj][m][0] * w8, v1 = acc[ai][bj][m][1] * w8;
                        u32x4 w; w.x = cvt_pk_bf16(v0[0], v0[1]); w.y = cvt_pk_bf16(v0[2], v0[3]); w.z = cvt_pk_bf16(v1[0], v1[1]); w.w = cvt_pk_bf16(v1[2], v1[3]);
                        *(u32x4*)(rowp + bj * HALF) = w; } } }
    }
};
}

struct Args { const float* in[36]; float* out; unsigned char* ws; int ph_lo, ph_hi; };
struct Fr {
    LAS unsigned char* lds; int tid, lane, wave, G, vcu, gw, NGW; const __attribute__((address_space(4))) Args* A;
    __device__ __forceinline__ const float* x() const { return A->in[0]; }
    __device__ __forceinline__ const float* cvec() const { return A->in[1]; }
    __device__ __forceinline__ const float* ctx() const { return A->in[2]; }
    __device__ __forceinline__ const float* cctx() const { return A->in[3]; }
    __device__ __forceinline__ const float* w_mod() const { return A->in[4]; }
    __device__ __forceinline__ const float* b_mod() const { return A->in[5]; }
    __device__ __forceinline__ const float* g_mix() const { return A->in[6]; }
    __device__ __forceinline__ const float* w_in() const { return A->in[7]; }
    __device__ __forceinline__ const float* w_out() const { return A->in[8]; }
    __device__ __forceinline__ const float* na_gq() const { return A->in[9]; }
    __device__ __forceinline__ const float* na_gk() const { return A->in[10]; }
    __device__ __forceinline__ const float* na_rb() const { return A->in[11]; }
    __device__ __forceinline__ const float* mla_gqa() const { return A->in[12]; }
    __device__ __forceinline__ const float* mla_wqb() const { return A->in[13]; }
    __device__ __forceinline__ const float* mla_gkva() const { return A->in[14]; }
    __device__ __forceinline__ const float* mla_wkvb() const { return A->in[15]; }
    __device__ __forceinline__ const float* mla_gq() const { return A->in[16]; }
    __device__ __forceinline__ const float* mla_gk() const { return A->in[17]; }
    __device__ __forceinline__ const float* df_gq() const { return A->in[18]; }
    __device__ __forceinline__ const float* df_gk() const { return A->in[19]; }
    __device__ __forceinline__ const float* df_lam() const { return A->in[20]; }
    __device__ __forceinline__ const float* df_gsub() const { return A->in[21]; }
    __device__ __forceinline__ const float* conv_w() const { return A->in[22]; }
    __device__ __forceinline__ const float* conv_b() const { return A->in[23]; }
    __device__ __forceinline__ const float* dt_bias() const { return A->in[24]; }
    __device__ __forceinline__ const float* a_log() const { return A->in[25]; }
    __device__ __forceinline__ const float* ssd_d() const { return A->in[26]; }
    __device__ __forceinline__ const float* ssd_gn() const { return A->in[27]; }
    __device__ __forceinline__ const float* g_ffn() const { return A->in[28]; }
    __device__ __forceinline__ const float* w_grp() const { return A->in[29]; }
    __device__ __forceinline__ const float* b_grp() const { return A->in[30]; }
    __device__ __forceinline__ const float* w_exp() const { return A->in[31]; }
    __device__ __forceinline__ const float* b_exp() const { return A->in[32]; }
    __device__ __forceinline__ const float* w_gate() const { return A->in[33]; }
    __device__ __forceinline__ const float* w_up() const { return A->in[34]; }
    __device__ __forceinline__ const float* w_down() const { return A->in[35]; }
    __device__ __forceinline__ float* out() const { return A->out; }
    __device__ __forceinline__ unsigned* ctl() const { return (unsigned*)(A->ws + WS_CTL); }
    __device__ __forceinline__ float* modv() const { return (float*)(A->ws + WS_MOD); }
    __device__ __forceinline__ float* rcos() const { return (float*)(A->ws + WS_ROPE); }
    __device__ __forceinline__ float* rsin() const { return (float*)(A->ws + WS_ROPE + TLAT * 16 * 4); }
    __device__ __forceinline__ bf16* winT() const { return (bf16*)(A->ws + WS_WIN); }
    __device__ __forceinline__ bf16* woutT() const { return (bf16*)(A->ws + WS_WOUT); }
    __device__ __forceinline__ bf16* wqbT() const { return (bf16*)(A->ws + WS_WQB); }
    __device__ __forceinline__ bf16* wkvbT() const { return (bf16*)(A->ws + WS_WKVB); }
    __device__ __forceinline__ bf16* wgu(int par = 0) const { return (bf16*)(A->ws + (par ? WS_WGU2 : WS_WGU)); }
    __device__ __forceinline__ bf16* wd(int par = 0) const { return (bf16*)(A->ws + (par ? WS_WD2 : WS_WD)); }
    __device__ __forceinline__ float* hc() const { return (float*)(A->ws + WS_HC); }
    __device__ __forceinline__ bf16* abuf() const { return (bf16*)(A->ws + WS_A); }
    __device__ __forceinline__ bf16* pbuf() const { return (bf16*)(A->ws + WS_P); }
    __device__ __forceinline__ bf16* act() const { return (bf16*)(A->ws + WS_ACT); }
    __device__ __forceinline__ bf16* yk() const { return (bf16*)(A->ws + WS_YK); }
    __device__ __forceinline__ bf16* mix() const { return (bf16*)(A->ws + WS_MIX); }
    __device__ __forceinline__ bf16* qna() const { return (bf16*)(A->ws + WS_QNA); }
    __device__ __forceinline__ bf16* kna() const { return (bf16*)(A->ws + WS_KNA); }
    __device__ __forceinline__ bf16* vna() const { return (bf16*)(A->ws + WS_VNA); }
    __device__ __forceinline__ bf16* qml() const { return (bf16*)(A->ws + WS_QML); }
    __device__ __forceinline__ bf16* kml() const { return (bf16*)(A->ws + WS_KML); }
    __device__ __forceinline__ bf16* vml() const { return (bf16*)(A->ws + WS_VML); }
    __device__ __forceinline__ bf16* qdf() const { return (bf16*)(A->ws + WS_QDF); }
    __device__ __forceinline__ bf16* kdf() const { return (bf16*)(A->ws + WS_KDF); }
    __device__ __forceinline__ bf16* vdf() const { return (bf16*)(A->ws + WS_VDF); }
    __device__ __forceinline__ bf16* xT() const { return (bf16*)(A->ws + WS_XT); }
    __device__ __forceinline__ bf16* btm() const { return (bf16*)(A->ws + WS_BTM); }
    __device__ __forceinline__ bf16* bT() const { return (bf16*)(A->ws + WS_BT); }
    __device__ __forceinline__ bf16* ctm() const { return (bf16*)(A->ws + WS_CTM); }
    __device__ __forceinline__ float* dtv() const { return (float*)(A->ws + WS_DT); }
    __device__ __forceinline__ float* cst() const { return (float*)(A->ws + WS_CST); }
    __device__ __forceinline__ float* cdec() const { return (float*)(A->ws + WS_CDEC); }
    __device__ __forceinline__ bf16* hent() const { return (bf16*)(A->ws + WS_HENT); }
    __device__ __forceinline__ float* ydir() const { return (float*)(A->ws + WS_CST); }
    __device__ __forceinline__ int* rte() const { return (int*)(A->ws + WS_RT); }
    __device__ __forceinline__ float* rtw() const { return (float*)(A->ws + WS_RT + 256 * 1024); }
    __device__ __forceinline__ int* elist() const { return (int*)(A->ws + WS_ELIST); }
};

__device__ __forceinline__ Fr refresh(const Fr& F0) { Fr F = F0; int w = F0.wave; asm volatile("" : "+s"(w)); asm volatile("" : "+s"(F.A));
    int l; asm volatile("v_mbcnt_lo_u32_b32 %0, -1, 0\n\tv_mbcnt_hi_u32_b32 %0, -1, %0" : "=v"(l)); F.wave = w; F.lane = l; F.tid = w * 64 + l; F.gw = F.vcu * 8 + w; return F; }
__device__ __forceinline__ void tr_item(const float* W, int ldw, int nvalid, int k0, int n0, bf16* dst, int ldd, LAS float* scr, int lane, const float* ksc = nullptr) {
    const int cn = n0 + (lane & 31), cnc = min(cn, nvalid - 1);
    float tv[32];
#pragma unroll
    for (int i = 0; i < 32; ++i) { const int kk = 2 * i + (lane >> 5); tv[i] = W[(size_t)(k0 + kk) * ldw + cnc]; }
#pragma unroll
    for (int i = 0; i < 32; ++i) { const int kk = 2 * i + (lane >> 5); const float sc1 = ksc ? ksc[k0 + kk] : 1.f; scr[kk * 33 + (lane & 31)] = cn < nvalid ? tv[i] * sc1 : 0.f; }
    LDS_WAIT();
    const int c = lane & 7;
#pragma unroll
    for (int j = 0; j < 4; ++j) { const int n = (lane >> 3) + 8 * j; const LAS float* s = scr + (8 * c) * 33 + n;
        u32x4 o; o.x = pk2(s[0 * 33], s[1 * 33]); o.y = pk2(s[2 * 33], s[3 * 33]); o.z = pk2(s[4 * 33], s[5 * 33]); o.w = pk2(s[6 * 33], s[7 * 33]);
        *(u32x4*)(dst + (size_t)n * ldd + k0 + 8 * c) = o; }
    LDS_WAIT();
}
__device__ __forceinline__ void moe_weight_convert(const Fr& F, int L, int gw0 = -1, int ngw0 = 0) {
    LAS float* scr = (LAS float*)(F.lds + F.wave * 16384);
    const int gwc = gw0 >= 0 ? gw0 : F.gw, ngwc = gw0 >= 0 ? ngw0 : F.NGW; bf16* const wgu_ = F.wgu(L & 1); bf16* const wd_ = F.wd(L & 1);
    constexpr int I_GU = 16 * 16, I_D = 8 * 32;
    for (int it = gwc; it < NEXP * (2 * I_GU + I_D); it += ngwc) {
        const int e = it / (2 * I_GU + I_D); int r = it % (2 * I_GU + I_D);
        if (r < 2 * I_GU) { const int bj = r / I_GU; r %= I_GU; const int kb = r / 16, nb = r % 16, n0 = nb * 32;
            const float* W = (bj ? F.w_up() : F.w_gate()) + ((size_t)L * NEXP + e) * DM * FF;
            tr_item(W, FF, FF, kb * 64, n0, wgu_ + ((size_t)e * 1024 + (n0 >> 7) * 256 + bj * 128 + (n0 & 127)) * DM, DM, scr, F.lane);
        } else { r -= 2 * I_GU; const int kb = r / 32, nb = r % 32, n0 = nb * 32;
            const float* W = F.w_down() + ((size_t)L * NEXP + e) * FF * DM;
            tr_item(W, DM, DM, kb * 64, n0, wd_ + ((size_t)e * 1024 + n0) * FF, FF, scr, F.lane); }
    }
}
__device__ __forceinline__ void phase_prologue(const Fr& F) {
    {   LAS float* sc = (LAS float*)F.lds;
        LAS float* part = (LAS float*)(F.lds + 40960);
        for (int i = F.tid; i < 9 * 1024; i += 512) { const float v = i < 8192 ? F.cvec()[i] : F.cctx()[i - 8192]; sc[i] = siluf(v); }
        __syncthreads();
        for (int u = F.vcu; u < 384; u += F.G) {
            const int col = u * 64 + F.lane, L = col / 6144, n = col - L * 6144;
            const float* w = F.w_mod() + ((size_t)L * 1024 + F.wave * 128) * 6144 + n;
            float acc[9];
#pragma unroll
            for (int b = 0; b < 9; ++b) acc[b] = 0.f;
#pragma unroll 1
            for (int k0 = 0; k0 < 128; k0 += 16) { float wv[16];
#pragma unroll
                for (int j = 0; j < 16; ++j) wv[j] = w[(size_t)(k0 + j) * 6144];
#pragma unroll
                for (int j = 0; j < 16; ++j)
#pragma unroll
                    for (int b = 0; b < 9; ++b) acc[b] += sc[b * 1024 + F.wave * 128 + k0 + j] * wv[j]; }
#pragma unroll
            for (int b = 0; b < 9; ++b) part[(F.wave * 9 + b) * 64 + F.lane] = acc[b];
            __syncthreads();
            for (int i = F.tid; i < 9 * 64; i += 512) { const int b = i >> 6, l = i & 63; float s = 0.f;
#pragma unroll
                for (int w8 = 0; w8 < 8; ++w8) s += part[(w8 * 9 + b) * 64 + l];
                const int c2 = u * 64 + l, L2 = c2 / 6144, n2 = c2 - L2 * 6144;
                F.modv()[((size_t)L2 * 9 + b) * 6144 + n2] = s + F.b_mod()[L2 * 6144 + n2]; }
            __syncthreads();
        }
    }
    if (blockIdx.x == 0 && F.wave < 4) {
#pragma unroll 1
        for (int q = 0; q < 4; ++q) { const int lh = F.wave * 4 + q; float bm = 0.f;
            for (int i = F.lane; i < 465; i += 64) bm = fmaxf(bm, F.na_rb()[lh * 465 + i]);
            bm = wmaxf(bm); if (F.lane == 0) (F.rcos() + 2 * TLAT * 16)[lh] = bm * 1.4426950408889634f; } }
    for (int i = blockIdx.x * 512 + F.tid; i < TLAT * 16; i += F.G * 512) { const int t = i >> 4, k = i & 15; const float inv = powf(10000.f, -(float)(k & 7) / 8.f);
        const float pos = (k < 8) ? (float)(t >> 6) : (float)(t & 63); const float ang = pos * inv; F.rcos()[i] = cosf(ang); F.rsin()[i] = sinf(ang); }
    __syncthreads();
    LAS float* scr = (LAS float*)(F.lds + F.wave * 16384);
    constexpr int I_IN = 16 * 96, I_OUT = 16 * 32, I_QB = 4 * 12, I_KVB = 2 * 16, I_L = I_IN + I_OUT + I_QB + I_KVB;
    for (int it = F.gw; it < DEPTH * I_L; it += F.NGW) {
        const int L = it / I_L; int r = it % I_L;
        if (r < I_IN) { const int kb = r / 96, nb = r % 96; tr_item(F.w_in() + (size_t)L * DM * NIN, NIN, NIN, kb * 64, nb * 32, F.winT() + ((size_t)L * NP + nb * 32) * DM, DM, scr, F.lane); continue; } r -= I_IN;
        if (r < I_OUT) { const int kb = r / 32, nb = r % 32; tr_item(F.w_out() + (size_t)L * DM * DM, DM, DM, kb * 64, nb * 32, F.woutT() + ((size_t)L * DM + nb * 32) * DM, DM, scr, F.lane); continue; } r -= I_OUT;
        if (r < I_QB) { const int kb = r / 12, nb = r % 12; tr_item(F.mla_wqb() + (size_t)L * 256 * 384, 384, 384, kb * 64, nb * 32, F.wqbT() + ((size_t)L * 384 + nb * 32) * 256, 256, scr, F.lane, F.mla_gqa() + L * 256); continue; } r -= I_QB;
        { const int kb = r / 16, nb = r % 16; tr_item(F.mla_wkvb() + (size_t)L * 128 * 512, 512, 512, kb * 64, nb * 32, F.wkvbT() + ((size_t)L * 512 + nb * 32) * 128, 128, scr, F.lane, F.mla_gkva() + L * 128); }
    }
}

__device__ __forceinline__ void phase_norm(const Fr& F, int L, bool combine = true) {
    const int nrows = (L == DEPTH) ? NLAT : NROW;
    for (int r = F.gw; r < nrows; r += F.NGW) {
        const bool lat = r < NLAT; const int bb = lat ? (r >> 11) : 8;
        const float* hin = (L == 0) ? (lat ? F.x() + (size_t)r * DM : F.ctx() + (size_t)(r - NLAT) * DM) : (lat ? F.out() + (size_t)r * DM : F.hc() + (size_t)(r - NLAT) * DM);
        float* hout = lat ? F.out() + (size_t)r * DM : F.hc() + (size_t)(r - NLAT) * DM;
        f32x4 v[4];
#pragma unroll
        for (int j = 0; j < 4; ++j) v[j] = *(const f32x4*)(hin + 4 * F.lane + 256 * j);
        if (L > 0 && combine) {
            const float* m5 = F.modv() + ((size_t)(L - 1) * 9 + bb) * 6144 + 5 * 1024;
#pragma unroll
            for (int j = 0; j < 4; ++j) { const int c = 4 * F.lane + 256 * j; const f32x4 g = *(const f32x4*)(m5 + c);
                const u32x2 y0 = *(const u32x2*)(F.yk() + (size_t)(2 * r) * DM + c), y1 = *(const u32x2*)(F.yk() + (size_t)(2 * r + 1) * DM + c);
                f32x4 ys; ys[0] = __uint_as_float(y0.x << 16) + __uint_as_float(y1.x << 16); ys[1] = __uint_as_float(y0.x & 0xffff0000u) + __uint_as_float(y1.x & 0xffff0000u);
                ys[2] = __uint_as_float(y0.y << 16) + __uint_as_float(y1.y << 16); ys[3] = __uint_as_float(y0.y & 0xffff0000u) + __uint_as_float(y1.y & 0xffff0000u);
                v[j] = v[j] + g * ys; *(f32x4*)(hout + c) = v[j]; }
        }
        if (L == DEPTH) continue;
        float ss = 0.f;
#pragma unroll
        for (int j = 0; j < 4; ++j) ss += (v[j][0] * v[j][0] + v[j][1] * v[j][1]) + (v[j][2] * v[j][2] + v[j][3] * v[j][3]);
        const float rstd = rsqrtf(wsum(ss) * (1.f / DM) + EPS);
        const float* md = F.modv() + ((size_t)L * 9 + bb) * 6144;
#pragma unroll
        for (int j = 0; j < 4; ++j) { const int c = 4 * F.lane + 256 * j; const f32x4 g = *(const f32x4*)(F.g_mix() + L * DM + c), sh = *(const f32x4*)(md + c), scl = *(const f32x4*)(md + 1024 + c);
            const f32x4 a = v[j] * rstd * g * (scl + 1.f) + sh; u32x2 o; o.x = pk2(a[0], a[1]); o.y = pk2(a[2], a[3]); *(u32x2*)(F.abuf() + (size_t)r * DM + c) = o; }
    }
}

__device__ __forceinline__ void prep_row(const Fr& F, int L, int r, LAS float* scr) {
    int lane_ = F.lane; asm volatile("" : "+v"(lane_)); const int lane = lane_; int b, s; row2bs(r, b, s); const bool lat = r < NLAT; const int t = s - 256;
    const bf16* p = F.pbuf() + (size_t)r * NP;
#pragma unroll
    for (int h = 0; h < 4; ++h) {
        const float q = bf2f(p[C_NA + h * 64 + lane]), k = bf2f(p[C_NA + 256 + h * 64 + lane]);
        const float rq = rsqrtf(wsum(q * q) * (1.f / 64) + EPS), rk = rsqrtf(wsum(k * k) * (1.f / 64) + EPS);
        const size_t o = ((size_t)(b * 4 + h) * SQ + s) * 64 + lane;
        F.qna()[o] = f2bf(q * rq * F.na_gq()[L * 64 + lane]); F.kna()[o] = f2bf(k * rk * F.na_gk()[L * 64 + lane]);
    }
    {
        const int idx = lane & 31; float cs = 1.f, sn = 0.f;
        if (lat) { cs = F.rcos()[t * 16 + (idx & 15)]; sn = F.rsin()[t * 16 + (idx & 15)]; }
#pragma unroll
        for (int h = 0; h < 4; ++h) {
            float q = bf2f(p[C_DF + h * 64 + lane]), k = bf2f(p[C_DF + 256 + h * 64 + lane]);
            float sq = q * q, sk = k * k;
#pragma unroll
            for (int o = 16; o >= 1; o >>= 1) { sq += __shfl_xor(sq, o); sk += __shfl_xor(sk, o); }
            q *= rsqrtf(sq * (1.f / 32) + EPS) * F.df_gq()[L * 32 + idx]; k *= rsqrtf(sk * (1.f / 32) + EPS) * F.df_gk()[L * 32 + idx];
            const float qp = __shfl_xor(q, 16), kp = __shfl_xor(k, 16);
            if (lat) { q = (idx < 16) ? q * cs - qp * sn : qp * sn + q * cs; k = (idx < 16) ? k * cs - kp * sn : kp * sn + k * cs; }
            const size_t o = ((size_t)(b * 4 + h) * SQ + s) * 64 + lane;
            F.qdf()[o] = f2bf(q); F.kdf()[o] = f2bf(k);
        }
    }
}
__device__ __forceinline__ void prep_tile(const Fr& F, int L, int b, int c) {
    int tid_ = F.tid; asm volatile("" : "+v"(tid_)); const int tid = tid_;
    const int s0 = 64 * c; const size_t r0 = bs2row(b, s0);
    LAS bf16* Lv = (LAS bf16*)F.lds;
#ifndef PT_MASK
#define PT_MASK 7
#endif
    if (PT_MASK & 1)
#pragma unroll 1
    for (int mx = 0; mx < 2; ++mx) {
        const int voff = mx == 0 ? C_NA + 512 : C_DF + 512; bf16* vt = mx == 0 ? F.vna() : F.vdf();
#pragma unroll
        for (int k = 0; k < 4; ++k) { const int idx = tid + 512 * k, tok = idx >> 5, d8 = (idx & 31) * 8;
            const u32x4 v = *(const u32x4*)(F.pbuf() + (r0 + tok) * NP + voff + d8); const int pc = vpos(tok);
#pragma unroll
            for (int e = 0; e < 4; ++e) { Lv[(d8 + 2 * e) * 72 + pc] = (bf16)(v[e] & 0xffffu); Lv[(d8 + 2 * e + 1) * 72 + pc] = (bf16)(v[e] >> 16); } }
        __syncthreads();
#pragma unroll
        for (int k = 0; k < 4; ++k) { const int idx = tid + 512 * k, dv = idx >> 3, pc = idx & 7;
            const u32x4 v = *(const LAS u32x4*)(Lv + dv * 72 + pc * 8);
#ifndef PT_NOSTORE
#define PT_NOSTORE 0
#endif
            if (!PT_NOSTORE || v.x == 0x12345678u) *(u32x4*)(vt + ((size_t)(b * 4 + (dv >> 6)) * 64 + (dv & 63)) * SQ + s0 + pc * 8) = v; }
        __syncthreads();
    }
    const int len = c < 4 ? TCTX : TLAT, t0 = c < 4 ? s0 : s0 - 256;
    LAS bf16* Lc = (LAS bf16*)F.lds;
    if (PT_MASK & 2)
#pragma unroll 1
    for (int gch = 0; gch < 3; ++gch) {
        {   u32x4 v[5];
#pragma unroll
            for (int k = 0; k < 5; ++k) { const int idx = min(tid + 512 * k, 68 * 32 - 1), j = idx >> 5, c8 = (idx & 31) * 8, tj = t0 - 2 + j, jc = min(max(tj, 0), len - 1) - t0;
                v[k] = *(const u32x4*)(F.pbuf() + (size_t)((long)r0 + jc) * NP + C_XBC + gch * 256 + c8);
                const unsigned keep = (tj >= 0 && tj < len) ? 0xffffffffu : 0u; v[k].x &= keep; v[k].y &= keep; v[k].z &= keep; v[k].w &= keep; }
#pragma unroll
            for (int k = 0; k < 5; ++k) { const int idx = tid + 512 * k, j = idx >> 5, c8 = (idx & 31) * 8; if (idx < 68 * 32) *(LAS u32x4*)(Lc + j * 256 + c8) = v[k]; }
        }
        __syncthreads();
        const int ch = tid & 255, tq = tid >> 8, cg = gch * 256 + ch;
        float w[5];
#pragma unroll
        for (int j = 0; j < 5; ++j) w[j] = F.conv_w()[(L * 5 + j) * 768 + cg];
        const float bias = F.conv_b()[L * 768 + cg];
        const LAS bf16* lp = Lc + (32 * tq) * 256 + ch;
        float x0 = bf2f(lp[0]), x1 = bf2f(lp[256]), x2 = bf2f(lp[512]), x3 = bf2f(lp[768]);
        bf16* tm = (gch == 1 ? F.btm() : F.ctm()) + ((size_t)b * SQ + s0 + 32 * tq) * 256 + ch;
        bf16* cm = (gch == 0 ? F.xT() : F.bT()) + ((size_t)b * 256 + ch) * SQ + s0 + 32 * tq;
#pragma unroll
        for (int g8 = 0; g8 < 4; ++g8) { unsigned pk[4];
#pragma unroll
            for (int e = 0; e < 8; ++e) { const int i = 8 * g8 + e; const float x4 = bf2f(lp[(i + 4) * 256]);
                const float acc = bias + w[0] * x0 + w[1] * x1 + w[2] * x2 + w[3] * x3 + w[4] * x4; const unsigned o = f2bf(siluf(acc));
                if (gch >= 1) tm[(size_t)i * 256] = (bf16)o;
                if (e & 1) pk[e >> 1] |= o << 16; else pk[e >> 1] = o;
                x0 = x1; x1 = x2; x2 = x3; x3 = x4; }
            if (gch <= 1) { u32x4 v; v.x = pk[0]; v.y = pk[1]; v.z = pk[2]; v.w = pk[3]; *(u32x4*)(cm + 8 * g8) = v; } }
        __syncthreads();
    }
    if (PT_MASK & 4) { const int tok = tid >> 3, i = tid & 7; const float raw = bf2f(F.pbuf()[(r0 + tok) * NP + C_DT + i]) + F.dt_bias()[L * 8 + i]; const float ex = __expf(raw);
      F.dtv()[((size_t)b * 8 + i) * SQ + s0 + tok] = raw > 20.f ? raw : (ex < 0.03f ? ex * (1.f - ex * (0.5f - ex * (0.33333334f - 0.25f * ex))) : __logf(1.f + ex)); }
}
__device__ __forceinline__ void mla_prep_block(const Fr& F, int L, int b, int j32) {
    int lane_ = F.lane; asm volatile("" : "+v"(lane_));
    const int lane = lane_, wave = F.wave, r = lane & 31, hh = lane >> 5, s = 32 * j32 + r, t = s - 256; const bool lat = s >= 256;
    const size_t row = bs2row(b, s);
    const bf16* p = F.pbuf() + row * NP + C_MLA;
    const int tt = lat ? t : 0; const float latf = lat ? 1.f : 0.f;
    if (wave < 4) {
        const int hq = wave;
        bf16x8 Bq[16]; float ss = 0.f;
#pragma unroll
        for (int kk = 0; kk < 16; ++kk) { Bq[kk] = *(const bf16x8*)(p + 16 * kk + 8 * hh);
#pragma unroll
            for (int j = 0; j < 8; ++j) { const float v = bf2f((bf16)Bq[kk][j]); ss += v * v; } }
        ss += __shfl_xor(ss, 32); const float rq = rsqrtf(ss * (1.f / 256) + EPS);
        f32x16 acc[3]; float hs = 0.f;
#pragma unroll
        for (int j3 = 0; j3 < 3; ++j3) {
#pragma unroll
            for (int i = 0; i < 16; ++i) acc[j3][i] = 0.f;
            const bf16* wp = F.wqbT() + ((size_t)L * 384 + 96 * hq + 32 * j3 + r) * 256 + 8 * hh;
#pragma unroll
            for (int kk = 0; kk < 16; ++kk) acc[j3] = MFMA32(*(const bf16x8*)(wp + 16 * kk), Bq[kk], acc[j3]);
            asm volatile("" ::: "memory");
#pragma unroll
            for (int i = 0; i < 16; ++i) hs += acc[j3][i] * acc[j3][i]; }
        hs = (hs + __shfl_xor(hs, 32)) * rq * rq; const float rs = rsqrtf(hs * (1.f / 96) + EPS) * rq;
        bf16* qo = F.qml() + ((size_t)(b * 4 + hq) * SQ + s) * 96 + 4 * hh;
#pragma unroll
        for (int j3 = 0; j3 < 3; ++j3) {
#pragma unroll
            for (int i = 0; i < 16; ++i) acc[j3][i] *= rs * F.mla_gq()[L * 96 + 32 * j3 + crow16(i, hh)];
            if (j3 == 2) {
#pragma unroll
                for (int i = 0; i < 8; ++i) { const float rc = lat ? F.rcos()[tt * 16 + crow16(i, hh)] : 1.f, rsn = F.rsin()[tt * 16 + crow16(i, hh)] * latf;
                    const float x1 = acc[2][i], x2 = acc[2][i + 8]; acc[2][i] = x1 * rc - x2 * rsn; acc[2][i + 8] = x1 * rsn + x2 * rc; } }
#pragma unroll
            for (int g = 0; g < 4; ++g) { u32x2 w; w.x = pk2(acc[j3][4 * g], acc[j3][4 * g + 1]); w.y = pk2(acc[j3][4 * g + 2], acc[j3][4 * g + 3]); *(u32x2*)(qo + 32 * j3 + 8 * g) = w; } }
    } else {
        const int hk = wave - 4;
        LAS unsigned char* wl = F.lds + wave * 16384;
        bf16x8 Bkv[8]; float ss = 0.f;
#pragma unroll
        for (int kk = 0; kk < 8; ++kk) { Bkv[kk] = *(const bf16x8*)(p + 256 + 16 * kk + 8 * hh);
#pragma unroll
            for (int j = 0; j < 8; ++j) { const float v = bf2f((bf16)Bkv[kk][j]); ss += v * v; } }
        ss += __shfl_xor(ss, 32); const float rk = rsqrtf(ss * (1.f / 128) + EPS);
        float kr[16]; float hs = 0.f;
#pragma unroll
        for (int g = 0; g < 4; ++g) { const u32x2 k4 = *(const u32x2*)(p + 384 + 8 * g + 4 * hh);
            kr[4 * g] = __uint_as_float(k4.x << 16); kr[4 * g + 1] = __uint_as_float(k4.x & 0xffff0000u); kr[4 * g + 2] = __uint_as_float(k4.y << 16); kr[4 * g + 3] = __uint_as_float(k4.y & 0xffff0000u); }
#pragma unroll
        for (int i = 0; i < 16; ++i) hs += kr[i] * kr[i];
        f32x16 acc[4]; float ks = 0.f;
#pragma unroll
        for (int j4 = 0; j4 < 4; ++j4) {
#pragma unroll
            for (int i = 0; i < 16; ++i) acc[j4][i] = 0.f;
            const bf16* wp = F.wkvbT() + ((size_t)L * 512 + 128 * hk + 32 * j4 + r) * 128 + 8 * hh;
#pragma unroll
            for (int kk = 0; kk < 8; ++kk) acc[j4] = MFMA32(*(const bf16x8*)(wp + 16 * kk), Bkv[kk], acc[j4]);
            asm volatile("" ::: "memory");
            if (j4 < 2) {
#pragma unroll
                for (int i = 0; i < 16; ++i) ks += acc[j4][i] * acc[j4][i]; } }
        hs += ks * rk * rk; hs += __shfl_xor(hs, 32); const float rs = rsqrtf(hs * (1.f / 96) + EPS);
        bf16* ko = F.kml() + ((size_t)(b * 4 + hk) * SQ + s) * 96 + 4 * hh;
#pragma unroll
        for (int j2 = 0; j2 < 2; ++j2) {
#pragma unroll
            for (int i = 0; i < 16; ++i) acc[j2][i] *= rs * rk * F.mla_gk()[L * 96 + 32 * j2 + crow16(i, hh)];
#pragma unroll
            for (int g = 0; g < 4; ++g) { u32x2 w; w.x = pk2(acc[j2][4 * g], acc[j2][4 * g + 1]); w.y = pk2(acc[j2][4 * g + 2], acc[j2][4 * g + 3]); *(u32x2*)(ko + 32 * j2 + 8 * g) = w; } }
#pragma unroll
        for (int i = 0; i < 16; ++i) kr[i] *= rs * F.mla_gk()[L * 96 + 64 + crow16(i, hh)];
#pragma unroll
        for (int i = 0; i < 8; ++i) { const float rc = lat ? F.rcos()[tt * 16 + crow16(i, hh)] : 1.f, rsn = F.rsin()[tt * 16 + crow16(i, hh)] * latf;
            const float x1 = kr[i], x2 = kr[i + 8]; kr[i] = x1 * rc - x2 * rsn; kr[i + 8] = x1 * rsn + x2 * rc; }
#pragma unroll
        for (int g = 0; g < 4; ++g) { u32x2 w; w.x = pk2(kr[4 * g], kr[4 * g + 1]); w.y = pk2(kr[4 * g + 2], kr[4 * g + 3]); *(u32x2*)(ko + 64 + 8 * g) = w; }
        { float n2 = 0.f;
#pragma unroll
          for (int i = 0; i < 16; ++i) n2 += acc[0][i] * acc[0][i] + acc[1][i] * acc[1][i] + kr[i] * kr[i];
          n2 += __shfl_xor(n2, 32); n2 = wmaxf(n2);
          if (lane == 0) atomicMax(F.ctl() + CW_KMAX + ((L * 3 + 1) * 8 + b) * 8 + hk * 2, __float_as_uint(n2 * 1.02f)); }
        LAS bf16* vl = (LAS bf16*)wl;
#pragma unroll
        for (int mt = 0; mt < 2; ++mt)
#pragma unroll
            for (int i = 0; i < 16; ++i) vl[(32 * mt + crow16(i, hh)) * 40 + vpos(r)] = f2bf(acc[2 + mt][i] * rk);
        LDS_WAIT();
        { const LAS u32x4* src4 = (const LAS u32x4*)(wl + lane * 80); u32x4* dst = (u32x4*)(F.vml() + ((size_t)(b * 4 + hk) * 64 + lane) * SQ + 32 * j32);
#pragma unroll
          for (int q = 0; q < 4; ++q) dst[q] = src4[q]; }
        LDS_WAIT();
    }
}
__device__ __forceinline__ int grab_unit(const Fr& F, unsigned* ctr) {
    volatile LAS int* slot = (volatile LAS int*)(F.lds + LDSCTL_OFF + 256);
    __syncthreads();
    if (F.tid == 0) *slot = (int)__hip_atomic_fetch_add(ctr, 1u, __ATOMIC_RELAXED, __HIP_MEMORY_SCOPE_AGENT);
    __syncthreads();
    return __builtin_amdgcn_readfirstlane(*slot);
}
__device__ __forceinline__ void prep_qk(const Fr& F, int L, int b, int j32) {
    int lane_ = F.lane; asm volatile("" : "+v"(lane_)); const int l = lane_, h = l >> 4;
    u32x2 raw[4][4];
#pragma unroll
    for (int i = 0; i < 4; ++i) { const int s = 32 * j32 + 4 * F.wave + i; const bf16* p = F.pbuf() + (size_t)bs2row(b, s) * NP + 4 * l;
        raw[i][0] = *(const u32x2*)(p + C_NA); raw[i][1] = *(const u32x2*)(p + C_NA + 256); raw[i][2] = *(const u32x2*)(p + C_DF); raw[i][3] = *(const u32x2*)(p + C_DF + 256); }
    const f32x4 gnq = *(const f32x4*)(F.na_gq() + L * 64 + 4 * (l & 15)), gnk = *(const f32x4*)(F.na_gk() + L * 64 + 4 * (l & 15));
    const f32x4 gdq = *(const f32x4*)(F.df_gq() + L * 32 + 4 * (l & 7)), gdk = *(const f32x4*)(F.df_gk() + L * 32 + 4 * (l & 7));
    float kmx_na = 0.f, kmx_df = 0.f;
#pragma unroll
    for (int i = 0; i < 4; ++i) { const int s = 32 * j32 + 4 * F.wave + i, t = s - 256; const bool lat = s >= 256;
#pragma unroll
        for (int w = 0; w < 4; ++w) {
            f32x4 x; x[0] = __uint_as_float(raw[i][w].x << 16); x[1] = __uint_as_float(raw[i][w].x & 0xffff0000u); x[2] = __uint_as_float(raw[i][w].y << 16); x[3] = __uint_as_float(raw[i][w].y & 0xffff0000u);
            float ss = (x[0] * x[0] + x[1] * x[1]) + (x[2] * x[2] + x[3] * x[3]);
            ss += dppf<0xB1>(ss); ss += dppf<0x4E>(ss); ss += dppf<0x141>(ss);
            if (w < 2) { ss += dppf<0x140>(ss);
                const float rs = rsqrtf(ss * (1.f / 64) + EPS); const f32x4 g = w == 0 ? gnq : gnk; x = x * rs * g;
                u32x2 o; o.x = pk2(x[0], x[1]); o.y = pk2(x[2], x[3]);
                if (w == 1) { float n2 = (x[0] * x[0] + x[1] * x[1]) + (x[2] * x[2] + x[3] * x[3]); n2 += dppf<0xB1>(n2); n2 += dppf<0x4E>(n2); n2 += dppf<0x141>(n2); n2 += dppf<0x140>(n2); kmx_na = fmaxf(kmx_na, n2); }
                *(u32x2*)((w == 0 ? F.qna() : F.kna()) + ((size_t)(b * 4 + h) * SQ + s) * 64 + 4 * (l & 15)) = o;
            } else {
                const float rs = rsqrtf(ss * (1.f / 32) + EPS); const f32x4 g = w == 2 ? gdq : gdk; x = x * rs * g;
                f32x4 xp; xp[0] = __shfl_xor(x[0], 4); xp[1] = __shfl_xor(x[1], 4); xp[2] = __shfl_xor(x[2], 4); xp[3] = __shfl_xor(x[3], 4);
                if (lat) { const f32x4 cs = *(const f32x4*)(F.rcos() + t * 16 + 4 * (l & 3)), sn = *(const f32x4*)(F.rsin() + t * 16 + 4 * (l & 3));
                    x = (l & 4) ? xp * sn + x * cs : x * cs - xp * sn; }
                u32x2 o; o.x = pk2(x[0], x[1]); o.y = pk2(x[2], x[3]);
                if (w == 3) { float n2 = (x[0] * x[0] + x[1] * x[1]) + (x[2] * x[2] + x[3] * x[3]); n2 += dppf<0xB1>(n2); n2 += dppf<0x4E>(n2); n2 += dppf<0x141>(n2); kmx_df = fmaxf(kmx_df, n2); }
                *(u32x2*)((w == 2 ? F.qdf() : F.kdf()) + ((size_t)(b * 4 + h) * SQ + s) * 64 + 4 * (l & 15)) = o;
            } } }
    if ((l & 15) == 0) atomicMax(F.ctl() + CW_KMAX + ((L * 3 + 0) * 8 + b) * 8 + h * 2, __float_as_uint(kmx_na * 1.02f));
    if ((l & 7) == 0) atomicMax(F.ctl() + CW_KMAX + ((L * 3 + 2) * 8 + b) * 8 + h * 2 + ((l >> 3) & 1), __float_as_uint(kmx_df * 1.02f));
}
__device__ __forceinline__ void prep_vconv(const Fr& F, int L, int b, int j32) {
    int tid_ = F.tid; asm volatile("; VCONV_BEGIN" : "+v"(tid_)); const int tid = tid_;
    const int s0 = 32 * j32; const size_t r0 = bs2row(b, s0);
    LAS bf16* Lv = (LAS bf16*)F.lds;
#ifndef VC_MASK
#define VC_MASK 7
#endif
    if (VC_MASK & 1) {   u32x4 v[4];
#pragma unroll
        for (int k = 0; k < 4; ++k) { const int idx = tid + 512 * k, mx = idx >> 10, tok = (idx >> 5) & 31, d8 = (idx & 31) * 8;
            v[k] = *(const u32x4*)(F.pbuf() + (r0 + tok) * NP + (mx ? C_DF + 512 : C_NA + 512) + d8); }
#pragma unroll
        for (int k = 0; k < 4; ++k) { const int idx = tid + 512 * k, mx = idx >> 10, tok = (idx >> 5) & 31, d8 = (idx & 31) * 8, pc = vpos(tok);
#pragma unroll
            for (int e = 0; e < 4; ++e) { Lv[(mx * 256 + d8 + 2 * e) * 40 + pc] = (bf16)(v[k][e] & 0xffffu); Lv[(mx * 256 + d8 + 2 * e + 1) * 40 + pc] = (bf16)(v[k][e] >> 16); } }
        __syncthreads();
#pragma unroll
        for (int k = 0; k < 4; ++k) { const int idx = tid + 512 * k, mx = idx >> 10, dv = (idx >> 2) & 255, pc = idx & 3;
            const u32x4 w = *(const LAS u32x4*)(Lv + (mx * 256 + dv) * 40 + pc * 8);
            *(u32x4*)((mx ? F.vdf() : F.vna()) + ((size_t)(b * 4 + (dv >> 6)) * 64 + (dv & 63)) * SQ + s0 + pc * 8) = w; }
        __syncthreads();
    }
    const bool isctx = s0 < 256; const int len = isctx ? TCTX : TLAT, t0 = isctx ? s0 : s0 - 256;
    LAS bf16* Lc = (LAS bf16*)F.lds;
    if (VC_MASK & 2) {   u32x4 v[7];
#pragma unroll
        for (int k = 0; k < 7; ++k) { const int idx = tid + 512 * k, j = idx / 96, c8 = (idx - 96 * j) * 8, tj = t0 - 2 + j; const int jc = min(max(tj, 0), len - 1) - t0;
            v[k] = (u32x4){0u, 0u, 0u, 0u};
            if (idx < 36 * 96) { v[k] = *(const u32x4*)(F.pbuf() + (size_t)((long)r0 + jc) * NP + C_XBC + c8); if (tj < 0 || tj >= len) v[k] = (u32x4){0u, 0u, 0u, 0u}; } }
#pragma unroll
        for (int k = 0; k < 7; ++k) { const int idx = tid + 512 * k, j = idx / 96, c8 = (idx - 96 * j) * 8; if (idx < 36 * 96) *(LAS u32x4*)(Lc + j * 768 + c8) = v[k]; }
    }
    __syncthreads();
    if (VC_MASK & 2)
#pragma unroll 1
    for (int pass = 0; pass < 2; ++pass) {
        const int cg = pass == 0 ? tid : 512 + tid;
        if (cg < 768) {
            float w[5];
#pragma unroll
            for (int j = 0; j < 5; ++j) w[j] = F.conv_w()[(L * 5 + j) * 768 + cg];
            const float bias = F.conv_b()[L * 768 + cg];
            const LAS bf16* lp = Lc + cg;
            float x0 = bf2f(lp[0]), x1 = bf2f(lp[768]), x2 = bf2f(lp[2 * 768]), x3 = bf2f(lp[3 * 768]);
            const int gch = cg >> 8, ch = cg & 255;
            bf16* tm = (gch == 1 ? F.btm() : F.ctm()) + ((size_t)b * SQ + s0) * 256 + ch;
            bf16* cm = (gch == 0 ? F.xT() : F.bT()) + ((size_t)b * 256 + ch) * SQ + s0;
#pragma unroll
            for (int g8 = 0; g8 < 4; ++g8) { unsigned pk[4];
#pragma unroll
                for (int e = 0; e < 8; ++e) { const int i = 8 * g8 + e; const float x4 = bf2f(lp[(i + 4) * 768]);
                    const float acc = bias + w[0] * x0 + w[1] * x1 + w[2] * x2 + w[3] * x3 + w[4] * x4; const unsigned o = f2bf(siluf(acc));
                    if (gch >= 1) tm[(size_t)i * 256] = (bf16)o;
                    if (e & 1) pk[e >> 1] |= o << 16; else pk[e >> 1] = o;
                    x0 = x1; x1 = x2; x2 = x3; x3 = x4; }
                if (gch <= 1) { u32x4 v; v.x = pk[0]; v.y = pk[1]; v.z = pk[2]; v.w = pk[3]; *(u32x4*)(cm + 8 * g8) = v; } }
        }
    }
    if ((VC_MASK & 4) && tid < 256) { const int tok = tid >> 3, i = tid & 7; const float raw = bf2f(F.pbuf()[(r0 + tok) * NP + C_DT + i]) + F.dt_bias()[L * 8 + i]; const float ex = __expf(raw);
      F.dtv()[((size_t)b * 8 + i) * SQ + s0 + tok] = raw > 20.f ? raw : (ex < 0.03f ? ex * (1.f - ex * (0.5f - ex * (0.33333334f - 0.25f * ex))) : __logf(1.f + ex)); }
    __syncthreads();
    asm volatile("; VCONV_END" ::: "memory");
}
__device__ __forceinline__ void phase_prep(const Fr& F0_, int L) {
    unsigned* ctr = F0_.ctl() + CW_QUEUE + (L * 16 + 0) * 64;
    for (;;) {
        const int u = grab_unit(F0_, ctr); if (u >= NB * 72) break;
        const int b = u / 72, j32 = u - 72 * b;
        { const Fr F = refresh(F0_); prep_qk(F, L, b, j32); }
        { const Fr F = refresh(F0_); mla_prep_block(F, L, b, j32); }
        __syncthreads();
    }
    { unsigned* ctr2 = F0_.ctl() + CW_QUEUE + (L * 16 + 2) * 64;
      for (;;) { const int u = grab_unit(F0_, ctr2); if (u >= NB * 36) break; const Fr F3 = refresh(F0_); prep_tile(F3, L, u / 36, u % 36); } }
}

__device__ __forceinline__ void phase_ssd_naive(const Fr& F, int L) {
    if (F.wave != 0 || blockIdx.x >= 64) return;
    const int w = blockIdx.x, b = w >> 3, d = (w >> 2) & 1, h = w & 3, g = h >> 1, p = F.lane;
    const float a = -expf(F.a_log()[L * 8 + d * 4 + h]);
    float hs[128];
#pragma unroll
    for (int n = 0; n < 128; ++n) hs[n] = 0.f;
    const float* dtp = F.dtv() + ((size_t)b * 8 + d * 4 + h) * SQ;
    const bf16* xp = F.xT() + ((size_t)b * 256 + h * 64 + p) * SQ;
    for (int step = 0; step < SQ; ++step) {
        const int s = d == 0 ? step : (step < 256 ? 255 - step : SQ - 1 - (step - 256));
        const float dtv = dtp[s], dA = __expf(dtv * a), xv = bf2f(xp[s]) * dtv;
        const u32x4* Bp = (const u32x4*)(F.btm() + ((size_t)b * SQ + s) * 256 + g * 128);
        const u32x4* Cp = (const u32x4*)(F.ctm() + ((size_t)b * SQ + s) * 256 + g * 128);
        float y = 0.f;
#pragma unroll
        for (int n8 = 0; n8 < 16; ++n8) { const u32x4 bv = Bp[n8], cv = Cp[n8];
#pragma unroll
            for (int j = 0; j < 4; ++j) { const int n = n8 * 8 + 2 * j;
                hs[n] = hs[n] * dA + xv * __uint_as_float(bv[j] << 16); hs[n + 1] = hs[n + 1] * dA + xv * __uint_as_float(bv[j] & 0xffff0000u);
                y += __uint_as_float(cv[j] << 16) * hs[n] + __uint_as_float(cv[j] & 0xffff0000u) * hs[n + 1]; } }
        F.ydir()[((size_t)d * NROW + bs2row(b, s)) * 256 + h * 64 + p] = y;
    }
}

template <int KIND>
__device__ __forceinline__ void naive_attn_job(const Fr& F, int L, int r, int h, LAS float* scr) {
    constexpr int DQ = KIND == 1 ? 96 : (KIND == 0 ? 64 : 32), QS = KIND == 1 ? 96 : 64;
    const int lane = F.lane; int b, s; row2bs(r, b, s); const bool lat = r < NLAT; const int t = s - 256;
    const bf16* Qb = (KIND == 0 ? F.qna() : KIND == 1 ? F.qml() : F.qdf()) + ((size_t)(b * 4 + h) * SQ + s) * QS;
    const bf16* Kb = (KIND == 0 ? F.kna() : KIND == 1 ? F.kml() : F.kdf()) + (size_t)(b * 4 + h) * SQ * QS;
    const bf16* Vt = (KIND == 0 ? F.vna() : KIND == 1 ? F.vml() : F.vdf()) + ((size_t)(b * 4 + h) * 64 + lane) * SQ;
    const float scale = KIND == 1 ? 0.10206207261596577f : (KIND == 0 ? 0.125f : 0.17677669529663687f);
    const int qr = t >> 6, qc = t & 63, row_lo = min(max(qr - 4, 0), 24), col_lo = min(max(qc - 8, 0), 48);
    const bool nb = (KIND == 0) && lat;
    const int nk = lat ? (KIND == 0 ? 768 : SQ) : 256;
    const int koff = nb ? row_lo * 64 : 0;
    float oc[2] = {0.f, 0.f};
#pragma unroll
    for (int comp = 0; comp < (KIND == 2 ? 2 : 1); ++comp) {
        for (int i = lane; i < DQ; i += 64) scr[i] = bf2f(Qb[comp * 32 + i]);
        LDS_WAIT();
        float m = -INFINITY;
        for (int kk = lane; kk < nk; kk += 64) {
            const int sk = kk < 256 ? kk : kk + koff; float bias = 0.f; bool valid = true;
            if (nb && kk >= 256) { const int w = kk - 256, kr = w >> 6, kc = w & 63; valid = kc >= col_lo && kc < col_lo + 16;
                const int ro = row_lo + kr - qr + 7, co = min(max(kc - qc, -15), 15) + 15; bias = F.na_rb()[((L * 4 + h) * 15 + ro) * 31 + co]; }
            const u32x4* kp = (const u32x4*)(Kb + (size_t)sk * QS + (KIND == 2 ? comp * 32 : 0));
            float dot = 0.f;
#pragma unroll
            for (int i8 = 0; i8 < DQ / 8; ++i8) { const u32x4 kv = kp[i8];
#pragma unroll
                for (int j = 0; j < 4; ++j) dot += scr[i8 * 8 + 2 * j] * __uint_as_float(kv[j] << 16) + scr[i8 * 8 + 2 * j + 1] * __uint_as_float(kv[j] & 0xffff0000u); }
            const float sc = valid ? dot * scale + bias : -INFINITY;
            scr[128 + kk] = sc; m = fmaxf(m, sc);
        }
        m = wmaxf(m);
        float sum = 0.f;
        for (int kk = lane; kk < nk; kk += 64) { const float pv = __expf(scr[128 + kk] - m); scr[128 + kk] = pv; sum += pv; }
        sum = wsum(sum);
        LDS_WAIT();
        float o = 0.f;
        for (int kb = 0; kb < nk; kb += 8) {
            const int sb = kb < 256 ? kb : kb + koff;
            const u32x4 vv = *(const u32x4*)(Vt + sb);
#pragma unroll
            for (int j = 0; j < 8; ++j) { const int kk = (kb & ~15) + vpos((kb & 15) + j); const unsigned wv = vv[j >> 1];
                o += scr[128 + kk] * ((j & 1) ? __uint_as_float(wv & 0xffff0000u) : __uint_as_float(wv << 16)); }
        }
        oc[comp] = o / sum;
        LDS_WAIT();
    }
    bf16* mo = F.mix() + (size_t)r * DM + (KIND == 0 ? 0 : KIND == 1 ? 256 : 512) + h * 64 + lane;
    if (KIND == 2) {
        const float* lv = F.df_lam() + L * 128; const float li = 0.8f - 0.6f * expf(-0.3f * (float)L);
        float d1 = 0.f, d2 = 0.f;
#pragma unroll
        for (int i = 0; i < 32; ++i) { d1 += lv[i] * lv[32 + i]; d2 += lv[64 + i] * lv[96 + i]; }
        const float lam = expf(d1) - expf(d2) + li;
        const float o = oc[0] - lam * oc[1];
        const float rs = rsqrtf(wsum(o * o) * (1.f / 64) + EPS);
        *mo = f2bf(o * rs * F.df_gsub()[L * 64 + lane] * (1.f - li));
    } else *mo = f2bf(oc[0]);
}
__device__ __forceinline__ void phase_mix_naive(const Fr& F, int L) {
    LAS float* scr = (LAS float*)(F.lds + F.wave * 16384);
    const int nrows = (L == DEPTH - 1) ? NLAT : NROW;
    for (int j = F.gw; j < nrows * 4; j += F.NGW) naive_attn_job<2>(F, L, j >> 2, j & 3, scr);
    for (int j = F.gw; j < nrows * 4; j += F.NGW) naive_attn_job<1>(F, L, j >> 2, j & 3, scr);
    for (int j = F.gw; j < nrows * 4; j += F.NGW) naive_attn_job<0>(F, L, j >> 2, j & 3, scr);
    for (int r = F.gw; r < nrows; r += F.NGW) {
        int b, s; row2bs(r, b, s); const int h = F.lane >> 4; const float dsk = F.ssd_d()[L * 8 + h] + F.ssd_d()[L * 8 + 4 + h];
        float y[4]; float ss = 0.f;
#pragma unroll
        for (int j = 0; j < 4; ++j) { const int ch = F.lane * 4 + j; const float xv = bf2f(F.xT()[((size_t)b * 256 + ch) * SQ + s]);
            const float z = bf2f(F.pbuf()[(size_t)r * NP + C_Z + ch]);
            y[j] = (F.ydir()[(size_t)r * 256 + ch] + F.ydir()[((size_t)NROW + r) * 256 + ch] + dsk * xv) * siluf(z); ss += y[j] * y[j]; }
        const float rs = rsqrtf(wsum(ss) * (1.f / 256) + EPS);
#pragma unroll
        for (int j = 0; j < 4; ++j) { const int ch = F.lane * 4 + j; F.mix()[(size_t)r * DM + 768 + ch] = f2bf(y[j] * rs * F.ssd_gn()[L * 256 + ch]); }
    }
}

template <int S8> __device__ __forceinline__ bf16x8 pack_step(const f32x16& x) {
    u32x4 p;
    asm volatile("v_cvt_pk_bf16_f32 %0, %4, %5\n\tv_cvt_pk_bf16_f32 %1, %6, %7\n\tv_cvt_pk_bf16_f32 %2, %8, %9\n\tv_cvt_pk_bf16_f32 %3, %10, %11\n\ts_nop 1"
                 : "=&v"(p[0]), "=&v"(p[1]), "=&v"(p[2]), "=&v"(p[3])
                 : "v"(x[S8]), "v"(x[S8 + 1]), "v"(x[S8 + 2]), "v"(x[S8 + 3]), "v"(x[S8 + 4]), "v"(x[S8 + 5]), "v"(x[S8 + 6]), "v"(x[S8 + 7]));
    return __builtin_bit_cast(bf16x8, p);
}
constexpr float LOG2E = 1.4426950408889634f;
template <int KIND>
__device__ __forceinline__ void attn_unit(const Fr& F, int L, int b, int h, int qb) {
    constexpr int QS = KIND == 1 ? 96 : 64, NKS = KIND == 1 ? 6 : (KIND == 0 ? 4 : 2);
    constexpr int PK = QS * 2 + 16, PV = 272, KBYTES = 128 * PK, VBYTES = 64 * PV, NKP = QS == 96 ? 3 : 2, PPR = QS / 8;
    LAS unsigned char* const Kl = F.lds; LAS unsigned char* const Vl = F.lds + 2 * KBYTES;
    LAS float* const biasl = (LAS float*)(F.lds + 2 * KBYTES + 2 * VBYTES);
    const int lane = F.lane, wave = F.wave, tid = F.tid, r = lane & 31, hh = lane >> 5;
    const bool isctx = qb < 0;
    const int comp = KIND == 2 ? (wave & 1) : 0, qg = KIND == 2 ? (wave >> 1) : wave;
    const bf16* Qg = (KIND == 0 ? F.qna() : KIND == 1 ? F.qml() : F.qdf()) + (size_t)(b * 4 + h) * SQ * QS;
    const bf16* Kg = (KIND == 0 ? F.kna() : KIND == 1 ? F.kml() : F.kdf()) + (size_t)(b * 4 + h) * SQ * QS;
    const bf16* Vg = (KIND == 0 ? F.vna() : KIND == 1 ? F.vml() : F.vdf()) + (size_t)(b * 4 + h) * 64 * SQ;
    const float cs = (KIND == 1 ? 0.10206207261596577f : (KIND == 0 ? 0.125f : 0.17677669529663687f)) * LOG2E;
    int sq, qrow = 0, qcol = 0;
    if (KIND == 2) sq = (isctx ? 128 * (-qb - 1) : 256 + 128 * qb) + 32 * qg + r;
    else if (isctx) sq = 32 * wave + r; else if (KIND == 0) { qrow = 4 * qb + (wave >> 1); qcol = 32 * (wave & 1) + r; sq = 256 + 64 * qrow + qcol; } else sq = 256 + 256 * qb + 32 * wave + r;
    int nt = 36, lo_u = 0;
    if (isctx) nt = 4; else if (KIND == 0) { lo_u = min(max(4 * qb - 4, 0), 24); nt = 4 + min(max(4 * qb - 1, 0), 24) + 8 - lo_u; }
    const int np = (nt + 1) >> 1;
    const int my_lo = min(max(qrow - 4, 0), 24), col_lo = min(max(qcol - 8, 0), 48);
    if (KIND == 0 && !isctx) for (int i = tid; i < 465; i += 512) biasl[i] = F.na_rb()[(L * 4 + h) * 465 + i] * LOG2E;
    bf16x8 Q[NKS];
    { const bf16* qp = Qg + (size_t)sq * QS + comp * 32 + 8 * hh;
#pragma unroll
      for (int kk = 0; kk < NKS; ++kk) Q[kk] = *(const bf16x8*)(qp + 16 * kk); }
    f32x16 O[2]; float l = 0.f;
#pragma unroll
    for (int mt = 0; mt < 2; ++mt)
#pragma unroll
        for (int i = 0; i < 16; ++i) O[mt][i] = 0.f;
    float m;
    {   float q2 = 0.f;
#pragma unroll
        for (int kk = 0; kk < NKS; ++kk)
#pragma unroll
            for (int j = 0; j < 8; ++j) { const float v = bf2f((bf16)Q[kk][j]); q2 += v * v; }
        q2 += __shfl_xor(q2, 32);
        const float k2 = __uint_as_float(__hip_atomic_load(F.ctl() + CW_KMAX + ((L * 3 + KIND) * 8 + b) * 8 + h * 2 + comp, __ATOMIC_RELAXED, __HIP_MEMORY_SCOPE_AGENT));
        m = sqrtf(q2 * k2) * cs;
        if (KIND == 0 && !isctx) m += (F.rcos() + 2 * TLAT * 16)[L * 4 + h];
    }
    u32x4 rk_0[NKP], rv_0[2];
#define AT_SK0(t) ((isctx || KIND != 0) ? 64 * (t) : ((t) < 4 ? 64 * (t) : 256 + 64 * (lo_u + (t) - 4)))
#define AT_LOAD(p, S_) do { const int sk0_ = AT_SK0(2 * (p)); const char* kg_ = (const char*)(Kg + (size_t)sk0_ * QS); \
        _Pragma("unroll") for (int i_ = 0; i_ < NKP; ++i_) rk_##S_[i_] = *(const u32x4*)(kg_ + (tid + 512 * i_) * 16); \
        _Pragma("unroll") for (int i_ = 0; i_ < 2; ++i_) { const int pi_ = tid + 512 * i_; rv_##S_[i_] = *(const u32x4*)(Vg + (size_t)(pi_ >> 4) * SQ + sk0_ + (pi_ & 15) * 8); } } while (0)
#define AT_STORE(buf, S_) do { \
        _Pragma("unroll") for (int i_ = 0; i_ < NKP; ++i_) { const int pi_ = tid + 512 * i_; *(LAS u32x4*)(Kl + (buf) * KBYTES + (pi_ / PPR) * PK + (pi_ % PPR) * 16) = rk_##S_[i_]; } \
        _Pragma("unroll") for (int i_ = 0; i_ < 2; ++i_) { const int pi_ = tid + 512 * i_; *(LAS u32x4*)(Vl + (buf) * VBYTES + (pi_ >> 4) * PV + (pi_ & 15) * 16) = rv_##S_[i_]; } } while (0)
#define AT_QK(SA, SB, kb_) do { \
        _Pragma("unroll") for (int i = 0; i < 16; ++i) { SA[i] = 0.f; SB[i] = 0.f; } \
        _Pragma("unroll") for (int kk = 0; kk < NKS; ++kk) { const bf16x8 a0 = *(const LAS bf16x8*)((kb_) + 32 * kk), a1 = *(const LAS bf16x8*)((kb_) + 32 * PK + 32 * kk); \
            SA = MFMA32(a0, Q[kk], SA); SB = MFMA32(a1, Q[kk], SB); } } while (0)
#define AT_SMPV(S0, S1, t_, vb_) do { \
        const int krow = lo_u + (t_) - 4; const bool nbt = (KIND == 0) && !isctx && (t_) >= 4; \
        float ps = 0.f; \
        if (nbt) { const int drow = (krow - qrow + 7) * 31 - qcol + 15; const float nm = -m; \
            _Pragma("unroll") for (int i = 0; i < 16; ++i) { const int kc = (i & 3) + 8 * (i >> 2) + 4 * hh; \
                { const bool v = (unsigned)(kc - col_lo) < 16u; const float bb = biasl[v ? drow + kc : 0]; S0[i] = v ? __builtin_amdgcn_exp2f(__builtin_fmaf(S0[i], cs, bb + nm)) : 0.f; } \
                { const bool v = (unsigned)(kc + 32 - col_lo) < 16u; const float bb = biasl[v ? drow + kc + 32 : 0]; S1[i] = v ? __builtin_amdgcn_exp2f(__builtin_fmaf(S1[i], cs, bb + nm)) : 0.f; } \
                ps += S0[i] + S1[i]; } \
        } else { const float nm = -m; \
            _Pragma("unroll") for (int i = 0; i < 16; ++i) { S0[i] = __builtin_amdgcn_exp2f(__builtin_fmaf(S0[i], cs, nm)); S1[i] = __builtin_amdgcn_exp2f(__builtin_fmaf(S1[i], cs, nm)); ps += S0[i] + S1[i]; } } \
        l += ps; \
        const bf16x8 p00 = pack_step<0>(S0), p01 = pack_step<8>(S0), p10 = pack_step<0>(S1), p11 = pack_step<8>(S1); \
        _Pragma("unroll") for (int mt = 0; mt < 2; ++mt) { \
            const LAS unsigned char* vb = (vb_) + mt * 32 * PV; \
            O[mt] = MFMA32(*(const LAS bf16x8*)(vb + 0), p00, O[mt]); O[mt] = MFMA32(*(const LAS bf16x8*)(vb + 32), p01, O[mt]); \
            O[mt] = MFMA32(*(const LAS bf16x8*)(vb + 64), p10, O[mt]); O[mt] = MFMA32(*(const LAS bf16x8*)(vb + 96), p11, O[mt]); } } while (0)
#define AT_COMPUTE(p_, buf_) do { \
        const int t0_ = 2 * (p_), t1_ = t0_ + 1; \
        const bool g0_ = (KIND != 0) || isctx || t0_ < 4 || (lo_u + t0_ - 4 >= my_lo && lo_u + t0_ - 4 < my_lo + 8); \
        const bool g1_ = (t1_ < nt) && ((KIND != 0) || isctx || t1_ < 4 || (lo_u + t1_ - 4 >= my_lo && lo_u + t1_ - 4 < my_lo + 8)); \
        const LAS unsigned char* Kb = Kl + (buf_) * KBYTES + r * PK + (comp * 32 + 8 * hh) * 2; const LAS unsigned char* Vb = Vl + (buf_) * VBYTES + r * PV + 16 * hh; \
        if (KIND == 0) { f32x16 S00, S01; \
            if (g0_) { AT_QK(S00, S01, Kb); AT_SMPV(S00, S01, t0_, Vb); } \
            if (g1_) { AT_QK(S00, S01, Kb + 64 * PK); AT_SMPV(S00, S01, t1_, Vb + 128); } \
        } else { f32x16 S00, S01, S10, S11; \
            AT_QK(S00, S01, Kb); \
            AT_QK(S10, S11, Kb + 64 * PK); \
            AT_SMPV(S00, S01, t0_, Vb); \
            AT_SMPV(S10, S11, t1_, Vb + 128); } } while (0)
    AT_LOAD(0, 0);
    AT_STORE(0, 0);
    __syncthreads();
    for (int p = 0; p < np; ++p) {
        const int buf = p & 1;
        if (p + 1 < np) AT_LOAD(p + 1, 0);
        AT_COMPUTE(p, buf);
        if (p + 1 < np) AT_STORE(buf ^ 1, 0);
        __syncthreads();
    }
#undef AT_COMPUTE
#undef AT_SMPV
#undef AT_QK
#undef AT_SK0
#undef AT_LOAD
#undef AT_STORE
    const float inv = 1.f / (l + __shfl_xor(l, 32));
    bf16* mo = F.mix() + (size_t)bs2row(b, sq) * DM + (KIND == 0 ? 0 : KIND == 1 ? 256 : 512) + h * 64 + 4 * hh;
    if (KIND == 2) {
        LAS float* xo = (LAS float*)F.lds + qg * 2048;
        if (comp == 1) {
#pragma unroll
            for (int mt = 0; mt < 2; ++mt)
#pragma unroll
                for (int i = 0; i < 16; ++i) xo[(mt * 16 + i) * 64 + lane] = O[mt][i] * inv; }
        __syncthreads();
        if (comp == 0) {
            const float* lv = F.df_lam() + L * 128; const float li = 0.8f - 0.6f * expf(-0.3f * (float)L);
            float d1 = 0.f, d2 = 0.f;
#pragma unroll
            for (int i = 0; i < 32; ++i) { d1 += lv[i] * lv[32 + i]; d2 += lv[64 + i] * lv[96 + i]; }
            const float lam = expf(d1) - expf(d2) + li;
            float ss = 0.f;
#pragma unroll
            for (int mt = 0; mt < 2; ++mt)
#pragma unroll
                for (int i = 0; i < 16; ++i) { const float o = O[mt][i] * inv - lam * xo[(mt * 16 + i) * 64 + lane]; O[mt][i] = o; ss += o * o; }
            ss += __shfl_xor(ss, 32);
            const float rs = rsqrtf(ss * (1.f / 64) + EPS) * (1.f - li);
#pragma unroll
            for (int mt = 0; mt < 2; ++mt)
#pragma unroll
                for (int g = 0; g < 4; ++g) { const f32x4 gs = *(const f32x4*)(F.df_gsub() + L * 64 + 32 * mt + 8 * g + 4 * hh);
                    u32x2 w; w.x = pk2(O[mt][4 * g] * rs * gs[0], O[mt][4 * g + 1] * rs * gs[1]); w.y = pk2(O[mt][4 * g + 2] * rs * gs[2], O[mt][4 * g + 3] * rs * gs[3]);
                    *(u32x2*)(mo + 32 * mt + 8 * g) = w; }
        }
        __syncthreads();
    } else {
#pragma unroll
        for (int mt = 0; mt < 2; ++mt)
#pragma unroll
            for (int g = 0; g < 4; ++g) { u32x2 w; w.x = pk2(O[mt][4 * g] * inv, O[mt][4 * g + 1] * inv); w.y = pk2(O[mt][4 * g + 2] * inv, O[mt][4 * g + 3] * inv);
                *(u32x2*)(mo + 32 * mt + 8 * g) = w; }
    }
}
__device__ __forceinline__ float ssd_cum(const Fr& F, int L, int b, int h, int d, int s0, float& dt, float& cum) {
    const int lane = F.lane;
    dt = F.dtv()[((size_t)b * 8 + d * 4 + h) * SQ + s0 + lane];
    const float la = dt * -__expf(F.a_log()[L * 8 + d * 4 + h]);
    float v = la;
#pragma unroll
    for (int o = 1; o < 64; o <<= 1) { const float t = __shfl_up(v, o); if (lane >= o) v += t; }
    const float total = __shfl(v, 63);
    cum = d == 0 ? v : total - v + la;
    return total;
}
__device__ __forceinline__ void ssd_s1_job(const Fr& F, int L, int b, int c, int h, LAS float* scr) {
    const int lane = F.lane, r = lane & 31, hh = lane >> 5, s0 = 64 * c, g = h >> 1;
#pragma unroll
    for (int d = 0; d < 2; ++d) { float dt, cum; const float tot = ssd_cum(F, L, b, h, d, s0, dt, cum); scr[d * 64 + lane] = dt * __expf(tot - cum);
        if (lane == 0) F.cdec()[((b * 2 + d) * 4 + h) * 36 + c] = __expf(tot); }
    LDS_WAIT();
    bf16x8 A[2][2][4];
#pragma unroll
    for (int mt = 0; mt < 2; ++mt)
#pragma unroll
        for (int kk = 0; kk < 4; ++kk) { const bf16x8 raw = *(const bf16x8*)(F.xT() + ((size_t)b * 256 + h * 64 + 32 * mt + r) * SQ + s0 + 16 * kk + 8 * hh);
#pragma unroll
            for (int d = 0; d < 2; ++d) { u32x4 o;
#pragma unroll
                for (int j = 0; j < 4; ++j) { const float w0 = scr[d * 64 + 16 * kk + 8 * hh + 2 * j], w1 = scr[d * 64 + 16 * kk + 8 * hh + 2 * j + 1];
                    o[j] = pk2(bf2f((bf16)raw[2 * j]) * w0, bf2f((bf16)raw[2 * j + 1]) * w1); }
                A[d][mt][kk] = __builtin_bit_cast(bf16x8, o); } }
#pragma unroll
    for (int nt = 0; nt < 4; ++nt) {
        bf16x8 Bf[4];
#pragma unroll
        for (int kk = 0; kk < 4; ++kk) Bf[kk] = *(const bf16x8*)(F.bT() + ((size_t)b * 256 + g * 128 + 32 * nt + r) * SQ + s0 + 16 * kk + 8 * hh);
#pragma unroll
        for (int d = 0; d < 2; ++d)
#pragma unroll
            for (int mt = 0; mt < 2; ++mt) { f32x16 acc;
#pragma unroll
                for (int i = 0; i < 16; ++i) acc[i] = 0.f;
#pragma unroll
                for (int kk = 0; kk < 4; ++kk) acc = MFMA32(A[d][mt][kk], Bf[kk], acc);
                float* dst = F.cst() + ((((size_t)(b * 2 + d) * 4 + h) * 36 + c) * 64 + 32 * mt) * 128 + 32 * nt + r;
#pragma unroll
                for (int i = 0; i < 16; ++i) dst[crow16(i, hh) * 128] = acc[i]; }
    }
    LDS_WAIT();
}
__device__ __forceinline__ void phase_ssd_s1(const Fr& F, int L) {
    LAS float* scr = (LAS float*)(F.lds + F.wave * 16384);
    for (int j = F.gw; j < NB * 36 * 4; j += F.NGW) ssd_s1_job(F, L, j / 144, (j / 4) % 36, j & 3, scr);
}
__device__ __forceinline__ void phase_ssd_scan(const Fr& F, int L) {
    for (int e4 = blockIdx.x * 512 + F.tid; e4 < NB * 2 * 4 * 2048; e4 += F.G * 512) {
        const int bdh = e4 >> 11, pn = (e4 & 2047) * 4, d = (bdh >> 2) & 1;
        f32x4 hst = (f32x4){0.f, 0.f, 0.f, 0.f};
        const float* cs_ = F.cst() + (size_t)bdh * 36 * 8192 + pn; bf16* he_ = F.hent() + (size_t)bdh * 36 * 8192 + pn; const float* cd_ = F.cdec() + bdh * 36;
#pragma unroll 1
        for (int s6 = 0; s6 < 36; s6 += 6) {
            f32x4 v[6]; float dc[6]; int cc[6];
#pragma unroll
            for (int j = 0; j < 6; ++j) { const int step = s6 + j; cc[j] = d == 0 ? step : (step < 4 ? 3 - step : 39 - step); v[j] = *(const f32x4*)(cs_ + (size_t)cc[j] * 8192); dc[j] = cd_[cc[j]]; }
#pragma unroll
            for (int j = 0; j < 6; ++j) { u32x2 o; o.x = pk2(hst[0], hst[1]); o.y = pk2(hst[2], hst[3]); *(u32x2*)(he_ + (size_t)cc[j] * 8192) = o; hst = hst * dc[j] + v[j]; }
        }
    }
}
__device__ __forceinline__ void ssd_s3_unit(const Fr& F, int L, int b, int c) {
    const int lane = F.lane, wave = F.wave, r = lane & 31, hh = lane >> 5, s0 = 64 * c, h = wave >> 1, it = wave & 1, g = h >> 1, itok = 32 * it + r;
    LAS float* scr = (LAS float*)(F.lds + wave * 16384);
    LAS float* red = (LAS float*)(F.lds + 8192);
#pragma unroll
    for (int d = 0; d < 2; ++d) { float dt, cum; (void)ssd_cum(F, L, b, h, d, s0, dt, cum); scr[d * 128 + lane] = cum; scr[d * 128 + 64 + lane] = dt; }
    LDS_WAIT();
    bf16x8 Cf[8];
#pragma unroll
    for (int kk = 0; kk < 8; ++kk) Cf[kk] = *(const bf16x8*)(F.ctm() + ((size_t)b * SQ + s0 + itok) * 256 + g * 128 + 16 * kk + 8 * hh);
    f32x16 G[2];
#pragma unroll
    for (int jt = 0; jt < 2; ++jt) {
#pragma unroll
        for (int i = 0; i < 16; ++i) G[jt][i] = 0.f;
#pragma unroll
        for (int kk = 0; kk < 8; ++kk) { const bf16x8 bf = *(const bf16x8*)(F.btm() + ((size_t)b * SQ + s0 + 32 * jt + r) * 256 + g * 128 + 16 * kk + 8 * hh); G[jt] = MFMA32(bf, Cf[kk], G[jt]); } }
    bf16x8 X[2][4];
#pragma unroll
    for (int mt = 0; mt < 2; ++mt)
#pragma unroll
        for (int ks = 0; ks < 4; ++ks) { const bf16* xp = F.xT() + ((size_t)b * 256 + h * 64 + 32 * mt + r) * SQ + s0 + 16 * ks + 4 * hh;
            const u32x2 lo = *(const u32x2*)xp, hi = *(const u32x2*)(xp + 8); u32x4 o; o.x = lo.x; o.y = lo.y; o.z = hi.x; o.w = hi.y; X[mt][ks] = __builtin_bit_cast(bf16x8, o); }
    f32x16 Y[2];
#pragma unroll
    for (int mt = 0; mt < 2; ++mt)
#pragma unroll
        for (int i = 0; i < 16; ++i) Y[mt][i] = 0.f;
    const float Dsum = F.ssd_d()[L * 8 + h] + F.ssd_d()[L * 8 + 4 + h];
#pragma unroll 1
    for (int d = 0; d < 2; ++d) {
        const float cum_i = scr[d * 128 + itok];
        f32x16 Pm[2];
#pragma unroll
        for (int jt = 0; jt < 2; ++jt)
#pragma unroll
            for (int i = 0; i < 16; ++i) { const int j = 32 * jt + crow16(i, hh); const bool valid = d == 0 ? (j <= itok) : (j >= itok);
                const float arg = valid ? cum_i - scr[d * 128 + j] : -INFINITY;
                float pv = G[jt][i] * __expf(arg) * scr[d * 128 + 64 + j];
                if (d == 0 && j == itok) pv += Dsum;
                Pm[jt][i] = pv; }
        const bf16x8 p0 = pack_step<0>(Pm[0]), p1 = pack_step<8>(Pm[0]), p2 = pack_step<0>(Pm[1]), p3 = pack_step<8>(Pm[1]);
#pragma unroll
        for (int mt = 0; mt < 2; ++mt) { Y[mt] = MFMA32(X[mt][0], p0, Y[mt]); Y[mt] = MFMA32(X[mt][1], p1, Y[mt]); Y[mt] = MFMA32(X[mt][2], p2, Y[mt]); Y[mt] = MFMA32(X[mt][3], p3, Y[mt]); }
        const float ei = __expf(cum_i);
#pragma unroll
        for (int mt = 0; mt < 2; ++mt) { f32x16 T;
#pragma unroll
            for (int i = 0; i < 16; ++i) T[i] = 0.f;
#pragma unroll
            for (int kk = 0; kk < 8; ++kk) { const bf16x8 hf = *(const bf16x8*)(F.hent() + ((((size_t)(b * 2 + d) * 4 + h) * 36 + c) * 64 + 32 * mt + r) * 128 + 16 * kk + 8 * hh); T = MFMA32(hf, Cf[kk], T); }
#pragma unroll
            for (int i = 0; i < 16; ++i) Y[mt][i] += ei * T[i]; }
    }
    const size_t row = bs2row(b, s0 + itok);
    const bf16* zp = F.pbuf() + row * NP + C_Z + h * 64 + 4 * hh;
    float ss = 0.f;
#pragma unroll
    for (int mt = 0; mt < 2; ++mt)
#pragma unroll
        for (int gq = 0; gq < 4; ++gq) { const u32x2 z4 = *(const u32x2*)(zp + 32 * mt + 8 * gq);
            const float z0 = __uint_as_float(z4.x << 16), z1 = __uint_as_float(z4.x & 0xffff0000u), z2 = __uint_as_float(z4.y << 16), z3 = __uint_as_float(z4.y & 0xffff0000u);
            Y[mt][4 * gq] *= siluf(z0); Y[mt][4 * gq + 1] *= siluf(z1); Y[mt][4 * gq + 2] *= siluf(z2); Y[mt][4 * gq + 3] *= siluf(z3);
            ss += (Y[mt][4 * gq] * Y[mt][4 * gq] + Y[mt][4 * gq + 1] * Y[mt][4 * gq + 1]) + (Y[mt][4 * gq + 2] * Y[mt][4 * gq + 2] + Y[mt][4 * gq + 3] * Y[mt][4 * gq + 3]); }
    ss += __shfl_xor(ss, 32);
    if (hh == 0) red[(it * 4 + h) * 32 + r] = ss;
    __syncthreads();
    const float tot = (red[(it * 4 + 0) * 32 + r] + red[(it * 4 + 1) * 32 + r]) + (red[(it * 4 + 2) * 32 + r] + red[(it * 4 + 3) * 32 + r]);
    const float rs = rsqrtf(tot * (1.f / 256) + EPS);
    bf16* mo = F.mix() + row * DM + 768 + h * 64 + 4 * hh;
#pragma unroll
    for (int mt = 0; mt < 2; ++mt)
#pragma unroll
        for (int gq = 0; gq < 4; ++gq) { const f32x4 gn = *(const f32x4*)(F.ssd_gn() + L * 256 + h * 64 + 32 * mt + 8 * gq + 4 * hh);
            u32x2 w; w.x = pk2(Y[mt][4 * gq] * rs * gn[0], Y[mt][4 * gq + 1] * rs * gn[1]); w.y = pk2(Y[mt][4 * gq + 2] * rs * gn[2], Y[mt][4 * gq + 3] * rs * gn[3]);
            *(u32x2*)(mo + 32 * mt + 8 * gq) = w; }
    __syncthreads();
}
template <int KIND> __device__ __forceinline__ void attn_units(const Fr& F, int L) {
    if (KIND == 2) { const int nu = (L == DEPTH - 1) ? 512 : 576;
        for (int u = F.vcu; u < nu; u += F.G) { if (u < 512) attn_unit<2>(F, L, u >> 6, (u >> 4) & 3, u & 15); else attn_unit<2>(F, L, (u - 512) >> 3, ((u - 512) >> 1) & 3, -1 - (u & 1)); }
    } else { const int nu = (L == DEPTH - 1) ? 256 : 288;
        for (int u = F.vcu; u < nu; u += F.G) { if (u < 256) attn_unit<KIND>(F, L, u >> 5, (u >> 3) & 3, u & 7); else attn_unit<KIND>(F, L, (u - 256) >> 2, (u - 256) & 3, -1); } }
}
__device__ __forceinline__ void phase_mix_fast(const Fr& F, int L) {
#ifndef ATT_MASK
#define ATT_MASK 15
#endif
#ifndef ATT_DUP
#define ATT_DUP 0
#endif
#ifndef ATT_MASK
#define ATT_MASK 15
#endif
    if (ATT_MASK & 4) for (int rp = 0; rp < ((ATT_DUP & 4) ? 2 : 1); ++rp) { const Fr Fa = refresh(F); attn_units<2>(Fa, L); }
    if (ATT_MASK & 2) for (int rp = 0; rp < ((ATT_DUP & 2) ? 2 : 1); ++rp) { const Fr Fa = refresh(F); attn_units<1>(Fa, L); }
    if (ATT_MASK & 1) for (int rp = 0; rp < ((ATT_DUP & 1) ? 2 : 1); ++rp) { const Fr Fa = refresh(F); attn_units<0>(Fa, L); }
    const int c0 = (L == DEPTH - 1) ? 4 : 0;
    if (ATT_MASK & 8) { const Fr Fa = refresh(F); unsigned* ctr = Fa.ctl() + CW_QUEUE + (L * 16 + 1) * 64;
        for (;;) { const int u = grab_unit(Fa, ctr); if (u >= NB * (36 - c0)) break; ssd_s3_unit(Fa, L, u / (36 - c0), c0 + u % (36 - c0)); } }
}

__device__ __forceinline__ void phase_route(const Fr& F, int L, bool commit = true) {
    const int nrows = (L == DEPTH - 1) ? NLAT : NROW;
    LAS float* wl = (LAS float*)F.lds;
    {   const f32x4* wg4 = (const f32x4*)(F.w_grp() + (size_t)L * DM * 4); const f32x4* we4 = (const f32x4*)(F.w_exp() + (size_t)L * DM * 16);
        f32x4 tg[2], te[8];
#pragma unroll
        for (int n = 0; n < 2; ++n) tg[n] = wg4[F.tid + 512 * n];
#pragma unroll
        for (int n = 0; n < 8; ++n) te[n] = we4[F.tid + 512 * n];
#pragma unroll
        for (int n = 0; n < 2; ++n) { const int k = F.tid + 512 * n;
#pragma unroll
            for (int o = 0; o < 4; ++o) wl[o * DM + k] = tg[n][o]; }
#pragma unroll
        for (int n = 0; n < 8; ++n) { const int i = F.tid + 512 * n, k = i >> 2, q = i & 3;
#pragma unroll
            for (int o = 0; o < 4; ++o) wl[(4 + 4 * q + o) * DM + k] = te[n][o]; }
    }
    __syncthreads();
    float keep[20];
#pragma unroll
    for (int o = 0; o < 20; ++o) keep[o] = 0.f;
    f32x4 v[4], vn[4];
    { const int r = F.gw; if (r < nrows) { const float* hp = r < NLAT ? F.out() + (size_t)r * DM : F.hc() + (size_t)(r - NLAT) * DM;
#pragma unroll
        for (int j = 0; j < 4; ++j) vn[j] = *(const f32x4*)(hp + 4 * F.lane + 256 * j); } }
    int it = 0;
    for (int r = F.gw; r < nrows; r += F.NGW, ++it) {
        const bool lat = r < NLAT; const int bb = lat ? (r >> 11) : 8;
#pragma unroll
        for (int j = 0; j < 4; ++j) v[j] = vn[j];
        { const int rn = r + F.NGW; if (rn < nrows) { const float* hp = rn < NLAT ? F.out() + (size_t)rn * DM : F.hc() + (size_t)(rn - NLAT) * DM;
#pragma unroll
            for (int j = 0; j < 4; ++j) vn[j] = *(const f32x4*)(hp + 4 * F.lane + 256 * j); } }
        float ss = 0.f;
#pragma unroll
        for (int j = 0; j < 4; ++j) ss += (v[j][0] * v[j][0] + v[j][1] * v[j][1]) + (v[j][2] * v[j][2] + v[j][3] * v[j][3]);
        const float rstd = rsqrtf(wsum(ss) * (1.f / DM) + EPS);
        const float* md = F.modv() + ((size_t)L * 9 + bb) * 6144;
        float lg[20];
#pragma unroll
        for (int o = 0; o < 20; ++o) lg[o] = 0.f;
#pragma unroll
        for (int j = 0; j < 4; ++j) { const int c = 4 * F.lane + 256 * j; const f32x4 g = *(const f32x4*)(F.g_ffn() + L * DM + c), sh = *(const f32x4*)(md + 3 * 1024 + c), scl = *(const f32x4*)(md + 4 * 1024 + c);
            const f32x4 f = v[j] * rstd * g * (scl + 1.f) + sh; u32x2 o2; o2.x = pk2(f[0], f[1]); o2.y = pk2(f[2], f[3]); *(u32x2*)(F.abuf() + (size_t)r * DM + c) = o2;
#pragma unroll
            for (int o = 0; o < 20; ++o) { const f32x4 w = *(const LAS f32x4*)(wl + o * DM + c); lg[o] += (f[0] * w[0] + f[1] * w[1]) + (f[2] * w[2] + f[3] * w[3]); }
            asm volatile("" ::: "memory"); }
#pragma unroll
        for (int o = 0; o < 20; ++o) { const float t = wsum(lg[o]); keep[o] = (F.lane == it) ? t : keep[o]; }
    }
    if (F.lane < it) {
        const int r = F.gw + F.lane * F.NGW;
        float gl[4]; float gm = -INFINITY; int gt = 0;
#pragma unroll
        for (int o = 0; o < 4; ++o) { gl[o] = keep[o] + F.b_grp()[L * 4 + o]; if (gl[o] > gm) { gm = gl[o]; gt = o; } }
        float gs = 0.f;
#pragma unroll
        for (int o = 0; o < 4; ++o) gs += expf(gl[o] - gm);
        const float gp = 1.f / gs;
        float el[4];
#pragma unroll
        for (int o = 0; o < 4; ++o) { float v4 = 0.f;
#pragma unroll
            for (int q = 0; q < 4; ++q) v4 = (gt == q) ? keep[4 + 4 * q + o] + F.b_exp()[L * 16 + 4 * q + o] : v4;
            el[o] = v4; }
        int i0 = 0; float m0 = el[0];
#pragma unroll
        for (int o = 1; o < 4; ++o) if (el[o] > m0) { m0 = el[o]; i0 = o; }
        int i1 = i0 == 0 ? 1 : 0; float m1 = i0 == 0 ? el[1] : el[0];
#pragma unroll
        for (int o = 1; o < 4; ++o) if (o != i0 && el[o] > m1) { m1 = el[o]; i1 = o; }
        const float e1 = expf(m1 - m0), w0 = gp / (1.f + e1), w1 = gp * e1 / (1.f + e1);
        const int x0 = gt * 4 + i0, x1 = gt * 4 + i1;
        if (commit) {
            F.rtw()[2 * r] = w0; F.rtw()[2 * r + 1] = w1;
            const unsigned p0 = atomicAdd(F.ctl() + CW_ECNT + (L * 16 + x0) * 64, 1u), p1 = atomicAdd(F.ctl() + CW_ECNT + (L * 16 + x1) * 64, 1u);
            F.elist()[x0 * NROW + p0] = 2 * r; F.elist()[x1 * NROW + p1] = 2 * r + 1; }
        else if (w0 + w1 < -1.f) F.rtw()[0] = 0.f;
    }
    __syncthreads();
}
__device__ __forceinline__ void moe_table(const Fr& F, int L) {
    volatile LAS int* T = (volatile LAS int*)(F.lds + LDSCTL_OFF + 64);
    volatile LAS int* Cn = (volatile LAS int*)(F.lds + LDSCTL_OFF + 160);
    __syncthreads();
    if (F.tid == 0) { int acc = 0;
        for (int e = 0; e < 16; ++e) { int c = (int)__hip_atomic_load(F.ctl() + CW_ECNT + (L * 16 + e) * 64, __ATOMIC_RELAXED, __HIP_MEMORY_SCOPE_AGENT); c = min(max(c, 0), NROW); T[e] = acc; Cn[e] = c; acc += (c + 255) >> 8; }
        T[16] = acc; }
    __syncthreads();
}

__global__ void __launch_bounds__(512, 2) fwd_kernel(Args args) {
    extern __shared__ __attribute__((aligned(16))) unsigned char lds_raw[];
    Fr F0;
    F0.lds = (LAS unsigned char*)lds_raw; F0.tid = threadIdx.x; F0.lane = F0.tid & 63; F0.wave = __builtin_amdgcn_readfirstlane(F0.tid >> 6);
    F0.G = gridDim.x; { const int bx = blockIdx.x; F0.vcu = (F0.G % 8 == 0) ? (bx % 8) * (F0.G / 8) + bx / 8 : bx; }
    F0.gw = F0.vcu * 8 + F0.wave; F0.NGW = F0.G * 8;
    F0.A = (const __attribute__((address_space(4))) Args*)__builtin_amdgcn_kernarg_segment_ptr();
    for (int u = F0.tid; u < (LDS_BYTES - LDSCTL_OFF) / 4; u += 512) ((LAS unsigned*)(F0.lds + LDSCTL_OFF))[u] = 0u;
    __syncthreads();
    const int lo = args.ph_lo, hi = args.ph_hi;
    XcdBarrier bar; bar.bar = F0.ctl() + CW_BAR; bar.x = 0; bar.st = nullptr;
    if (hi - lo > 1) bar = xcd_barrier_post(F0.ctl() + CW_BAR, (volatile LAS unsigned*)(F0.lds + LDSCTL_OFF));
#ifndef PH_MASK
#define PH_MASK 0xFFFF
#endif
#define PM(b) ((PH_MASK >> (b)) & 1)
#ifndef DUP_MASK
#define DUP_MASK 0
#endif
#ifndef DBL_SEAM
#define DBL_SEAM 0
#endif
#define NREP(b) (((DUP_MASK >> (b)) & 1) ? 2 : 1)
#define IN(k) (lo <= (k) && (k) < hi)
#define SEAM(k) do { if (IN(k) && IN((k) + 1)) { const Fr Fb = refresh(F0); XcdBarrier b2 = bar; b2.bar = Fb.ctl() + CW_BAR; xcd_barrier(b2); if ((DUP_MASK & 0x10000) || ((DBL_SEAM >> (((k) + NPH_L - 1) % NPH_L)) & 1)) xcd_barrier(b2); } } while (0)

    if (PM(0) && IN(0)) { for (int rep_ = 0; rep_ < NREP(0); ++rep_) { if (rep_) __syncthreads(); const Fr F = refresh(F0); phase_prologue(F); } }
    SEAM(0);
    for (int L = 0; L < DEPTH; ++L) {
        const int pb = 1 + NPH_L * L;
        const bool lastL = (L == DEPTH - 1);
        if (PM(1) && IN(pb + 0)) { const Fr F = refresh(F0); phase_norm(F, L); if (DUP_MASK & 2048) { __syncthreads(); phase_norm(F, L, false); } if (L == 0) for (int rp = 0; rp < NREP(10); ++rp) moe_weight_convert(F, 0); }
        SEAM(pb + 0);
        if (PM(2) && IN(pb + 1)) { for (int rep_ = 0; rep_ < NREP(2); ++rep_) { if (rep_) __syncthreads(); const Fr F = refresh(F0); pg8::DenseSched S; S.init(F.abuf(), F.winT() + (size_t)L * NP * DM, DM, NROW, NP, F.G, (int)blockIdx.x); pg8::EpiP E{F.pbuf()}; pg8::gemm_phase(F.lds, F.tid, DM, S, E); } }
        SEAM(pb + 1);
        if (PM(3) && IN(pb + 2)) { for (int rep_ = 0; rep_ < NREP(3); ++rep_) { if (rep_) __syncthreads(); const Fr F = refresh(F0); phase_prep(F, L); } }
        SEAM(pb + 2);
        if (PM(4) && IN(pb + 3)) { for (int rep_ = 0; rep_ < NREP(4); ++rep_) { if (rep_) __syncthreads(); const Fr F = refresh(F0); phase_ssd_s1(F, L); } }
        SEAM(pb + 3);
        if (PM(4) && IN(pb + 4)) { for (int rep_ = 0; rep_ < NREP(6); ++rep_) { if (rep_) __syncthreads(); const Fr F = refresh(F0); phase_ssd_scan(F, L); } }
        SEAM(pb + 4);
        if (PM(5) && IN(pb + 5)) { for (int rep_ = 0; rep_ < NREP(5); ++rep_) { if (rep_) __syncthreads(); const Fr F = refresh(F0); phase_mix_fast(F, L); } }
        SEAM(pb + 5);
        if (PM(6) && IN(pb + 6)) { const Fr F = refresh(F0); pg8::DenseSched S; S.init(F.mix(), F.woutT() + (size_t)L * DM * DM, DM, lastL ? NLAT : NROW, DM, F.G, (int)blockIdx.x);
            pg8::EpiRes E{L == 0 ? F.x() : F.out(), L == 0 ? F.ctx() : F.hc(), F.out(), F.hc(), F.modv() + (size_t)L * 9 * 6144 + 2 * 1024, 1.f}; pg8::gemm_phase(F.lds, F.tid, DM, S, E);
            if (!lastL && blockIdx.x >= 32) { __syncthreads(); moe_weight_convert(F, L + 1, ((int)blockIdx.x - 32) * 8 + F.wave, (F.G - 32) * 8); __syncthreads(); }
            if (DUP_MASK & 8192) { __syncthreads(); pg8::EpiRes E2{F.out(), F.hc(), F.out(), F.hc(), F.modv() + (size_t)L * 9 * 6144 + 2 * 1024, 0.f}; pg8::gemm_phase(F.lds, F.tid, DM, S, E2); } }
        SEAM(pb + 6);
        if (PM(7) && IN(pb + 7)) { const Fr F = refresh(F0); phase_route(F, L); if (DUP_MASK & 4096) phase_route(F, L, false); }
        SEAM(pb + 7);
        if (PM(8) && IN(pb + 8)) { for (int rep_ = 0; rep_ < NREP(8); ++rep_) { if (rep_) __syncthreads(); const Fr F = refresh(F0); moe_table(F, L);
            pg8::MoeSched<true> S{(const char*)F.abuf(), (const char*)F.wgu(L & 1), (size_t)1024 * DM * 2, DM, F.G, F.vcu, F.elist(), (const volatile LAS int*)(F.lds + LDSCTL_OFF + 64), (const volatile LAS int*)(F.lds + LDSCTL_OFF + 160)};
            pg8::EpiAct E{F.act()}; pg8::gemm_phase(F.lds, F.tid, DM, S, E); } }
        SEAM(pb + 8);
        if (PM(9) && IN(pb + 9)) { for (int rep_ = 0; rep_ < NREP(9); ++rep_) { if (rep_) __syncthreads(); const Fr F = refresh(F0); moe_table(F, L);
            pg8::MoeSched<false> S{(const char*)F.act(), (const char*)F.wd(L & 1), (size_t)1024 * FF * 2, FF, F.G, F.vcu, F.elist(), (const volatile LAS int*)(F.lds + LDSCTL_OFF + 64), (const volatile LAS int*)(F.lds + LDSCTL_OFF + 160)};
            pg8::EpiDown E{F.yk(), F.elist(), F.rtw()}; pg8::gemm_phase(F.lds, F.tid, FF, S, E); } }
        SEAM(pb + 9);
    }
    if (PM(1) && IN(PH_FINAL)) { const Fr F = refresh(F0); phase_norm(F, DEPTH); }
#undef IN
#undef SEAM
}

extern "C" void kernel_launch(void* const* d_in, const int* in_sizes, int n_in, void* d_out, int out_size, void* d_ws, size_t ws_size, hipStream_t stream) {
    static int grid = 0;
    if (grid == 0) {
        if (n_in != 36 || out_size != NLAT * DM || ws_size < WS_END) { fprintf(stderr, "kernel_launch: unexpected shapes (n_in %d out %d ws %zu)\n", n_in, out_size, ws_size); grid = -1; return; }
        int dev = 0, cus = 0, per_cu = 0;
        if (hipGetDevice(&dev) != hipSuccess || hipDeviceGetAttribute(&cus, hipDeviceAttributeMultiprocessorCount, dev) != hipSuccess) { grid = -1; return; }
        if (hipFuncSetAttribute((const void*)fwd_kernel, hipFuncAttributeMaxDynamicSharedMemorySize, LDS_BYTES) != hipSuccess) { fprintf(stderr, "kernel_launch: hipFuncSetAttribute failed\n"); grid = -1; return; }
        if (hipOccupancyMaxActiveBlocksPerMultiprocessor(&per_cu, (const void*)fwd_kernel, 512, LDS_BYTES) != hipSuccess || per_cu < 1) { fprintf(stderr, "kernel_launch: occupancy query says %d\n", per_cu); }
        (void)hipGetLastError();
        grid = cus;
    }
    if (grid < 0) return;
    (void)hipMemsetAsync((char*)d_ws + WS_CTL, 0, CTL_BYTES, stream);
    Args a{};
    for (int i = 0; i < 36; ++i) a.in[i] = (const float*)d_in[i];
    a.out = (float*)d_out; a.ws = (unsigned char*)d_ws;
#if MK_ONE_LAUNCH
    a.ph_lo = 0; a.ph_hi = NPHASE;
    hipLaunchKernelGGL(fwd_kernel, dim3(grid), dim3(512), LDS_BYTES, stream, a);
#else
    for (int ph = 0; ph < NPHASE; ++ph) { a.ph_lo = ph; a.ph_hi = ph + 1; hipLaunchKernelGGL(fwd_kernel, dim3(grid), dim3(512), LDS_BYTES, stream, a); }
#endif
}
```

```cpp
#include <hip/hip_runtime.h>
#include <cstdio>
#include <cstdint>

#ifndef MK_ONE_LAUNCH
#define MK_ONE_LAUNCH 1
#endif

#define LAS __attribute__((address_space(3)))
typedef unsigned short bf16;
typedef short bf16x8 __attribute__((ext_vector_type(8)));
typedef float f32x4 __attribute__((ext_vector_type(4)));
typedef float f32x2 __attribute__((ext_vector_type(2)));
typedef unsigned u32x4 __attribute__((ext_vector_type(4)));
typedef unsigned u32x2 __attribute__((ext_vector_type(2)));

constexpr int NB = 8, TLAT = 2048, TCTX = 256, SQ = 2304, DM = 1024, DEPTH = 4;
constexpr int NLAT = NB * TLAT, NCTXR = NB * TCTX, NROW = NLAT + NCTXR;
constexpr int NIN = 2984, NP = 3072;
constexpr int C_NA = 0, C_MLA = 768, C_DF = 1184, C_SSD = 1952;
constexpr int C_Z = C_SSD, C_XBC = C_SSD + 256, C_DT = C_SSD + 1024;
constexpr float EPS = 1e-6f;
constexpr int NEXP = 16, FF = 512, ACT_ROWS = 40960;
constexpr int NPH_L = 10, PH_FINAL = 1 + NPH_L * DEPTH, NPHASE = PH_FINAL + 1;

constexpr size_t MiB = 1u << 20;
constexpr size_t WS_CTL = 0, CTL_BYTES = 1 * MiB;
constexpr size_t WS_MOD = 1 * MiB;
constexpr size_t WS_ROPE = 2 * MiB;
constexpr size_t WS_WIN = 4 * MiB;
constexpr size_t WS_WOUT = 28 * MiB;
constexpr size_t WS_WQB = 36 * MiB;
constexpr size_t WS_WKVB = 37 * MiB;
constexpr size_t WS_WGU = 38 * MiB;
constexpr size_t WS_WD = 70 * MiB;
constexpr size_t WS_HC = 86 * MiB;
constexpr size_t WS_A = 94 * MiB;
constexpr size_t WS_P = 130 * MiB;
constexpr size_t WS_ACT = 130 * MiB;
constexpr size_t WS_YK = 170 * MiB;
constexpr size_t WS_MIX = 238 * MiB;
constexpr size_t WS_QNA = 274 * MiB, WS_KNA = 283 * MiB, WS_VNA = 292 * MiB;
constexpr size_t WS_QML = 301 * MiB, WS_KML = 315 * MiB, WS_VML = 329 * MiB;
constexpr size_t WS_QDF = 338 * MiB, WS_KDF = 347 * MiB, WS_VDF = 356 * MiB;
constexpr size_t WS_XT = 365 * MiB, WS_BTM = 374 * MiB, WS_BT = 383 * MiB, WS_CTM = 392 * MiB;
constexpr size_t WS_DT = 401 * MiB;
constexpr size_t WS_CST = 402 * MiB;
constexpr size_t WS_CDEC = 474 * MiB;
constexpr size_t WS_HENT = 475 * MiB;
constexpr size_t WS_RT = 511 * MiB;
constexpr size_t WS_ELIST = 512 * MiB;
constexpr size_t WS_WGU2 = 514 * MiB;
constexpr size_t WS_WD2 = 546 * MiB;
constexpr size_t WS_END = 562 * MiB;
constexpr int CW_BAR = 4096;
constexpr int CW_ECNT = 16384;
constexpr int CW_KMAX = 65536;
constexpr int CW_QUEUE = 32768;

constexpr int RING_BYTES = 131072, LDSCTL_OFF = RING_BYTES, LDS_BYTES = 147456;

typedef float f32x16 __attribute__((ext_vector_type(16)));
#define MFMA32(a, b, c) __builtin_amdgcn_mfma_f32_32x32x16_bf16((a), (b), (c), 0, 0, 0)
__device__ __forceinline__ int crow16(int reg, int hh) { return (reg & 3) + 8 * (reg >> 2) + 4 * hh; }
__device__ __forceinline__ float bf2f(bf16 v) { return __uint_as_float(((unsigned)v) << 16); }
__device__ __forceinline__ bf16 f2bf(float f) { unsigned u = __float_as_uint(f); return (bf16)((u + 0x7fffu + ((u >> 16) & 1u)) >> 16); }
__device__ __forceinline__ unsigned pk2(float lo, float hi) { return (unsigned)f2bf(lo) | ((unsigned)f2bf(hi) << 16); }
template <int CTRL> __device__ __forceinline__ float dppf(float v) { return __int_as_float(__builtin_amdgcn_update_dpp(0, __float_as_int(v), CTRL, 0xF, 0xF, true)); }
__device__ __forceinline__ float rlane(float v, int l) { return __int_as_float(__builtin_amdgcn_readlane(__float_as_int(v), l)); }
__device__ __forceinline__ float wsum(float v) {
    v += dppf<0xB1>(v); v += dppf<0x4E>(v); v += dppf<0x141>(v); v += dppf<0x140>(v);
    return (rlane(v, 0) + rlane(v, 16)) + (rlane(v, 32) + rlane(v, 48)); }
__device__ __forceinline__ float wmaxf(float v) {
    v = fmaxf(v, dppf<0xB1>(v)); v = fmaxf(v, dppf<0x4E>(v)); v = fmaxf(v, dppf<0x141>(v)); v = fmaxf(v, dppf<0x140>(v));
    return fmaxf(fmaxf(rlane(v, 0), rlane(v, 16)), fmaxf(rlane(v, 32), rlane(v, 48))); }
#define LDS_WAIT() asm volatile("s_waitcnt lgkmcnt(0)" ::: "memory")
__device__ __forceinline__ void row2bs(int r, int& b, int& s) { if (r < NLAT) { b = r >> 11; s = 256 + (r & 2047); } else { const int j = r - NLAT; b = j >> 8; s = j & 255; } }
__device__ __forceinline__ int bs2row(int b, int s) { return s < 256 ? NLAT + b * 256 + s : b * 2048 + s - 256; }
__device__ __forceinline__ int vpos(int s) { return (s & ~12) | ((s & 4) << 1) | ((s & 8) >> 1); }
__device__ __forceinline__ float siluf(float x) { return x / (1.f + __expf(-x)); }

#define XB_TMO      128
#define XB_XCNT(j)  (256  + 64 * (j))
#define XB_XSUB(j)  (1280 + 64 * (j))
#define XB_XGEN(j)  (2304 + 64 * (j))
#define XB_TOP      3328
#define XB_TOPGEN   3392
#define XCD_BAR_WORDS 3456
#define XB_SPIN_CAP (1u << 24)
__device__ __forceinline__ unsigned xb_ld(unsigned* p)              { return __hip_atomic_load(p, __ATOMIC_RELAXED, __HIP_MEMORY_SCOPE_AGENT); }
__device__ __forceinline__ unsigned xb_add(unsigned* p, unsigned v) { return __hip_atomic_fetch_add(p, v, __ATOMIC_RELAXED, __HIP_MEMORY_SCOPE_AGENT); }
__device__ __forceinline__ unsigned xb_xcc_id() { return (unsigned)__builtin_amdgcn_s_getreg((3 << 11) | 20) & 0xFu; }
#define XB_SPIN(cond, bar) do { unsigned _sp = 0; while (cond) { __builtin_amdgcn_s_sleep(1); \
    if ((++_sp & 255u) == 0u) { if (xb_ld(&(bar)[XB_TMO])) break; if (_sp > XB_SPIN_CAP) { atomicAdd(&(bar)[XB_TMO], 1u); break; } } } } while (0)
struct XcdBarrier { unsigned* bar; unsigned x; volatile LAS unsigned* st; };
__device__ __forceinline__ XcdBarrier xcd_barrier_post(unsigned* bar, volatile LAS unsigned* st) {
    XcdBarrier b; b.bar = bar; b.x = xb_xcc_id(); b.st = st;
    if (threadIdx.x == 0) (void)xb_add(&bar[XB_XCNT(b.x)], 1u);
    return b;
}
__device__ __forceinline__ void xcd_barrier_complete(unsigned* bar, unsigned x, unsigned& nloc, unsigned& nx) {
    const unsigned G = gridDim.x * gridDim.y * gridDim.z;
    unsigned sum, cnt, mine, sp = 0u;
    for (;;) {
        sum = 0u; cnt = 0u; mine = 0u;
#pragma unroll
        for (unsigned j = 0; j < 16; ++j) { const unsigned c = xb_ld(&bar[XB_XCNT(j)]); sum += c; cnt += (c > 0u) ? 1u : 0u; mine = (j == x) ? c : mine; }
        if (sum == G) break;
        __builtin_amdgcn_s_sleep(1);
        if ((++sp & 255u) == 0u) { if (xb_ld(&bar[XB_TMO])) break; if (sp > XB_SPIN_CAP) { atomicAdd(&bar[XB_TMO], 1u); break; } }
    }
    nloc = mine > 0u ? mine : 1u; nx = cnt > 0u ? cnt : 1u;
}
__device__ __forceinline__ void xcd_barrier(const XcdBarrier& b) {
    asm volatile("s_waitcnt vmcnt(0)" ::: "memory");
    __syncthreads();
    if (threadIdx.x == 0) {
        unsigned* bar = b.bar;
        __builtin_amdgcn_s_waitcnt(0);
        unsigned nloc = b.st[0], nx = b.st[1];
        if (nloc == 0u) { xcd_barrier_complete(bar, b.x, nloc, nx); b.st[0] = nloc; b.st[1] = nx; }
        const unsigned old = xb_add(&bar[XB_XSUB(b.x)], 1u);
        const unsigned gen = old / nloc;
        if (old + 1u == (gen + 1u) * nloc) {
            __builtin_amdgcn_fence(__ATOMIC_RELEASE, "agent");
            asm volatile("s_waitcnt vmcnt(0)" ::: "memory");
            const unsigned og = xb_add(&bar[XB_TOP], 1u);
            const unsigned tg = og / nx;
            if (og + 1u == (tg + 1u) * nx) xb_add(&bar[XB_TOPGEN], 1u);
            else XB_SPIN(xb_ld(&bar[XB_TOPGEN]) == tg, bar);
            __builtin_amdgcn_fence(__ATOMIC_ACQUIRE, "agent");
            xb_add(&bar[XB_XGEN(b.x)], 1u);
            asm volatile("s_waitcnt vmcnt(0)" ::: "memory");
        } else {
            XB_SPIN(xb_ld(&bar[XB_XGEN(b.x)]) == gen, bar);
            __builtin_amdgcn_fence(__ATOMIC_ACQUIRE, "agent");
            asm volatile("s_waitcnt vmcnt(0)" ::: "memory");
        }
    }
    __syncthreads();
}

namespace pg8 {
constexpr int BM = 256, BK = 64, HALF = 128, HTB = HALF * BK * 2, NXCD = 8, WGM = 8;
__device__ __forceinline__ int lds_byte(int r, int c) { const int st = (r >> 4) * 2 + (c >> 5), rr = r & 15, cc = c & 31, ob = rr * 64 + cc * 2; return st * 1024 + (ob ^ (((ob >> 9) & 1) << 5)); }
__device__ __forceinline__ void stage_rc(int b, int& R, int& C) { const int st = b / 1024, sb = b % 1024, swz = sb ^ (((sb >> 9) & 1) << 5); R = (st >> 1) * 16 + swz / 64; C = (st & 1) * 32 + (swz % 64) / 2; }
__device__ __forceinline__ int perm32(int rho) { const int n = rho >> 4, i = rho & 15; return 8 * (i >> 2) + 4 * n + (i & 3); }
struct Unit { int pm, pn, e, j, cnt; };

template <class Epi, class Sched>
__device__ __forceinline__ void gemm_phase(LAS unsigned char* lds, const int tid, const int K, const Sched& S, const Epi& E) {
    const int wid = __builtin_amdgcn_readfirstlane(tid >> 6), lane = tid & 63, wr = wid >> 2, wc = wid & 3, fr = lane & 15, fq = lane >> 4;
    const int nt = K / BK;
    int Rr[2]; unsigned Cb[2], voffB[2];
#pragma unroll
    for (int i = 0; i < 2; ++i) { int R, C; stage_rc(tid * 16 + i * 8192, R, C); const int Rb = Epi::PERM ? ((R & ~31) + perm32(R & 31)) : R;
        Rr[i] = R; Cb[i] = (unsigned)C * 2u; voffB[i] = (unsigned)(Rb * K + C) * 2u; }
    const size_t kstep = (size_t)(BK * 2);
    const size_t hstep = (size_t)HALF * K * 2;
    const unsigned ldsw = (unsigned)wid * 1024u;
    const int aoff = lds_byte(wr * 64 + fr, fq * 8), boff = lds_byte(wc * 32 + fr, fq * 8);
#define PG8_SA(b, h) (((b) * 2 + (h)) * HTB)
#define PG8_SB(b, h) ((4 + (b) * 2 + (h)) * HTB)
#define PG8_STAGE(bufoff, gbase, voff) do { _Pragma("unroll") for (int _i = 0; _i < 2; ++_i) \
        __builtin_amdgcn_global_load_lds((const unsigned*)((const char*)(gbase) + (voff)[_i]), (LAS unsigned*)(lds + (bufoff) + ldsw + _i * 8192), 16, 0, 0); } while (0)
#define PG8_LDA(dst, b, h) do { _Pragma("unroll") for (int m = 0; m < 4; ++m) _Pragma("unroll") for (int k = 0; k < 2; ++k) dst[m][k] = *(const LAS bf16x8*)(lds + PG8_SA(b, h) + aoff + m * 2048 + k * 1024); } while (0)
#define PG8_LDB(dst, b, h) do { _Pragma("unroll") for (int n = 0; n < 2; ++n) _Pragma("unroll") for (int k = 0; k < 2; ++k) dst[n][k] = *(const LAS bf16x8*)(lds + PG8_SB(b, h) + boff + n * 2048 + k * 1024); } while (0)
#define PG8_MMA(ai, bj, At, Bt) do { __builtin_amdgcn_s_setprio(1); _Pragma("unroll") for (int m = 0; m < 4; ++m) _Pragma("unroll") for (int n = 0; n < 2; ++n) _Pragma("unroll") for (int k = 0; k < 2; ++k) \
        acc[ai][bj][m][n] = __builtin_amdgcn_mfma_f32_16x16x32_bf16(Bt[n][k], At[m][k], acc[ai][bj][m][n], 0, 0, 0); __builtin_amdgcn_s_setprio(0); } while (0)
#define PG8_WAIT_V(n) asm volatile("s_waitcnt vmcnt(" #n ")" ::: "memory")
#define PG8_WAIT_L(n) asm volatile("s_waitcnt lgkmcnt(" #n ")" ::: "memory")
#define PG8_BAR __builtin_amdgcn_s_barrier()
#define PG8_SCHED __builtin_amdgcn_sched_barrier(0)
    Unit cur, nxt; int ui = 0;
    if (!S.next(0, cur)) return;
    f32x4 acc[2][2][4][2];
#pragma unroll
    for (int a = 0; a < 2; ++a)
#pragma unroll
        for (int b = 0; b < 2; ++b)
#pragma unroll
            for (int m = 0; m < 4; ++m)
#pragma unroll
                for (int n = 0; n < 2; ++n) acc[a][b][m][n] = (f32x4){0.f, 0.f, 0.f, 0.f};
    bf16x8 At[4][2], B0[2][2], B1[2][2];
    unsigned vA0[2], vA1[2];
    const char* cA = S.a_ptr(cur);
    if constexpr (Sched::GATHER) { S.a_offs(cur, Rr, vA0, vA1);
#pragma unroll
        for (int i = 0; i < 2; ++i) { vA0[i] += Cb[i]; vA1[i] += Cb[i]; }
        asm volatile("s_waitcnt vmcnt(0)" ::: "memory");
    } else {
#pragma unroll
        for (int i = 0; i < 2; ++i) { vA0[i] = (unsigned)(Rr[i] * K * 2) + Cb[i]; vA1[i] = vA0[i]; } }
    const size_t ahs = Sched::GATHER ? (size_t)0 : hstep;
    const char* cB = S.b_ptr(cur);
    PG8_STAGE(PG8_SB(0, 0), cB, voffB); PG8_STAGE(PG8_SB(0, 1), cB + hstep, voffB); PG8_STAGE(PG8_SA(0, 0), cA, vA0); PG8_STAGE(PG8_SA(0, 1), cA + ahs, vA1);
    if (wr == 1) PG8_BAR;
    PG8_WAIT_V(2); PG8_BAR;
    PG8_STAGE(PG8_SB(1, 0), cB + kstep, voffB); PG8_STAGE(PG8_SA(1, 0), cA + kstep, vA0); PG8_STAGE(PG8_SB(1, 1), cB + hstep + kstep, voffB);
    PG8_WAIT_V(6); PG8_BAR;
    for (;;) {
        const bool has_next = S.next(ui + 1, nxt);
        const char* nA = has_next ? S.a_ptr(nxt) : cA; const char* nB = has_next ? S.b_ptr(nxt) : cB;
        for (int t = 0; t < nt; t += 2) {
            const bool last = (t == nt - 2);
            const char* a1 = cA + (size_t)(t + 1) * kstep;
            const char* a2 = last ? nA : cA + (size_t)(t + 2) * kstep; const char* b2 = last ? nB : cB + (size_t)(t + 2) * kstep;
            const char* a3 = a2 + kstep; const char* b3 = b2 + kstep;
            PG8_LDB(B0, 0, 0); PG8_LDB(B1, 0, 1); PG8_SCHED; PG8_LDA(At, 0, 0); PG8_STAGE(PG8_SA(1, 1), a1 + ahs, vA1);
            if constexpr (Sched::GATHER) { if (last && has_next) { S.a_offs(nxt, Rr, vA0, vA1);
#pragma unroll
                for (int i = 0; i < 2; ++i) { vA0[i] += Cb[i]; vA1[i] += Cb[i]; }
                asm volatile("s_waitcnt vmcnt(0)" ::: "memory"); } }
            PG8_WAIT_V(8); PG8_WAIT_L(0); PG8_BAR; PG8_MMA(0, 0, At, B0); PG8_MMA(0, 1, At, B1); PG8_BAR; PG8_SCHED;
            PG8_LDA(At, 0, 1); PG8_STAGE(PG8_SB(0, 0), b2, voffB); PG8_STAGE(PG8_SB(0, 1), b2 + hstep, voffB); PG8_STAGE(PG8_SA(0, 0), a2, vA0);
            PG8_WAIT_V(8); PG8_WAIT_L(0); PG8_BAR; PG8_MMA(1, 0, At, B0); PG8_MMA(1, 1, At, B1); PG8_BAR; PG8_SCHED;
            PG8_LDB(B0, 1, 0); PG8_LDB(B1, 1, 1); PG8_SCHED; PG8_LDA(At, 1, 0); PG8_STAGE(PG8_SA(0, 1), a2 + ahs, vA1);
            PG8_WAIT_V(8); PG8_WAIT_L(0); PG8_BAR; PG8_MMA(0, 0, At, B0); PG8_MMA(0, 1, At, B1); PG8_BAR; PG8_SCHED;
            PG8_LDA(At, 1, 1); PG8_STAGE(PG8_SB(1, 0), b3, voffB); PG8_STAGE(PG8_SB(1, 1), b3 + hstep, voffB); PG8_STAGE(PG8_SA(1, 0), a3, vA0);
            PG8_WAIT_V(8); PG8_WAIT_L(0); PG8_BAR; PG8_MMA(1, 0, At, B0); PG8_MMA(1, 1, At, B1); PG8_BAR; PG8_SCHED;
        }
        if (wr == 0) PG8_BAR;
        E(acc, cur, wr, wc, fr, fq);
        if (!has_next) break;
#pragma unroll
        for (int a = 0; a < 2; ++a)
#pragma unroll
            for (int b = 0; b < 2; ++b)
#pragma unroll
                for (int m = 0; m < 4; ++m)
#pragma unroll
                    for (int n = 0; n < 2; ++n) acc[a][b][m][n] = (f32x4){0.f, 0.f, 0.f, 0.f};
        cur = nxt; cA = nA; cB = nB; ++ui;
        if (wr == 1) PG8_BAR;
    }
    PG8_WAIT_V(0);
    PG8_BAR;
#undef PG8_SA
#undef PG8_SB
#undef PG8_STAGE
#undef PG8_LDA
#undef PG8_LDB
#undef PG8_MMA
#undef PG8_WAIT_V
#undef PG8_WAIT_L
#undef PG8_BAR
#undef PG8_SCHED
}
__device__ __forceinline__ unsigned cvt_pk_bf16(float lo, float hi) { unsigned r; asm volatile("v_cvt_pk_bf16_f32 %0, %1, %2" : "=v"(r) : "v"(lo), "v"(hi)); return r; }

struct DenseSched {
    const char* A; const char* Bt; int K, nM, nN, nwg, G, c;
    __device__ void init(const void* A_, const void* Bt_, int K_, int M, int N, int G_, int c_) { A = (const char*)A_; Bt = (const char*)Bt_; K = K_; nM = M / BM; nN = N / BM; nwg = nM * nN; G = G_; c = c_; }
    __device__ __forceinline__ bool next(int i, Unit& u) const {
        const long L = (long)i * G + c; if (L >= nwg) return false;
        int wgid = (int)L; { const int q = nwg / NXCD, r = nwg % NXCD, xcd = wgid % NXCD, off = wgid / NXCD; wgid = (xcd < r ? xcd * (q + 1) : r * (q + 1) + (xcd - r) * q) + off; }
        const int nig = WGM * nN, gid = wgid / nig, fm = gid * WGM, gsz = (nM - fm) < WGM ? (nM - fm) : WGM;
        u.pm = fm + ((wgid % nig) % gsz); u.pn = (wgid % nig) / gsz; u.e = 0; u.j = 0; u.cnt = 256; return true;
    }
    static constexpr bool GATHER = false;
    __device__ __forceinline__ const char* a_ptr(const Unit& u) const { return A + (size_t)u.pm * BM * K * 2; }
    __device__ __forceinline__ void a_offs(const Unit&, const int (&)[2], unsigned (&)[2], unsigned (&)[2]) const {}
    __device__ __forceinline__ const char* b_ptr(const Unit& u) const { return Bt + (size_t)u.pn * BM * K * 2; }
};
template <bool GATHER_> struct MoeSched {
    static constexpr bool GATHER = GATHER_;
    const char* A; const char* W; size_t wstride; int K, G, c; const int* elist; const volatile LAS int* T; const volatile LAS int* Cn;
    __device__ __forceinline__ bool next(int i, Unit& u) const {
        const long L = (long)i * G + c; const int nT = T[16]; if (L >= 4L * nT) return false;
        const int tile = (int)(L >> 2); u.pn = (int)(L & 3); u.pm = tile;
        int e = 0;
#pragma unroll
        for (int k = 1; k < 16; ++k) e += (tile >= T[k]) ? 1 : 0;
        u.e = e; u.j = tile - T[e]; u.cnt = Cn[e]; return true;
    }
    __device__ __forceinline__ const char* a_ptr(const Unit& u) const { return GATHER ? A : A + (size_t)u.pm * BM * K * 2; }
    __device__ __forceinline__ void a_offs(const Unit& u, const int (&Rr)[2], unsigned (&v0)[2], unsigned (&v1)[2]) const {
#pragma unroll
        for (int i = 0; i < 2; ++i) {
            const int p0 = u.j * BM + Rr[i], p1 = p0 + HALF;
            int t0 = p0 < u.cnt ? (elist[u.e * NROW + p0] >> 1) : 0, t1 = p1 < u.cnt ? (elist[u.e * NROW + p1] >> 1) : 0;
            t0 = min(max(t0, 0), NROW - 1); t1 = min(max(t1, 0), NROW - 1);
            v0[i] = (unsigned)(t0 * K * 2); v1[i] = (unsigned)(t1 * K * 2);
        } }
    __device__ __forceinline__ const char* b_ptr(const Unit& u) const { return W + (size_t)u.e * wstride + (size_t)u.pn * BM * K * 2; }
};
struct EpiP {
    static constexpr bool PERM = true;
    bf16* O;
    __device__ __forceinline__ void operator()(const f32x4 (&acc)[2][2][4][2], const Unit& u, int wr, int wc, int fr, int fq) const {
        const int row0 = u.pm * BM + wr * 64 + fr, col0 = u.pn * BM + wc * 32 + 8 * fq;
#pragma unroll
        for (int ai = 0; ai < 2; ++ai)
#pragma unroll
            for (int m = 0; m < 4; ++m) { bf16* rowp = O + (size_t)(row0 + ai * HALF + m * 16) * NP + col0;
#pragma unroll
                for (int bj = 0; bj < 2; ++bj) { const f32x4 v0 = acc[ai][bj][m][0], v1 = acc[ai][bj][m][1];
                    u32x4 w; w.x = cvt_pk_bf16(v0[0], v0[1]); w.y = cvt_pk_bf16(v0[2], v0[3]); w.z = cvt_pk_bf16(v1[0], v1[1]); w.w = cvt_pk_bf16(v1[2], v1[3]);
                    *(u32x4*)(rowp + bj * HALF) = w; } }
    }
};
struct EpiRes {
    static constexpr bool PERM = false;
    const float* hin_l; const float* hin_c; float* hout_l; float* hout_c; const float* gate; float gsc;
    __device__ __forceinline__ void operator()(const f32x4 (&acc)[2][2][4][2], const Unit& u, int wr, int wc, int fr, int fq) const {
        const int row0 = u.pm * BM + wr * 64 + fr, col0 = u.pn * BM + wc * 32 + 4 * fq;
#pragma unroll
        for (int ai = 0; ai < 2; ++ai)
#pragma unroll
            for (int m = 0; m < 4; ++m) { const int r = row0 + ai * HALF + m * 16; const bool lat = r < NLAT; const int bb = lat ? (r >> 11) : 8;
                const float* hi = lat ? hin_l + (size_t)r * DM : hin_c + (size_t)(r - NLAT) * DM; float* ho = lat ? hout_l + (size_t)r * DM : hout_c + (size_t)(r - NLAT) * DM;
                const float* g = gate + (size_t)bb * 6144;
#pragma unroll
                for (int bj = 0; bj < 2; ++bj)
#pragma unroll
                    for (int n = 0; n < 2; ++n) { const int c = col0 + bj * HALF + n * 16; const f32x4 gv = *(const f32x4*)(g + c), hv = *(const f32x4*)(hi + c);
                        *(f32x4*)(ho + c) = hv + gv * gsc * acc[ai][bj][m][n]; } }
    }
};
struct EpiAct {
    static constexpr bool PERM = true;
    bf16* O;
    __device__ __forceinline__ void operator()(const f32x4 (&acc)[2][2][4][2], const Unit& u, int wr, int wc, int fr, int fq) const {
        const int row0 = u.pm * BM + wr * 64 + fr, col0 = u.pn * HALF + wc * 32 + 8 * fq;
#pragma unroll
        for (int ai = 0; ai < 2; ++ai)
#pragma unroll
            for (int m = 0; m < 4; ++m) { bf16* rowp = O + (size_t)(row0 + ai * HALF + m * 16) * FF + col0;
                float o[8];
#pragma unroll
                for (int n = 0; n < 2; ++n)
#pragma unroll
                    for (int j = 0; j < 4; ++j) { const float g = acc[ai][0][m][n][j], up = acc[ai][1][m][n][j]; o[n * 4 + j] = g / (1.f + __expf(-g)) * up; }
                u32x4 w; w.x = cvt_pk_bf16(o[0], o[1]); w.y = cvt_pk_bf16(o[2], o[3]); w.z = cvt_pk_bf16(o[4], o[5]); w.w = cvt_pk_bf16(o[6], o[7]);
                *(u32x4*)rowp = w; }
    }
};
struct EpiDown {
    static constexpr bool PERM = true;
    bf16* O; const int* elist; const float* rtw;
    __device__ __forceinline__ void operator()(const f32x4 (&acc)[2][2][4][2], const Unit& u, int wr, int wc, int fr, int fq) const {
        const int col0 = u.pn * BM + wc * 32 + 8 * fq;
#pragma unroll
        for (int ai = 0; ai < 2; ++ai)
#pragma unroll
            for (int m = 0; m < 4; ++m) { const int pos = u.j * BM + ai * HALF + wr * 64 + m * 16 + fr;
                if (pos < u.cnt) { const int a = min(max(elist[u.e * NROW + pos], 0), 2 * NROW - 1); const float w8 = rtw[a]; bf16* rowp = O + (size_t)a * DM + col0;
#pragma unroll
                    for (int bj = 0; bj < 2; ++bj) { const f32x4 v0 = acc[ai][bj][m][0] * w8, v1 = acc[ai][bj][m][1] * w8;
                        u32x4 w; w.x = cvt_pk_bf16(v0[0], v0[1]); w.y = cvt_pk_bf16(v0[2], v0[3]); w.z = cvt_pk_bf16(v1[0], v1[1]); w.w = cvt_pk_bf16(v1[2], v1[3]);
                        *(u32x4*)(rowp + bj * HALF) = w; } } }
    }
};
}

struct Args { const float* in[36]; float* out; unsigned char* ws; int ph_lo, ph_hi; };
struct Fr {
    LAS unsigned char* lds; int tid, lane, wave, G, vcu, gw, NGW; const __attribute__((address_space(4))) Args* A;
    __device__ __forceinline__ const float* x() const { return A->in[0]; }
    __device__ __forceinline__ const float* cvec() const { return A->in[1]; }
    __device__ __forceinline__ const float* ctx() const { return A->in[2]; }
    __device__ __forceinline__ const float* cctx() const { return A->in[3]; }
    __device__ __forceinline__ const float* w_mod() const { return A->in[4]; }
    __device__ __forceinline__ const float* b_mod() const { return A->in[5]; }
    __device__ __forceinline__ const float* g_mix() const { return A->in[6]; }
    __device__ __forceinline__ const float* w_in() const { return A->in[7]; }
    __device__ __forceinline__ const float* w_out() const { return A->in[8]; }
    __device__ __forceinline__ const float* na_gq() const { return A->in[9]; }
    __device__ __forceinline__ const float* na_gk() const { return A->in[10]; }
    __device__ __forceinline__ const float* na_rb() const { return A->in[11]; }
    __device__ __forceinline__ const float* mla_gqa() const { return A->in[12]; }
    __device__ __forceinline__ const float* mla_wqb() const { return A->in[13]; }
    __device__ __forceinline__ const float* mla_gkva() const { return A->in[14]; }
    __device__ __forceinline__ const float* mla_wkvb() const { return A->in[15]; }
    __device__ __forceinline__ const float* mla_gq() const { return A->in[16]; }
    __device__ __forceinline__ const float* mla_gk() const { return A->in[17]; }
    __device__ __forceinline__ const float* df_gq() const { return A->in[18]; }
    __device__ __forceinline__ const float* df_gk() const { return A->in[19]; }
    __device__ __forceinline__ const float* df_lam() const { return A->in[20]; }
    __device__ __forceinline__ const float* df_gsub() const { return A->in[21]; }
    __device__ __forceinline__ const float* conv_w() const { return A->in[22]; }
    __device__ __forceinline__ const float* conv_b() const { return A->in[23]; }
    __device__ __forceinline__ const float* dt_bias() const { return A->in[24]; }
    __device__ __forceinline__ const float* a_log() const { return A->in[25]; }
    __device__ __forceinline__ const float* ssd_d() const { return A->in[26]; }
    __device__ __forceinline__ const float* ssd_gn() const { return A->in[27]; }
    __device__ __forceinline__ const float* g_ffn() const { return A->in[28]; }
    __device__ __forceinline__ const float* w_grp() const { return A->in[29]; }
    __device__ __forceinline__ const float* b_grp() const { return A->in[30]; }
    __device__ __forceinline__ const float* w_exp() const { return A->in[31]; }
    __device__ __forceinline__ const float* b_exp() const { return A->in[32]; }
    __device__ __forceinline__ const float* w_gate() const { return A->in[33]; }
    __device__ __forceinline__ const float* w_up() const { return A->in[34]; }
    __device__ __forceinline__ const float* w_down() const { return A->in[35]; }
    __device__ __forceinline__ float* out() const { return A->out; }
    __device__ __forceinline__ unsigned* ctl() const { return (unsigned*)(A->ws + WS_CTL); }
    __device__ __forceinline__ float* modv() const { return (float*)(A->ws + WS_MOD); }
    __device__ __forceinline__ float* rcos() const { return (float*)(A->ws + WS_ROPE); }
    __device__ __forceinline__ float* rsin() const { return (float*)(A->ws + WS_ROPE + TLAT * 16 * 4); }
    __device__ __forceinline__ bf16* winT() const { return (bf16*)(A->ws + WS_WIN); }
    __device__ __forceinline__ bf16* woutT() const { return (bf16*)(A->ws + WS_WOUT); }
    __device__ __forceinline__ bf16* wqbT() const { return (bf16*)(A->ws + WS_WQB); }
    __device__ __forceinline__ bf16* wkvbT() const { return (bf16*)(A->ws + WS_WKVB); }
    __device__ __forceinline__ bf16* wgu(int par = 0) const { return (bf16*)(A->ws + (par ? WS_WGU2 : WS_WGU)); }
    __device__ __forceinline__ bf16* wd(int par = 0) const { return (bf16*)(A->ws + (par ? WS_WD2 : WS_WD)); }
    __device__ __forceinline__ float* hc() const { return (float*)(A->ws + WS_HC); }
    __device__ __forceinline__ bf16* abuf() const { return (bf16*)(A->ws + WS_A); }
    __device__ __forceinline__ bf16* pbuf() const { return (bf16*)(A->ws + WS_P); }
    __device__ __forceinline__ bf16* act() const { return (bf16*)(A->ws + WS_ACT); }
    __device__ __forceinline__ bf16* yk() const { return (bf16*)(A->ws + WS_YK); }
    __device__ __forceinline__ bf16* mix() const { return (bf16*)(A->ws + WS_MIX); }
    __device__ __forceinline__ bf16* qna() const { return (bf16*)(A->ws + WS_QNA); }
    __device__ __forceinline__ bf16* kna() const { return (bf16*)(A->ws + WS_KNA); }
    __device__ __forceinline__ bf16* vna() const { return (bf16*)(A->ws + WS_VNA); }
    __device__ __forceinline__ bf16* qml() const { return (bf16*)(A->ws + WS_QML); }
    __device__ __forceinline__ bf16* kml() const { return (bf16*)(A->ws + WS_KML); }
    __device__ __forceinline__ bf16* vml() const { return (bf16*)(A->ws + WS_VML); }
    __device__ __forceinline__ bf16* qdf() const { return (bf16*)(A->ws + WS_QDF); }
    __device__ __forceinline__ bf16* kdf() const { return (bf16*)(A->ws + WS_KDF); }
    __device__ __forceinline__ bf16* vdf() const { return (bf16*)(A->ws + WS_VDF); }
    __device__ __forceinline__ bf16* xT() const { return (bf16*)(A->ws + WS_XT); }
    __device__ __forceinline__ bf16* btm() const { return (bf16*)(A->ws + WS_BTM); }
    __device__ __forceinline__ bf16* bT() const { return (bf16*)(A->ws + WS_BT); }
    __device__ __forceinline__ bf16* ctm() const { return (bf16*)(A->ws + WS_CTM); }
    __device__ __forceinline__ float* dtv() const { return (float*)(A->ws + WS_DT); }
    __device__ __forceinline__ float* cst() const { return (float*)(A->ws + WS_CST); }
    __device__ __forceinline__ float* cdec() const { return (float*)(A->ws + WS_CDEC); }
    __device__ __forceinline__ bf16* hent() const { return (bf16*)(A->ws + WS_HENT); }
    __device__ __forceinline__ float* ydir() const { return (float*)(A->ws + WS_CST); }
    __device__ __forceinline__ int* rte() const { return (int*)(A->ws + WS_RT); }
    __device__ __forceinline__ float* rtw() const { return (float*)(A->ws + WS_RT + 256 * 1024); }
    __device__ __forceinline__ int* elist() const { return (int*)(A->ws + WS_ELIST); }
};

__device__ __forceinline__ Fr refresh(const Fr& F0) { Fr F = F0; int w = F0.wave; asm volatile("" : "+s"(w)); asm volatile("" : "+s"(F.A));
    int l; asm volatile("v_mbcnt_lo_u32_b32 %0, -1, 0\n\tv_mbcnt_hi_u32_b32 %0, -1, %0" : "=v"(l)); F.wave = w; F.lane = l; F.tid = w * 64 + l; F.gw = F.vcu * 8 + w; return F; }
__device__ __forceinline__ void tr_item(const float* W, int ldw, int nvalid, int k0, int n0, bf16* dst, int ldd, LAS float* scr, int lane, const float* ksc = nullptr) {
    const int cn = n0 + (lane & 31), cnc = min(cn, nvalid - 1);
    float tv[32];
#pragma unroll
    for (int i = 0; i < 32; ++i) { const int kk = 2 * i + (lane >> 5); tv[i] = W[(size_t)(k0 + kk) * ldw + cnc]; }
#pragma unroll
    for (int i = 0; i < 32; ++i) { const int kk = 2 * i + (lane >> 5); const float sc1 = ksc ? ksc[k0 + kk] : 1.f; scr[kk * 33 + (lane & 31)] = cn < nvalid ? tv[i] * sc1 : 0.f; }
    LDS_WAIT();
    const int c = lane & 7;
#pragma unroll
    for (int j = 0; j < 4; ++j) { const int n = (lane >> 3) + 8 * j; const LAS float* s = scr + (8 * c) * 33 + n;
        u32x4 o; o.x = pk2(s[0 * 33], s[1 * 33]); o.y = pk2(s[2 * 33], s[3 * 33]); o.z = pk2(s[4 * 33], s[5 * 33]); o.w = pk2(s[6 * 33], s[7 * 33]);
        *(u32x4*)(dst + (size_t)n * ldd + k0 + 8 * c) = o; }
    LDS_WAIT();
}
__device__ __forceinline__ void moe_weight_convert(const Fr& F, int L, int gw0 = -1, int ngw0 = 0) {
    LAS float* scr = (LAS float*)(F.lds + F.wave * 16384);
    const int gwc = gw0 >= 0 ? gw0 : F.gw, ngwc = gw0 >= 0 ? ngw0 : F.NGW; bf16* const wgu_ = F.wgu(L & 1); bf16* const wd_ = F.wd(L & 1);
    constexpr int I_GU = 16 * 16, I_D = 8 * 32;
    for (int it = gwc; it < NEXP * (2 * I_GU + I_D); it += ngwc) {
        const int e = it / (2 * I_GU + I_D); int r = it % (2 * I_GU + I_D);
        if (r < 2 * I_GU) { const int bj = r / I_GU; r %= I_GU; const int kb = r / 16, nb = r % 16, n0 = nb * 32;
            const float* W = (bj ? F.w_up() : F.w_gate()) + ((size_t)L * NEXP + e) * DM * FF;
            tr_item(W, FF, FF, kb * 64, n0, wgu_ + ((size_t)e * 1024 + (n0 >> 7) * 256 + bj * 128 + (n0 & 127)) * DM, DM, scr, F.lane);
        } else { r -= 2 * I_GU; const int kb = r / 32, nb = r % 32, n0 = nb * 32;
            const float* W = F.w_down() + ((size_t)L * NEXP + e) * FF * DM;
            tr_item(W, DM, DM, kb * 64, n0, wd_ + ((size_t)e * 1024 + n0) * FF, FF, scr, F.lane); }
    }
}
__device__ __forceinline__ void phase_prologue(const Fr& F) {
    {   LAS float* sc = (LAS float*)F.lds;
        LAS float* part = (LAS float*)(F.lds + 40960);
        for (int i = F.tid; i < 9 * 1024; i += 512) { const float v = i < 8192 ? F.cvec()[i] : F.cctx()[i - 8192]; sc[i] = siluf(v); }
        __syncthreads();
        for (int u = F.vcu; u < 384; u += F.G) {
            const int col = u * 64 + F.lane, L = col / 6144, n = col - L * 6144;
            const float* w = F.w_mod() + ((size_t)L * 1024 + F.wave * 128) * 6144 + n;
            float acc[9];
#pragma unroll
            for (int b = 0; b < 9; ++b) acc[b] = 0.f;
#pragma unroll 1
            for (int k0 = 0; k0 < 128; k0 += 16) { float wv[16];
#pragma unroll
                for (int j = 0; j < 16; ++j) wv[j] = w[(size_t)(k0 + j) * 6144];
#pragma unroll
                for (int j = 0; j < 16; ++j)
#pragma unroll
                    for (int b = 0; b < 9; ++b) acc[b] += sc[b * 1024 + F.wave * 128 + k0 + j] * wv[j]; }
#pragma unroll
            for (int b = 0; b < 9; ++b) part[(F.wave * 9 + b) * 64 + F.lane] = acc[b];
            __syncthreads();
            for (int i = F.tid; i < 9 * 64; i += 512) { const int b = i >> 6, l = i & 63; float s = 0.f;
#pragma unroll
                for (int w8 = 0; w8 < 8; ++w8) s += part[(w8 * 9 + b) * 64 + l];
                const int c2 = u * 64 + l, L2 = c2 / 6144, n2 = c2 - L2 * 6144;
                F.modv()[((size_t)L2 * 9 + b) * 6144 + n2] = s + F.b_mod()[L2 * 6144 + n2]; }
            __syncthreads();
        }
    }
    if (blockIdx.x == 0 && F.wave < 4) {
#pragma unroll 1
        for (int q = 0; q < 4; ++q) { const int lh = F.wave * 4 + q; float bm = 0.f;
            for (int i = F.lane; i < 465; i += 64) bm = fmaxf(bm, F.na_rb()[lh * 465 + i]);
            bm = wmaxf(bm); if (F.lane == 0) (F.rcos() + 2 * TLAT * 16)[lh] = bm * 1.4426950408889634f; } }
    for (int i = blockIdx.x * 512 + F.tid; i < TLAT * 16; i += F.G * 512) { const int t = i >> 4, k = i & 15; const float inv = powf(10000.f, -(float)(k & 7) / 8.f);
        const float pos = (k < 8) ? (float)(t >> 6) : (float)(t & 63); const float ang = pos * inv; F.rcos()[i] = cosf(ang); F.rsin()[i] = sinf(ang); }
    __syncthreads();
    LAS float* scr = (LAS float*)(F.lds + F.wave * 16384);
    constexpr int I_IN = 16 * 96, I_OUT = 16 * 32, I_QB = 4 * 12, I_KVB = 2 * 16, I_L = I_IN + I_OUT + I_QB + I_KVB;
    for (int it = F.gw; it < DEPTH * I_L; it += F.NGW) {
        const int L = it / I_L; int r = it % I_L;
        if (r < I_IN) { const int kb = r / 96, nb = r % 96; tr_item(F.w_in() + (size_t)L * DM * NIN, NIN, NIN, kb * 64, nb * 32, F.winT() + ((size_t)L * NP + nb * 32) * DM, DM, scr, F.lane); continue; } r -= I_IN;
        if (r < I_OUT) { const int kb = r / 32, nb = r % 32; tr_item(F.w_out() + (size_t)L * DM * DM, DM, DM, kb * 64, nb * 32, F.woutT() + ((size_t)L * DM + nb * 32) * DM, DM, scr, F.lane); continue; } r -= I_OUT;
        if (r < I_QB) { const int kb = r / 12, nb = r % 12; tr_item(F.mla_wqb() + (size_t)L * 256 * 384, 384, 384, kb * 64, nb * 32, F.wqbT() + ((size_t)L * 384 + nb * 32) * 256, 256, scr, F.lane, F.mla_gqa() + L * 256); continue; } r -= I_QB;
        { const int kb = r / 16, nb = r % 16; tr_item(F.mla_wkvb() + (size_t)L * 128 * 512, 512, 512, kb * 64, nb * 32, F.wkvbT() + ((size_t)L * 512 + nb * 32) * 128, 128, scr, F.lane, F.mla_gkva() + L * 128); }
    }
}

__device__ __forceinline__ void phase_norm(const Fr& F, int L, bool combine = true) {
    const int nrows = (L == DEPTH) ? NLAT : NROW;
    for (int r = F.gw; r < nrows; r += F.NGW) {
        const bool lat = r < NLAT; const int bb = lat ? (r >> 11) : 8;
        const float* hin = (L == 0) ? (lat ? F.x() + (size_t)r * DM : F.ctx() + (size_t)(r - NLAT) * DM) : (lat ? F.out() + (size_t)r * DM : F.hc() + (size_t)(r - NLAT) * DM);
        float* hout = lat ? F.out() + (size_t)r * DM : F.hc() + (size_t)(r - NLAT) * DM;
        f32x4 v[4];
#pragma unroll
        for (int j = 0; j < 4; ++j) v[j] = *(const f32x4*)(hin + 4 * F.lane + 256 * j);
        if (L > 0 && combine) {
            const float* m5 = F.modv() + ((size_t)(L - 1) * 9 + bb) * 6144 + 5 * 1024;
#pragma unroll
            for (int j = 0; j < 4; ++j) { const int c = 4 * F.lane + 256 * j; const f32x4 g = *(const f32x4*)(m5 + c);
                const u32x2 y0 = *(const u32x2*)(F.yk() + (size_t)(2 * r) * DM + c), y1 = *(const u32x2*)(F.yk() + (size_t)(2 * r + 1) * DM + c);
                f32x4 ys; ys[0] = __uint_as_float(y0.x << 16) + __uint_as_float(y1.x << 16); ys[1] = __uint_as_float(y0.x & 0xffff0000u) + __uint_as_float(y1.x & 0xffff0000u);
                ys[2] = __uint_as_float(y0.y << 16) + __uint_as_float(y1.y << 16); ys[3] = __uint_as_float(y0.y & 0xffff0000u) + __uint_as_float(y1.y & 0xffff0000u);
                v[j] = v[j] + g * ys; *(f32x4*)(hout + c) = v[j]; }
        }
        if (L == DEPTH) continue;
        float ss = 0.f;
#pragma unroll
        for (int j = 0; j < 4; ++j) ss += (v[j][0] * v[j][0] + v[j][1] * v[j][1]) + (v[j][2] * v[j][2] + v[j][3] * v[j][3]);
        const float rstd = rsqrtf(wsum(ss) * (1.f / DM) + EPS);
        const float* md = F.modv() + ((size_t)L * 9 + bb) * 6144;
#pragma unroll
        for (int j = 0; j < 4; ++j) { const int c = 4 * F.lane + 256 * j; const f32x4 g = *(const f32x4*)(F.g_mix() + L * DM + c), sh = *(const f32x4*)(md + c), scl = *(const f32x4*)(md + 1024 + c);
            const f32x4 a = v[j] * rstd * g * (scl + 1.f) + sh; u32x2 o; o.x = pk2(a[0], a[1]); o.y = pk2(a[2], a[3]); *(u32x2*)(F.abuf() + (size_t)r * DM + c) = o; }
    }
}

__device__ __forceinline__ void prep_row(const Fr& F, int L, int r, LAS float* scr) {
    int lane_ = F.lane; asm volatile("" : "+v"(lane_)); const int lane = lane_; int b, s; row2bs(r, b, s); const bool lat = r < NLAT; const int t = s - 256;
    const bf16* p = F.pbuf() + (size_t)r * NP;
#pragma unroll
    for (int h = 0; h < 4; ++h) {
        const float q = bf2f(p[C_NA + h * 64 + lane]), k = bf2f(p[C_NA + 256 + h * 64 + lane]);
        const float rq = rsqrtf(wsum(q * q) * (1.f / 64) + EPS), rk = rsqrtf(wsum(k * k) * (1.f / 64) + EPS);
        const size_t o = ((size_t)(b * 4 + h) * SQ + s) * 64 + lane;
        F.qna()[o] = f2bf(q * rq * F.na_gq()[L * 64 + lane]); F.kna()[o] = f2bf(k * rk * F.na_gk()[L * 64 + lane]);
    }
    {
        const int idx = lane & 31; float cs = 1.f, sn = 0.f;
        if (lat) { cs = F.rcos()[t * 16 + (idx & 15)]; sn = F.rsin()[t * 16 + (idx & 15)]; }
#pragma unroll
        for (int h = 0; h < 4; ++h) {
            float q = bf2f(p[C_DF + h * 64 + lane]), k = bf2f(p[C_DF + 256 + h * 64 + lane]);
            float sq = q * q, sk = k * k;
#pragma unroll
            for (int o = 16; o >= 1; o >>= 1) { sq += __shfl_xor(sq, o); sk += __shfl_xor(sk, o); }
            q *= rsqrtf(sq * (1.f / 32) + EPS) * F.df_gq()[L * 32 + idx]; k *= rsqrtf(sk * (1.f / 32) + EPS) * F.df_gk()[L * 32 + idx];
            const float qp = __shfl_xor(q, 16), kp = __shfl_xor(k, 16);
            if (lat) { q = (idx < 16) ? q * cs - qp * sn : qp * sn + q * cs; k = (idx < 16) ? k * cs - kp * sn : kp * sn + k * cs; }
            const size_t o = ((size_t)(b * 4 + h) * SQ + s) * 64 + lane;
            F.qdf()[o] = f2bf(q); F.kdf()[o] = f2bf(k);
        }
    }
}
__device__ __forceinline__ void prep_tile(const Fr& F, int L, int b, int c) {
    int tid_ = F.tid; asm volatile("" : "+v"(tid_)); const int tid = tid_;
    const int s0 = 64 * c; const size_t r0 = bs2row(b, s0);
    LAS bf16* Lv = (LAS bf16*)F.lds;
#ifndef PT_MASK
#define PT_MASK 7
#endif
    if (PT_MASK & 1)
#pragma unroll 1
    for (int mx = 0; mx < 2; ++mx) {
        const int voff = mx == 0 ? C_NA + 512 : C_DF + 512; bf16* vt = mx == 0 ? F.vna() : F.vdf();
#pragma unroll
        for (int k = 0; k < 4; ++k) { const int idx = tid + 512 * k, tok = idx >> 5, d8 = (idx & 31) * 8;
            const u32x4 v = *(const u32x4*)(F.pbuf() + (r0 + tok) * NP + voff + d8); const int pc = vpos(tok);
#pragma unroll
            for (int e = 0; e < 4; ++e) { Lv[(d8 + 2 * e) * 72 + pc] = (bf16)(v[e] & 0xffffu); Lv[(d8 + 2 * e + 1) * 72 + pc] = (bf16)(v[e] >> 16); } }
        __syncthreads();
#pragma unroll
        for (int k = 0; k < 4; ++k) { const int idx = tid + 512 * k, dv = idx >> 3, pc = idx & 7;
            const u32x4 v = *(const LAS u32x4*)(Lv + dv * 72 + pc * 8);
#ifndef PT_NOSTORE
#define PT_NOSTORE 0
#endif
            if (!PT_NOSTORE || v.x == 0x12345678u) *(u32x4*)(vt + ((size_t)(b * 4 + (dv >> 6)) * 64 + (dv & 63)) * SQ + s0 + pc * 8) = v; }
        __syncthreads();
    }
    const int len = c < 4 ? TCTX : TLAT, t0 = c < 4 ? s0 : s0 - 256;
    LAS bf16* Lc = (LAS bf16*)F.lds;
    if (PT_MASK & 2)
#pragma unroll 1
    for (int gch = 0; gch < 3; ++gch) {
        {   u32x4 v[5];
#pragma unroll
            for (int k = 0; k < 5; ++k) { const int idx = min(tid + 512 * k, 68 * 32 - 1), j = idx >> 5, c8 = (idx & 31) * 8, tj = t0 - 2 + j, jc = min(max(tj, 0), len - 1) - t0;
                v[k] = *(const u32x4*)(F.pbuf() + (size_t)((long)r0 + jc) * NP + C_XBC + gch * 256 + c8);
                const unsigned keep = (tj >= 0 && tj < len) ? 0xffffffffu : 0u; v[k].x &= keep; v[k].y &= keep; v[k].z &= keep; v[k].w &= keep; }
#pragma unroll
            for (int k = 0; k < 5; ++k) { const int idx = tid + 512 * k, j = idx >> 5, c8 = (idx & 31) * 8; if (idx < 68 * 32) *(LAS u32x4*)(Lc + j * 256 + c8) = v[k]; }
        }
        __syncthreads();
        const int ch = tid & 255, tq = tid >> 8, cg = gch * 256 + ch;
        float w[5];
#pragma unroll
        for (int j = 0; j < 5; ++j) w[j] = F.conv_w()[(L * 5 + j) * 768 + cg];
        const float bias = F.conv_b()[L * 768 + cg];
        const LAS bf16* lp = Lc + (32 * tq) * 256 + ch;
        float x0 = bf2f(lp[0]), x1 = bf2f(lp[256]), x2 = bf2f(lp[512]), x3 = bf2f(lp[768]);
        bf16* tm = (gch == 1 ? F.btm() : F.ctm()) + ((size_t)b * SQ + s0 + 32 * tq) * 256 + ch;
        bf16* cm = (gch == 0 ? F.xT() : F.bT()) + ((size_t)b * 256 + ch) * SQ + s0 + 32 * tq;
#pragma unroll
        for (int g8 = 0; g8 < 4; ++g8) { unsigned pk[4];
#pragma unroll
            for (int e = 0; e < 8; ++e) { const int i = 8 * g8 + e; const float x4 = bf2f(lp[(i + 4) * 256]);
                const float acc = bias + w[0] * x0 + w[1] * x1 + w[2] * x2 + w[3] * x3 + w[4] * x4; const unsigned o = f2bf(siluf(acc));
                if (gch >= 1) tm[(size_t)i * 256] = (bf16)o;
                if (e & 1) pk[e >> 1] |= o << 16; else pk[e >> 1] = o;
                x0 = x1; x1 = x2; x2 = x3; x3 = x4; }
            if (gch <= 1) { u32x4 v; v.x = pk[0]; v.y = pk[1]; v.z = pk[2]; v.w = pk[3]; *(u32x4*)(cm + 8 * g8) = v; } }
        __syncthreads();
    }
    if (PT_MASK & 4) { const int tok = tid >> 3, i = tid & 7; const float raw = bf2f(F.pbuf()[(r0 + tok) * NP + C_DT + i]) + F.dt_bias()[L * 8 + i]; const float ex = __expf(raw);
      F.dtv()[((size_t)b * 8 + i) * SQ + s0 + tok] = raw > 20.f ? raw : (ex < 0.03f ? ex * (1.f - ex * (0.5f - ex * (0.33333334f - 0.25f * ex))) : __logf(1.f + ex)); }
}
__device__ __forceinline__ void mla_prep_block(const Fr& F, int L, int b, int j32) {
    int lane_ = F.lane; asm volatile("" : "+v"(lane_));
    const int lane = lane_, wave = F.wave, r = lane & 31, hh = lane >> 5, s = 32 * j32 + r, t = s - 256; const bool lat = s >= 256;
    const size_t row = bs2row(b, s);
    const bf16* p = F.pbuf() + row * NP + C_MLA;
    const int tt = lat ? t : 0; const float latf = lat ? 1.f : 0.f;
    if (wave < 4) {
        const int hq = wave;
        bf16x8 Bq[16]; float ss = 0.f;
#pragma unroll
        for (int kk = 0; kk < 16; ++kk) { Bq[kk] = *(const bf16x8*)(p + 16 * kk + 8 * hh);
#pragma unroll
            for (int j = 0; j < 8; ++j) { const float v = bf2f((bf16)Bq[kk][j]); ss += v * v; } }
        ss += __shfl_xor(ss, 32); const float rq = rsqrtf(ss * (1.f / 256) + EPS);
        f32x16 acc[3]; float hs = 0.f;
#pragma unroll
        for (int j3 = 0; j3 < 3; ++j3) {
#pragma unroll
            for (int i = 0; i < 16; ++i) acc[j3][i] = 0.f;
            const bf16* wp = F.wqbT() + ((size_t)L * 384 + 96 * hq + 32 * j3 + r) * 256 + 8 * hh;
#pragma unroll
            for (int kk = 0; kk < 16; ++kk) acc[j3] = MFMA32(*(const bf16x8*)(wp + 16 * kk), Bq[kk], acc[j3]);
            asm volatile("" ::: "memory");
#pragma unroll
            for (int i = 0; i < 16; ++i) hs += acc[j3][i] * acc[j3][i]; }
        hs = (hs + __shfl_xor(hs, 32)) * rq * rq; const float rs = rsqrtf(hs * (1.f / 96) + EPS) * rq;
        bf16* qo = F.qml() + ((size_t)(b * 4 + hq) * SQ + s) * 96 + 4 * hh;
#pragma unroll
        for (int j3 = 0; j3 < 3; ++j3) {
#pragma unroll
            for (int i = 0; i < 16; ++i) acc[j3][i] *= rs * F.mla_gq()[L * 96 + 32 * j3 + crow16(i, hh)];
            if (j3 == 2) {
#pragma unroll
                for (int i = 0; i < 8; ++i) { const float rc = lat ? F.rcos()[tt * 16 + crow16(i, hh)] : 1.f, rsn = F.rsin()[tt * 16 + crow16(i, hh)] * latf;
                    const float x1 = acc[2][i], x2 = acc[2][i + 8]; acc[2][i] = x1 * rc - x2 * rsn; acc[2][i + 8] = x1 * rsn + x2 * rc; } }
#pragma unroll
            for (int g = 0; g < 4; ++g) { u32x2 w; w.x = pk2(acc[j3][4 * g], acc[j3][4 * g + 1]); w.y = pk2(acc[j3][4 * g + 2], acc[j3][4 * g + 3]); *(u32x2*)(qo + 32 * j3 + 8 * g) = w; } }
    } else {
        const int hk = wave - 4;
        LAS unsigned char* wl = F.lds + wave * 16384;
        bf16x8 Bkv[8]; float ss = 0.f;
#pragma unroll
        for (int kk = 0; kk < 8; ++kk) { Bkv[kk] = *(const bf16x8*)(p + 256 + 16 * kk + 8 * hh);
#pragma unroll
            for (int j = 0; j < 8; ++j) { const float v = bf2f((bf16)Bkv[kk][j]); ss += v * v; } }
        ss += __shfl_xor(ss, 32); const float rk = rsqrtf(ss * (1.f / 128) + EPS);
        float kr[16]; float hs = 0.f;
#pragma unroll
        for (int g = 0; g < 4; ++g) { const u32x2 k4 = *(const u32x2*)(p + 384 + 8 * g + 4 * hh);
            kr[4 * g] = __uint_as_float(k4.x << 16); kr[4 * g + 1] = __uint_as_float(k4.x & 0xffff0000u); kr[4 * g + 2] = __uint_as_float(k4.y << 16); kr[4 * g + 3] = __uint_as_float(k4.y & 0xffff0000u); }
#pragma unroll
        for (int i = 0; i < 16; ++i) hs += kr[i] * kr[i];
        f32x16 acc[4]; float ks = 0.f;
#pragma unroll
        for (int j4 = 0; j4 < 4; ++j4) {
#pragma unroll
            for (int i = 0; i < 16; ++i) acc[j4][i] = 0.f;
            const bf16* wp = F.wkvbT() + ((size_t)L * 512 + 128 * hk + 32 * j4 + r) * 128 + 8 * hh;
#pragma unroll
            for (int kk = 0; kk < 8; ++kk) acc[j4] = MFMA32(*(const bf16x8*)(wp + 16 * kk), Bkv[kk], acc[j4]);
            asm volatile("" ::: "memory");
            if (j4 < 2) {
#pragma unroll
                for (int i = 0; i < 16; ++i) ks += acc[j4][i] * acc[j4][i]; } }
        hs += ks * rk * rk; hs += __shfl_xor(hs, 32); const float rs = rsqrtf(hs * (1.f / 96) + EPS);
        bf16* ko = F.kml() + ((size_t)(b * 4 + hk) * SQ + s) * 96 + 4 * hh;
#pragma unroll
        for (int j2 = 0; j2 < 2; ++j2) {
#pragma unroll
            for (int i = 0; i < 16; ++i) acc[j2][i] *= rs * rk * F.mla_gk()[L * 96 + 32 * j2 + crow16(i, hh)];
#pragma unroll
            for (int g = 0; g < 4; ++g) { u32x2 w; w.x = pk2(acc[j2][4 * g], acc[j2][4 * g + 1]); w.y = pk2(acc[j2][4 * g + 2], acc[j2][4 * g + 3]); *(u32x2*)(ko + 32 * j2 + 8 * g) = w; } }
#pragma unroll
        for (int i = 0; i < 16; ++i) kr[i] *= rs * F.mla_gk()[L * 96 + 64 + crow16(i, hh)];
#pragma unroll
        for (int i = 0; i < 8; ++i) { const float rc = lat ? F.rcos()[tt * 16 + crow16(i, hh)] : 1.f, rsn = F.rsin()[tt * 16 + crow16(i, hh)] * latf;
            const float x1 = kr[i], x2 = kr[i + 8]; kr[i] = x1 * rc - x2 * rsn; kr[i + 8] = x1 * rsn + x2 * rc; }
#pragma unroll
        for (int g = 0; g < 4; ++g) { u32x2 w; w.x = pk2(kr[4 * g], kr[4 * g + 1]); w.y = pk2(kr[4 * g + 2], kr[4 * g + 3]); *(u32x2*)(ko + 64 + 8 * g) = w; }
        { float n2 = 0.f;
#pragma unroll
          for (int i = 0; i < 16; ++i) n2 += acc[0][i] * acc[0][i] + acc[1][i] * acc[1][i] + kr[i] * kr[i];
          n2 += __shfl_xor(n2, 32); n2 = wmaxf(n2);
          if (lane == 0) atomicMax(F.ctl() + CW_KMAX + ((L * 3 + 1) * 8 + b) * 8 + hk * 2, __float_as_uint(n2 * 1.02f)); }
        LAS bf16* vl = (LAS bf16*)wl;
#pragma unroll
        for (int mt = 0; mt < 2; ++mt)
#pragma unroll
            for (int i = 0; i < 16; ++i) vl[(32 * mt + crow16(i, hh)) * 40 + vpos(r)] = f2bf(acc[2 + mt][i] * rk);
        LDS_WAIT();
        { const LAS u32x4* src4 = (const LAS u32x4*)(wl + lane * 80); u32x4* dst = (u32x4*)(F.vml() + ((size_t)(b * 4 + hk) * 64 + lane) * SQ + 32 * j32);
#pragma unroll
          for (int q = 0; q < 4; ++q) dst[q] = src4[q]; }
        LDS_WAIT();
    }
}
__device__ __forceinline__ int grab_unit(const Fr& F, unsigned* ctr) {
    volatile LAS int* slot = (volatile LAS int*)(F.lds + LDSCTL_OFF + 256);
    __syncthreads();
    if (F.tid == 0) *slot = (int)__hip_atomic_fetch_add(ctr, 1u, __ATOMIC_RELAXED, __HIP_MEMORY_SCOPE_AGENT);
    __syncthreads();
    return __builtin_amdgcn_readfirstlane(*slot);
}
__device__ __forceinline__ void prep_qk(const Fr& F, int L, int b, int j32) {
    int lane_ = F.lane; asm volatile("" : "+v"(lane_)); const int l = lane_, h = l >> 4;
    u32x2 raw[4][4];
#pragma unroll
    for (int i = 0; i < 4; ++i) { const int s = 32 * j32 + 4 * F.wave + i; const bf16* p = F.pbuf() + (size_t)bs2row(b, s) * NP + 4 * l;
        raw[i][0] = *(const u32x2*)(p + C_NA); raw[i][1] = *(const u32x2*)(p + C_NA + 256); raw[i][2] = *(const u32x2*)(p + C_DF); raw[i][3] = *(const u32x2*)(p + C_DF + 256); }
    const f32x4 gnq = *(const f32x4*)(F.na_gq() + L * 64 + 4 * (l & 15)), gnk = *(const f32x4*)(F.na_gk() + L * 64 + 4 * (l & 15));
    const f32x4 gdq = *(const f32x4*)(F.df_gq() + L * 32 + 4 * (l & 7)), gdk = *(const f32x4*)(F.df_gk() + L * 32 + 4 * (l & 7));
    float kmx_na = 0.f, kmx_df = 0.f;
#pragma unroll
    for (int i = 0; i < 4; ++i) { const int s = 32 * j32 + 4 * F.wave + i, t = s - 256; const bool lat = s >= 256;
#pragma unroll
        for (int w = 0; w < 4; ++w) {
            f32x4 x; x[0] = __uint_as_float(raw[i][w].x << 16); x[1] = __uint_as_float(raw[i][w].x & 0xffff0000u); x[2] = __uint_as_float(raw[i][w].y << 16); x[3] = __uint_as_float(raw[i][w].y & 0xffff0000u);
            float ss = (x[0] * x[0] + x[1] * x[1]) + (x[2] * x[2] + x[3] * x[3]);
            ss += dppf<0xB1>(ss); ss += dppf<0x4E>(ss); ss += dppf<0x141>(ss);
            if (w < 2) { ss += dppf<0x140>(ss);
                const float rs = rsqrtf(ss * (1.f / 64) + EPS); const f32x4 g = w == 0 ? gnq : gnk; x = x * rs * g;
                u32x2 o; o.x = pk2(x[0], x[1]); o.y = pk2(x[2], x[3]);
                if (w == 1) { float n2 = (x[0] * x[0] + x[1] * x[1]) + (x[2] * x[2] + x[3] * x[3]); n2 += dppf<0xB1>(n2); n2 += dppf<0x4E>(n2); n2 += dppf<0x141>(n2); n2 += dppf<0x140>(n2); kmx_na = fmaxf(kmx_na, n2); }
                *(u32x2*)((w == 0 ? F.qna() : F.kna()) + ((size_t)(b * 4 + h) * SQ + s) * 64 + 4 * (l & 15)) = o;
            } else {
                const float rs = rsqrtf(ss * (1.f / 32) + EPS); const f32x4 g = w == 2 ? gdq : gdk; x = x * rs * g;
                f32x4 xp; xp[0] = __shfl_xor(x[0], 4); xp[1] = __shfl_xor(x[1], 4); xp[2] = __shfl_xor(x[2], 4); xp[3] = __shfl_xor(x[3], 4);
                if (lat) { const f32x4 cs = *(const f32x4*)(F.rcos() + t * 16 + 4 * (l & 3)), sn = *(const f32x4*)(F.rsin() + t * 16 + 4 * (l & 3));
                    x = (l & 4) ? xp * sn + x * cs : x * cs - xp * sn; }
                u32x2 o; o.x = pk2(x[0], x[1]); o.y = pk2(x[2], x[3]);
                if (w == 3) { float n2 = (x[0] * x[0] + x[1] * x[1]) + (x[2] * x[2] + x[3] * x[3]); n2 += dppf<0xB1>(n2); n2 += dppf<0x4E>(n2); n2 += dppf<0x141>(n2); kmx_df = fmaxf(kmx_df, n2); }
                *(u32x2*)((w == 2 ? F.qdf() : F.kdf()) + ((size_t)(b * 4 + h) * SQ + s) * 64 + 4 * (l & 15)) = o;
            } } }
    if ((l & 15) == 0) atomicMax(F.ctl() + CW_KMAX + ((L * 3 + 0) * 8 + b) * 8 + h * 2, __float_as_uint(kmx_na * 1.02f));
    if ((l & 7) == 0) atomicMax(F.ctl() + CW_KMAX + ((L * 3 + 2) * 8 + b) * 8 + h * 2 + ((l >> 3) & 1), __float_as_uint(kmx_df * 1.02f));
}
__device__ __forceinline__ void prep_vconv(const Fr& F, int L, int b, int j32) {
    int tid_ = F.tid; asm volatile("; VCONV_BEGIN" : "+v"(tid_)); const int tid = tid_;
    const int s0 = 32 * j32; const size_t r0 = bs2row(b, s0);
    LAS bf16* Lv = (LAS bf16*)F.lds;
#ifndef VC_MASK
#define VC_MASK 7
#endif
    if (VC_MASK & 1) {   u32x4 v[4];
#pragma unroll
        for (int k = 0; k < 4; ++k) { const int idx = tid + 512 * k, mx = idx >> 10, tok = (idx >> 5) & 31, d8 = (idx & 31) * 8;
            v[k] = *(const u32x4*)(F.pbuf() + (r0 + tok) * NP + (mx ? C_DF + 512 : C_NA + 512) + d8); }
#pragma unroll
        for (int k = 0; k < 4; ++k) { const int idx = tid + 512 * k, mx = idx >> 10, tok = (idx >> 5) & 31, d8 = (idx & 31) * 8, pc = vpos(tok);
#pragma unroll
            for (int e = 0; e < 4; ++e) { Lv[(mx * 256 + d8 + 2 * e) * 40 + pc] = (bf16)(v[k][e] & 0xffffu); Lv[(mx * 256 + d8 + 2 * e + 1) * 40 + pc] = (bf16)(v[k][e] >> 16); } }
        __syncthreads();
#pragma unroll
        for (int k = 0; k < 4; ++k) { const int idx = tid + 512 * k, mx = idx >> 10, dv = (idx >> 2) & 255, pc = idx & 3;
            const u32x4 w = *(const LAS u32x4*)(Lv + (mx * 256 + dv) * 40 + pc * 8);
            *(u32x4*)((mx ? F.vdf() : F.vna()) + ((size_t)(b * 4 + (dv >> 6)) * 64 + (dv & 63)) * SQ + s0 + pc * 8) = w; }
        __syncthreads();
    }
    const bool isctx = s0 < 256; const int len = isctx ? TCTX : TLAT, t0 = isctx ? s0 : s0 - 256;
    LAS bf16* Lc = (LAS bf16*)F.lds;
    if (VC_MASK & 2) {   u32x4 v[7];
#pragma unroll
        for (int k = 0; k < 7; ++k) { const int idx = tid + 512 * k, j = idx / 96, c8 = (idx - 96 * j) * 8, tj = t0 - 2 + j; const int jc = min(max(tj, 0), len - 1) - t0;
            v[k] = (u32x4){0u, 0u, 0u, 0u};
            if (idx < 36 * 96) { v[k] = *(const u32x4*)(F.pbuf() + (size_t)((long)r0 + jc) * NP + C_XBC + c8); if (tj < 0 || tj >= len) v[k] = (u32x4){0u, 0u, 0u, 0u}; } }
#pragma unroll
        for (int k = 0; k < 7; ++k) { const int idx = tid + 512 * k, j = idx / 96, c8 = (idx - 96 * j) * 8; if (idx < 36 * 96) *(LAS u32x4*)(Lc + j * 768 + c8) = v[k]; }
    }
    __syncthreads();
    if (VC_MASK & 2)
#pragma unroll 1
    for (int pass = 0; pass < 2; ++pass) {
        const int cg = pass == 0 ? tid : 512 + tid;
        if (cg < 768) {
            float w[5];
#pragma unroll
            for (int j = 0; j < 5; ++j) w[j] = F.conv_w()[(L * 5 + j) * 768 + cg];
            const float bias = F.conv_b()[L * 768 + cg];
            const LAS bf16* lp = Lc + cg;
            float x0 = bf2f(lp[0]), x1 = bf2f(lp[768]), x2 = bf2f(lp[2 * 768]), x3 = bf2f(lp[3 * 768]);
            const int gch = cg >> 8, ch = cg & 255;
            bf16* tm = (gch == 1 ? F.btm() : F.ctm()) + ((size_t)b * SQ + s0) * 256 + ch;
            bf16* cm = (gch == 0 ? F.xT() : F.bT()) + ((size_t)b * 256 + ch) * SQ + s0;
#pragma unroll
            for (int g8 = 0; g8 < 4; ++g8) { unsigned pk[4];
#pragma unroll
                for (int e = 0; e < 8; ++e) { const int i = 8 * g8 + e; const float x4 = bf2f(lp[(i + 4) * 768]);
                    const float acc = bias + w[0] * x0 + w[1] * x1 + w[2] * x2 + w[3] * x3 + w[4] * x4; const unsigned o = f2bf(siluf(acc));
                    if (gch >= 1) tm[(size_t)i * 256] = (bf16)o;
                    if (e & 1) pk[e >> 1] |= o << 16; else pk[e >> 1] = o;
                    x0 = x1; x1 = x2; x2 = x3; x3 = x4; }
                if (gch <= 1) { u32x4 v; v.x = pk[0]; v.y = pk[1]; v.z = pk[2]; v.w = pk[3]; *(u32x4*)(cm + 8 * g8) = v; } }
        }
    }
    if ((VC_MASK & 4) && tid < 256) { const int tok = tid >> 3, i = tid & 7; const float raw = bf2f(F.pbuf()[(r0 + tok) * NP + C_DT + i]) + F.dt_bias()[L * 8 + i]; const float ex = __expf(raw);
      F.dtv()[((size_t)b * 8 + i) * SQ + s0 + tok] = raw > 20.f ? raw : (ex < 0.03f ? ex * (1.f - ex * (0.5f - ex * (0.33333334f - 0.25f * ex))) : __logf(1.f + ex)); }
    __syncthreads();
    asm volatile("; VCONV_END" ::: "memory");
}
__device__ __forceinline__ void phase_prep(const Fr& F0_, int L) {
    unsigned* ctr = F0_.ctl() + CW_QUEUE + (L * 16 + 0) * 64;
    for (;;) {
        const int u = grab_unit(F0_, ctr); if (u >= NB * 72) break;
        const int b = u / 72, j32 = u - 72 * b;
        { const Fr F = refresh(F0_); prep_qk(F, L, b, j32); }
        { const Fr F = refresh(F0_); mla_prep_block(F, L, b, j32); }
        __syncthreads();
    }
    { unsigned* ctr2 = F0_.ctl() + CW_QUEUE + (L * 16 + 2) * 64;
      for (;;) { const int u = grab_unit(F0_, ctr2); if (u >= NB * 36) break; const Fr F3 = refresh(F0_); prep_tile(F3, L, u / 36, u % 36); } }
}

__device__ __forceinline__ void phase_ssd_naive(const Fr& F, int L) {
    if (F.wave != 0 || blockIdx.x >= 64) return;
    const int w = blockIdx.x, b = w >> 3, d = (w >> 2) & 1, h = w & 3, g = h >> 1, p = F.lane;
    const float a = -expf(F.a_log()[L * 8 + d * 4 + h]);
    float hs[128];
#pragma unroll
    for (int n = 0; n < 128; ++n) hs[n] = 0.f;
    const float* dtp = F.dtv() + ((size_t)b * 8 + d * 4 + h) * SQ;
    const bf16* xp = F.xT() + ((size_t)b * 256 + h * 64 + p) * SQ;
    for (int step = 0; step < SQ; ++step) {
        const int s = d == 0 ? step : (step < 256 ? 255 - step : SQ - 1 - (step - 256));
        const float dtv = dtp[s], dA = __expf(dtv * a), xv = bf2f(xp[s]) * dtv;
        const u32x4* Bp = (const u32x4*)(F.btm() + ((size_t)b * SQ + s) * 256 + g * 128);
        const u32x4* Cp = (const u32x4*)(F.ctm() + ((size_t)b * SQ + s) * 256 + g * 128);
        float y = 0.f;
#pragma unroll
        for (int n8 = 0; n8 < 16; ++n8) { const u32x4 bv = Bp[n8], cv = Cp[n8];
#pragma unroll
            for (int j = 0; j < 4; ++j) { const int n = n8 * 8 + 2 * j;
                hs[n] = hs[n] * dA + xv * __uint_as_float(bv[j] << 16); hs[n + 1] = hs[n + 1] * dA + xv * __uint_as_float(bv[j] & 0xffff0000u);
                y += __uint_as_float(cv[j] << 16) * hs[n] + __uint_as_float(cv[j] & 0xffff0000u) * hs[n + 1]; } }
        F.ydir()[((size_t)d * NROW + bs2row(b, s)) * 256 + h * 64 + p] = y;
    }
}

template <int KIND>
__device__ __forceinline__ void naive_attn_job(const Fr& F, int L, int r, int h, LAS float* scr) {
    constexpr int DQ = KIND == 1 ? 96 : (KIND == 0 ? 64 : 32), QS = KIND == 1 ? 96 : 64;
    const int lane = F.lane; int b, s; row2bs(r, b, s); const bool lat = r < NLAT; const int t = s - 256;
    const bf16* Qb = (KIND == 0 ? F.qna() : KIND == 1 ? F.qml() : F.qdf()) + ((size_t)(b * 4 + h) * SQ + s) * QS;
    const bf16* Kb = (KIND == 0 ? F.kna() : KIND == 1 ? F.kml() : F.kdf()) + (size_t)(b * 4 + h) * SQ * QS;
    const bf16* Vt = (KIND == 0 ? F.vna() : KIND == 1 ? F.vml() : F.vdf()) + ((size_t)(b * 4 + h) * 64 + lane) * SQ;
    const float scale = KIND == 1 ? 0.10206207261596577f : (KIND == 0 ? 0.125f : 0.17677669529663687f);
    const int qr = t >> 6, qc = t & 63, row_lo = min(max(qr - 4, 0), 24), col_lo = min(max(qc - 8, 0), 48);
    const bool nb = (KIND == 0) && lat;
    const int nk = lat ? (KIND == 0 ? 768 : SQ) : 256;
    const int koff = nb ? row_lo * 64 : 0;
    float oc[2] = {0.f, 0.f};
#pragma unroll
    for (int comp = 0; comp < (KIND == 2 ? 2 : 1); ++comp) {
        for (int i = lane; i < DQ; i += 64) scr[i] = bf2f(Qb[comp * 32 + i]);
        LDS_WAIT();
        float m = -INFINITY;
        for (int kk = lane; kk < nk; kk += 64) {
            const int sk = kk < 256 ? kk : kk + koff; float bias = 0.f; bool valid = true;
            if (nb && kk >= 256) { const int w = kk - 256, kr = w >> 6, kc = w & 63; valid = kc >= col_lo && kc < col_lo + 16;
                const int ro = row_lo + kr - qr + 7, co = min(max(kc - qc, -15), 15) + 15; bias = F.na_rb()[((L * 4 + h) * 15 + ro) * 31 + co]; }
            const u32x4* kp = (const u32x4*)(Kb + (size_t)sk * QS + (KIND == 2 ? comp * 32 : 0));
            float dot = 0.f;
#pragma unroll
            for (int i8 = 0; i8 < DQ / 8; ++i8) { const u32x4 kv = kp[i8];
#pragma unroll
                for (int j = 0; j < 4; ++j) dot += scr[i8 * 8 + 2 * j] * __uint_as_float(kv[j] << 16) + scr[i8 * 8 + 2 * j + 1] * __uint_as_float(kv[j] & 0xffff0000u); }
            const float sc = valid ? dot * scale + bias : -INFINITY;
            scr[128 + kk] = sc; m = fmaxf(m, sc);
        }
        m = wmaxf(m);
        float sum = 0.f;
        for (int kk = lane; kk < nk; kk += 64) { const float pv = __expf(scr[128 + kk] - m); scr[128 + kk] = pv; sum += pv; }
        sum = wsum(sum);
        LDS_WAIT();
        float o = 0.f;
        for (int kb = 0; kb < nk; kb += 8) {
            const int sb = kb < 256 ? kb : kb + koff;
            const u32x4 vv = *(const u32x4*)(Vt + sb);
#pragma unroll
            for (int j = 0; j < 8; ++j) { const int kk = (kb & ~15) + vpos((kb & 15) + j); const unsigned wv = vv[j >> 1];
                o += scr[128 + kk] * ((j & 1) ? __uint_as_float(wv & 0xffff0000u) : __uint_as_float(wv << 16)); }
        }
        oc[comp] = o / sum;
        LDS_WAIT();
    }
    bf16* mo = F.mix() + (size_t)r * DM + (KIND == 0 ? 0 : KIND == 1 ? 256 : 512) + h * 64 + lane;
    if (KIND == 2) {
        const float* lv = F.df_lam() + L * 128; const float li = 0.8f - 0.6f * expf(-0.3f * (float)L);
        float d1 = 0.f, d2 = 0.f;
#pragma unroll
        for (int i = 0; i < 32; ++i) { d1 += lv[i] * lv[32 + i]; d2 += lv[64 + i] * lv[96 + i]; }
        const float lam = expf(d1) - expf(d2) + li;
        const float o = oc[0] - lam * oc[1];
        const float rs = rsqrtf(wsum(o * o) * (1.f / 64) + EPS);
        *mo = f2bf(o * rs * F.df_gsub()[L * 64 + lane] * (1.f - li));
    } else *mo = f2bf(oc[0]);
}
__device__ __forceinline__ void phase_mix_naive(const Fr& F, int L) {
    LAS float* scr = (LAS float*)(F.lds + F.wave * 16384);
    const int nrows = (L == DEPTH - 1) ? NLAT : NROW;
    for (int j = F.gw; j < nrows * 4; j += F.NGW) naive_attn_job<2>(F, L, j >> 2, j & 3, scr);
    for (int j = F.gw; j < nrows * 4; j += F.NGW) naive_attn_job<1>(F, L, j >> 2, j & 3, scr);
    for (int j = F.gw; j < nrows * 4; j += F.NGW) naive_attn_job<0>(F, L, j >> 2, j & 3, scr);
    for (int r = F.gw; r < nrows; r += F.NGW) {
        int b, s; row2bs(r, b, s); const int h = F.lane >> 4; const float dsk = F.ssd_d()[L * 8 + h] + F.ssd_d()[L * 8 + 4 + h];
        float y[4]; float ss = 0.f;
#pragma unroll
        for (int j = 0; j < 4; ++j) { const int ch = F.lane * 4 + j; const float xv = bf2f(F.xT()[((size_t)b * 256 + ch) * SQ + s]);
            const float z = bf2f(F.pbuf()[(size_t)r * NP + C_Z + ch]);
            y[j] = (F.ydir()[(size_t)r * 256 + ch] + F.ydir()[((size_t)NROW + r) * 256 + ch] + dsk * xv) * siluf(z); ss += y[j] * y[j]; }
        const float rs = rsqrtf(wsum(ss) * (1.f / 256) + EPS);
#pragma unroll
        for (int j = 0; j < 4; ++j) { const int ch = F.lane * 4 + j; F.mix()[(size_t)r * DM + 768 + ch] = f2bf(y[j] * rs * F.ssd_gn()[L * 256 + ch]); }
    }
}

template <int S8> __device__ __forceinline__ bf16x8 pack_step(const f32x16& x) {
    u32x4 p;
    asm volatile("v_cvt_pk_bf16_f32 %0, %4, %5\n\tv_cvt_pk_bf16_f32 %1, %6, %7\n\tv_cvt_pk_bf16_f32 %2, %8, %9\n\tv_cvt_pk_bf16_f32 %3, %10, %11\n\ts_nop 1"
                 : "=&v"(p[0]), "=&v"(p[1]), "=&v"(p[2]), "=&v"(p[3])
                 : "v"(x[S8]), "v"(x[S8 + 1]), "v"(x[S8 + 2]), "v"(x[S8 + 3]), "v"(x[S8 + 4]), "v"(x[S8 + 5]), "v"(x[S8 + 6]), "v"(x[S8 + 7]));
    return __builtin_bit_cast(bf16x8, p);
}
constexpr float LOG2E = 1.4426950408889634f;
template <int KIND>
__device__ __forceinline__ void attn_unit(const Fr& F, int L, int b, int h, int qb) {
    constexpr int QS = KIND == 1 ? 96 : 64, NKS = KIND == 1 ? 6 : (KIND == 0 ? 4 : 2);
    constexpr int PK = QS * 2 + 16, PV = 272, KBYTES = 128 * PK, VBYTES = 64 * PV, NKP = QS == 96 ? 3 : 2, PPR = QS / 8;
    LAS unsigned char* const Kl = F.lds; LAS unsigned char* const Vl = F.lds + 2 * KBYTES;
    LAS float* const biasl = (LAS float*)(F.lds + 2 * KBYTES + 2 * VBYTES);
    const int lane = F.lane, wave = F.wave, tid = F.tid, r = lane & 31, hh = lane >> 5;
    const bool isctx = qb < 0;
    const int comp = KIND == 2 ? (wave & 1) : 0, qg = KIND == 2 ? (wave >> 1) : wave;
    const bf16* Qg = (KIND == 0 ? F.qna() : KIND == 1 ? F.qml() : F.qdf()) + (size_t)(b * 4 + h) * SQ * QS;
    const bf16* Kg = (KIND == 0 ? F.kna() : KIND == 1 ? F.kml() : F.kdf()) + (size_t)(b * 4 + h) * SQ * QS;
    const bf16* Vg = (KIND == 0 ? F.vna() : KIND == 1 ? F.vml() : F.vdf()) + (size_t)(b * 4 + h) * 64 * SQ;
    const float cs = (KIND == 1 ? 0.10206207261596577f : (KIND == 0 ? 0.125f : 0.17677669529663687f)) * LOG2E;
    int sq, qrow = 0, qcol = 0;
    if (KIND == 2) sq = (isctx ? 128 * (-qb - 1) : 256 + 128 * qb) + 32 * qg + r;
    else if (isctx) sq = 32 * wave + r; else if (KIND == 0) { qrow = 4 * qb + (wave >> 1); qcol = 32 * (wave & 1) + r; sq = 256 + 64 * qrow + qcol; } else sq = 256 + 256 * qb + 32 * wave + r;
    int nt = 36, lo_u = 0;
    if (isctx) nt = 4; else if (KIND == 0) { lo_u = min(max(4 * qb - 4, 0), 24); nt = 4 + min(max(4 * qb - 1, 0), 24) + 8 - lo_u; }
    const int np = (nt + 1) >> 1;
    const int my_lo = min(max(qrow - 4, 0), 24), col_lo = min(max(qcol - 8, 0), 48);
    if (KIND == 0 && !isctx) for (int i = tid; i < 465; i += 512) biasl[i] = F.na_rb()[(L * 4 + h) * 465 + i] * LOG2E;
    bf16x8 Q[NKS];
    { const bf16* qp = Qg + (size_t)sq * QS + comp * 32 + 8 * hh;
#pragma unroll
      for (int kk = 0; kk < NKS; ++kk) Q[kk] = *(const bf16x8*)(qp + 16 * kk); }
    f32x16 O[2]; float l = 0.f;
#pragma unroll
    for (int mt = 0; mt < 2; ++mt)
#pragma unroll
        for (int i = 0; i < 16; ++i) O[mt][i] = 0.f;
    float m;
    {   float q2 = 0.f;
#pragma unroll
        for (int kk = 0; kk < NKS; ++kk)
#pragma unroll
            for (int j = 0; j < 8; ++j) { const float v = bf2f((bf16)Q[kk][j]); q2 += v * v; }
        q2 += __shfl_xor(q2, 32);
        const float k2 = __uint_as_float(__hip_atomic_load(F.ctl() + CW_KMAX + ((L * 3 + KIND) * 8 + b) * 8 + h * 2 + comp, __ATOMIC_RELAXED, __HIP_MEMORY_SCOPE_AGENT));
        m = sqrtf(q2 * k2) * cs;
        if (KIND == 0 && !isctx) m += (F.rcos() + 2 * TLAT * 16)[L * 4 + h];
    }
    u32x4 rk_0[NKP], rv_0[2];
#define AT_SK0(t) ((isctx || KIND != 0) ? 64 * (t) : ((t) < 4 ? 64 * (t) : 256 + 64 * (lo_u + (t) - 4)))
#define AT_LOAD(p, S_) do { const int sk0_ = AT_SK0(2 * (p)); const char* kg_ = (const char*)(Kg + (size_t)sk0_ * QS); \
        _Pragma("unroll") for (int i_ = 0; i_ < NKP; ++i_) rk_##S_[i_] = *(const u32x4*)(kg_ + (tid + 512 * i_) * 16); \
        _Pragma("unroll") for (int i_ = 0; i_ < 2; ++i_) { const int pi_ = tid + 512 * i_; rv_##S_[i_] = *(const u32x4*)(Vg + (size_t)(pi_ >> 4) * SQ + sk0_ + (pi_ & 15) * 8); } } while (0)
#define AT_STORE(buf, S_) do { \
        _Pragma("unroll") for (int i_ = 0; i_ < NKP; ++i_) { const int pi_ = tid + 512 * i_; *(LAS u32x4*)(Kl + (buf) * KBYTES + (pi_ / PPR) * PK + (pi_ % PPR) * 16) = rk_##S_[i_]; } \
        _Pragma("unroll") for (int i_ = 0; i_ < 2; ++i_) { const int pi_ = tid + 512 * i_; *(LAS u32x4*)(Vl + (buf) * VBYTES + (pi_ >> 4) * PV + (pi_ & 15) * 16) = rv_##S_[i_]; } } while (0)
#define AT_QK(SA, SB, kb_) do { \
        _Pragma("unroll") for (int i = 0; i < 16; ++i) { SA[i] = 0.f; SB[i] = 0.f; } \
        _Pragma("unroll") for (int kk = 0; kk < NKS; ++kk) { const bf16x8 a0 = *(const LAS bf16x8*)((kb_) + 32 * kk), a1 = *(const LAS bf16x8*)((kb_) + 32 * PK + 32 * kk); \
            SA = MFMA32(a0, Q[kk], SA); SB = MFMA32(a1, Q[kk], SB); } } while (0)
#define AT_SMPV(S0, S1, t_, vb_) do { \
        const int krow = lo_u + (t_) - 4; const bool nbt = (KIND == 0) && !isctx && (t_) >= 4; \
        float ps = 0.f; \
        if (nbt) { const int drow = (krow - qrow + 7) * 31 - qcol + 15; const float nm = -m; \
            _Pragma("unroll") for (int i = 0; i < 16; ++i) { const int kc = (i & 3) + 8 * (i >> 2) + 4 * hh; \
                { const bool v = (unsigned)(kc - col_lo) < 16u; const float bb = biasl[v ? drow + kc : 0]; S0[i] = v ? __builtin_amdgcn_exp2f(__builtin_fmaf(S0[i], cs, bb + nm)) : 0.f; } \
                { const bool v = (unsigned)(kc + 32 - col_lo) < 16u; const float bb = biasl[v ? drow + kc + 32 : 0]; S1[i] = v ? __builtin_amdgcn_exp2f(__builtin_fmaf(S1[i], cs, bb + nm)) : 0.f; } \
                ps += S0[i] + S1[i]; } \
        } else { const float nm = -m; \
            _Pragma("unroll") for (int i = 0; i < 16; ++i) { S0[i] = __builtin_amdgcn_exp2f(__builtin_fmaf(S0[i], cs, nm)); S1[i] = __builtin_amdgcn_exp2f(__builtin_fmaf(S1[i], cs, nm)); ps += S0[i] + S1[i]; } } \
        l += ps; \
        const bf16x8 p00 = pack_step<0>(S0), p01 = pack_step<8>(S0), p10 = pack_step<0>(S1), p11 = pack_step<8>(S1); \
        _Pragma("unroll") for (int mt = 0; mt < 2; ++mt) { \
            const LAS unsigned char* vb = (vb_) + mt * 32 * PV; \
            O[mt] = MFMA32(*(const LAS bf16x8*)(vb + 0), p00, O[mt]); O[mt] = MFMA32(*(const LAS bf16x8*)(vb + 32), p01, O[mt]); \
            O[mt] = MFMA32(*(const LAS bf16x8*)(vb + 64), p10, O[mt]); O[mt] = MFMA32(*(const LAS bf16x8*)(vb + 96), p11, O[mt]); } } while (0)
#define AT_COMPUTE(p_, buf_) do { \
        const int t0_ = 2 * (p_), t1_ = t0_ + 1; \
        const bool g0_ = (KIND != 0) || isctx || t0_ < 4 || (lo_u + t0_ - 4 >= my_lo && lo_u + t0_ - 4 < my_lo + 8); \
        const bool g1_ = (t1_ < nt) && ((KIND != 0) || isctx || t1_ < 4 || (lo_u + t1_ - 4 >= my_lo && lo_u + t1_ - 4 < my_lo + 8)); \
        const LAS unsigned char* Kb = Kl + (buf_) * KBYTES + r * PK + (comp * 32 + 8 * hh) * 2; const LAS unsigned char* Vb = Vl + (buf_) * VBYTES + r * PV + 16 * hh; \
        if (KIND == 0) { f32x16 S00, S01; \
            if (g0_) { AT_QK(S00, S01, Kb); AT_SMPV(S00, S01, t0_, Vb); } \
            if (g1_) { AT_QK(S00, S01, Kb + 64 * PK); AT_SMPV(S00, S01, t1_, Vb + 128); } \
        } else { f32x16 S00, S01, S10, S11; \
            __builtin_amdgcn_iglp_opt(0); \
            AT_QK(S00, S01, Kb); \
            AT_QK(S10, S11, Kb + 64 * PK); \
            AT_SMPV(S00, S01, t0_, Vb); \
            AT_SMPV(S10, S11, t1_, Vb + 128); } } while (0)
    AT_LOAD(0, 0);
    AT_STORE(0, 0);
    __syncthreads();
    for (int p = 0; p < np; ++p) {
        const int buf = p & 1;
        if (p + 1 < np) AT_LOAD(p + 1, 0);
        AT_COMPUTE(p, buf);
        if (p + 1 < np) AT_STORE(buf ^ 1, 0);
        __syncthreads();
    }
#undef AT_COMPUTE
#undef AT_SMPV
#undef AT_QK
#undef AT_SK0
#undef AT_LOAD
#undef AT_STORE
    const float inv = 1.f / (l + __shfl_xor(l, 32));
    bf16* mo = F.mix() + (size_t)bs2row(b, sq) * DM + (KIND == 0 ? 0 : KIND == 1 ? 256 : 512) + h * 64 + 4 * hh;
    if (KIND == 2) {
        LAS float* xo = (LAS float*)F.lds + qg * 2048;
        if (comp == 1) {
#pragma unroll
            for (int mt = 0; mt < 2; ++mt)
#pragma unroll
                for (int i = 0; i < 16; ++i) xo[(mt * 16 + i) * 64 + lane] = O[mt][i] * inv; }
        __syncthreads();
        if (comp == 0) {
            const float* lv = F.df_lam() + L * 128; const float li = 0.8f - 0.6f * expf(-0.3f * (float)L);
            float d1 = 0.f, d2 = 0.f;
#pragma unroll
            for (int i = 0; i < 32; ++i) { d1 += lv[i] * lv[32 + i]; d2 += lv[64 + i] * lv[96 + i]; }
            const float lam = expf(d1) - expf(d2) + li;
            float ss = 0.f;
#pragma unroll
            for (int mt = 0; mt < 2; ++mt)
#pragma unroll
                for (int i = 0; i < 16; ++i) { const float o = O[mt][i] * inv - lam * xo[(mt * 16 + i) * 64 + lane]; O[mt][i] = o; ss += o * o; }
            ss += __shfl_xor(ss, 32);
            const float rs = rsqrtf(ss * (1.f / 64) + EPS) * (1.f - li);
#pragma unroll
            for (int mt = 0; mt < 2; ++mt)
#pragma unroll
                for (int g = 0; g < 4; ++g) { const f32x4 gs = *(const f32x4*)(F.df_gsub() + L * 64 + 32 * mt + 8 * g + 4 * hh);
                    u32x2 w; w.x = pk2(O[mt][4 * g] * rs * gs[0], O[mt][4 * g + 1] * rs * gs[1]); w.y = pk2(O[mt][4 * g + 2] * rs * gs[2], O[mt][4 * g + 3] * rs * gs[3]);
                    *(u32x2*)(mo + 32 * mt + 8 * g) = w; }
        }
        __syncthreads();
    } else {
#pragma unroll
        for (int mt = 0; mt < 2; ++mt)
#pragma unroll
            for (int g = 0; g < 4; ++g) { u32x2 w; w.x = pk2(O[mt][4 * g] * inv, O[mt][4 * g + 1] * inv); w.y = pk2(O[mt][4 * g + 2] * inv, O[mt][4 * g + 3] * inv);
                *(u32x2*)(mo + 32 * mt + 8 * g) = w; }
    }
}
__device__ __forceinline__ float ssd_cum(const Fr& F, int L, int b, int h, int d, int s0, float& dt, float& cum) {
    const int lane = F.lane;
    dt = F.dtv()[((size_t)b * 8 + d * 4 + h) * SQ + s0 + lane];
    const float la = dt * -__expf(F.a_log()[L * 8 + d * 4 + h]);
    float v = la;
#pragma unroll
    for (int o = 1; o < 64; o <<= 1) { const float t = __shfl_up(v, o); if (lane >= o) v += t; }
    const float total = __shfl(v, 63);
    cum = d == 0 ? v : total - v + la;
    return total;
}
__device__ __forceinline__ void ssd_s1_job(const Fr& F, int L, int b, int c, int h, LAS float* scr) {
    const int lane = F.lane, r = lane & 31, hh = lane >> 5, s0 = 64 * c, g = h >> 1;
#pragma unroll
    for (int d = 0; d < 2; ++d) { float dt, cum; const float tot = ssd_cum(F, L, b, h, d, s0, dt, cum); scr[d * 64 + lane] = dt * __expf(tot - cum);
        if (lane == 0) F.cdec()[((b * 2 + d) * 4 + h) * 36 + c] = __expf(tot); }
    LDS_WAIT();
    bf16x8 A[2][2][4];
#pragma unroll
    for (int mt = 0; mt < 2; ++mt)
#pragma unroll
        for (int kk = 0; kk < 4; ++kk) { const bf16x8 raw = *(const bf16x8*)(F.xT() + ((size_t)b * 256 + h * 64 + 32 * mt + r) * SQ + s0 + 16 * kk + 8 * hh);
#pragma unroll
            for (int d = 0; d < 2; ++d) { u32x4 o;
#pragma unroll
                for (int j = 0; j < 4; ++j) { const float w0 = scr[d * 64 + 16 * kk + 8 * hh + 2 * j], w1 = scr[d * 64 + 16 * kk + 8 * hh + 2 * j + 1];
                    o[j] = pk2(bf2f((bf16)raw[2 * j]) * w0, bf2f((bf16)raw[2 * j + 1]) * w1); }
                A[d][mt][kk] = __builtin_bit_cast(bf16x8, o); } }
#pragma unroll
    for (int nt = 0; nt < 4; ++nt) {
        bf16x8 Bf[4];
#pragma unroll
        for (int kk = 0; kk < 4; ++kk) Bf[kk] = *(const bf16x8*)(F.bT() + ((size_t)b * 256 + g * 128 + 32 * nt + r) * SQ + s0 + 16 * kk + 8 * hh);
#pragma unroll
        for (int d = 0; d < 2; ++d)
#pragma unroll
            for (int mt = 0; mt < 2; ++mt) { f32x16 acc;
#pragma unroll
                for (int i = 0; i < 16; ++i) acc[i] = 0.f;
#pragma unroll
                for (int kk = 0; kk < 4; ++kk) acc = MFMA32(A[d][mt][kk], Bf[kk], acc);
                float* dst = F.cst() + ((((size_t)(b * 2 + d) * 4 + h) * 36 + c) * 64 + 32 * mt) * 128 + 32 * nt + r;
#pragma unroll
                for (int i = 0; i < 16; ++i) dst[crow16(i, hh) * 128] = acc[i]; }
    }
    LDS_WAIT();
}
__device__ __forceinline__ void phase_ssd_s1(const Fr& F, int L) {
    LAS float* scr = (LAS float*)(F.lds + F.wave * 16384);
    for (int j = F.gw; j < NB * 36 * 4; j += F.NGW) ssd_s1_job(F, L, j / 144, (j / 4) % 36, j & 3, scr);
}
__device__ __forceinline__ void phase_ssd_scan(const Fr& F, int L) {
    for (int e4 = blockIdx.x * 512 + F.tid; e4 < NB * 2 * 4 * 2048; e4 += F.G * 512) {
        const int bdh = e4 >> 11, pn = (e4 & 2047) * 4, d = (bdh >> 2) & 1;
        f32x4 hst = (f32x4){0.f, 0.f, 0.f, 0.f};
        const float* cs_ = F.cst() + (size_t)bdh * 36 * 8192 + pn; bf16* he_ = F.hent() + (size_t)bdh * 36 * 8192 + pn; const float* cd_ = F.cdec() + bdh * 36;
#pragma unroll 1
        for (int s6 = 0; s6 < 36; s6 += 6) {
            f32x4 v[6]; float dc[6]; int cc[6];
#pragma unroll
            for (int j = 0; j < 6; ++j) { const int step = s6 + j; cc[j] = d == 0 ? step : (step < 4 ? 3 - step : 39 - step); v[j] = *(const f32x4*)(cs_ + (size_t)cc[j] * 8192); dc[j] = cd_[cc[j]]; }
#pragma unroll
            for (int j = 0; j < 6; ++j) { u32x2 o; o.x = pk2(hst[0], hst[1]); o.y = pk2(hst[2], hst[3]); *(u32x2*)(he_ + (size_t)cc[j] * 8192) = o; hst = hst * dc[j] + v[j]; }
        }
    }
}
__device__ __forceinline__ void ssd_s3_unit(const Fr& F, int L, int b, int c) {
    const int lane = F.lane, wave = F.wave, r = lane & 31, hh = lane >> 5, s0 = 64 * c, h = wave >> 1, it = wave & 1, g = h >> 1, itok = 32 * it + r;
    LAS float* scr = (LAS float*)(F.lds + wave * 16384);
    LAS float* red = (LAS float*)(F.lds + 8192);
#pragma unroll
    for (int d = 0; d < 2; ++d) { float dt, cum; (void)ssd_cum(F, L, b, h, d, s0, dt, cum); scr[d * 128 + lane] = cum; scr[d * 128 + 64 + lane] = dt; }
    LDS_WAIT();
    bf16x8 Cf[8];
#pragma unroll
    for (int kk = 0; kk < 8; ++kk) Cf[kk] = *(const bf16x8*)(F.ctm() + ((size_t)b * SQ + s0 + itok) * 256 + g * 128 + 16 * kk + 8 * hh);
    f32x16 G[2];
#pragma unroll
    for (int jt = 0; jt < 2; ++jt) {
#pragma unroll
        for (int i = 0; i < 16; ++i) G[jt][i] = 0.f;
#pragma unroll
        for (int kk = 0; kk < 8; ++kk) { const bf16x8 bf = *(const bf16x8*)(F.btm() + ((size_t)b * SQ + s0 + 32 * jt + r) * 256 + g * 128 + 16 * kk + 8 * hh); G[jt] = MFMA32(bf, Cf[kk], G[jt]); } }
    bf16x8 X[2][4];
#pragma unroll
    for (int mt = 0; mt < 2; ++mt)
#pragma unroll
        for (int ks = 0; ks < 4; ++ks) { const bf16* xp = F.xT() + ((size_t)b * 256 + h * 64 + 32 * mt + r) * SQ + s0 + 16 * ks + 4 * hh;
            const u32x2 lo = *(const u32x2*)xp, hi = *(const u32x2*)(xp + 8); u32x4 o; o.x = lo.x; o.y = lo.y; o.z = hi.x; o.w = hi.y; X[mt][ks] = __builtin_bit_cast(bf16x8, o); }
    f32x16 Y[2];
#pragma unroll
    for (int mt = 0; mt < 2; ++mt)
#pragma unroll
        for (int i = 0; i < 16; ++i) Y[mt][i] = 0.f;
    const float Dsum = F.ssd_d()[L * 8 + h] + F.ssd_d()[L * 8 + 4 + h];
#pragma unroll 1
    for (int d = 0; d < 2; ++d) {
        const float cum_i = scr[d * 128 + itok];
        f32x16 Pm[2];
#pragma unroll
        for (int jt = 0; jt < 2; ++jt)
#pragma unroll
            for (int i = 0; i < 16; ++i) { const int j = 32 * jt + crow16(i, hh); const bool valid = d == 0 ? (j <= itok) : (j >= itok);
                const float arg = valid ? cum_i - scr[d * 128 + j] : -INFINITY;
                float pv = G[jt][i] * __expf(arg) * scr[d * 128 + 64 + j];
                if (d == 0 && j == itok) pv += Dsum;
                Pm[jt][i] = pv; }
        const bf16x8 p0 = pack_step<0>(Pm[0]), p1 = pack_step<8>(Pm[0]), p2 = pack_step<0>(Pm[1]), p3 = pack_step<8>(Pm[1]);
#pragma unroll
        for (int mt = 0; mt < 2; ++mt) { Y[mt] = MFMA32(X[mt][0], p0, Y[mt]); Y[mt] = MFMA32(X[mt][1], p1, Y[mt]); Y[mt] = MFMA32(X[mt][2], p2, Y[mt]); Y[mt] = MFMA32(X[mt][3], p3, Y[mt]); }
        const float ei = __expf(cum_i);
#pragma unroll
        for (int mt = 0; mt < 2; ++mt) { f32x16 T;
#pragma unroll
            for (int i = 0; i < 16; ++i) T[i] = 0.f;
#pragma unroll
            for (int kk = 0; kk < 8; ++kk) { const bf16x8 hf = *(const bf16x8*)(F.hent() + ((((size_t)(b * 2 + d) * 4 + h) * 36 + c) * 64 + 32 * mt + r) * 128 + 16 * kk + 8 * hh); T = MFMA32(hf, Cf[kk], T); }
#pragma unroll
            for (int i = 0; i < 16; ++i) Y[mt][i] += ei * T[i]; }
    }
    const size_t row = bs2row(b, s0 + itok);
    const bf16* zp = F.pbuf() + row * NP + C_Z + h * 64 + 4 * hh;
    float ss = 0.f;
#pragma unroll
    for (int mt = 0; mt < 2; ++mt)
#pragma unroll
        for (int gq = 0; gq < 4; ++gq) { const u32x2 z4 = *(const u32x2*)(zp + 32 * mt + 8 * gq);
            const float z0 = __uint_as_float(z4.x << 16), z1 = __uint_as_float(z4.x & 0xffff0000u), z2 = __uint_as_float(z4.y << 16), z3 = __uint_as_float(z4.y & 0xffff0000u);
            Y[mt][4 * gq] *= siluf(z0); Y[mt][4 * gq + 1] *= siluf(z1); Y[mt][4 * gq + 2] *= siluf(z2); Y[mt][4 * gq + 3] *= siluf(z3);
            ss += (Y[mt][4 * gq] * Y[mt][4 * gq] + Y[mt][4 * gq + 1] * Y[mt][4 * gq + 1]) + (Y[mt][4 * gq + 2] * Y[mt][4 * gq + 2] + Y[mt][4 * gq + 3] * Y[mt][4 * gq + 3]); }
    ss += __shfl_xor(ss, 32);
    if (hh == 0) red[(it * 4 + h) * 32 + r] = ss;
    __syncthreads();
    const float tot = (red[(it * 4 + 0) * 32 + r] + red[(it * 4 + 1) * 32 + r]) + (red[(it * 4 + 2) * 32 + r] + red[(it * 4 + 3) * 32 + r]);
    const float rs = rsqrtf(tot * (1.f / 256) + EPS);
    bf16* mo = F.mix() + row * DM + 768 + h * 64 + 4 * hh;
#pragma unroll
    for (int mt = 0; mt < 2; ++mt)
#pragma unroll
        for (int gq = 0; gq < 4; ++gq) { const f32x4 gn = *(const f32x4*)(F.ssd_gn() + L * 256 + h * 64 + 32 * mt + 8 * gq + 4 * hh);
            u32x2 w; w.x = pk2(Y[mt][4 * gq] * rs * gn[0], Y[mt][4 * gq + 1] * rs * gn[1]); w.y = pk2(Y[mt][4 * gq + 2] * rs * gn[2], Y[mt][4 * gq + 3] * rs * gn[3]);
            *(u32x2*)(mo + 32 * mt + 8 * gq) = w; }
    __syncthreads();
}
template <int KIND> __device__ __forceinline__ void attn_units(const Fr& F, int L) {
    if (KIND == 2) { const int nu = (L == DEPTH - 1) ? 512 : 576;
        for (int u = F.vcu; u < nu; u += F.G) { if (u < 512) attn_unit<2>(F, L, u >> 6, (u >> 4) & 3, u & 15); else attn_unit<2>(F, L, (u - 512) >> 3, ((u - 512) >> 1) & 3, -1 - (u & 1)); }
    } else { const int nu = (L == DEPTH - 1) ? 256 : 288;
        for (int u = F.vcu; u < nu; u += F.G) { if (u < 256) attn_unit<KIND>(F, L, u >> 5, (u >> 3) & 3, u & 7); else attn_unit<KIND>(F, L, (u - 256) >> 2, (u - 256) & 3, -1); } }
}
__device__ __forceinline__ void phase_mix_fast(const Fr& F, int L) {
#ifndef ATT_MASK
#define ATT_MASK 15
#endif
#ifndef ATT_DUP
#define ATT_DUP 0
#endif
#ifndef ATT_MASK
#define ATT_MASK 15
#endif
    if (ATT_MASK & 4) for (int rp = 0; rp < ((ATT_DUP & 4) ? 2 : 1); ++rp) { const Fr Fa = refresh(F); attn_units<2>(Fa, L); }
    if (ATT_MASK & 2) for (int rp = 0; rp < ((ATT_DUP & 2) ? 2 : 1); ++rp) { const Fr Fa = refresh(F); attn_units<1>(Fa, L); }
    if (ATT_MASK & 1) for (int rp = 0; rp < ((ATT_DUP & 1) ? 2 : 1); ++rp) { const Fr Fa = refresh(F); attn_units<0>(Fa, L); }
    const int c0 = (L == DEPTH - 1) ? 4 : 0;
    if (ATT_MASK & 8) { const Fr Fa = refresh(F); unsigned* ctr = Fa.ctl() + CW_QUEUE + (L * 16 + 1) * 64;
        for (;;) { const int u = grab_unit(Fa, ctr); if (u >= NB * (36 - c0)) break; ssd_s3_unit(Fa, L, u / (36 - c0), c0 + u % (36 - c0)); } }
}

__device__ __forceinline__ void phase_route(const Fr& F, int L, bool commit = true) {
    const int nrows = (L == DEPTH - 1) ? NLAT : NROW;
    LAS float* wl = (LAS float*)F.lds;
    {   const f32x4* wg4 = (const f32x4*)(F.w_grp() + (size_t)L * DM * 4); const f32x4* we4 = (const f32x4*)(F.w_exp() + (size_t)L * DM * 16);
        f32x4 tg[2], te[8];
#pragma unroll
        for (int n = 0; n < 2; ++n) tg[n] = wg4[F.tid + 512 * n];
#pragma unroll
        for (int n = 0; n < 8; ++n) te[n] = we4[F.tid + 512 * n];
#pragma unroll
        for (int n = 0; n < 2; ++n) { const int k = F.tid + 512 * n;
#pragma unroll
            for (int o = 0; o < 4; ++o) wl[o * DM + k] = tg[n][o]; }
#pragma unroll
        for (int n = 0; n < 8; ++n) { const int i = F.tid + 512 * n, k = i >> 2, q = i & 3;
#pragma unroll
            for (int o = 0; o < 4; ++o) wl[(4 + 4 * q + o) * DM + k] = te[n][o]; }
    }
    __syncthreads();
    float keep[20];
#pragma unroll
    for (int o = 0; o < 20; ++o) keep[o] = 0.f;
    f32x4 v[4], vn[4];
    { const int r = F.gw; if (r < nrows) { const float* hp = r < NLAT ? F.out() + (size_t)r * DM : F.hc() + (size_t)(r - NLAT) * DM;
#pragma unroll
        for (int j = 0; j < 4; ++j) vn[j] = *(const f32x4*)(hp + 4 * F.lane + 256 * j); } }
    int it = 0;
    for (int r = F.gw; r < nrows; r += F.NGW, ++it) {
        const bool lat = r < NLAT; const int bb = lat ? (r >> 11) : 8;
#pragma unroll
        for (int j = 0; j < 4; ++j) v[j] = vn[j];
        { const int rn = r + F.NGW; if (rn < nrows) { const float* hp = rn < NLAT ? F.out() + (size_t)rn * DM : F.hc() + (size_t)(rn - NLAT) * DM;
#pragma unroll
            for (int j = 0; j < 4; ++j) vn[j] = *(const f32x4*)(hp + 4 * F.lane + 256 * j); } }
        float ss = 0.f;
#pragma unroll
        for (int j = 0; j < 4; ++j) ss += (v[j][0] * v[j][0] + v[j][1] * v[j][1]) + (v[j][2] * v[j][2] + v[j][3] * v[j][3]);
        const float rstd = rsqrtf(wsum(ss) * (1.f / DM) + EPS);
        const float* md = F.modv() + ((size_t)L * 9 + bb) * 6144;
        float lg[20];
#pragma unroll
        for (int o = 0; o < 20; ++o) lg[o] = 0.f;
#pragma unroll
        for (int j = 0; j < 4; ++j) { const int c = 4 * F.lane + 256 * j; const f32x4 g = *(const f32x4*)(F.g_ffn() + L * DM + c), sh = *(const f32x4*)(md + 3 * 1024 + c), scl = *(const f32x4*)(md + 4 * 1024 + c);
            const f32x4 f = v[j] * rstd * g * (scl + 1.f) + sh; u32x2 o2; o2.x = pk2(f[0], f[1]); o2.y = pk2(f[2], f[3]); *(u32x2*)(F.abuf() + (size_t)r * DM + c) = o2;
#pragma unroll
            for (int o = 0; o < 20; ++o) { const f32x4 w = *(const LAS f32x4*)(wl + o * DM + c); lg[o] += (f[0] * w[0] + f[1] * w[1]) + (f[2] * w[2] + f[3] * w[3]); }
            asm volatile("" ::: "memory"); }
#pragma unroll
        for (int o = 0; o < 20; ++o) { const float t = wsum(lg[o]); keep[o] = (F.lane == it) ? t : keep[o]; }
    }
    if (F.lane < it) {
        const int r = F.gw + F.lane * F.NGW;
        float gl[4]; float gm = -INFINITY; int gt = 0;
#pragma unroll
        for (int o = 0; o < 4; ++o) { gl[o] = keep[o] + F.b_grp()[L * 4 + o]; if (gl[o] > gm) { gm = gl[o]; gt = o; } }
        float gs = 0.f;
#pragma unroll
        for (int o = 0; o < 4; ++o) gs += expf(gl[o] - gm);
        const float gp = 1.f / gs;
        float el[4];
#pragma unroll
        for (int o = 0; o < 4; ++o) { float v4 = 0.f;
#pragma unroll
            for (int q = 0; q < 4; ++q) v4 = (gt == q) ? keep[4 + 4 * q + o] + F.b_exp()[L * 16 + 4 * q + o] : v4;
            el[o] = v4; }
        int i0 = 0; float m0 = el[0];
#pragma unroll
        for (int o = 1; o < 4; ++o) if (el[o] > m0) { m0 = el[o]; i0 = o; }
        int i1 = i0 == 0 ? 1 : 0; float m1 = i0 == 0 ? el[1] : el[0];
#pragma unroll
        for (int o = 1; o < 4; ++o) if (o != i0 && el[o] > m1) { m1 = el[o]; i1 = o; }
        const float e1 = expf(m1 - m0), w0 = gp / (1.f + e1), w1 = gp * e1 / (1.f + e1);
        const int x0 = gt * 4 + i0, x1 = gt * 4 + i1;
        if (commit) {
            F.rtw()[2 * r] = w0; F.rtw()[2 * r + 1] = w1;
            const unsigned p0 = atomicAdd(F.ctl() + CW_ECNT + (L * 16 + x0) * 64, 1u), p1 = atomicAdd(F.ctl() + CW_ECNT + (L * 16 + x1) * 64, 1u);
            F.elist()[x0 * NROW + p0] = 2 * r; F.elist()[x1 * NROW + p1] = 2 * r + 1; }
        else if (w0 + w1 < -1.f) F.rtw()[0] = 0.f;
    }
    __syncthreads();
}
__device__ __forceinline__ void moe_table(const Fr& F, int L) {
    volatile LAS int* T = (volatile LAS int*)(F.lds + LDSCTL_OFF + 64);
    volatile LAS int* Cn = (volatile LAS int*)(F.lds + LDSCTL_OFF + 160);
    __syncthreads();
    if (F.tid == 0) { int acc = 0;
        for (int e = 0; e < 16; ++e) { int c = (int)__hip_atomic_load(F.ctl() + CW_ECNT + (L * 16 + e) * 64, __ATOMIC_RELAXED, __HIP_MEMORY_SCOPE_AGENT); c = min(max(c, 0), NROW); T[e] = acc; Cn[e] = c; acc += (c + 255) >> 8; }
        T[16] = acc; }
    __syncthreads();
}

__global__ void __launch_bounds__(512, 2) fwd_kernel(Args args) {
    extern __shared__ __attribute__((aligned(16))) unsigned char lds_raw[];
    Fr F0;
    F0.lds = (LAS unsigned char*)lds_raw; F0.tid = threadIdx.x; F0.lane = F0.tid & 63; F0.wave = __builtin_amdgcn_readfirstlane(F0.tid >> 6);
    F0.G = gridDim.x; { const int bx = blockIdx.x; F0.vcu = (F0.G % 8 == 0) ? (bx % 8) * (F0.G / 8) + bx / 8 : bx; }
    F0.gw = F0.vcu * 8 + F0.wave; F0.NGW = F0.G * 8;
    F0.A = (const __attribute__((address_space(4))) Args*)__builtin_amdgcn_kernarg_segment_ptr();
    for (int u = F0.tid; u < (LDS_BYTES - LDSCTL_OFF) / 4; u += 512) ((LAS unsigned*)(F0.lds + LDSCTL_OFF))[u] = 0u;
    __syncthreads();
    const int lo = args.ph_lo, hi = args.ph_hi;
    XcdBarrier bar; bar.bar = F0.ctl() + CW_BAR; bar.x = 0; bar.st = nullptr;
    if (hi - lo > 1) bar = xcd_barrier_post(F0.ctl() + CW_BAR, (volatile LAS unsigned*)(F0.lds + LDSCTL_OFF));
#ifndef PH_MASK
#define PH_MASK 0xFFFF
#endif
#define PM(b) ((PH_MASK >> (b)) & 1)
#ifndef DUP_MASK
#define DUP_MASK 0
#endif
#ifndef DBL_SEAM
#define DBL_SEAM 0
#endif
#define NREP(b) (((DUP_MASK >> (b)) & 1) ? 2 : 1)
#define IN(k) (lo <= (k) && (k) < hi)
#define SEAM(k) do { if (IN(k) && IN((k) + 1)) { const Fr Fb = refresh(F0); XcdBarrier b2 = bar; b2.bar = Fb.ctl() + CW_BAR; xcd_barrier(b2); if ((DUP_MASK & 0x10000) || ((DBL_SEAM >> (((k) + NPH_L - 1) % NPH_L)) & 1)) xcd_barrier(b2); } } while (0)

    if (PM(0) && IN(0)) { for (int rep_ = 0; rep_ < NREP(0); ++rep_) { if (rep_) __syncthreads(); const Fr F = refresh(F0); phase_prologue(F); } }
    SEAM(0);
    for (int L = 0; L < DEPTH; ++L) {
        const int pb = 1 + NPH_L * L;
        const bool lastL = (L == DEPTH - 1);
        if (PM(1) && IN(pb + 0)) { const Fr F = refresh(F0); phase_norm(F, L); if (DUP_MASK & 2048) { __syncthreads(); phase_norm(F, L, false); } if (L == 0) for (int rp = 0; rp < NREP(10); ++rp) moe_weight_convert(F, 0); }
        SEAM(pb + 0);
        if (PM(2) && IN(pb + 1)) { for (int rep_ = 0; rep_ < NREP(2); ++rep_) { if (rep_) __syncthreads(); const Fr F = refresh(F0); pg8::DenseSched S; S.init(F.abuf(), F.winT() + (size_t)L * NP * DM, DM, NROW, NP, F.G, (int)blockIdx.x); pg8::EpiP E{F.pbuf()}; pg8::gemm_phase(F.lds, F.tid, DM, S, E); } }
        SEAM(pb + 1);
        if (PM(3) && IN(pb + 2)) { for (int rep_ = 0; rep_ < NREP(3); ++rep_) { if (rep_) __syncthreads(); const Fr F = refresh(F0); phase_prep(F, L); } }
        SEAM(pb + 2);
        if (PM(4) && IN(pb + 3)) { for (int rep_ = 0; rep_ < NREP(4); ++rep_) { if (rep_) __syncthreads(); const Fr F = refresh(F0); phase_ssd_s1(F, L); } }
        SEAM(pb + 3);
        if (PM(4) && IN(pb + 4)) { for (int rep_ = 0; rep_ < NREP(6); ++rep_) { if (rep_) __syncthreads(); const Fr F = refresh(F0); phase_ssd_scan(F, L); } }
        SEAM(pb + 4);
        if (PM(5) && IN(pb + 5)) { for (int rep_ = 0; rep_ < NREP(5); ++rep_) { if (rep_) __syncthreads(); const Fr F = refresh(F0); phase_mix_fast(F, L); } }
        SEAM(pb + 5);
        if (PM(6) && IN(pb + 6)) { const Fr F = refresh(F0); pg8::DenseSched S; S.init(F.mix(), F.woutT() + (size_t)L * DM * DM, DM, lastL ? NLAT : NROW, DM, F.G, (int)blockIdx.x);
            pg8::EpiRes E{L == 0 ? F.x() : F.out(), L == 0 ? F.ctx() : F.hc(), F.out(), F.hc(), F.modv() + (size_t)L * 9 * 6144 + 2 * 1024, 1.f}; pg8::gemm_phase(F.lds, F.tid, DM, S, E);
            if (!lastL && blockIdx.x >= 32) { __syncthreads(); moe_weight_convert(F, L + 1, ((int)blockIdx.x - 32) * 8 + F.wave, (F.G - 32) * 8); __syncthreads(); }
            if (DUP_MASK & 8192) { __syncthreads(); pg8::EpiRes E2{F.out(), F.hc(), F.out(), F.hc(), F.modv() + (size_t)L * 9 * 6144 + 2 * 1024, 0.f}; pg8::gemm_phase(F.lds, F.tid, DM, S, E2); } }
        SEAM(pb + 6);
        if (PM(7) && IN(pb + 7)) { const Fr F = refresh(F0); phase_route(F, L); if (DUP_MASK & 4096) phase_route(F, L, false); }
        SEAM(pb + 7);
        if (PM(8) && IN(pb + 8)) { for (int rep_ = 0; rep_ < NREP(8); ++rep_) { if (rep_) __syncthreads(); const Fr F = refresh(F0); moe_table(F, L);
            pg8::MoeSched<true> S{(const char*)F.abuf(), (const char*)F.wgu(L & 1), (size_t)1024 * DM * 2, DM, F.G, F.vcu, F.elist(), (const volatile LAS int*)(F.lds + LDSCTL_OFF + 64), (const volatile LAS int*)(F.lds + LDSCTL_OFF + 160)};
            pg8::EpiAct E{F.act()}; pg8::gemm_phase(F.lds, F.tid, DM, S, E); } }
        SEAM(pb + 8);
        if (PM(9) && IN(pb + 9)) { for (int rep_ = 0; rep_ < NREP(9); ++rep_) { if (rep_) __syncthreads(); const Fr F = refresh(F0); moe_table(F, L);
            pg8::MoeSched<false> S{(const char*)F.act(), (const char*)F.wd(L & 1), (size_t)1024 * FF * 2, FF, F.G, F.vcu, F.elist(), (const volatile LAS int*)(F.lds + LDSCTL_OFF + 64), (const volatile LAS int*)(F.lds + LDSCTL_OFF + 160)};
            pg8::EpiDown E{F.yk(), F.elist(), F.rtw()}; pg8::gemm_phase(F.lds, F.tid, FF, S, E); } }
        SEAM(pb + 9);
    }
    if (PM(1) && IN(PH_FINAL)) { const Fr F = refresh(F0); phase_norm(F, DEPTH); }
#undef IN
#undef SEAM
}

extern "C" void kernel_launch(void* const* d_in, const int* in_sizes, int n_in, void* d_out, int out_size, void* d_ws, size_t ws_size, hipStream_t stream) {
    static int grid = 0;
    if (grid == 0) {
        if (n_in != 36 || out_size != NLAT * DM || ws_size < WS_END) { fprintf(stderr, "kernel_launch: unexpected shapes (n_in %d out %d ws %zu)\n", n_in, out_size, ws_size); grid = -1; return; }
        int dev = 0, cus = 0, per_cu = 0;
        if (hipGetDevice(&dev) != hipSuccess || hipDeviceGetAttribute(&cus, hipDeviceAttributeMultiprocessorCount, dev) != hipSuccess) { grid = -1; return; }
        if (hipFuncSetAttribute((const void*)fwd_kernel, hipFuncAttributeMaxDynamicSharedMemorySize, LDS_BYTES) != hipSuccess) { fprintf(stderr, "kernel_launch: hipFuncSetAttribute failed\n"); grid = -1; return; }
        if (hipOccupancyMaxActiveBlocksPerMultiprocessor(&per_cu, (const void*)fwd_kernel, 512, LDS_BYTES) != hipSuccess || per_cu < 1) { fprintf(stderr, "kernel_launch: occupancy query says %d\n", per_cu); }
        (void)hipGetLastError();
        grid = cus;
    }
    if (grid < 0) return;
    (void)hipMemsetAsync((char*)d_ws + WS_CTL, 0, CTL_BYTES, stream);
    Args a{};
    for (int i = 0; i < 36; ++i) a.in[i] = (const float*)d_in[i];
    a.out = (float*)d_out; a.ws = (unsigned char*)d_ws;
#if MK_ONE_LAUNCH
    a.ph_lo = 0; a.ph_hi = NPHASE;
    hipLaunchKernelGGL(fwd_kernel, dim3(grid), dim3(512), LDS_BYTES, stream, a);
#else
    for (int ph = 0; ph < NPHASE; ++ph) { a.ph_lo = ph; a.ph_hi = ph + 1; hipLaunchKernelGGL(fwd_kernel, dim3(grid), dim3(512), LDS_BYTES, stream, a); }
#endif
}
```

```cpp
#include <hip/hip_runtime.h>
#include <cstdio>
#include <cstdint>

#ifndef MK_ONE_LAUNCH
#define MK_ONE_LAUNCH 1
#endif

#define LAS __attribute__((address_space(3)))
typedef unsigned short bf16;
typedef short bf16x8 __attribute__((ext_vector_type(8)));
typedef float f32x4 __attribute__((ext_vector_type(4)));
typedef float f32x2 __attribute__((ext_vector_type(2)));
typedef unsigned u32x4 __attribute__((ext_vector_type(4)));
typedef unsigned u32x2 __attribute__((ext_vector_type(2)));

constexpr int NB = 8, TLAT = 2048, TCTX = 256, SQ = 2304, DM = 1024, DEPTH = 4;
constexpr int NLAT = NB * TLAT, NCTXR = NB * TCTX, NROW = NLAT + NCTXR;
constexpr int NIN = 2984, NP = 3072;
constexpr int C_NA = 0, C_MLA = 768, C_DF = 1184, C_SSD = 1952;
constexpr int C_Z = C_SSD, C_XBC = C_SSD + 256, C_DT = C_SSD + 1024;
constexpr float EPS = 1e-6f;
constexpr int NEXP = 16, FF = 512, ACT_ROWS = 40960;
constexpr int NPH_L = 10, PH_FINAL = 1 + NPH_L * DEPTH, NPHASE = PH_FINAL + 1;

constexpr size_t MiB = 1u << 20;
constexpr size_t WS_CTL = 0, CTL_BYTES = 1 * MiB;
constexpr size_t WS_MOD = 1 * MiB;
constexpr size_t WS_ROPE = 2 * MiB;
constexpr size_t WS_WIN = 4 * MiB;
constexpr size_t WS_WOUT = 28 * MiB;
constexpr size_t WS_WQB = 36 * MiB;
constexpr size_t WS_WKVB = 37 * MiB;
constexpr size_t WS_WGU = 38 * MiB;
constexpr size_t WS_WD = 70 * MiB;
constexpr size_t WS_HC = 86 * MiB;
constexpr size_t WS_A = 94 * MiB;
constexpr size_t WS_P = 130 * MiB;
constexpr size_t WS_ACT = 130 * MiB;
constexpr size_t WS_YK = 170 * MiB;
constexpr size_t WS_MIX = 238 * MiB;
constexpr size_t WS_QNA = 274 * MiB, WS_KNA = 283 * MiB, WS_VNA = 292 * MiB;
constexpr size_t WS_QML = 301 * MiB, WS_KML = 315 * MiB, WS_VML = 329 * MiB;
constexpr size_t WS_QDF = 338 * MiB, WS_KDF = 347 * MiB, WS_VDF = 356 * MiB;
constexpr size_t WS_XT = 365 * MiB, WS_BTM = 374 * MiB, WS_BT = 383 * MiB, WS_CTM = 392 * MiB;
constexpr size_t WS_DT = 401 * MiB;
constexpr size_t WS_CST = 402 * MiB;
constexpr size_t WS_CDEC = 474 * MiB;
constexpr size_t WS_HENT = 475 * MiB;
constexpr size_t WS_RT = 511 * MiB;
constexpr size_t WS_ELIST = 512 * MiB;
constexpr size_t WS_WGU2 = 514 * MiB;
constexpr size_t WS_WD2 = 546 * MiB;
constexpr size_t WS_END = 562 * MiB;
constexpr int CW_BAR = 4096;
constexpr int CW_ECNT = 16384;
constexpr int CW_KMAX = 65536;
constexpr int CW_QUEUE = 32768;

constexpr int RING_BYTES = 131072, LDSCTL_OFF = RING_BYTES, LDS_BYTES = 147456;

typedef float f32x16 __attribute__((ext_vector_type(16)));
#define MFMA32(a, b, c) __builtin_amdgcn_mfma_f32_32x32x16_bf16((a), (b), (c), 0, 0, 0)
__device__ __forceinline__ int crow16(int reg, int hh) { return (reg & 3) + 8 * (reg >> 2) + 4 * hh; }
__device__ __forceinline__ float bf2f(bf16 v) { return __uint_as_float(((unsigned)v) << 16); }
__device__ __forceinline__ bf16 f2bf(float f) { unsigned u = __float_as_uint(f); return (bf16)((u + 0x7fffu + ((u >> 16) & 1u)) >> 16); }
__device__ __forceinline__ unsigned pk2(float lo, float hi) { return (unsigned)f2bf(lo) | ((unsigned)f2bf(hi) << 16); }
template <int CTRL> __device__ __forceinline__ float dppf(float v) { return __int_as_float(__builtin_amdgcn_update_dpp(0, __float_as_int(v), CTRL, 0xF, 0xF, true)); }
__device__ __forceinline__ float rlane(float v, int l) { return __int_as_float(__builtin_amdgcn_readlane(__float_as_int(v), l)); }
__device__ __forceinline__ float wsum(float v) {
    v += dppf<0xB1>(v); v += dppf<0x4E>(v); v += dppf<0x141>(v); v += dppf<0x140>(v);
    return (rlane(v, 0) + rlane(v, 16)) + (rlane(v, 32) + rlane(v, 48)); }
__device__ __forceinline__ float wmaxf(float v) {
    v = fmaxf(v, dppf<0xB1>(v)); v = fmaxf(v, dppf<0x4E>(v)); v = fmaxf(v, dppf<0x141>(v)); v = fmaxf(v, dppf<0x140>(v));
    return fmaxf(fmaxf(rlane(v, 0), rlane(v, 16)), fmaxf(rlane(v, 32), rlane(v, 48))); }
#define LDS_WAIT() asm volatile("s_waitcnt lgkmcnt(0)" ::: "memory")
__device__ __forceinline__ void row2bs(int r, int& b, int& s) { if (r < NLAT) { b = r >> 11; s = 256 + (r & 2047); } else { const int j = r - NLAT; b = j >> 8; s = j & 255; } }
__device__ __forceinline__ int bs2row(int b, int s) { return s < 256 ? NLAT + b * 256 + s : b * 2048 + s - 256; }
__device__ __forceinline__ int vpos(int s) { return (s & ~12) | ((s & 4) << 1) | ((s & 8) >> 1); }
__device__ __forceinline__ float siluf(float x) { return x / (1.f + __expf(-x)); }

#define XB_TMO      128
#define XB_XCNT(j)  (256  + 64 * (j))
#define XB_XSUB(j)  (1280 + 64 * (j))
#define XB_XGEN(j)  (2304 + 64 * (j))
#define XB_TOP      3328
#define XB_TOPGEN   3392
#define XCD_BAR_WORDS 3456
#define XB_SPIN_CAP (1u << 24)
__device__ __forceinline__ unsigned xb_ld(unsigned* p)              { return __hip_atomic_load(p, __ATOMIC_RELAXED, __HIP_MEMORY_SCOPE_AGENT); }
__device__ __forceinline__ unsigned xb_add(unsigned* p, unsigned v) { return __hip_atomic_fetch_add(p, v, __ATOMIC_RELAXED, __HIP_MEMORY_SCOPE_AGENT); }
__device__ __forceinline__ unsigned xb_xcc_id() { return (unsigned)__builtin_amdgcn_s_getreg((3 << 11) | 20) & 0xFu; }
#define XB_SPIN(cond, bar) do { unsigned _sp = 0; while (cond) { __builtin_amdgcn_s_sleep(1); \
    if ((++_sp & 255u) == 0u) { if (xb_ld(&(bar)[XB_TMO])) break; if (_sp > XB_SPIN_CAP) { atomicAdd(&(bar)[XB_TMO], 1u); break; } } } } while (0)
struct XcdBarrier { unsigned* bar; unsigned x; volatile LAS unsigned* st; };
__device__ __forceinline__ XcdBarrier xcd_barrier_post(unsigned* bar, volatile LAS unsigned* st) {
    XcdBarrier b; b.bar = bar; b.x = xb_xcc_id(); b.st = st;
    if (threadIdx.x == 0) (void)xb_add(&bar[XB_XCNT(b.x)], 1u);
    return b;
}
__device__ __forceinline__ void xcd_barrier_complete(unsigned* bar, unsigned x, unsigned& nloc, unsigned& nx) {
    const unsigned G = gridDim.x * gridDim.y * gridDim.z;
    unsigned sum, cnt, mine, sp = 0u;
    for (;;) {
        sum = 0u; cnt = 0u; mine = 0u;
#pragma unroll
        for (unsigned j = 0; j < 16; ++j) { const unsigned c = xb_ld(&bar[XB_XCNT(j)]); sum += c; cnt += (c > 0u) ? 1u : 0u; mine = (j == x) ? c : mine; }
        if (sum == G) break;
        __builtin_amdgcn_s_sleep(1);
        if ((++sp & 255u) == 0u) { if (xb_ld(&bar[XB_TMO])) break; if (sp > XB_SPIN_CAP) { atomicAdd(&bar[XB_TMO], 1u); break; } }
    }
    nloc = mine > 0u ? mine : 1u; nx = cnt > 0u ? cnt : 1u;
}
__device__ __forceinline__ void xcd_barrier(const XcdBarrier& b) {
    asm volatile("s_waitcnt vmcnt(0)" ::: "memory");
    __syncthreads();
    if (threadIdx.x == 0) {
        unsigned* bar = b.bar;
        __builtin_amdgcn_s_waitcnt(0);
        unsigned nloc = b.st[0], nx = b.st[1];
        if (nloc == 0u) { xcd_barrier_complete(bar, b.x, nloc, nx); b.st[0] = nloc; b.st[1] = nx; }
        const unsigned old = xb_add(&bar[XB_XSUB(b.x)], 1u);
        const unsigned gen = old / nloc;
        if (old + 1u == (gen + 1u) * nloc) {
            __builtin_amdgcn_fence(__ATOMIC_RELEASE, "agent");
            asm volatile("s_waitcnt vmcnt(0)" ::: "memory");
            const unsigned og = xb_add(&bar[XB_TOP], 1u);
            const unsigned tg = og / nx;
            if (og + 1u == (tg + 1u) * nx) xb_add(&bar[XB_TOPGEN], 1u);
            else XB_SPIN(xb_ld(&bar[XB_TOPGEN]) == tg, bar);
            __builtin_amdgcn_fence(__ATOMIC_ACQUIRE, "agent");
            xb_add(&bar[XB_XGEN(b.x)], 1u);
            asm volatile("s_waitcnt vmcnt(0)" ::: "memory");
        } else {
            XB_SPIN(xb_ld(&bar[XB_XGEN(b.x)]) == gen, bar);
            __builtin_amdgcn_fence(__ATOMIC_ACQUIRE, "agent");
            asm volatile("s_waitcnt vmcnt(0)" ::: "memory");
        }
    }
    __syncthreads();
}

namespace pg8 {
constexpr int BM = 256, BK = 64, HALF = 128, HTB = HALF * BK * 2, NXCD = 8, WGM = 8;
__device__ __forceinline__ int lds_byte(int r, int c) { const int st = (r >> 4) * 2 + (c >> 5), rr = r & 15, cc = c & 31, ob = rr * 64 + cc * 2; return st * 1024 + (ob ^ (((ob >> 9) & 1) << 5)); }
__device__ __forceinline__ void stage_rc(int b, int& R, int& C) { const int st = b / 1024, sb = b % 1024, swz = sb ^ (((sb >> 9) & 1) << 5); R = (st >> 1) * 16 + swz / 64; C = (st & 1) * 32 + (swz % 64) / 2; }
__device__ __forceinline__ int perm32(int rho) { const int n = rho >> 4, i = rho & 15; return 8 * (i >> 2) + 4 * n + (i & 3); }
struct Unit { int pm, pn, e, j, cnt; };

template <class Epi, class Sched>
__device__ __forceinline__ void gemm_phase(LAS unsigned char* lds, const int tid, const int K, const Sched& S, const Epi& E) {
    const int wid = __builtin_amdgcn_readfirstlane(tid >> 6), lane = tid & 63, wr = wid >> 2, wc = wid & 3, fr = lane & 15, fq = lane >> 4;
    const int nt = K / BK;
    int Rr[2]; unsigned Cb[2], voffB[2];
#pragma unroll
    for (int i = 0; i < 2; ++i) { int R, C; stage_rc(tid * 16 + i * 8192, R, C); const int Rb = Epi::PERM ? ((R & ~31) + perm32(R & 31)) : R;
        Rr[i] = R; Cb[i] = (unsigned)C * 2u; voffB[i] = (unsigned)(Rb * K + C) * 2u; }
    const size_t kstep = (size_t)(BK * 2);
    const size_t hstep = (size_t)HALF * K * 2;
    const unsigned ldsw = (unsigned)wid * 1024u;
    const int aoff = lds_byte(wr * 64 + fr, fq * 8), boff = lds_byte(wc * 32 + fr, fq * 8);
#define PG8_SA(b, h) (((b) * 2 + (h)) * HTB)
#define PG8_SB(b, h) ((4 + (b) * 2 + (h)) * HTB)
#define PG8_STAGE(bufoff, gbase, voff) do { _Pragma("unroll") for (int _i = 0; _i < 2; ++_i) \
        __builtin_amdgcn_global_load_lds((const unsigned*)((const char*)(gbase) + (voff)[_i]), (LAS unsigned*)(lds + (bufoff) + ldsw + _i * 8192), 16, 0, 0); } while (0)
#define PG8_LDA(dst, b, h) do { _Pragma("unroll") for (int m = 0; m < 4; ++m) _Pragma("unroll") for (int k = 0; k < 2; ++k) dst[m][k] = *(const LAS bf16x8*)(lds + PG8_SA(b, h) + aoff + m * 2048 + k * 1024); } while (0)
#define PG8_LDB(dst, b, h) do { _Pragma("unroll") for (int n = 0; n < 2; ++n) _Pragma("unroll") for (int k = 0; k < 2; ++k) dst[n][k] = *(const LAS bf16x8*)(lds + PG8_SB(b, h) + boff + n * 2048 + k * 1024); } while (0)
#define PG8_MMA(ai, bj, At, Bt) do { __builtin_amdgcn_s_setprio(1); _Pragma("unroll") for (int m = 0; m < 4; ++m) _Pragma("unroll") for (int n = 0; n < 2; ++n) _Pragma("unroll") for (int k = 0; k < 2; ++k) \
        acc[ai][bj][m][n] = __builtin_amdgcn_mfma_f32_16x16x32_bf16(Bt[n][k], At[m][k], acc[ai][bj][m][n], 0, 0, 0); __builtin_amdgcn_s_setprio(0); } while (0)
#define PG8_WAIT_V(n) asm volatile("s_waitcnt vmcnt(" #n ")" ::: "memory")
#define PG8_WAIT_L(n) asm volatile("s_waitcnt lgkmcnt(" #n ")" ::: "memory")
#define PG8_BAR __builtin_amdgcn_s_barrier()
#define PG8_SCHED __builtin_amdgcn_sched_barrier(0)
    Unit cur, nxt; int ui = 0;
    if (!S.next(0, cur)) return;
    f32x4 acc[2][2][4][2];
#pragma unroll
    for (int a = 0; a < 2; ++a)
#pragma unroll
        for (int b = 0; b < 2; ++b)
#pragma unroll
            for (int m = 0; m < 4; ++m)
#pragma unroll
                for (int n = 0; n < 2; ++n) acc[a][b][m][n] = (f32x4){0.f, 0.f, 0.f, 0.f};
    bf16x8 At[4][2], B0[2][2], B1[2][2];
    unsigned vA0[2], vA1[2];
    const char* cA = S.a_ptr(cur);
    if constexpr (Sched::GATHER) { S.a_offs(cur, Rr, vA0, vA1);
#pragma unroll
        for (int i = 0; i < 2; ++i) { vA0[i] += Cb[i]; vA1[i] += Cb[i]; }
        asm volatile("s_waitcnt vmcnt(0)" ::: "memory");
    } else {
#pragma unroll
        for (int i = 0; i < 2; ++i) { vA0[i] = (unsigned)(Rr[i] * K * 2) + Cb[i]; vA1[i] = vA0[i]; } }
    const size_t ahs = Sched::GATHER ? (size_t)0 : hstep;
    const char* cB = S.b_ptr(cur);
    PG8_STAGE(PG8_SB(0, 0), cB, voffB); PG8_STAGE(PG8_SB(0, 1), cB + hstep, voffB); PG8_STAGE(PG8_SA(0, 0), cA, vA0); PG8_STAGE(PG8_SA(0, 1), cA + ahs, vA1);
    if (wr == 1) PG8_BAR;
    PG8_WAIT_V(2); PG8_BAR;
    PG8_STAGE(PG8_SB(1, 0), cB + kstep, voffB); PG8_STAGE(PG8_SA(1, 0), cA + kstep, vA0); PG8_STAGE(PG8_SB(1, 1), cB + hstep + kstep, voffB);
    PG8_WAIT_V(6); PG8_BAR;
    for (;;) {
        const bool has_next = S.next(ui + 1, nxt);
        const char* nA = has_next ? S.a_ptr(nxt) : cA; const char* nB = has_next ? S.b_ptr(nxt) : cB;
        for (int t = 0; t < nt; t += 2) {
            const bool last = (t == nt - 2);
            const char* a1 = cA + (size_t)(t + 1) * kstep;
            const char* a2 = last ? nA : cA + (size_t)(t + 2) * kstep; const char* b2 = last ? nB : cB + (size_t)(t + 2) * kstep;
            const char* a3 = a2 + kstep; const char* b3 = b2 + kstep;
            PG8_LDB(B0, 0, 0); PG8_LDB(B1, 0, 1); PG8_SCHED; PG8_LDA(At, 0, 0); PG8_STAGE(PG8_SA(1, 1), a1 + ahs, vA1);
            if constexpr (Sched::GATHER) { if (last && has_next) { S.a_offs(nxt, Rr, vA0, vA1);
#pragma unroll
                for (int i = 0; i < 2; ++i) { vA0[i] += Cb[i]; vA1[i] += Cb[i]; }
                asm volatile("s_waitcnt vmcnt(0)" ::: "memory"); } }
            PG8_WAIT_V(8); PG8_WAIT_L(0); PG8_BAR; PG8_MMA(0, 0, At, B0); PG8_MMA(0, 1, At, B1); PG8_BAR; PG8_SCHED;
            PG8_LDA(At, 0, 1); PG8_STAGE(PG8_SB(0, 0), b2, voffB); PG8_STAGE(PG8_SB(0, 1), b2 + hstep, voffB); PG8_STAGE(PG8_SA(0, 0), a2, vA0);
            PG8_WAIT_V(8); PG8_WAIT_L(0); PG8_BAR; PG8_MMA(1, 0, At, B0); PG8_MMA(1, 1, At, B1); PG8_BAR; PG8_SCHED;
            PG8_LDB(B0, 1, 0); PG8_LDB(B1, 1, 1); PG8_SCHED; PG8_LDA(At, 1, 0); PG8_STAGE(PG8_SA(0, 1), a2 + ahs, vA1);
            PG8_WAIT_V(8); PG8_WAIT_L(0); PG8_BAR; PG8_MMA(0, 0, At, B0); PG8_MMA(0, 1, At, B1); PG8_BAR; PG8_SCHED;
            PG8_LDA(At, 1, 1); PG8_STAGE(PG8_SB(1, 0), b3, voffB); PG8_STAGE(PG8_SB(1, 1), b3 + hstep, voffB); PG8_STAGE(PG8_SA(1, 0), a3, vA0);
            PG8_WAIT_V(8); PG8_WAIT_L(0); PG8_BAR; PG8_MMA(1, 0, At, B0); PG8_MMA(1, 1, At, B1); PG8_BAR; PG8_SCHED;
        }
        if (wr == 0) PG8_BAR;
        E(acc, cur, wr, wc, fr, fq);
        if (!has_next) break;
#pragma unroll
        for (int a = 0; a < 2; ++a)
#pragma unroll
            for (int b = 0; b < 2; ++b)
#pragma unroll
                for (int m = 0; m < 4; ++m)
#pragma unroll
                    for (int n = 0; n < 2; ++n) acc[a][b][m][n] = (f32x4){0.f, 0.f, 0.f, 0.f};
        cur = nxt; cA = nA; cB = nB; ++ui;
        if (wr == 1) PG8_BAR;
    }
    PG8_WAIT_V(0);
    PG8_BAR;
#undef PG8_SA
#undef PG8_SB
#undef PG8_STAGE
#undef PG8_LDA
#undef PG8_LDB
#undef PG8_MMA
#undef PG8_WAIT_V
#undef PG8_WAIT_L
#undef PG8_BAR
#undef PG8_SCHED
}
__device__ __forceinline__ unsigned cvt_pk_bf16(float lo, float hi) { unsigned r; asm volatile("v_cvt_pk_bf16_f32 %0, %1, %2" : "=v"(r) : "v"(lo), "v"(hi)); return r; }

struct DenseSched {
    const char* A; const char* Bt; int K, nM, nN, nwg, G, c;
    __device__ void init(const void* A_, const void* Bt_, int K_, int M, int N, int G_, int c_) { A = (const char*)A_; Bt = (const char*)Bt_; K = K_; nM = M / BM; nN = N / BM; nwg = nM * nN; G = G_; c = c_; }
    __device__ __forceinline__ bool next(int i, Unit& u) const {
        const long L = (long)i * G + c; if (L >= nwg) return false;
        int wgid = (int)L; { const int q = nwg / NXCD, r = nwg % NXCD, xcd = wgid % NXCD, off = wgid / NXCD; wgid = (xcd < r ? xcd * (q + 1) : r * (q + 1) + (xcd - r) * q) + off; }
        const int nig = WGM * nN, gid = wgid / nig, fm = gid * WGM, gsz = (nM - fm) < WGM ? (nM - fm) : WGM;
        u.pm = fm + ((wgid % nig) % gsz); u.pn = (wgid % nig) / gsz; u.e = 0; u.j = 0; u.cnt = 256; return true;
    }
    static constexpr bool GATHER = false;
    __device__ __forceinline__ const char* a_ptr(const Unit& u) const { return A + (size_t)u.pm * BM * K * 2; }
    __device__ __forceinline__ void a_offs(const Unit&, const int (&)[2], unsigned (&)[2], unsigned (&)[2]) const {}
    __device__ __forceinline__ const char* b_ptr(const Unit& u) const { return Bt + (size_t)u.pn * BM * K * 2; }
};
template <bool GATHER_> struct MoeSched {
    static constexpr bool GATHER = GATHER_;
    const char* A; const char* W; size_t wstride; int K, G, c; const int* elist; const volatile LAS int* T; const volatile LAS int* Cn;
    __device__ __forceinline__ bool next(int i, Unit& u) const {
        const long L = (long)i * G + c; const int nT = T[16]; if (L >= 4L * nT) return false;
        const int tile = (int)(L >> 2); u.pn = (int)(L & 3); u.pm = tile;
        int e = 0;
#pragma unroll
        for (int k = 1; k < 16; ++k) e += (tile >= T[k]) ? 1 : 0;
        u.e = e; u.j = tile - T[e]; u.cnt = Cn[e]; return true;
    }
    __device__ __forceinline__ const char* a_ptr(const Unit& u) const { return GATHER ? A : A + (size_t)u.pm * BM * K * 2; }
    __device__ __forceinline__ void a_offs(const Unit& u, const int (&Rr)[2], unsigned (&v0)[2], unsigned (&v1)[2]) const {
#pragma unroll
        for (int i = 0; i < 2; ++i) {
            const int p0 = u.j * BM + Rr[i], p1 = p0 + HALF;
            int t0 = p0 < u.cnt ? (elist[u.e * NROW + p0] >> 1) : 0, t1 = p1 < u.cnt ? (elist[u.e * NROW + p1] >> 1) : 0;
            t0 = min(max(t0, 0), NROW - 1); t1 = min(max(t1, 0), NROW - 1);
            v0[i] = (unsigned)(t0 * K * 2); v1[i] = (unsigned)(t1 * K * 2);
        } }
    __device__ __forceinline__ const char* b_ptr(const Unit& u) const { return W + (size_t)u.e * wstride + (size_t)u.pn * BM * K * 2; }
};
struct EpiP {
    static constexpr bool PERM = true;
    bf16* O;
    __device__ __forceinline__ void operator()(const f32x4 (&acc)[2][2][4][2], const Unit& u, int wr, int wc, int fr, int fq) const {
        const int row0 = u.pm * BM + wr * 64 + fr, col0 = u.pn * BM + wc * 32 + 8 * fq;
#pragma unroll
        for (int ai = 0; ai < 2; ++ai)
#pragma unroll
            for (int m = 0; m < 4; ++m) { bf16* rowp = O + (size_t)(row0 + ai * HALF + m * 16) * NP + col0;
#pragma unroll
                for (int bj = 0; bj < 2; ++bj) { const f32x4 v0 = acc[ai][bj][m][0], v1 = acc[ai][bj][m][1];
                    u32x4 w; w.x = cvt_pk_bf16(v0[0], v0[1]); w.y = cvt_pk_bf16(v0[2], v0[3]); w.z = cvt_pk_bf16(v1[0], v1[1]); w.w = cvt_pk_bf16(v1[2], v1[3]);
                    *(u32x4*)(rowp + bj * HALF) = w; } }
    }
};
struct EpiRes {
    static constexpr bool PERM = false;
    const float* hin_l; const float* hin_c; float* hout_l; float* hout_c; const float* gate; float gsc;
    __device__ __forceinline__ void operator()(const f32x4 (&acc)[2][2][4][2], const Unit& u, int wr, int wc, int fr, int fq) const {
        const int row0 = u.pm * BM + wr * 64 + fr, col0 = u.pn * BM + wc * 32 + 4 * fq;
#pragma unroll
        for (int ai = 0; ai < 2; ++ai)
#pragma unroll
            for (int m = 0; m < 4; ++m) { const int r = row0 + ai * HALF + m * 16; const bool lat = r < NLAT; const int bb = lat ? (r >> 11) : 8;
                const float* hi = lat ? hin_l + (size_t)r * DM : hin_c + (size_t)(r - NLAT) * DM; float* ho = lat ? hout_l + (size_t)r * DM : hout_c + (size_t)(r - NLAT) * DM;
                const float* g = gate + (size_t)bb * 6144;
#pragma unroll
                for (int bj = 0; bj < 2; ++bj)
#pragma unroll
                    for (int n = 0; n < 2; ++n) { const int c = col0 + bj * HALF + n * 16; const f32x4 gv = *(const f32x4*)(g + c), hv = *(const f32x4*)(hi + c);
                        *(f32x4*)(ho + c) = hv + gv * gsc * acc[ai][bj][m][n]; } }
    }
};
struct EpiAct {
    static constexpr bool PERM = true;
    bf16* O;
    __device__ __forceinline__ void operator()(const f32x4 (&acc)[2][2][4][2], const Unit& u, int wr, int wc, int fr, int fq) const {
        const int row0 = u.pm * BM + wr * 64 + fr, col0 = u.pn * HALF + wc * 32 + 8 * fq;
#pragma unroll
        for (int ai = 0; ai < 2; ++ai)
#pragma unroll
            for (int m = 0; m < 4; ++m) { bf16* rowp = O + (size_t)(row0 + ai * HALF + m * 16) * FF + col0;
                float o[8];
#pragma unroll
                for (int n = 0; n < 2; ++n)
#pragma unroll
                    for (int j = 0; j < 4; ++j) { const float g = acc[ai][0][m][n][j], up = acc[ai][1][m][n][j]; o[n * 4 + j] = g / (1.f + __expf(-g)) * up; }
                u32x4 w; w.x = cvt_pk_bf16(o[0], o[1]); w.y = cvt_pk_bf16(o[2], o[3]); w.z = cvt_pk_bf16(o[4], o[5]); w.w = cvt_pk_bf16(o[6], o[7]);
                *(u32x4*)rowp = w; }
    }
};
struct EpiDown {
    static constexpr bool PERM = true;
    bf16* O; const int* elist; const float* rtw;
    __device__ __forceinline__ void operator()(const f32x4 (&acc)[2][2][4][2], const Unit& u, int wr, int wc, int fr, int fq) const {
        const int col0 = u.pn * BM + wc * 32 + 8 * fq;
#pragma unroll
        for (int ai = 0; ai < 2; ++ai)
#pragma unroll
            for (int m = 0; m < 4; ++m) { const int pos = u.j * BM + ai * HALF + wr * 64 + m * 16 + fr;
                if (pos < u.cnt) { const int a = min(max(elist[u.e * NROW + pos], 0), 2 * NROW - 1); const float w8 = rtw[a]; bf16* rowp = O + (size_t)a * DM + col0;
#pragma unroll
                    for (int bj = 0; bj < 2; ++bj) { const f32x4 v0 = acc[ai][bj][m][0] * w8, v1 = acc[ai][bj][m][1] * w8;
                        u32x4 w; w.x = cvt_pk_bf16(v0[0], v0[1]); w.y = cvt_pk_bf16(v0[2], v0[3]); w.z = cvt_pk_bf16(v1[0], v1[1]); w.w = cvt_pk_bf16(v1[2], v1[3]);
                        *(u32x4*)(rowp + bj * HALF) = w; } } }
    }
};
}

struct Args { const float* in[36]; float* out; unsigned char* ws; int ph_lo, ph_hi; };
struct Fr {
    LAS unsigned char* lds; int tid, lane, wave, G, vcu, gw, NGW; const __attribute__((address_space(4))) Args* A;
    __device__ __forceinline__ const float* x() const { return A->in[0]; }
    __device__ __forceinline__ const float* cvec() const { return A->in[1]; }
    __device__ __forceinline__ const float* ctx() const { return A->in[2]; }
    __device__ __forceinline__ const float* cctx() const { return A->in[3]; }
    __device__ __forceinline__ const float* w_mod() const { return A->in[4]; }
    __device__ __forceinline__ const float* b_mod() const { return A->in[5]; }
    __device__ __forceinline__ const float* g_mix() const { return A->in[6]; }
    __device__ __forceinline__ const float* w_in() const { return A->in[7]; }
    __device__ __forceinline__ const float* w_out() const { return A->in[8]; }
    __device__ __forceinline__ const float* na_gq() const { return A->in[9]; }
    __device__ __forceinline__ const float* na_gk() const { return A->in[10]; }
    __device__ __forceinline__ const float* na_rb() const { return A->in[11]; }
    __device__ __forceinline__ const float* mla_gqa() const { return A->in[12]; }
    __device__ __forceinline__ const float* mla_wqb() const { return A->in[13]; }
    __device__ __forceinline__ const float* mla_gkva() const { return A->in[14]; }
    __device__ __forceinline__ const float* mla_wkvb() const { return A->in[15]; }
    __device__ __forceinline__ const float* mla_gq() const { return A->in[16]; }
    __device__ __forceinline__ const float* mla_gk() const { return A->in[17]; }
    __device__ __forceinline__ const float* df_gq() const { return A->in[18]; }
    __device__ __forceinline__ const float* df_gk() const { return A->in[19]; }
    __device__ __forceinline__ const float* df_lam() const { return A->in[20]; }
    __device__ __forceinline__ const float* df_gsub() const { return A->in[21]; }
    __device__ __forceinline__ const float* conv_w() const { return A->in[22]; }
    __device__ __forceinline__ const float* conv_b() const { return A->in[23]; }
    __device__ __forceinline__ const float* dt_bias() const { return A->in[24]; }
    __device__ __forceinline__ const float* a_log() const { return A->in[25]; }
    __device__ __forceinline__ const float* ssd_d() const { return A->in[26]; }
    __device__ __forceinline__ const float* ssd_gn() const { return A->in[27]; }
    __device__ __forceinline__ const float* g_ffn() const { return A->in[28]; }
    __device__ __forceinline__ const float* w_grp() const { return A->in[29]; }
    __device__ __forceinline__ const float* b_grp() const { return A->in[30]; }
    __device__ __forceinline__ const float* w_exp() const { return A->in[31]; }
    __device__ __forceinline__ const float* b_exp() const { return A->in[32]; }
    __device__ __forceinline__ const float* w_gate() const { return A->in[33]; }
    __device__ __forceinline__ const float* w_up() const { return A->in[34]; }
    __device__ __forceinline__ const float* w_down() const { return A->in[35]; }
    __device__ __forceinline__ float* out() const { return A->out; }
    __device__ __forceinline__ unsigned* ctl() const { return (unsigned*)(A->ws + WS_CTL); }
    __device__ __forceinline__ float* modv() const { return (float*)(A->ws + WS_MOD); }
    __device__ __forceinline__ float* rcos() const { return (float*)(A->ws + WS_ROPE); }
    __device__ __forceinline__ float* rsin() const { return (float*)(A->ws + WS_ROPE + TLAT * 16 * 4); }
    __device__ __forceinline__ bf16* winT() const { return (bf16*)(A->ws + WS_WIN); }
    __device__ __forceinline__ bf16* woutT() const { return (bf16*)(A->ws + WS_WOUT); }
    __device__ __forceinline__ bf16* wqbT() const { return (bf16*)(A->ws + WS_WQB); }
    __device__ __forceinline__ bf16* wkvbT() const { return (bf16*)(A->ws + WS_WKVB); }
    __device__ __forceinline__ bf16* wgu(int par = 0) const { return (bf16*)(A->ws + (par ? WS_WGU2 : WS_WGU)); }
    __device__ __forceinline__ bf16* wd(int par = 0) const { return (bf16*)(A->ws + (par ? WS_WD2 : WS_WD)); }
    __device__ __forceinline__ float* hc() const { return (float*)(A->ws + WS_HC); }
    __device__ __forceinline__ bf16* abuf() const { return (bf16*)(A->ws + WS_A); }
    __device__ __forceinline__ bf16* pbuf() const { return (bf16*)(A->ws + WS_P); }
    __device__ __forceinline__ bf16* act() const { return (bf16*)(A->ws + WS_ACT); }
    __device__ __forceinline__ bf16* yk() const { return (bf16*)(A->ws + WS_YK); }
    __device__ __forceinline__ bf16* mix() const { return (bf16*)(A->ws + WS_MIX); }
    __device__ __forceinline__ bf16* qna() const { return (bf16*)(A->ws + WS_QNA); }
    __device__ __forceinline__ bf16* kna() const { return (bf16*)(A->ws + WS_KNA); }
    __device__ __forceinline__ bf16* vna() const { return (bf16*)(A->ws + WS_VNA); }
    __device__ __forceinline__ bf16* qml() const { return (bf16*)(A->ws + WS_QML); }
    __device__ __forceinline__ bf16* kml() const { return (bf16*)(A->ws + WS_KML); }
    __device__ __forceinline__ bf16* vml() const { return (bf16*)(A->ws + WS_VML); }
    __device__ __forceinline__ bf16* qdf() const { return (bf16*)(A->ws + WS_QDF); }
    __device__ __forceinline__ bf16* kdf() const { return (bf16*)(A->ws + WS_KDF); }
    __device__ __forceinline__ bf16* vdf() const { return (bf16*)(A->ws + WS_VDF); }
    __device__ __forceinline__ bf16* xT() const { return (bf16*)(A->ws + WS_XT); }
    __device__ __forceinline__ bf16* btm() const { return (bf16*)(A->ws + WS_BTM); }
    __device__ __forceinline__ bf16* bT() const { return (bf16*)(A->ws + WS_BT); }
    __device__ __forceinline__ bf16* ctm() const { return (bf16*)(A->ws + WS_CTM); }
    __device__ __forceinline__ float* dtv() const { return (float*)(A->ws + WS_DT); }
    __device__ __forceinline__ float* cst() const { return (float*)(A->ws + WS_CST); }
    __device__ __forceinline__ float* cdec() const { return (float*)(A->ws + WS_CDEC); }
    __device__ __forceinline__ bf16* hent() const { return (bf16*)(A->ws + WS_HENT); }
    __device__ __forceinline__ float* ydir() const { return (float*)(A->ws + WS_CST); }
    __device__ __forceinline__ int* rte() const { return (int*)(A->ws + WS_RT); }
    __device__ __forceinline__ float* rtw() const { return (float*)(A->ws + WS_RT + 256 * 1024); }
    __device__ __forceinline__ int* elist() const { return (int*)(A->ws + WS_ELIST); }
};

__device__ __forceinline__ Fr refresh(const Fr& F0) { Fr F = F0; int w = F0.wave; asm volatile("" : "+s"(w)); asm volatile("" : "+s"(F.A));
    int l; asm volatile("v_mbcnt_lo_u32_b32 %0, -1, 0\n\tv_mbcnt_hi_u32_b32 %0, -1, %0" : "=v"(l)); F.wave = w; F.lane = l; F.tid = w * 64 + l; F.gw = F.vcu * 8 + w; return F; }
__device__ __forceinline__ void tr_item(const float* W, int ldw, int nvalid, int k0, int n0, bf16* dst, int ldd, LAS float* scr, int lane, const float* ksc = nullptr) {
    const int cn = n0 + (lane & 31), cnc = min(cn, nvalid - 1);
    float tv[32];
#pragma unroll
    for (int i = 0; i < 32; ++i) { const int kk = 2 * i + (lane >> 5); tv[i] = W[(size_t)(k0 + kk) * ldw + cnc]; }
#pragma unroll
    for (int i = 0; i < 32; ++i) { const int kk = 2 * i + (lane >> 5); const float sc1 = ksc ? ksc[k0 + kk] : 1.f; scr[kk * 33 + (lane & 31)] = cn < nvalid ? tv[i] * sc1 : 0.f; }
    LDS_WAIT();
    const int c = lane & 7;
#pragma unroll
    for (int j = 0; j < 4; ++j) { const int n = (lane >> 3) + 8 * j; const LAS float* s = scr + (8 * c) * 33 + n;
        u32x4 o; o.x = pk2(s[0 * 33], s[1 * 33]); o.y = pk2(s[2 * 33], s[3 * 33]); o.z = pk2(s[4 * 33], s[5 * 33]); o.w = pk2(s[6 * 33], s[7 * 33]);
        *(u32x4*)(dst + (size_t)n * ldd + k0 + 8 * c) = o; }
    LDS_WAIT();
}
__device__ __forceinline__ void moe_weight_convert(const Fr& F, int L, int gw0 = -1, int ngw0 = 0) {
    LAS float* scr = (LAS float*)(F.lds + F.wave * 16384);
    const int gwc = gw0 >= 0 ? gw0 : F.gw, ngwc = gw0 >= 0 ? ngw0 : F.NGW; bf16* const wgu_ = F.wgu(L & 1); bf16* const wd_ = F.wd(L & 1);
    constexpr int I_GU = 16 * 16, I_D = 8 * 32;
    for (int it = gwc; it < NEXP * (2 * I_GU + I_D); it += ngwc) {
        const int e = it / (2 * I_GU + I_D); int r = it % (2 * I_GU + I_D);
        if (r < 2 * I_GU) { const int bj = r / I_GU; r %= I_GU; const int kb = r / 16, nb = r % 16, n0 = nb * 32;
            const float* W = (bj ? F.w_up() : F.w_gate()) + ((size_t)L * NEXP + e) * DM * FF;
            tr_item(W, FF, FF, kb * 64, n0, wgu_ + ((size_t)e * 1024 + (n0 >> 7) * 256 + bj * 128 + (n0 & 127)) * DM, DM, scr, F.lane);
        } else { r -= 2 * I_GU; const int kb = r / 32, nb = r % 32, n0 = nb * 32;
            const float* W = F.w_down() + ((size_t)L * NEXP + e) * FF * DM;
            tr_item(W, DM, DM, kb * 64, n0, wd_ + ((size_t)e * 1024 + n0) * FF, FF, scr, F.lane); }
    }
}
__device__ __forceinline__ void phase_prologue(const Fr& F) {
    {   LAS float* sc = (LAS float*)F.lds;
        LAS float* part = (LAS float*)(F.lds + 40960);
        for (int i = F.tid; i < 9 * 1024; i += 512) { const float v = i < 8192 ? F.cvec()[i] : F.cctx()[i - 8192]; sc[i] = siluf(v); }
        __syncthreads();
        for (int u = F.vcu; u < 384; u += F.G) {
            const int col = u * 64 + F.lane, L = col / 6144, n = col - L * 6144;
            const float* w = F.w_mod() + ((size_t)L * 1024 + F.wave * 128) * 6144 + n;
            float acc[9];
#pragma unroll
            for (int b = 0; b < 9; ++b) acc[b] = 0.f;
#pragma unroll 1
            for (int k0 = 0; k0 < 128; k0 += 16) { float wv[16];
#pragma unroll
                for (int j = 0; j < 16; ++j) wv[j] = w[(size_t)(k0 + j) * 6144];
#pragma unroll
                for (int j = 0; j < 16; ++j)
#pragma unroll
                    for (int b = 0; b < 9; ++b) acc[b] += sc[b * 1024 + F.wave * 128 + k0 + j] * wv[j]; }
#pragma unroll
            for (int b = 0; b < 9; ++b) part[(F.wave * 9 + b) * 64 + F.lane] = acc[b];
            __syncthreads();
            for (int i = F.tid; i < 9 * 64; i += 512) { const int b = i >> 6, l = i & 63; float s = 0.f;
#pragma unroll
                for (int w8 = 0; w8 < 8; ++w8) s += part[(w8 * 9 + b) * 64 + l];
                const int c2 = u * 64 + l, L2 = c2 / 6144, n2 = c2 - L2 * 6144;
                F.modv()[((size_t)L2 * 9 + b) * 6144 + n2] = s + F.b_mod()[L2 * 6144 + n2]; }
            __syncthreads();
        }
    }
    if (blockIdx.x == 0 && F.wave < 4) {
#pragma unroll 1
        for (int q = 0; q < 4; ++q) { const int lh = F.wave * 4 + q; float bm = 0.f;
            for (int i = F.lane; i < 465; i += 64) bm = fmaxf(bm, F.na_rb()[lh * 465 + i]);
            bm = wmaxf(bm); if (F.lane == 0) (F.rcos() + 2 * TLAT * 16)[lh] = bm * 1.4426950408889634f; } }
    for (int i = blockIdx.x * 512 + F.tid; i < TLAT * 16; i += F.G * 512) { const int t = i >> 4, k = i & 15; const float inv = powf(10000.f, -(float)(k & 7) / 8.f);
        const float pos = (k < 8) ? (float)(t >> 6) : (float)(t & 63); const float ang = pos * inv; F.rcos()[i] = cosf(ang); F.rsin()[i] = sinf(ang); }
    __syncthreads();
    LAS float* scr = (LAS float*)(F.lds + F.wave * 16384);
    constexpr int I_IN = 16 * 96, I_OUT = 16 * 32, I_QB = 4 * 12, I_KVB = 2 * 16, I_L = I_IN + I_OUT + I_QB + I_KVB;
    for (int it = F.gw; it < DEPTH * I_L; it += F.NGW) {
        const int L = it / I_L; int r = it % I_L;
        if (r < I_IN) { const int kb = r / 96, nb = r % 96; tr_item(F.w_in() + (size_t)L * DM * NIN, NIN, NIN, kb * 64, nb * 32, F.winT() + ((size_t)L * NP + nb * 32) * DM, DM, scr, F.lane); continue; } r -= I_IN;
        if (r < I_OUT) { const int kb = r / 32, nb = r % 32; tr_item(F.w_out() + (size_t)L * DM * DM, DM, DM, kb * 64, nb * 32, F.woutT() + ((size_t)L * DM + nb * 32) * DM, DM, scr, F.lane); continue; } r -= I_OUT;
        if (r < I_QB) { const int kb = r / 12, nb = r % 12; tr_item(F.mla_wqb() + (size_t)L * 256 * 384, 384, 384, kb * 64, nb * 32, F.wqbT() + ((size_t)L * 384 + nb * 32) * 256, 256, scr, F.lane, F.mla_gqa() + L * 256); continue; } r -= I_QB;
        { const int kb = r / 16, nb = r % 16; tr_item(F.mla_wkvb() + (size_t)L * 128 * 512, 512, 512, kb * 64, nb * 32, F.wkvbT() + ((size_t)L * 512 + nb * 32) * 128, 128, scr, F.lane, F.mla_gkva() + L * 128); }
    }
}

__device__ __forceinline__ void phase_norm(const Fr& F, int L, bool combine = true) {
    const int nrows = (L == DEPTH) ? NLAT : NROW;
    for (int r = F.gw; r < nrows; r += F.NGW) {
        const bool lat = r < NLAT; const int bb = lat ? (r >> 11) : 8;
        const float* hin = (L == 0) ? (lat ? F.x() + (size_t)r * DM : F.ctx() + (size_t)(r - NLAT) * DM) : (lat ? F.out() + (size_t)r * DM : F.hc() + (size_t)(r - NLAT) * DM);
        float* hout = lat ? F.out() + (size_t)r * DM : F.hc() + (size_t)(r - NLAT) * DM;
        f32x4 v[4];
#pragma unroll
        for (int j = 0; j < 4; ++j) v[j] = *(const f32x4*)(hin + 4 * F.lane + 256 * j);
        if (L > 0 && combine) {
            const float* m5 = F.modv() + ((size_t)(L - 1) * 9 + bb) * 6144 + 5 * 1024;
#pragma unroll
            for (int j = 0; j < 4; ++j) { const int c = 4 * F.lane + 256 * j; const f32x4 g = *(const f32x4*)(m5 + c);
                const u32x2 y0 = *(const u32x2*)(F.yk() + (size_t)(2 * r) * DM + c), y1 = *(const u32x2*)(F.yk() + (size_t)(2 * r + 1) * DM + c);
                f32x4 ys; ys[0] = __uint_as_float(y0.x << 16) + __uint_as_float(y1.x << 16); ys[1] = __uint_as_float(y0.x & 0xffff0000u) + __uint_as_float(y1.x & 0xffff0000u);
                ys[2] = __uint_as_float(y0.y << 16) + __uint_as_float(y1.y << 16); ys[3] = __uint_as_float(y0.y & 0xffff0000u) + __uint_as_float(y1.y & 0xffff0000u);
                v[j] = v[j] + g * ys; *(f32x4*)(hout + c) = v[j]; }
        }
        if (L == DEPTH) continue;
        float ss = 0.f;
#pragma unroll
        for (int j = 0; j < 4; ++j) ss += (v[j][0] * v[j][0] + v[j][1] * v[j][1]) + (v[j][2] * v[j][2] + v[j][3] * v[j][3]);
        const float rstd = rsqrtf(wsum(ss) * (1.f / DM) + EPS);
        const float* md = F.modv() + ((size_t)L * 9 + bb) * 6144;
#pragma unroll
        for (int j = 0; j < 4; ++j) { const int c = 4 * F.lane + 256 * j; const f32x4 g = *(const f32x4*)(F.g_mix() + L * DM + c), sh = *(const f32x4*)(md + c), scl = *(const f32x4*)(md + 1024 + c);
            const f32x4 a = v[j] * rstd * g * (scl + 1.f) + sh; u32x2 o; o.x = pk2(a[0], a[1]); o.y = pk2(a[2], a[3]); *(u32x2*)(F.abuf() + (size_t)r * DM + c) = o; }
    }
}

__device__ __forceinline__ void prep_row(const Fr& F, int L, int r, LAS float* scr) {
    int lane_ = F.lane; asm volatile("" : "+v"(lane_)); const int lane = lane_; int b, s; row2bs(r, b, s); const bool lat = r < NLAT; const int t = s - 256;
    const bf16* p = F.pbuf() + (size_t)r * NP;
#pragma unroll
    for (int h = 0; h < 4; ++h) {
        const float q = bf2f(p[C_NA + h * 64 + lane]), k = bf2f(p[C_NA + 256 + h * 64 + lane]);
        const float rq = rsqrtf(wsum(q * q) * (1.f / 64) + EPS), rk = rsqrtf(wsum(k * k) * (1.f / 64) + EPS);
        const size_t o = ((size_t)(b * 4 + h) * SQ + s) * 64 + lane;
        F.qna()[o] = f2bf(q * rq * F.na_gq()[L * 64 + lane]); F.kna()[o] = f2bf(k * rk * F.na_gk()[L * 64 + lane]);
    }
    {
        const int idx = lane & 31; float cs = 1.f, sn = 0.f;
        if (lat) { cs = F.rcos()[t * 16 + (idx & 15)]; sn = F.rsin()[t * 16 + (idx & 15)]; }
#pragma unroll
        for (int h = 0; h < 4; ++h) {
            float q = bf2f(p[C_DF + h * 64 + lane]), k = bf2f(p[C_DF + 256 + h * 64 + lane]);
            float sq = q * q, sk = k * k;
#pragma unroll
            for (int o = 16; o >= 1; o >>= 1) { sq += __shfl_xor(sq, o); sk += __shfl_xor(sk, o); }
            q *= rsqrtf(sq * (1.f / 32) + EPS) * F.df_gq()[L * 32 + idx]; k *= rsqrtf(sk * (1.f / 32) + EPS) * F.df_gk()[L * 32 + idx];
            const float qp = __shfl_xor(q, 16), kp = __shfl_xor(k, 16);
            if (lat) { q = (idx < 16) ? q * cs - qp * sn : qp * sn + q * cs; k = (idx < 16) ? k * cs - kp * sn : kp * sn + k * cs; }
            const size_t o = ((size_t)(b * 4 + h) * SQ + s) * 64 + lane;
            F.qdf()[o] = f2bf(q); F.kdf()[o] = f2bf(k);
        }
    }
}
__device__ __forceinline__ void prep_tile(const Fr& F, int L, int b, int c) {
    int tid_ = F.tid; asm volatile("" : "+v"(tid_)); const int tid = tid_;
    const int s0 = 64 * c; const size_t r0 = bs2row(b, s0);
    LAS bf16* Lv = (LAS bf16*)F.lds;
#ifndef PT_MASK
#define PT_MASK 7
#endif
    if (PT_MASK & 1)
#pragma unroll 1
    for (int mx = 0; mx < 2; ++mx) {
        const int voff = mx == 0 ? C_NA + 512 : C_DF + 512; bf16* vt = mx == 0 ? F.vna() : F.vdf();
#pragma unroll
        for (int k = 0; k < 4; ++k) { const int idx = tid + 512 * k, tok = idx >> 5, d8 = (idx & 31) * 8;
            const u32x4 v = *(const u32x4*)(F.pbuf() + (r0 + tok) * NP + voff + d8); const int pc = vpos(tok);
#pragma unroll
            for (int e = 0; e < 4; ++e) { Lv[(d8 + 2 * e) * 72 + pc] = (bf16)(v[e] & 0xffffu); Lv[(d8 + 2 * e + 1) * 72 + pc] = (bf16)(v[e] >> 16); } }
        __syncthreads();
#pragma unroll
        for (int k = 0; k < 4; ++k) { const int idx = tid + 512 * k, dv = idx >> 3, pc = idx & 7;
            const u32x4 v = *(const LAS u32x4*)(Lv + dv * 72 + pc * 8);
#ifndef PT_NOSTORE
#define PT_NOSTORE 0
#endif
            if (!PT_NOSTORE || v.x == 0x12345678u) *(u32x4*)(vt + ((size_t)(b * 4 + (dv >> 6)) * 64 + (dv & 63)) * SQ + s0 + pc * 8) = v; }
        __syncthreads();
    }
    const int len = c < 4 ? TCTX : TLAT, t0 = c < 4 ? s0 : s0 - 256;
    LAS bf16* Lc = (LAS bf16*)F.lds;
    if (PT_MASK & 2)
#pragma unroll 1
    for (int gch = 0; gch < 3; ++gch) {
        {   u32x4 v[5];
#pragma unroll
            for (int k = 0; k < 5; ++k) { const int idx = min(tid + 512 * k, 68 * 32 - 1), j = idx >> 5, c8 = (idx & 31) * 8, tj = t0 - 2 + j, jc = min(max(tj, 0), len - 1) - t0;
                v[k] = *(const u32x4*)(F.pbuf() + (size_t)((long)r0 + jc) * NP + C_XBC + gch * 256 + c8);
                const unsigned keep = (tj >= 0 && tj < len) ? 0xffffffffu : 0u; v[k].x &= keep; v[k].y &= keep; v[k].z &= keep; v[k].w &= keep; }
#pragma unroll
            for (int k = 0; k < 5; ++k) { const int idx = tid + 512 * k, j = idx >> 5, c8 = (idx & 31) * 8; if (idx < 68 * 32) *(LAS u32x4*)(Lc + j * 256 + c8) = v[k]; }
        }
        __syncthreads();
        const int ch = tid & 255, tq = tid >> 8, cg = gch * 256 + ch;
        float w[5];
#pragma unroll
        for (int j = 0; j < 5; ++j) w[j] = F.conv_w()[(L * 5 + j) * 768 + cg];
        const float bias = F.conv_b()[L * 768 + cg];
        const LAS bf16* lp = Lc + (32 * tq) * 256 + ch;
        float x0 = bf2f(lp[0]), x1 = bf2f(lp[256]), x2 = bf2f(lp[512]), x3 = bf2f(lp[768]);
        bf16* tm = (gch == 1 ? F.btm() : F.ctm()) + ((size_t)b * SQ + s0 + 32 * tq) * 256 + ch;
        bf16* cm = (gch == 0 ? F.xT() : F.bT()) + ((size_t)b * 256 + ch) * SQ + s0 + 32 * tq;
#pragma unroll
        for (int g8 = 0; g8 < 4; ++g8) { unsigned pk[4];
#pragma unroll
            for (int e = 0; e < 8; ++e) { const int i = 8 * g8 + e; const float x4 = bf2f(lp[(i + 4) * 256]);
                const float acc = bias + w[0] * x0 + w[1] * x1 + w[2] * x2 + w[3] * x3 + w[4] * x4; const unsigned o = f2bf(siluf(acc));
                if (gch >= 1) tm[(size_t)i * 256] = (bf16)o;
                if (e & 1) pk[e >> 1] |= o << 16; else pk[e >> 1] = o;
                x0 = x1; x1 = x2; x2 = x3; x3 = x4; }
            if (gch <= 1) { u32x4 v; v.x = pk[0]; v.y = pk[1]; v.z = pk[2]; v.w = pk[3]; *(u32x4*)(cm + 8 * g8) = v; } }
        __syncthreads();
    }
    if (PT_MASK & 4) { const int tok = tid >> 3, i = tid & 7; const float raw = bf2f(F.pbuf()[(r0 + tok) * NP + C_DT + i]) + F.dt_bias()[L * 8 + i]; const float ex = __expf(raw);
      F.dtv()[((size_t)b * 8 + i) * SQ + s0 + tok] = raw > 20.f ? raw : (ex < 0.03f ? ex * (1.f - ex * (0.5f - ex * (0.33333334f - 0.25f * ex))) : __logf(1.f + ex)); }
}
__device__ __forceinline__ void mla_prep_block(const Fr& F, int L, int b, int j32) {
    int lane_ = F.lane; asm volatile("" : "+v"(lane_));
    const int lane = lane_, wave = F.wave, r = lane & 31, hh = lane >> 5, s = 32 * j32 + r, t = s - 256; const bool lat = s >= 256;
    const size_t row = bs2row(b, s);
    const bf16* p = F.pbuf() + row * NP + C_MLA;
    const int tt = lat ? t : 0; const float latf = lat ? 1.f : 0.f;
    if (wave < 4) {
        const int hq = wave;
        bf16x8 Bq[16]; float ss = 0.f;
#pragma unroll
        for (int kk = 0; kk < 16; ++kk) { Bq[kk] = *(const bf16x8*)(p + 16 * kk + 8 * hh);
#pragma unroll
            for (int j = 0; j < 8; ++j) { const float v = bf2f((bf16)Bq[kk][j]); ss += v * v; } }
        ss += __shfl_xor(ss, 32); const float rq = rsqrtf(ss * (1.f / 256) + EPS);
        f32x16 acc[3]; float hs = 0.f;
#pragma unroll
        for (int j3 = 0; j3 < 3; ++j3) {
#pragma unroll
            for (int i = 0; i < 16; ++i) acc[j3][i] = 0.f;
            const bf16* wp = F.wqbT() + ((size_t)L * 384 + 96 * hq + 32 * j3 + r) * 256 + 8 * hh;
#pragma unroll
            for (int kk = 0; kk < 16; ++kk) acc[j3] = MFMA32(*(const bf16x8*)(wp + 16 * kk), Bq[kk], acc[j3]);
            asm volatile("" ::: "memory");
#pragma unroll
            for (int i = 0; i < 16; ++i) hs += acc[j3][i] * acc[j3][i]; }
        hs = (hs + __shfl_xor(hs, 32)) * rq * rq; const float rs = rsqrtf(hs * (1.f / 96) + EPS) * rq;
        bf16* qo = F.qml() + ((size_t)(b * 4 + hq) * SQ + s) * 96 + 4 * hh;
#pragma unroll
        for (int j3 = 0; j3 < 3; ++j3) {
#pragma unroll
            for (int i = 0; i < 16; ++i) acc[j3][i] *= rs * F.mla_gq()[L * 96 + 32 * j3 + crow16(i, hh)];
            if (j3 == 2) {
#pragma unroll
                for (int i = 0; i < 8; ++i) { const float rc = lat ? F.rcos()[tt * 16 + crow16(i, hh)] : 1.f, rsn = F.rsin()[tt * 16 + crow16(i, hh)] * latf;
                    const float x1 = acc[2][i], x2 = acc[2][i + 8]; acc[2][i] = x1 * rc - x2 * rsn; acc[2][i + 8] = x1 * rsn + x2 * rc; } }
#pragma unroll
            for (int g = 0; g < 4; ++g) { u32x2 w; w.x = pk2(acc[j3][4 * g], acc[j3][4 * g + 1]); w.y = pk2(acc[j3][4 * g + 2], acc[j3][4 * g + 3]); *(u32x2*)(qo + 32 * j3 + 8 * g) = w; } }
    } else {
        const int hk = wave - 4;
        LAS unsigned char* wl = F.lds + wave * 16384;
        bf16x8 Bkv[8]; float ss = 0.f;
#pragma unroll
        for (int kk = 0; kk < 8; ++kk) { Bkv[kk] = *(const bf16x8*)(p + 256 + 16 * kk + 8 * hh);
#pragma unroll
            for (int j = 0; j < 8; ++j) { const float v = bf2f((bf16)Bkv[kk][j]); ss += v * v; } }
        ss += __shfl_xor(ss, 32); const float rk = rsqrtf(ss * (1.f / 128) + EPS);
        float kr[16]; float hs = 0.f;
#pragma unroll
        for (int g = 0; g < 4; ++g) { const u32x2 k4 = *(const u32x2*)(p + 384 + 8 * g + 4 * hh);
            kr[4 * g] = __uint_as_float(k4.x << 16); kr[4 * g + 1] = __uint_as_float(k4.x & 0xffff0000u); kr[4 * g + 2] = __uint_as_float(k4.y << 16); kr[4 * g + 3] = __uint_as_float(k4.y & 0xffff0000u); }
#pragma unroll
        for (int i = 0; i < 16; ++i) hs += kr[i] * kr[i];
        f32x16 acc[4]; float ks = 0.f;
#pragma unroll
        for (int j4 = 0; j4 < 4; ++j4) {
#pragma unroll
            for (int i = 0; i < 16; ++i) acc[j4][i] = 0.f;
            const bf16* wp = F.wkvbT() + ((size_t)L * 512 + 128 * hk + 32 * j4 + r) * 128 + 8 * hh;
#pragma unroll
            for (int kk = 0; kk < 8; ++kk) acc[j4] = MFMA32(*(const bf16x8*)(wp + 16 * kk), Bkv[kk], acc[j4]);
            asm volatile("" ::: "memory");
            if (j4 < 2) {
#pragma unroll
                for (int i = 0; i < 16; ++i) ks += acc[j4][i] * acc[j4][i]; } }
        hs += ks * rk * rk; hs += __shfl_xor(hs, 32); const float rs = rsqrtf(hs * (1.f / 96) + EPS);
        bf16* ko = F.kml() + ((size_t)(b * 4 + hk) * SQ + s) * 96 + 4 * hh;
#pragma unroll
        for (int j2 = 0; j2 < 2; ++j2) {
#pragma unroll
            for (int i = 0; i < 16; ++i) acc[j2][i] *= rs * rk * F.mla_gk()[L * 96 + 32 * j2 + crow16(i, hh)];
#pragma unroll
            for (int g = 0; g < 4; ++g) { u32x2 w; w.x = pk2(acc[j2][4 * g], acc[j2][4 * g + 1]); w.y = pk2(acc[j2][4 * g + 2], acc[j2][4 * g + 3]); *(u32x2*)(ko + 32 * j2 + 8 * g) = w; } }
#pragma unroll
        for (int i = 0; i < 16; ++i) kr[i] *= rs * F.mla_gk()[L * 96 + 64 + crow16(i, hh)];
#pragma unroll
        for (int i = 0; i < 8; ++i) { const float rc = lat ? F.rcos()[tt * 16 + crow16(i, hh)] : 1.f, rsn = F.rsin()[tt * 16 + crow16(i, hh)] * latf;
            const float x1 = kr[i], x2 = kr[i + 8]; kr[i] = x1 * rc - x2 * rsn; kr[i + 8] = x1 * rsn + x2 * rc; }
#pragma unroll
        for (int g = 0; g < 4; ++g) { u32x2 w; w.x = pk2(kr[4 * g], kr[4 * g + 1]); w.y = pk2(kr[4 * g + 2], kr[4 * g + 3]); *(u32x2*)(ko + 64 + 8 * g) = w; }
        { float n2 = 0.f;
#pragma unroll
          for (int i = 0; i < 16; ++i) n2 += acc[0][i] * acc[0][i] + acc[1][i] * acc[1][i] + kr[i] * kr[i];
          n2 += __shfl_xor(n2, 32); n2 = wmaxf(n2);
          if (lane == 0) atomicMax(F.ctl() + CW_KMAX + ((L * 3 + 1) * 8 + b) * 8 + hk * 2, __float_as_uint(n2 * 1.02f)); }
        LAS bf16* vl = (LAS bf16*)wl;
#pragma unroll
        for (int mt = 0; mt < 2; ++mt)
#pragma unroll
            for (int i = 0; i < 16; ++i) vl[(32 * mt + crow16(i, hh)) * 40 + vpos(r)] = f2bf(acc[2 + mt][i] * rk);
        LDS_WAIT();
        { const LAS u32x4* src4 = (const LAS u32x4*)(wl + lane * 80); u32x4* dst = (u32x4*)(F.vml() + ((size_t)(b * 4 + hk) * 64 + lane) * SQ + 32 * j32);
#pragma unroll
          for (int q = 0; q < 4; ++q) dst[q] = src4[q]; }
        LDS_WAIT();
    }
}
__device__ __forceinline__ int grab_unit(const Fr& F, unsigned* ctr) {
    volatile LAS int* slot = (volatile LAS int*)(F.lds + LDSCTL_OFF + 256);
    __syncthreads();
    if (F.tid == 0) *slot = (int)__hip_atomic_fetch_add(ctr, 1u, __ATOMIC_RELAXED, __HIP_MEMORY_SCOPE_AGENT);
    __syncthreads();
    return __builtin_amdgcn_readfirstlane(*slot);
}
__device__ __forceinline__ void prep_qk(const Fr& F, int L, int b, int j32) {
    int lane_ = F.lane; asm volatile("" : "+v"(lane_)); const int l = lane_, h = l >> 4;
    u32x2 raw[4][4];
#pragma unroll
    for (int i = 0; i < 4; ++i) { const int s = 32 * j32 + 4 * F.wave + i; const bf16* p = F.pbuf() + (size_t)bs2row(b, s) * NP + 4 * l;
        raw[i][0] = *(const u32x2*)(p + C_NA); raw[i][1] = *(const u32x2*)(p + C_NA + 256); raw[i][2] = *(const u32x2*)(p + C_DF); raw[i][3] = *(const u32x2*)(p + C_DF + 256); }
    const f32x4 gnq = *(const f32x4*)(F.na_gq() + L * 64 + 4 * (l & 15)), gnk = *(const f32x4*)(F.na_gk() + L * 64 + 4 * (l & 15));
    const f32x4 gdq = *(const f32x4*)(F.df_gq() + L * 32 + 4 * (l & 7)), gdk = *(const f32x4*)(F.df_gk() + L * 32 + 4 * (l & 7));
    float kmx_na = 0.f, kmx_df = 0.f;
#pragma unroll
    for (int i = 0; i < 4; ++i) { const int s = 32 * j32 + 4 * F.wave + i, t = s - 256; const bool lat = s >= 256;
#pragma unroll
        for (int w = 0; w < 4; ++w) {
            f32x4 x; x[0] = __uint_as_float(raw[i][w].x << 16); x[1] = __uint_as_float(raw[i][w].x & 0xffff0000u); x[2] = __uint_as_float(raw[i][w].y << 16); x[3] = __uint_as_float(raw[i][w].y & 0xffff0000u);
            float ss = (x[0] * x[0] + x[1] * x[1]) + (x[2] * x[2] + x[3] * x[3]);
            ss += dppf<0xB1>(ss); ss += dppf<0x4E>(ss); ss += dppf<0x141>(ss);
            if (w < 2) { ss += dppf<0x140>(ss);
                const float rs = rsqrtf(ss * (1.f / 64) + EPS); const f32x4 g = w == 0 ? gnq : gnk; x = x * rs * g;
                u32x2 o; o.x = pk2(x[0], x[1]); o.y = pk2(x[2], x[3]);
                if (w == 1) { float n2 = (x[0] * x[0] + x[1] * x[1]) + (x[2] * x[2] + x[3] * x[3]); n2 += dppf<0xB1>(n2); n2 += dppf<0x4E>(n2); n2 += dppf<0x141>(n2); n2 += dppf<0x140>(n2); kmx_na = fmaxf(kmx_na, n2); }
                *(u32x2*)((w == 0 ? F.qna() : F.kna()) + ((size_t)(b * 4 + h) * SQ + s) * 64 + 4 * (l & 15)) = o;
            } else {
                const float rs = rsqrtf(ss * (1.f / 32) + EPS); const f32x4 g = w == 2 ? gdq : gdk; x = x * rs * g;
                f32x4 xp; xp[0] = __shfl_xor(x[0], 4); xp[1] = __shfl_xor(x[1], 4); xp[2] = __shfl_xor(x[2], 4); xp[3] = __shfl_xor(x[3], 4);
                if (lat) { const f32x4 cs = *(const f32x4*)(F.rcos() + t * 16 + 4 * (l & 3)), sn = *(const f32x4*)(F.rsin() + t * 16 + 4 * (l & 3));
                    x = (l & 4) ? xp * sn + x * cs : x * cs - xp * sn; }
                u32x2 o; o.x = pk2(x[0], x[1]); o.y = pk2(x[2], x[3]);
                if (w == 3) { float n2 = (x[0] * x[0] + x[1] * x[1]) + (x[2] * x[2] + x[3] * x[3]); n2 += dppf<0xB1>(n2); n2 += dppf<0x4E>(n2); n2 += dppf<0x141>(n2); kmx_df = fmaxf(kmx_df, n2); }
                *(u32x2*)((w == 2 ? F.qdf() : F.kdf()) + ((size_t)(b * 4 + h) * SQ + s) * 64 + 4 * (l & 15)) = o;
            } } }
    if ((l & 15) == 0) atomicMax(F.ctl() + CW_KMAX + ((L * 3 + 0) * 8 + b) * 8 + h * 2, __float_as_uint(kmx_na * 1.02f));
    if ((l & 7) == 0) atomicMax(F.ctl() + CW_KMAX + ((L * 3 + 2) * 8 + b) * 8 + h * 2 + ((l >> 3) & 1), __float_as_uint(kmx_df * 1.02f));
}
__device__ __forceinline__ void prep_vconv(const Fr& F, int L, int b, int j32) {
    int tid_ = F.tid; asm volatile("; VCONV_BEGIN" : "+v"(tid_)); const int tid = tid_;
    const int s0 = 32 * j32; const size_t r0 = bs2row(b, s0);
    LAS bf16* Lv = (LAS bf16*)F.lds;
#ifndef VC_MASK
#define VC_MASK 7
#endif
    if (VC_MASK & 1) {   u32x4 v[4];
#pragma unroll
        for (int k = 0; k < 4; ++k) { const int idx = tid + 512 * k, mx = idx >> 10, tok = (idx >> 5) & 31, d8 = (idx & 31) * 8;
            v[k] = *(const u32x4*)(F.pbuf() + (r0 + tok) * NP + (mx ? C_DF + 512 : C_NA + 512) + d8); }
#pragma unroll
        for (int k = 0; k < 4; ++k) { const int idx = tid + 512 * k, mx = idx >> 10, tok = (idx >> 5) & 31, d8 = (idx & 31) * 8, pc = vpos(tok);
#pragma unroll
            for (int e = 0; e < 4; ++e) { Lv[(mx * 256 + d8 + 2 * e) * 40 + pc] = (bf16)(v[k][e] & 0xffffu); Lv[(mx * 256 + d8 + 2 * e + 1) * 40 + pc] = (bf16)(v[k][e] >> 16); } }
        __syncthreads();
#pragma unroll
        for (int k = 0; k < 4; ++k) { const int idx = tid + 512 * k, mx = idx >> 10, dv = (idx >> 2) & 255, pc = idx & 3;
            const u32x4 w = *(const LAS u32x4*)(Lv + (mx * 256 + dv) * 40 + pc * 8);
            *(u32x4*)((mx ? F.vdf() : F.vna()) + ((size_t)(b * 4 + (dv >> 6)) * 64 + (dv & 63)) * SQ + s0 + pc * 8) = w; }
        __syncthreads();
    }
    const bool isctx = s0 < 256; const int len = isctx ? TCTX : TLAT, t0 = isctx ? s0 : s0 - 256;
    LAS bf16* Lc = (LAS bf16*)F.lds;
    if (VC_MASK & 2) {   u32x4 v[7];
#pragma unroll
        for (int k = 0; k < 7; ++k) { const int idx = tid + 512 * k, j = idx / 96, c8 = (idx - 96 * j) * 8, tj = t0 - 2 + j; const int jc = min(max(tj, 0), len - 1) - t0;
            v[k] = (u32x4){0u, 0u, 0u, 0u};
            if (idx < 36 * 96) { v[k] = *(const u32x4*)(F.pbuf() + (size_t)((long)r0 + jc) * NP + C_XBC + c8); if (tj < 0 || tj >= len) v[k] = (u32x4){0u, 0u, 0u, 0u}; } }
#pragma unroll
        for (int k = 0; k < 7; ++k) { const int idx = tid + 512 * k, j = idx / 96, c8 = (idx - 96 * j) * 8; if (idx < 36 * 96) *(LAS u32x4*)(Lc + j * 768 + c8) = v[k]; }
    }
    __syncthreads();
    if (VC_MASK & 2)
#pragma unroll 1
    for (int pass = 0; pass < 2; ++pass) {
        const int cg = pass == 0 ? tid : 512 + tid;
        if (cg < 768) {
            float w[5];
#pragma unroll
            for (int j = 0; j < 5; ++j) w[j] = F.conv_w()[(L * 5 + j) * 768 + cg];
            const float bias = F.conv_b()[L * 768 + cg];
            const LAS bf16* lp = Lc + cg;
            float x0 = bf2f(lp[0]), x1 = bf2f(lp[768]), x2 = bf2f(lp[2 * 768]), x3 = bf2f(lp[3 * 768]);
            const int gch = cg >> 8, ch = cg & 255;
            bf16* tm = (gch == 1 ? F.btm() : F.ctm()) + ((size_t)b * SQ + s0) * 256 + ch;
            bf16* cm = (gch == 0 ? F.xT() : F.bT()) + ((size_t)b * 256 + ch) * SQ + s0;
#pragma unroll
            for (int g8 = 0; g8 < 4; ++g8) { unsigned pk[4];
#pragma unroll
                for (int e = 0; e < 8; ++e) { const int i = 8 * g8 + e; const float x4 = bf2f(lp[(i + 4) * 768]);
                    const float acc = bias + w[0] * x0 + w[1] * x1 + w[2] * x2 + w[3] * x3 + w[4] * x4; const unsigned o = f2bf(siluf(acc));
                    if (gch >= 1) tm[(size_t)i * 256] = (bf16)o;
                    if (e & 1) pk[e >> 1] |= o << 16; else pk[e >> 1] = o;
                    x0 = x1; x1 = x2; x2 = x3; x3 = x4; }
                if (gch <= 1) { u32x4 v; v.x = pk[0]; v.y = pk[1]; v.z = pk[2]; v.w = pk[3]; *(u32x4*)(cm + 8 * g8) = v; } }
        }
    }
    if ((VC_MASK & 4) && tid < 256) { const int tok = tid >> 3, i = tid & 7; const float raw = bf2f(F.pbuf()[(r0 + tok) * NP + C_DT + i]) + F.dt_bias()[L * 8 + i]; const float ex = __expf(raw);
      F.dtv()[((size_t)b * 8 + i) * SQ + s0 + tok] = raw > 20.f ? raw : (ex < 0.03f ? ex * (1.f - ex * (0.5f - ex * (0.33333334f - 0.25f * ex))) : __logf(1.f + ex)); }
    __syncthreads();
    asm volatile("; VCONV_END" ::: "memory");
}
__device__ __forceinline__ void phase_prep(const Fr& F0_, int L) {
    unsigned* ctr = F0_.ctl() + CW_QUEUE + (L * 16 + 0) * 64;
    for (;;) {
        const int u = grab_unit(F0_, ctr); if (u >= NB * 72) break;
        const int b = u / 72, j32 = u - 72 * b;
        { const Fr F = refresh(F0_); prep_qk(F, L, b, j32); }
        { const Fr F = refresh(F0_); mla_prep_block(F, L, b, j32); }
        __syncthreads();
    }
    { unsigned* ctr2 = F0_.ctl() + CW_QUEUE + (L * 16 + 2) * 64;
      for (;;) { const int u = grab_unit(F0_, ctr2); if (u >= NB * 36) break; const Fr F3 = refresh(F0_); prep_tile(F3, L, u / 36, u % 36); } }
}

__device__ __forceinline__ void phase_ssd_naive(const Fr& F, int L) {
    if (F.wave != 0 || blockIdx.x >= 64) return;
    const int w = blockIdx.x, b = w >> 3, d = (w >> 2) & 1, h = w & 3, g = h >> 1, p = F.lane;
    const float a = -expf(F.a_log()[L * 8 + d * 4 + h]);
    float hs[128];
#pragma unroll
    for (int n = 0; n < 128; ++n) hs[n] = 0.f;
    const float* dtp = F.dtv() + ((size_t)b * 8 + d * 4 + h) * SQ;
    const bf16* xp = F.xT() + ((size_t)b * 256 + h * 64 + p) * SQ;
    for (int step = 0; step < SQ; ++step) {
        const int s = d == 0 ? step : (step < 256 ? 255 - step : SQ - 1 - (step - 256));
        const float dtv = dtp[s], dA = __expf(dtv * a), xv = bf2f(xp[s]) * dtv;
        const u32x4* Bp = (const u32x4*)(F.btm() + ((size_t)b * SQ + s) * 256 + g * 128);
        const u32x4* Cp = (const u32x4*)(F.ctm() + ((size_t)b * SQ + s) * 256 + g * 128);
        float y = 0.f;
#pragma unroll
        for (int n8 = 0; n8 < 16; ++n8) { const u32x4 bv = Bp[n8], cv = Cp[n8];
#pragma unroll
            for (int j = 0; j < 4; ++j) { const int n = n8 * 8 + 2 * j;
                hs[n] = hs[n] * dA + xv * __uint_as_float(bv[j] << 16); hs[n + 1] = hs[n + 1] * dA + xv * __uint_as_float(bv[j] & 0xffff0000u);
                y += __uint_as_float(cv[j] << 16) * hs[n] + __uint_as_float(cv[j] & 0xffff0000u) * hs[n + 1]; } }
        F.ydir()[((size_t)d * NROW + bs2row(b, s)) * 256 + h * 64 + p] = y;
    }
}

template <int KIND>
__device__ __forceinline__ void naive_attn_job(const Fr& F, int L, int r, int h, LAS float* scr) {
    constexpr int DQ = KIND == 1 ? 96 : (KIND == 0 ? 64 : 32), QS = KIND == 1 ? 96 : 64;
    const int lane = F.lane; int b, s; row2bs(r, b, s); const bool lat = r < NLAT; const int t = s - 256;
    const bf16* Qb = (KIND == 0 ? F.qna() : KIND == 1 ? F.qml() : F.qdf()) + ((size_t)(b * 4 + h) * SQ + s) * QS;
    const bf16* Kb = (KIND == 0 ? F.kna() : KIND == 1 ? F.kml() : F.kdf()) + (size_t)(b * 4 + h) * SQ * QS;
    const bf16* Vt = (KIND == 0 ? F.vna() : KIND == 1 ? F.vml() : F.vdf()) + ((size_t)(b * 4 + h) * 64 + lane) * SQ;
    const float scale = KIND == 1 ? 0.10206207261596577f : (KIND == 0 ? 0.125f : 0.17677669529663687f);
    const int qr = t >> 6, qc = t & 63, row_lo = min(max(qr - 4, 0), 24), col_lo = min(max(qc - 8, 0), 48);
    const bool nb = (KIND == 0) && lat;
    const int nk = lat ? (KIND == 0 ? 768 : SQ) : 256;
    const int koff = nb ? row_lo * 64 : 0;
    float oc[2] = {0.f, 0.f};
#pragma unroll
    for (int comp = 0; comp < (KIND == 2 ? 2 : 1); ++comp) {
        for (int i = lane; i < DQ; i += 64) scr[i] = bf2f(Qb[comp * 32 + i]);
        LDS_WAIT();
        float m = -INFINITY;
        for (int kk = lane; kk < nk; kk += 64) {
            const int sk = kk < 256 ? kk : kk + koff; float bias = 0.f; bool valid = true;
            if (nb && kk >= 256) { const int w = kk - 256, kr = w >> 6, kc = w & 63; valid = kc >= col_lo && kc < col_lo + 16;
                const int ro = row_lo + kr - qr + 7, co = min(max(kc - qc, -15), 15) + 15; bias = F.na_rb()[((L * 4 + h) * 15 + ro) * 31 + co]; }
            const u32x4* kp = (const u32x4*)(Kb + (size_t)sk * QS + (KIND == 2 ? comp * 32 : 0));
            float dot = 0.f;
#pragma unroll
            for (int i8 = 0; i8 < DQ / 8; ++i8) { const u32x4 kv = kp[i8];
#pragma unroll
                for (int j = 0; j < 4; ++j) dot += scr[i8 * 8 + 2 * j] * __uint_as_float(kv[j] << 16) + scr[i8 * 8 + 2 * j + 1] * __uint_as_float(kv[j] & 0xffff0000u); }
            const float sc = valid ? dot * scale + bias : -INFINITY;
            scr[128 + kk] = sc; m = fmaxf(m, sc);
        }
        m = wmaxf(m);
        float sum = 0.f;
        for (int kk = lane; kk < nk; kk += 64) { const float pv = __expf(scr[128 + kk] - m); scr[128 + kk] = pv; sum += pv; }
        sum = wsum(sum);
        LDS_WAIT();
        float o = 0.f;
        for (int kb = 0; kb < nk; kb += 8) {
            const int sb = kb < 256 ? kb : kb + koff;
            const u32x4 vv = *(const u32x4*)(Vt + sb);
#pragma unroll
            for (int j = 0; j < 8; ++j) { const int kk = (kb & ~15) + vpos((kb & 15) + j); const unsigned wv = vv[j >> 1];
                o += scr[128 + kk] * ((j & 1) ? __uint_as_float(wv & 0xffff0000u) : __uint_as_float(wv << 16)); }
        }
        oc[comp] = o / sum;
        LDS_WAIT();
    }
    bf16* mo = F.mix() + (size_t)r * DM + (KIND == 0 ? 0 : KIND == 1 ? 256 : 512) + h * 64 + lane;
    if (KIND == 2) {
        const float* lv = F.df_lam() + L * 128; const float li = 0.8f - 0.6f * expf(-0.3f * (float)L);
        float d1 = 0.f, d2 = 0.f;
#pragma unroll
        for (int i = 0; i < 32; ++i) { d1 += lv[i] * lv[32 + i]; d2 += lv[64 + i] * lv[96 + i]; }
        const float lam = expf(d1) - expf(d2) + li;
        const float o = oc[0] - lam * oc[1];
        const float rs = rsqrtf(wsum(o * o) * (1.f / 64) + EPS);
        *mo = f2bf(o * rs * F.df_gsub()[L * 64 + lane] * (1.f - li));
    } else *mo = f2bf(oc[0]);
}
__device__ __forceinline__ void phase_mix_naive(const Fr& F, int L) {
    LAS float* scr = (LAS float*)(F.lds + F.wave * 16384);
    const int nrows = (L == DEPTH - 1) ? NLAT : NROW;
    for (int j = F.gw; j < nrows * 4; j += F.NGW) naive_attn_job<2>(F, L, j >> 2, j & 3, scr);
    for (int j = F.gw; j < nrows * 4; j += F.NGW) naive_attn_job<1>(F, L, j >> 2, j & 3, scr);
    for (int j = F.gw; j < nrows * 4; j += F.NGW) naive_attn_job<0>(F, L, j >> 2, j & 3, scr);
    for (int r = F.gw; r < nrows; r += F.NGW) {
        int b, s; row2bs(r, b, s); const int h = F.lane >> 4; const float dsk = F.ssd_d()[L * 8 + h] + F.ssd_d()[L * 8 + 4 + h];
        float y[4]; float ss = 0.f;
#pragma unroll
        for (int j = 0; j < 4; ++j) { const int ch = F.lane * 4 + j; const float xv = bf2f(F.xT()[((size_t)b * 256 + ch) * SQ + s]);
            const float z = bf2f(F.pbuf()[(size_t)r * NP + C_Z + ch]);
            y[j] = (F.ydir()[(size_t)r * 256 + ch] + F.ydir()[((size_t)NROW + r) * 256 + ch] + dsk * xv) * siluf(z); ss += y[j] * y[j]; }
        const float rs = rsqrtf(wsum(ss) * (1.f / 256) + EPS);
#pragma unroll
        for (int j = 0; j < 4; ++j) { const int ch = F.lane * 4 + j; F.mix()[(size_t)r * DM + 768 + ch] = f2bf(y[j] * rs * F.ssd_gn()[L * 256 + ch]); }
    }
}

template <int S8> __device__ __forceinline__ bf16x8 pack_step(const f32x16& x) {
    u32x4 p;
    asm volatile("v_cvt_pk_bf16_f32 %0, %4, %5\n\tv_cvt_pk_bf16_f32 %1, %6, %7\n\tv_cvt_pk_bf16_f32 %2, %8, %9\n\tv_cvt_pk_bf16_f32 %3, %10, %11\n\ts_nop 1"
                 : "=&v"(p[0]), "=&v"(p[1]), "=&v"(p[2]), "=&v"(p[3])
                 : "v"(x[S8]), "v"(x[S8 + 1]), "v"(x[S8 + 2]), "v"(x[S8 + 3]), "v"(x[S8 + 4]), "v"(x[S8 + 5]), "v"(x[S8 + 6]), "v"(x[S8 + 7]));
    return __builtin_bit_cast(bf16x8, p);
}
constexpr float LOG2E = 1.4426950408889634f;
template <int KIND>
__device__ __forceinline__ void attn_unit(const Fr& F, int L, int b, int h, int qb) {
    constexpr int QS = KIND == 1 ? 96 : 64, NKS = KIND == 1 ? 6 : (KIND == 0 ? 4 : 2);
    constexpr int PK = QS * 2 + 16, PV = 272, KBYTES = 128 * PK, VBYTES = 64 * PV, NKP = QS == 96 ? 3 : 2, PPR = QS / 8;
    LAS unsigned char* const Kl = F.lds; LAS unsigned char* const Vl = F.lds + 2 * KBYTES;
    LAS float* const biasl = (LAS float*)(F.lds + 2 * KBYTES + 2 * VBYTES);
    const int lane = F.lane, wave = F.wave, tid = F.tid, r = lane & 31, hh = lane >> 5;
    const bool isctx = qb < 0;
    const int comp = KIND == 2 ? (wave & 1) : 0, qg = KIND == 2 ? (wave >> 1) : wave;
    const bf16* Qg = (KIND == 0 ? F.qna() : KIND == 1 ? F.qml() : F.qdf()) + (size_t)(b * 4 + h) * SQ * QS;
    const bf16* Kg = (KIND == 0 ? F.kna() : KIND == 1 ? F.kml() : F.kdf()) + (size_t)(b * 4 + h) * SQ * QS;
    const bf16* Vg = (KIND == 0 ? F.vna() : KIND == 1 ? F.vml() : F.vdf()) + (size_t)(b * 4 + h) * 64 * SQ;
    const float cs = (KIND == 1 ? 0.10206207261596577f : (KIND == 0 ? 0.125f : 0.17677669529663687f)) * LOG2E;
    int sq, qrow = 0, qcol = 0;
    if (KIND == 2) sq = (isctx ? 128 * (-qb - 1) : 256 + 128 * qb) + 32 * qg + r;
    else if (isctx) sq = 32 * wave + r; else if (KIND == 0) { qrow = 4 * qb + (wave >> 1); qcol = 32 * (wave & 1) + r; sq = 256 + 64 * qrow + qcol; } else sq = 256 + 256 * qb + 32 * wave + r;
    int nt = 36, lo_u = 0;
    if (isctx) nt = 4; else if (KIND == 0) { lo_u = min(max(4 * qb - 4, 0), 24); nt = 4 + min(max(4 * qb - 1, 0), 24) + 8 - lo_u; }
    const int np = (nt + 1) >> 1;
    const int my_lo = min(max(qrow - 4, 0), 24), col_lo = min(max(qcol - 8, 0), 48);
    if (KIND == 0 && !isctx) for (int i = tid; i < 465; i += 512) biasl[i] = F.na_rb()[(L * 4 + h) * 465 + i] * LOG2E;
    bf16x8 Q[NKS];
    { const bf16* qp = Qg + (size_t)sq * QS + comp * 32 + 8 * hh;
#pragma unroll
      for (int kk = 0; kk < NKS; ++kk) Q[kk] = *(const bf16x8*)(qp + 16 * kk); }
    f32x16 O[2]; float l = 0.f;
#pragma unroll
    for (int mt = 0; mt < 2; ++mt)
#pragma unroll
        for (int i = 0; i < 16; ++i) O[mt][i] = 0.f;
    float m;
    {   float q2 = 0.f;
#pragma unroll
        for (int kk = 0; kk < NKS; ++kk)
#pragma unroll
            for (int j = 0; j < 8; ++j) { const float v = bf2f((bf16)Q[kk][j]); q2 += v * v; }
        q2 += __shfl_xor(q2, 32);
        const float k2 = __uint_as_float(__hip_atomic_load(F.ctl() + CW_KMAX + ((L * 3 + KIND) * 8 + b) * 8 + h * 2 + comp, __ATOMIC_RELAXED, __HIP_MEMORY_SCOPE_AGENT));
        m = sqrtf(q2 * k2) * cs;
        if (KIND == 0 && !isctx) m += (F.rcos() + 2 * TLAT * 16)[L * 4 + h];
    }
    u32x4 rk_0[NKP], rv_0[2];
#define AT_SK0(t) ((isctx || KIND != 0) ? 64 * (t) : ((t) < 4 ? 64 * (t) : 256 + 64 * (lo_u + (t) - 4)))
#define AT_LOAD(p, S_) do { const int sk0_ = AT_SK0(2 * (p)); const char* kg_ = (const char*)(Kg + (size_t)sk0_ * QS); \
        _Pragma("unroll") for (int i_ = 0; i_ < NKP; ++i_) rk_##S_[i_] = *(const u32x4*)(kg_ + (tid + 512 * i_) * 16); \
        _Pragma("unroll") for (int i_ = 0; i_ < 2; ++i_) { const int pi_ = tid + 512 * i_; rv_##S_[i_] = *(const u32x4*)(Vg + (size_t)(pi_ >> 4) * SQ + sk0_ + (pi_ & 15) * 8); } } while (0)
#define AT_STORE(buf, S_) do { \
        _Pragma("unroll") for (int i_ = 0; i_ < NKP; ++i_) { const int pi_ = tid + 512 * i_; *(LAS u32x4*)(Kl + (buf) * KBYTES + (pi_ / PPR) * PK + (pi_ % PPR) * 16) = rk_##S_[i_]; } \
        _Pragma("unroll") for (int i_ = 0; i_ < 2; ++i_) { const int pi_ = tid + 512 * i_; *(LAS u32x4*)(Vl + (buf) * VBYTES + (pi_ >> 4) * PV + (pi_ & 15) * 16) = rv_##S_[i_]; } } while (0)
#define AT_QK(SA, SB, kb_) do { \
        _Pragma("unroll") for (int i = 0; i < 16; ++i) { SA[i] = 0.f; SB[i] = 0.f; } \
        _Pragma("unroll") for (int kk = 0; kk < NKS; ++kk) { const bf16x8 a0 = *(const LAS bf16x8*)((kb_) + 32 * kk), a1 = *(const LAS bf16x8*)((kb_) + 32 * PK + 32 * kk); \
            SA = MFMA32(a0, Q[kk], SA); SB = MFMA32(a1, Q[kk], SB); } } while (0)
#define AT_SMPV(S0, S1, t_, vb_) do { \
        const int krow = lo_u + (t_) - 4; const bool nbt = (KIND == 0) && !isctx && (t_) >= 4; \
        float ps = 0.f; \
        if (nbt) { const int drow = (krow - qrow + 7) * 31 - qcol + 15; const float nm = -m; \
            _Pragma("unroll") for (int i = 0; i < 16; ++i) { const int kc = (i & 3) + 8 * (i >> 2) + 4 * hh; \
                { const bool v = (unsigned)(kc - col_lo) < 16u; const float bb = biasl[v ? drow + kc : 0]; S0[i] = v ? __builtin_amdgcn_exp2f(__builtin_fmaf(S0[i], cs, bb + nm)) : 0.f; } \
                { const bool v = (unsigned)(kc + 32 - col_lo) < 16u; const float bb = biasl[v ? drow + kc + 32 : 0]; S1[i] = v ? __builtin_amdgcn_exp2f(__builtin_fmaf(S1[i], cs, bb + nm)) : 0.f; } \
                ps += S0[i] + S1[i]; } \
        } else { const float nm = -m; \
            _Pragma("unroll") for (int i = 0; i < 16; ++i) { S0[i] = __builtin_amdgcn_exp2f(__builtin_fmaf(S0[i], cs, nm)); S1[i] = __builtin_amdgcn_exp2f(__builtin_fmaf(S1[i], cs, nm)); } \
            const f32x16 T_ = S0 + S1; \
            ps = (((T_[0] + T_[1]) + (T_[2] + T_[3])) + ((T_[4] + T_[5]) + (T_[6] + T_[7]))) + (((T_[8] + T_[9]) + (T_[10] + T_[11])) + ((T_[12] + T_[13]) + (T_[14] + T_[15]))); } \
        l += ps; \
        const bf16x8 p00 = pack_step<0>(S0), p01 = pack_step<8>(S0), p10 = pack_step<0>(S1), p11 = pack_step<8>(S1); \
        _Pragma("unroll") for (int mt = 0; mt < 2; ++mt) { \
            const LAS unsigned char* vb = (vb_) + mt * 32 * PV; \
            O[mt] = MFMA32(*(const LAS bf16x8*)(vb + 0), p00, O[mt]); O[mt] = MFMA32(*(const LAS bf16x8*)(vb + 32), p01, O[mt]); \
            O[mt] = MFMA32(*(const LAS bf16x8*)(vb + 64), p10, O[mt]); O[mt] = MFMA32(*(const LAS bf16x8*)(vb + 96), p11, O[mt]); } } while (0)
#define AT_COMPUTE(p_, buf_) do { \
        const int t0_ = 2 * (p_), t1_ = t0_ + 1; \
        const bool g0_ = (KIND != 0) || isctx || t0_ < 4 || (lo_u + t0_ - 4 >= my_lo && lo_u + t0_ - 4 < my_lo + 8); \
        const bool g1_ = (t1_ < nt) && ((KIND != 0) || isctx || t1_ < 4 || (lo_u + t1_ - 4 >= my_lo && lo_u + t1_ - 4 < my_lo + 8)); \
        const LAS unsigned char* Kb = Kl + (buf_) * KBYTES + r * PK + (comp * 32 + 8 * hh) * 2; const LAS unsigned char* Vb = Vl + (buf_) * VBYTES + r * PV + 16 * hh; \
        if (KIND == 0) { f32x16 S00, S01; \
            if (g0_) { AT_QK(S00, S01, Kb); AT_SMPV(S00, S01, t0_, Vb); } \
            if (g1_) { AT_QK(S00, S01, Kb + 64 * PK); AT_SMPV(S00, S01, t1_, Vb + 128); } \
        } else { f32x16 S00, S01, S10, S11; \
            __builtin_amdgcn_iglp_opt(0); \
            AT_QK(S00, S01, Kb); \
            AT_QK(S10, S11, Kb + 64 * PK); \
            AT_SMPV(S00, S01, t0_, Vb); \
            AT_SMPV(S10, S11, t1_, Vb + 128); } } while (0)
    AT_LOAD(0, 0);
    AT_STORE(0, 0);
    __syncthreads();
    for (int p = 0; p < np; ++p) {
        const int buf = p & 1;
        if (p + 1 < np) AT_LOAD(p + 1, 0);
        AT_COMPUTE(p, buf);
        if (p + 1 < np) AT_STORE(buf ^ 1, 0);
        __syncthreads();
    }
#undef AT_COMPUTE
#undef AT_SMPV
#undef AT_QK
#undef AT_SK0
#undef AT_LOAD
#undef AT_STORE
    const float inv = 1.f / (l + __shfl_xor(l, 32));
    bf16* mo = F.mix() + (size_t)bs2row(b, sq) * DM + (KIND == 0 ? 0 : KIND == 1 ? 256 : 512) + h * 64 + 4 * hh;
    if (KIND == 2) {
        LAS float* xo = (LAS float*)F.lds + qg * 2048;
        if (comp == 1) {
#pragma unroll
            for (int mt = 0; mt < 2; ++mt)
#pragma unroll
                for (int i = 0; i < 16; ++i) xo[(mt * 16 + i) * 64 + lane] = O[mt][i] * inv; }
        __syncthreads();
        if (comp == 0) {
            const float* lv = F.df_lam() + L * 128; const float li = 0.8f - 0.6f * expf(-0.3f * (float)L);
            float d1 = 0.f, d2 = 0.f;
#pragma unroll
            for (int i = 0; i < 32; ++i) { d1 += lv[i] * lv[32 + i]; d2 += lv[64 + i] * lv[96 + i]; }
            const float lam = expf(d1) - expf(d2) + li;
            float ss = 0.f;
#pragma unroll
            for (int mt = 0; mt < 2; ++mt)
#pragma unroll
                for (int i = 0; i < 16; ++i) { const float o = O[mt][i] * inv - lam * xo[(mt * 16 + i) * 64 + lane]; O[mt][i] = o; ss += o * o; }
            ss += __shfl_xor(ss, 32);
            const float rs = rsqrtf(ss * (1.f / 64) + EPS) * (1.f - li);
#pragma unroll
            for (int mt = 0; mt < 2; ++mt)
#pragma unroll
                for (int g = 0; g < 4; ++g) { const f32x4 gs = *(const f32x4*)(F.df_gsub() + L * 64 + 32 * mt + 8 * g + 4 * hh);
                    u32x2 w; w.x = pk2(O[mt][4 * g] * rs * gs[0], O[mt][4 * g + 1] * rs * gs[1]); w.y = pk2(O[mt][4 * g + 2] * rs * gs[2], O[mt][4 * g + 3] * rs * gs[3]);
                    *(u32x2*)(mo + 32 * mt + 8 * g) = w; }
        }
        __syncthreads();
    } else {
#pragma unroll
        for (int mt = 0; mt < 2; ++mt)
#pragma unroll
            for (int g = 0; g < 4; ++g) { u32x2 w; w.x = pk2(O[mt][4 * g] * inv, O[mt][4 * g + 1] * inv); w.y = pk2(O[mt][4 * g + 2] * inv, O[mt][4 * g + 3] * inv);
                *(u32x2*)(mo + 32 * mt + 8 * g) = w; }
    }
}
__device__ __forceinline__ float ssd_cum(const Fr& F, int L, int b, int h, int d, int s0, float& dt, float& cum) {
    const int lane = F.lane;
    dt = F.dtv()[((size_t)b * 8 + d * 4 + h) * SQ + s0 + lane];
    const float la = dt * -__expf(F.a_log()[L * 8 + d * 4 + h]);
    float v = la;
#pragma unroll
    for (int o = 1; o < 64; o <<= 1) { const float t = __shfl_up(v, o); if (lane >= o) v += t; }
    const float total = __shfl(v, 63);
    cum = d == 0 ? v : total - v + la;
    return total;
}
__device__ __forceinline__ void ssd_s1_job(const Fr& F, int L, int b, int c, int h, LAS float* scr) {
    const int lane = F.lane, r = lane & 31, hh = lane >> 5, s0 = 64 * c, g = h >> 1;
#pragma unroll
    for (int d = 0; d < 2; ++d) { float dt, cum; const float tot = ssd_cum(F, L, b, h, d, s0, dt, cum); scr[d * 64 + lane] = dt * __expf(tot - cum);
        if (lane == 0) F.cdec()[((b * 2 + d) * 4 + h) * 36 + c] = __expf(tot); }
    LDS_WAIT();
    bf16x8 A[2][2][4];
#pragma unroll
    for (int mt = 0; mt < 2; ++mt)
#pragma unroll
        for (int kk = 0; kk < 4; ++kk) { const bf16x8 raw = *(const bf16x8*)(F.xT() + ((size_t)b * 256 + h * 64 + 32 * mt + r) * SQ + s0 + 16 * kk + 8 * hh);
#pragma unroll
            for (int d = 0; d < 2; ++d) { u32x4 o;
#pragma unroll
                for (int j = 0; j < 4; ++j) { const float w0 = scr[d * 64 + 16 * kk + 8 * hh + 2 * j], w1 = scr[d * 64 + 16 * kk + 8 * hh + 2 * j + 1];
                    o[j] = pk2(bf2f((bf16)raw[2 * j]) * w0, bf2f((bf16)raw[2 * j + 1]) * w1); }
                A[d][mt][kk] = __builtin_bit_cast(bf16x8, o); } }
#pragma unroll
    for (int nt = 0; nt < 4; ++nt) {
        bf16x8 Bf[4];
#pragma unroll
        for (int kk = 0; kk < 4; ++kk) Bf[kk] = *(const bf16x8*)(F.bT() + ((size_t)b * 256 + g * 128 + 32 * nt + r) * SQ + s0 + 16 * kk + 8 * hh);
#pragma unroll
        for (int d = 0; d < 2; ++d)
#pragma unroll
            for (int mt = 0; mt < 2; ++mt) { f32x16 acc;
#pragma unroll
                for (int i = 0; i < 16; ++i) acc[i] = 0.f;
#pragma unroll
                for (int kk = 0; kk < 4; ++kk) acc = MFMA32(A[d][mt][kk], Bf[kk], acc);
                float* dst = F.cst() + ((((size_t)(b * 2 + d) * 4 + h) * 36 + c) * 64 + 32 * mt) * 128 + 32 * nt + r;
#pragma unroll
                for (int i = 0; i < 16; ++i) dst[crow16(i, hh) * 128] = acc[i]; }
    }
    LDS_WAIT();
}
__device__ __forceinline__ void phase_ssd_s1(const Fr& F, int L) {
    LAS float* scr = (LAS float*)(F.lds + F.wave * 16384);
    for (int j = F.gw; j < NB * 36 * 4; j += F.NGW) ssd_s1_job(F, L, j / 144, (j / 4) % 36, j & 3, scr);
}
__device__ __forceinline__ void phase_ssd_scan(const Fr& F, int L) {
    for (int e4 = blockIdx.x * 512 + F.tid; e4 < NB * 2 * 4 * 2048; e4 += F.G * 512) {
        const int bdh = e4 >> 11, pn = (e4 & 2047) * 4, d = (bdh >> 2) & 1;
        f32x4 hst = (f32x4){0.f, 0.f, 0.f, 0.f};
        const float* cs_ = F.cst() + (size_t)bdh * 36 * 8192 + pn; bf16* he_ = F.hent() + (size_t)bdh * 36 * 8192 + pn; const float* cd_ = F.cdec() + bdh * 36;
#pragma unroll 1
        for (int s6 = 0; s6 < 36; s6 += 6) {
            f32x4 v[6]; float dc[6]; int cc[6];
#pragma unroll
            for (int j = 0; j < 6; ++j) { const int step = s6 + j; cc[j] = d == 0 ? step : (step < 4 ? 3 - step : 39 - step); v[j] = *(const f32x4*)(cs_ + (size_t)cc[j] * 8192); dc[j] = cd_[cc[j]]; }
#pragma unroll
            for (int j = 0; j < 6; ++j) { u32x2 o; o.x = pk2(hst[0], hst[1]); o.y = pk2(hst[2], hst[3]); *(u32x2*)(he_ + (size_t)cc[j] * 8192) = o; hst = hst * dc[j] + v[j]; }
        }
    }
}
__device__ __forceinline__ void ssd_s3_unit(const Fr& F, int L, int b, int c) {
    const int lane = F.lane, wave = F.wave, r = lane & 31, hh = lane >> 5, s0 = 64 * c, h = wave >> 1, it = wave & 1, g = h >> 1, itok = 32 * it + r;
    LAS float* scr = (LAS float*)(F.lds + wave * 16384);
    LAS float* red = (LAS float*)(F.lds + 8192);
#pragma unroll
    for (int d = 0; d < 2; ++d) { float dt, cum; (void)ssd_cum(F, L, b, h, d, s0, dt, cum); scr[d * 128 + lane] = cum; scr[d * 128 + 64 + lane] = dt; }
    LDS_WAIT();
    bf16x8 Cf[8];
#pragma unroll
    for (int kk = 0; kk < 8; ++kk) Cf[kk] = *(const bf16x8*)(F.ctm() + ((size_t)b * SQ + s0 + itok) * 256 + g * 128 + 16 * kk + 8 * hh);
    f32x16 G[2];
#pragma unroll
    for (int jt = 0; jt < 2; ++jt) {
#pragma unroll
        for (int i = 0; i < 16; ++i) G[jt][i] = 0.f;
#pragma unroll
        for (int kk = 0; kk < 8; ++kk) { const bf16x8 bf = *(const bf16x8*)(F.btm() + ((size_t)b * SQ + s0 + 32 * jt + r) * 256 + g * 128 + 16 * kk + 8 * hh); G[jt] = MFMA32(bf, Cf[kk], G[jt]); } }
    bf16x8 X[2][4];
#pragma unroll
    for (int mt = 0; mt < 2; ++mt)
#pragma unroll
        for (int ks = 0; ks < 4; ++ks) { const bf16* xp = F.xT() + ((size_t)b * 256 + h * 64 + 32 * mt + r) * SQ + s0 + 16 * ks + 4 * hh;
            const u32x2 lo = *(const u32x2*)xp, hi = *(const u32x2*)(xp + 8); u32x4 o; o.x = lo.x; o.y = lo.y; o.z = hi.x; o.w = hi.y; X[mt][ks] = __builtin_bit_cast(bf16x8, o); }
    f32x16 Y[2];
#pragma unroll
    for (int mt = 0; mt < 2; ++mt)
#pragma unroll
        for (int i = 0; i < 16; ++i) Y[mt][i] = 0.f;
    const float Dsum = F.ssd_d()[L * 8 + h] + F.ssd_d()[L * 8 + 4 + h];
#pragma unroll 1
    for (int d = 0; d < 2; ++d) {
        const float cum_i = scr[d * 128 + itok];
        f32x16 Pm[2];
#pragma unroll
        for (int jt = 0; jt < 2; ++jt)
#pragma unroll
            for (int i = 0; i < 16; ++i) { const int j = 32 * jt + crow16(i, hh); const bool valid = d == 0 ? (j <= itok) : (j >= itok);
                const float arg = valid ? cum_i - scr[d * 128 + j] : -INFINITY;
                float pv = G[jt][i] * __expf(arg) * scr[d * 128 + 64 + j];
                if (d == 0 && j == itok) pv += Dsum;
                Pm[jt][i] = pv; }
        const bf16x8 p0 = pack_step<0>(Pm[0]), p1 = pack_step<8>(Pm[0]), p2 = pack_step<0>(Pm[1]), p3 = pack_step<8>(Pm[1]);
#pragma unroll
        for (int mt = 0; mt < 2; ++mt) { Y[mt] = MFMA32(X[mt][0], p0, Y[mt]); Y[mt] = MFMA32(X[mt][1], p1, Y[mt]); Y[mt] = MFMA32(X[mt][2], p2, Y[mt]); Y[mt] = MFMA32(X[mt][3], p3, Y[mt]); }
        const float ei = __expf(cum_i);
#pragma unroll
        for (int mt = 0; mt < 2; ++mt) { f32x16 T;
#pragma unroll
            for (int i = 0; i < 16; ++i) T[i] = 0.f;
#pragma unroll
            for (int kk = 0; kk < 8; ++kk) { const bf16x8 hf = *(const bf16x8*)(F.hent() + ((((size_t)(b * 2 + d) * 4 + h) * 36 + c) * 64 + 32 * mt + r) * 128 + 16 * kk + 8 * hh); T = MFMA32(hf, Cf[kk], T); }
#pragma unroll
            for (int i = 0; i < 16; ++i) Y[mt][i] += ei * T[i]; }
    }
    const size_t row = bs2row(b, s0 + itok);
    const bf16* zp = F.pbuf() + row * NP + C_Z + h * 64 + 4 * hh;
    float ss = 0.f;
#pragma unroll
    for (int mt = 0; mt < 2; ++mt)
#pragma unroll
        for (int gq = 0; gq < 4; ++gq) { const u32x2 z4 = *(const u32x2*)(zp + 32 * mt + 8 * gq);
            const float z0 = __uint_as_float(z4.x << 16), z1 = __uint_as_float(z4.x & 0xffff0000u), z2 = __uint_as_float(z4.y << 16), z3 = __uint_as_float(z4.y & 0xffff0000u);
            Y[mt][4 * gq] *= siluf(z0); Y[mt][4 * gq + 1] *= siluf(z1); Y[mt][4 * gq + 2] *= siluf(z2); Y[mt][4 * gq + 3] *= siluf(z3);
            ss += (Y[mt][4 * gq] * Y[mt][4 * gq] + Y[mt][4 * gq + 1] * Y[mt][4 * gq + 1]) + (Y[mt][4 * gq + 2] * Y[mt][4 * gq + 2] + Y[mt][4 * gq + 3] * Y[mt][4 * gq + 3]); }
    ss += __shfl_xor(ss, 32);
    if (hh == 0) red[(it * 4 + h) * 32 + r] = ss;
    __syncthreads();
    const float tot = (red[(it * 4 + 0) * 32 + r] + red[(it * 4 + 1) * 32 + r]) + (red[(it * 4 + 2) * 32 + r] + red[(it * 4 + 3) * 32 + r]);
    const float rs = rsqrtf(tot * (1.f / 256) + EPS);
    bf16* mo = F.mix() + row * DM + 768 + h * 64 + 4 * hh;
#pragma unroll
    for (int mt = 0; mt < 2; ++mt)
#pragma unroll
        for (int gq = 0; gq < 4; ++gq) { const f32x4 gn = *(const f32x4*)(F.ssd_gn() + L * 256 + h * 64 + 32 * mt + 8 * gq + 4 * hh);
            u32x2 w; w.x = pk2(Y[mt][4 * gq] * rs * gn[0], Y[mt][4 * gq + 1] * rs * gn[1]); w.y = pk2(Y[mt][4 * gq + 2] * rs * gn[2], Y[mt][4 * gq + 3] * rs * gn[3]);
            *(u32x2*)(mo + 32 * mt + 8 * gq) = w; }
    __syncthreads();
}
template <int KIND> __device__ __forceinline__ void attn_units(const Fr& F, int L) {
    if (KIND == 2) { const int nu = (L == DEPTH - 1) ? 512 : 576;
        for (int u = F.vcu; u < nu; u += F.G) { if (u < 512) attn_unit<2>(F, L, u >> 6, (u >> 4) & 3, u & 15); else attn_unit<2>(F, L, (u - 512) >> 3, ((u - 512) >> 1) & 3, -1 - (u & 1)); }
    } else { const int nu = (L == DEPTH - 1) ? 256 : 288;
        for (int u = F.vcu; u < nu; u += F.G) { if (u < 256) attn_unit<KIND>(F, L, u >> 5, (u >> 3) & 3, u & 7); else attn_unit<KIND>(F, L, (u - 256) >> 2, (u - 256) & 3, -1); } }
}
__device__ __forceinline__ void phase_mix_fast(const Fr& F, int L) {
#ifndef ATT_MASK
#define ATT_MASK 15
#endif
#ifndef ATT_DUP
#define ATT_DUP 0
#endif
#ifndef ATT_MASK
#define ATT_MASK 15
#endif
    if (ATT_MASK & 4) for (int rp = 0; rp < ((ATT_DUP & 4) ? 2 : 1); ++rp) { const Fr Fa = refresh(F); attn_units<2>(Fa, L); }
    if (ATT_MASK & 2) for (int rp = 0; rp < ((ATT_DUP & 2) ? 2 : 1); ++rp) { const Fr Fa = refresh(F); attn_units<1>(Fa, L); }
    if (ATT_MASK & 1) for (int rp = 0; rp < ((ATT_DUP & 1) ? 2 : 1); ++rp) { const Fr Fa = refresh(F); attn_units<0>(Fa, L); }
    const int c0 = (L == DEPTH - 1) ? 4 : 0;
    if (ATT_MASK & 8) { const Fr Fa = refresh(F); unsigned* ctr = Fa.ctl() + CW_QUEUE + (L * 16 + 1) * 64;
        for (;;) { const int u = grab_unit(Fa, ctr); if (u >= NB * (36 - c0)) break; ssd_s3_unit(Fa, L, u / (36 - c0), c0 + u % (36 - c0)); } }
}

__device__ __forceinline__ void phase_route(const Fr& F, int L, bool commit = true) {
    const int nrows = (L == DEPTH - 1) ? NLAT : NROW;
    LAS float* wl = (LAS float*)F.lds;
    {   const f32x4* wg4 = (const f32x4*)(F.w_grp() + (size_t)L * DM * 4); const f32x4* we4 = (const f32x4*)(F.w_exp() + (size_t)L * DM * 16);
        f32x4 tg[2], te[8];
#pragma unroll
        for (int n = 0; n < 2; ++n) tg[n] = wg4[F.tid + 512 * n];
#pragma unroll
        for (int n = 0; n < 8; ++n) te[n] = we4[F.tid + 512 * n];
#pragma unroll
        for (int n = 0; n < 2; ++n) { const int k = F.tid + 512 * n;
#pragma unroll
            for (int o = 0; o < 4; ++o) wl[o * DM + k] = tg[n][o]; }
#pragma unroll
        for (int n = 0; n < 8; ++n) { const int i = F.tid + 512 * n, k = i >> 2, q = i & 3;
#pragma unroll
            for (int o = 0; o < 4; ++o) wl[(4 + 4 * q + o) * DM + k] = te[n][o]; }
    }
    __syncthreads();
    float keep[20];
#pragma unroll
    for (int o = 0; o < 20; ++o) keep[o] = 0.f;
    f32x4 v[4], vn[4];
    { const int r = F.gw; if (r < nrows) { const float* hp = r < NLAT ? F.out() + (size_t)r * DM : F.hc() + (size_t)(r - NLAT) * DM;
#pragma unroll
        for (int j = 0; j < 4; ++j) vn[j] = *(const f32x4*)(hp + 4 * F.lane + 256 * j); } }
    int it = 0;
    for (int r = F.gw; r < nrows; r += F.NGW, ++it) {
        const bool lat = r < NLAT; const int bb = lat ? (r >> 11) : 8;
#pragma unroll
        for (int j = 0; j < 4; ++j) v[j] = vn[j];
        { const int rn = r + F.NGW; if (rn < nrows) { const float* hp = rn < NLAT ? F.out() + (size_t)rn * DM : F.hc() + (size_t)(rn - NLAT) * DM;
#pragma unroll
            for (int j = 0; j < 4; ++j) vn[j] = *(const f32x4*)(hp + 4 * F.lane + 256 * j); } }
        float ss = 0.f;
#pragma unroll
        for (int j = 0; j < 4; ++j) ss += (v[j][0] * v[j][0] + v[j][1] * v[j][1]) + (v[j][2] * v[j][2] + v[j][3] * v[j][3]);
        const float rstd = rsqrtf(wsum(ss) * (1.f / DM) + EPS);
        const float* md = F.modv() + ((size_t)L * 9 + bb) * 6144;
        float lg[20];
#pragma unroll
        for (int o = 0; o < 20; ++o) lg[o] = 0.f;
#pragma unroll
        for (int j = 0; j < 4; ++j) { const int c = 4 * F.lane + 256 * j; const f32x4 g = *(const f32x4*)(F.g_ffn() + L * DM + c), sh = *(const f32x4*)(md + 3 * 1024 + c), scl = *(const f32x4*)(md + 4 * 1024 + c);
            const f32x4 f = v[j] * rstd * g * (scl + 1.f) + sh; u32x2 o2; o2.x = pk2(f[0], f[1]); o2.y = pk2(f[2], f[3]); *(u32x2*)(F.abuf() + (size_t)r * DM + c) = o2;
#pragma unroll
            for (int o = 0; o < 20; ++o) { const f32x4 w = *(const LAS f32x4*)(wl + o * DM + c); lg[o] += (f[0] * w[0] + f[1] * w[1]) + (f[2] * w[2] + f[3] * w[3]); }
            asm volatile("" ::: "memory"); }
#pragma unroll
        for (int o = 0; o < 20; ++o) { const float t = wsum(lg[o]); keep[o] = (F.lane == it) ? t : keep[o]; }
    }
    if (F.lane < it) {
        const int r = F.gw + F.lane * F.NGW;
        float gl[4]; float gm = -INFINITY; int gt = 0;
#pragma unroll
        for (int o = 0; o < 4; ++o) { gl[o] = keep[o] + F.b_grp()[L * 4 + o]; if (gl[o] > gm) { gm = gl[o]; gt = o; } }
        float gs = 0.f;
#pragma unroll
        for (int o = 0; o < 4; ++o) gs += expf(gl[o] - gm);
        const float gp = 1.f / gs;
        float el[4];
#pragma unroll
        for (int o = 0; o < 4; ++o) { float v4 = 0.f;
#pragma unroll
            for (int q = 0; q < 4; ++q) v4 = (gt == q) ? keep[4 + 4 * q + o] + F.b_exp()[L * 16 + 4 * q + o] : v4;
            el[o] = v4; }
        int i0 = 0; float m0 = el[0];
#pragma unroll
        for (int o = 1; o < 4; ++o) if (el[o] > m0) { m0 = el[o]; i0 = o; }
        int i1 = i0 == 0 ? 1 : 0; float m1 = i0 == 0 ? el[1] : el[0];
#pragma unroll
        for (int o = 1; o < 4; ++o) if (o != i0 && el[o] > m1) { m1 = el[o]; i1 = o; }
        const float e1 = expf(m1 - m0), w0 = gp / (1.f + e1), w1 = gp * e1 / (1.f + e1);
        const int x0 = gt * 4 + i0, x1 = gt * 4 + i1;
        if (commit) {
            F.rtw()[2 * r] = w0; F.rtw()[2 * r + 1] = w1;
            const unsigned p0 = atomicAdd(F.ctl() + CW_ECNT + (L * 16 + x0) * 64, 1u), p1 = atomicAdd(F.ctl() + CW_ECNT + (L * 16 + x1) * 64, 1u);
            F.elist()[x0 * NROW + p0] = 2 * r; F.elist()[x1 * NROW + p1] = 2 * r + 1; }
        else if (w0 + w1 < -1.f) F.rtw()[0] = 0.f;
    }
    __syncthreads();
}
__device__ __forceinline__ void moe_table(const Fr& F, int L) {
    volatile LAS int* T = (volatile LAS int*)(F.lds + LDSCTL_OFF + 64);
    volatile LAS int* Cn = (volatile LAS int*)(F.lds + LDSCTL_OFF + 160);
    __syncthreads();
    if (F.tid == 0) { int acc = 0;
        for (int e = 0; e < 16; ++e) { int c = (int)__hip_atomic_load(F.ctl() + CW_ECNT + (L * 16 + e) * 64, __ATOMIC_RELAXED, __HIP_MEMORY_SCOPE_AGENT); c = min(max(c, 0), NROW); T[e] = acc; Cn[e] = c; acc += (c + 255) >> 8; }
        T[16] = acc; }
    __syncthreads();
}

__global__ void __launch_bounds__(512, 2) fwd_kernel(Args args) {
    extern __shared__ __attribute__((aligned(16))) unsigned char lds_raw[];
    Fr F0;
    F0.lds = (LAS unsigned char*)lds_raw; F0.tid = threadIdx.x; F0.lane = F0.tid & 63; F0.wave = __builtin_amdgcn_readfirstlane(F0.tid >> 6);
    F0.G = gridDim.x; { const int bx = blockIdx.x; F0.vcu = (F0.G % 8 == 0) ? (bx % 8) * (F0.G / 8) + bx / 8 : bx; }
    F0.gw = F0.vcu * 8 + F0.wave; F0.NGW = F0.G * 8;
    F0.A = (const __attribute__((address_space(4))) Args*)__builtin_amdgcn_kernarg_segment_ptr();
    for (int u = F0.tid; u < (LDS_BYTES - LDSCTL_OFF) / 4; u += 512) ((LAS unsigned*)(F0.lds + LDSCTL_OFF))[u] = 0u;
    __syncthreads();
    const int lo = args.ph_lo, hi = args.ph_hi;
    XcdBarrier bar; bar.bar = F0.ctl() + CW_BAR; bar.x = 0; bar.st = nullptr;
    if (hi - lo > 1) bar = xcd_barrier_post(F0.ctl() + CW_BAR, (volatile LAS unsigned*)(F0.lds + LDSCTL_OFF));
#ifndef PH_MASK
#define PH_MASK 0xFFFF
#endif
#define PM(b) ((PH_MASK >> (b)) & 1)
#ifndef DUP_MASK
#define DUP_MASK 0
#endif
#ifndef DBL_SEAM
#define DBL_SEAM 0
#endif
#define NREP(b) (((DUP_MASK >> (b)) & 1) ? 2 : 1)
#define IN(k) (lo <= (k) && (k) < hi)
#define SEAM(k) do { if (IN(k) && IN((k) + 1)) { const Fr Fb = refresh(F0); XcdBarrier b2 = bar; b2.bar = Fb.ctl() + CW_BAR; xcd_barrier(b2); if ((DUP_MASK & 0x10000) || ((DBL_SEAM >> (((k) + NPH_L - 1) % NPH_L)) & 1)) xcd_barrier(b2); } } while (0)

    if (PM(0) && IN(0)) { for (int rep_ = 0; rep_ < NREP(0); ++rep_) { if (rep_) __syncthreads(); const Fr F = refresh(F0); phase_prologue(F); } }
    SEAM(0);
    for (int L = 0; L < DEPTH; ++L) {
        const int pb = 1 + NPH_L * L;
        const bool lastL = (L == DEPTH - 1);
        if (PM(1) && IN(pb + 0)) { const Fr F = refresh(F0); phase_norm(F, L); if (DUP_MASK & 2048) { __syncthreads(); phase_norm(F, L, false); } if (L == 0) for (int rp = 0; rp < NREP(10); ++rp) moe_weight_convert(F, 0); }
        SEAM(pb + 0);
        if (PM(2) && IN(pb + 1)) { for (int rep_ = 0; rep_ < NREP(2); ++rep_) { if (rep_) __syncthreads(); const Fr F = refresh(F0); pg8::DenseSched S; S.init(F.abuf(), F.winT() + (size_t)L * NP * DM, DM, NROW, NP, F.G, (int)blockIdx.x); pg8::EpiP E{F.pbuf()}; pg8::gemm_phase(F.lds, F.tid, DM, S, E); } }
        SEAM(pb + 1);
        if (PM(3) && IN(pb + 2)) { for (int rep_ = 0; rep_ < NREP(3); ++rep_) { if (rep_) __syncthreads(); const Fr F = refresh(F0); phase_prep(F, L); } }
        SEAM(pb + 2);
        if (PM(4) && IN(pb + 3)) { for (int rep_ = 0; rep_ < NREP(4); ++rep_) { if (rep_) __syncthreads(); const Fr F = refresh(F0); phase_ssd_s1(F, L); } }
        SEAM(pb + 3);
        if (PM(4) && IN(pb + 4)) { for (int rep_ = 0; rep_ < NREP(6); ++rep_) { if (rep_) __syncthreads(); const Fr F = refresh(F0); phase_ssd_scan(F, L); } }
        SEAM(pb + 4);
        if (PM(5) && IN(pb + 5)) { for (int rep_ = 0; rep_ < NREP(5); ++rep_) { if (rep_) __syncthreads(); const Fr F = refresh(F0); phase_mix_fast(F, L); } }
        SEAM(pb + 5);
        if (PM(6) && IN(pb + 6)) { const Fr F = refresh(F0); pg8::DenseSched S; S.init(F.mix(), F.woutT() + (size_t)L * DM * DM, DM, lastL ? NLAT : NROW, DM, F.G, (int)blockIdx.x);
            pg8::EpiRes E{L == 0 ? F.x() : F.out(), L == 0 ? F.ctx() : F.hc(), F.out(), F.hc(), F.modv() + (size_t)L * 9 * 6144 + 2 * 1024, 1.f}; pg8::gemm_phase(F.lds, F.tid, DM, S, E);
            if (!lastL && blockIdx.x >= 32) { __syncthreads(); moe_weight_convert(F, L + 1, ((int)blockIdx.x - 32) * 8 + F.wave, (F.G - 32) * 8); __syncthreads(); }
            if (DUP_MASK & 8192) { __syncthreads(); pg8::EpiRes E2{F.out(), F.hc(), F.out(), F.hc(), F.modv() + (size_t)L * 9 * 6144 + 2 * 1024, 0.f}; pg8::gemm_phase(F.lds, F.tid, DM, S, E2); } }
        SEAM(pb + 6);
        if (PM(7) && IN(pb + 7)) { const Fr F = refresh(F0); phase_route(F, L); if (DUP_MASK & 4096) phase_route(F, L, false); }
        SEAM(pb + 7);
        if (PM(8) && IN(pb + 8)) { for (int rep_ = 0; rep_ < NREP(8); ++rep_) { if (rep_) __syncthreads(); const Fr F = refresh(F0); moe_table(F, L);
            pg8::MoeSched<true> S{(const char*)F.abuf(), (const char*)F.wgu(L & 1), (size_t)1024 * DM * 2, DM, F.G, F.vcu, F.elist(), (const volatile LAS int*)(F.lds + LDSCTL_OFF + 64), (const volatile LAS int*)(F.lds + LDSCTL_OFF + 160)};
            pg8::EpiAct E{F.act()}; pg8::gemm_phase(F.lds, F.tid, DM, S, E); } }
        SEAM(pb + 8);
        if (PM(9) && IN(pb + 9)) { for (int rep_ = 0; rep_ < NREP(9); ++rep_) { if (rep_) __syncthreads(); const Fr F = refresh(F0); moe_table(F, L);
            pg8::MoeSched<false> S{(const char*)F.act(), (const char*)F.wd(L & 1), (size_t)1024 * FF * 2, FF, F.G, F.vcu, F.elist(), (const volatile LAS int*)(F.lds + LDSCTL_OFF + 64), (const volatile LAS int*)(F.lds + LDSCTL_OFF + 160)};
            pg8::EpiDown E{F.yk(), F.elist(), F.rtw()}; pg8::gemm_phase(F.lds, F.tid, FF, S, E); } }
        SEAM(pb + 9);
    }
    if (PM(1) && IN(PH_FINAL)) { const Fr F = refresh(F0); phase_norm(F, DEPTH); }
#undef IN
#undef SEAM
}

extern "C" void kernel_launch(void* const* d_in, const int* in_sizes, int n_in, void* d_out, int out_size, void* d_ws, size_t ws_size, hipStream_t stream) {
    static int grid = 0;
    if (grid == 0) {
        if (n_in != 36 || out_size != NLAT * DM || ws_size < WS_END) { fprintf(stderr, "kernel_launch: unexpected shapes (n_in %d out %d ws %zu)\n", n_in, out_size, ws_size); grid = -1; return; }
        int dev = 0, cus = 0, per_cu = 0;
        if (hipGetDevice(&dev) != hipSuccess || hipDeviceGetAttribute(&cus, hipDeviceAttributeMultiprocessorCount, dev) != hipSuccess) { grid = -1; return; }
        if (hipFuncSetAttribute((const void*)fwd_kernel, hipFuncAttributeMaxDynamicSharedMemorySize, LDS_BYTES) != hipSuccess) { fprintf(stderr, "kernel_launch: hipFuncSetAttribute failed\n"); grid = -1; return; }
        if (hipOccupancyMaxActiveBlocksPerMultiprocessor(&per_cu, (const void*)fwd_kernel, 512, LDS_BYTES) != hipSuccess || per_cu < 1) { fprintf(stderr, "kernel_launch: occupancy query says %d\n", per_cu); }
        (void)hipGetLastError();
        grid = cus;
    }
    if (grid < 0) return;
    (void)hipMemsetAsync((char*)d_ws + WS_CTL, 0, CTL_BYTES, stream);
    Args a{};
    for (int i = 0; i < 36; ++i) a.in[i] = (const float*)d_in[i];
    a.out = (float*)d_out; a.ws = (unsigned char*)d_ws;
#if MK_ONE_LAUNCH
    a.ph_lo = 0; a.ph_hi = NPHASE;
    hipLaunchKernelGGL(fwd_kernel, dim3(grid), dim3(512), LDS_BYTES, stream, a);
#else
    for (int ph = 0; ph < NPHASE; ++ph) { a.ph_lo = ph; a.ph_hi = ph + 1; hipLaunchKernelGGL(fwd_kernel, dim3(grid), dim3(512), LDS_BYTES, stream, a); }
#endif
}
```

```cpp
#include <hip/hip_runtime.h>
#include <cstdio>
#include <cstdint>

#ifndef MK_ONE_LAUNCH
#define MK_ONE_LAUNCH 1
#endif

#define LAS __attribute__((address_space(3)))
typedef unsigned short bf16;
typedef short bf16x8 __attribute__((ext_vector_type(8)));
typedef float f32x4 __attribute__((ext_vector_type(4)));
typedef float f32x2 __attribute__((ext_vector_type(2)));
typedef unsigned u32x4 __attribute__((ext_vector_type(4)));
typedef unsigned u32x2 __attribute__((ext_vector_type(2)));

constexpr int NB = 8, TLAT = 2048, TCTX = 256, SQ = 2304, DM = 1024, DEPTH = 4;
constexpr int NLAT = NB * TLAT, NCTXR = NB * TCTX, NROW = NLAT + NCTXR;
constexpr int NIN = 2984, NP = 3072;
constexpr int C_NA = 0, C_MLA = 768, C_DF = 1184, C_SSD = 1952;
constexpr int C_Z = C_SSD, C_XBC = C_SSD + 256, C_DT = C_SSD + 1024;
constexpr float EPS = 1e-6f;
constexpr int NEXP = 16, FF = 512, ACT_ROWS = 40960;
constexpr int NPH_L = 10, PH_FINAL = 1 + NPH_L * DEPTH, NPHASE = PH_FINAL + 1;

constexpr size_t MiB = 1u << 20;
constexpr size_t WS_CTL = 0, CTL_BYTES = 1 * MiB;
constexpr size_t WS_MOD = 1 * MiB;
constexpr size_t WS_ROPE = 2 * MiB;
constexpr size_t WS_WIN = 4 * MiB;
constexpr size_t WS_WOUT = 28 * MiB;
constexpr size_t WS_WQB = 36 * MiB;
constexpr size_t WS_WKVB = 37 * MiB;
constexpr size_t WS_WGU = 38 * MiB;
constexpr size_t WS_WD = 70 * MiB;
constexpr size_t WS_HC = 86 * MiB;
constexpr size_t WS_A = 94 * MiB;
constexpr size_t WS_P = 130 * MiB;
constexpr size_t WS_ACT = 130 * MiB;
constexpr size_t WS_YK = 170 * MiB;
constexpr size_t WS_MIX = 238 * MiB;
constexpr size_t WS_QNA = 274 * MiB, WS_KNA = 283 * MiB, WS_VNA = 292 * MiB;
constexpr size_t WS_QML = 301 * MiB, WS_KML = 315 * MiB, WS_VML = 329 * MiB;
constexpr size_t WS_QDF = 338 * MiB, WS_KDF = 347 * MiB, WS_VDF = 356 * MiB;
constexpr size_t WS_XT = 365 * MiB, WS_BTM = 374 * MiB, WS_BT = 383 * MiB, WS_CTM = 392 * MiB;
constexpr size_t WS_DT = 401 * MiB;
constexpr size_t WS_CST = 402 * MiB;
constexpr size_t WS_CDEC = 474 * MiB;
constexpr size_t WS_HENT = 475 * MiB;
constexpr size_t WS_RT = 511 * MiB;
constexpr size_t WS_ELIST = 512 * MiB;
constexpr size_t WS_WGU2 = 514 * MiB;
constexpr size_t WS_WD2 = 546 * MiB;
constexpr size_t WS_END = 562 * MiB;
constexpr int CW_BAR = 4096;
constexpr int CW_ECNT = 16384;
constexpr int CW_KMAX = 65536;
constexpr int CW_QUEUE = 32768;

constexpr int RING_BYTES = 131072, LDSCTL_OFF = RING_BYTES, LDS_BYTES = 147456;

typedef float f32x16 __attribute__((ext_vector_type(16)));
#define MFMA32(a, b, c) __builtin_amdgcn_mfma_f32_32x32x16_bf16((a), (b), (c), 0, 0, 0)
__device__ __forceinline__ int crow16(int reg, int hh) { return (reg & 3) + 8 * (reg >> 2) + 4 * hh; }
__device__ __forceinline__ float bf2f(bf16 v) { return __uint_as_float(((unsigned)v) << 16); }
__device__ __forceinline__ bf16 f2bf(float f) { unsigned u = __float_as_uint(f); return (bf16)((u + 0x7fffu + ((u >> 16) & 1u)) >> 16); }
__device__ __forceinline__ unsigned pk2(float lo, float hi) { return (unsigned)f2bf(lo) | ((unsigned)f2bf(hi) << 16); }
template <int CTRL> __device__ __forceinline__ float dppf(float v) { return __int_as_float(__builtin_amdgcn_update_dpp(0, __float_as_int(v), CTRL, 0xF, 0xF, true)); }
__device__ __forceinline__ float rlane(float v, int l) { return __int_as_float(__builtin_amdgcn_readlane(__float_as_int(v), l)); }
__device__ __forceinline__ float wsum(float v) {
    v += dppf<0xB1>(v); v += dppf<0x4E>(v); v += dppf<0x141>(v); v += dppf<0x140>(v);
    return (rlane(v, 0) + rlane(v, 16)) + (rlane(v, 32) + rlane(v, 48)); }
__device__ __forceinline__ float wmaxf(float v) {
    v = fmaxf(v, dppf<0xB1>(v)); v = fmaxf(v, dppf<0x4E>(v)); v = fmaxf(v, dppf<0x141>(v)); v = fmaxf(v, dppf<0x140>(v));
    return fmaxf(fmaxf(rlane(v, 0), rlane(v, 16)), fmaxf(rlane(v, 32), rlane(v, 48))); }
#define LDS_WAIT() asm volatile("s_waitcnt lgkmcnt(0)" ::: "memory")
__device__ __forceinline__ void row2bs(int r, int& b, int& s) { if (r < NLAT) { b = r >> 11; s = 256 + (r & 2047); } else { const int j = r - NLAT; b = j >> 8; s = j & 255; } }
__device__ __forceinline__ int bs2row(int b, int s) { return s < 256 ? NLAT + b * 256 + s : b * 2048 + s - 256; }
__device__ __forceinline__ int vpos(int s) { return (s & ~12) | ((s & 4) << 1) | ((s & 8) >> 1); }
__device__ __forceinline__ float siluf(float x) { return x / (1.f + __expf(-x)); }

#define XB_TMO      128
#define XB_XCNT(j)  (256  + 64 * (j))
#define XB_XSUB(j)  (1280 + 64 * (j))
#define XB_XGEN(j)  (2304 + 64 * (j))
#define XB_TOP      3328
#define XB_TOPGEN   3392
#define XCD_BAR_WORDS 3456
#define XB_SPIN_CAP (1u << 24)
__device__ __forceinline__ unsigned xb_ld(unsigned* p)              { return __hip_atomic_load(p, __ATOMIC_RELAXED, __HIP_MEMORY_SCOPE_AGENT); }
__device__ __forceinline__ unsigned xb_add(unsigned* p, unsigned v) { return __hip_atomic_fetch_add(p, v, __ATOMIC_RELAXED, __HIP_MEMORY_SCOPE_AGENT); }
__device__ __forceinline__ unsigned xb_xcc_id() { return (unsigned)__builtin_amdgcn_s_getreg((3 << 11) | 20) & 0xFu; }
#define XB_SPIN(cond, bar) do { unsigned _sp = 0; while (cond) { __builtin_amdgcn_s_sleep(1); \
    if ((++_sp & 255u) == 0u) { if (xb_ld(&(bar)[XB_TMO])) break; if (_sp > XB_SPIN_CAP) { atomicAdd(&(bar)[XB_TMO], 1u); break; } } } } while (0)
struct XcdBarrier { unsigned* bar; unsigned x; volatile LAS unsigned* st; };
__device__ __forceinline__ XcdBarrier xcd_barrier_post(unsigned* bar, volatile LAS unsigned* st) {
    XcdBarrier b; b.bar = bar; b.x = xb_xcc_id(); b.st = st;
    if (threadIdx.x == 0) (void)xb_add(&bar[XB_XCNT(b.x)], 1u);
    return b;
}
__device__ __forceinline__ void xcd_barrier_complete(unsigned* bar, unsigned x, unsigned& nloc, unsigned& nx) {
    const unsigned G = gridDim.x * gridDim.y * gridDim.z;
    unsigned sum, cnt, mine, sp = 0u;
    for (;;) {
        sum = 0u; cnt = 0u; mine = 0u;
#pragma unroll
        for (unsigned j = 0; j < 16; ++j) { const unsigned c = xb_ld(&bar[XB_XCNT(j)]); sum += c; cnt += (c > 0u) ? 1u : 0u; mine = (j == x) ? c : mine; }
        if (sum == G) break;
        __builtin_amdgcn_s_sleep(1);
        if ((++sp & 255u) == 0u) { if (xb_ld(&bar[XB_TMO])) break; if (sp > XB_SPIN_CAP) { atomicAdd(&bar[XB_TMO], 1u); break; } }
    }
    nloc = mine > 0u ? mine : 1u; nx = cnt > 0u ? cnt : 1u;
}
__device__ __forceinline__ void xcd_barrier(const XcdBarrier& b) {
    asm volatile("s_waitcnt vmcnt(0)" ::: "memory");
    __syncthreads();
    if (threadIdx.x == 0) {
        unsigned* bar = b.bar;
        __builtin_amdgcn_s_waitcnt(0);
        unsigned nloc = b.st[0], nx = b.st[1];
        if (nloc == 0u) { xcd_barrier_complete(bar, b.x, nloc, nx); b.st[0] = nloc; b.st[1] = nx; }
        const unsigned old = xb_add(&bar[XB_XSUB(b.x)], 1u);
        const unsigned gen = old / nloc;
        if (old + 1u == (gen + 1u) * nloc) {
            __builtin_amdgcn_fence(__ATOMIC_RELEASE, "agent");
            asm volatile("s_waitcnt vmcnt(0)" ::: "memory");
            const unsigned og = xb_add(&bar[XB_TOP], 1u);
            const unsigned tg = og / nx;
            if (og + 1u == (tg + 1u) * nx) xb_add(&bar[XB_TOPGEN], 1u);
            else XB_SPIN(xb_ld(&bar[XB_TOPGEN]) == tg, bar);
            __builtin_amdgcn_fence(__ATOMIC_ACQUIRE, "agent");
            xb_add(&bar[XB_XGEN(b.x)], 1u);
            asm volatile("s_waitcnt vmcnt(0)" ::: "memory");
        } else {
            XB_SPIN(xb_ld(&bar[XB_XGEN(b.x)]) == gen, bar);
            __builtin_amdgcn_fence(__ATOMIC_ACQUIRE, "agent");
            asm volatile("s_waitcnt vmcnt(0)" ::: "memory");
        }
    }
    __syncthreads();
}

namespace pg8 {
constexpr int BM = 256, BK = 64, HALF = 128, HTB = HALF * BK * 2, NXCD = 8, WGM = 8;
__device__ __forceinline__ int lds_byte(int r, int c) { const int st = (r >> 4) * 2 + (c >> 5), rr = r & 15, cc = c & 31, ob = rr * 64 + cc * 2; return st * 1024 + (ob ^ (((ob >> 9) & 1) << 5)); }
__device__ __forceinline__ void stage_rc(int b, int& R, int& C) { const int st = b / 1024, sb = b % 1024, swz = sb ^ (((sb >> 9) & 1) << 5); R = (st >> 1) * 16 + swz / 64; C = (st & 1) * 32 + (swz % 64) / 2; }
__device__ __forceinline__ int perm32(int rho) { const int n = rho >> 4, i = rho & 15; return 8 * (i >> 2) + 4 * n + (i & 3); }
struct Unit { int pm, pn, e, j, cnt; };

template <class Epi, class Sched>
__device__ __forceinline__ void gemm_phase(LAS unsigned char* lds, const int tid, const int K, const Sched& S, const Epi& E) {
    const int wid = __builtin_amdgcn_readfirstlane(tid >> 6), lane = tid & 63, wr = wid >> 2, wc = wid & 3, fr = lane & 15, fq = lane >> 4;
    const int nt = K / BK;
    int Rr[2]; unsigned Cb[2], voffB[2];
#pragma unroll
    for (int i = 0; i < 2; ++i) { int R, C; stage_rc(tid * 16 + i * 8192, R, C); const int Rb = Epi::PERM ? ((R & ~31) + perm32(R & 31)) : R;
        Rr[i] = R; Cb[i] = (unsigned)C * 2u; voffB[i] = (unsigned)(Rb * K + C) * 2u; }
    const size_t kstep = (size_t)(BK * 2);
    const size_t hstep = (size_t)HALF * K * 2;
    const unsigned ldsw = (unsigned)wid * 1024u;
    const int aoff = lds_byte(wr * 64 + fr, fq * 8), boff = lds_byte(wc * 32 + fr, fq * 8);
#define PG8_SA(b, h) (((b) * 2 + (h)) * HTB)
#define PG8_SB(b, h) ((4 + (b) * 2 + (h)) * HTB)
#define PG8_STAGE(bufoff, gbase, voff) do { _Pragma("unroll") for (int _i = 0; _i < 2; ++_i) \
        __builtin_amdgcn_global_load_lds((const unsigned*)((const char*)(gbase) + (voff)[_i]), (LAS unsigned*)(lds + (bufoff) + ldsw + _i * 8192), 16, 0, 0); } while (0)
#define PG8_LDA(dst, b, h) do { _Pragma("unroll") for (int m = 0; m < 4; ++m) _Pragma("unroll") for (int k = 0; k < 2; ++k) dst[m][k] = *(const LAS bf16x8*)(lds + PG8_SA(b, h) + aoff + m * 2048 + k * 1024); } while (0)
#define PG8_LDB(dst, b, h) do { _Pragma("unroll") for (int n = 0; n < 2; ++n) _Pragma("unroll") for (int k = 0; k < 2; ++k) dst[n][k] = *(const LAS bf16x8*)(lds + PG8_SB(b, h) + boff + n * 2048 + k * 1024); } while (0)
#define PG8_MMA(ai, bj, At, Bt) do { __builtin_amdgcn_s_setprio(1); _Pragma("unroll") for (int m = 0; m < 4; ++m) _Pragma("unroll") for (int n = 0; n < 2; ++n) _Pragma("unroll") for (int k = 0; k < 2; ++k) \
        acc[ai][bj][m][n] = __builtin_amdgcn_mfma_f32_16x16x32_bf16(Bt[n][k], At[m][k], acc[ai][bj][m][n], 0, 0, 0); __builtin_amdgcn_s_setprio(0); } while (0)
#define PG8_WAIT_V(n) asm volatile("s_waitcnt vmcnt(" #n ")" ::: "memory")
#define PG8_WAIT_L(n) asm volatile("s_waitcnt lgkmcnt(" #n ")" ::: "memory")
#define PG8_BAR __builtin_amdgcn_s_barrier()
#define PG8_SCHED __builtin_amdgcn_sched_barrier(0)
    Unit cur, nxt; int ui = 0;
    if (!S.next(0, cur)) return;
    f32x4 acc[2][2][4][2];
#pragma unroll
    for (int a = 0; a < 2; ++a)
#pragma unroll
        for (int b = 0; b < 2; ++b)
#pragma unroll
            for (int m = 0; m < 4; ++m)
#pragma unroll
                for (int n = 0; n < 2; ++n) acc[a][b][m][n] = (f32x4){0.f, 0.f, 0.f, 0.f};
    bf16x8 At[4][2], B0[2][2], B1[2][2];
    unsigned vA0[2], vA1[2];
    const char* cA = S.a_ptr(cur);
    if constexpr (Sched::GATHER) { S.a_offs(cur, Rr, vA0, vA1);
#pragma unroll
        for (int i = 0; i < 2; ++i) { vA0[i] += Cb[i]; vA1[i] += Cb[i]; }
        asm volatile("s_waitcnt vmcnt(0)" ::: "memory");
    } else {
#pragma unroll
        for (int i = 0; i < 2; ++i) { vA0[i] = (unsigned)(Rr[i] * K * 2) + Cb[i]; vA1[i] = vA0[i]; } }
    const size_t ahs = Sched::GATHER ? (size_t)0 : hstep;
    const char* cB = S.b_ptr(cur);
    PG8_STAGE(PG8_SB(0, 0), cB, voffB); PG8_STAGE(PG8_SB(0, 1), cB + hstep, voffB); PG8_STAGE(PG8_SA(0, 0), cA, vA0); PG8_STAGE(PG8_SA(0, 1), cA + ahs, vA1);
    if (wr == 1) PG8_BAR;
    PG8_WAIT_V(2); PG8_BAR;
    PG8_STAGE(PG8_SB(1, 0), cB + kstep, voffB); PG8_STAGE(PG8_SA(1, 0), cA + kstep, vA0); PG8_STAGE(PG8_SB(1, 1), cB + hstep + kstep, voffB);
    PG8_WAIT_V(6); PG8_BAR;
    for (;;) {
        const bool has_next = S.next(ui + 1, nxt);
        const char* nA = has_next ? S.a_ptr(nxt) : cA; const char* nB = has_next ? S.b_ptr(nxt) : cB;
        for (int t = 0; t < nt; t += 2) {
            const bool last = (t == nt - 2);
            const char* a1 = cA + (size_t)(t + 1) * kstep;
            const char* a2 = last ? nA : cA + (size_t)(t + 2) * kstep; const char* b2 = last ? nB : cB + (size_t)(t + 2) * kstep;
            const char* a3 = a2 + kstep; const char* b3 = b2 + kstep;
            PG8_LDB(B0, 0, 0); PG8_LDB(B1, 0, 1); PG8_SCHED; PG8_LDA(At, 0, 0); PG8_STAGE(PG8_SA(1, 1), a1 + ahs, vA1);
            if constexpr (Sched::GATHER) { if (last && has_next) { S.a_offs(nxt, Rr, vA0, vA1);
#pragma unroll
                for (int i = 0; i < 2; ++i) { vA0[i] += Cb[i]; vA1[i] += Cb[i]; }
                asm volatile("s_waitcnt vmcnt(0)" ::: "memory"); } }
            PG8_WAIT_V(8); PG8_WAIT_L(0); PG8_BAR; PG8_MMA(0, 0, At, B0); PG8_MMA(0, 1, At, B1); PG8_BAR; PG8_SCHED;
            PG8_LDA(At, 0, 1); PG8_STAGE(PG8_SB(0, 0), b2, voffB); PG8_STAGE(PG8_SB(0, 1), b2 + hstep, voffB); PG8_STAGE(PG8_SA(0, 0), a2, vA0);
            PG8_WAIT_V(8); PG8_WAIT_L(0); PG8_BAR; PG8_MMA(1, 0, At, B0); PG8_MMA(1, 1, At, B1); PG8_BAR; PG8_SCHED;
            PG8_LDB(B0, 1, 0); PG8_LDB(B1, 1, 1); PG8_SCHED; PG8_LDA(At, 1, 0); PG8_STAGE(PG8_SA(0, 1), a2 + ahs, vA1);
            PG8_WAIT_V(8); PG8_WAIT_L(0); PG8_BAR; PG8_MMA(0, 0, At, B0); PG8_MMA(0, 1, At, B1); PG8_BAR; PG8_SCHED;
            PG8_LDA(At, 1, 1); PG8_STAGE(PG8_SB(1, 0), b3, voffB); PG8_STAGE(PG8_SB(1, 1), b3 + hstep, voffB); PG8_STAGE(PG8_SA(1, 0), a3, vA0);
            PG8_WAIT_V(8); PG8_WAIT_L(0); PG8_BAR; PG8_MMA(1, 0, At, B0); PG8_MMA(1, 1, At, B1); PG8_BAR; PG8_SCHED;
        }
        if (wr == 0) PG8_BAR;
        E(acc, cur, wr, wc, fr, fq);
        if (!has_next) break;
#pragma unroll
        for (int a = 0; a < 2; ++a)
#pragma unroll
            for (int b = 0; b < 2; ++b)
#pragma unroll
                for (int m = 0; m < 4; ++m)
#pragma unroll
                    for (int n = 0; n < 2; ++n) acc[a][b][m][n] = (f32x4){0.f, 0.f, 0.f, 0.f};
        cur = nxt; cA = nA; cB = nB; ++ui;
        if (wr == 1) PG8_BAR;
    }
    PG8_WAIT_V(0);
    PG8_BAR;
#undef PG8_SA
#undef PG8_SB
#undef PG8_STAGE
#undef PG8_LDA
#undef PG8_LDB
#undef PG8_MMA
#undef PG8_WAIT_V
#undef PG8_WAIT_L
#undef PG8_BAR
#undef PG8_SCHED
}
__device__ __forceinline__ unsigned cvt_pk_bf16(float lo, float hi) { unsigned r; asm volatile("v_cvt_pk_bf16_f32 %0, %1, %2" : "=v"(r) : "v"(lo), "v"(hi)); return r; }

struct DenseSched {
    const char* A; const char* Bt; int K, nM, nN, nwg, G, c;
    __device__ void init(const void* A_, const void* Bt_, int K_, int M, int N, int G_, int c_) { A = (const char*)A_; Bt = (const char*)Bt_; K = K_; nM = M / BM; nN = N / BM; nwg = nM * nN; G = G_; c = c_; }
    __device__ __forceinline__ bool next(int i, Unit& u) const {
        const long L = (long)i * G + c; if (L >= nwg) return false;
        int wgid = (int)L; { const int q = nwg / NXCD, r = nwg % NXCD, xcd = wgid % NXCD, off = wgid / NXCD; wgid = (xcd < r ? xcd * (q + 1) : r * (q + 1) + (xcd - r) * q) + off; }
        const int nig = WGM * nN, gid = wgid / nig, fm = gid * WGM, gsz = (nM - fm) < WGM ? (nM - fm) : WGM;
        u.pm = fm + ((wgid % nig) % gsz); u.pn = (wgid % nig) / gsz; u.e = 0; u.j = 0; u.cnt = 256; return true;
    }
    static constexpr bool GATHER = false;
    __device__ __forceinline__ const char* a_ptr(const Unit& u) const { return A + (size_t)u.pm * BM * K * 2; }
    __device__ __forceinline__ void a_offs(const Unit&, const int (&)[2], unsigned (&)[2], unsigned (&)[2]) const {}
    __device__ __forceinline__ const char* b_ptr(const Unit& u) const { return Bt + (size_t)u.pn * BM * K * 2; }
};
template <bool GATHER_> struct MoeSched {
    static constexpr bool GATHER = GATHER_;
    const char* A; const char* W; size_t wstride; int K, G, c; const int* elist; const volatile LAS int* T; const volatile LAS int* Cn;
    __device__ __forceinline__ bool next(int i, Unit& u) const {
        const long L = (long)i * G + c; const int nT = T[16]; if (L >= 4L * nT) return false;
        const int tile = (int)(L >> 2); u.pn = (int)(L & 3); u.pm = tile;
        int e = 0;
#pragma unroll
        for (int k = 1; k < 16; ++k) e += (tile >= T[k]) ? 1 : 0;
        u.e = e; u.j = tile - T[e]; u.cnt = Cn[e]; return true;
    }
    __device__ __forceinline__ const char* a_ptr(const Unit& u) const { return GATHER ? A : A + (size_t)u.pm * BM * K * 2; }
    __device__ __forceinline__ void a_offs(const Unit& u, const int (&Rr)[2], unsigned (&v0)[2], unsigned (&v1)[2]) const {
#pragma unroll
        for (int i = 0; i < 2; ++i) {
            const int p0 = u.j * BM + Rr[i], p1 = p0 + HALF;
            int t0 = p0 < u.cnt ? (elist[u.e * NROW + p0] >> 1) : 0, t1 = p1 < u.cnt ? (elist[u.e * NROW + p1] >> 1) : 0;
            t0 = min(max(t0, 0), NROW - 1); t1 = min(max(t1, 0), NROW - 1);
            v0[i] = (unsigned)(t0 * K * 2); v1[i] = (unsigned)(t1 * K * 2);
        } }
    __device__ __forceinline__ const char* b_ptr(const Unit& u) const { return W + (size_t)u.e * wstride + (size_t)u.pn * BM * K * 2; }
};
struct EpiP {
    static constexpr bool PERM = true;
    bf16* O;
    __device__ __forceinline__ void operator()(const f32x4 (&acc)[2][2][4][2], const Unit& u, int wr, int wc, int fr, int fq) const {
        const int row0 = u.pm * BM + wr * 64 + fr, col0 = u.pn * BM + wc * 32 + 8 * fq;
#pragma unroll
        for (int ai = 0; ai < 2; ++ai)
#pragma unroll
            for (int m = 0; m < 4; ++m) { bf16* rowp = O + (size_t)(row0 + ai * HALF + m * 16) * NP + col0;
#pragma unroll
                for (int bj = 0; bj < 2; ++bj) { const f32x4 v0 = acc[ai][bj][m][0], v1 = acc[ai][bj][m][1];
                    u32x4 w; w.x = cvt_pk_bf16(v0[0], v0[1]); w.y = cvt_pk_bf16(v0[2], v0[3]); w.z = cvt_pk_bf16(v1[0], v1[1]); w.w = cvt_pk_bf16(v1[2], v1[3]);
                    *(u32x4*)(rowp + bj * HALF) = w; } }
    }
};
struct EpiRes {
    static constexpr bool PERM = false;
    const float* hin_l; const float* hin_c; float* hout_l; float* hout_c; const float* gate; float gsc;
    __device__ __forceinline__ void operator()(const f32x4 (&acc)[2][2][4][2], const Unit& u, int wr, int wc, int fr, int fq) const {
        const int row0 = u.pm * BM + wr * 64 + fr, col0 = u.pn * BM + wc * 32 + 4 * fq;
#pragma unroll
        for (int ai = 0; ai < 2; ++ai)
#pragma unroll
            for (int m = 0; m < 4; ++m) { const int r = row0 + ai * HALF + m * 16; const bool lat = r < NLAT; const int bb = lat ? (r >> 11) : 8;
                const float* hi = lat ? hin_l + (size_t)r * DM : hin_c + (size_t)(r - NLAT) * DM; float* ho = lat ? hout_l + (size_t)r * DM : hout_c + (size_t)(r - NLAT) * DM;
                const float* g = gate + (size_t)bb * 6144;
#pragma unroll
                for (int bj = 0; bj < 2; ++bj)
#pragma unroll
                    for (int n = 0; n < 2; ++n) { const int c = col0 + bj * HALF + n * 16; const f32x4 gv = *(const f32x4*)(g + c), hv = *(const f32x4*)(hi + c);
                        *(f32x4*)(ho + c) = hv + gv * gsc * acc[ai][bj][m][n]; } }
    }
};
struct EpiAct {
    static constexpr bool PERM = true;
    bf16* O;
    __device__ __forceinline__ void operator()(const f32x4 (&acc)[2][2][4][2], const Unit& u, int wr, int wc, int fr, int fq) const {
        const int row0 = u.pm * BM + wr * 64 + fr, col0 = u.pn * HALF + wc * 32 + 8 * fq;
#pragma unroll
        for (int ai = 0; ai < 2; ++ai)
#pragma unroll
            for (int m = 0; m < 4; ++m) { bf16* rowp = O + (size_t)(row0 + ai * HALF + m * 16) * FF + col0;
                float o[8];
#pragma unroll
                for (int n = 0; n < 2; ++n)
#pragma unroll
                    for (int j = 0; j < 4; ++j) { const float g = acc[ai][0][m][n][j], up = acc[ai][1][m][n][j]; o[n * 4 + j] = g / (1.f + __expf(-g)) * up; }
                u32x4 w; w.x = cvt_pk_bf16(o[0], o[1]); w.y = cvt_pk_bf16(o[2], o[3]); w.z = cvt_pk_bf16(o[4], o[5]); w.w = cvt_pk_bf16(o[6], o[7]);
                *(u32x4*)rowp = w; }
    }
};
struct EpiDown {
    static constexpr bool PERM = true;
    bf16* O; const int* elist; const float* rtw;
    __device__ __forceinline__ void operator()(const f32x4 (&acc)[2][2][4][2], const Unit& u, int wr, int wc, int fr, int fq) const {
        const int col0 = u.pn * BM + wc * 32 + 8 * fq;
#pragma unroll
        for (int ai = 0; ai < 2; ++ai)
#pragma unroll
            for (int m = 0; m < 4; ++m) { const int pos = u.j * BM + ai * HALF + wr * 64 + m * 16 + fr;
                if (pos < u.cnt) { const int a = min(max(elist[u.e * NROW + pos], 0), 2 * NROW - 1); const float w8 = rtw[a]; bf16* rowp = O + (size_t)a * DM + col0;
#pragma unroll
                    for (int bj = 0; bj < 2; ++bj) { const f32x4 v0 = acc[ai][bj][m][0] * w8, v1 = acc[ai][bj][m][1] * w8;
                        u32x4 w; w.x = cvt_pk_bf16(v0[0], v0[1]); w.y = cvt_pk_bf16(v0[2], v0[3]); w.z = cvt_pk_bf16(v1[0], v1[1]); w.w = cvt_pk_bf16(v1[2], v1[3]);
                        *(u32x4*)(rowp + bj * HALF) = w; } } }
    }
};
}

struct Args { const float* in[36]; float* out; unsigned char* ws; int ph_lo, ph_hi; };
struct Fr {
    LAS unsigned char* lds; int tid, lane, wave, G, vcu, gw, NGW; const __attribute__((address_space(4))) Args* A;
    __device__ __forceinline__ const float* x() const { return A->in[0]; }
    __device__ __forceinline__ const float* cvec() const { return A->in[1]; }
    __device__ __forceinline__ const float* ctx() const { return A->in[2]; }
    __device__ __forceinline__ const float* cctx() const { return A->in[3]; }
    __device__ __forceinline__ const float* w_mod() const { return A->in[4]; }
    __device__ __forceinline__ const float* b_mod() const { return A->in[5]; }
    __device__ __forceinline__ const float* g_mix() const { return A->in[6]; }
    __device__ __forceinline__ const float* w_in() const { return A->in[7]; }
    __device__ __forceinline__ const float* w_out() const { return A->in[8]; }
    __device__ __forceinline__ const float* na_gq() const { return A->in[9]; }
    __device__ __forceinline__ const float* na_gk() const { return A->in[10]; }
    __device__ __forceinline__ const float* na_rb() const { return A->in[11]; }
    __device__ __forceinline__ const float* mla_gqa() const { return A->in[12]; }
    __device__ __forceinline__ const float* mla_wqb() const { return A->in[13]; }
    __device__ __forceinline__ const float* mla_gkva() const { return A->in[14]; }
    __device__ __forceinline__ const float* mla_wkvb() const { return A->in[15]; }
    __device__ __forceinline__ const float* mla_gq() const { return A->in[16]; }
    __device__ __forceinline__ const float* mla_gk() const { return A->in[17]; }
    __device__ __forceinline__ const float* df_gq() const { return A->in[18]; }
    __device__ __forceinline__ const float* df_gk() const { return A->in[19]; }
    __device__ __forceinline__ const float* df_lam() const { return A->in[20]; }
    __device__ __forceinline__ const float* df_gsub() const { return A->in[21]; }
    __device__ __forceinline__ const float* conv_w() const { return A->in[22]; }
    __device__ __forceinline__ const float* conv_b() const { return A->in[23]; }
    __device__ __forceinline__ const float* dt_bias() const { return A->in[24]; }
    __device__ __forceinline__ const float* a_log() const { return A->in[25]; }
    __device__ __forceinline__ const float* ssd_d() const { return A->in[26]; }
    __device__ __forceinline__ const float* ssd_gn() const { return A->in[27]; }
    __device__ __forceinline__ const float* g_ffn() const { return A->in[28]; }
    __device__ __forceinline__ const float* w_grp() const { return A->in[29]; }
    __device__ __forceinline__ const float* b_grp() const { return A->in[30]; }
    __device__ __forceinline__ const float* w_exp() const { return A->in[31]; }
    __device__ __forceinline__ const float* b_exp() const { return A->in[32]; }
    __device__ __forceinline__ const float* w_gate() const { return A->in[33]; }
    __device__ __forceinline__ const float* w_up() const { return A->in[34]; }
    __device__ __forceinline__ const float* w_down() const { return A->in[35]; }
    __device__ __forceinline__ float* out() const { return A->out; }
    __device__ __forceinline__ unsigned* ctl() const { return (unsigned*)(A->ws + WS_CTL); }
    __device__ __forceinline__ float* modv() const { return (float*)(A->ws + WS_MOD); }
    __device__ __forceinline__ float* rcos() const { return (float*)(A->ws + WS_ROPE); }
    __device__ __forceinline__ float* rsin() const { return (float*)(A->ws + WS_ROPE + TLAT * 16 * 4); }
    __device__ __forceinline__ bf16* winT() const { return (bf16*)(A->ws + WS_WIN); }
    __device__ __forceinline__ bf16* woutT() const { return (bf16*)(A->ws + WS_WOUT); }
    __device__ __forceinline__ bf16* wqbT() const { return (bf16*)(A->ws + WS_WQB); }
    __device__ __forceinline__ bf16* wkvbT() const { return (bf16*)(A->ws + WS_WKVB); }
    __device__ __forceinline__ bf16* wgu(int par = 0) const { return (bf16*)(A->ws + (par ? WS_WGU2 : WS_WGU)); }
    __device__ __forceinline__ bf16* wd(int par = 0) const { return (bf16*)(A->ws + (par ? WS_WD2 : WS_WD)); }
    __device__ __forceinline__ float* hc() const { return (float*)(A->ws + WS_HC); }
    __device__ __forceinline__ bf16* abuf() const { return (bf16*)(A->ws + WS_A); }
    __device__ __forceinline__ bf16* pbuf() const { return (bf16*)(A->ws + WS_P); }
    __device__ __forceinline__ bf16* act() const { return (bf16*)(A->ws + WS_ACT); }
    __device__ __forceinline__ bf16* yk() const { return (bf16*)(A->ws + WS_YK); }
    __device__ __forceinline__ bf16* mix() const { return (bf16*)(A->ws + WS_MIX); }
    __device__ __forceinline__ bf16* qna() const { return (bf16*)(A->ws + WS_QNA); }
    __device__ __forceinline__ bf16* kna() const { return (bf16*)(A->ws + WS_KNA); }
    __device__ __forceinline__ bf16* vna() const { return (bf16*)(A->ws + WS_VNA); }
    __device__ __forceinline__ bf16* qml() const { return (bf16*)(A->ws + WS_QML); }
    __device__ __forceinline__ bf16* kml() const { return (bf16*)(A->ws + WS_KML); }
    __device__ __forceinline__ bf16* vml() const { return (bf16*)(A->ws + WS_VML); }
    __device__ __forceinline__ bf16* qdf() const { return (bf16*)(A->ws + WS_QDF); }
    __device__ __forceinline__ bf16* kdf() const { return (bf16*)(A->ws + WS_KDF); }
    __device__ __forceinline__ bf16* vdf() const { return (bf16*)(A->ws + WS_VDF); }
    __device__ __forceinline__ bf16* xT() const { return (bf16*)(A->ws + WS_XT); }
    __device__ __forceinline__ bf16* btm() const { return (bf16*)(A->ws + WS_BTM); }
    __device__ __forceinline__ bf16* bT() const { return (bf16*)(A->ws + WS_BT); }
    __device__ __forceinline__ bf16* ctm() const { return (bf16*)(A->ws + WS_CTM); }
    __device__ __forceinline__ float* dtv() const { return (float*)(A->ws + WS_DT); }
    __device__ __forceinline__ float* cst() const { return (float*)(A->ws + WS_CST); }
    __device__ __forceinline__ float* cdec() const { return (float*)(A->ws + WS_CDEC); }
    __device__ __forceinline__ bf16* hent() const { return (bf16*)(A->ws + WS_HENT); }
    __device__ __forceinline__ float* ydir() const { return (float*)(A->ws + WS_CST); }
    __device__ __forceinline__ int* rte() const { return (int*)(A->ws + WS_RT); }
    __device__ __forceinline__ float* rtw() const { return (float*)(A->ws + WS_RT + 256 * 1024); }
    __device__ __forceinline__ int* elist() const { return (int*)(A->ws + WS_ELIST); }
};

__device__ __forceinline__ Fr refresh(const Fr& F0) { Fr F = F0; int w = F0.wave; asm volatile("" : "+s"(w)); asm volatile("" : "+s"(F.A));
    int l; asm volatile("v_mbcnt_lo_u32_b32 %0, -1, 0\n\tv_mbcnt_hi_u32_b32 %0, -1, %0" : "=v"(l)); F.wave = w; F.lane = l; F.tid = w * 64 + l; F.gw = F.vcu * 8 + w; return F; }
__device__ __forceinline__ void tr_item(const float* W, int ldw, int nvalid, int k0, int n0, bf16* dst, int ldd, LAS float* scr, int lane, const float* ksc = nullptr) {
    const int cn = n0 + (lane & 31), cnc = min(cn, nvalid - 1);
    float tv[32];
#pragma unroll
    for (int i = 0; i < 32; ++i) { const int kk = 2 * i + (lane >> 5); tv[i] = W[(size_t)(k0 + kk) * ldw + cnc]; }
#pragma unroll
    for (int i = 0; i < 32; ++i) { const int kk = 2 * i + (lane >> 5); const float sc1 = ksc ? ksc[k0 + kk] : 1.f; scr[kk * 33 + (lane & 31)] = cn < nvalid ? tv[i] * sc1 : 0.f; }
    LDS_WAIT();
    const int c = lane & 7;
#pragma unroll
    for (int j = 0; j < 4; ++j) { const int n = (lane >> 3) + 8 * j; const LAS float* s = scr + (8 * c) * 33 + n;
        u32x4 o; o.x = pk2(s[0 * 33], s[1 * 33]); o.y = pk2(s[2 * 33], s[3 * 33]); o.z = pk2(s[4 * 33], s[5 * 33]); o.w = pk2(s[6 * 33], s[7 * 33]);
        *(u32x4*)(dst + (size_t)n * ldd + k0 + 8 * c) = o; }
    LDS_WAIT();
}
__device__ __forceinline__ void moe_weight_convert(const Fr& F, int L, int gw0 = -1, int ngw0 = 0) {
    LAS float* scr = (LAS float*)(F.lds + F.wave * 16384);
    const int gwc = gw0 >= 0 ? gw0 : F.gw, ngwc = gw0 >= 0 ? ngw0 : F.NGW; bf16* const wgu_ = F.wgu(L & 1); bf16* const wd_ = F.wd(L & 1);
    constexpr int I_GU = 16 * 16, I_D = 8 * 32;
    for (int it = gwc; it < NEXP * (2 * I_GU + I_D); it += ngwc) {
        const int e = it / (2 * I_GU + I_D); int r = it % (2 * I_GU + I_D);
        if (r < 2 * I_GU) { const int bj = r / I_GU; r %= I_GU; const int kb = r / 16, nb = r % 16, n0 = nb * 32;
            const float* W = (bj ? F.w_up() : F.w_gate()) + ((size_t)L * NEXP + e) * DM * FF;
            tr_item(W, FF, FF, kb * 64, n0, wgu_ + ((size_t)e * 1024 + (n0 >> 7) * 256 + bj * 128 + (n0 & 127)) * DM, DM, scr, F.lane);
        } else { r -= 2 * I_GU; const int kb = r / 32, nb = r % 32, n0 = nb * 32;
            const float* W = F.w_down() + ((size_t)L * NEXP + e) * FF * DM;
            tr_item(W, DM, DM, kb * 64, n0, wd_ + ((size_t)e * 1024 + n0) * FF, FF, scr, F.lane); }
    }
}
__device__ __forceinline__ void phase_prologue(const Fr& F) {
    {   LAS float* sc = (LAS float*)F.lds;
        LAS float* part = (LAS float*)(F.lds + 40960);
        for (int i = F.tid; i < 9 * 1024; i += 512) { const float v = i < 8192 ? F.cvec()[i] : F.cctx()[i - 8192]; sc[i] = siluf(v); }
        __syncthreads();
        for (int u = F.vcu; u < 384; u += F.G) {
            const int col = u * 64 + F.lane, L = col / 6144, n = col - L * 6144;
            const float* w = F.w_mod() + ((size_t)L * 1024 + F.wave * 128) * 6144 + n;
            float acc[9];
#pragma unroll
            for (int b = 0; b < 9; ++b) acc[b] = 0.f;
#pragma unroll 1
            for (int k0 = 0; k0 < 128; k0 += 16) { float wv[16];
#pragma unroll
                for (int j = 0; j < 16; ++j) wv[j] = w[(size_t)(k0 + j) * 6144];
#pragma unroll
                for (int j = 0; j < 16; ++j)
#pragma unroll
                    for (int b = 0; b < 9; ++b) acc[b] += sc[b * 1024 + F.wave * 128 + k0 + j] * wv[j]; }
#pragma unroll
            for (int b = 0; b < 9; ++b) part[(F.wave * 9 + b) * 64 + F.lane] = acc[b];
            __syncthreads();
            for (int i = F.tid; i < 9 * 64; i += 512) { const int b = i >> 6, l = i & 63; float s = 0.f;
#pragma unroll
                for (int w8 = 0; w8 < 8; ++w8) s += part[(w8 * 9 + b) * 64 + l];
                const int c2 = u * 64 + l, L2 = c2 / 6144, n2 = c2 - L2 * 6144;
                F.modv()[((size_t)L2 * 9 + b) * 6144 + n2] = s + F.b_mod()[L2 * 6144 + n2]; }
            __syncthreads();
        }
    }
    if (blockIdx.x == 0 && F.wave < 4) {
#pragma unroll 1
        for (int q = 0; q < 4; ++q) { const int lh = F.wave * 4 + q; float bm = 0.f;
            for (int i = F.lane; i < 465; i += 64) bm = fmaxf(bm, F.na_rb()[lh * 465 + i]);
            bm = wmaxf(bm); if (F.lane == 0) (F.rcos() + 2 * TLAT * 16)[lh] = bm * 1.4426950408889634f; } }
    for (int i = blockIdx.x * 512 + F.tid; i < TLAT * 16; i += F.G * 512) { const int t = i >> 4, k = i & 15; const float inv = powf(10000.f, -(float)(k & 7) / 8.f);
        const float pos = (k < 8) ? (float)(t >> 6) : (float)(t & 63); const float ang = pos * inv; F.rcos()[i] = cosf(ang); F.rsin()[i] = sinf(ang); }
    __syncthreads();
    LAS float* scr = (LAS float*)(F.lds + F.wave * 16384);
    constexpr int I_IN = 16 * 96, I_OUT = 16 * 32, I_QB = 4 * 12, I_KVB = 2 * 16, I_L = I_IN + I_OUT + I_QB + I_KVB;
    for (int it = F.gw; it < DEPTH * I_L; it += F.NGW) {
        const int L = it / I_L; int r = it % I_L;
        if (r < I_IN) { const int kb = r / 96, nb = r % 96; tr_item(F.w_in() + (size_t)L * DM * NIN, NIN, NIN, kb * 64, nb * 32, F.winT() + ((size_t)L * NP + nb * 32) * DM, DM, scr, F.lane); continue; } r -= I_IN;
        if (r < I_OUT) { const int kb = r / 32, nb = r % 32; tr_item(F.w_out() + (size_t)L * DM * DM, DM, DM, kb * 64, nb * 32, F.woutT() + ((size_t)L * DM + nb * 32) * DM, DM, scr, F.lane); continue; } r -= I_OUT;
        if (r < I_QB) { const int kb = r / 12, nb = r % 12; tr_item(F.mla_wqb() + (size_t)L * 256 * 384, 384, 384, kb * 64, nb * 32, F.wqbT() + ((size_t)L * 384 + nb * 32) * 256, 256, scr, F.lane, F.mla_gqa() + L * 256); continue; } r -= I_QB;
        { const int kb = r / 16, nb = r % 16; tr_item(F.mla_wkvb() + (size_t)L * 128 * 512, 512, 512, kb * 64, nb * 32, F.wkvbT() + ((size_t)L * 512 + nb * 32) * 128, 128, scr, F.lane, F.mla_gkva() + L * 128); }
    }
}

__device__ __forceinline__ void phase_norm(const Fr& F, int L, bool combine = true) {
    const int nrows = (L == DEPTH) ? NLAT : NROW;
    for (int r = F.gw; r < nrows; r += F.NGW) {
        const bool lat = r < NLAT; const int bb = lat ? (r >> 11) : 8;
        const float* hin = (L == 0) ? (lat ? F.x() + (size_t)r * DM : F.ctx() + (size_t)(r - NLAT) * DM) : (lat ? F.out() + (size_t)r * DM : F.hc() + (size_t)(r - NLAT) * DM);
        float* hout = lat ? F.out() + (size_t)r * DM : F.hc() + (size_t)(r - NLAT) * DM;
        f32x4 v[4];
#pragma unroll
        for (int j = 0; j < 4; ++j) v[j] = *(const f32x4*)(hin + 4 * F.lane + 256 * j);
        if (L > 0 && combine) {
            const float* m5 = F.modv() + ((size_t)(L - 1) * 9 + bb) * 6144 + 5 * 1024;
#pragma unroll
            for (int j = 0; j < 4; ++j) { const int c = 4 * F.lane + 256 * j; const f32x4 g = *(const f32x4*)(m5 + c);
                const u32x2 y0 = *(const u32x2*)(F.yk() + (size_t)(2 * r) * DM + c), y1 = *(const u32x2*)(F.yk() + (size_t)(2 * r + 1) * DM + c);
                f32x4 ys; ys[0] = __uint_as_float(y0.x << 16) + __uint_as_float(y1.x << 16); ys[1] = __uint_as_float(y0.x & 0xffff0000u) + __uint_as_float(y1.x & 0xffff0000u);
                ys[2] = __uint_as_float(y0.y << 16) + __uint_as_float(y1.y << 16); ys[3] = __uint_as_float(y0.y & 0xffff0000u) + __uint_as_float(y1.y & 0xffff0000u);
                v[j] = v[j] + g * ys; *(f32x4*)(hout + c) = v[j]; }
        }
        if (L == DEPTH) continue;
        float ss = 0.f;
#pragma unroll
        for (int j = 0; j < 4; ++j) ss += (v[j][0] * v[j][0] + v[j][1] * v[j][1]) + (v[j][2] * v[j][2] + v[j][3] * v[j][3]);
        const float rstd = rsqrtf(wsum(ss) * (1.f / DM) + EPS);
        const float* md = F.modv() + ((size_t)L * 9 + bb) * 6144;
#pragma unroll
        for (int j = 0; j < 4; ++j) { const int c = 4 * F.lane + 256 * j; const f32x4 g = *(const f32x4*)(F.g_mix() + L * DM + c), sh = *(const f32x4*)(md + c), scl = *(const f32x4*)(md + 1024 + c);
            const f32x4 a = v[j] * rstd * g * (scl + 1.f) + sh; u32x2 o; o.x = pk2(a[0], a[1]); o.y = pk2(a[2], a[3]); *(u32x2*)(F.abuf() + (size_t)r * DM + c) = o; }
    }
}

__device__ __forceinline__ void prep_row(const Fr& F, int L, int r, LAS float* scr) {
    int lane_ = F.lane; asm volatile("" : "+v"(lane_)); const int lane = lane_; int b, s; row2bs(r, b, s); const bool lat = r < NLAT; const int t = s - 256;
    const bf16* p = F.pbuf() + (size_t)r * NP;
#pragma unroll
    for (int h = 0; h < 4; ++h) {
        const float q = bf2f(p[C_NA + h * 64 + lane]), k = bf2f(p[C_NA + 256 + h * 64 + lane]);
        const float rq = rsqrtf(wsum(q * q) * (1.f / 64) + EPS), rk = rsqrtf(wsum(k * k) * (1.f / 64) + EPS);
        const size_t o = ((size_t)(b * 4 + h) * SQ + s) * 64 + lane;
        F.qna()[o] = f2bf(q * rq * F.na_gq()[L * 64 + lane]); F.kna()[o] = f2bf(k * rk * F.na_gk()[L * 64 + lane]);
    }
    {
        const int idx = lane & 31; float cs = 1.f, sn = 0.f;
        if (lat) { cs = F.rcos()[t * 16 + (idx & 15)]; sn = F.rsin()[t * 16 + (idx & 15)]; }
#pragma unroll
        for (int h = 0; h < 4; ++h) {
            float q = bf2f(p[C_DF + h * 64 + lane]), k = bf2f(p[C_DF + 256 + h * 64 + lane]);
            float sq = q * q, sk = k * k;
#pragma unroll
            for (int o = 16; o >= 1; o >>= 1) { sq += __shfl_xor(sq, o); sk += __shfl_xor(sk, o); }
            q *= rsqrtf(sq * (1.f / 32) + EPS) * F.df_gq()[L * 32 + idx]; k *= rsqrtf(sk * (1.f / 32) + EPS) * F.df_gk()[L * 32 + idx];
            const float qp = __shfl_xor(q, 16), kp = __shfl_xor(k, 16);
            if (lat) { q = (idx < 16) ? q * cs - qp * sn : qp * sn + q * cs; k = (idx < 16) ? k * cs - kp * sn : kp * sn + k * cs; }
            const size_t o = ((size_t)(b * 4 + h) * SQ + s) * 64 + lane;
            F.qdf()[o] = f2bf(q); F.kdf()[o] = f2bf(k);
        }
    }
}
__device__ __forceinline__ void prep_tile(const Fr& F, int L, int b, int c) {
    int tid_ = F.tid; asm volatile("" : "+v"(tid_)); const int tid = tid_;
    const int s0 = 64 * c; const size_t r0 = bs2row(b, s0);
    LAS bf16* Lv = (LAS bf16*)F.lds;
#ifndef PT_MASK
#define PT_MASK 7
#endif
    if (PT_MASK & 1)
#pragma unroll 1
    for (int mx = 0; mx < 2; ++mx) {
        const int voff = mx == 0 ? C_NA + 512 : C_DF + 512; bf16* vt = mx == 0 ? F.vna() : F.vdf();
#pragma unroll
        for (int k = 0; k < 4; ++k) { const int idx = tid + 512 * k, tok = idx >> 5, d8 = (idx & 31) * 8;
            const u32x4 v = *(const u32x4*)(F.pbuf() + (r0 + tok) * NP + voff + d8); const int pc = vpos(tok);
#pragma unroll
            for (int e = 0; e < 4; ++e) { Lv[(d8 + 2 * e) * 72 + pc] = (bf16)(v[e] & 0xffffu); Lv[(d8 + 2 * e + 1) * 72 + pc] = (bf16)(v[e] >> 16); } }
        __syncthreads();
#pragma unroll
        for (int k = 0; k < 4; ++k) { const int idx = tid + 512 * k, dv = idx >> 3, pc = idx & 7;
            const u32x4 v = *(const LAS u32x4*)(Lv + dv * 72 + pc * 8);
#ifndef PT_NOSTORE
#define PT_NOSTORE 0
#endif
            if (!PT_NOSTORE || v.x == 0x12345678u) *(u32x4*)(vt + ((size_t)(b * 4 + (dv >> 6)) * 64 + (dv & 63)) * SQ + s0 + pc * 8) = v; }
        __syncthreads();
    }
    const int len = c < 4 ? TCTX : TLAT, t0 = c < 4 ? s0 : s0 - 256;
    LAS bf16* Lc = (LAS bf16*)F.lds;
    if (PT_MASK & 2)
#pragma unroll 1
    for (int gch = 0; gch < 3; ++gch) {
        {   u32x4 v[5];
#pragma unroll
            for (int k = 0; k < 5; ++k) { const int idx = min(tid + 512 * k, 68 * 32 - 1), j = idx >> 5, c8 = (idx & 31) * 8, tj = t0 - 2 + j, jc = min(max(tj, 0), len - 1) - t0;
                v[k] = *(const u32x4*)(F.pbuf() + (size_t)((long)r0 + jc) * NP + C_XBC + gch * 256 + c8);
                const unsigned keep = (tj >= 0 && tj < len) ? 0xffffffffu : 0u; v[k].x &= keep; v[k].y &= keep; v[k].z &= keep; v[k].w &= keep; }
#pragma unroll
            for (int k = 0; k < 5; ++k) { const int idx = tid + 512 * k, j = idx >> 5, c8 = (idx & 31) * 8; if (idx < 68 * 32) *(LAS u32x4*)(Lc + j * 256 + c8) = v[k]; }
        }
        __syncthreads();
        const int ch = tid & 255, tq = tid >> 8, cg = gch * 256 + ch;
        float w[5];
#pragma unroll
        for (int j = 0; j < 5; ++j) w[j] = F.conv_w()[(L * 5 + j) * 768 + cg];
        const float bias = F.conv_b()[L * 768 + cg];
        const LAS bf16* lp = Lc + (32 * tq) * 256 + ch;
        float x0 = bf2f(lp[0]), x1 = bf2f(lp[256]), x2 = bf2f(lp[512]), x3 = bf2f(lp[768]);
        bf16* tm = (gch == 1 ? F.btm() : F.ctm()) + ((size_t)b * SQ + s0 + 32 * tq) * 256 + ch;
        bf16* cm = (gch == 0 ? F.xT() : F.bT()) + ((size_t)b * 256 + ch) * SQ + s0 + 32 * tq;
#pragma unroll
        for (int g8 = 0; g8 < 4; ++g8) { unsigned pk[4];
#pragma unroll
            for (int e = 0; e < 8; ++e) { const int i = 8 * g8 + e; const float x4 = bf2f(lp[(i + 4) * 256]);
                const float acc = bias + w[0] * x0 + w[1] * x1 + w[2] * x2 + w[3] * x3 + w[4] * x4; const unsigned o = f2bf(siluf(acc));
                if (gch >= 1) tm[(size_t)i * 256] = (bf16)o;
                if (e & 1) pk[e >> 1] |= o << 16; else pk[e >> 1] = o;
                x0 = x1; x1 = x2; x2 = x3; x3 = x4; }
            if (gch <= 1) { u32x4 v; v.x = pk[0]; v.y = pk[1]; v.z = pk[2]; v.w = pk[3]; *(u32x4*)(cm + 8 * g8) = v; } }
        __syncthreads();
    }
    if (PT_MASK & 4) { const int tok = tid >> 3, i = tid & 7; const float raw = bf2f(F.pbuf()[(r0 + tok) * NP + C_DT + i]) + F.dt_bias()[L * 8 + i]; const float ex = __expf(raw);
      F.dtv()[((size_t)b * 8 + i) * SQ + s0 + tok] = raw > 20.f ? raw : (ex < 0.03f ? ex * (1.f - ex * (0.5f - ex * (0.33333334f - 0.25f * ex))) : __logf(1.f + ex)); }
}
__device__ __forceinline__ void mla_prep_block(const Fr& F, int L, int b, int j32) {
    int lane_ = F.lane; asm volatile("" : "+v"(lane_));
    const int lane = lane_, wave = F.wave, r = lane & 31, hh = lane >> 5, s = 32 * j32 + r, t = s - 256; const bool lat = s >= 256;
    const size_t row = bs2row(b, s);
    const bf16* p = F.pbuf() + row * NP + C_MLA;
    const int tt = lat ? t : 0; const float latf = lat ? 1.f : 0.f;
    if (wave < 4) {
        const int hq = wave;
        bf16x8 Bq[16]; float ss = 0.f;
#pragma unroll
        for (int kk = 0; kk < 16; ++kk) { Bq[kk] = *(const bf16x8*)(p + 16 * kk + 8 * hh);
#pragma unroll
            for (int j = 0; j < 8; ++j) { const float v = bf2f((bf16)Bq[kk][j]); ss += v * v; } }
        ss += __shfl_xor(ss, 32); const float rq = rsqrtf(ss * (1.f / 256) + EPS);
        f32x16 acc[3]; float hs = 0.f;
#pragma unroll
        for (int j3 = 0; j3 < 3; ++j3) {
#pragma unroll
            for (int i = 0; i < 16; ++i) acc[j3][i] = 0.f;
            const bf16* wp = F.wqbT() + ((size_t)L * 384 + 96 * hq + 32 * j3 + r) * 256 + 8 * hh;
#pragma unroll
            for (int kk = 0; kk < 16; ++kk) acc[j3] = MFMA32(*(const bf16x8*)(wp + 16 * kk), Bq[kk], acc[j3]);
            asm volatile("" ::: "memory");
#pragma unroll
            for (int i = 0; i < 16; ++i) hs += acc[j3][i] * acc[j3][i]; }
        hs = (hs + __shfl_xor(hs, 32)) * rq * rq; const float rs = rsqrtf(hs * (1.f / 96) + EPS) * rq;
        bf16* qo = F.qml() + ((size_t)(b * 4 + hq) * SQ + s) * 96 + 4 * hh;
#pragma unroll
        for (int j3 = 0; j3 < 3; ++j3) {
#pragma unroll
            for (int i = 0; i < 16; ++i) acc[j3][i] *= rs * F.mla_gq()[L * 96 + 32 * j3 + crow16(i, hh)];
            if (j3 == 2) {
#pragma unroll
                for (int i = 0; i < 8; ++i) { const float rc = lat ? F.rcos()[tt * 16 + crow16(i, hh)] : 1.f, rsn = F.rsin()[tt * 16 + crow16(i, hh)] * latf;
                    const float x1 = acc[2][i], x2 = acc[2][i + 8]; acc[2][i] = x1 * rc - x2 * rsn; acc[2][i + 8] = x1 * rsn + x2 * rc; } }
#pragma unroll
            for (int g = 0; g < 4; ++g) { u32x2 w; w.x = pk2(acc[j3][4 * g], acc[j3][4 * g + 1]); w.y = pk2(acc[j3][4 * g + 2], acc[j3][4 * g + 3]); *(u32x2*)(qo + 32 * j3 + 8 * g) = w; } }
    } else {
        const int hk = wave - 4;
        LAS unsigned char* wl = F.lds + wave * 16384;
        bf16x8 Bkv[8]; float ss = 0.f;
#pragma unroll
        for (int kk = 0; kk < 8; ++kk) { Bkv[kk] = *(const bf16x8*)(p + 256 + 16 * kk + 8 * hh);
#pragma unroll
            for (int j = 0; j < 8; ++j) { const float v = bf2f((bf16)Bkv[kk][j]); ss += v * v; } }
        ss += __shfl_xor(ss, 32); const float rk = rsqrtf(ss * (1.f / 128) + EPS);
        float kr[16]; float hs = 0.f;
#pragma unroll
        for (int g = 0; g < 4; ++g) { const u32x2 k4 = *(const u32x2*)(p + 384 + 8 * g + 4 * hh);
            kr[4 * g] = __uint_as_float(k4.x << 16); kr[4 * g + 1] = __uint_as_float(k4.x & 0xffff0000u); kr[4 * g + 2] = __uint_as_float(k4.y << 16); kr[4 * g + 3] = __uint_as_float(k4.y & 0xffff0000u); }
#pragma unroll
        for (int i = 0; i < 16; ++i) hs += kr[i] * kr[i];
        f32x16 acc[4]; float ks = 0.f;
#pragma unroll
        for (int j4 = 0; j4 < 4; ++j4) {
#pragma unroll
            for (int i = 0; i < 16; ++i) acc[j4][i] = 0.f;
            const bf16* wp = F.wkvbT() + ((size_t)L * 512 + 128 * hk + 32 * j4 + r) * 128 + 8 * hh;
#pragma unroll
            for (int kk = 0; kk < 8; ++kk) acc[j4] = MFMA32(*(const bf16x8*)(wp + 16 * kk), Bkv[kk], acc[j4]);
            asm volatile("" ::: "memory");
            if (j4 < 2) {
#pragma unroll
                for (int i = 0; i < 16; ++i) ks += acc[j4][i] * acc[j4][i]; } }
        hs += ks * rk * rk; hs += __shfl_xor(hs, 32); const float rs = rsqrtf(hs * (1.f / 96) + EPS);
        bf16* ko = F.kml() + ((size_t)(b * 4 + hk) * SQ + s) * 96 + 4 * hh;
#pragma unroll
        for (int j2 = 0; j2 < 2; ++j2) {
#pragma unroll
            for (int i = 0; i < 16; ++i) acc[j2][i] *= rs * rk * F.mla_gk()[L * 96 + 32 * j2 + crow16(i, hh)];
#pragma unroll
            for (int g = 0; g < 4; ++g) { u32x2 w; w.x = pk2(acc[j2][4 * g], acc[j2][4 * g + 1]); w.y = pk2(acc[j2][4 * g + 2], acc[j2][4 * g + 3]); *(u32x2*)(ko + 32 * j2 + 8 * g) = w; } }
#pragma unroll
        for (int i = 0; i < 16; ++i) kr[i] *= rs * F.mla_gk()[L * 96 + 64 + crow16(i, hh)];
#pragma unroll
        for (int i = 0; i < 8; ++i) { const float rc = lat ? F.rcos()[tt * 16 + crow16(i, hh)] : 1.f, rsn = F.rsin()[tt * 16 + crow16(i, hh)] * latf;
            const float x1 = kr[i], x2 = kr[i + 8]; kr[i] = x1 * rc - x2 * rsn; kr[i + 8] = x1 * rsn + x2 * rc; }
#pragma unroll
        for (int g = 0; g < 4; ++g) { u32x2 w; w.x = pk2(kr[4 * g], kr[4 * g + 1]); w.y = pk2(kr[4 * g + 2], kr[4 * g + 3]); *(u32x2*)(ko + 64 + 8 * g) = w; }
        { float n2 = 0.f;
#pragma unroll
          for (int i = 0; i < 16; ++i) n2 += acc[0][i] * acc[0][i] + acc[1][i] * acc[1][i] + kr[i] * kr[i];
          n2 += __shfl_xor(n2, 32); n2 = wmaxf(n2);
          if (lane == 0) atomicMax(F.ctl() + CW_KMAX + ((L * 3 + 1) * 8 + b) * 8 + hk * 2, __float_as_uint(n2 * 1.02f)); }
        LAS bf16* vl = (LAS bf16*)wl;
#pragma unroll
        for (int mt = 0; mt < 2; ++mt)
#pragma unroll
            for (int i = 0; i < 16; ++i) vl[(32 * mt + crow16(i, hh)) * 40 + vpos(r)] = f2bf(acc[2 + mt][i] * rk);
        LDS_WAIT();
        { const LAS u32x4* src4 = (const LAS u32x4*)(wl + lane * 80); u32x4* dst = (u32x4*)(F.vml() + ((size_t)(b * 4 + hk) * 64 + lane) * SQ + 32 * j32);
#pragma unroll
          for (int q = 0; q < 4; ++q) dst[q] = src4[q]; }
        LDS_WAIT();
    }
}
__device__ __forceinline__ void ssd_s1_job(const Fr& F, int L, int b, int c, int h, LAS float* scr);
__device__ __forceinline__ int grab_unit(const Fr& F, unsigned* ctr) {
    volatile LAS int* slot = (volatile LAS int*)(F.lds + LDSCTL_OFF + 256);
    __syncthreads();
    if (F.tid == 0) *slot = (int)__hip_atomic_fetch_add(ctr, 1u, __ATOMIC_RELAXED, __HIP_MEMORY_SCOPE_AGENT);
    __syncthreads();
    return __builtin_amdgcn_readfirstlane(*slot);
}
__device__ __forceinline__ void prep_qk(const Fr& F, int L, int b, int j32) {
    int lane_ = F.lane; asm volatile("" : "+v"(lane_)); const int l = lane_, h = l >> 4;
    u32x2 raw[4][4];
#pragma unroll
    for (int i = 0; i < 4; ++i) { const int s = 32 * j32 + 4 * F.wave + i; const bf16* p = F.pbuf() + (size_t)bs2row(b, s) * NP + 4 * l;
        raw[i][0] = *(const u32x2*)(p + C_NA); raw[i][1] = *(const u32x2*)(p + C_NA + 256); raw[i][2] = *(const u32x2*)(p + C_DF); raw[i][3] = *(const u32x2*)(p + C_DF + 256); }
    const f32x4 gnq = *(const f32x4*)(F.na_gq() + L * 64 + 4 * (l & 15)), gnk = *(const f32x4*)(F.na_gk() + L * 64 + 4 * (l & 15));
    const f32x4 gdq = *(const f32x4*)(F.df_gq() + L * 32 + 4 * (l & 7)), gdk = *(const f32x4*)(F.df_gk() + L * 32 + 4 * (l & 7));
    float kmx_na = 0.f, kmx_df = 0.f;
#pragma unroll
    for (int i = 0; i < 4; ++i) { const int s = 32 * j32 + 4 * F.wave + i, t = s - 256; const bool lat = s >= 256;
#pragma unroll
        for (int w = 0; w < 4; ++w) {
            f32x4 x; x[0] = __uint_as_float(raw[i][w].x << 16); x[1] = __uint_as_float(raw[i][w].x & 0xffff0000u); x[2] = __uint_as_float(raw[i][w].y << 16); x[3] = __uint_as_float(raw[i][w].y & 0xffff0000u);
            float ss = (x[0] * x[0] + x[1] * x[1]) + (x[2] * x[2] + x[3] * x[3]);
            ss += dppf<0xB1>(ss); ss += dppf<0x4E>(ss); ss += dppf<0x141>(ss);
            if (w < 2) { ss += dppf<0x140>(ss);
                const float rs = rsqrtf(ss * (1.f / 64) + EPS); const f32x4 g = w == 0 ? gnq : gnk; x = x * rs * g;
                u32x2 o; o.x = pk2(x[0], x[1]); o.y = pk2(x[2], x[3]);
                if (w == 1) { float n2 = (x[0] * x[0] + x[1] * x[1]) + (x[2] * x[2] + x[3] * x[3]); n2 += dppf<0xB1>(n2); n2 += dppf<0x4E>(n2); n2 += dppf<0x141>(n2); n2 += dppf<0x140>(n2); kmx_na = fmaxf(kmx_na, n2); }
                *(u32x2*)((w == 0 ? F.qna() : F.kna()) + ((size_t)(b * 4 + h) * SQ + s) * 64 + 4 * (l & 15)) = o;
            } else {
                const float rs = rsqrtf(ss * (1.f / 32) + EPS); const f32x4 g = w == 2 ? gdq : gdk; x = x * rs * g;
                f32x4 xp; xp[0] = __shfl_xor(x[0], 4); xp[1] = __shfl_xor(x[1], 4); xp[2] = __shfl_xor(x[2], 4); xp[3] = __shfl_xor(x[3], 4);
                if (lat) { const f32x4 cs = *(const f32x4*)(F.rcos() + t * 16 + 4 * (l & 3)), sn = *(const f32x4*)(F.rsin() + t * 16 + 4 * (l & 3));
                    x = (l & 4) ? xp * sn + x * cs : x * cs - xp * sn; }
                u32x2 o; o.x = pk2(x[0], x[1]); o.y = pk2(x[2], x[3]);
                if (w == 3) { float n2 = (x[0] * x[0] + x[1] * x[1]) + (x[2] * x[2] + x[3] * x[3]); n2 += dppf<0xB1>(n2); n2 += dppf<0x4E>(n2); n2 += dppf<0x141>(n2); kmx_df = fmaxf(kmx_df, n2); }
                *(u32x2*)((w == 2 ? F.qdf() : F.kdf()) + ((size_t)(b * 4 + h) * SQ + s) * 64 + 4 * (l & 15)) = o;
            } } }
    if ((l & 15) == 0) atomicMax(F.ctl() + CW_KMAX + ((L * 3 + 0) * 8 + b) * 8 + h * 2, __float_as_uint(kmx_na * 1.02f));
    if ((l & 7) == 0) atomicMax(F.ctl() + CW_KMAX + ((L * 3 + 2) * 8 + b) * 8 + h * 2 + ((l >> 3) & 1), __float_as_uint(kmx_df * 1.02f));
}
__device__ __forceinline__ void prep_vconv(const Fr& F, int L, int b, int j32) {
    int tid_ = F.tid; asm volatile("; VCONV_BEGIN" : "+v"(tid_)); const int tid = tid_;
    const int s0 = 32 * j32; const size_t r0 = bs2row(b, s0);
    LAS bf16* Lv = (LAS bf16*)F.lds;
#ifndef VC_MASK
#define VC_MASK 7
#endif
    if (VC_MASK & 1) {   u32x4 v[4];
#pragma unroll
        for (int k = 0; k < 4; ++k) { const int idx = tid + 512 * k, mx = idx >> 10, tok = (idx >> 5) & 31, d8 = (idx & 31) * 8;
            v[k] = *(const u32x4*)(F.pbuf() + (r0 + tok) * NP + (mx ? C_DF + 512 : C_NA + 512) + d8); }
#pragma unroll
        for (int k = 0; k < 4; ++k) { const int idx = tid + 512 * k, mx = idx >> 10, tok = (idx >> 5) & 31, d8 = (idx & 31) * 8, pc = vpos(tok);
#pragma unroll
            for (int e = 0; e < 4; ++e) { Lv[(mx * 256 + d8 + 2 * e) * 40 + pc] = (bf16)(v[k][e] & 0xffffu); Lv[(mx * 256 + d8 + 2 * e + 1) * 40 + pc] = (bf16)(v[k][e] >> 16); } }
        __syncthreads();
#pragma unroll
        for (int k = 0; k < 4; ++k) { const int idx = tid + 512 * k, mx = idx >> 10, dv = (idx >> 2) & 255, pc = idx & 3;
            const u32x4 w = *(const LAS u32x4*)(Lv + (mx * 256 + dv) * 40 + pc * 8);
            *(u32x4*)((mx ? F.vdf() : F.vna()) + ((size_t)(b * 4 + (dv >> 6)) * 64 + (dv & 63)) * SQ + s0 + pc * 8) = w; }
        __syncthreads();
    }
    const bool isctx = s0 < 256; const int len = isctx ? TCTX : TLAT, t0 = isctx ? s0 : s0 - 256;
    LAS bf16* Lc = (LAS bf16*)F.lds;
    if (VC_MASK & 2) {   u32x4 v[7];
#pragma unroll
        for (int k = 0; k < 7; ++k) { const int idx = tid + 512 * k, j = idx / 96, c8 = (idx - 96 * j) * 8, tj = t0 - 2 + j; const int jc = min(max(tj, 0), len - 1) - t0;
            v[k] = (u32x4){0u, 0u, 0u, 0u};
            if (idx < 36 * 96) { v[k] = *(const u32x4*)(F.pbuf() + (size_t)((long)r0 + jc) * NP + C_XBC + c8); if (tj < 0 || tj >= len) v[k] = (u32x4){0u, 0u, 0u, 0u}; } }
#pragma unroll
        for (int k = 0; k < 7; ++k) { const int idx = tid + 512 * k, j = idx / 96, c8 = (idx - 96 * j) * 8; if (idx < 36 * 96) *(LAS u32x4*)(Lc + j * 768 + c8) = v[k]; }
    }
    __syncthreads();
    if (VC_MASK & 2)
#pragma unroll 1
    for (int pass = 0; pass < 2; ++pass) {
        const int cg = pass == 0 ? tid : 512 + tid;
        if (cg < 768) {
            float w[5];
#pragma unroll
            for (int j = 0; j < 5; ++j) w[j] = F.conv_w()[(L * 5 + j) * 768 + cg];
            const float bias = F.conv_b()[L * 768 + cg];
            const LAS bf16* lp = Lc + cg;
            float x0 = bf2f(lp[0]), x1 = bf2f(lp[768]), x2 = bf2f(lp[2 * 768]), x3 = bf2f(lp[3 * 768]);
            const int gch = cg >> 8, ch = cg & 255;
            bf16* tm = (gch == 1 ? F.btm() : F.ctm()) + ((size_t)b * SQ + s0) * 256 + ch;
            bf16* cm = (gch == 0 ? F.xT() : F.bT()) + ((size_t)b * 256 + ch) * SQ + s0;
#pragma unroll
            for (int g8 = 0; g8 < 4; ++g8) { unsigned pk[4];
#pragma unroll
                for (int e = 0; e < 8; ++e) { const int i = 8 * g8 + e; const float x4 = bf2f(lp[(i + 4) * 768]);
                    const float acc = bias + w[0] * x0 + w[1] * x1 + w[2] * x2 + w[3] * x3 + w[4] * x4; const unsigned o = f2bf(siluf(acc));
                    if (gch >= 1) tm[(size_t)i * 256] = (bf16)o;
                    if (e & 1) pk[e >> 1] |= o << 16; else pk[e >> 1] = o;
                    x0 = x1; x1 = x2; x2 = x3; x3 = x4; }
                if (gch <= 1) { u32x4 v; v.x = pk[0]; v.y = pk[1]; v.z = pk[2]; v.w = pk[3]; *(u32x4*)(cm + 8 * g8) = v; } }
        }
    }
    if ((VC_MASK & 4) && tid < 256) { const int tok = tid >> 3, i = tid & 7; const float raw = bf2f(F.pbuf()[(r0 + tok) * NP + C_DT + i]) + F.dt_bias()[L * 8 + i]; const float ex = __expf(raw);
      F.dtv()[((size_t)b * 8 + i) * SQ + s0 + tok] = raw > 20.f ? raw : (ex < 0.03f ? ex * (1.f - ex * (0.5f - ex * (0.33333334f - 0.25f * ex))) : __logf(1.f + ex)); }
    __syncthreads();
    asm volatile("; VCONV_END" ::: "memory");
}
__device__ __forceinline__ void phase_prep(const Fr& F0_, int L) {
    unsigned* ctr = F0_.ctl() + CW_QUEUE + (L * 16 + 0) * 64;
    for (;;) {
        const int u = grab_unit(F0_, ctr); if (u >= NB * 72) break;
        const int b = u / 72, j32 = u - 72 * b;
        { const Fr F = refresh(F0_); prep_qk(F, L, b, j32); }
        { const Fr F = refresh(F0_); mla_prep_block(F, L, b, j32); }
        __syncthreads();
    }
    { unsigned* ctr2 = F0_.ctl() + CW_QUEUE + (L * 16 + 2) * 64;
      for (;;) { const int u = grab_unit(F0_, ctr2); if (u >= NB * 36) break; { const Fr F3 = refresh(F0_); prep_tile(F3, L, u / 36, u % 36); }
          asm volatile("s_waitcnt vmcnt(0)" ::: "memory"); __syncthreads();
          { const Fr F4 = refresh(F0_); if (F4.wave < 4) ssd_s1_job(F4, L, u / 36, u % 36, F4.wave, (LAS float*)(F4.lds + F4.wave * 16384)); } } }
}

__device__ __forceinline__ void phase_ssd_naive(const Fr& F, int L) {
    if (F.wave != 0 || blockIdx.x >= 64) return;
    const int w = blockIdx.x, b = w >> 3, d = (w >> 2) & 1, h = w & 3, g = h >> 1, p = F.lane;
    const float a = -expf(F.a_log()[L * 8 + d * 4 + h]);
    float hs[128];
#pragma unroll
    for (int n = 0; n < 128; ++n) hs[n] = 0.f;
    const float* dtp = F.dtv() + ((size_t)b * 8 + d * 4 + h) * SQ;
    const bf16* xp = F.xT() + ((size_t)b * 256 + h * 64 + p) * SQ;
    for (int step = 0; step < SQ; ++step) {
        const int s = d == 0 ? step : (step < 256 ? 255 - step : SQ - 1 - (step - 256));
        const float dtv = dtp[s], dA = __expf(dtv * a), xv = bf2f(xp[s]) * dtv;
        const u32x4* Bp = (const u32x4*)(F.btm() + ((size_t)b * SQ + s) * 256 + g * 128);
        const u32x4* Cp = (const u32x4*)(F.ctm() + ((size_t)b * SQ + s) * 256 + g * 128);
        float y = 0.f;
#pragma unroll
        for (int n8 = 0; n8 < 16; ++n8) { const u32x4 bv = Bp[n8], cv = Cp[n8];
#pragma unroll
            for (int j = 0; j < 4; ++j) { const int n = n8 * 8 + 2 * j;
                hs[n] = hs[n] * dA + xv * __uint_as_float(bv[j] << 16); hs[n + 1] = hs[n + 1] * dA + xv * __uint_as_float(bv[j] & 0xffff0000u);
                y += __uint_as_float(cv[j] << 16) * hs[n] + __uint_as_float(cv[j] & 0xffff0000u) * hs[n + 1]; } }
        F.ydir()[((size_t)d * NROW + bs2row(b, s)) * 256 + h * 64 + p] = y;
    }
}

template <int KIND>
__device__ __forceinline__ void naive_attn_job(const Fr& F, int L, int r, int h, LAS float* scr) {
    constexpr int DQ = KIND == 1 ? 96 : (KIND == 0 ? 64 : 32), QS = KIND == 1 ? 96 : 64;
    const int lane = F.lane; int b, s; row2bs(r, b, s); const bool lat = r < NLAT; const int t = s - 256;
    const bf16* Qb = (KIND == 0 ? F.qna() : KIND == 1 ? F.qml() : F.qdf()) + ((size_t)(b * 4 + h) * SQ + s) * QS;
    const bf16* Kb = (KIND == 0 ? F.kna() : KIND == 1 ? F.kml() : F.kdf()) + (size_t)(b * 4 + h) * SQ * QS;
    const bf16* Vt = (KIND == 0 ? F.vna() : KIND == 1 ? F.vml() : F.vdf()) + ((size_t)(b * 4 + h) * 64 + lane) * SQ;
    const float scale = KIND == 1 ? 0.10206207261596577f : (KIND == 0 ? 0.125f : 0.17677669529663687f);
    const int qr = t >> 6, qc = t & 63, row_lo = min(max(qr - 4, 0), 24), col_lo = min(max(qc - 8, 0), 48);
    const bool nb = (KIND == 0) && lat;
    const int nk = lat ? (KIND == 0 ? 768 : SQ) : 256;
    const int koff = nb ? row_lo * 64 : 0;
    float oc[2] = {0.f, 0.f};
#pragma unroll
    for (int comp = 0; comp < (KIND == 2 ? 2 : 1); ++comp) {
        for (int i = lane; i < DQ; i += 64) scr[i] = bf2f(Qb[comp * 32 + i]);
        LDS_WAIT();
        float m = -INFINITY;
        for (int kk = lane; kk < nk; kk += 64) {
            const int sk = kk < 256 ? kk : kk + koff; float bias = 0.f; bool valid = true;
            if (nb && kk >= 256) { const int w = kk - 256, kr = w >> 6, kc = w & 63; valid = kc >= col_lo && kc < col_lo + 16;
                const int ro = row_lo + kr - qr + 7, co = min(max(kc - qc, -15), 15) + 15; bias = F.na_rb()[((L * 4 + h) * 15 + ro) * 31 + co]; }
            const u32x4* kp = (const u32x4*)(Kb + (size_t)sk * QS + (KIND == 2 ? comp * 32 : 0));
            float dot = 0.f;
#pragma unroll
            for (int i8 = 0; i8 < DQ / 8; ++i8) { const u32x4 kv = kp[i8];
#pragma unroll
                for (int j = 0; j < 4; ++j) dot += scr[i8 * 8 + 2 * j] * __uint_as_float(kv[j] << 16) + scr[i8 * 8 + 2 * j + 1] * __uint_as_float(kv[j] & 0xffff0000u); }
            const float sc = valid ? dot * scale + bias : -INFINITY;
            scr[128 + kk] = sc; m = fmaxf(m, sc);
        }
        m = wmaxf(m);
        float sum = 0.f;
        for (int kk = lane; kk < nk; kk += 64) { const float pv = __expf(scr[128 + kk] - m); scr[128 + kk] = pv; sum += pv; }
        sum = wsum(sum);
        LDS_WAIT();
        float o = 0.f;
        for (int kb = 0; kb < nk; kb += 8) {
            const int sb = kb < 256 ? kb : kb + koff;
            const u32x4 vv = *(const u32x4*)(Vt + sb);
#pragma unroll
            for (int j = 0; j < 8; ++j) { const int kk = (kb & ~15) + vpos((kb & 15) + j); const unsigned wv = vv[j >> 1];
                o += scr[128 + kk] * ((j & 1) ? __uint_as_float(wv & 0xffff0000u) : __uint_as_float(wv << 16)); }
        }
        oc[comp] = o / sum;
        LDS_WAIT();
    }
    bf16* mo = F.mix() + (size_t)r * DM + (KIND == 0 ? 0 : KIND == 1 ? 256 : 512) + h * 64 + lane;
    if (KIND == 2) {
        const float* lv = F.df_lam() + L * 128; const float li = 0.8f - 0.6f * expf(-0.3f * (float)L);
        float d1 = 0.f, d2 = 0.f;
#pragma unroll
        for (int i = 0; i < 32; ++i) { d1 += lv[i] * lv[32 + i]; d2 += lv[64 + i] * lv[96 + i]; }
        const float lam = expf(d1) - expf(d2) + li;
        const float o = oc[0] - lam * oc[1];
        const float rs = rsqrtf(wsum(o * o) * (1.f / 64) + EPS);
        *mo = f2bf(o * rs * F.df_gsub()[L * 64 + lane] * (1.f - li));
    } else *mo = f2bf(oc[0]);
}
__device__ __forceinline__ void phase_mix_naive(const Fr& F, int L) {
    LAS float* scr = (LAS float*)(F.lds + F.wave * 16384);
    const int nrows = (L == DEPTH - 1) ? NLAT : NROW;
    for (int j = F.gw; j < nrows * 4; j += F.NGW) naive_attn_job<2>(F, L, j >> 2, j & 3, scr);
    for (int j = F.gw; j < nrows * 4; j += F.NGW) naive_attn_job<1>(F, L, j >> 2, j & 3, scr);
    for (int j = F.gw; j < nrows * 4; j += F.NGW) naive_attn_job<0>(F, L, j >> 2, j & 3, scr);
    for (int r = F.gw; r < nrows; r += F.NGW) {
        int b, s; row2bs(r, b, s); const int h = F.lane >> 4; const float dsk = F.ssd_d()[L * 8 + h] + F.ssd_d()[L * 8 + 4 + h];
        float y[4]; float ss = 0.f;
#pragma unroll
        for (int j = 0; j < 4; ++j) { const int ch = F.lane * 4 + j; const float xv = bf2f(F.xT()[((size_t)b * 256 + ch) * SQ + s]);
            const float z = bf2f(F.pbuf()[(size_t)r * NP + C_Z + ch]);
            y[j] = (F.ydir()[(size_t)r * 256 + ch] + F.ydir()[((size_t)NROW + r) * 256 + ch] + dsk * xv) * siluf(z); ss += y[j] * y[j]; }
        const float rs = rsqrtf(wsum(ss) * (1.f / 256) + EPS);
#pragma unroll
        for (int j = 0; j < 4; ++j) { const int ch = F.lane * 4 + j; F.mix()[(size_t)r * DM + 768 + ch] = f2bf(y[j] * rs * F.ssd_gn()[L * 256 + ch]); }
    }
}

template <int S8> __device__ __forceinline__ bf16x8 pack_step(const f32x16& x) {
    u32x4 p;
    asm volatile("v_cvt_pk_bf16_f32 %0, %4, %5\n\tv_cvt_pk_bf16_f32 %1, %6, %7\n\tv_cvt_pk_bf16_f32 %2, %8, %9\n\tv_cvt_pk_bf16_f32 %3, %10, %11\n\ts_nop 1"
                 : "=&v"(p[0]), "=&v"(p[1]), "=&v"(p[2]), "=&v"(p[3])
                 : "v"(x[S8]), "v"(x[S8 + 1]), "v"(x[S8 + 2]), "v"(x[S8 + 3]), "v"(x[S8 + 4]), "v"(x[S8 + 5]), "v"(x[S8 + 6]), "v"(x[S8 + 7]));
    return __builtin_bit_cast(bf16x8, p);
}
constexpr float LOG2E = 1.4426950408889634f;
template <int KIND>
__device__ __forceinline__ void attn_unit(const Fr& F, int L, int b, int h, int qb) {
    constexpr int QS = KIND == 1 ? 96 : 64, NKS = KIND == 1 ? 6 : (KIND == 0 ? 4 : 2);
    constexpr int PK = QS * 2 + 16, PV = 272, KBYTES = 128 * PK, VBYTES = 64 * PV, NKP = QS == 96 ? 3 : 2, PPR = QS / 8;
    LAS unsigned char* const Kl = F.lds; LAS unsigned char* const Vl = F.lds + 2 * KBYTES;
    LAS float* const biasl = (LAS float*)(F.lds + 2 * KBYTES + 2 * VBYTES);
    const int lane = F.lane, wave = F.wave, tid = F.tid, r = lane & 31, hh = lane >> 5;
    const bool isctx = qb < 0;
    const int comp = KIND == 2 ? (wave & 1) : 0, qg = KIND == 2 ? (wave >> 1) : wave;
    const bf16* Qg = (KIND == 0 ? F.qna() : KIND == 1 ? F.qml() : F.qdf()) + (size_t)(b * 4 + h) * SQ * QS;
    const bf16* Kg = (KIND == 0 ? F.kna() : KIND == 1 ? F.kml() : F.kdf()) + (size_t)(b * 4 + h) * SQ * QS;
    const bf16* Vg = (KIND == 0 ? F.vna() : KIND == 1 ? F.vml() : F.vdf()) + (size_t)(b * 4 + h) * 64 * SQ;
    const float cs = (KIND == 1 ? 0.10206207261596577f : (KIND == 0 ? 0.125f : 0.17677669529663687f)) * LOG2E;
    int sq, qrow = 0, qcol = 0;
    if (KIND == 2) sq = (isctx ? 128 * (-qb - 1) : 256 + 128 * qb) + 32 * qg + r;
    else if (isctx) sq = 32 * wave + r; else if (KIND == 0) { qrow = 4 * qb + (wave >> 1); qcol = 32 * (wave & 1) + r; sq = 256 + 64 * qrow + qcol; } else sq = 256 + 256 * qb + 32 * wave + r;
    int nt = 36, lo_u = 0;
    if (isctx) nt = 4; else if (KIND == 0) { lo_u = min(max(4 * qb - 4, 0), 24); nt = 4 + min(max(4 * qb - 1, 0), 24) + 8 - lo_u; }
    const int np = (nt + 1) >> 1;
    const int my_lo = min(max(qrow - 4, 0), 24), col_lo = min(max(qcol - 8, 0), 48);
    if (KIND == 0 && !isctx) for (int i = tid; i < 465; i += 512) biasl[i] = F.na_rb()[(L * 4 + h) * 465 + i] * LOG2E;
    bf16x8 Q[NKS];
    { const bf16* qp = Qg + (size_t)sq * QS + comp * 32 + 8 * hh;
#pragma unroll
      for (int kk = 0; kk < NKS; ++kk) Q[kk] = *(const bf16x8*)(qp + 16 * kk); }
    f32x16 O[2]; float l = 0.f;
#pragma unroll
    for (int mt = 0; mt < 2; ++mt)
#pragma unroll
        for (int i = 0; i < 16; ++i) O[mt][i] = 0.f;
    float m;
    {   float q2 = 0.f;
#pragma unroll
        for (int kk = 0; kk < NKS; ++kk)
#pragma unroll
            for (int j = 0; j < 8; ++j) { const float v = bf2f((bf16)Q[kk][j]); q2 += v * v; }
        q2 += __shfl_xor(q2, 32);
        const float k2 = __uint_as_float(__hip_atomic_load(F.ctl() + CW_KMAX + ((L * 3 + KIND) * 8 + b) * 8 + h * 2 + comp, __ATOMIC_RELAXED, __HIP_MEMORY_SCOPE_AGENT));
        m = sqrtf(q2 * k2) * cs;
        if (KIND == 0 && !isctx) m += (F.rcos() + 2 * TLAT * 16)[L * 4 + h];
    }
    u32x4 rk_0[NKP], rv_0[2];
#define AT_SK0(t) ((isctx || KIND != 0) ? 64 * (t) : ((t) < 4 ? 64 * (t) : 256 + 64 * (lo_u + (t) - 4)))
#define AT_LOAD(p, S_) do { const int sk0_ = AT_SK0(2 * (p)); const char* kg_ = (const char*)(Kg + (size_t)sk0_ * QS); \
        _Pragma("unroll") for (int i_ = 0; i_ < NKP; ++i_) rk_##S_[i_] = *(const u32x4*)(kg_ + (tid + 512 * i_) * 16); \
        _Pragma("unroll") for (int i_ = 0; i_ < 2; ++i_) { const int pi_ = tid + 512 * i_; rv_##S_[i_] = *(const u32x4*)(Vg + (size_t)(pi_ >> 4) * SQ + sk0_ + (pi_ & 15) * 8); } } while (0)
#define AT_STORE(buf, S_) do { \
        _Pragma("unroll") for (int i_ = 0; i_ < NKP; ++i_) { const int pi_ = tid + 512 * i_; *(LAS u32x4*)(Kl + (buf) * KBYTES + (pi_ / PPR) * PK + (pi_ % PPR) * 16) = rk_##S_[i_]; } \
        _Pragma("unroll") for (int i_ = 0; i_ < 2; ++i_) { const int pi_ = tid + 512 * i_; *(LAS u32x4*)(Vl + (buf) * VBYTES + (pi_ >> 4) * PV + (pi_ & 15) * 16) = rv_##S_[i_]; } } while (0)
#define AT_QK(SA, SB, kb_) do { \
        _Pragma("unroll") for (int i = 0; i < 16; ++i) { SA[i] = 0.f; SB[i] = 0.f; } \
        _Pragma("unroll") for (int kk = 0; kk < NKS; ++kk) { const bf16x8 a0 = *(const LAS bf16x8*)((kb_) + 32 * kk), a1 = *(const LAS bf16x8*)((kb_) + 32 * PK + 32 * kk); \
            SA = MFMA32(a0, Q[kk], SA); SB = MFMA32(a1, Q[kk], SB); } } while (0)
#define AT_SMPV(S0, S1, t_, vb_) do { \
        const int krow = lo_u + (t_) - 4; const bool nbt = (KIND == 0) && !isctx && (t_) >= 4; \
        float ps = 0.f; \
        if (nbt) { const int drow = (krow - qrow + 7) * 31 - qcol + 15; const float nm = -m; \
            _Pragma("unroll") for (int i = 0; i < 16; ++i) { const int kc = (i & 3) + 8 * (i >> 2) + 4 * hh; \
                { const bool v = (unsigned)(kc - col_lo) < 16u; const float bb = biasl[v ? drow + kc : 0]; S0[i] = v ? __builtin_amdgcn_exp2f(__builtin_fmaf(S0[i], cs, bb + nm)) : 0.f; } \
                { const bool v = (unsigned)(kc + 32 - col_lo) < 16u; const float bb = biasl[v ? drow + kc + 32 : 0]; S1[i] = v ? __builtin_amdgcn_exp2f(__builtin_fmaf(S1[i], cs, bb + nm)) : 0.f; } \
                ps += S0[i] + S1[i]; } \
        } else { const float nm = -m; \
            _Pragma("unroll") for (int i = 0; i < 16; ++i) { S0[i] = __builtin_amdgcn_exp2f(__builtin_fmaf(S0[i], cs, nm)); S1[i] = __builtin_amdgcn_exp2f(__builtin_fmaf(S1[i], cs, nm)); } \
            const f32x16 T_ = S0 + S1; \
            ps = (((T_[0] + T_[1]) + (T_[2] + T_[3])) + ((T_[4] + T_[5]) + (T_[6] + T_[7]))) + (((T_[8] + T_[9]) + (T_[10] + T_[11])) + ((T_[12] + T_[13]) + (T_[14] + T_[15]))); } \
        l += ps; \
        const bf16x8 p00 = pack_step<0>(S0), p01 = pack_step<8>(S0), p10 = pack_step<0>(S1), p11 = pack_step<8>(S1); \
        _Pragma("unroll") for (int mt = 0; mt < 2; ++mt) { \
            const LAS unsigned char* vb = (vb_) + mt * 32 * PV; \
            O[mt] = MFMA32(*(const LAS bf16x8*)(vb + 0), p00, O[mt]); O[mt] = MFMA32(*(const LAS bf16x8*)(vb + 32), p01, O[mt]); \
            O[mt] = MFMA32(*(const LAS bf16x8*)(vb + 64), p10, O[mt]); O[mt] = MFMA32(*(const LAS bf16x8*)(vb + 96), p11, O[mt]); } } while (0)
#define AT_COMPUTE(p_, buf_) do { \
        const int t0_ = 2 * (p_), t1_ = t0_ + 1; \
        const bool g0_ = (KIND != 0) || isctx || t0_ < 4 || (lo_u + t0_ - 4 >= my_lo && lo_u + t0_ - 4 < my_lo + 8); \
        const bool g1_ = (t1_ < nt) && ((KIND != 0) || isctx || t1_ < 4 || (lo_u + t1_ - 4 >= my_lo && lo_u + t1_ - 4 < my_lo + 8)); \
        const LAS unsigned char* Kb = Kl + (buf_) * KBYTES + r * PK + (comp * 32 + 8 * hh) * 2; const LAS unsigned char* Vb = Vl + (buf_) * VBYTES + r * PV + 16 * hh; \
        if (KIND == 0) { f32x16 S00, S01; \
            if (g0_) { AT_QK(S00, S01, Kb); AT_SMPV(S00, S01, t0_, Vb); } \
            if (g1_) { AT_QK(S00, S01, Kb + 64 * PK); AT_SMPV(S00, S01, t1_, Vb + 128); } \
        } else { f32x16 S00, S01, S10, S11; \
            __builtin_amdgcn_iglp_opt(0); \
            AT_QK(S00, S01, Kb); \
            AT_QK(S10, S11, Kb + 64 * PK); \
            AT_SMPV(S00, S01, t0_, Vb); \
            AT_SMPV(S10, S11, t1_, Vb + 128); } } while (0)
    AT_LOAD(0, 0);
    AT_STORE(0, 0);
    __syncthreads();
    for (int p = 0; p < np; ++p) {
        const int buf = p & 1;
        if (p + 1 < np) AT_LOAD(p + 1, 0);
        AT_COMPUTE(p, buf);
        if (p + 1 < np) AT_STORE(buf ^ 1, 0);
        __syncthreads();
    }
#undef AT_COMPUTE
#undef AT_SMPV
#undef AT_QK
#undef AT_SK0
#undef AT_LOAD
#undef AT_STORE
    const float inv = 1.f / (l + __shfl_xor(l, 32));
    bf16* mo = F.mix() + (size_t)bs2row(b, sq) * DM + (KIND == 0 ? 0 : KIND == 1 ? 256 : 512) + h * 64 + 4 * hh;
    if (KIND == 2) {
        LAS float* xo = (LAS float*)F.lds + qg * 2048;
        if (comp == 1) {
#pragma unroll
            for (int mt = 0; mt < 2; ++mt)
#pragma unroll
                for (int i = 0; i < 16; ++i) xo[(mt * 16 + i) * 64 + lane] = O[mt][i] * inv; }
        __syncthreads();
        if (comp == 0) {
            const float* lv = F.df_lam() + L * 128; const float li = 0.8f - 0.6f * expf(-0.3f * (float)L);
            float d1 = 0.f, d2 = 0.f;
#pragma unroll
            for (int i = 0; i < 32; ++i) { d1 += lv[i] * lv[32 + i]; d2 += lv[64 + i] * lv[96 + i]; }
            const float lam = expf(d1) - expf(d2) + li;
            float ss = 0.f;
#pragma unroll
            for (int mt = 0; mt < 2; ++mt)
#pragma unroll
                for (int i = 0; i < 16; ++i) { const float o = O[mt][i] * inv - lam * xo[(mt * 16 + i) * 64 + lane]; O[mt][i] = o; ss += o * o; }
            ss += __shfl_xor(ss, 32);
            const float rs = rsqrtf(ss * (1.f / 64) + EPS) * (1.f - li);
#pragma unroll
            for (int mt = 0; mt < 2; ++mt)
#pragma unroll
                for (int g = 0; g < 4; ++g) { const f32x4 gs = *(const f32x4*)(F.df_gsub() + L * 64 + 32 * mt + 8 * g + 4 * hh);
                    u32x2 w; w.x = pk2(O[mt][4 * g] * rs * gs[0], O[mt][4 * g + 1] * rs * gs[1]); w.y = pk2(O[mt][4 * g + 2] * rs * gs[2], O[mt][4 * g + 3] * rs * gs[3]);
                    *(u32x2*)(mo + 32 * mt + 8 * g) = w; }
        }
        __syncthreads();
    } else {
#pragma unroll
        for (int mt = 0; mt < 2; ++mt)
#pragma unroll
            for (int g = 0; g < 4; ++g) { u32x2 w; w.x = pk2(O[mt][4 * g] * inv, O[mt][4 * g + 1] * inv); w.y = pk2(O[mt][4 * g + 2] * inv, O[mt][4 * g + 3] * inv);
                *(u32x2*)(mo + 32 * mt + 8 * g) = w; }
    }
}
__device__ __forceinline__ float ssd_cum(const Fr& F, int L, int b, int h, int d, int s0, float& dt, float& cum) {
    const int lane = F.lane;
    dt = F.dtv()[((size_t)b * 8 + d * 4 + h) * SQ + s0 + lane];
    const float la = dt * -__expf(F.a_log()[L * 8 + d * 4 + h]);
    float v = la;
#pragma unroll
    for (int o = 1; o < 64; o <<= 1) { const float t = __shfl_up(v, o); if (lane >= o) v += t; }
    const float total = __shfl(v, 63);
    cum = d == 0 ? v : total - v + la;
    return total;
}
__device__ __forceinline__ void ssd_s1_job(const Fr& F, int L, int b, int c, int h, LAS float* scr) {
    const int lane = F.lane, r = lane & 31, hh = lane >> 5, s0 = 64 * c, g = h >> 1;
#pragma unroll
    for (int d = 0; d < 2; ++d) { float dt, cum; const float tot = ssd_cum(F, L, b, h, d, s0, dt, cum); scr[d * 64 + lane] = dt * __expf(tot - cum);
        if (lane == 0) F.cdec()[((b * 2 + d) * 4 + h) * 36 + c] = __expf(tot); }
    LDS_WAIT();
    bf16x8 A[2][2][4];
#pragma unroll
    for (int mt = 0; mt < 2; ++mt)
#pragma unroll
        for (int kk = 0; kk < 4; ++kk) { const bf16x8 raw = *(const bf16x8*)(F.xT() + ((size_t)b * 256 + h * 64 + 32 * mt + r) * SQ + s0 + 16 * kk + 8 * hh);
#pragma unroll
            for (int d = 0; d < 2; ++d) { u32x4 o;
#pragma unroll
                for (int j = 0; j < 4; ++j) { const float w0 = scr[d * 64 + 16 * kk + 8 * hh + 2 * j], w1 = scr[d * 64 + 16 * kk + 8 * hh + 2 * j + 1];
                    o[j] = pk2(bf2f((bf16)raw[2 * j]) * w0, bf2f((bf16)raw[2 * j + 1]) * w1); }
                A[d][mt][kk] = __builtin_bit_cast(bf16x8, o); } }
#pragma unroll
    for (int nt = 0; nt < 4; ++nt) {
        bf16x8 Bf[4];
#pragma unroll
        for (int kk = 0; kk < 4; ++kk) Bf[kk] = *(const bf16x8*)(F.bT() + ((size_t)b * 256 + g * 128 + 32 * nt + r) * SQ + s0 + 16 * kk + 8 * hh);
#pragma unroll
        for (int d = 0; d < 2; ++d)
#pragma unroll
            for (int mt = 0; mt < 2; ++mt) { f32x16 acc;
#pragma unroll
                for (int i = 0; i < 16; ++i) acc[i] = 0.f;
#pragma unroll
                for (int kk = 0; kk < 4; ++kk) acc = MFMA32(A[d][mt][kk], Bf[kk], acc);
                float* dst = F.cst() + ((((size_t)(b * 2 + d) * 4 + h) * 36 + c) * 64 + 32 * mt) * 128 + 32 * nt + r;
#pragma unroll
                for (int i = 0; i < 16; ++i) dst[crow16(i, hh) * 128] = acc[i]; }
    }
    LDS_WAIT();
}
__device__ __forceinline__ void phase_ssd_s1(const Fr& F, int L) {
    LAS float* scr = (LAS float*)(F.lds + F.wave * 16384);
    for (int j = F.gw; j < NB * 36 * 4; j += F.NGW) ssd_s1_job(F, L, j / 144, (j / 4) % 36, j & 3, scr);
}
__device__ __forceinline__ void phase_ssd_scan(const Fr& F, int L) {
    for (int e4 = blockIdx.x * 512 + F.tid; e4 < NB * 2 * 4 * 2048; e4 += F.G * 512) {
        const int bdh = e4 >> 11, pn = (e4 & 2047) * 4, d = (bdh >> 2) & 1;
        f32x4 hst = (f32x4){0.f, 0.f, 0.f, 0.f};
        const float* cs_ = F.cst() + (size_t)bdh * 36 * 8192 + pn; bf16* he_ = F.hent() + (size_t)bdh * 36 * 8192 + pn; const float* cd_ = F.cdec() + bdh * 36;
#pragma unroll 1
        for (int s6 = 0; s6 < 36; s6 += 6) {
            f32x4 v[6]; float dc[6]; int cc[6];
#pragma unroll
            for (int j = 0; j < 6; ++j) { const int step = s6 + j; cc[j] = d == 0 ? step : (step < 4 ? 3 - step : 39 - step); v[j] = *(const f32x4*)(cs_ + (size_t)cc[j] * 8192); dc[j] = cd_[cc[j]]; }
#pragma unroll
            for (int j = 0; j < 6; ++j) { u32x2 o; o.x = pk2(hst[0], hst[1]); o.y = pk2(hst[2], hst[3]); *(u32x2*)(he_ + (size_t)cc[j] * 8192) = o; hst = hst * dc[j] + v[j]; }
        }
    }
}
__device__ __forceinline__ void ssd_s3_unit(const Fr& F, int L, int b, int c) {
    const int lane = F.lane, wave = F.wave, r = lane & 31, hh = lane >> 5, s0 = 64 * c, h = wave >> 1, it = wave & 1, g = h >> 1, itok = 32 * it + r;
    LAS float* scr = (LAS float*)(F.lds + wave * 16384);
    LAS float* red = (LAS float*)(F.lds + 8192);
#pragma unroll
    for (int d = 0; d < 2; ++d) { float dt, cum; (void)ssd_cum(F, L, b, h, d, s0, dt, cum); scr[d * 128 + lane] = cum; scr[d * 128 + 64 + lane] = dt; }
    LDS_WAIT();
    bf16x8 Cf[8];
#pragma unroll
    for (int kk = 0; kk < 8; ++kk) Cf[kk] = *(const bf16x8*)(F.ctm() + ((size_t)b * SQ + s0 + itok) * 256 + g * 128 + 16 * kk + 8 * hh);
    f32x16 G[2];
#pragma unroll
    for (int jt = 0; jt < 2; ++jt) {
#pragma unroll
        for (int i = 0; i < 16; ++i) G[jt][i] = 0.f;
#pragma unroll
        for (int kk = 0; kk < 8; ++kk) { const bf16x8 bf = *(const bf16x8*)(F.btm() + ((size_t)b * SQ + s0 + 32 * jt + r) * 256 + g * 128 + 16 * kk + 8 * hh); G[jt] = MFMA32(bf, Cf[kk], G[jt]); } }
    bf16x8 X[2][4];
#pragma unroll
    for (int mt = 0; mt < 2; ++mt)
#pragma unroll
        for (int ks = 0; ks < 4; ++ks) { const bf16* xp = F.xT() + ((size_t)b * 256 + h * 64 + 32 * mt + r) * SQ + s0 + 16 * ks + 4 * hh;
            const u32x2 lo = *(const u32x2*)xp, hi = *(const u32x2*)(xp + 8); u32x4 o; o.x = lo.x; o.y = lo.y; o.z = hi.x; o.w = hi.y; X[mt][ks] = __builtin_bit_cast(bf16x8, o); }
    f32x16 Y[2];
#pragma unroll
    for (int mt = 0; mt < 2; ++mt)
#pragma unroll
        for (int i = 0; i < 16; ++i) Y[mt][i] = 0.f;
    const float Dsum = F.ssd_d()[L * 8 + h] + F.ssd_d()[L * 8 + 4 + h];
#pragma unroll 1
    for (int d = 0; d < 2; ++d) {
        const float cum_i = scr[d * 128 + itok];
        f32x16 Pm[2];
#pragma unroll
        for (int jt = 0; jt < 2; ++jt)
#pragma unroll
            for (int i = 0; i < 16; ++i) { const int j = 32 * jt + crow16(i, hh); const bool valid = d == 0 ? (j <= itok) : (j >= itok);
                const float arg = valid ? cum_i - scr[d * 128 + j] : -INFINITY;
                float pv = G[jt][i] * __expf(arg) * scr[d * 128 + 64 + j];
                if (d == 0 && j == itok) pv += Dsum;
                Pm[jt][i] = pv; }
        const bf16x8 p0 = pack_step<0>(Pm[0]), p1 = pack_step<8>(Pm[0]), p2 = pack_step<0>(Pm[1]), p3 = pack_step<8>(Pm[1]);
#pragma unroll
        for (int mt = 0; mt < 2; ++mt) { Y[mt] = MFMA32(X[mt][0], p0, Y[mt]); Y[mt] = MFMA32(X[mt][1], p1, Y[mt]); Y[mt] = MFMA32(X[mt][2], p2, Y[mt]); Y[mt] = MFMA32(X[mt][3], p3, Y[mt]); }
        const float ei = __expf(cum_i);
#pragma unroll
        for (int mt = 0; mt < 2; ++mt) { f32x16 T;
#pragma unroll
            for (int i = 0; i < 16; ++i) T[i] = 0.f;
#pragma unroll
            for (int kk = 0; kk < 8; ++kk) { const bf16x8 hf = *(const bf16x8*)(F.hent() + ((((size_t)(b * 2 + d) * 4 + h) * 36 + c) * 64 + 32 * mt + r) * 128 + 16 * kk + 8 * hh); T = MFMA32(hf, Cf[kk], T); }
#pragma unroll
            for (int i = 0; i < 16; ++i) Y[mt][i] += ei * T[i]; }
    }
    const size_t row = bs2row(b, s0 + itok);
    const bf16* zp = F.pbuf() + row * NP + C_Z + h * 64 + 4 * hh;
    float ss = 0.f;
#pragma unroll
    for (int mt = 0; mt < 2; ++mt)
#pragma unroll
        for (int gq = 0; gq < 4; ++gq) { const u32x2 z4 = *(const u32x2*)(zp + 32 * mt + 8 * gq);
            const float z0 = __uint_as_float(z4.x << 16), z1 = __uint_as_float(z4.x & 0xffff0000u), z2 = __uint_as_float(z4.y << 16), z3 = __uint_as_float(z4.y & 0xffff0000u);
            Y[mt][4 * gq] *= siluf(z0); Y[mt][4 * gq + 1] *= siluf(z1); Y[mt][4 * gq + 2] *= siluf(z2); Y[mt][4 * gq + 3] *= siluf(z3);
            ss += (Y[mt][4 * gq] * Y[mt][4 * gq] + Y[mt][4 * gq + 1] * Y[mt][4 * gq + 1]) + (Y[mt][4 * gq + 2] * Y[mt][4 * gq + 2] + Y[mt][4 * gq + 3] * Y[mt][4 * gq + 3]); }
    ss += __shfl_xor(ss, 32);
    if (hh == 0) red[(it * 4 + h) * 32 + r] = ss;
    __syncthreads();
    const float tot = (red[(it * 4 + 0) * 32 + r] + red[(it * 4 + 1) * 32 + r]) + (red[(it * 4 + 2) * 32 + r] + red[(it * 4 + 3) * 32 + r]);
    const float rs = rsqrtf(tot * (1.f / 256) + EPS);
    bf16* mo = F.mix() + row * DM + 768 + h * 64 + 4 * hh;
#pragma unroll
    for (int mt = 0; mt < 2; ++mt)
#pragma unroll
        for (int gq = 0; gq < 4; ++gq) { const f32x4 gn = *(const f32x4*)(F.ssd_gn() + L * 256 + h * 64 + 32 * mt + 8 * gq + 4 * hh);
            u32x2 w; w.x = pk2(Y[mt][4 * gq] * rs * gn[0], Y[mt][4 * gq + 1] * rs * gn[1]); w.y = pk2(Y[mt][4 * gq + 2] * rs * gn[2], Y[mt][4 * gq + 3] * rs * gn[3]);
            *(u32x2*)(mo + 32 * mt + 8 * gq) = w; }
    __syncthreads();
}
template <int KIND> __device__ __forceinline__ void attn_units(const Fr& F, int L) {
    if (KIND == 2) { const int nu = (L == DEPTH - 1) ? 512 : 576;
        for (int u = F.vcu; u < nu; u += F.G) { if (u < 512) attn_unit<2>(F, L, u >> 6, (u >> 4) & 3, u & 15); else attn_unit<2>(F, L, (u - 512) >> 3, ((u - 512) >> 1) & 3, -1 - (u & 1)); }
    } else { const int nu = (L == DEPTH - 1) ? 256 : 288;
        for (int u = F.vcu; u < nu; u += F.G) { if (u < 256) attn_unit<KIND>(F, L, u >> 5, (u >> 3) & 3, u & 7); else attn_unit<KIND>(F, L, (u - 256) >> 2, (u - 256) & 3, -1); } }
}
__device__ __forceinline__ void phase_mix_fast(const Fr& F, int L) {
#ifndef ATT_MASK
#define ATT_MASK 15
#endif
#ifndef ATT_DUP
#define ATT_DUP 0
#endif
#ifndef ATT_MASK
#define ATT_MASK 15
#endif
    if (ATT_MASK & 4) for (int rp = 0; rp < ((ATT_DUP & 4) ? 2 : 1); ++rp) { const Fr Fa = refresh(F); attn_units<2>(Fa, L); }
    if (ATT_MASK & 2) for (int rp = 0; rp < ((ATT_DUP & 2) ? 2 : 1); ++rp) { const Fr Fa = refresh(F); attn_units<1>(Fa, L); }
    if (ATT_MASK & 1) for (int rp = 0; rp < ((ATT_DUP & 1) ? 2 : 1); ++rp) { const Fr Fa = refresh(F); attn_units<0>(Fa, L); }
    const int c0 = (L == DEPTH - 1) ? 4 : 0;
    if (ATT_MASK & 8) { const Fr Fa = refresh(F); unsigned* ctr = Fa.ctl() + CW_QUEUE + (L * 16 + 1) * 64;
        for (;;) { const int u = grab_unit(Fa, ctr); if (u >= NB * (36 - c0)) break; ssd_s3_unit(Fa, L, u / (36 - c0), c0 + u % (36 - c0)); } }
}

__device__ __forceinline__ void phase_route(const Fr& F, int L, bool commit = true) {
    const int nrows = (L == DEPTH - 1) ? NLAT : NROW;
    LAS float* wl = (LAS float*)F.lds;
    {   const f32x4* wg4 = (const f32x4*)(F.w_grp() + (size_t)L * DM * 4); const f32x4* we4 = (const f32x4*)(F.w_exp() + (size_t)L * DM * 16);
        f32x4 tg[2], te[8];
#pragma unroll
        for (int n = 0; n < 2; ++n) tg[n] = wg4[F.tid + 512 * n];
#pragma unroll
        for (int n = 0; n < 8; ++n) te[n] = we4[F.tid + 512 * n];
#pragma unroll
        for (int n = 0; n < 2; ++n) { const int k = F.tid + 512 * n;
#pragma unroll
            for (int o = 0; o < 4; ++o) wl[o * DM + k] = tg[n][o]; }
#pragma unroll
        for (int n = 0; n < 8; ++n) { const int i = F.tid + 512 * n, k = i >> 2, q = i & 3;
#pragma unroll
            for (int o = 0; o < 4; ++o) wl[(4 + 4 * q + o) * DM + k] = te[n][o]; }
    }
    __syncthreads();
    float keep[20];
#pragma unroll
    for (int o = 0; o < 20; ++o) keep[o] = 0.f;
    f32x4 v[4], vn[4];
    { const int r = F.gw; if (r < nrows) { const float* hp = r < NLAT ? F.out() + (size_t)r * DM : F.hc() + (size_t)(r - NLAT) * DM;
#pragma unroll
        for (int j = 0; j < 4; ++j) vn[j] = *(const f32x4*)(hp + 4 * F.lane + 256 * j); } }
    int it = 0;
    for (int r = F.gw; r < nrows; r += F.NGW, ++it) {
        const bool lat = r < NLAT; const int bb = lat ? (r >> 11) : 8;
#pragma unroll
        for (int j = 0; j < 4; ++j) v[j] = vn[j];
        { const int rn = r + F.NGW; if (rn < nrows) { const float* hp = rn < NLAT ? F.out() + (size_t)rn * DM : F.hc() + (size_t)(rn - NLAT) * DM;
#pragma unroll
            for (int j = 0; j < 4; ++j) vn[j] = *(const f32x4*)(hp + 4 * F.lane + 256 * j); } }
        float ss = 0.f;
#pragma unroll
        for (int j = 0; j < 4; ++j) ss += (v[j][0] * v[j][0] + v[j][1] * v[j][1]) + (v[j][2] * v[j][2] + v[j][3] * v[j][3]);
        const float rstd = rsqrtf(wsum(ss) * (1.f / DM) + EPS);
        const float* md = F.modv() + ((size_t)L * 9 + bb) * 6144;
        float lg[20];
#pragma unroll
        for (int o = 0; o < 20; ++o) lg[o] = 0.f;
#pragma unroll
        for (int j = 0; j < 4; ++j) { const int c = 4 * F.lane + 256 * j; const f32x4 g = *(const f32x4*)(F.g_ffn() + L * DM + c), sh = *(const f32x4*)(md + 3 * 1024 + c), scl = *(const f32x4*)(md + 4 * 1024 + c);
            const f32x4 f = v[j] * rstd * g * (scl + 1.f) + sh; u32x2 o2; o2.x = pk2(f[0], f[1]); o2.y = pk2(f[2], f[3]); *(u32x2*)(F.abuf() + (size_t)r * DM + c) = o2;
#pragma unroll
            for (int o = 0; o < 20; ++o) { const f32x4 w = *(const LAS f32x4*)(wl + o * DM + c); lg[o] += (f[0] * w[0] + f[1] * w[1]) + (f[2] * w[2] + f[3] * w[3]); }
            asm volatile("" ::: "memory"); }
#pragma unroll
        for (int o = 0; o < 20; ++o) { const float t = wsum(lg[o]); keep[o] = (F.lane == it) ? t : keep[o]; }
    }
    if (F.lane < it) {
        const int r = F.gw + F.lane * F.NGW;
        float gl[4]; float gm = -INFINITY; int gt = 0;
#pragma unroll
        for (int o = 0; o < 4; ++o) { gl[o] = keep[o] + F.b_grp()[L * 4 + o]; if (gl[o] > gm) { gm = gl[o]; gt = o; } }
        float gs = 0.f;
#pragma unroll
        for (int o = 0; o < 4; ++o) gs += expf(gl[o] - gm);
        const float gp = 1.f / gs;
        float el[4];
#pragma unroll
        for (int o = 0; o < 4; ++o) { float v4 = 0.f;
#pragma unroll
            for (int q = 0; q < 4; ++q) v4 = (gt == q) ? keep[4 + 4 * q + o] + F.b_exp()[L * 16 + 4 * q + o] : v4;
            el[o] = v4; }
        int i0 = 0; float m0 = el[0];
#pragma unroll
        for (int o = 1; o < 4; ++o) if (el[o] > m0) { m0 = el[o]; i0 = o; }
        int i1 = i0 == 0 ? 1 : 0; float m1 = i0 == 0 ? el[1] : el[0];
#pragma unroll
        for (int o = 1; o < 4; ++o) if (o != i0 && el[o] > m1) { m1 = el[o]; i1 = o; }
        const float e1 = expf(m1 - m0), w0 = gp / (1.f + e1), w1 = gp * e1 / (1.f + e1);
        const int x0 = gt * 4 + i0, x1 = gt * 4 + i1;
        if (commit) {
            F.rtw()[2 * r] = w0; F.rtw()[2 * r + 1] = w1;
            const unsigned p0 = atomicAdd(F.ctl() + CW_ECNT + (L * 16 + x0) * 64, 1u), p1 = atomicAdd(F.ctl() + CW_ECNT + (L * 16 + x1) * 64, 1u);
            F.elist()[x0 * NROW + p0] = 2 * r; F.elist()[x1 * NROW + p1] = 2 * r + 1; }
        else if (w0 + w1 < -1.f) F.rtw()[0] = 0.f;
    }
    __syncthreads();
}
__device__ __forceinline__ void moe_table(const Fr& F, int L) {
    volatile LAS int* T = (volatile LAS int*)(F.lds + LDSCTL_OFF + 64);
    volatile LAS int* Cn = (volatile LAS int*)(F.lds + LDSCTL_OFF + 160);
    __syncthreads();
    if (F.tid == 0) { int acc = 0;
        for (int e = 0; e < 16; ++e) { int c = (int)__hip_atomic_load(F.ctl() + CW_ECNT + (L * 16 + e) * 64, __ATOMIC_RELAXED, __HIP_MEMORY_SCOPE_AGENT); c = min(max(c, 0), NROW); T[e] = acc; Cn[e] = c; acc += (c + 255) >> 8; }
        T[16] = acc; }
    __syncthreads();
}

__global__ void __launch_bounds__(512, 2) fwd_kernel(Args args) {
    extern __shared__ __attribute__((aligned(16))) unsigned char lds_raw[];
    Fr F0;
    F0.lds = (LAS unsigned char*)lds_raw; F0.tid = threadIdx.x; F0.lane = F0.tid & 63; F0.wave = __builtin_amdgcn_readfirstlane(F0.tid >> 6);
    F0.G = gridDim.x; { const int bx = blockIdx.x; F0.vcu = (F0.G % 8 == 0) ? (bx % 8) * (F0.G / 8) + bx / 8 : bx; }
    F0.gw = F0.vcu * 8 + F0.wave; F0.NGW = F0.G * 8;
    F0.A = (const __attribute__((address_space(4))) Args*)__builtin_amdgcn_kernarg_segment_ptr();
    for (int u = F0.tid; u < (LDS_BYTES - LDSCTL_OFF) / 4; u += 512) ((LAS unsigned*)(F0.lds + LDSCTL_OFF))[u] = 0u;
    __syncthreads();
    const int lo = args.ph_lo, hi = args.ph_hi;
    XcdBarrier bar; bar.bar = F0.ctl() + CW_BAR; bar.x = 0; bar.st = nullptr;
    if (hi - lo > 1) bar = xcd_barrier_post(F0.ctl() + CW_BAR, (volatile LAS unsigned*)(F0.lds + LDSCTL_OFF));
#ifndef PH_MASK
#define PH_MASK 0xFFFF
#endif
#define PM(b) ((PH_MASK >> (b)) & 1)
#ifndef DUP_MASK
#define DUP_MASK 0
#endif
#ifndef DBL_SEAM
#define DBL_SEAM 0
#endif
#define NREP(b) (((DUP_MASK >> (b)) & 1) ? 2 : 1)
#define IN(k) (lo <= (k) && (k) < hi)
#define SEAM(k) do { if (IN(k) && IN((k) + 1)) { const Fr Fb = refresh(F0); XcdBarrier b2 = bar; b2.bar = Fb.ctl() + CW_BAR; xcd_barrier(b2); if ((DUP_MASK & 0x10000) || ((DBL_SEAM >> (((k) + NPH_L - 1) % NPH_L)) & 1)) xcd_barrier(b2); } } while (0)

    if (PM(0) && IN(0)) { for (int rep_ = 0; rep_ < NREP(0); ++rep_) { if (rep_) __syncthreads(); const Fr F = refresh(F0); phase_prologue(F); } }
    SEAM(0);
    for (int L = 0; L < DEPTH; ++L) {
        const int pb = 1 + NPH_L * L;
        const bool lastL = (L == DEPTH - 1);
        if (PM(1) && IN(pb + 0)) { const Fr F = refresh(F0); phase_norm(F, L); if (DUP_MASK & 2048) { __syncthreads(); phase_norm(F, L, false); } if (L == 0) for (int rp = 0; rp < NREP(10); ++rp) moe_weight_convert(F, 0); }
        SEAM(pb + 0);
        if (PM(2) && IN(pb + 1)) { for (int rep_ = 0; rep_ < NREP(2); ++rep_) { if (rep_) __syncthreads(); const Fr F = refresh(F0); pg8::DenseSched S; S.init(F.abuf(), F.winT() + (size_t)L * NP * DM, DM, NROW, NP, F.G, (int)blockIdx.x); pg8::EpiP E{F.pbuf()}; pg8::gemm_phase(F.lds, F.tid, DM, S, E); } }
        SEAM(pb + 1);
        if (PM(3) && IN(pb + 2)) { for (int rep_ = 0; rep_ < NREP(3); ++rep_) { if (rep_) __syncthreads(); const Fr F = refresh(F0); phase_prep(F, L); } }
        SEAM(pb + 2);
        if (PM(4) && IN(pb + 4)) { for (int rep_ = 0; rep_ < NREP(6); ++rep_) { if (rep_) __syncthreads(); const Fr F = refresh(F0); phase_ssd_scan(F, L); } }
        SEAM(pb + 4);
        if (PM(5) && IN(pb + 5)) { for (int rep_ = 0; rep_ < NREP(5); ++rep_) { if (rep_) __syncthreads(); const Fr F = refresh(F0); phase_mix_fast(F, L); } }
        SEAM(pb + 5);
        if (PM(6) && IN(pb + 6)) { const Fr F = refresh(F0); pg8::DenseSched S; S.init(F.mix(), F.woutT() + (size_t)L * DM * DM, DM, lastL ? NLAT : NROW, DM, F.G, (int)blockIdx.x);
            pg8::EpiRes E{L == 0 ? F.x() : F.out(), L == 0 ? F.ctx() : F.hc(), F.out(), F.hc(), F.modv() + (size_t)L * 9 * 6144 + 2 * 1024, 1.f}; pg8::gemm_phase(F.lds, F.tid, DM, S, E);
            if (!lastL && blockIdx.x >= 32) { __syncthreads(); moe_weight_convert(F, L + 1, ((int)blockIdx.x - 32) * 8 + F.wave, (F.G - 32) * 8); __syncthreads(); }
            if (DUP_MASK & 8192) { __syncthreads(); pg8::EpiRes E2{F.out(), F.hc(), F.out(), F.hc(), F.modv() + (size_t)L * 9 * 6144 + 2 * 1024, 0.f}; pg8::gemm_phase(F.lds, F.tid, DM, S, E2); } }
        SEAM(pb + 6);
        if (PM(7) && IN(pb + 7)) { const Fr F = refresh(F0); phase_route(F, L); if (DUP_MASK & 4096) phase_route(F, L, false); }
        SEAM(pb + 7);
        if (PM(8) && IN(pb + 8)) { for (int rep_ = 0; rep_ < NREP(8); ++rep_) { if (rep_) __syncthreads(); const Fr F = refresh(F0); moe_table(F, L);
            pg8::MoeSched<true> S{(const char*)F.abuf(), (const char*)F.wgu(L & 1), (size_t)1024 * DM * 2, DM, F.G, F.vcu, F.elist(), (const volatile LAS int*)(F.lds + LDSCTL_OFF + 64), (const volatile LAS int*)(F.lds + LDSCTL_OFF + 160)};
            pg8::EpiAct E{F.act()}; pg8::gemm_phase(F.lds, F.tid, DM, S, E); } }
        SEAM(pb + 8);
        if (PM(9) && IN(pb + 9)) { for (int rep_ = 0; rep_ < NREP(9); ++rep_) { if (rep_) __syncthreads(); const Fr F = refresh(F0); moe_table(F, L);
            pg8::MoeSched<false> S{(const char*)F.act(), (const char*)F.wd(L & 1), (size_t)1024 * FF * 2, FF, F.G, F.vcu, F.elist(), (const volatile LAS int*)(F.lds + LDSCTL_OFF + 64), (const volatile LAS int*)(F.lds + LDSCTL_OFF + 160)};
            pg8::EpiDown E{F.yk(), F.elist(), F.rtw()}; pg8::gemm_phase(F.lds, F.tid, FF, S, E); } }
        SEAM(pb + 9);
    }
    if (PM(1) && IN(PH_FINAL)) { const Fr F = refresh(F0); phase_norm(F, DEPTH); }
#undef IN
#undef SEAM
}

extern "C" void kernel_launch(void* const* d_in, const int* in_sizes, int n_in, void* d_out, int out_size, void* d_ws, size_t ws_size, hipStream_t stream) {
    static int grid = 0;
    if (grid == 0) {
        if (n_in != 36 || out_size != NLAT * DM || ws_size < WS_END) { fprintf(stderr, "kernel_launch: unexpected shapes (n_in %d out %d ws %zu)\n", n_in, out_size, ws_size); grid = -1; return; }
        int dev = 0, cus = 0, per_cu = 0;
        if (hipGetDevice(&dev) != hipSuccess || hipDeviceGetAttribute(&cus, hipDeviceAttributeMultiprocessorCount, dev) != hipSuccess) { grid = -1; return; }
        if (hipFuncSetAttribute((const void*)fwd_kernel, hipFuncAttributeMaxDynamicSharedMemorySize, LDS_BYTES) != hipSuccess) { fprintf(stderr, "kernel_launch: hipFuncSetAttribute failed\n"); grid = -1; return; }
        if (hipOccupancyMaxActiveBlocksPerMultiprocessor(&per_cu, (const void*)fwd_kernel, 512, LDS_BYTES) != hipSuccess || per_cu < 1) { fprintf(stderr, "kernel_launch: occupancy query says %d\n", per_cu); }
        (void)hipGetLastError();
        grid = cus;
    }
    if (grid < 0) return;
    (void)hipMemsetAsync((char*)d_ws + WS_CTL, 0, CTL_BYTES, stream);
    Args a{};
    for (int i = 0; i < 36; ++i) a.in[i] = (const float*)d_in[i];
    a.out = (float*)d_out; a.ws = (unsigned char*)d_ws;
#if MK_ONE_LAUNCH
    a.ph_lo = 0; a.ph_hi = NPHASE;
    hipLaunchKernelGGL(fwd_kernel, dim3(grid), dim3(512), LDS_BYTES, stream, a);
#else
    for (int ph = 0; ph < NPHASE; ++ph) { a.ph_lo = ph; a.ph_hi = ph + 1; hipLaunchKernelGGL(fwd_kernel, dim3(grid), dim3(512), LDS_BYTES, stream, a); }
#endif
}
```

```cpp
#include <hip/hip_runtime.h>
#include <cstdio>
#include <cstdint>

#ifndef MK_ONE_LAUNCH
#define MK_ONE_LAUNCH 1
#endif

#define LAS __attribute__((address_space(3)))
typedef unsigned short bf16;
typedef short bf16x8 __attribute__((ext_vector_type(8)));
typedef float f32x4 __attribute__((ext_vector_type(4)));
typedef float f32x2 __attribute__((ext_vector_type(2)));
typedef unsigned u32x4 __attribute__((ext_vector_type(4)));
typedef unsigned u32x2 __attribute__((ext_vector_type(2)));

constexpr int NB = 8, TLAT = 2048, TCTX = 256, SQ = 2304, DM = 1024, DEPTH = 4;
constexpr int NLAT = NB * TLAT, NCTXR = NB * TCTX, NROW = NLAT + NCTXR;
constexpr int NIN = 2984, NP = 3072;
constexpr int C_NA = 0, C_MLA = 768, C_DF = 1184, C_SSD = 1952;
constexpr int C_Z = C_SSD, C_XBC = C_SSD + 256, C_DT = C_SSD + 1024;
constexpr float EPS = 1e-6f;
constexpr int NEXP = 16, FF = 512, ACT_ROWS = 40960;
constexpr int NPH_L = 10, PH_FINAL = 1 + NPH_L * DEPTH, NPHASE = PH_FINAL + 1;

constexpr size_t MiB = 1u << 20;
constexpr size_t WS_CTL = 0, CTL_BYTES = 1 * MiB;
constexpr size_t WS_MOD = 1 * MiB;
constexpr size_t WS_ROPE = 2 * MiB;
constexpr size_t WS_WIN = 4 * MiB;
constexpr size_t WS_WOUT = 28 * MiB;
constexpr size_t WS_WQB = 36 * MiB;
constexpr size_t WS_WKVB = 37 * MiB;
constexpr size_t WS_WGU = 38 * MiB;
constexpr size_t WS_WD = 70 * MiB;
constexpr size_t WS_HC = 86 * MiB;
constexpr size_t WS_A = 94 * MiB;
constexpr size_t WS_P = 130 * MiB;
constexpr size_t WS_ACT = 130 * MiB;
constexpr size_t WS_YK = 170 * MiB;
constexpr size_t WS_MIX = 238 * MiB;
constexpr size_t WS_QNA = 274 * MiB, WS_KNA = 283 * MiB, WS_VNA = 292 * MiB;
constexpr size_t WS_QML = 301 * MiB, WS_KML = 315 * MiB, WS_VML = 329 * MiB;
constexpr size_t WS_QDF = 338 * MiB, WS_KDF = 347 * MiB, WS_VDF = 356 * MiB;
constexpr size_t WS_XT = 365 * MiB, WS_BTM = 374 * MiB, WS_BT = 383 * MiB, WS_CTM = 392 * MiB;
constexpr size_t WS_DT = 401 * MiB;
constexpr size_t WS_CST = 402 * MiB;
constexpr size_t WS_CDEC = 474 * MiB;
constexpr size_t WS_HENT = 475 * MiB;
constexpr size_t WS_RT = 511 * MiB;
constexpr size_t WS_ELIST = 512 * MiB;
constexpr size_t WS_WGU2 = 514 * MiB;
constexpr size_t WS_WD2 = 546 * MiB;
constexpr size_t WS_END = 562 * MiB;
constexpr int CW_BAR = 4096;
constexpr int CW_ECNT = 16384;
constexpr int CW_KMAX = 65536;
constexpr int CW_QUEUE = 32768;

constexpr int RING_BYTES = 131072, LDSCTL_OFF = RING_BYTES, LDS_BYTES = 147456;

typedef float f32x16 __attribute__((ext_vector_type(16)));
#define MFMA32(a, b, c) __builtin_amdgcn_mfma_f32_32x32x16_bf16((a), (b), (c), 0, 0, 0)
__device__ __forceinline__ int crow16(int reg, int hh) { return (reg & 3) + 8 * (reg >> 2) + 4 * hh; }
__device__ __forceinline__ float bf2f(bf16 v) { return __uint_as_float(((unsigned)v) << 16); }
__device__ __forceinline__ bf16 f2bf(float f) { unsigned u = __float_as_uint(f); return (bf16)((u + 0x7fffu + ((u >> 16) & 1u)) >> 16); }
__device__ __forceinline__ unsigned pk2(float lo, float hi) { return (unsigned)f2bf(lo) | ((unsigned)f2bf(hi) << 16); }
template <int CTRL> __device__ __forceinline__ float dppf(float v) { return __int_as_float(__builtin_amdgcn_update_dpp(0, __float_as_int(v), CTRL, 0xF, 0xF, true)); }
__device__ __forceinline__ float rlane(float v, int l) { return __int_as_float(__builtin_amdgcn_readlane(__float_as_int(v), l)); }
__device__ __forceinline__ float wsum(float v) {
    v += dppf<0xB1>(v); v += dppf<0x4E>(v); v += dppf<0x141>(v); v += dppf<0x140>(v);
    return (rlane(v, 0) + rlane(v, 16)) + (rlane(v, 32) + rlane(v, 48)); }
__device__ __forceinline__ float wmaxf(float v) {
    v = fmaxf(v, dppf<0xB1>(v)); v = fmaxf(v, dppf<0x4E>(v)); v = fmaxf(v, dppf<0x141>(v)); v = fmaxf(v, dppf<0x140>(v));
    return fmaxf(fmaxf(rlane(v, 0), rlane(v, 16)), fmaxf(rlane(v, 32), rlane(v, 48))); }
#define LDS_WAIT() asm volatile("s_waitcnt lgkmcnt(0)" ::: "memory")
__device__ __forceinline__ void row2bs(int r, int& b, int& s) { if (r < NLAT) { b = r >> 11; s = 256 + (r & 2047); } else { const int j = r - NLAT; b = j >> 8; s = j & 255; } }
__device__ __forceinline__ int bs2row(int b, int s) { return s < 256 ? NLAT + b * 256 + s : b * 2048 + s - 256; }
__device__ __forceinline__ int vpos(int s) { return (s & ~12) | ((s & 4) << 1) | ((s & 8) >> 1); }
__device__ __forceinline__ float siluf(float x) { return x / (1.f + __expf(-x)); }

#define XB_TMO      128
#define XB_XCNT(j)  (256  + 64 * (j))
#define XB_XSUB(j)  (1280 + 64 * (j))
#define XB_XGEN(j)  (2304 + 64 * (j))
#define XB_TOP      3328
#define XB_TOPGEN   3392
#define XCD_BAR_WORDS 3456
#define XB_SPIN_CAP (1u << 24)
__device__ __forceinline__ unsigned xb_ld(unsigned* p)              { return __hip_atomic_load(p, __ATOMIC_RELAXED, __HIP_MEMORY_SCOPE_AGENT); }
__device__ __forceinline__ unsigned xb_add(unsigned* p, unsigned v) { return __hip_atomic_fetch_add(p, v, __ATOMIC_RELAXED, __HIP_MEMORY_SCOPE_AGENT); }
__device__ __forceinline__ unsigned xb_xcc_id() { return (unsigned)__builtin_amdgcn_s_getreg((3 << 11) | 20) & 0xFu; }
#define XB_SPIN(cond, bar) do { unsigned _sp = 0; while (cond) { __builtin_amdgcn_s_sleep(1); \
    if ((++_sp & 255u) == 0u) { if (xb_ld(&(bar)[XB_TMO])) break; if (_sp > XB_SPIN_CAP) { atomicAdd(&(bar)[XB_TMO], 1u); break; } } } } while (0)
struct XcdBarrier { unsigned* bar; unsigned x; volatile LAS unsigned* st; };
__device__ __forceinline__ XcdBarrier xcd_barrier_post(unsigned* bar, volatile LAS unsigned* st) {
    XcdBarrier b; b.bar = bar; b.x = xb_xcc_id(); b.st = st;
    if (threadIdx.x == 0) (void)xb_add(&bar[XB_XCNT(b.x)], 1u);
    return b;
}
__device__ __forceinline__ void xcd_barrier_complete(unsigned* bar, unsigned x, unsigned& nloc, unsigned& nx) {
    const unsigned G = gridDim.x * gridDim.y * gridDim.z;
    unsigned sum, cnt, mine, sp = 0u;
    for (;;) {
        sum = 0u; cnt = 0u; mine = 0u;
#pragma unroll
        for (unsigned j = 0; j < 16; ++j) { const unsigned c = xb_ld(&bar[XB_XCNT(j)]); sum += c; cnt += (c > 0u) ? 1u : 0u; mine = (j == x) ? c : mine; }
        if (sum == G) break;
        __builtin_amdgcn_s_sleep(1);
        if ((++sp & 255u) == 0u) { if (xb_ld(&bar[XB_TMO])) break; if (sp > XB_SPIN_CAP) { atomicAdd(&bar[XB_TMO], 1u); break; } }
    }
    nloc = mine > 0u ? mine : 1u; nx = cnt > 0u ? cnt : 1u;
}
__device__ __forceinline__ void xcd_barrier(const XcdBarrier& b) {
    asm volatile("s_waitcnt vmcnt(0)" ::: "memory");
    __syncthreads();
    if (threadIdx.x == 0) {
        unsigned* bar = b.bar;
        __builtin_amdgcn_s_waitcnt(0);
        unsigned nloc = b.st[0], nx = b.st[1];
        if (nloc == 0u) { xcd_barrier_complete(bar, b.x, nloc, nx); b.st[0] = nloc; b.st[1] = nx; }
        const unsigned old = xb_add(&bar[XB_XSUB(b.x)], 1u);
        const unsigned gen = old / nloc;
        if (old + 1u == (gen + 1u) * nloc) {
            __builtin_amdgcn_fence(__ATOMIC_RELEASE, "agent");
            asm volatile("s_waitcnt vmcnt(0)" ::: "memory");
            const unsigned og = xb_add(&bar[XB_TOP], 1u);
            const unsigned tg = og / nx;
            if (og + 1u == (tg + 1u) * nx) xb_add(&bar[XB_TOPGEN], 1u);
            else XB_SPIN(xb_ld(&bar[XB_TOPGEN]) == tg, bar);
            __builtin_amdgcn_fence(__ATOMIC_ACQUIRE, "agent");
            xb_add(&bar[XB_XGEN(b.x)], 1u);
            asm volatile("s_waitcnt vmcnt(0)" ::: "memory");
        } else {
            XB_SPIN(xb_ld(&bar[XB_XGEN(b.x)]) == gen, bar);
            __builtin_amdgcn_fence(__ATOMIC_ACQUIRE, "agent");
            asm volatile("s_waitcnt vmcnt(0)" ::: "memory");
        }
    }
    __syncthreads();
}

namespace pg8 {
constexpr int BM = 256, BK = 64, HALF = 128, HTB = HALF * BK * 2, NXCD = 8, WGM = 8;
__device__ __forceinline__ int lds_byte(int r, int c) { const int st = (r >> 4) * 2 + (c >> 5), rr = r & 15, cc = c & 31, ob = rr * 64 + cc * 2; return st * 1024 + (ob ^ (((ob >> 9) & 1) << 5)); }
__device__ __forceinline__ void stage_rc(int b, int& R, int& C) { const int st = b / 1024, sb = b % 1024, swz = sb ^ (((sb >> 9) & 1) << 5); R = (st >> 1) * 16 + swz / 64; C = (st & 1) * 32 + (swz % 64) / 2; }
__device__ __forceinline__ int perm32(int rho) { const int n = rho >> 4, i = rho & 15; return 8 * (i >> 2) + 4 * n + (i & 3); }
struct Unit { int pm, pn, e, j, cnt; };

template <class Epi, class Sched>
__device__ __forceinline__ void gemm_phase(LAS unsigned char* lds, const int tid, const int K, const Sched& S, const Epi& E) {
    const int wid = __builtin_amdgcn_readfirstlane(tid >> 6), lane = tid & 63, wr = wid >> 2, wc = wid & 3, fr = lane & 15, fq = lane >> 4;
    const int nt = K / BK;
    int Rr[2]; unsigned Cb[2], voffB[2];
#pragma unroll
    for (int i = 0; i < 2; ++i) { int R, C; stage_rc(tid * 16 + i * 8192, R, C); const int Rb = Epi::PERM ? ((R & ~31) + perm32(R & 31)) : R;
        Rr[i] = R; Cb[i] = (unsigned)C * 2u; voffB[i] = (unsigned)(Rb * K + C) * 2u; }
    const size_t kstep = (size_t)(BK * 2);
    const size_t hstep = (size_t)HALF * K * 2;
    const unsigned ldsw = (unsigned)wid * 1024u;
    const int aoff = lds_byte(wr * 64 + fr, fq * 8), boff = lds_byte(wc * 32 + fr, fq * 8);
#define PG8_SA(b, h) (((b) * 2 + (h)) * HTB)
#define PG8_SB(b, h) ((4 + (b) * 2 + (h)) * HTB)
#define PG8_STAGE(bufoff, gbase, voff) do { _Pragma("unroll") for (int _i = 0; _i < 2; ++_i) \
        __builtin_amdgcn_global_load_lds((const unsigned*)((const char*)(gbase) + (voff)[_i]), (LAS unsigned*)(lds + (bufoff) + ldsw + _i * 8192), 16, 0, 0); } while (0)
#define PG8_LDA(dst, b, h) do { _Pragma("unroll") for (int m = 0; m < 4; ++m) _Pragma("unroll") for (int k = 0; k < 2; ++k) dst[m][k] = *(const LAS bf16x8*)(lds + PG8_SA(b, h) + aoff + m * 2048 + k * 1024); } while (0)
#define PG8_LDB(dst, b, h) do { _Pragma("unroll") for (int n = 0; n < 2; ++n) _Pragma("unroll") for (int k = 0; k < 2; ++k) dst[n][k] = *(const LAS bf16x8*)(lds + PG8_SB(b, h) + boff + n * 2048 + k * 1024); } while (0)
#define PG8_MMA(ai, bj, At, Bt) do { __builtin_amdgcn_s_setprio(1); _Pragma("unroll") for (int m = 0; m < 4; ++m) _Pragma("unroll") for (int n = 0; n < 2; ++n) _Pragma("unroll") for (int k = 0; k < 2; ++k) \
        acc[ai][bj][m][n] = __builtin_amdgcn_mfma_f32_16x16x32_bf16(Bt[n][k], At[m][k], acc[ai][bj][m][n], 0, 0, 0); __builtin_amdgcn_s_setprio(0); } while (0)
#define PG8_WAIT_V(n) asm volatile("s_waitcnt vmcnt(" #n ")" ::: "memory")
#define PG8_WAIT_L(n) asm volatile("s_waitcnt lgkmcnt(" #n ")" ::: "memory")
#define PG8_BAR __builtin_amdgcn_s_barrier()
#define PG8_SCHED __builtin_amdgcn_sched_barrier(0)
    Unit cur, nxt; int ui = 0;
    if (!S.next(0, cur)) return;
    f32x4 acc[2][2][4][2];
#pragma unroll
    for (int a = 0; a < 2; ++a)
#pragma unroll
        for (int b = 0; b < 2; ++b)
#pragma unroll
            for (int m = 0; m < 4; ++m)
#pragma unroll
                for (int n = 0; n < 2; ++n) acc[a][b][m][n] = (f32x4){0.f, 0.f, 0.f, 0.f};
    bf16x8 At[4][2], B0[2][2], B1[2][2];
    unsigned vA0[2], vA1[2];
    const char* cA = S.a_ptr(cur);
    if constexpr (Sched::GATHER) { S.a_offs(cur, Rr, vA0, vA1);
#pragma unroll
        for (int i = 0; i < 2; ++i) { vA0[i] += Cb[i]; vA1[i] += Cb[i]; }
        asm volatile("s_waitcnt vmcnt(0)" ::: "memory");
    } else {
#pragma unroll
        for (int i = 0; i < 2; ++i) { vA0[i] = (unsigned)(Rr[i] * K * 2) + Cb[i]; vA1[i] = vA0[i]; } }
    const size_t ahs = Sched::GATHER ? (size_t)0 : hstep;
    const char* cB = S.b_ptr(cur);
    PG8_STAGE(PG8_SB(0, 0), cB, voffB); PG8_STAGE(PG8_SB(0, 1), cB + hstep, voffB); PG8_STAGE(PG8_SA(0, 0), cA, vA0); PG8_STAGE(PG8_SA(0, 1), cA + ahs, vA1);
    if (wr == 1) PG8_BAR;
    PG8_WAIT_V(2); PG8_BAR;
    PG8_STAGE(PG8_SB(1, 0), cB + kstep, voffB); PG8_STAGE(PG8_SA(1, 0), cA + kstep, vA0); PG8_STAGE(PG8_SB(1, 1), cB + hstep + kstep, voffB);
    PG8_WAIT_V(6); PG8_BAR;
    for (;;) {
        const bool has_next = S.next(ui + 1, nxt);
        const char* nA = has_next ? S.a_ptr(nxt) : cA; const char* nB = has_next ? S.b_ptr(nxt) : cB;
        for (int t = 0; t < nt; t += 2) {
            const bool last = (t == nt - 2);
            const char* a1 = cA + (size_t)(t + 1) * kstep;
            const char* a2 = last ? nA : cA + (size_t)(t + 2) * kstep; const char* b2 = last ? nB : cB + (size_t)(t + 2) * kstep;
            const char* a3 = a2 + kstep; const char* b3 = b2 + kstep;
            PG8_LDB(B0, 0, 0); PG8_LDB(B1, 0, 1); PG8_SCHED; PG8_LDA(At, 0, 0); PG8_STAGE(PG8_SA(1, 1), a1 + ahs, vA1);
            if constexpr (Sched::GATHER) { if (last && has_next) { S.a_offs(nxt, Rr, vA0, vA1);
#pragma unroll
                for (int i = 0; i < 2; ++i) { vA0[i] += Cb[i]; vA1[i] += Cb[i]; }
                asm volatile("s_waitcnt vmcnt(0)" ::: "memory"); } }
            PG8_WAIT_V(8); PG8_WAIT_L(0); PG8_BAR; PG8_MMA(0, 0, At, B0); PG8_MMA(0, 1, At, B1); PG8_BAR; PG8_SCHED;
            PG8_LDA(At, 0, 1); PG8_STAGE(PG8_SB(0, 0), b2, voffB); PG8_STAGE(PG8_SB(0, 1), b2 + hstep, voffB); PG8_STAGE(PG8_SA(0, 0), a2, vA0);
            PG8_WAIT_V(8); PG8_WAIT_L(0); PG8_BAR; PG8_MMA(1, 0, At, B0); PG8_MMA(1, 1, At, B1); PG8_BAR; PG8_SCHED;
            PG8_LDB(B0, 1, 0); PG8_LDB(B1, 1, 1); PG8_SCHED; PG8_LDA(At, 1, 0); PG8_STAGE(PG8_SA(0, 1), a2 + ahs, vA1);
            PG8_WAIT_V(8); PG8_WAIT_L(0); PG8_BAR; PG8_MMA(0, 0, At, B0); PG8_MMA(0, 1, At, B1); PG8_BAR; PG8_SCHED;
            PG8_LDA(At, 1, 1); PG8_STAGE(PG8_SB(1, 0), b3, voffB); PG8_STAGE(PG8_SB(1, 1), b3 + hstep, voffB); PG8_STAGE(PG8_SA(1, 0), a3, vA0);
            PG8_WAIT_V(8); PG8_WAIT_L(0); PG8_BAR; PG8_MMA(1, 0, At, B0); PG8_MMA(1, 1, At, B1); PG8_BAR; PG8_SCHED;
        }
        if (wr == 0) PG8_BAR;
        E(acc, cur, wr, wc, fr, fq);
        if (!has_next) break;
#pragma unroll
        for (int a = 0; a < 2; ++a)
#pragma unroll
            for (int b = 0; b < 2; ++b)
#pragma unroll
                for (int m = 0; m < 4; ++m)
#pragma unroll
                    for (int n = 0; n < 2; ++n) acc[a][b][m][n] = (f32x4){0.f, 0.f, 0.f, 0.f};
        cur = nxt; cA = nA; cB = nB; ++ui;
        if (wr == 1) PG8_BAR;
    }
    PG8_WAIT_V(0);
    PG8_BAR;
#undef PG8_SA
#undef PG8_SB
#undef PG8_STAGE
#undef PG8_LDA
#undef PG8_LDB
#undef PG8_MMA
#undef PG8_WAIT_V
#undef PG8_WAIT_L
#undef PG8_BAR
#undef PG8_SCHED
}
__device__ __forceinline__ unsigned cvt_pk_bf16(float lo, float hi) { unsigned r; asm volatile("v_cvt_pk_bf16_f32 %0, %1, %2" : "=v"(r) : "v"(lo), "v"(hi)); return r; }

struct DenseSched {
    const char* A; const char* Bt; int K, nM, nN, nwg, G, c;
    __device__ void init(const void* A_, const void* Bt_, int K_, int M, int N, int G_, int c_) { A = (const char*)A_; Bt = (const char*)Bt_; K = K_; nM = M / BM; nN = N / BM; nwg = nM * nN; G = G_; c = c_; }
    __device__ __forceinline__ bool next(int i, Unit& u) const {
        const long L = (long)i * G + c; if (L >= nwg) return false;
        int wgid = (int)L; { const int q = nwg / NXCD, r = nwg % NXCD, xcd = wgid % NXCD, off = wgid / NXCD; wgid = (xcd < r ? xcd * (q + 1) : r * (q + 1) + (xcd - r) * q) + off; }
        const int nig = WGM * nN, gid = wgid / nig, fm = gid * WGM, gsz = (nM - fm) < WGM ? (nM - fm) : WGM;
        u.pm = fm + ((wgid % nig) % gsz); u.pn = (wgid % nig) / gsz; u.e = 0; u.j = 0; u.cnt = 256; return true;
    }
    static constexpr bool GATHER = false;
    __device__ __forceinline__ const char* a_ptr(const Unit& u) const { return A + (size_t)u.pm * BM * K * 2; }
    __device__ __forceinline__ void a_offs(const Unit&, const int (&)[2], unsigned (&)[2], unsigned (&)[2]) const {}
    __device__ __forceinline__ const char* b_ptr(const Unit& u) const { return Bt + (size_t)u.pn * BM * K * 2; }
};
template <bool GATHER_> struct MoeSched {
    static constexpr bool GATHER = GATHER_;
    const char* A; const char* W; size_t wstride; int K, G, c; const int* elist; const volatile LAS int* T; const volatile LAS int* Cn;
    __device__ __forceinline__ bool next(int i, Unit& u) const {
        const long L = (long)i * G + c; const int nT = T[16]; if (L >= 4L * nT) return false;
        const int tile = (int)(L >> 2); u.pn = (int)(L & 3); u.pm = tile;
        int e = 0;
#pragma unroll
        for (int k = 1; k < 16; ++k) e += (tile >= T[k]) ? 1 : 0;
        u.e = e; u.j = tile - T[e]; u.cnt = Cn[e]; return true;
    }
    __device__ __forceinline__ const char* a_ptr(const Unit& u) const { return GATHER ? A : A + (size_t)u.pm * BM * K * 2; }
    __device__ __forceinline__ void a_offs(const Unit& u, const int (&Rr)[2], unsigned (&v0)[2], unsigned (&v1)[2]) const {
#pragma unroll
        for (int i = 0; i < 2; ++i) {
            const int p0 = u.j * BM + Rr[i], p1 = p0 + HALF;
            int t0 = p0 < u.cnt ? (elist[u.e * NROW + p0] >> 1) : 0, t1 = p1 < u.cnt ? (elist[u.e * NROW + p1] >> 1) : 0;
            t0 = min(max(t0, 0), NROW - 1); t1 = min(max(t1, 0), NROW - 1);
            v0[i] = (unsigned)(t0 * K * 2); v1[i] = (unsigned)(t1 * K * 2);
        } }
    __device__ __forceinline__ const char* b_ptr(const Unit& u) const { return W + (size_t)u.e * wstride + (size_t)u.pn * BM * K * 2; }
};
struct EpiP {
    static constexpr bool PERM = true;
    bf16* O;
    __device__ __forceinline__ void operator()(const f32x4 (&acc)[2][2][4][2], const Unit& u, int wr, int wc, int fr, int fq) const {
        const int row0 = u.pm * BM + wr * 64 + fr, col0 = u.pn * BM + wc * 32 + 8 * fq;
#pragma unroll
        for (int ai = 0; ai < 2; ++ai)
#pragma unroll
            for (int m = 0; m < 4; ++m) { bf16* rowp = O + (size_t)(row0 + ai * HALF + m * 16) * NP + col0;
#pragma unroll
                for (int bj = 0; bj < 2; ++bj) { const f32x4 v0 = acc[ai][bj][m][0], v1 = acc[ai][bj][m][1];
                    u32x4 w; w.x = cvt_pk_bf16(v0[0], v0[1]); w.y = cvt_pk_bf16(v0[2], v0[3]); w.z = cvt_pk_bf16(v1[0], v1[1]); w.w = cvt_pk_bf16(v1[2], v1[3]);
                    *(u32x4*)(rowp + bj * HALF) = w; } }
    }
};
struct EpiRes {
    static constexpr bool PERM = false;
    const float* hin_l; const float* hin_c; float* hout_l; float* hout_c; const float* gate; float gsc;
    __device__ __forceinline__ void operator()(const f32x4 (&acc)[2][2][4][2], const Unit& u, int wr, int wc, int fr, int fq) const {
        const int row0 = u.pm * BM + wr * 64 + fr, col0 = u.pn * BM + wc * 32 + 4 * fq;
#pragma unroll
        for (int ai = 0; ai < 2; ++ai)
#pragma unroll
            for (int m = 0; m < 4; ++m) { const int r = row0 + ai * HALF + m * 16; const bool lat = r < NLAT; const int bb = lat ? (r >> 11) : 8;
                const float* hi = lat ? hin_l + (size_t)r * DM : hin_c + (size_t)(r - NLAT) * DM; float* ho = lat ? hout_l + (size_t)r * DM : hout_c + (size_t)(r - NLAT) * DM;
                const float* g = gate + (size_t)bb * 6144;
#pragma unroll
                for (int bj = 0; bj < 2; ++bj)
#pragma unroll
                    for (int n = 0; n < 2; ++n) { const int c = col0 + bj * HALF + n * 16; const f32x4 gv = *(const f32x4*)(g + c), hv = *(const f32x4*)(hi + c);
                        *(f32x4*)(ho + c) = hv + gv * gsc * acc[ai][bj][m][n]; } }
    }
};
struct EpiAct {
    static constexpr bool PERM = true;
    bf16* O;
    __device__ __forceinline__ void operator()(const f32x4 (&acc)[2][2][4][2], const Unit& u, int wr, int wc, int fr, int fq) const {
        const int row0 = u.pm * BM + wr * 64 + fr, col0 = u.pn * HALF + wc * 32 + 8 * fq;
#pragma unroll
        for (int ai = 0; ai < 2; ++ai)
#pragma unroll
            for (int m = 0; m < 4; ++m) { bf16* rowp = O + (size_t)(row0 + ai * HALF + m * 16) * FF + col0;
                float o[8];
#pragma unroll
                for (int n = 0; n < 2; ++n)
#pragma unroll
                    for (int j = 0; j < 4; ++j) { const float g = acc[ai][0][m][n][j], up = acc[ai][1][m][n][j]; o[n * 4 + j] = g / (1.f + __expf(-g)) * up; }
                u32x4 w; w.x = cvt_pk_bf16(o[0], o[1]); w.y = cvt_pk_bf16(o[2], o[3]); w.z = cvt_pk_bf16(o[4], o[5]); w.w = cvt_pk_bf16(o[6], o[7]);
                *(u32x4*)rowp = w; }
    }
};
struct EpiDown {
    static constexpr bool PERM = true;
    bf16* O; const int* elist; const float* rtw;
    __device__ __forceinline__ void operator()(const f32x4 (&acc)[2][2][4][2], const Unit& u, int wr, int wc, int fr, int fq) const {
        const int col0 = u.pn * BM + wc * 32 + 8 * fq;
#pragma unroll
        for (int ai = 0; ai < 2; ++ai)
#pragma unroll
            for (int m = 0; m < 4; ++m) { const int pos = u.j * BM + ai * HALF + wr * 64 + m * 16 + fr;
                if (pos < u.cnt) { const int a = min(max(elist[u.e * NROW + pos], 0), 2 * NROW - 1); const float w8 = rtw[a]; bf16* rowp = O + (size_t)a * DM + col0;
#pragma unroll
                    for (int bj = 0; bj < 2; ++bj) { const f32x4 v0 = acc[ai][bj][m][0] * w8, v1 = acc[ai][bj][m][1] * w8;
                        u32x4 w; w.x = cvt_pk_bf16(v0[0], v0[1]); w.y = cvt_pk_bf16(v0[2], v0[3]); w.z = cvt_pk_bf16(v1[0], v1[1]); w.w = cvt_pk_bf16(v1[2], v1[3]);
                        *(u32x4*)(rowp + bj * HALF) = w; } } }
    }
};
}

struct Args { const float* in[36]; float* out; unsigned char* ws; int ph_lo, ph_hi; };
struct Fr {
    LAS unsigned char* lds; int tid, lane, wave, G, vcu, gw, NGW; const __attribute__((address_space(4))) Args* A;
    __device__ __forceinline__ const float* x() const { return A->in[0]; }
    __device__ __forceinline__ const float* cvec() const { return A->in[1]; }
    __device__ __forceinline__ const float* ctx() const { return A->in[2]; }
    __device__ __forceinline__ const float* cctx() const { return A->in[3]; }
    __device__ __forceinline__ const float* w_mod() const { return A->in[4]; }
    __device__ __forceinline__ const float* b_mod() const { return A->in[5]; }
    __device__ __forceinline__ const float* g_mix() const { return A->in[6]; }
    __device__ __forceinline__ const float* w_in() const { return A->in[7]; }
    __device__ __forceinline__ const float* w_out() const { return A->in[8]; }
    __device__ __forceinline__ const float* na_gq() const { return A->in[9]; }
    __device__ __forceinline__ const float* na_gk() const { return A->in[10]; }
    __device__ __forceinline__ const float* na_rb() const { return A->in[11]; }
    __device__ __forceinline__ const float* mla_gqa() const { return A->in[12]; }
    __device__ __forceinline__ const float* mla_wqb() const { return A->in[13]; }
    __device__ __forceinline__ const float* mla_gkva() const { return A->in[14]; }
    __device__ __forceinline__ const float* mla_wkvb() const { return A->in[15]; }
    __device__ __forceinline__ const float* mla_gq() const { return A->in[16]; }
    __device__ __forceinline__ const float* mla_gk() const { return A->in[17]; }
    __device__ __forceinline__ const float* df_gq() const { return A->in[18]; }
    __device__ __forceinline__ const float* df_gk() const { return A->in[19]; }
    __device__ __forceinline__ const float* df_lam() const { return A->in[20]; }
    __device__ __forceinline__ const float* df_gsub() const { return A->in[21]; }
    __device__ __forceinline__ const float* conv_w() const { return A->in[22]; }
    __device__ __forceinline__ const float* conv_b() const { return A->in[23]; }
    __device__ __forceinline__ const float* dt_bias() const { return A->in[24]; }
    __device__ __forceinline__ const float* a_log() const { return A->in[25]; }
    __device__ __forceinline__ const float* ssd_d() const { return A->in[26]; }
    __device__ __forceinline__ const float* ssd_gn() const { return A->in[27]; }
    __device__ __forceinline__ const float* g_ffn() const { return A->in[28]; }
    __device__ __forceinline__ const float* w_grp() const { return A->in[29]; }
    __device__ __forceinline__ const float* b_grp() const { return A->in[30]; }
    __device__ __forceinline__ const float* w_exp() const { return A->in[31]; }
    __device__ __forceinline__ const float* b_exp() const { return A->in[32]; }
    __device__ __forceinline__ const float* w_gate() const { return A->in[33]; }
    __device__ __forceinline__ const float* w_up() const { return A->in[34]; }
    __device__ __forceinline__ const float* w_down() const { return A->in[35]; }
    __device__ __forceinline__ float* out() const { return A->out; }
    __device__ __forceinline__ unsigned* ctl() const { return (unsigned*)(A->ws + WS_CTL); }
    __device__ __forceinline__ float* modv() const { return (float*)(A->ws + WS_MOD); }
    __device__ __forceinline__ float* rcos() const { return (float*)(A->ws + WS_ROPE); }
    __device__ __forceinline__ float* rsin() const { return (float*)(A->ws + WS_ROPE + TLAT * 16 * 4); }
    __device__ __forceinline__ bf16* winT() const { return (bf16*)(A->ws + WS_WIN); }
    __device__ __forceinline__ bf16* woutT() const { return (bf16*)(A->ws + WS_WOUT); }
    __device__ __forceinline__ bf16* wqbT() const { return (bf16*)(A->ws + WS_WQB); }
    __device__ __forceinline__ bf16* wkvbT() const { return (bf16*)(A->ws + WS_WKVB); }
    __device__ __forceinline__ bf16* wgu(int par = 0) const { return (bf16*)(A->ws + (par ? WS_WGU2 : WS_WGU)); }
    __device__ __forceinline__ bf16* wd(int par = 0) const { return (bf16*)(A->ws + (par ? WS_WD2 : WS_WD)); }
    __device__ __forceinline__ float* hc() const { return (float*)(A->ws + WS_HC); }
    __device__ __forceinline__ bf16* abuf() const { return (bf16*)(A->ws + WS_A); }
    __device__ __forceinline__ bf16* pbuf() const { return (bf16*)(A->ws + WS_P); }
    __device__ __forceinline__ bf16* act() const { return (bf16*)(A->ws + WS_ACT); }
    __device__ __forceinline__ bf16* yk() const { return (bf16*)(A->ws + WS_YK); }
    __device__ __forceinline__ bf16* mix() const { return (bf16*)(A->ws + WS_MIX); }
    __device__ __forceinline__ bf16* qna() const { return (bf16*)(A->ws + WS_QNA); }
    __device__ __forceinline__ bf16* kna() const { return (bf16*)(A->ws + WS_KNA); }
    __device__ __forceinline__ bf16* vna() const { return (bf16*)(A->ws + WS_VNA); }
    __device__ __forceinline__ bf16* qml() const { return (bf16*)(A->ws + WS_QML); }
    __device__ __forceinline__ bf16* kml() const { return (bf16*)(A->ws + WS_KML); }
    __device__ __forceinline__ bf16* vml() const { return (bf16*)(A->ws + WS_VML); }
    __device__ __forceinline__ bf16* qdf() const { return (bf16*)(A->ws + WS_QDF); }
    __device__ __forceinline__ bf16* kdf() const { return (bf16*)(A->ws + WS_KDF); }
    __device__ __forceinline__ bf16* vdf() const { return (bf16*)(A->ws + WS_VDF); }
    __device__ __forceinline__ bf16* xT() const { return (bf16*)(A->ws + WS_XT); }
    __device__ __forceinline__ bf16* btm() const { return (bf16*)(A->ws + WS_BTM); }
    __device__ __forceinline__ bf16* bT() const { return (bf16*)(A->ws + WS_BT); }
    __device__ __forceinline__ bf16* ctm() const { return (bf16*)(A->ws + WS_CTM); }
    __device__ __forceinline__ float* dtv() const { return (float*)(A->ws + WS_DT); }
    __device__ __forceinline__ float* cst() const { return (float*)(A->ws + WS_CST); }
    __device__ __forceinline__ float* cdec() const { return (float*)(A->ws + WS_CDEC); }
    __device__ __forceinline__ bf16* hent() const { return (bf16*)(A->ws + WS_HENT); }
    __device__ __forceinline__ float* ydir() const { return (float*)(A->ws + WS_CST); }
    __device__ __forceinline__ int* rte() const { return (int*)(A->ws + WS_RT); }
    __device__ __forceinline__ float* rtw() const { return (float*)(A->ws + WS_RT + 256 * 1024); }
    __device__ __forceinline__ int* elist() const { return (int*)(A->ws + WS_ELIST); }
};

__device__ __forceinline__ Fr refresh(const Fr& F0) { Fr F = F0; int w = F0.wave; asm volatile("" : "+s"(w)); asm volatile("" : "+s"(F.A));
    int l; asm volatile("v_mbcnt_lo_u32_b32 %0, -1, 0\n\tv_mbcnt_hi_u32_b32 %0, -1, %0" : "=v"(l)); F.wave = w; F.lane = l; F.tid = w * 64 + l; F.gw = F.vcu * 8 + w; return F; }
__device__ __forceinline__ void tr_item(const float* W, int ldw, int nvalid, int k0, int n0, bf16* dst, int ldd, LAS float* scr, int lane, const float* ksc = nullptr) {
    const int cn = n0 + (lane & 31), cnc = min(cn, nvalid - 1);
    float tv[32];
#pragma unroll
    for (int i = 0; i < 32; ++i) { const int kk = 2 * i + (lane >> 5); tv[i] = W[(size_t)(k0 + kk) * ldw + cnc]; }
#pragma unroll
    for (int i = 0; i < 32; ++i) { const int kk = 2 * i + (lane >> 5); const float sc1 = ksc ? ksc[k0 + kk] : 1.f; scr[kk * 33 + (lane & 31)] = cn < nvalid ? tv[i] * sc1 : 0.f; }
    LDS_WAIT();
    const int c = lane & 7;
#pragma unroll
    for (int j = 0; j < 4; ++j) { const int n = (lane >> 3) + 8 * j; const LAS float* s = scr + (8 * c) * 33 + n;
        u32x4 o; o.x = pk2(s[0 * 33], s[1 * 33]); o.y = pk2(s[2 * 33], s[3 * 33]); o.z = pk2(s[4 * 33], s[5 * 33]); o.w = pk2(s[6 * 33], s[7 * 33]);
        *(u32x4*)(dst + (size_t)n * ldd + k0 + 8 * c) = o; }
    LDS_WAIT();
}
__device__ __forceinline__ void moe_weight_convert(const Fr& F, int L, int gw0 = -1, int ngw0 = 0) {
    LAS float* scr = (LAS float*)(F.lds + F.wave * 16384);
    const int gwc = gw0 >= 0 ? gw0 : F.gw, ngwc = gw0 >= 0 ? ngw0 : F.NGW; bf16* const wgu_ = F.wgu(L & 1); bf16* const wd_ = F.wd(L & 1);
    constexpr int I_GU = 16 * 16, I_D = 8 * 32;
    for (int it = gwc; it < NEXP * (2 * I_GU + I_D); it += ngwc) {
        const int e = it / (2 * I_GU + I_D); int r = it % (2 * I_GU + I_D);
        if (r < 2 * I_GU) { const int bj = r / I_GU; r %= I_GU; const int kb = r / 16, nb = r % 16, n0 = nb * 32;
            const float* W = (bj ? F.w_up() : F.w_gate()) + ((size_t)L * NEXP + e) * DM * FF;
            tr_item(W, FF, FF, kb * 64, n0, wgu_ + ((size_t)e * 1024 + (n0 >> 7) * 256 + bj * 128 + (n0 & 127)) * DM, DM, scr, F.lane);
        } else { r -= 2 * I_GU; const int kb = r / 32, nb = r % 32, n0 = nb * 32;
            const float* W = F.w_down() + ((size_t)L * NEXP + e) * FF * DM;
            tr_item(W, DM, DM, kb * 64, n0, wd_ + ((size_t)e * 1024 + n0) * FF, FF, scr, F.lane); }
    }
}
__device__ __forceinline__ void phase_prologue(const Fr& F) {
    {   LAS float* sc = (LAS float*)F.lds;
        LAS float* part = (LAS float*)(F.lds + 40960);
        for (int i = F.tid; i < 9 * 1024; i += 512) { const float v = i < 8192 ? F.cvec()[i] : F.cctx()[i - 8192]; sc[i] = siluf(v); }
        __syncthreads();
        for (int u = F.vcu; u < 384; u += F.G) {
            const int col = u * 64 + F.lane, L = col / 6144, n = col - L * 6144;
            const float* w = F.w_mod() + ((size_t)L * 1024 + F.wave * 128) * 6144 + n;
            float acc[9];
#pragma unroll
            for (int b = 0; b < 9; ++b) acc[b] = 0.f;
#pragma unroll 1
            for (int k0 = 0; k0 < 128; k0 += 16) { float wv[16];
#pragma unroll
                for (int j = 0; j < 16; ++j) wv[j] = w[(size_t)(k0 + j) * 6144];
#pragma unroll
                for (int j = 0; j < 16; ++j)
#pragma unroll
                    for (int b = 0; b < 9; ++b) acc[b] += sc[b * 1024 + F.wave * 128 + k0 + j] * wv[j]; }
#pragma unroll
            for (int b = 0; b < 9; ++b) part[(F.wave * 9 + b) * 64 + F.lane] = acc[b];
            __syncthreads();
            for (int i = F.tid; i < 9 * 64; i += 512) { const int b = i >> 6, l = i & 63; float s = 0.f;
#pragma unroll
                for (int w8 = 0; w8 < 8; ++w8) s += part[(w8 * 9 + b) * 64 + l];
                const int c2 = u * 64 + l, L2 = c2 / 6144, n2 = c2 - L2 * 6144;
                F.modv()[((size_t)L2 * 9 + b) * 6144 + n2] = s + F.b_mod()[L2 * 6144 + n2]; }
            __syncthreads();
        }
    }
    if (blockIdx.x == 0 && F.wave < 4) {
#pragma unroll 1
        for (int q = 0; q < 4; ++q) { const int lh = F.wave * 4 + q; float bm = 0.f;
            for (int i = F.lane; i < 465; i += 64) bm = fmaxf(bm, F.na_rb()[lh * 465 + i]);
            bm = wmaxf(bm); if (F.lane == 0) (F.rcos() + 2 * TLAT * 16)[lh] = bm * 1.4426950408889634f; } }
    for (int i = blockIdx.x * 512 + F.tid; i < TLAT * 16; i += F.G * 512) { const int t = i >> 4, k = i & 15; const float inv = powf(10000.f, -(float)(k & 7) / 8.f);
        const float pos = (k < 8) ? (float)(t >> 6) : (float)(t & 63); const float ang = pos * inv; F.rcos()[i] = cosf(ang); F.rsin()[i] = sinf(ang); }
    __syncthreads();
    LAS float* scr = (LAS float*)(F.lds + F.wave * 16384);
    constexpr int I_IN = 16 * 96, I_OUT = 16 * 32, I_QB = 4 * 12, I_KVB = 2 * 16, I_L = I_IN + I_OUT + I_QB + I_KVB;
    for (int it = F.gw; it < DEPTH * I_L; it += F.NGW) {
        const int L = it / I_L; int r = it % I_L;
        if (r < I_IN) { const int kb = r / 96, nb = r % 96; tr_item(F.w_in() + (size_t)L * DM * NIN, NIN, NIN, kb * 64, nb * 32, F.winT() + ((size_t)L * NP + nb * 32) * DM, DM, scr, F.lane); continue; } r -= I_IN;
        if (r < I_OUT) { const int kb = r / 32, nb = r % 32; tr_item(F.w_out() + (size_t)L * DM * DM, DM, DM, kb * 64, nb * 32, F.woutT() + ((size_t)L * DM + nb * 32) * DM, DM, scr, F.lane); continue; } r -= I_OUT;
        if (r < I_QB) { const int kb = r / 12, nb = r % 12; tr_item(F.mla_wqb() + (size_t)L * 256 * 384, 384, 384, kb * 64, nb * 32, F.wqbT() + ((size_t)L * 384 + nb * 32) * 256, 256, scr, F.lane, F.mla_gqa() + L * 256); continue; } r -= I_QB;
        { const int kb = r / 16, nb = r % 16; tr_item(F.mla_wkvb() + (size_t)L * 128 * 512, 512, 512, kb * 64, nb * 32, F.wkvbT() + ((size_t)L * 512 + nb * 32) * 128, 128, scr, F.lane, F.mla_gkva() + L * 128); }
    }
}

__device__ __forceinline__ void phase_norm(const Fr& F, int L, bool combine = true) {
    const int nrows = (L == DEPTH) ? NLAT : NROW;
    for (int r = F.gw; r < nrows; r += F.NGW) {
        const bool lat = r < NLAT; const int bb = lat ? (r >> 11) : 8;
        const float* hin = (L == 0) ? (lat ? F.x() + (size_t)r * DM : F.ctx() + (size_t)(r - NLAT) * DM) : (lat ? F.out() + (size_t)r * DM : F.hc() + (size_t)(r - NLAT) * DM);
        float* hout = lat ? F.out() + (size_t)r * DM : F.hc() + (size_t)(r - NLAT) * DM;
        f32x4 v[4];
#pragma unroll
        for (int j = 0; j < 4; ++j) v[j] = *(const f32x4*)(hin + 4 * F.lane + 256 * j);
        if (L > 0 && combine) {
            const float* m5 = F.modv() + ((size_t)(L - 1) * 9 + bb) * 6144 + 5 * 1024;
#pragma unroll
            for (int j = 0; j < 4; ++j) { const int c = 4 * F.lane + 256 * j; const f32x4 g = *(const f32x4*)(m5 + c);
                const u32x2 y0 = *(const u32x2*)(F.yk() + (size_t)(2 * r) * DM + c), y1 = *(const u32x2*)(F.yk() + (size_t)(2 * r + 1) * DM + c);
                f32x4 ys; ys[0] = __uint_as_float(y0.x << 16) + __uint_as_float(y1.x << 16); ys[1] = __uint_as_float(y0.x & 0xffff0000u) + __uint_as_float(y1.x & 0xffff0000u);
                ys[2] = __uint_as_float(y0.y << 16) + __uint_as_float(y1.y << 16); ys[3] = __uint_as_float(y0.y & 0xffff0000u) + __uint_as_float(y1.y & 0xffff0000u);
                v[j] = v[j] + g * ys; *(f32x4*)(hout + c) = v[j]; }
        }
        if (L == DEPTH) continue;
        float ss = 0.f;
#pragma unroll
        for (int j = 0; j < 4; ++j) ss += (v[j][0] * v[j][0] + v[j][1] * v[j][1]) + (v[j][2] * v[j][2] + v[j][3] * v[j][3]);
        const float rstd = rsqrtf(wsum(ss) * (1.f / DM) + EPS);
        const float* md = F.modv() + ((size_t)L * 9 + bb) * 6144;
#pragma unroll
        for (int j = 0; j < 4; ++j) { const int c = 4 * F.lane + 256 * j; const f32x4 g = *(const f32x4*)(F.g_mix() + L * DM + c), sh = *(const f32x4*)(md + c), scl = *(const f32x4*)(md + 1024 + c);
            const f32x4 a = v[j] * rstd * g * (scl + 1.f) + sh; u32x2 o; o.x = pk2(a[0], a[1]); o.y = pk2(a[2], a[3]); *(u32x2*)(F.abuf() + (size_t)r * DM + c) = o; }
    }
}

__device__ __forceinline__ void prep_row(const Fr& F, int L, int r, LAS float* scr) {
    int lane_ = F.lane; asm volatile("" : "+v"(lane_)); const int lane = lane_; int b, s; row2bs(r, b, s); const bool lat = r < NLAT; const int t = s - 256;
    const bf16* p = F.pbuf() + (size_t)r * NP;
#pragma unroll
    for (int h = 0; h < 4; ++h) {
        const float q = bf2f(p[C_NA + h * 64 + lane]), k = bf2f(p[C_NA + 256 + h * 64 + lane]);
        const float rq = rsqrtf(wsum(q * q) * (1.f / 64) + EPS), rk = rsqrtf(wsum(k * k) * (1.f / 64) + EPS);
        const size_t o = ((size_t)(b * 4 + h) * SQ + s) * 64 + lane;
        F.qna()[o] = f2bf(q * rq * F.na_gq()[L * 64 + lane]); F.kna()[o] = f2bf(k * rk * F.na_gk()[L * 64 + lane]);
    }
    {
        const int idx = lane & 31; float cs = 1.f, sn = 0.f;
        if (lat) { cs = F.rcos()[t * 16 + (idx & 15)]; sn = F.rsin()[t * 16 + (idx & 15)]; }
#pragma unroll
        for (int h = 0; h < 4; ++h) {
            float q = bf2f(p[C_DF + h * 64 + lane]), k = bf2f(p[C_DF + 256 + h * 64 + lane]);
            float sq = q * q, sk = k * k;
#pragma unroll
            for (int o = 16; o >= 1; o >>= 1) { sq += __shfl_xor(sq, o); sk += __shfl_xor(sk, o); }
            q *= rsqrtf(sq * (1.f / 32) + EPS) * F.df_gq()[L * 32 + idx]; k *= rsqrtf(sk * (1.f / 32) + EPS) * F.df_gk()[L * 32 + idx];
            const float qp = __shfl_xor(q, 16), kp = __shfl_xor(k, 16);
            if (lat) { q = (idx < 16) ? q * cs - qp * sn : qp * sn + q * cs; k = (idx < 16) ? k * cs - kp * sn : kp * sn + k * cs; }
            const size_t o = ((size_t)(b * 4 + h) * SQ + s) * 64 + lane;
            F.qdf()[o] = f2bf(q); F.kdf()[o] = f2bf(k);
        }
    }
}
__device__ __forceinline__ void prep_tile(const Fr& F, int L, int b, int c) {
    int tid_ = F.tid; asm volatile("" : "+v"(tid_)); const int tid = tid_;
    const int s0 = 64 * c; const size_t r0 = bs2row(b, s0);
    LAS bf16* Lv = (LAS bf16*)F.lds;
#ifndef PT_MASK
#define PT_MASK 7
#endif
    if (PT_MASK & 1)
#pragma unroll 1
    for (int mx = 0; mx < 2; ++mx) {
        const int voff = mx == 0 ? C_NA + 512 : C_DF + 512; bf16* vt = mx == 0 ? F.vna() : F.vdf();
#pragma unroll
        for (int k = 0; k < 4; ++k) { const int idx = tid + 512 * k, tok = idx >> 5, d8 = (idx & 31) * 8;
            const u32x4 v = *(const u32x4*)(F.pbuf() + (r0 + tok) * NP + voff + d8); const int pc = vpos(tok);
#pragma unroll
            for (int e = 0; e < 4; ++e) { Lv[(d8 + 2 * e) * 72 + pc] = (bf16)(v[e] & 0xffffu); Lv[(d8 + 2 * e + 1) * 72 + pc] = (bf16)(v[e] >> 16); } }
        __syncthreads();
#pragma unroll
        for (int k = 0; k < 4; ++k) { const int idx = tid + 512 * k, dv = idx >> 3, pc = idx & 7;
            const u32x4 v = *(const LAS u32x4*)(Lv + dv * 72 + pc * 8);
#ifndef PT_NOSTORE
#define PT_NOSTORE 0
#endif
            if (!PT_NOSTORE || v.x == 0x12345678u) *(u32x4*)(vt + ((size_t)(b * 4 + (dv >> 6)) * 64 + (dv & 63)) * SQ + s0 + pc * 8) = v; }
        __syncthreads();
    }
    const int len = c < 4 ? TCTX : TLAT, t0 = c < 4 ? s0 : s0 - 256;
    LAS bf16* Lc = (LAS bf16*)F.lds;
    if (PT_MASK & 2)
#pragma unroll 1
    for (int gch = 0; gch < 3; ++gch) {
        {   u32x4 v[5];
#pragma unroll
            for (int k = 0; k < 5; ++k) { const int idx = min(tid + 512 * k, 68 * 32 - 1), j = idx >> 5, c8 = (idx & 31) * 8, tj = t0 - 2 + j, jc = min(max(tj, 0), len - 1) - t0;
                v[k] = *(const u32x4*)(F.pbuf() + (size_t)((long)r0 + jc) * NP + C_XBC + gch * 256 + c8);
                const unsigned keep = (tj >= 0 && tj < len) ? 0xffffffffu : 0u; v[k].x &= keep; v[k].y &= keep; v[k].z &= keep; v[k].w &= keep; }
#pragma unroll
            for (int k = 0; k < 5; ++k) { const int idx = tid + 512 * k, j = idx >> 5, c8 = (idx & 31) * 8; if (idx < 68 * 32) *(LAS u32x4*)(Lc + j * 256 + c8) = v[k]; }
        }
        __syncthreads();
        const int ch = tid & 255, tq = tid >> 8, cg = gch * 256 + ch;
        float w[5];
#pragma unroll
        for (int j = 0; j < 5; ++j) w[j] = F.conv_w()[(L * 5 + j) * 768 + cg];
        const float bias = F.conv_b()[L * 768 + cg];
        const LAS bf16* lp = Lc + (32 * tq) * 256 + ch;
        float x0 = bf2f(lp[0]), x1 = bf2f(lp[256]), x2 = bf2f(lp[512]), x3 = bf2f(lp[768]);
        bf16* tm = (gch == 1 ? F.btm() : F.ctm()) + ((size_t)b * SQ + s0 + 32 * tq) * 256 + ch;
        bf16* cm = (gch == 0 ? F.xT() : F.bT()) + ((size_t)b * 256 + ch) * SQ + s0 + 32 * tq;
#pragma unroll
        for (int g8 = 0; g8 < 4; ++g8) { unsigned pk[4];
#pragma unroll
            for (int e = 0; e < 8; ++e) { const int i = 8 * g8 + e; const float x4 = bf2f(lp[(i + 4) * 256]);
                const float acc = bias + w[0] * x0 + w[1] * x1 + w[2] * x2 + w[3] * x3 + w[4] * x4; const unsigned o = f2bf(siluf(acc));
                if (gch >= 1) tm[(size_t)i * 256] = (bf16)o;
                if (e & 1) pk[e >> 1] |= o << 16; else pk[e >> 1] = o;
                x0 = x1; x1 = x2; x2 = x3; x3 = x4; }
            if (gch <= 1) { u32x4 v; v.x = pk[0]; v.y = pk[1]; v.z = pk[2]; v.w = pk[3]; *(u32x4*)(cm + 8 * g8) = v; } }
        __syncthreads();
    }
    if (PT_MASK & 4) { const int tok = tid >> 3, i = tid & 7; const float raw = bf2f(F.pbuf()[(r0 + tok) * NP + C_DT + i]) + F.dt_bias()[L * 8 + i]; const float ex = __expf(raw);
      F.dtv()[((size_t)b * 8 + i) * SQ + s0 + tok] = raw > 20.f ? raw : (ex < 0.03f ? ex * (1.f - ex * (0.5f - ex * (0.33333334f - 0.25f * ex))) : __logf(1.f + ex)); }
}
__device__ __forceinline__ void mla_prep_block(const Fr& F, int L, int b, int j32) {
    int lane_ = F.lane; asm volatile("" : "+v"(lane_));
    const int lane = lane_, wave = F.wave, r = lane & 31, hh = lane >> 5, s = 32 * j32 + r, t = s - 256; const bool lat = s >= 256;
    const size_t row = bs2row(b, s);
    const bf16* p = F.pbuf() + row * NP + C_MLA;
    const int tt = lat ? t : 0; const float latf = lat ? 1.f : 0.f;
    if (wave < 4) {
        const int hq = wave;
        bf16x8 Bq[16]; float ss = 0.f;
#pragma unroll
        for (int kk = 0; kk < 16; ++kk) { Bq[kk] = *(const bf16x8*)(p + 16 * kk + 8 * hh);
#pragma unroll
            for (int j = 0; j < 8; ++j) { const float v = bf2f((bf16)Bq[kk][j]); ss += v * v; } }
        ss += __shfl_xor(ss, 32); const float rq = rsqrtf(ss * (1.f / 256) + EPS);
        f32x16 acc[3]; float hs = 0.f;
#pragma unroll
        for (int j3 = 0; j3 < 3; ++j3) {
#pragma unroll
            for (int i = 0; i < 16; ++i) acc[j3][i] = 0.f;
            const bf16* wp = F.wqbT() + ((size_t)L * 384 + 96 * hq + 32 * j3 + r) * 256 + 8 * hh;
#pragma unroll
            for (int kk = 0; kk < 16; ++kk) acc[j3] = MFMA32(*(const bf16x8*)(wp + 16 * kk), Bq[kk], acc[j3]);
            asm volatile("" ::: "memory");
#pragma unroll
            for (int i = 0; i < 16; ++i) hs += acc[j3][i] * acc[j3][i]; }
        hs = (hs + __shfl_xor(hs, 32)) * rq * rq; const float rs = rsqrtf(hs * (1.f / 96) + EPS) * rq;
        bf16* qo = F.qml() + ((size_t)(b * 4 + hq) * SQ + s) * 96 + 4 * hh;
#pragma unroll
        for (int j3 = 0; j3 < 3; ++j3) {
#pragma unroll
            for (int i = 0; i < 16; ++i) acc[j3][i] *= rs * F.mla_gq()[L * 96 + 32 * j3 + crow16(i, hh)];
            if (j3 == 2) {
#pragma unroll
                for (int i = 0; i < 8; ++i) { const float rc = lat ? F.rcos()[tt * 16 + crow16(i, hh)] : 1.f, rsn = F.rsin()[tt * 16 + crow16(i, hh)] * latf;
                    const float x1 = acc[2][i], x2 = acc[2][i + 8]; acc[2][i] = x1 * rc - x2 * rsn; acc[2][i + 8] = x1 * rsn + x2 * rc; } }
#pragma unroll
            for (int g = 0; g < 4; ++g) { u32x2 w; w.x = pk2(acc[j3][4 * g], acc[j3][4 * g + 1]); w.y = pk2(acc[j3][4 * g + 2], acc[j3][4 * g + 3]); *(u32x2*)(qo + 32 * j3 + 8 * g) = w; } }
    } else {
        const int hk = wave - 4;
        LAS unsigned char* wl = F.lds + wave * 16384;
        bf16x8 Bkv[8]; float ss = 0.f;
#pragma unroll
        for (int kk = 0; kk < 8; ++kk) { Bkv[kk] = *(const bf16x8*)(p + 256 + 16 * kk + 8 * hh);
#pragma unroll
            for (int j = 0; j < 8; ++j) { const float v = bf2f((bf16)Bkv[kk][j]); ss += v * v; } }
        ss += __shfl_xor(ss, 32); const float rk = rsqrtf(ss * (1.f / 128) + EPS);
        float kr[16]; float hs = 0.f;
#pragma unroll
        for (int g = 0; g < 4; ++g) { const u32x2 k4 = *(const u32x2*)(p + 384 + 8 * g + 4 * hh);
            kr[4 * g] = __uint_as_float(k4.x << 16); kr[4 * g + 1] = __uint_as_float(k4.x & 0xffff0000u); kr[4 * g + 2] = __uint_as_float(k4.y << 16); kr[4 * g + 3] = __uint_as_float(k4.y & 0xffff0000u); }
#pragma unroll
        for (int i = 0; i < 16; ++i) hs += kr[i] * kr[i];
        f32x16 acc[4]; float ks = 0.f;
#pragma unroll
        for (int j4 = 0; j4 < 4; ++j4) {
#pragma unroll
            for (int i = 0; i < 16; ++i) acc[j4][i] = 0.f;
            const bf16* wp = F.wkvbT() + ((size_t)L * 512 + 128 * hk + 32 * j4 + r) * 128 + 8 * hh;
#pragma unroll
            for (int kk = 0; kk < 8; ++kk) acc[j4] = MFMA32(*(const bf16x8*)(wp + 16 * kk), Bkv[kk], acc[j4]);
            asm volatile("" ::: "memory");
            if (j4 < 2) {
#pragma unroll
                for (int i = 0; i < 16; ++i) ks += acc[j4][i] * acc[j4][i]; } }
        hs += ks * rk * rk; hs += __shfl_xor(hs, 32); const float rs = rsqrtf(hs * (1.f / 96) + EPS);
        bf16* ko = F.kml() + ((size_t)(b * 4 + hk) * SQ + s) * 96 + 4 * hh;
#pragma unroll
        for (int j2 = 0; j2 < 2; ++j2) {
#pragma unroll
            for (int i = 0; i < 16; ++i) acc[j2][i] *= rs * rk * F.mla_gk()[L * 96 + 32 * j2 + crow16(i, hh)];
#pragma unroll
            for (int g = 0; g < 4; ++g) { u32x2 w; w.x = pk2(acc[j2][4 * g], acc[j2][4 * g + 1]); w.y = pk2(acc[j2][4 * g + 2], acc[j2][4 * g + 3]); *(u32x2*)(ko + 32 * j2 + 8 * g) = w; } }
#pragma unroll
        for (int i = 0; i < 16; ++i) kr[i] *= rs * F.mla_gk()[L * 96 + 64 + crow16(i, hh)];
#pragma unroll
        for (int i = 0; i < 8; ++i) { const float rc = lat ? F.rcos()[tt * 16 + crow16(i, hh)] : 1.f, rsn = F.rsin()[tt * 16 + crow16(i, hh)] * latf;
            const float x1 = kr[i], x2 = kr[i + 8]; kr[i] = x1 * rc - x2 * rsn; kr[i + 8] = x1 * rsn + x2 * rc; }
#pragma unroll
        for (int g = 0; g < 4; ++g) { u32x2 w; w.x = pk2(kr[4 * g], kr[4 * g + 1]); w.y = pk2(kr[4 * g + 2], kr[4 * g + 3]); *(u32x2*)(ko + 64 + 8 * g) = w; }
        { float n2 = 0.f;
#pragma unroll
          for (int i = 0; i < 16; ++i) n2 += acc[0][i] * acc[0][i] + acc[1][i] * acc[1][i] + kr[i] * kr[i];
          n2 += __shfl_xor(n2, 32); n2 = wmaxf(n2);
          if (lane == 0) atomicMax(F.ctl() + CW_KMAX + ((L * 3 + 1) * 8 + b) * 8 + hk * 2, __float_as_uint(n2 * 1.02f)); }
        LAS bf16* vl = (LAS bf16*)wl;
#pragma unroll
        for (int mt = 0; mt < 2; ++mt)
#pragma unroll
            for (int i = 0; i < 16; ++i) vl[(32 * mt + crow16(i, hh)) * 40 + vpos(r)] = f2bf(acc[2 + mt][i] * rk);
        LDS_WAIT();
        { const LAS u32x4* src4 = (const LAS u32x4*)(wl + lane * 80); u32x4* dst = (u32x4*)(F.vml() + ((size_t)(b * 4 + hk) * 64 + lane) * SQ + 32 * j32);
#pragma unroll
          for (int q = 0; q < 4; ++q) dst[q] = src4[q]; }
        LDS_WAIT();
    }
}
__device__ __forceinline__ void ssd_s1_job(const Fr& F, int L, int b, int c, int h, LAS float* scr);
__device__ __forceinline__ int grab_unit(const Fr& F, unsigned* ctr) {
    volatile LAS int* slot = (volatile LAS int*)(F.lds + LDSCTL_OFF + 256);
    __syncthreads();
    if (F.tid == 0) *slot = (int)__hip_atomic_fetch_add(ctr, 1u, __ATOMIC_RELAXED, __HIP_MEMORY_SCOPE_AGENT);
    __syncthreads();
    return __builtin_amdgcn_readfirstlane(*slot);
}
__device__ __forceinline__ void prep_qk(const Fr& F, int L, int b, int j32) {
    int lane_ = F.lane; asm volatile("" : "+v"(lane_)); const int l = lane_, h = l >> 4;
    u32x2 raw[4][4];
#pragma unroll
    for (int i = 0; i < 4; ++i) { const int s = 32 * j32 + 4 * F.wave + i; const bf16* p = F.pbuf() + (size_t)bs2row(b, s) * NP + 4 * l;
        raw[i][0] = *(const u32x2*)(p + C_NA); raw[i][1] = *(const u32x2*)(p + C_NA + 256); raw[i][2] = *(const u32x2*)(p + C_DF); raw[i][3] = *(const u32x2*)(p + C_DF + 256); }
    const f32x4 gnq = *(const f32x4*)(F.na_gq() + L * 64 + 4 * (l & 15)), gnk = *(const f32x4*)(F.na_gk() + L * 64 + 4 * (l & 15));
    const f32x4 gdq = *(const f32x4*)(F.df_gq() + L * 32 + 4 * (l & 7)), gdk = *(const f32x4*)(F.df_gk() + L * 32 + 4 * (l & 7));
    float kmx_na = 0.f, kmx_df = 0.f;
#pragma unroll
    for (int i = 0; i < 4; ++i) { const int s = 32 * j32 + 4 * F.wave + i, t = s - 256; const bool lat = s >= 256;
#pragma unroll
        for (int w = 0; w < 4; ++w) {
            f32x4 x; x[0] = __uint_as_float(raw[i][w].x << 16); x[1] = __uint_as_float(raw[i][w].x & 0xffff0000u); x[2] = __uint_as_float(raw[i][w].y << 16); x[3] = __uint_as_float(raw[i][w].y & 0xffff0000u);
            float ss = (x[0] * x[0] + x[1] * x[1]) + (x[2] * x[2] + x[3] * x[3]);
            ss += dppf<0xB1>(ss); ss += dppf<0x4E>(ss); ss += dppf<0x141>(ss);
            if (w < 2) { ss += dppf<0x140>(ss);
                const float rs = rsqrtf(ss * (1.f / 64) + EPS); const f32x4 g = w == 0 ? gnq : gnk; x = x * rs * g;
                u32x2 o; o.x = pk2(x[0], x[1]); o.y = pk2(x[2], x[3]);
                if (w == 1) { float n2 = (x[0] * x[0] + x[1] * x[1]) + (x[2] * x[2] + x[3] * x[3]); n2 += dppf<0xB1>(n2); n2 += dppf<0x4E>(n2); n2 += dppf<0x141>(n2); n2 += dppf<0x140>(n2); kmx_na = fmaxf(kmx_na, n2); }
                *(u32x2*)((w == 0 ? F.qna() : F.kna()) + ((size_t)(b * 4 + h) * SQ + s) * 64 + 4 * (l & 15)) = o;
            } else {
                const float rs = rsqrtf(ss * (1.f / 32) + EPS); const f32x4 g = w == 2 ? gdq : gdk; x = x * rs * g;
                f32x4 xp; xp[0] = __shfl_xor(x[0], 4); xp[1] = __shfl_xor(x[1], 4); xp[2] = __shfl_xor(x[2], 4); xp[3] = __shfl_xor(x[3], 4);
                if (lat) { const f32x4 cs = *(const f32x4*)(F.rcos() + t * 16 + 4 * (l & 3)), sn = *(const f32x4*)(F.rsin() + t * 16 + 4 * (l & 3));
                    x = (l & 4) ? xp * sn + x * cs : x * cs - xp * sn; }
                u32x2 o; o.x = pk2(x[0], x[1]); o.y = pk2(x[2], x[3]);
                if (w == 3) { float n2 = (x[0] * x[0] + x[1] * x[1]) + (x[2] * x[2] + x[3] * x[3]); n2 += dppf<0xB1>(n2); n2 += dppf<0x4E>(n2); n2 += dppf<0x141>(n2); kmx_df = fmaxf(kmx_df, n2); }
                *(u32x2*)((w == 2 ? F.qdf() : F.kdf()) + ((size_t)(b * 4 + h) * SQ + s) * 64 + 4 * (l & 15)) = o;
            } } }
    if ((l & 15) == 0) atomicMax(F.ctl() + CW_KMAX + ((L * 3 + 0) * 8 + b) * 8 + h * 2, __float_as_uint(kmx_na * 1.02f));
    if ((l & 7) == 0) atomicMax(F.ctl() + CW_KMAX + ((L * 3 + 2) * 8 + b) * 8 + h * 2 + ((l >> 3) & 1), __float_as_uint(kmx_df * 1.02f));
}
__device__ __forceinline__ void prep_vconv(const Fr& F, int L, int b, int j32) {
    int tid_ = F.tid; asm volatile("; VCONV_BEGIN" : "+v"(tid_)); const int tid = tid_;
    const int s0 = 32 * j32; const size_t r0 = bs2row(b, s0);
    LAS bf16* Lv = (LAS bf16*)F.lds;
#ifndef VC_MASK
#define VC_MASK 7
#endif
    if (VC_MASK & 1) {   u32x4 v[4];
#pragma unroll
        for (int k = 0; k < 4; ++k) { const int idx = tid + 512 * k, mx = idx >> 10, tok = (idx >> 5) & 31, d8 = (idx & 31) * 8;
            v[k] = *(const u32x4*)(F.pbuf() + (r0 + tok) * NP + (mx ? C_DF + 512 : C_NA + 512) + d8); }
#pragma unroll
        for (int k = 0; k < 4; ++k) { const int idx = tid + 512 * k, mx = idx >> 10, tok = (idx >> 5) & 31, d8 = (idx & 31) * 8, pc = vpos(tok);
#pragma unroll
            for (int e = 0; e < 4; ++e) { Lv[(mx * 256 + d8 + 2 * e) * 40 + pc] = (bf16)(v[k][e] & 0xffffu); Lv[(mx * 256 + d8 + 2 * e + 1) * 40 + pc] = (bf16)(v[k][e] >> 16); } }
        __syncthreads();
#pragma unroll
        for (int k = 0; k < 4; ++k) { const int idx = tid + 512 * k, mx = idx >> 10, dv = (idx >> 2) & 255, pc = idx & 3;
            const u32x4 w = *(const LAS u32x4*)(Lv + (mx * 256 + dv) * 40 + pc * 8);
            *(u32x4*)((mx ? F.vdf() : F.vna()) + ((size_t)(b * 4 + (dv >> 6)) * 64 + (dv & 63)) * SQ + s0 + pc * 8) = w; }
        __syncthreads();
    }
    const bool isctx = s0 < 256; const int len = isctx ? TCTX : TLAT, t0 = isctx ? s0 : s0 - 256;
    LAS bf16* Lc = (LAS bf16*)F.lds;
    if (VC_MASK & 2) {   u32x4 v[7];
#pragma unroll
        for (int k = 0; k < 7; ++k) { const int idx = tid + 512 * k, j = idx / 96, c8 = (idx - 96 * j) * 8, tj = t0 - 2 + j; const int jc = min(max(tj, 0), len - 1) - t0;
            v[k] = (u32x4){0u, 0u, 0u, 0u};
            if (idx < 36 * 96) { v[k] = *(const u32x4*)(F.pbuf() + (size_t)((long)r0 + jc) * NP + C_XBC + c8); if (tj < 0 || tj >= len) v[k] = (u32x4){0u, 0u, 0u, 0u}; } }
#pragma unroll
        for (int k = 0; k < 7; ++k) { const int idx = tid + 512 * k, j = idx / 96, c8 = (idx - 96 * j) * 8; if (idx < 36 * 96) *(LAS u32x4*)(Lc + j * 768 + c8) = v[k]; }
    }
    __syncthreads();
    if (VC_MASK & 2)
#pragma unroll 1
    for (int pass = 0; pass < 2; ++pass) {
        const int cg = pass == 0 ? tid : 512 + tid;
        if (cg < 768) {
            float w[5];
#pragma unroll
            for (int j = 0; j < 5; ++j) w[j] = F.conv_w()[(L * 5 + j) * 768 + cg];
            const float bias = F.conv_b()[L * 768 + cg];
            const LAS bf16* lp = Lc + cg;
            float x0 = bf2f(lp[0]), x1 = bf2f(lp[768]), x2 = bf2f(lp[2 * 768]), x3 = bf2f(lp[3 * 768]);
            const int gch = cg >> 8, ch = cg & 255;
            bf16* tm = (gch == 1 ? F.btm() : F.ctm()) + ((size_t)b * SQ + s0) * 256 + ch;
            bf16* cm = (gch == 0 ? F.xT() : F.bT()) + ((size_t)b * 256 + ch) * SQ + s0;
#pragma unroll
            for (int g8 = 0; g8 < 4; ++g8) { unsigned pk[4];
#pragma unroll
                for (int e = 0; e < 8; ++e) { const int i = 8 * g8 + e; const float x4 = bf2f(lp[(i + 4) * 768]);
                    const float acc = bias + w[0] * x0 + w[1] * x1 + w[2] * x2 + w[3] * x3 + w[4] * x4; const unsigned o = f2bf(siluf(acc));
                    if (gch >= 1) tm[(size_t)i * 256] = (bf16)o;
                    if (e & 1) pk[e >> 1] |= o << 16; else pk[e >> 1] = o;
                    x0 = x1; x1 = x2; x2 = x3; x3 = x4; }
                if (gch <= 1) { u32x4 v; v.x = pk[0]; v.y = pk[1]; v.z = pk[2]; v.w = pk[3]; *(u32x4*)(cm + 8 * g8) = v; } }
        }
    }
    if ((VC_MASK & 4) && tid < 256) { const int tok = tid >> 3, i = tid & 7; const float raw = bf2f(F.pbuf()[(r0 + tok) * NP + C_DT + i]) + F.dt_bias()[L * 8 + i]; const float ex = __expf(raw);
      F.dtv()[((size_t)b * 8 + i) * SQ + s0 + tok] = raw > 20.f ? raw : (ex < 0.03f ? ex * (1.f - ex * (0.5f - ex * (0.33333334f - 0.25f * ex))) : __logf(1.f + ex)); }
    __syncthreads();
    asm volatile("; VCONV_END" ::: "memory");
}
__device__ __forceinline__ void phase_prep(const Fr& F0_, int L) {
    unsigned* ctr = F0_.ctl() + CW_QUEUE + (L * 16 + 0) * 64;
    for (;;) {
        const int u = grab_unit(F0_, ctr); if (u >= NB * 72) break;
        const int b = u / 72, j32 = u - 72 * b;
        { const Fr F = refresh(F0_); prep_qk(F, L, b, j32); }
        { const Fr F = refresh(F0_); mla_prep_block(F, L, b, j32); }
        __syncthreads();
    }
    { unsigned* ctr2 = F0_.ctl() + CW_QUEUE + (L * 16 + 2) * 64;
      for (;;) { const int u = grab_unit(F0_, ctr2); if (u >= NB * 36) break; { const Fr F3 = refresh(F0_); prep_tile(F3, L, u / 36, u % 36); }
          asm volatile("s_waitcnt vmcnt(0)" ::: "memory"); __syncthreads();
          { const Fr F4 = refresh(F0_); if (F4.wave < 4) ssd_s1_job(F4, L, u / 36, u % 36, F4.wave, (LAS float*)(F4.lds + F4.wave * 16384)); } } }
}

__device__ __forceinline__ void phase_ssd_naive(const Fr& F, int L) {
    if (F.wave != 0 || blockIdx.x >= 64) return;
    const int w = blockIdx.x, b = w >> 3, d = (w >> 2) & 1, h = w & 3, g = h >> 1, p = F.lane;
    const float a = -expf(F.a_log()[L * 8 + d * 4 + h]);
    float hs[128];
#pragma unroll
    for (int n = 0; n < 128; ++n) hs[n] = 0.f;
    const float* dtp = F.dtv() + ((size_t)b * 8 + d * 4 + h) * SQ;
    const bf16* xp = F.xT() + ((size_t)b * 256 + h * 64 + p) * SQ;
    for (int step = 0; step < SQ; ++step) {
        const int s = d == 0 ? step : (step < 256 ? 255 - step : SQ - 1 - (step - 256));
        const float dtv = dtp[s], dA = __expf(dtv * a), xv = bf2f(xp[s]) * dtv;
        const u32x4* Bp = (const u32x4*)(F.btm() + ((size_t)b * SQ + s) * 256 + g * 128);
        const u32x4* Cp = (const u32x4*)(F.ctm() + ((size_t)b * SQ + s) * 256 + g * 128);
        float y = 0.f;
#pragma unroll
        for (int n8 = 0; n8 < 16; ++n8) { const u32x4 bv = Bp[n8], cv = Cp[n8];
#pragma unroll
            for (int j = 0; j < 4; ++j) { const int n = n8 * 8 + 2 * j;
                hs[n] = hs[n] * dA + xv * __uint_as_float(bv[j] << 16); hs[n + 1] = hs[n + 1] * dA + xv * __uint_as_float(bv[j] & 0xffff0000u);
                y += __uint_as_float(cv[j] << 16) * hs[n] + __uint_as_float(cv[j] & 0xffff0000u) * hs[n + 1]; } }
        F.ydir()[((size_t)d * NROW + bs2row(b, s)) * 256 + h * 64 + p] = y;
    }
}

template <int KIND>
__device__ __forceinline__ void naive_attn_job(const Fr& F, int L, int r, int h, LAS float* scr) {
    constexpr int DQ = KIND == 1 ? 96 : (KIND == 0 ? 64 : 32), QS = KIND == 1 ? 96 : 64;
    const int lane = F.lane; int b, s; row2bs(r, b, s); const bool lat = r < NLAT; const int t = s - 256;
    const bf16* Qb = (KIND == 0 ? F.qna() : KIND == 1 ? F.qml() : F.qdf()) + ((size_t)(b * 4 + h) * SQ + s) * QS;
    const bf16* Kb = (KIND == 0 ? F.kna() : KIND == 1 ? F.kml() : F.kdf()) + (size_t)(b * 4 + h) * SQ * QS;
    const bf16* Vt = (KIND == 0 ? F.vna() : KIND == 1 ? F.vml() : F.vdf()) + ((size_t)(b * 4 + h) * 64 + lane) * SQ;
    const float scale = KIND == 1 ? 0.10206207261596577f : (KIND == 0 ? 0.125f : 0.17677669529663687f);
    const int qr = t >> 6, qc = t & 63, row_lo = min(max(qr - 4, 0), 24), col_lo = min(max(qc - 8, 0), 48);
    const bool nb = (KIND == 0) && lat;
    const int nk = lat ? (KIND == 0 ? 768 : SQ) : 256;
    const int koff = nb ? row_lo * 64 : 0;
    float oc[2] = {0.f, 0.f};
#pragma unroll
    for (int comp = 0; comp < (KIND == 2 ? 2 : 1); ++comp) {
        for (int i = lane; i < DQ; i += 64) scr[i] = bf2f(Qb[comp * 32 + i]);
        LDS_WAIT();
        float m = -INFINITY;
        for (int kk = lane; kk < nk; kk += 64) {
            const int sk = kk < 256 ? kk : kk + koff; float bias = 0.f; bool valid = true;
            if (nb && kk >= 256) { const int w = kk - 256, kr = w >> 6, kc = w & 63; valid = kc >= col_lo && kc < col_lo + 16;
                const int ro = row_lo + kr - qr + 7, co = min(max(kc - qc, -15), 15) + 15; bias = F.na_rb()[((L * 4 + h) * 15 + ro) * 31 + co]; }
            const u32x4* kp = (const u32x4*)(Kb + (size_t)sk * QS + (KIND == 2 ? comp * 32 : 0));
            float dot = 0.f;
#pragma unroll
            for (int i8 = 0; i8 < DQ / 8; ++i8) { const u32x4 kv = kp[i8];
#pragma unroll
                for (int j = 0; j < 4; ++j) dot += scr[i8 * 8 + 2 * j] * __uint_as_float(kv[j] << 16) + scr[i8 * 8 + 2 * j + 1] * __uint_as_float(kv[j] & 0xffff0000u); }
            const float sc = valid ? dot * scale + bias : -INFINITY;
            scr[128 + kk] = sc; m = fmaxf(m, sc);
        }
        m = wmaxf(m);
        float sum = 0.f;
        for (int kk = lane; kk < nk; kk += 64) { const float pv = __expf(scr[128 + kk] - m); scr[128 + kk] = pv; sum += pv; }
        sum = wsum(sum);
        LDS_WAIT();
        float o = 0.f;
        for (int kb = 0; kb < nk; kb += 8) {
            const int sb = kb < 256 ? kb : kb + koff;
            const u32x4 vv = *(const u32x4*)(Vt + sb);
#pragma unroll
            for (int j = 0; j < 8; ++j) { const int kk = (kb & ~15) + vpos((kb & 15) + j); const unsigned wv = vv[j >> 1];
                o += scr[128 + kk] * ((j & 1) ? __uint_as_float(wv & 0xffff0000u) : __uint_as_float(wv << 16)); }
        }
        oc[comp] = o / sum;
        LDS_WAIT();
    }
    bf16* mo = F.mix() + (size_t)r * DM + (KIND == 0 ? 0 : KIND == 1 ? 256 : 512) + h * 64 + lane;
    if (KIND == 2) {
        const float* lv = F.df_lam() + L * 128; const float li = 0.8f - 0.6f * expf(-0.3f * (float)L);
        float d1 = 0.f, d2 = 0.f;
#pragma unroll
        for (int i = 0; i < 32; ++i) { d1 += lv[i] * lv[32 + i]; d2 += lv[64 + i] * lv[96 + i]; }
        const float lam = expf(d1) - expf(d2) + li;
        const float o = oc[0] - lam * oc[1];
        const float rs = rsqrtf(wsum(o * o) * (1.f / 64) + EPS);
        *mo = f2bf(o * rs * F.df_gsub()[L * 64 + lane] * (1.f - li));
    } else *mo = f2bf(oc[0]);
}
__device__ __forceinline__ void phase_mix_naive(const Fr& F, int L) {
    LAS float* scr = (LAS float*)(F.lds + F.wave * 16384);
    const int nrows = (L == DEPTH - 1) ? NLAT : NROW;
    for (int j = F.gw; j < nrows * 4; j += F.NGW) naive_attn_job<2>(F, L, j >> 2, j & 3, scr);
    for (int j = F.gw; j < nrows * 4; j += F.NGW) naive_attn_job<1>(F, L, j >> 2, j & 3, scr);
    for (int j = F.gw; j < nrows * 4; j += F.NGW) naive_attn_job<0>(F, L, j >> 2, j & 3, scr);
    for (int r = F.gw; r < nrows; r += F.NGW) {
        int b, s; row2bs(r, b, s); const int h = F.lane >> 4; const float dsk = F.ssd_d()[L * 8 + h] + F.ssd_d()[L * 8 + 4 + h];
        float y[4]; float ss = 0.f;
#pragma unroll
        for (int j = 0; j < 4; ++j) { const int ch = F.lane * 4 + j; const float xv = bf2f(F.xT()[((size_t)b * 256 + ch) * SQ + s]);
            const float z = bf2f(F.pbuf()[(size_t)r * NP + C_Z + ch]);
            y[j] = (F.ydir()[(size_t)r * 256 + ch] + F.ydir()[((size_t)NROW + r) * 256 + ch] + dsk * xv) * siluf(z); ss += y[j] * y[j]; }
        const float rs = rsqrtf(wsum(ss) * (1.f / 256) + EPS);
#pragma unroll
        for (int j = 0; j < 4; ++j) { const int ch = F.lane * 4 + j; F.mix()[(size_t)r * DM + 768 + ch] = f2bf(y[j] * rs * F.ssd_gn()[L * 256 + ch]); }
    }
}

template <int S8> __device__ __forceinline__ bf16x8 pack_step(const f32x16& x) {
    u32x4 p;
    asm volatile("v_cvt_pk_bf16_f32 %0, %4, %5\n\tv_cvt_pk_bf16_f32 %1, %6, %7\n\tv_cvt_pk_bf16_f32 %2, %8, %9\n\tv_cvt_pk_bf16_f32 %3, %10, %11\n\ts_nop 1"
                 : "=&v"(p[0]), "=&v"(p[1]), "=&v"(p[2]), "=&v"(p[3])
                 : "v"(x[S8]), "v"(x[S8 + 1]), "v"(x[S8 + 2]), "v"(x[S8 + 3]), "v"(x[S8 + 4]), "v"(x[S8 + 5]), "v"(x[S8 + 6]), "v"(x[S8 + 7]));
    return __builtin_bit_cast(bf16x8, p);
}
constexpr float LOG2E = 1.4426950408889634f;
template <int KIND>
__device__ __forceinline__ void attn_unit(const Fr& F, int L, int b, int h, int qb) {
    constexpr int QS = KIND == 1 ? 96 : 64, NKS = KIND == 1 ? 6 : (KIND == 0 ? 4 : 2);
    constexpr int PK = QS * 2 + 16, PV = 272, KBYTES = 128 * PK, VBYTES = 64 * PV, NKP = QS == 96 ? 3 : 2, PPR = QS / 8;
    LAS unsigned char* const Kl = F.lds; LAS unsigned char* const Vl = F.lds + 2 * KBYTES;
    LAS float* const biasl = (LAS float*)(F.lds + 2 * KBYTES + 2 * VBYTES);
    const int lane = F.lane, wave = F.wave, tid = F.tid, r = lane & 31, hh = lane >> 5;
    const bool isctx = qb < 0;
    const int comp = KIND == 2 ? (wave & 1) : 0, qg = KIND == 2 ? (wave >> 1) : wave;
    const bf16* Qg = (KIND == 0 ? F.qna() : KIND == 1 ? F.qml() : F.qdf()) + (size_t)(b * 4 + h) * SQ * QS;
    const bf16* Kg = (KIND == 0 ? F.kna() : KIND == 1 ? F.kml() : F.kdf()) + (size_t)(b * 4 + h) * SQ * QS;
    const bf16* Vg = (KIND == 0 ? F.vna() : KIND == 1 ? F.vml() : F.vdf()) + (size_t)(b * 4 + h) * 64 * SQ;
    const float cs = (KIND == 1 ? 0.10206207261596577f : (KIND == 0 ? 0.125f : 0.17677669529663687f)) * LOG2E;
    int sq, qrow = 0, qcol = 0;
    if (KIND == 2) sq = (isctx ? 128 * (-qb - 1) : 256 + 128 * qb) + 32 * qg + r;
    else if (isctx) sq = 32 * wave + r; else if (KIND == 0) { qrow = 4 * qb + (wave >> 1); qcol = 32 * (wave & 1) + r; sq = 256 + 64 * qrow + qcol; } else sq = 256 + 256 * qb + 32 * wave + r;
    int nt = 36, lo_u = 0;
    if (isctx) nt = 4; else if (KIND == 0) { lo_u = min(max(4 * qb - 4, 0), 24); nt = 4 + min(max(4 * qb - 1, 0), 24) + 8 - lo_u; }
    const int np = (nt + 1) >> 1;
    const int my_lo = min(max(qrow - 4, 0), 24), col_lo = min(max(qcol - 8, 0), 48);
    if (KIND == 0 && !isctx) for (int i = tid; i < 465; i += 512) biasl[i] = F.na_rb()[(L * 4 + h) * 465 + i] * LOG2E;
    bf16x8 Q[NKS];
    { const bf16* qp = Qg + (size_t)sq * QS + comp * 32 + 8 * hh;
#pragma unroll
      for (int kk = 0; kk < NKS; ++kk) Q[kk] = *(const bf16x8*)(qp + 16 * kk); }
    f32x16 O[2]; float l = 0.f;
#pragma unroll
    for (int mt = 0; mt < 2; ++mt)
#pragma unroll
        for (int i = 0; i < 16; ++i) O[mt][i] = 0.f;
    float m;
    {   float q2 = 0.f;
#pragma unroll
        for (int kk = 0; kk < NKS; ++kk)
#pragma unroll
            for (int j = 0; j < 8; ++j) { const float v = bf2f((bf16)Q[kk][j]); q2 += v * v; }
        q2 += __shfl_xor(q2, 32);
        const float k2 = __uint_as_float(__hip_atomic_load(F.ctl() + CW_KMAX + ((L * 3 + KIND) * 8 + b) * 8 + h * 2 + comp, __ATOMIC_RELAXED, __HIP_MEMORY_SCOPE_AGENT));
        m = sqrtf(q2 * k2) * cs;
        if (KIND == 0 && !isctx) m += (F.rcos() + 2 * TLAT * 16)[L * 4 + h];
    }
    u32x4 rk_0[NKP], rv_0[2];
#define AT_SK0(t) ((isctx || KIND != 0) ? 64 * (t) : ((t) < 4 ? 64 * (t) : 256 + 64 * (lo_u + (t) - 4)))
#define AT_LOAD(p, S_) do { const int sk0_ = AT_SK0(2 * (p)); const char* kg_ = (const char*)(Kg + (size_t)sk0_ * QS); \
        _Pragma("unroll") for (int i_ = 0; i_ < NKP; ++i_) rk_##S_[i_] = *(const u32x4*)(kg_ + (tid + 512 * i_) * 16); \
        _Pragma("unroll") for (int i_ = 0; i_ < 2; ++i_) { const int pi_ = tid + 512 * i_; rv_##S_[i_] = *(const u32x4*)(Vg + (size_t)(pi_ >> 4) * SQ + sk0_ + (pi_ & 15) * 8); } } while (0)
#define AT_STORE(buf, S_) do { \
        _Pragma("unroll") for (int i_ = 0; i_ < NKP; ++i_) { const int pi_ = tid + 512 * i_; *(LAS u32x4*)(Kl + (buf) * KBYTES + (pi_ / PPR) * PK + (pi_ % PPR) * 16) = rk_##S_[i_]; } \
        _Pragma("unroll") for (int i_ = 0; i_ < 2; ++i_) { const int pi_ = tid + 512 * i_; *(LAS u32x4*)(Vl + (buf) * VBYTES + (pi_ >> 4) * PV + (pi_ & 15) * 16) = rv_##S_[i_]; } } while (0)
#define AT_QK(SA, SB, kb_) do { \
        _Pragma("unroll") for (int i = 0; i < 16; ++i) { SA[i] = 0.f; SB[i] = 0.f; } \
        _Pragma("unroll") for (int kk = 0; kk < NKS; ++kk) { const bf16x8 a0 = *(const LAS bf16x8*)((kb_) + 32 * kk), a1 = *(const LAS bf16x8*)((kb_) + 32 * PK + 32 * kk); \
            SA = MFMA32(a0, Q[kk], SA); SB = MFMA32(a1, Q[kk], SB); } } while (0)
#define AT_SMPV(S0, S1, t_, vb_) do { \
        const int krow = lo_u + (t_) - 4; const bool nbt = (KIND == 0) && !isctx && (t_) >= 4; \
        float ps = 0.f; \
        if (nbt) { const int drow = (krow - qrow + 7) * 31 - qcol + 15; const float nm = -m; \
            _Pragma("unroll") for (int i = 0; i < 16; ++i) { const int kc = (i & 3) + 8 * (i >> 2) + 4 * hh; \
                { const bool v = (unsigned)(kc - col_lo) < 16u; const float bb = biasl[v ? drow + kc : 0]; S0[i] = v ? __builtin_amdgcn_exp2f(__builtin_fmaf(S0[i], cs, bb + nm)) : 0.f; } \
                { const bool v = (unsigned)(kc + 32 - col_lo) < 16u; const float bb = biasl[v ? drow + kc + 32 : 0]; S1[i] = v ? __builtin_amdgcn_exp2f(__builtin_fmaf(S1[i], cs, bb + nm)) : 0.f; } \
                ps += S0[i] + S1[i]; } \
        } else { const float nm = -m; \
            _Pragma("unroll") for (int i = 0; i < 16; ++i) { S0[i] = __builtin_amdgcn_exp2f(__builtin_fmaf(S0[i], cs, nm)); S1[i] = __builtin_amdgcn_exp2f(__builtin_fmaf(S1[i], cs, nm)); } \
            const f32x16 T_ = S0 + S1; \
            ps = (((T_[0] + T_[1]) + (T_[2] + T_[3])) + ((T_[4] + T_[5]) + (T_[6] + T_[7]))) + (((T_[8] + T_[9]) + (T_[10] + T_[11])) + ((T_[12] + T_[13]) + (T_[14] + T_[15]))); } \
        l += ps; \
        const bf16x8 p00 = pack_step<0>(S0), p01 = pack_step<8>(S0), p10 = pack_step<0>(S1), p11 = pack_step<8>(S1); \
        _Pragma("unroll") for (int mt = 0; mt < 2; ++mt) { \
            const LAS unsigned char* vb = (vb_) + mt * 32 * PV; \
            O[mt] = MFMA32(*(const LAS bf16x8*)(vb + 0), p00, O[mt]); O[mt] = MFMA32(*(const LAS bf16x8*)(vb + 32), p01, O[mt]); \
            O[mt] = MFMA32(*(const LAS bf16x8*)(vb + 64), p10, O[mt]); O[mt] = MFMA32(*(const LAS bf16x8*)(vb + 96), p11, O[mt]); } } while (0)
#define AT_COMPUTE(p_, buf_) do { \
        const int t0_ = 2 * (p_), t1_ = t0_ + 1; \
        const bool g0_ = (KIND != 0) || isctx || t0_ < 4 || (lo_u + t0_ - 4 >= my_lo && lo_u + t0_ - 4 < my_lo + 8); \
        const bool g1_ = (t1_ < nt) && ((KIND != 0) || isctx || t1_ < 4 || (lo_u + t1_ - 4 >= my_lo && lo_u + t1_ - 4 < my_lo + 8)); \
        const LAS unsigned char* Kb = Kl + (buf_) * KBYTES + r * PK + (comp * 32 + 8 * hh) * 2; const LAS unsigned char* Vb = Vl + (buf_) * VBYTES + r * PV + 16 * hh; \
        if (KIND == 0) { f32x16 S00, S01; \
            if (g0_) { AT_QK(S00, S01, Kb); AT_SMPV(S00, S01, t0_, Vb); } \
            if (g1_) { AT_QK(S00, S01, Kb + 64 * PK); AT_SMPV(S00, S01, t1_, Vb + 128); } \
        } else { f32x16 S00, S01, S10, S11; \
            __builtin_amdgcn_iglp_opt(0); \
            AT_QK(S00, S01, Kb); \
            AT_QK(S10, S11, Kb + 64 * PK); \
            AT_SMPV(S00, S01, t0_, Vb); \
            AT_SMPV(S10, S11, t1_, Vb + 128); } } while (0)
    AT_LOAD(0, 0);
    AT_STORE(0, 0);
    __syncthreads();
    for (int p = 0; p < np; ++p) {
        const int buf = p & 1;
        if (p + 1 < np) AT_LOAD(p + 1, 0);
        AT_COMPUTE(p, buf);
        if (p + 1 < np) AT_STORE(buf ^ 1, 0);
        __syncthreads();
    }
#undef AT_COMPUTE
#undef AT_SMPV
#undef AT_QK
#undef AT_SK0
#undef AT_LOAD
#undef AT_STORE
    const float inv = 1.f / (l + __shfl_xor(l, 32));
    bf16* mo = F.mix() + (size_t)bs2row(b, sq) * DM + (KIND == 0 ? 0 : KIND == 1 ? 256 : 512) + h * 64 + 4 * hh;
    if (KIND == 2) {
        LAS float* xo = (LAS float*)F.lds + qg * 2048;
        if (comp == 1) {
#pragma unroll
            for (int mt = 0; mt < 2; ++mt)
#pragma unroll
                for (int i = 0; i < 16; ++i) xo[(mt * 16 + i) * 64 + lane] = O[mt][i] * inv; }
        __syncthreads();
        if (comp == 0) {
            const float* lv = F.df_lam() + L * 128; const float li = 0.8f - 0.6f * expf(-0.3f * (float)L);
            float d1 = 0.f, d2 = 0.f;
#pragma unroll
            for (int i = 0; i < 32; ++i) { d1 += lv[i] * lv[32 + i]; d2 += lv[64 + i] * lv[96 + i]; }
            const float lam = expf(d1) - expf(d2) + li;
            float ss = 0.f;
#pragma unroll
            for (int mt = 0; mt < 2; ++mt)
#pragma unroll
                for (int i = 0; i < 16; ++i) { const float o = O[mt][i] * inv - lam * xo[(mt * 16 + i) * 64 + lane]; O[mt][i] = o; ss += o * o; }
            ss += __shfl_xor(ss, 32);
            const float rs = rsqrtf(ss * (1.f / 64) + EPS) * (1.f - li);
#pragma unroll
            for (int mt = 0; mt < 2; ++mt)
#pragma unroll
                for (int g = 0; g < 4; ++g) { const f32x4 gs = *(const f32x4*)(F.df_gsub() + L * 64 + 32 * mt + 8 * g + 4 * hh);
                    u32x2 w; w.x = pk2(O[mt][4 * g] * rs * gs[0], O[mt][4 * g + 1] * rs * gs[1]); w.y = pk2(O[mt][4 * g + 2] * rs * gs[2], O[mt][4 * g + 3] * rs * gs[3]);
                    *(u32x2*)(mo + 32 * mt + 8 * g) = w; }
        }
        __syncthreads();
    } else {
#pragma unroll
        for (int mt = 0; mt < 2; ++mt)
#pragma unroll
            for (int g = 0; g < 4; ++g) { u32x2 w; w.x = pk2(O[mt][4 * g] * inv, O[mt][4 * g + 1] * inv); w.y = pk2(O[mt][4 * g + 2] * inv, O[mt][4 * g + 3] * inv);
                *(u32x2*)(mo + 32 * mt + 8 * g) = w; }
    }
}
__device__ __forceinline__ float ssd_cum(const Fr& F, int L, int b, int h, int d, int s0, float& dt, float& cum) {
    const int lane = F.lane;
    dt = F.dtv()[((size_t)b * 8 + d * 4 + h) * SQ + s0 + lane];
    const float la = dt * -__expf(F.a_log()[L * 8 + d * 4 + h]);
    float v = la;
#pragma unroll
    for (int o = 1; o < 64; o <<= 1) { const float t = __shfl_up(v, o); if (lane >= o) v += t; }
    const float total = __shfl(v, 63);
    cum = d == 0 ? v : total - v + la;
    return total;
}
__device__ __forceinline__ void ssd_s1_job(const Fr& F, int L, int b, int c, int h, LAS float* scr) {
    const int lane = F.lane, r = lane & 31, hh = lane >> 5, s0 = 64 * c, g = h >> 1;
#pragma unroll
    for (int d = 0; d < 2; ++d) { float dt, cum; const float tot = ssd_cum(F, L, b, h, d, s0, dt, cum); scr[d * 64 + lane] = dt * __expf(tot - cum);
        if (lane == 0) F.cdec()[((b * 2 + d) * 4 + h) * 36 + c] = __expf(tot); }
    LDS_WAIT();
    bf16x8 A[2][2][4];
#pragma unroll
    for (int mt = 0; mt < 2; ++mt)
#pragma unroll
        for (int kk = 0; kk < 4; ++kk) { const bf16x8 raw = *(const bf16x8*)(F.xT() + ((size_t)b * 256 + h * 64 + 32 * mt + r) * SQ + s0 + 16 * kk + 8 * hh);
#pragma unroll
            for (int d = 0; d < 2; ++d) { u32x4 o;
#pragma unroll
                for (int j = 0; j < 4; ++j) { const float w0 = scr[d * 64 + 16 * kk + 8 * hh + 2 * j], w1 = scr[d * 64 + 16 * kk + 8 * hh + 2 * j + 1];
                    o[j] = pk2(bf2f((bf16)raw[2 * j]) * w0, bf2f((bf16)raw[2 * j + 1]) * w1); }
                A[d][mt][kk] = __builtin_bit_cast(bf16x8, o); } }
#pragma unroll
    for (int nt = 0; nt < 4; ++nt) {
        bf16x8 Bf[4];
#pragma unroll
        for (int kk = 0; kk < 4; ++kk) Bf[kk] = *(const bf16x8*)(F.bT() + ((size_t)b * 256 + g * 128 + 32 * nt + r) * SQ + s0 + 16 * kk + 8 * hh);
#pragma unroll
        for (int d = 0; d < 2; ++d)
#pragma unroll
            for (int mt = 0; mt < 2; ++mt) { f32x16 acc;
#pragma unroll
                for (int i = 0; i < 16; ++i) acc[i] = 0.f;
#pragma unroll
                for (int kk = 0; kk < 4; ++kk) acc = MFMA32(A[d][mt][kk], Bf[kk], acc);
                float* dst = F.cst() + ((((size_t)(b * 2 + d) * 4 + h) * 36 + c) * 64 + 32 * mt) * 128 + 32 * nt + r;
#pragma unroll
                for (int i = 0; i < 16; ++i) dst[crow16(i, hh) * 128] = acc[i]; }
    }
    LDS_WAIT();
}
__device__ __forceinline__ void phase_ssd_s1(const Fr& F, int L) {
    LAS float* scr = (LAS float*)(F.lds + F.wave * 16384);
    for (int j = F.gw; j < NB * 36 * 4; j += F.NGW) ssd_s1_job(F, L, j / 144, (j / 4) % 36, j & 3, scr);
}
__device__ __forceinline__ void phase_ssd_scan(const Fr& F, int L) {
    for (int e4 = blockIdx.x * 512 + F.tid; e4 < NB * 2 * 4 * 2048; e4 += F.G * 512) {
        const int bdh = e4 >> 11, pn = (e4 & 2047) * 4, d = (bdh >> 2) & 1;
        f32x4 hst = (f32x4){0.f, 0.f, 0.f, 0.f};
        const float* cs_ = F.cst() + (size_t)bdh * 36 * 8192 + pn; bf16* he_ = F.hent() + (size_t)bdh * 36 * 8192 + pn; const float* cd_ = F.cdec() + bdh * 36;
#pragma unroll 1
        for (int s6 = 0; s6 < 36; s6 += 6) {
            f32x4 v[6]; float dc[6]; int cc[6];
#pragma unroll
            for (int j = 0; j < 6; ++j) { const int step = s6 + j; cc[j] = d == 0 ? step : (step < 4 ? 3 - step : 39 - step); v[j] = *(const f32x4*)(cs_ + (size_t)cc[j] * 8192); dc[j] = cd_[cc[j]]; }
#pragma unroll
            for (int j = 0; j < 6; ++j) { u32x2 o; o.x = pk2(hst[0], hst[1]); o.y = pk2(hst[2], hst[3]); *(u32x2*)(he_ + (size_t)cc[j] * 8192) = o; hst = hst * dc[j] + v[j]; }
        }
    }
}
__device__ __forceinline__ void ssd_s3_unit(const Fr& F, int L, int b, int c) {
    const int lane = F.lane, wave = F.wave, r = lane & 31, hh = lane >> 5, s0 = 64 * c, h = wave >> 1, it = wave & 1, g = h >> 1, itok = 32 * it + r;
    LAS float* scr = (LAS float*)(F.lds + wave * 16384);
    LAS float* red = (LAS float*)(F.lds + 8192);
#pragma unroll
    for (int d = 0; d < 2; ++d) { float dt, cum; (void)ssd_cum(F, L, b, h, d, s0, dt, cum); scr[d * 128 + lane] = cum; scr[d * 128 + 64 + lane] = dt; }
    LDS_WAIT();
    bf16x8 Cf[8];
#pragma unroll
    for (int kk = 0; kk < 8; ++kk) Cf[kk] = *(const bf16x8*)(F.ctm() + ((size_t)b * SQ + s0 + itok) * 256 + g * 128 + 16 * kk + 8 * hh);
    f32x16 G[2];
#pragma unroll
    for (int jt = 0; jt < 2; ++jt) {
#pragma unroll
        for (int i = 0; i < 16; ++i) G[jt][i] = 0.f;
#pragma unroll
        for (int kk = 0; kk < 8; ++kk) { const bf16x8 bf = *(const bf16x8*)(F.btm() + ((size_t)b * SQ + s0 + 32 * jt + r) * 256 + g * 128 + 16 * kk + 8 * hh); G[jt] = MFMA32(bf, Cf[kk], G[jt]); } }
    bf16x8 X[2][4];
#pragma unroll
    for (int mt = 0; mt < 2; ++mt)
#pragma unroll
        for (int ks = 0; ks < 4; ++ks) { const bf16* xp = F.xT() + ((size_t)b * 256 + h * 64 + 32 * mt + r) * SQ + s0 + 16 * ks + 4 * hh;
            const u32x2 lo = *(const u32x2*)xp, hi = *(const u32x2*)(xp + 8); u32x4 o; o.x = lo.x; o.y = lo.y; o.z = hi.x; o.w = hi.y; X[mt][ks] = __builtin_bit_cast(bf16x8, o); }
    f32x16 Y[2];
#pragma unroll
    for (int mt = 0; mt < 2; ++mt)
#pragma unroll
        for (int i = 0; i < 16; ++i) Y[mt][i] = 0.f;
    const float Dsum = F.ssd_d()[L * 8 + h] + F.ssd_d()[L * 8 + 4 + h];
#pragma unroll 1
    for (int d = 0; d < 2; ++d) {
        const float cum_i = scr[d * 128 + itok];
        f32x16 Pm[2];
#pragma unroll
        for (int jt = 0; jt < 2; ++jt)
#pragma unroll
            for (int i = 0; i < 16; ++i) { const int j = 32 * jt + crow16(i, hh); const bool valid = d == 0 ? (j <= itok) : (j >= itok);
                const float arg = valid ? cum_i - scr[d * 128 + j] : -INFINITY;
                float pv = G[jt][i] * __expf(arg) * scr[d * 128 + 64 + j];
                if (d == 0 && j == itok) pv += Dsum;
                Pm[jt][i] = pv; }
        const bf16x8 p0 = pack_step<0>(Pm[0]), p1 = pack_step<8>(Pm[0]), p2 = pack_step<0>(Pm[1]), p3 = pack_step<8>(Pm[1]);
#pragma unroll
        for (int mt = 0; mt < 2; ++mt) { Y[mt] = MFMA32(X[mt][0], p0, Y[mt]); Y[mt] = MFMA32(X[mt][1], p1, Y[mt]); Y[mt] = MFMA32(X[mt][2], p2, Y[mt]); Y[mt] = MFMA32(X[mt][3], p3, Y[mt]); }
        const float ei = __expf(cum_i);
#pragma unroll
        for (int mt = 0; mt < 2; ++mt) { f32x16 T;
#pragma unroll
            for (int i = 0; i < 16; ++i) T[i] = 0.f;
#pragma unroll
            for (int kk = 0; kk < 8; ++kk) { const bf16x8 hf = *(const bf16x8*)(F.hent() + ((((size_t)(b * 2 + d) * 4 + h) * 36 + c) * 64 + 32 * mt + r) * 128 + 16 * kk + 8 * hh); T = MFMA32(hf, Cf[kk], T); }
#pragma unroll
            for (int i = 0; i < 16; ++i) Y[mt][i] += ei * T[i]; }
    }
    const size_t row = bs2row(b, s0 + itok);
    const bf16* zp = F.pbuf() + row * NP + C_Z + h * 64 + 4 * hh;
    float ss = 0.f;
#pragma unroll
    for (int mt = 0; mt < 2; ++mt)
#pragma unroll
        for (int gq = 0; gq < 4; ++gq) { const u32x2 z4 = *(const u32x2*)(zp + 32 * mt + 8 * gq);
            const float z0 = __uint_as_float(z4.x << 16), z1 = __uint_as_float(z4.x & 0xffff0000u), z2 = __uint_as_float(z4.y << 16), z3 = __uint_as_float(z4.y & 0xffff0000u);
            Y[mt][4 * gq] *= siluf(z0); Y[mt][4 * gq + 1] *= siluf(z1); Y[mt][4 * gq + 2] *= siluf(z2); Y[mt][4 * gq + 3] *= siluf(z3);
            ss += (Y[mt][4 * gq] * Y[mt][4 * gq] + Y[mt][4 * gq + 1] * Y[mt][4 * gq + 1]) + (Y[mt][4 * gq + 2] * Y[mt][4 * gq + 2] + Y[mt][4 * gq + 3] * Y[mt][4 * gq + 3]); }
    ss += __shfl_xor(ss, 32);
    if (hh == 0) red[(it * 4 + h) * 32 + r] = ss;
    __syncthreads();
    const float tot = (red[(it * 4 + 0) * 32 + r] + red[(it * 4 + 1) * 32 + r]) + (red[(it * 4 + 2) * 32 + r] + red[(it * 4 + 3) * 32 + r]);
    const float rs = rsqrtf(tot * (1.f / 256) + EPS);
    bf16* mo = F.mix() + row * DM + 768 + h * 64 + 4 * hh;
#pragma unroll
    for (int mt = 0; mt < 2; ++mt)
#pragma unroll
        for (int gq = 0; gq < 4; ++gq) { const f32x4 gn = *(const f32x4*)(F.ssd_gn() + L * 256 + h * 64 + 32 * mt + 8 * gq + 4 * hh);
            u32x2 w; w.x = pk2(Y[mt][4 * gq] * rs * gn[0], Y[mt][4 * gq + 1] * rs * gn[1]); w.y = pk2(Y[mt][4 * gq + 2] * rs * gn[2], Y[mt][4 * gq + 3] * rs * gn[3]);
            *(u32x2*)(mo + 32 * mt + 8 * gq) = w; }
    __syncthreads();
}
template <int KIND> __device__ __forceinline__ void attn_units(const Fr& F, int L) {
    if (KIND == 2) { const int nu = (L == DEPTH - 1) ? 512 : 576;
        for (int u = F.vcu; u < nu; u += F.G) { if (u < 512) attn_unit<2>(F, L, u >> 6, (u >> 4) & 3, u & 15); else attn_unit<2>(F, L, (u - 512) >> 3, ((u - 512) >> 1) & 3, -1 - (u & 1)); }
    } else { const int nu = (L == DEPTH - 1) ? 256 : 288;
        for (int u = F.vcu; u < nu; u += F.G) { if (u < 256) attn_unit<KIND>(F, L, u >> 5, (u >> 3) & 3, u & 7); else attn_unit<KIND>(F, L, (u - 256) >> 2, (u - 256) & 3, -1); } }
}
__device__ __forceinline__ void phase_mix_fast(const Fr& F, int L) {
#ifndef ATT_MASK
#define ATT_MASK 15
#endif
#ifndef ATT_DUP
#define ATT_DUP 0
#endif
#ifndef ATT_MASK
#define ATT_MASK 15
#endif
    if (ATT_MASK & 4) for (int rp = 0; rp < ((ATT_DUP & 4) ? 2 : 1); ++rp) { const Fr Fa = refresh(F); attn_units<2>(Fa, L); }
    if (ATT_MASK & 2) for (int rp = 0; rp < ((ATT_DUP & 2) ? 2 : 1); ++rp) { const Fr Fa = refresh(F); attn_units<1>(Fa, L); }
    if (ATT_MASK & 1) for (int rp = 0; rp < ((ATT_DUP & 1) ? 2 : 1); ++rp) { const Fr Fa = refresh(F); attn_units<0>(Fa, L); }
    const int c0 = (L == DEPTH - 1) ? 4 : 0;
    if (ATT_MASK & 8) { const Fr Fa = refresh(F); unsigned* ctr = Fa.ctl() + CW_QUEUE + (L * 16 + 1) * 64;
        for (;;) { const int u = grab_unit(Fa, ctr); if (u >= NB * (36 - c0)) break; ssd_s3_unit(Fa, L, u / (36 - c0), c0 + u % (36 - c0)); } }
}

__device__ __forceinline__ void phase_route(const Fr& F, int L, bool commit = true) {
    const int nrows = (L == DEPTH - 1) ? NLAT : NROW;
    LAS float* wl = (LAS float*)F.lds;
    {   const f32x4* wg4 = (const f32x4*)(F.w_grp() + (size_t)L * DM * 4); const f32x4* we4 = (const f32x4*)(F.w_exp() + (size_t)L * DM * 16);
        f32x4 tg[2], te[8];
#pragma unroll
        for (int n = 0; n < 2; ++n) tg[n] = wg4[F.tid + 512 * n];
#pragma unroll
        for (int n = 0; n < 8; ++n) te[n] = we4[F.tid + 512 * n];
#pragma unroll
        for (int n = 0; n < 2; ++n) { const int k = F.tid + 512 * n;
#pragma unroll
            for (int o = 0; o < 4; ++o) wl[o * DM + k] = tg[n][o]; }
#pragma unroll
        for (int n = 0; n < 8; ++n) { const int i = F.tid + 512 * n, k = i >> 2, q = i & 3;
#pragma unroll
            for (int o = 0; o < 4; ++o) wl[(4 + 4 * q + o) * DM + k] = te[n][o]; }
    }
    __syncthreads();
    float keep[8];
    int keepg = 0;
#pragma unroll
    for (int o = 0; o < 8; ++o) keep[o] = 0.f;
    f32x4 v[4], vn[4];
    { const int r = F.gw; if (r < nrows) { const float* hp = r < NLAT ? F.out() + (size_t)r * DM : F.hc() + (size_t)(r - NLAT) * DM;
#pragma unroll
        for (int j = 0; j < 4; ++j) vn[j] = *(const f32x4*)(hp + 4 * F.lane + 256 * j); } }
    int it = 0;
    for (int r = F.gw; r < nrows; r += F.NGW, ++it) {
        const bool lat = r < NLAT; const int bb = lat ? (r >> 11) : 8;
#pragma unroll
        for (int j = 0; j < 4; ++j) v[j] = vn[j];
        { const int rn = r + F.NGW; if (rn < nrows) { const float* hp = rn < NLAT ? F.out() + (size_t)rn * DM : F.hc() + (size_t)(rn - NLAT) * DM;
#pragma unroll
            for (int j = 0; j < 4; ++j) vn[j] = *(const f32x4*)(hp + 4 * F.lane + 256 * j); } }
        float ss = 0.f;
#pragma unroll
        for (int j = 0; j < 4; ++j) ss += (v[j][0] * v[j][0] + v[j][1] * v[j][1]) + (v[j][2] * v[j][2] + v[j][3] * v[j][3]);
        const float rstd = rsqrtf(wsum(ss) * (1.f / DM) + EPS);
        const float* md = F.modv() + ((size_t)L * 9 + bb) * 6144;
        float lg[4];
#pragma unroll
        for (int o = 0; o < 4; ++o) lg[o] = 0.f;
#pragma unroll
        for (int j = 0; j < 4; ++j) { const int c = 4 * F.lane + 256 * j; const f32x4 g = *(const f32x4*)(F.g_ffn() + L * DM + c), sh = *(const f32x4*)(md + 3 * 1024 + c), scl = *(const f32x4*)(md + 4 * 1024 + c);
            const f32x4 f = v[j] * rstd * g * (scl + 1.f) + sh; v[j] = f; u32x2 o2; o2.x = pk2(f[0], f[1]); o2.y = pk2(f[2], f[3]); *(u32x2*)(F.abuf() + (size_t)r * DM + c) = o2;
#pragma unroll
            for (int o = 0; o < 4; ++o) { const f32x4 w = *(const LAS f32x4*)(wl + o * DM + c); lg[o] += (f[0] * w[0] + f[1] * w[1]) + (f[2] * w[2] + f[3] * w[3]); } }
        float gl[4]; float gm = -INFINITY; int gt = 0;
#pragma unroll
        for (int o = 0; o < 4; ++o) { gl[o] = wsum(lg[o]) + F.b_grp()[L * 4 + o]; if (gl[o] > gm) { gm = gl[o]; gt = o; } }
        gt = __builtin_amdgcn_readfirstlane(gt);
        float el[4];
#pragma unroll
        for (int o = 0; o < 4; ++o) el[o] = 0.f;
        const LAS float* we = wl + (4 + 4 * gt) * DM;
#pragma unroll
        for (int j = 0; j < 4; ++j) { const int c = 4 * F.lane + 256 * j;
#pragma unroll
            for (int o = 0; o < 4; ++o) { const f32x4 w = *(const LAS f32x4*)(we + o * DM + c); el[o] += (v[j][0] * w[0] + v[j][1] * w[1]) + (v[j][2] * w[2] + v[j][3] * w[3]); } }
#pragma unroll
        for (int o = 0; o < 4; ++o) { const float t = wsum(el[o]) + F.b_exp()[L * 16 + 4 * gt + o]; keep[o] = (F.lane == it) ? gl[o] : keep[o]; keep[4 + o] = (F.lane == it) ? t : keep[4 + o]; }
        keepg = (F.lane == it) ? gt : keepg;
    }
    if (F.lane < it) {
        const int r = F.gw + F.lane * F.NGW; const int gt = keepg;
        float gm = keep[0];
#pragma unroll
        for (int o = 1; o < 4; ++o) gm = fmaxf(gm, keep[o]);
        float gs = 0.f;
#pragma unroll
        for (int o = 0; o < 4; ++o) gs += expf(keep[o] - gm);
        const float gp = 1.f / gs;
        float el[4];
#pragma unroll
        for (int o = 0; o < 4; ++o) el[o] = keep[4 + o];
        int i0 = 0; float m0 = el[0];
#pragma unroll
        for (int o = 1; o < 4; ++o) if (el[o] > m0) { m0 = el[o]; i0 = o; }
        int i1 = i0 == 0 ? 1 : 0; float m1 = i0 == 0 ? el[1] : el[0];
#pragma unroll
        for (int o = 1; o < 4; ++o) if (o != i0 && el[o] > m1) { m1 = el[o]; i1 = o; }
        const float e1 = expf(m1 - m0), w0 = gp / (1.f + e1), w1 = gp * e1 / (1.f + e1);
        const int x0 = gt * 4 + i0, x1 = gt * 4 + i1;
        if (commit) {
            F.rtw()[2 * r] = w0; F.rtw()[2 * r + 1] = w1;
            const unsigned p0 = atomicAdd(F.ctl() + CW_ECNT + (L * 16 + x0) * 64, 1u), p1 = atomicAdd(F.ctl() + CW_ECNT + (L * 16 + x1) * 64, 1u);
            F.elist()[x0 * NROW + p0] = 2 * r; F.elist()[x1 * NROW + p1] = 2 * r + 1; }
        else if (w0 + w1 < -1.f) F.rtw()[0] = 0.f;
    }
    __syncthreads();
}
__device__ __forceinline__ void moe_table(const Fr& F, int L) {
    volatile LAS int* T = (volatile LAS int*)(F.lds + LDSCTL_OFF + 64);
    volatile LAS int* Cn = (volatile LAS int*)(F.lds + LDSCTL_OFF + 160);
    __syncthreads();
    if (F.tid == 0) { int acc = 0;
        for (int e = 0; e < 16; ++e) { int c = (int)__hip_atomic_load(F.ctl() + CW_ECNT + (L * 16 + e) * 64, __ATOMIC_RELAXED, __HIP_MEMORY_SCOPE_AGENT); c = min(max(c, 0), NROW); T[e] = acc; Cn[e] = c; acc += (c + 255) >> 8; }
        T[16] = acc; }
    __syncthreads();
}

__global__ void __launch_bounds__(512, 2) fwd_kernel(Args args) {
    extern __shared__ __attribute__((aligned(16))) unsigned char lds_raw[];
    Fr F0;
    F0.lds = (LAS unsigned char*)lds_raw; F0.tid = threadIdx.x; F0.lane = F0.tid & 63; F0.wave = __builtin_amdgcn_readfirstlane(F0.tid >> 6);
    F0.G = gridDim.x; { const int bx = blockIdx.x; F0.vcu = (F0.G % 8 == 0) ? (bx % 8) * (F0.G / 8) + bx / 8 : bx; }
    F0.gw = F0.vcu * 8 + F0.wave; F0.NGW = F0.G * 8;
    F0.A = (const __attribute__((address_space(4))) Args*)__builtin_amdgcn_kernarg_segment_ptr();
    for (int u = F0.tid; u < (LDS_BYTES - LDSCTL_OFF) / 4; u += 512) ((LAS unsigned*)(F0.lds + LDSCTL_OFF))[u] = 0u;
    __syncthreads();
    const int lo = args.ph_lo, hi = args.ph_hi;
    XcdBarrier bar; bar.bar = F0.ctl() + CW_BAR; bar.x = 0; bar.st = nullptr;
    if (hi - lo > 1) bar = xcd_barrier_post(F0.ctl() + CW_BAR, (volatile LAS unsigned*)(F0.lds + LDSCTL_OFF));
#ifndef PH_MASK
#define PH_MASK 0xFFFF
#endif
#define PM(b) ((PH_MASK >> (b)) & 1)
#ifndef DUP_MASK
#define DUP_MASK 0
#endif
#ifndef DBL_SEAM
#define DBL_SEAM 0
#endif
#define NREP(b) (((DUP_MASK >> (b)) & 1) ? 2 : 1)
#define IN(k) (lo <= (k) && (k) < hi)
#define SEAM(k) do { if (IN(k) && IN((k) + 1)) { const Fr Fb = refresh(F0); XcdBarrier b2 = bar; b2.bar = Fb.ctl() + CW_BAR; xcd_barrier(b2); if ((DUP_MASK & 0x10000) || ((DBL_SEAM >> (((k) + NPH_L - 1) % NPH_L)) & 1)) xcd_barrier(b2); } } while (0)

    if (PM(0) && IN(0)) { for (int rep_ = 0; rep_ < NREP(0); ++rep_) { if (rep_) __syncthreads(); const Fr F = refresh(F0); phase_prologue(F); } }
    SEAM(0);
    for (int L = 0; L < DEPTH; ++L) {
        const int pb = 1 + NPH_L * L;
        const bool lastL = (L == DEPTH - 1);
        if (PM(1) && IN(pb + 0)) { const Fr F = refresh(F0); phase_norm(F, L); if (DUP_MASK & 2048) { __syncthreads(); phase_norm(F, L, false); } if (L == 0) for (int rp = 0; rp < NREP(10); ++rp) moe_weight_convert(F, 0); }
        SEAM(pb + 0);
        if (PM(2) && IN(pb + 1)) { for (int rep_ = 0; rep_ < NREP(2); ++rep_) { if (rep_) __syncthreads(); const Fr F = refresh(F0); pg8::DenseSched S; S.init(F.abuf(), F.winT() + (size_t)L * NP * DM, DM, NROW, NP, F.G, (int)blockIdx.x); pg8::EpiP E{F.pbuf()}; pg8::gemm_phase(F.lds, F.tid, DM, S, E); } }
        SEAM(pb + 1);
        if (PM(3) && IN(pb + 2)) { for (int rep_ = 0; rep_ < NREP(3); ++rep_) { if (rep_) __syncthreads(); const Fr F = refresh(F0); phase_prep(F, L); } }
        SEAM(pb + 2);
        if (PM(4) && IN(pb + 4)) { for (int rep_ = 0; rep_ < NREP(6); ++rep_) { if (rep_) __syncthreads(); const Fr F = refresh(F0); phase_ssd_scan(F, L); } }
        SEAM(pb + 4);
        if (PM(5) && IN(pb + 5)) { for (int rep_ = 0; rep_ < NREP(5); ++rep_) { if (rep_) __syncthreads(); const Fr F = refresh(F0); phase_mix_fast(F, L); } }
        SEAM(pb + 5);
        if (PM(6) && IN(pb + 6)) { const Fr F = refresh(F0); pg8::DenseSched S; S.init(F.mix(), F.woutT() + (size_t)L * DM * DM, DM, lastL ? NLAT : NROW, DM, F.G, (int)blockIdx.x);
            pg8::EpiRes E{L == 0 ? F.x() : F.out(), L == 0 ? F.ctx() : F.hc(), F.out(), F.hc(), F.modv() + (size_t)L * 9 * 6144 + 2 * 1024, 1.f}; pg8::gemm_phase(F.lds, F.tid, DM, S, E);
            if (!lastL && blockIdx.x >= 32) { __syncthreads(); moe_weight_convert(F, L + 1, ((int)blockIdx.x - 32) * 8 + F.wave, (F.G - 32) * 8); __syncthreads(); }
            if (DUP_MASK & 8192) { __syncthreads(); pg8::EpiRes E2{F.out(), F.hc(), F.out(), F.hc(), F.modv() + (size_t)L * 9 * 6144 + 2 * 1024, 0.f}; pg8::gemm_phase(F.lds, F.tid, DM, S, E2); } }
        SEAM(pb + 6);
        if (PM(7) && IN(pb + 7)) { const Fr F = refresh(F0); phase_route(F, L); if (DUP_MASK & 4096) phase_route(F, L, false); }
        SEAM(pb + 7);
        if (PM(8) && IN(pb + 8)) { for (int rep_ = 0; rep_ < NREP(8); ++rep_) { if (rep_) __syncthreads(); const Fr F = refresh(F0); moe_table(F, L);
            pg8::MoeSched<true> S{(const char*)F.abuf(), (const char*)F.wgu(L & 1), (size_t)1024 * DM * 2, DM, F.G, F.vcu, F.elist(), (const volatile LAS int*)(F.lds + LDSCTL_OFF + 64), (const volatile LAS int*)(F.lds + LDSCTL_OFF + 160)};
            pg8::EpiAct E{F.act()}; pg8::gemm_phase(F.lds, F.tid, DM, S, E); } }
        SEAM(pb + 8);
        if (PM(9) && IN(pb + 9)) { for (int rep_ = 0; rep_ < NREP(9); ++rep_) { if (rep_) __syncthreads(); const Fr F = refresh(F0); moe_table(F, L);
            pg8::MoeSched<false> S{(const char*)F.act(), (const char*)F.wd(L & 1), (size_t)1024 * FF * 2, FF, F.G, F.vcu, F.elist(), (const volatile LAS int*)(F.lds + LDSCTL_OFF + 64), (const volatile LAS int*)(F.lds + LDSCTL_OFF + 160)};
            pg8::EpiDown E{F.yk(), F.elist(), F.rtw()}; pg8::gemm_phase(F.lds, F.tid, FF, S, E); } }
        SEAM(pb + 9);
    }
    if (PM(1) && IN(PH_FINAL)) { const Fr F = refresh(F0); phase_norm(F, DEPTH); }
#undef IN
#undef SEAM
}

extern "C" void kernel_launch(void* const* d_in, const int* in_sizes, int n_in, void* d_out, int out_size, void* d_ws, size_t ws_size, hipStream_t stream) {
    static int grid = 0;
    if (grid == 0) {
        if (n_in != 36 || out_size != NLAT * DM || ws_size < WS_END) { fprintf(stderr, "kernel_launch: unexpected shapes (n_in %d out %d ws %zu)\n", n_in, out_size, ws_size); grid = -1; return; }
        int dev = 0, cus = 0, per_cu = 0;
        if (hipGetDevice(&dev) != hipSuccess || hipDeviceGetAttribute(&cus, hipDeviceAttributeMultiprocessorCount, dev) != hipSuccess) { grid = -1; return; }
        if (hipFuncSetAttribute((const void*)fwd_kernel, hipFuncAttributeMaxDynamicSharedMemorySize, LDS_BYTES) != hipSuccess) { fprintf(stderr, "kernel_launch: hipFuncSetAttribute failed\n"); grid = -1; return; }
        if (hipOccupancyMaxActiveBlocksPerMultiprocessor(&per_cu, (const void*)fwd_kernel, 512, LDS_BYTES) != hipSuccess || per_cu < 1) { fprintf(stderr, "kernel_launch: occupancy query says %d\n", per_cu); }
        (void)hipGetLastError();
        grid = cus;
    }
    if (grid < 0) return;
    (void)hipMemsetAsync((char*)d_ws + WS_CTL, 0, CTL_BYTES, stream);
    Args a{};
    for (int i = 0; i < 36; ++i) a.in[i] = (const float*)d_in[i];
    a.out = (float*)d_out; a.ws = (unsigned char*)d_ws;
#if MK_ONE_LAUNCH
    a.ph_lo = 0; a.ph_hi = NPHASE;
    hipLaunchKernelGGL(fwd_kernel, dim3(grid), dim3(512), LDS_BYTES, stream, a);
#else
    for (int ph = 0; ph < NPHASE; ++ph) { a.ph_lo = ph; a.ph_hi = ph + 1; hipLaunchKernelGGL(fwd_kernel, dim3(grid), dim3(512), LDS_BYTES, stream, a); }
#endif
}
```
